# Optimizing an MI355X kernel written in HIP

```python
import math
import jax, jax.numpy as jnp
from jax import lax
import numpy as np

D_MODEL = 1024
BATCH = 8
SEQ = 4096
DEPTH = 4

D_MIX = D_MODEL
HEAD_DIM = 64
N_Q_HEADS = 8
N_KV_HEADS = 2
GQA_GROUP = N_Q_HEADS // N_KV_HEADS
D_ATTN = N_Q_HEADS * HEAD_DIM
D_KV = N_KV_HEADS * HEAD_DIM
WINDOW = 128
ATT_BLOCK = 128
N_BUCKETS = 32
MAX_DISTANCE = 128
D_CONV = D_MIX // 4
CONV_WIDTH = 3
D_SGU = D_MIX // 4
SGU_GROUPS = 4
SGU_GROUP_DIM = D_SGU // SGU_GROUPS
SGU_CHUNK = 128
IN_SPLITS = (D_ATTN, D_KV, D_KV, D_CONV, D_CONV, D_CONV, D_SGU, D_SGU)
D_IN = D_ATTN + 2 * D_KV + 3 * D_CONV + 2 * D_SGU
PEER_HEADS = 8
PEER_TOPK = 16
N_KEYS = 128
N_EXPERTS = N_KEYS * N_KEYS
PEER_QDIM = 256
PEER_HALF = PEER_QDIM // 2
PEER_TOKEN_BLOCK = 128
EPS = 1e-6
NEG_INF = -1e30

kernel_name = "hybrid_conv_swa_sgu_peer_adaln"


def rms_norm(x, g):
    xf = x.astype(jnp.float32)
    y = xf * lax.rsqrt(jnp.mean(xf * xf, axis=-1, keepdims=True) + EPS)
    return (y * g.astype(jnp.float32)).astype(x.dtype)


def t5_causal_bucket(dist):
    max_exact = N_BUCKETS // 2
    d = jnp.maximum(dist, 0)
    log_ratio = jnp.log(jnp.maximum(d, 1).astype(jnp.float32) / max_exact) / math.log(MAX_DISTANCE / max_exact)
    large = max_exact + (log_ratio * (N_BUCKETS - max_exact)).astype(jnp.int32)
    large = jnp.minimum(large, N_BUCKETS - 1)
    return jnp.where(d < max_exact, d, large)


def sliding_window_attention(q, k, v, sink, rel_bias):
    B, S = q.shape[0], q.shape[1]
    nb = S // ATT_BLOCK
    qb = q.reshape(B, nb, ATT_BLOCK, N_KV_HEADS, GQA_GROUP, HEAD_DIM)
    kb = k.reshape(B, nb, ATT_BLOCK, N_KV_HEADS, HEAD_DIM)
    vb = v.reshape(B, nb, ATT_BLOCK, N_KV_HEADS, HEAD_DIM)

    def with_prev(t):
        prev = jnp.pad(t[:, :-1], ((0, 0), (1, 0), (0, 0), (0, 0), (0, 0)))
        return jnp.concatenate([prev, t], axis=2)

    kw, vw = with_prev(kb), with_prev(vb)
    logits = jnp.einsum('bnqkgd,bnskd->bnkgqs', qb, kw,
                        preferred_element_type=jnp.float32) * (HEAD_DIM ** -0.5)
    q_idx = jnp.arange(ATT_BLOCK)[:, None]
    s_idx = jnp.arange(2 * ATT_BLOCK)[None, :]
    dist = q_idx + ATT_BLOCK - s_idx
    in_window = (dist >= 0) & (dist < WINDOW)
    blk = jnp.arange(nb)[:, None, None]
    key_exists = (blk * ATT_BLOCK + s_idx[None] - ATT_BLOCK) >= 0
    mask = in_window[None] & key_exists
    bias = rel_bias.astype(jnp.float32)[t5_causal_bucket(dist)]
    bias = bias.transpose(2, 0, 1).reshape(N_KV_HEADS, GQA_GROUP, ATT_BLOCK, 2 * ATT_BLOCK)
    logits = jnp.where(mask[None, :, None, None], logits + bias, NEG_INF)
    sink_l = sink.astype(jnp.float32).reshape(1, 1, N_KV_HEADS, GQA_GROUP, 1, 1)
    m = jnp.maximum(jnp.max(logits, axis=-1, keepdims=True), sink_l)
    p = jnp.exp(logits - m)
    p = p / (jnp.sum(p, axis=-1, keepdims=True) + jnp.exp(sink_l - m))
    out = jnp.einsum('bnkgqs,bnskd->bnqkgd', p.astype(v.dtype), vw)
    return out.reshape(B, S, D_ATTN)


def short_conv_mixer(b_gate, c_gate, h, conv_w):
    S = h.shape[1]
    z = c_gate * h
    zp = jnp.pad(z, ((0, 0), (CONV_WIDTH - 1, 0), (0, 0)))
    conv = zp[:, 0:S] * conv_w[0]
    for j in range(1, CONV_WIDTH):
        conv = conv + zp[:, j:j + S] * conv_w[j]
    return b_gate * conv


def chunked_spatial_gating(u, v, w_s, b_s):
    B, S = u.shape[0], u.shape[1]
    nc = S // SGU_CHUNK
    vf = v.astype(jnp.float32).reshape(B, S, SGU_GROUPS, SGU_GROUP_DIM)
    mu = jnp.mean(vf, axis=-1, keepdims=True)
    var = jnp.mean(jnp.square(vf - mu), axis=-1, keepdims=True)
    vn = ((vf - mu) * lax.rsqrt(var + EPS)).astype(v.dtype)
    vn = vn.reshape(B, nc, SGU_CHUNK, SGU_GROUPS, SGU_GROUP_DIM)
    causal = jnp.tril(jnp.ones((SGU_CHUNK, SGU_CHUNK), dtype=w_s.dtype))
    w = w_s * causal[None]
    mixed = jnp.einsum('gts,bnsgc->bntgc', w, vn) + b_s.T[None, None, :, :, None]
    return u * mixed.reshape(B, S, D_SGU)


def peer_ffn(h, w_pq, sub_keys, expert_down, expert_up):
    B, S, D = h.shape
    tokens = h.reshape(-1, PEER_TOKEN_BLOCK, D)

    def block(t):
        T = t.shape[0]
        q = (t @ w_pq).reshape(T, PEER_HEADS, 2, PEER_HALF)
        s = jnp.einsum('thpk,hpnk->thpn', q, sub_keys, preferred_element_type=jnp.float32)
        top_s, top_i = lax.top_k(s, PEER_TOPK)
        cand_s = top_s[:, :, 0, :, None] + top_s[:, :, 1, None, :]
        cand_i = top_i[:, :, 0, :, None] * N_KEYS + top_i[:, :, 1, None, :]
        best_s, best_pos = lax.top_k(cand_s.reshape(T, PEER_HEADS, PEER_TOPK * PEER_TOPK), PEER_TOPK)
        experts = jnp.take_along_axis(cand_i.reshape(T, PEER_HEADS, PEER_TOPK * PEER_TOPK), best_pos, axis=-1)
        gate = jax.nn.softmax(best_s, axis=-1)
        u = expert_down[experts]
        act = jax.nn.gelu(jnp.einsum('td,thkd->thk', t, u, preferred_element_type=jnp.float32),
                          approximate=False)
        wgt = (gate * act).astype(t.dtype)
        vv = expert_up[experts]
        return jnp.einsum('thk,thkd->td', wgt, vv)

    return lax.map(block, tokens).reshape(B, S, D)


def hybrid_layer(x, c_act, rel_bias, w_ada, b_ada, norm1_g, norm2_g, w_in, q_norm_g, k_norm_g,
                 attn_sink, conv_w, sgu_w, sgu_b, out_norm_g, w_out, peer_wq, peer_sub_keys,
                 peer_down, peer_up):
    B, S = x.shape[0], x.shape[1]
    mod = (c_act @ w_ada + b_ada)[:, None, :]
    sh1, sc1, g1, sh2, sc2, g2 = jnp.split(mod, 6, axis=-1)
    h = rms_norm(x, norm1_g) * (1 + sc1) + sh1
    proj = h @ w_in
    split_pts = [int(i) for i in np.cumsum(IN_SPLITS)[:-1]]
    q, k, v, cb, cc, ch, su, sv = jnp.split(proj, split_pts, axis=-1)
    q = rms_norm(q.reshape(B, S, N_Q_HEADS, HEAD_DIM), q_norm_g)
    k = rms_norm(k.reshape(B, S, N_KV_HEADS, HEAD_DIM), k_norm_g)
    v = v.reshape(B, S, N_KV_HEADS, HEAD_DIM)
    y_attn = sliding_window_attention(q, k, v, attn_sink, rel_bias)
    y_conv = short_conv_mixer(cb, cc, ch, conv_w)
    y_sgu = chunked_spatial_gating(su, sv, sgu_w, sgu_b)
    ga, gc, gs = jnp.split(out_norm_g, [D_ATTN, D_ATTN + D_CONV])
    merged = jnp.concatenate([rms_norm(y_attn, ga), rms_norm(y_conv, gc), rms_norm(y_sgu, gs)], axis=-1)
    x = x + g1 * (merged @ w_out)
    h2 = rms_norm(x, norm2_g) * (1 + sc2) + sh2
    x = x + g2 * peer_ffn(h2, peer_wq, peer_sub_keys, peer_down, peer_up)
    return x


def setup_inputs(seed: int = 0) -> dict:
    key = jax.random.key(seed)
    ks = jax.random.split(key, 20)
    f32 = jnp.float32
    nrm = lambda k, shape, s: jax.random.normal(k, shape, f32) * s
    return {
        "x": nrm(ks[0], (BATCH, SEQ, D_MODEL), 1.0),
        "c": nrm(ks[1], (BATCH, D_MODEL), 1.0),
        "rel_bias": nrm(ks[2], (N_BUCKETS, N_Q_HEADS), 0.5),
        "w_ada": nrm(ks[3], (DEPTH, D_MODEL, 6 * D_MODEL), 0.5 * D_MODEL ** -0.5),
        "b_ada": nrm(ks[4], (DEPTH, 6 * D_MODEL), 0.02),
        "norm1_g": 1.0 + nrm(ks[5], (DEPTH, D_MODEL), 0.02),
        "norm2_g": 1.0 + nrm(ks[6], (DEPTH, D_MODEL), 0.02),
        "w_in": nrm(ks[7], (DEPTH, D_MODEL, D_IN), D_MODEL ** -0.5),
        "q_norm_g": 1.0 + nrm(ks[8], (DEPTH, HEAD_DIM), 0.02),
        "k_norm_g": 1.0 + nrm(ks[9], (DEPTH, HEAD_DIM), 0.02),
        "attn_sink": nrm(ks[10], (DEPTH, N_Q_HEADS), 0.5),
        "conv_w": nrm(ks[11], (DEPTH, CONV_WIDTH, D_CONV), CONV_WIDTH ** -0.5),
        "sgu_w": nrm(ks[12], (DEPTH, SGU_GROUPS, SGU_CHUNK, SGU_CHUNK), SGU_CHUNK ** -0.5),
        "sgu_b": 1.0 + nrm(ks[13], (DEPTH, SGU_GROUPS, SGU_CHUNK), 0.02),
        "out_norm_g": 1.0 + nrm(ks[14], (DEPTH, D_MIX), 0.02),
        "w_out": nrm(ks[15], (DEPTH, D_MIX, D_MODEL), D_MIX ** -0.5),
        "peer_wq": nrm(ks[16], (DEPTH, D_MODEL, PEER_HEADS * PEER_QDIM), D_MODEL ** -0.5),
        "peer_sub_keys": nrm(ks[17], (DEPTH, PEER_HEADS, 2, N_KEYS, PEER_HALF), PEER_HALF ** -0.5),
        "peer_down": nrm(ks[18], (DEPTH, N_EXPERTS, D_MODEL), D_MODEL ** -0.5),
        "peer_up": nrm(ks[19], (DEPTH, N_EXPERTS, D_MODEL), 0.5 * PEER_HEADS ** -0.5),
    }


def reference(x, c, rel_bias, w_ada, b_ada, norm1_g, norm2_g, w_in, q_norm_g, k_norm_g, attn_sink,
              conv_w, sgu_w, sgu_b, out_norm_g, w_out, peer_wq, peer_sub_keys, peer_down, peer_up):
    c_act = jax.nn.silu(c)
    for l in range(DEPTH):
        x = hybrid_layer(x, c_act, rel_bias, w_ada[l], b_ada[l], norm1_g[l], norm2_g[l], w_in[l],
                         q_norm_g[l], k_norm_g[l], attn_sink[l], conv_w[l], sgu_w[l], sgu_b[l],
                         out_norm_g[l], w_out[l], peer_wq[l], peer_sub_keys[l], peer_down[l], peer_up[l])
    return x
```

```cpp
#include <hip/hip_runtime.h>
#include <cstdio>
#include <cstdint>

namespace nv {
constexpr int D = 1024, NB = 8, S = 4096, DEPTH = 4, T = NB * S;
constexpr int D_IN = 2048, HD = 64;
constexpr int OFF_Q = 0, OFF_K = 512, OFF_V = 640, OFF_CB = 768, OFF_CC = 1024, OFF_CH = 1280, OFF_SU = 1536, OFF_SV = 1792;
constexpr float EPS = 1e-6f;

__device__ __forceinline__ float wave_sum(float v) {
#pragma unroll
    for (int o = 1; o < 64; o <<= 1) v += __shfl_xor(v, o);
    return v;
}
__device__ __forceinline__ float wave_max(float v) {
#pragma unroll
    for (int o = 1; o < 64; o <<= 1) v = fmaxf(v, __shfl_xor(v, o));
    return v;
}

__global__ __launch_bounds__(256) void k_mod(const float* __restrict__ c, const float* __restrict__ w_ada, const float* __restrict__ b_ada, float* __restrict__ mod) {
    __shared__ float ca[8 * 1024];
    for (int i = threadIdx.x; i < 8192; i += 256) { float v = c[i]; ca[i] = v / (1.f + expf(-v)); }
    __syncthreads();
    const int l = blockIdx.y, j = blockIdx.x * 256 + threadIdx.x;
    const float* w = w_ada + (size_t)l * 1024 * 6144 + j;
    float acc[8];
#pragma unroll
    for (int b = 0; b < 8; ++b) acc[b] = 0.f;
    for (int i = 0; i < 1024; ++i) {
        const float wv = w[(size_t)i * 6144];
#pragma unroll
        for (int b = 0; b < 8; ++b) acc[b] += ca[b * 1024 + i] * wv;
    }
#pragma unroll
    for (int b = 0; b < 8; ++b) mod[((size_t)l * 8 + b) * 6144 + j] = acc[b] + b_ada[l * 6144 + j];
}

__global__ __launch_bounds__(256) void k_norm(const float* __restrict__ x, const float* __restrict__ g, const float* __restrict__ modl, int sh_off, int sc_off, float* __restrict__ h) {
    __shared__ float red[4];
    const int t = blockIdx.x, b = t / S, tid = threadIdx.x;
    const float4 v = ((const float4*)(x + (size_t)t * D))[tid];
    float ss = wave_sum(v.x * v.x + v.y * v.y + v.z * v.z + v.w * v.w);
    if ((tid & 63) == 0) red[tid >> 6] = ss;
    __syncthreads();
    const float tot = red[0] + red[1] + red[2] + red[3];
    const float r = rsqrtf(tot * (1.f / D) + EPS);
    const float* sh = modl + (size_t)b * 6144 + sh_off;
    const float* sc = modl + (size_t)b * 6144 + sc_off;
    const float4 gv = ((const float4*)g)[tid], shv = ((const float4*)sh)[tid], scv = ((const float4*)sc)[tid];
    float4 o;
    o.x = v.x * r * gv.x * (1.f + scv.x) + shv.x;
    o.y = v.y * r * gv.y * (1.f + scv.y) + shv.y;
    o.z = v.z * r * gv.z * (1.f + scv.z) + shv.z;
    o.w = v.w * r * gv.w * (1.f + scv.w) + shv.w;
    ((float4*)(h + (size_t)t * D))[tid] = o;
}

template <int MODE>
__global__ __launch_bounds__(256) void k_gemm(const float* __restrict__ A, const float* __restrict__ Bm, float* __restrict__ C, int M, int N, int K, const float* __restrict__ gate) {
    __shared__ float As[16][68];
    __shared__ float Bs[16][68];
    const int bm = blockIdx.y * 64, bn = blockIdx.x * 64, tid = threadIdx.x, tx = tid & 15, ty = tid >> 4;
    float acc[4][4];
#pragma unroll
    for (int i = 0; i < 4; ++i)
#pragma unroll
        for (int j = 0; j < 4; ++j) acc[i][j] = 0.f;
    const int ar = tid >> 2, ac = (tid & 3) * 4;
    const int br = tid >> 4, bc = (tid & 15) * 4;
    for (int k0 = 0; k0 < K; k0 += 16) {
        const float4 av = *(const float4*)(A + (size_t)(bm + ar) * K + k0 + ac);
        const float4 bv = *(const float4*)(Bm + (size_t)(k0 + br) * N + bn + bc);
        As[ac + 0][ar] = av.x; As[ac + 1][ar] = av.y; As[ac + 2][ar] = av.z; As[ac + 3][ar] = av.w;
        *(float4*)&Bs[br][bc] = bv;
        __syncthreads();
#pragma unroll
        for (int kk = 0; kk < 16; ++kk) {
            const float4 a4 = *(const float4*)&As[kk][ty * 4];
            const float4 b4 = *(const float4*)&Bs[kk][tx * 4];
            const float a[4] = {a4.x, a4.y, a4.z, a4.w}, bb[4] = {b4.x, b4.y, b4.z, b4.w};
#pragma unroll
            for (int i = 0; i < 4; ++i)
#pragma unroll
                for (int j = 0; j < 4; ++j) acc[i][j] += a[i] * bb[j];
        }
        __syncthreads();
    }
#pragma unroll
    for (int i = 0; i < 4; ++i) {
        const int row = bm + ty * 4 + i, col = bn + tx * 4;
        float4* p = (float4*)(C + (size_t)row * N + col);
        if (MODE == 0) { *p = make_float4(acc[i][0], acc[i][1], acc[i][2], acc[i][3]); }
        else {
            const float4 gv = *(const float4*)(gate + (size_t)(row / S) * 6144 + col);
            float4 o = *p;
            o.x += gv.x * acc[i][0]; o.y += gv.y * acc[i][1]; o.z += gv.z * acc[i][2]; o.w += gv.w * acc[i][3];
            *p = o;
        }
    }
}

__global__ __launch_bounds__(256) void k_qknorm(float* __restrict__ proj, const float* __restrict__ qg, const float* __restrict__ kg) {
    const int gw = blockIdx.x * 4 + (threadIdx.x >> 6), lane = threadIdx.x & 63;
    const int t = gw / 10, hh = gw % 10;
    float* p = proj + (size_t)t * D_IN + hh * 64 + lane;
    const float v = *p;
    const float ss = wave_sum(v * v);
    const float g = hh < 8 ? qg[lane] : kg[lane];
    *p = v * rsqrtf(ss * (1.f / 64.f) + EPS) * g;
}

__device__ __forceinline__ int t5_bucket(int d) {
    if (d < 16) return d;
    const float lr = logf((float)d / 16.f) / logf(8.f);
    int large = 16 + (int)(lr * 16.f);
    return large < 31 ? large : 31;
}

__global__ __launch_bounds__(256) void k_attn(const float* __restrict__ proj, const float* __restrict__ rel_bias, const float* __restrict__ sink, float* __restrict__ ypre) {
    const int gw = blockIdx.x * 4 + (threadIdx.x >> 6), lane = threadIdx.x & 63;
    const int t = gw >> 3, qh = gw & 7, kvh = qh >> 2;
    const int pos = t % S;
    const float qv = proj[(size_t)t * D_IN + OFF_Q + qh * 64 + lane];
    float lg[2];
#pragma unroll
    for (int r = 0; r < 2; ++r) {
        const int dist = lane + 64 * r;
        const bool valid = (pos - dist) >= 0;
        const float* kr = proj + (size_t)(valid ? t - dist : t) * D_IN + OFF_K + kvh * 64;
        float a = 0.f;
        for (int d = 0; d < 64; ++d) a += __shfl(qv, d) * kr[d];
        lg[r] = valid ? a * 0.125f + rel_bias[t5_bucket(dist) * 8 + qh] : -1e30f;
    }
    const float sk = sink[qh];
    const float m = fmaxf(wave_max(fmaxf(lg[0], lg[1])), sk);
    const float p0 = expf(lg[0] - m), p1 = expf(lg[1] - m);
    const float den = wave_sum(p0 + p1) + expf(sk - m);
    float o = 0.f;
    for (int j = 0; j < 64; ++j) {
        const float pa = __shfl(p0, j), pb = __shfl(p1, j);
        if (pos - j >= 0) o += pa * proj[(size_t)(t - j) * D_IN + OFF_V + kvh * 64 + lane];
        if (pos - j - 64 >= 0) o += pb * proj[(size_t)(t - j - 64) * D_IN + OFF_V + kvh * 64 + lane];
    }
    ypre[(size_t)t * D + qh * 64 + lane] = o / den;
}

__global__ __launch_bounds__(256) void k_conv(const float* __restrict__ proj, const float* __restrict__ cw, float* __restrict__ ypre) {
    const int t = blockIdx.x, c = threadIdx.x, pos = t % S;
    const float* pr = proj + (size_t)t * D_IN;
    float acc = cw[2 * 256 + c] * (pr[OFF_CC + c] * pr[OFF_CH + c]);
    if (pos >= 1) acc += cw[1 * 256 + c] * (pr[OFF_CC + c - D_IN] * pr[OFF_CH + c - D_IN]);
    if (pos >= 2) acc += cw[0 * 256 + c] * (pr[OFF_CC + c - 2 * D_IN] * pr[OFF_CH + c - 2 * D_IN]);
    ypre[(size_t)t * D + 512 + c] = pr[OFF_CB + c] * acc;
}

__global__ __launch_bounds__(256) void k_sgu(const float* __restrict__ proj, const float* __restrict__ w_s, const float* __restrict__ b_s, float* __restrict__ ypre) {
    __shared__ float vn[128][64];
    const int chunk = blockIdx.x >> 2, g = blockIdx.x & 3, tid = threadIdx.x;
    const int t0 = chunk * 128;
    for (int i = tid; i < 128 * 64; i += 256) { const int s = i >> 6, c = i & 63; vn[s][c] = proj[(size_t)(t0 + s) * D_IN + OFF_SV + g * 64 + c]; }
    __syncthreads();
    if (tid < 128) {
        float mu = 0.f;
        for (int c = 0; c < 64; ++c) mu += vn[tid][c];
        mu *= (1.f / 64.f);
        float var = 0.f;
        for (int c = 0; c < 64; ++c) { const float d = vn[tid][c] - mu; var += d * d; }
        var *= (1.f / 64.f);
        const float r = rsqrtf(var + EPS);
        for (int c = 0; c < 64; ++c) vn[tid][c] = (vn[tid][c] - mu) * r;
    }
    __syncthreads();
    const int c = tid & 63, tg = tid >> 6;
    for (int tt = tg * 32; tt < tg * 32 + 32; ++tt) {
        const float* wr = w_s + ((size_t)g * 128 + tt) * 128;
        float a = 0.f;
        for (int s = 0; s <= tt; ++s) a += wr[s] * vn[s][c];
        a += b_s[g * 128 + tt];
        const size_t tok = (size_t)(t0 + tt);
        ypre[tok * D + 768 + g * 64 + c] = proj[tok * D_IN + OFF_SU + g * 64 + c] * a;
    }
}

__global__ __launch_bounds__(256) void k_merge(const float* __restrict__ ypre, const float* __restrict__ og, float* __restrict__ merged) {
    __shared__ float red[4];
    const int t = blockIdx.x, tid = threadIdx.x, w = tid >> 6;
    const float4 v = ((const float4*)(ypre + (size_t)t * D))[tid];
    const float ss = wave_sum(v.x * v.x + v.y * v.y + v.z * v.z + v.w * v.w);
    if ((tid & 63) == 0) red[w] = ss;
    __syncthreads();
    float r;
    if (w < 2) r = rsqrtf((red[0] + red[1]) * (1.f / 512.f) + EPS);
    else r = rsqrtf(red[w] * (1.f / 256.f) + EPS);
    const float4 gv = ((const float4*)og)[tid];
    ((float4*)(merged + (size_t)t * D))[tid] = make_float4(v.x * r * gv.x, v.y * r * gv.y, v.z * r * gv.z, v.w * r * gv.w);
}

__global__ __launch_bounds__(256) void k_route(const float* __restrict__ qb, const float* __restrict__ keys  , int* __restrict__ ridx, float* __restrict__ rgate) {
    __shared__ float qs[4][256];
    __shared__ float tsv[4][2][16];
    __shared__ int tiv[4][2][16];
    __shared__ float bsv[4][16];
    __shared__ int bev[4][16];
    const int w = threadIdx.x >> 6, lane = threadIdx.x & 63;
    const int gw = blockIdx.x * 4 + w, t = gw >> 3, h = gw & 7;
    for (int i = lane; i < 256; i += 64) qs[w][i] = qb[(size_t)t * 2048 + h * 256 + i];
    __syncthreads();
    for (int p = 0; p < 2; ++p) {
        float sv[2];
#pragma unroll
        for (int r = 0; r < 2; ++r) {
            const int n = lane + 64 * r;
            const float* kr = keys + (((size_t)h * 2 + p) * 128 + n) * 128;
            float a = 0.f;
            for (int k = 0; k < 128; ++k) a += qs[w][p * 128 + k] * kr[k];
            sv[r] = a;
        }
        for (int it = 0; it < 16; ++it) {
            float bv; int bi;
            if (sv[0] >= sv[1]) { bv = sv[0]; bi = lane; } else { bv = sv[1]; bi = lane + 64; }
#pragma unroll
            for (int o = 1; o < 64; o <<= 1) {
                const float ov = __shfl_xor(bv, o); const int oi = __shfl_xor(bi, o);
                if (ov > bv || (ov == bv && oi < bi)) { bv = ov; bi = oi; }
            }
            if (lane == 0) { tsv[w][p][it] = bv; tiv[w][p][it] = bi; }
            if (bi == lane) sv[0] = -3.0e38f;
            if (bi == lane + 64) sv[1] = -3.0e38f;
        }
    }
    __syncthreads();
    float cv[4];
#pragma unroll
    for (int r = 0; r < 4; ++r) { const int cidx = lane + 64 * r; cv[r] = tsv[w][0][cidx >> 4] + tsv[w][1][cidx & 15]; }
    for (int it = 0; it < 16; ++it) {
        float bv = cv[0]; int bi = lane;
#pragma unroll
        for (int r = 1; r < 4; ++r) if (cv[r] > bv) { bv = cv[r]; bi = lane + 64 * r; }
#pragma unroll
        for (int o = 1; o < 64; o <<= 1) {
            const float ov = __shfl_xor(bv, o); const int oi = __shfl_xor(bi, o);
            if (ov > bv || (ov == bv && oi < bi)) { bv = ov; bi = oi; }
        }
        if (lane == 0) { bsv[w][it] = bv; bev[w][it] = tiv[w][0][bi >> 4] * 128 + tiv[w][1][bi & 15]; }
#pragma unroll
        for (int r = 0; r < 4; ++r) if (bi == lane + 64 * r) cv[r] = -3.0e38f;
    }
    __syncthreads();
    if (lane < 16) {
        const float mx = bsv[w][0];
        float den = 0.f;
        for (int it = 0; it < 16; ++it) den += expf(bsv[w][it] - mx);
        ridx[(size_t)t * 128 + h * 16 + lane] = bev[w][lane];
        rgate[(size_t)t * 128 + h * 16 + lane] = expf(bsv[w][lane] - mx) / den;
    }
}

__global__ __launch_bounds__(256) void k_peer(const float* __restrict__ h2, const int* __restrict__ ridx, const float* __restrict__ rgate, const float* __restrict__ down, const float* __restrict__ up, const float* __restrict__ modl, float* __restrict__ x) {
    __shared__ float wgt[128];
    __shared__ int eid[128];
    const int t = blockIdx.x, tid = threadIdx.x, w = tid >> 6, lane = tid & 63, b = t / S;
    if (tid < 128) eid[tid] = ridx[(size_t)t * 128 + tid];
    float4 hv[4];
#pragma unroll
    for (int j = 0; j < 4; ++j) hv[j] = ((const float4*)(h2 + (size_t)t * D))[lane + 64 * j];
    __syncthreads();
    for (int p = w; p < 128; p += 4) {
        const float4* dr = (const float4*)(down + (size_t)eid[p] * D);
        float a = 0.f;
#pragma unroll
        for (int j = 0; j < 4; ++j) { const float4 dv = dr[lane + 64 * j]; a += hv[j].x * dv.x + hv[j].y * dv.y + hv[j].z * dv.z + hv[j].w * dv.w; }
        a = wave_sum(a);
        if (lane == 0) wgt[p] = rgate[(size_t)t * 128 + p] * (0.5f * a * (1.f + erff(a * 0.70710678118654752f)));
    }
    __syncthreads();
    float4 o = make_float4(0.f, 0.f, 0.f, 0.f);
    for (int p = 0; p < 128; ++p) {
        const float4 uv = ((const float4*)(up + (size_t)eid[p] * D))[tid];
        const float wv = wgt[p];
        o.x += wv * uv.x; o.y += wv * uv.y; o.z += wv * uv.z; o.w += wv * uv.w;
    }
    const float4 gv = ((const float4*)(modl + (size_t)b * 6144 + 5120))[tid];
    float4* xp = (float4*)(x + (size_t)t * D) + tid;
    float4 xv = *xp;
    xv.x += gv.x * o.x; xv.y += gv.y * o.y; xv.z += gv.z * o.z; xv.w += gv.w * o.w;
    *xp = xv;
}
}

extern "C" void kernel_launch(void* const* d_in, const int* in_sizes, int n_in, void* d_out, int out_size, void* d_ws, size_t ws_size, hipStream_t stream) {
    using namespace nv;
    const float* x_in = (const float*)d_in[0];
    const float* c = (const float*)d_in[1];
    const float* rel_bias = (const float*)d_in[2];
    const float* w_ada = (const float*)d_in[3];
    const float* b_ada = (const float*)d_in[4];
    const float* norm1_g = (const float*)d_in[5];
    const float* norm2_g = (const float*)d_in[6];
    const float* w_in = (const float*)d_in[7];
    const float* q_norm_g = (const float*)d_in[8];
    const float* k_norm_g = (const float*)d_in[9];
    const float* attn_sink = (const float*)d_in[10];
    const float* conv_w = (const float*)d_in[11];
    const float* sgu_w = (const float*)d_in[12];
    const float* sgu_b = (const float*)d_in[13];
    const float* out_norm_g = (const float*)d_in[14];
    const float* w_out = (const float*)d_in[15];
    const float* peer_wq = (const float*)d_in[16];
    const float* peer_sub_keys = (const float*)d_in[17];
    const float* peer_down = (const float*)d_in[18];
    const float* peer_up = (const float*)d_in[19];
    float* x = (float*)d_out;

    const size_t MiB = 1u << 20;
    char* ws = (char*)d_ws;
    float* mod = (float*)(ws);
    float* hbuf = (float*)(ws + 1 * MiB);
    float* proj = (float*)(ws + 129 * MiB);
    float* ypre = (float*)(ws + 385 * MiB);
    int* ridx = (int*)(ws + 513 * MiB);
    float* rgate = (float*)(ws + 529 * MiB);
    if (ws_size < 545 * MiB) { fprintf(stderr, "kernel_launch: workspace too small (%zu)\n", ws_size); return; }

    hipMemcpyAsync(x, x_in, (size_t)T * D * 4, hipMemcpyDeviceToDevice, stream);
    k_mod<<<dim3(24, 4), 256, 0, stream>>>(c, w_ada, b_ada, mod);
    for (int l = 0; l < DEPTH; ++l) {
        const float* modl = mod + (size_t)l * 8 * 6144;
        k_norm<<<T, 256, 0, stream>>>(x, norm1_g + l * D, modl, 0, 1024, hbuf);
        k_gemm<0><<<dim3(D_IN / 64, T / 64), 256, 0, stream>>>(hbuf, w_in + (size_t)l * D * D_IN, proj, T, D_IN, D, nullptr);
        k_qknorm<<<T * 10 / 4, 256, 0, stream>>>(proj, q_norm_g + l * 64, k_norm_g + l * 64);
        k_attn<<<T * 8 / 4, 256, 0, stream>>>(proj, rel_bias, attn_sink + l * 8, ypre);
        k_conv<<<T, 256, 0, stream>>>(proj, conv_w + l * 3 * 256, ypre);
        k_sgu<<<(T / 128) * 4, 256, 0, stream>>>(proj, sgu_w + (size_t)l * 4 * 128 * 128, sgu_b + l * 4 * 128, ypre);
        k_merge<<<T, 256, 0, stream>>>(ypre, out_norm_g + l * D, hbuf);
        k_gemm<1><<<dim3(D / 64, T / 64), 256, 0, stream>>>(hbuf, w_out + (size_t)l * D * D, x, T, D, D, modl + 2048);
        k_norm<<<T, 256, 0, stream>>>(x, norm2_g + l * D, modl, 3072, 4096, hbuf);
        k_gemm<0><<<dim3(2048 / 64, T / 64), 256, 0, stream>>>(hbuf, peer_wq + (size_t)l * D * 2048, proj, T, 2048, D, nullptr);
        k_route<<<T * 8 / 4, 256, 0, stream>>>(proj, peer_sub_keys + (size_t)l * 8 * 2 * 128 * 128, ridx, rgate);
        k_peer<<<T, 256, 0, stream>>>(hbuf, ridx, rgate, peer_down + (size_t)l * 16384 * D, peer_up + (size_t)l * 16384 * D, modl, x);
    }
}
```

```cpp
#include <hip/hip_runtime.h>
#include <cstdio>
#include <cstdint>

namespace nv {
constexpr int D = 1024, NB = 8, S = 4096, DEPTH = 4, T = NB * S;
constexpr int D_IN = 2048, HD = 64;
constexpr int OFF_Q = 0, OFF_K = 512, OFF_V = 640, OFF_CB = 768, OFF_CC = 1024, OFF_CH = 1280, OFF_SU = 1536, OFF_SV = 1792;
constexpr float EPS = 1e-6f;

__device__ __forceinline__ float wave_sum(float v) {
#pragma unroll
    for (int o = 1; o < 64; o <<= 1) v += __shfl_xor(v, o);
    return v;
}
__device__ __forceinline__ float wave_max(float v) {
#pragma unroll
    for (int o = 1; o < 64; o <<= 1) v = fmaxf(v, __shfl_xor(v, o));
    return v;
}

__global__ __launch_bounds__(256) void k_mod(const float* __restrict__ c, const float* __restrict__ w_ada, const float* __restrict__ b_ada, float* __restrict__ mod) {
    __shared__ float ca[8 * 1024];
    for (int i = threadIdx.x; i < 8192; i += 256) { float v = c[i]; ca[i] = v / (1.f + expf(-v)); }
    __syncthreads();
    const int l = blockIdx.y, j = blockIdx.x * 256 + threadIdx.x;
    const float* w = w_ada + (size_t)l * 1024 * 6144 + j;
    float acc[8];
#pragma unroll
    for (int b = 0; b < 8; ++b) acc[b] = 0.f;
    for (int i = 0; i < 1024; ++i) {
        const float wv = w[(size_t)i * 6144];
#pragma unroll
        for (int b = 0; b < 8; ++b) acc[b] += ca[b * 1024 + i] * wv;
    }
#pragma unroll
    for (int b = 0; b < 8; ++b) mod[((size_t)l * 8 + b) * 6144 + j] = acc[b] + b_ada[l * 6144 + j];
}

__global__ __launch_bounds__(256) void k_norm(const float* __restrict__ x, const float* __restrict__ g, const float* __restrict__ modl, int sh_off, int sc_off, float* __restrict__ h) {
    __shared__ float red[4];
    const int t = blockIdx.x, b = t / S, tid = threadIdx.x;
    const float4 v = ((const float4*)(x + (size_t)t * D))[tid];
    float ss = wave_sum(v.x * v.x + v.y * v.y + v.z * v.z + v.w * v.w);
    if ((tid & 63) == 0) red[tid >> 6] = ss;
    __syncthreads();
    const float tot = red[0] + red[1] + red[2] + red[3];
    const float r = rsqrtf(tot * (1.f / D) + EPS);
    const float* sh = modl + (size_t)b * 6144 + sh_off;
    const float* sc = modl + (size_t)b * 6144 + sc_off;
    const float4 gv = ((const float4*)g)[tid], shv = ((const float4*)sh)[tid], scv = ((const float4*)sc)[tid];
    float4 o;
    o.x = v.x * r * gv.x * (1.f + scv.x) + shv.x;
    o.y = v.y * r * gv.y * (1.f + scv.y) + shv.y;
    o.z = v.z * r * gv.z * (1.f + scv.z) + shv.z;
    o.w = v.w * r * gv.w * (1.f + scv.w) + shv.w;
    ((float4*)(h + (size_t)t * D))[tid] = o;
}

template <int MODE>
__global__ __launch_bounds__(256) void k_gemm(const float* __restrict__ A, const float* __restrict__ Bm, float* __restrict__ C, int M, int N, int K, const float* __restrict__ gate) {
    __shared__ float As[16][68];
    __shared__ float Bs[16][68];
    const int bm = blockIdx.y * 64, bn = blockIdx.x * 64, tid = threadIdx.x, tx = tid & 15, ty = tid >> 4;
    float acc[4][4];
#pragma unroll
    for (int i = 0; i < 4; ++i)
#pragma unroll
        for (int j = 0; j < 4; ++j) acc[i][j] = 0.f;
    const int ar = tid >> 2, ac = (tid & 3) * 4;
    const int br = tid >> 4, bc = (tid & 15) * 4;
    for (int k0 = 0; k0 < K; k0 += 16) {
        const float4 av = *(const float4*)(A + (size_t)(bm + ar) * K + k0 + ac);
        const float4 bv = *(const float4*)(Bm + (size_t)(k0 + br) * N + bn + bc);
        As[ac + 0][ar] = av.x; As[ac + 1][ar] = av.y; As[ac + 2][ar] = av.z; As[ac + 3][ar] = av.w;
        *(float4*)&Bs[br][bc] = bv;
        __syncthreads();
#pragma unroll
        for (int kk = 0; kk < 16; ++kk) {
            const float4 a4 = *(const float4*)&As[kk][ty * 4];
            const float4 b4 = *(const float4*)&Bs[kk][tx * 4];
            const float a[4] = {a4.x, a4.y, a4.z, a4.w}, bb[4] = {b4.x, b4.y, b4.z, b4.w};
#pragma unroll
            for (int i = 0; i < 4; ++i)
#pragma unroll
                for (int j = 0; j < 4; ++j) acc[i][j] += a[i] * bb[j];
        }
        __syncthreads();
    }
#pragma unroll
    for (int i = 0; i < 4; ++i) {
        const int row = bm + ty * 4 + i, col = bn + tx * 4;
        float4* p = (float4*)(C + (size_t)row * N + col);
        if (MODE == 0) { *p = make_float4(acc[i][0], acc[i][1], acc[i][2], acc[i][3]); }
        else {
            const float4 gv = *(const float4*)(gate + (size_t)(row / S) * 6144 + col);
            float4 o = *p;
            o.x += gv.x * acc[i][0]; o.y += gv.y * acc[i][1]; o.z += gv.z * acc[i][2]; o.w += gv.w * acc[i][3];
            *p = o;
        }
    }
}

__global__ __launch_bounds__(256) void k_qknorm(float* __restrict__ proj, const float* __restrict__ qg, const float* __restrict__ kg) {
    const int gw = blockIdx.x * 4 + (threadIdx.x >> 6), lane = threadIdx.x & 63;
    const int t = gw / 10, hh = gw % 10;
    float* p = proj + (size_t)t * D_IN + hh * 64 + lane;
    const float v = *p;
    const float ss = wave_sum(v * v);
    const float g = hh < 8 ? qg[lane] : kg[lane];
    *p = v * rsqrtf(ss * (1.f / 64.f) + EPS) * g;
}

__device__ __forceinline__ int t5_bucket(int d) {
    if (d < 16) return d;
    const float lr = logf((float)d / 16.f) / logf(8.f);
    int large = 16 + (int)(lr * 16.f);
    return large < 31 ? large : 31;
}

__global__ __launch_bounds__(256) void k_attn(const float* __restrict__ proj, const float* __restrict__ rel_bias, const float* __restrict__ sink, float* __restrict__ ypre) {
    const int gw = blockIdx.x * 4 + (threadIdx.x >> 6), lane = threadIdx.x & 63;
    const int t = gw >> 3, qh = gw & 7, kvh = qh >> 2;
    const int pos = t % S;
    const float qv = proj[(size_t)t * D_IN + OFF_Q + qh * 64 + lane];
    float lg[2];
#pragma unroll
    for (int r = 0; r < 2; ++r) {
        const int dist = lane + 64 * r;
        const bool valid = (pos - dist) >= 0;
        const float* kr = proj + (size_t)(valid ? t - dist : t) * D_IN + OFF_K + kvh * 64;
        float a = 0.f;
        for (int d = 0; d < 64; ++d) a += __shfl(qv, d) * kr[d];
        lg[r] = valid ? a * 0.125f + rel_bias[t5_bucket(dist) * 8 + qh] : -1e30f;
    }
    const float sk = sink[qh];
    const float m = fmaxf(wave_max(fmaxf(lg[0], lg[1])), sk);
    const float p0 = expf(lg[0] - m), p1 = expf(lg[1] - m);
    const float den = wave_sum(p0 + p1) + expf(sk - m);
    float o = 0.f;
    for (int j = 0; j < 64; ++j) {
        const float pa = __shfl(p0, j), pb = __shfl(p1, j);
        if (pos - j >= 0) o += pa * proj[(size_t)(t - j) * D_IN + OFF_V + kvh * 64 + lane];
        if (pos - j - 64 >= 0) o += pb * proj[(size_t)(t - j - 64) * D_IN + OFF_V + kvh * 64 + lane];
    }
    ypre[(size_t)t * D + qh * 64 + lane] = o / den;
}

__global__ __launch_bounds__(256) void k_conv(const float* __restrict__ proj, const float* __restrict__ cw, float* __restrict__ ypre) {
    const int t = blockIdx.x, c = threadIdx.x, pos = t % S;
    const float* pr = proj + (size_t)t * D_IN;
    float acc = cw[2 * 256 + c] * (pr[OFF_CC + c] * pr[OFF_CH + c]);
    if (pos >= 1) acc += cw[1 * 256 + c] * (pr[OFF_CC + c - D_IN] * pr[OFF_CH + c - D_IN]);
    if (pos >= 2) acc += cw[0 * 256 + c] * (pr[OFF_CC + c - 2 * D_IN] * pr[OFF_CH + c - 2 * D_IN]);
    ypre[(size_t)t * D + 512 + c] = pr[OFF_CB + c] * acc;
}

__global__ __launch_bounds__(256) void k_sgu(const float* __restrict__ proj, const float* __restrict__ w_s, const float* __restrict__ b_s, float* __restrict__ ypre) {
    __shared__ float vn[128][64];
    const int chunk = blockIdx.x >> 2, g = blockIdx.x & 3, tid = threadIdx.x;
    const int t0 = chunk * 128;
    for (int i = tid; i < 128 * 64; i += 256) { const int s = i >> 6, c = i & 63; vn[s][c] = proj[(size_t)(t0 + s) * D_IN + OFF_SV + g * 64 + c]; }
    __syncthreads();
    if (tid < 128) {
        float mu = 0.f;
        for (int c = 0; c < 64; ++c) mu += vn[tid][c];
        mu *= (1.f / 64.f);
        float var = 0.f;
        for (int c = 0; c < 64; ++c) { const float d = vn[tid][c] - mu; var += d * d; }
        var *= (1.f / 64.f);
        const float r = rsqrtf(var + EPS);
        for (int c = 0; c < 64; ++c) vn[tid][c] = (vn[tid][c] - mu) * r;
    }
    __syncthreads();
    const int c = tid & 63, tg = tid >> 6;
    for (int tt = tg * 32; tt < tg * 32 + 32; ++tt) {
        const float* wr = w_s + ((size_t)g * 128 + tt) * 128;
        float a = 0.f;
        for (int s = 0; s <= tt; ++s) a += wr[s] * vn[s][c];
        a += b_s[g * 128 + tt];
        const size_t tok = (size_t)(t0 + tt);
        ypre[tok * D + 768 + g * 64 + c] = proj[tok * D_IN + OFF_SU + g * 64 + c] * a;
    }
}

__global__ __launch_bounds__(256) void k_merge(const float* __restrict__ ypre, const float* __restrict__ og, float* __restrict__ merged) {
    __shared__ float red[4];
    const int t = blockIdx.x, tid = threadIdx.x, w = tid >> 6;
    const float4 v = ((const float4*)(ypre + (size_t)t * D))[tid];
    const float ss = wave_sum(v.x * v.x + v.y * v.y + v.z * v.z + v.w * v.w);
    if ((tid & 63) == 0) red[w] = ss;
    __syncthreads();
    float r;
    if (w < 2) r = rsqrtf((red[0] + red[1]) * (1.f / 512.f) + EPS);
    else r = rsqrtf(red[w] * (1.f / 256.f) + EPS);
    const float4 gv = ((const float4*)og)[tid];
    ((float4*)(merged + (size_t)t * D))[tid] = make_float4(v.x * r * gv.x, v.y * r * gv.y, v.z * r * gv.z, v.w * r * gv.w);
}

__global__ __launch_bounds__(256) void k_route(const float* __restrict__ qb, const float* __restrict__ keys  , int* __restrict__ ridx, float* __restrict__ rgate) {
    __shared__ float qs[4][256];
    __shared__ float tsv[4][2][16];
    __shared__ int tiv[4][2][16];
    __shared__ float bsv[4][16];
    __shared__ int bev[4][16];
    const int w = threadIdx.x >> 6, lane = threadIdx.x & 63;
    const int gw = blockIdx.x * 4 + w, t = gw >> 3, h = gw & 7;
    for (int i = lane; i < 256; i += 64) qs[w][i] = qb[(size_t)t * 2048 + h * 256 + i];
    __syncthreads();
    for (int p = 0; p < 2; ++p) {
        float sv[2];
#pragma unroll
        for (int r = 0; r < 2; ++r) {
            const int n = lane + 64 * r;
            const float* kr = keys + (((size_t)h * 2 + p) * 128 + n) * 128;
            float a = 0.f;
            for (int k = 0; k < 128; ++k) a += qs[w][p * 128 + k] * kr[k];
            sv[r] = a;
        }
        for (int it = 0; it < 16; ++it) {
            float bv; int bi;
            if (sv[0] >= sv[1]) { bv = sv[0]; bi = lane; } else { bv = sv[1]; bi = lane + 64; }
#pragma unroll
            for (int o = 1; o < 64; o <<= 1) {
                const float ov = __shfl_xor(bv, o); const int oi = __shfl_xor(bi, o);
                if (ov > bv || (ov == bv && oi < bi)) { bv = ov; bi = oi; }
            }
            if (lane == 0) { tsv[w][p][it] = bv; tiv[w][p][it] = bi; }
            if (bi == lane) sv[0] = -3.0e38f;
            if (bi == lane + 64) sv[1] = -3.0e38f;
        }
    }
    __syncthreads();
    float cv[4];
#pragma unroll
    for (int r = 0; r < 4; ++r) { const int cidx = lane + 64 * r; cv[r] = tsv[w][0][cidx >> 4] + tsv[w][1][cidx & 15]; }
    for (int it = 0; it < 16; ++it) {
        float bv = cv[0]; int bi = lane;
#pragma unroll
        for (int r = 1; r < 4; ++r) if (cv[r] > bv) { bv = cv[r]; bi = lane + 64 * r; }
#pragma unroll
        for (int o = 1; o < 64; o <<= 1) {
            const float ov = __shfl_xor(bv, o); const int oi = __shfl_xor(bi, o);
            if (ov > bv || (ov == bv && oi < bi)) { bv = ov; bi = oi; }
        }
        if (lane == 0) { bsv[w][it] = bv; bev[w][it] = tiv[w][0][bi >> 4] * 128 + tiv[w][1][bi & 15]; }
#pragma unroll
        for (int r = 0; r < 4; ++r) if (bi == lane + 64 * r) cv[r] = -3.0e38f;
    }
    __syncthreads();
    if (lane < 16) {
        const float mx = bsv[w][0];
        float den = 0.f;
        for (int it = 0; it < 16; ++it) den += expf(bsv[w][it] - mx);
        ridx[(size_t)t * 128 + h * 16 + lane] = bev[w][lane];
        rgate[(size_t)t * 128 + h * 16 + lane] = expf(bsv[w][lane] - mx) / den;
    }
}

__global__ __launch_bounds__(256) void k_peer(const float* __restrict__ h2, const int* __restrict__ ridx, const float* __restrict__ rgate, const float* __restrict__ down, const float* __restrict__ up, const float* __restrict__ modl, float* __restrict__ x) {
    __shared__ float wgt[128];
    __shared__ int eid[128];
    const int t = blockIdx.x, tid = threadIdx.x, w = tid >> 6, lane = tid & 63, b = t / S;
    if (tid < 128) eid[tid] = ridx[(size_t)t * 128 + tid];
    float4 hv[4];
#pragma unroll
    for (int j = 0; j < 4; ++j) hv[j] = ((const float4*)(h2 + (size_t)t * D))[lane + 64 * j];
    __syncthreads();
    for (int p = w; p < 128; p += 4) {
        const float4* dr = (const float4*)(down + (size_t)eid[p] * D);
        float a = 0.f;
#pragma unroll
        for (int j = 0; j < 4; ++j) { const float4 dv = dr[lane + 64 * j]; a += hv[j].x * dv.x + hv[j].y * dv.y + hv[j].z * dv.z + hv[j].w * dv.w; }
        a = wave_sum(a);
        if (lane == 0) wgt[p] = rgate[(size_t)t * 128 + p] * (0.5f * a * (1.f + erff(a * 0.70710678118654752f)));
    }
    __syncthreads();
    float4 o = make_float4(0.f, 0.f, 0.f, 0.f);
    for (int p = 0; p < 128; ++p) {
        const float4 uv = ((const float4*)(up + (size_t)eid[p] * D))[tid];
        const float wv = wgt[p];
        o.x += wv * uv.x; o.y += wv * uv.y; o.z += wv * uv.z; o.w += wv * uv.w;
    }
    const float4 gv = ((const float4*)(modl + (size_t)b * 6144 + 5120))[tid];
    float4* xp = (float4*)(x + (size_t)t * D) + tid;
    float4 xv = *xp;
    xv.x += gv.x * o.x; xv.y += gv.y * o.y; xv.z += gv.z * o.z; xv.w += gv.w * o.w;
    *xp = xv;
}
}


namespace op {
#define DI __device__ __forceinline__
typedef unsigned short bf16_t;
typedef short bf16x8 __attribute__((ext_vector_type(8)));
typedef float f32x16 __attribute__((ext_vector_type(16)));
typedef float f32x2 __attribute__((ext_vector_type(2)));
typedef unsigned u32x4 __attribute__((ext_vector_type(4)));
typedef unsigned u32x2 __attribute__((ext_vector_type(2)));
typedef __bf16 bf16v2 __attribute__((ext_vector_type(2)));
constexpr int D = 1024, NB = 8, S = 4096, DEPTH = 4, T = NB * S, NTILE = T / 128;
constexpr float EPS = 1e-6f;
#define MFMA32(a, b, c) __builtin_amdgcn_mfma_f32_32x32x16_bf16((a), (b), (c), 0, 0, 0)

DI unsigned pk2(float lo, float hi) { f32x2 v = {lo, hi}; return __builtin_bit_cast(unsigned, __builtin_convertvector(v, bf16v2)); }
DI int crow(int reg, int hh) { return (reg & 3) + 8 * (reg >> 2) + 4 * hh; }
DI float wave_sum(float v) {
#pragma unroll
    for (int o = 1; o < 64; o <<= 1) v += __shfl_xor(v, o);
    return v;
}

DI int col_perm(int npos, int mode) {
    if (mode == 1 && npos >= 1024 && npos < 1536) { const int q = npos - 1024, w = q >> 6, nb = (q >> 5) & 1, r = q & 31; return (nb ? 1280 : 1024) + 32 * w + r; }
    return npos;
}
DI void conv_wfrag_item(const float* __restrict__ W, int N, int KB, bf16_t* __restrict__ WF, int gid, int mode) {
    const int l = gid & 63, kb = (gid >> 6) % KB, nbt = (gid >> 6) / KB, r = l & 31, hh = l >> 5;
    const int n = col_perm(nbt * 32 + r, mode);
    const float* p = W + (size_t)(kb * 16 + 8 * hh) * N + n;
    float v[8];
#pragma unroll
    for (int j = 0; j < 8; ++j) v[j] = p[(size_t)j * N];
    u32x4 o; o.x = pk2(v[0], v[1]); o.y = pk2(v[2], v[3]); o.z = pk2(v[4], v[5]); o.w = pk2(v[6], v[7]);
    *(u32x4*)(WF + (size_t)gid * 8) = o;
}

DI void norm_to_frag(const float* __restrict__ x, const float* __restrict__ g, const float* __restrict__ sh, const float* __restrict__ sc, bf16_t* __restrict__ hA, float* rstd_lds, int tile, int tid) {
    const int w = tid >> 6, lane = tid & 63;
    for (int rr = 0; rr < 16; ++rr) {
        const int row = w * 16 + rr;
        const float4* xr = (const float4*)(x + ((size_t)tile * 128 + row) * D);
        float ss = 0.f;
#pragma unroll
        for (int j = 0; j < 4; ++j) { const float4 v = xr[lane + 64 * j]; ss += v.x * v.x + v.y * v.y + v.z * v.z + v.w * v.w; }
        ss = wave_sum(ss);
        if (lane == 0) rstd_lds[row] = rsqrtf(ss * (1.f / D) + EPS);
    }
    __syncthreads();
    const int r5 = lane & 31, hh = lane >> 5;
    for (int it = w; it < 256; it += 8) {
        const int kb = it >> 2, mb = it & 3, row = mb * 32 + r5, k0 = kb * 16 + 8 * hh;
        const float4* xr = (const float4*)(x + ((size_t)tile * 128 + row) * D + k0);
        const float4 a = xr[0], b = xr[1];
        const float4 g0 = *(const float4*)(g + k0), g1 = *(const float4*)(g + k0 + 4);
        const float4 s0 = *(const float4*)(sc + k0), s1 = *(const float4*)(sc + k0 + 4);
        const float4 h0 = *(const float4*)(sh + k0), h1 = *(const float4*)(sh + k0 + 4);
        const float r = rstd_lds[row];
        u32x4 o;
        o.x = pk2(a.x * r * g0.x * (1.f + s0.x) + h0.x, a.y * r * g0.y * (1.f + s0.y) + h0.y);
        o.y = pk2(a.z * r * g0.z * (1.f + s0.z) + h0.z, a.w * r * g0.w * (1.f + s0.w) + h0.w);
        o.z = pk2(b.x * r * g1.x * (1.f + s1.x) + h1.x, b.y * r * g1.y * (1.f + s1.y) + h1.y);
        o.w = pk2(b.z * r * g1.z * (1.f + s1.z) + h1.z, b.w * r * g1.w * (1.f + s1.w) + h1.w);
        *(u32x4*)(hA + ((size_t)tile * 256 + it) * 512 + lane * 8) = o;
    }
}

template <int ORIENT>
DI void kloop(f32x16 (&acc)[4][2], const bf16_t* __restrict__ At, const bf16_t* __restrict__ W0, const bf16_t* __restrict__ W1, char* lds, int tid, int lane) {
#pragma unroll
    for (int mb = 0; mb < 4; ++mb)
#pragma unroll
        for (int nb = 0; nb < 2; ++nb)
#pragma unroll
            for (int i = 0; i < 16; ++i) acc[mb][nb][i] = 0.f;
    const u32x4* Ag = (const u32x4*)At + tid;
    const u32x4* W0g = (const u32x4*)W0 + lane;
    const u32x4* W1g = (const u32x4*)W1 + lane;
    u32x4 wq[4][2], ar[2];
    ar[0] = Ag[0]; ar[1] = Ag[512];
#pragma unroll
    for (int kk = 0; kk < 4; ++kk) { wq[kk][0] = W0g[kk * 64]; wq[kk][1] = W1g[kk * 64]; }
    *(u32x4*)(lds + tid * 16) = ar[0]; *(u32x4*)(lds + 8192 + tid * 16) = ar[1];
    __syncthreads();
    for (int kc = 0; kc < 16; ++kc) {
        char* cur = lds + (kc & 1) * 16384;
        char* nxt = lds + ((kc + 1) & 1) * 16384;
        const int kn = kc < 15 ? kc + 1 : 15;
        if (kc < 15) { ar[0] = Ag[(kc + 1) * 1024]; ar[1] = Ag[(kc + 1) * 1024 + 512]; }
        __builtin_amdgcn_sched_barrier(0);
#pragma unroll
        for (int kk = 0; kk < 4; ++kk) {
            bf16x8 afr[4];
#pragma unroll
            for (int mb = 0; mb < 4; ++mb) afr[mb] = *(const bf16x8*)(cur + ((kk * 4 + mb) * 64 + lane) * 16);
#pragma unroll
            for (int mb = 0; mb < 4; ++mb)
#pragma unroll
                for (int nb = 0; nb < 2; ++nb) {
                    const bf16x8 wf = __builtin_bit_cast(bf16x8, wq[kk][nb]);
                    if (ORIENT == 0) acc[mb][nb] = MFMA32(afr[mb], wf, acc[mb][nb]);
                    else acc[mb][nb] = MFMA32(wf, afr[mb], acc[mb][nb]);
                }
            wq[kk][0] = W0g[(kn * 4 + kk) * 64]; wq[kk][1] = W1g[(kn * 4 + kk) * 64];
            __builtin_amdgcn_sched_barrier(0);
        }
        if (kc < 15) { *(u32x4*)(nxt + tid * 16) = ar[0]; *(u32x4*)(nxt + 8192 + tid * 16) = ar[1]; }
        __syncthreads();
    }
}

DI void epi_f32row(const f32x16 (&acc)[4][2], float* __restrict__ C, int tile, int col0, int lane) {
    const int r5 = lane & 31, hh = lane >> 5;
    const unsigned boff = (unsigned)((tile * 128 + 4 * hh) * 2048 + col0 + r5);
#pragma unroll
    for (int mb = 0; mb < 4; ++mb)
#pragma unroll
        for (int nb = 0; nb < 2; ++nb)
#pragma unroll
            for (int i = 0; i < 16; ++i)
                C[boff + (unsigned)((mb * 32 + (i & 3) + 8 * (i >> 2)) * 2048 + nb * 32)] = acc[mb][nb][i];
}
DI void epi_resid(const f32x16 (&acc)[4][2], const float* __restrict__ xin, float* __restrict__ xout, const float* __restrict__ gate_b, int tile, int col0, int lane) {
    const int r5 = lane & 31, hh = lane >> 5;
    const unsigned boff = (unsigned)((tile * 128 + 4 * hh) * D + col0 + r5);
#pragma unroll
    for (int nb = 0; nb < 2; ++nb) {
        const float gv = gate_b[col0 + nb * 32 + r5];
#pragma unroll
        for (int mb = 0; mb < 4; ++mb)
#pragma unroll
            for (int i = 0; i < 16; ++i) {
                const unsigned o = boff + (unsigned)((mb * 32 + (i & 3) + 8 * (i >> 2)) * D + nb * 32);
                xout[o] = xin[o] + gv * acc[mb][nb][i];
            }
    }
}

DI void epi_qpf(const f32x16 (&acc)[4][2], bf16_t* __restrict__ QPF, int tile, int ft0, int lane) {
#pragma unroll
    for (int nb = 0; nb < 2; ++nb)
#pragma unroll
        for (int s = 0; s < 2; ++s)
#pragma unroll
            for (int mb = 0; mb < 4; ++mb) {
                const f32x16& a = acc[mb][nb];
                u32x4 o; o.x = pk2(a[8 * s], a[8 * s + 1]); o.y = pk2(a[8 * s + 2], a[8 * s + 3]); o.z = pk2(a[8 * s + 4], a[8 * s + 5]); o.w = pk2(a[8 * s + 6], a[8 * s + 7]);
                *(u32x4*)(QPF + ((unsigned)((((tile * 64 + ft0 + nb) * 2 + s) * 4 + mb) * 64 + lane)) * 8) = o;
            }
}

DI void conv_keys_item(const float* __restrict__ K, bf16_t* __restrict__ KF, int gid) {
    const int lane = gid & 63, s = (gid >> 6) & 1, nbl = (gid >> 7) & 3, nt = (gid >> 9) & 3, hp = gid >> 11;
    const int r = lane & 31, hh = lane >> 5;
    const float* p = K + ((size_t)hp * 128 + nt * 32 + r) * 128 + nbl * 32 + 16 * s + 4 * hh;
    const float4 a = *(const float4*)p, b = *(const float4*)(p + 8);
    u32x4 o; o.x = pk2(a.x, a.y); o.y = pk2(a.z, a.w); o.z = pk2(b.x, b.y); o.w = pk2(b.z, b.w);
    *(u32x4*)(KF + (size_t)gid * 8) = o;
}

DI void conv_table_row(const float* __restrict__ src, unsigned char* __restrict__ dst, float* __restrict__ sc, int lane) {
    const float4* p = (const float4*)src + lane * 4;
    float4 v[4];
    float m = 0.f;
#pragma unroll
    for (int j = 0; j < 4; ++j) { v[j] = p[j]; m = fmaxf(m, fmaxf(fmaxf(fabsf(v[j].x), fabsf(v[j].y)), fmaxf(fabsf(v[j].z), fabsf(v[j].w)))); }
#pragma unroll
    for (int o = 1; o < 64; o <<= 1) m = fmaxf(m, __shfl_xor(m, o));
    const float scale = m > 0.f ? m * (1.f / 416.f) : 1.f;
    const float inv = 1.f / scale;
    u32x4 o;
    unsigned* op = (unsigned*)&o;
#pragma unroll
    for (int j = 0; j < 4; ++j) {
        int wv = 0;
        wv = __builtin_amdgcn_cvt_pk_fp8_f32(v[j].x * inv, v[j].y * inv, wv, false);
        wv = __builtin_amdgcn_cvt_pk_fp8_f32(v[j].z * inv, v[j].w * inv, wv, true);
        op[j] = (unsigned)wv;
    }
    *(u32x4*)(dst + lane * 16) = o;
    if (lane == 0) *sc = scale;
}

DI void ce_desc(int& a, int& b) { const int mx = a > b ? a : b, mn = a > b ? b : a; a = mx; b = mn; }
DI void sort16_desc(int (&v)[16]) {
#pragma unroll
    for (int k = 2; k <= 16; k <<= 1)
#pragma unroll
        for (int j = k >> 1; j > 0; j >>= 1)
#pragma unroll
            for (int i = 0; i < 16; ++i) {
                const int l = i ^ j;
                if (l > i) { if ((i & k) == 0) ce_desc(v[i], v[l]); else ce_desc(v[l], v[i]); }
            }
}
DI void bitonic_merge16_desc(int (&v)[16]) {
#pragma unroll
    for (int j = 8; j > 0; j >>= 1)
#pragma unroll
        for (int i = 0; i < 16; ++i) { const int l = i ^ j; if (l > i) ce_desc(v[i], v[l]); }
}
DI void merge_top16(int (&a)[16], const int (&b)[16]) {
#pragma unroll
    for (int i = 0; i < 16; ++i) a[i] = a[i] > b[15 - i] ? a[i] : b[15 - i];
    bitonic_merge16_desc(a);
}
DI int f2ord(float f) { int b = __float_as_int(f); return b ^ ((b >> 31) & 0x7fffffff); }
DI float ord2f(int k) { return __int_as_float(k ^ ((k >> 31) & 0x7fffffff)); }

DI void route_tile(const bf16_t* __restrict__ QPF, const bf16_t* __restrict__ KF, int* __restrict__ ridx, float* __restrict__ rgate, unsigned char* lds_idx  , int tile, int tid) {
    const int lane = tid & 63, w = __builtin_amdgcn_readfirstlane(tid >> 6);
    const int r5 = lane & 31, hh = lane >> 5;
    unsigned char* myidx = lds_idx + w * 1024;
    for (int task = w; task < 32; task += 8) {
        const int h = task >> 2, tt = task & 3;
        f32x16 acc[2][4];
#pragma unroll
        for (int p = 0; p < 2; ++p)
#pragma unroll
            for (int nt = 0; nt < 4; ++nt)
#pragma unroll
                for (int i = 0; i < 16; ++i) acc[p][nt][i] = 0.f;
        {
            bf16x8 bq[2], ak[2][4];
#define ROUTE_LOAD(buf, step) do { const int p_ = (step) >> 3, ks_ = (step) & 7; \
                bq[buf] = *(const bf16x8*)(QPF + ((unsigned)((((tile * 64 + h * 8 + p_ * 4 + (ks_ >> 1)) * 2 + (ks_ & 1)) * 4 + tt) * 64 + lane)) * 8); \
                _Pragma("unroll") for (int nt = 0; nt < 4; ++nt) ak[buf][nt] = *(const bf16x8*)(KF + ((unsigned)(((((h * 2 + p_) * 4 + nt) * 8 + ks_) * 64) + lane)) * 8); } while (0)
            ROUTE_LOAD(0, 0);
#pragma unroll
            for (int step = 0; step < 16; ++step) {
                if (step < 15) ROUTE_LOAD((step + 1) & 1, step + 1);
#pragma unroll
                for (int nt = 0; nt < 4; ++nt) acc[step >> 3][nt] = MFMA32(ak[step & 1][nt], bq[step & 1], acc[step >> 3][nt]);
                __builtin_amdgcn_sched_barrier(0);
            }
#undef ROUTE_LOAD
        }
        int g[8][16];
#pragma unroll
        for (int nt = 0; nt < 4; ++nt)
#pragma unroll
            for (int i = 0; i < 16; ++i) {
                const unsigned a = __float_as_uint(acc[0][nt][i]), b = __float_as_uint(acc[1][nt][i]);
                auto sw = __builtin_amdgcn_permlane32_swap(a, b, false, false);
                const int n0 = nt * 32 + (i & 3) + 8 * (i >> 2);
                g[nt * 2 + (i >> 3)][i & 7] = (f2ord(__uint_as_float(sw[0])) & ~127) | n0;
                g[nt * 2 + (i >> 3)][8 + (i & 7)] = (f2ord(__uint_as_float(sw[1])) & ~127) | (n0 + 4);
            }
#pragma unroll
        for (int q = 0; q < 8; ++q) sort16_desc(g[q]);
        merge_top16(g[0], g[1]); merge_top16(g[2], g[3]); merge_top16(g[4], g[5]); merge_top16(g[6], g[7]);
        merge_top16(g[0], g[2]); merge_top16(g[4], g[6]);
        merge_top16(g[0], g[4]);
        {
            u32x4 pk;
            unsigned* pp = (unsigned*)&pk;
#pragma unroll
            for (int q = 0; q < 4; ++q) pp[q] = (unsigned)(g[0][4 * q] & 127) | ((unsigned)(g[0][4 * q + 1] & 127) << 8) | ((unsigned)(g[0][4 * q + 2] & 127) << 16) | ((unsigned)(g[0][4 * q + 3] & 127) << 24);
            *(u32x4*)(myidx + lane * 16) = pk;
        }
        float f0[16], f1[16];
#pragma unroll
        for (int i = 0; i < 16; ++i) {
            const unsigned a = (unsigned)g[0][i], b = a;
            auto sw = __builtin_amdgcn_permlane32_swap(a, b, false, false);
            f0[i] = ord2f((int)sw[0] & ~127); f1[i] = ord2f((int)sw[1] & ~127);
        }
        int c0[16], c1[16], c2[16], c3[16];
#pragma unroll
        for (int j = 0; j < 16; ++j) c0[j] = (f2ord(f0[0] + f1[j]) & ~255) | j;
#pragma unroll
        for (int i = 1; i < 16; ++i) c1[i - 1] = (f2ord(f0[i] + f1[0]) & ~255) | (i << 4);
        c1[15] = (int)0x80000000;
#define CK(i, j) ((f2ord(f0[i] + f1[j]) & ~255) | ((i) << 4) | (j))
        c2[0] = CK(1, 1); c2[1] = CK(1, 2); c2[2] = CK(1, 3); c2[3] = CK(1, 4); c2[4] = CK(1, 5); c2[5] = CK(1, 6); c2[6] = CK(1, 7);
        c2[7] = CK(2, 1); c2[8] = CK(2, 2); c2[9] = CK(2, 3); c2[10] = CK(2, 4);
        c2[11] = CK(3, 1); c2[12] = CK(3, 2); c2[13] = CK(3, 3);
        c2[14] = CK(4, 1); c2[15] = CK(4, 2);
        c3[0] = CK(5, 1); c3[1] = CK(6, 1); c3[2] = CK(7, 1);
#undef CK
#pragma unroll
        for (int q = 3; q < 16; ++q) c3[q] = (int)0x80000000;
        sort16_desc(c2);
        ce_desc(c3[0], c3[1]); ce_desc(c3[1], c3[2]); ce_desc(c3[0], c3[1]);
        merge_top16(c0, c1); merge_top16(c2, c3); merge_top16(c0, c2);
        float bs[16], den = 0.f;
#pragma unroll
        for (int i = 0; i < 16; ++i) { bs[i] = __expf(ord2f(c0[i] & ~255) - ord2f(c0[0] & ~255)); den += bs[i]; }
        const float rden = 1.f / den;
        asm volatile("s_waitcnt lgkmcnt(0)" ::: "memory");
        const int tok = tile * 128 + tt * 32 + r5;
#pragma unroll
        for (int q = 0; q < 8; ++q) {
            const int key = (int)__builtin_amdgcn_permlane32_swap((unsigned)c0[q], (unsigned)c0[8 + q], false, false)[0];
            const float gv = __uint_as_float(__builtin_amdgcn_permlane32_swap(__float_as_uint(bs[q]), __float_as_uint(bs[8 + q]), false, false)[0]) * rden;
            const int i = (key >> 4) & 15, j = key & 15;
            const int e = (int)myidx[r5 * 16 + i] * 128 + (int)myidx[(32 + r5) * 16 + j];
            ridx[(unsigned)(tok * 128 + h * 16 + 8 * hh + q)] = e;
            rgate[(unsigned)(tok * 128 + h * 16 + 8 * hh + q)] = gv;
        }
        asm volatile("s_waitcnt lgkmcnt(0)" ::: "memory");
    }
}

DI void peer_token(const bf16_t* __restrict__ hA, const int* __restrict__ ridx, const float* __restrict__ rgate, const unsigned char* __restrict__ TB, const float* __restrict__ SC,
                   const float* __restrict__ g2b, float* __restrict__ x, int t, int lane) {
    const int tile = t >> 7, row = t & 127, mb = row >> 5, r5 = row & 31;
    const bf16_t* hp = hA + ((unsigned)(((tile * 64 + lane) * 4 + mb) * 64 + r5)) * 8;
    const u32x4 ha = *(const u32x4*)hp, hb = *(const u32x4*)(hp + 32 * 8);
    f32x2 hv[8];
    {
        const unsigned hw[8] = {ha.x, ha.y, ha.z, ha.w, hb.x, hb.y, hb.z, hb.w};
#pragma unroll
        for (int q = 0; q < 8; ++q) { hv[q].x = __uint_as_float(hw[q] << 16); hv[q].y = __uint_as_float(hw[q] & 0xffff0000u); }
    }
    f32x2 acc[8];
#pragma unroll
    for (int q = 0; q < 8; ++q) acc[q] = (f32x2){0.f, 0.f};
    const int* ip = ridx + (unsigned)(t * 128);
    const float* gp = rgate + (unsigned)(t * 128);
    for (int p0 = 0; p0 < 128; p0 += 8) {
        int e[8];
        u32x4 dr[8], ur[8];
#pragma unroll
        for (int u = 0; u < 8; ++u) {
            e[u] = __builtin_amdgcn_readfirstlane(ip[p0 + u]);
            const unsigned char* rp = TB + (size_t)e[u] * 2048 + lane * 16;
            dr[u] = *(const u32x4*)rp; ur[u] = *(const u32x4*)(rp + 1024);
        }
        float part[8];
#pragma unroll
        for (int u = 0; u < 8; ++u) {
            const unsigned dw[4] = {dr[u].x, dr[u].y, dr[u].z, dr[u].w};
            f32x2 s2 = (f32x2){0.f, 0.f};
#pragma unroll
            for (int q = 0; q < 4; ++q) {
                const f32x2 lo = __builtin_amdgcn_cvt_pk_f32_fp8((int)dw[q], false), hi = __builtin_amdgcn_cvt_pk_f32_fp8((int)dw[q], true);
                s2 += lo * hv[2 * q]; s2 += hi * hv[2 * q + 1];
            }
            part[u] = s2.x + s2.y;
        }
        float r4[4], r2[2], r1;
        {
            const bool up = (lane & 32) != 0;
#pragma unroll
            for (int q = 0; q < 4; ++q) { const float keep = up ? part[q + 4] : part[q], give = up ? part[q] : part[q + 4]; r4[q] = keep + __shfl_xor(give, 32); }
            const bool up2 = (lane & 16) != 0;
#pragma unroll
            for (int q = 0; q < 2; ++q) { const float keep = up2 ? r4[q + 2] : r4[q], give = up2 ? r4[q] : r4[q + 2]; r2[q] = keep + __shfl_xor(give, 16); }
            const bool up3 = (lane & 8) != 0;
            { const float keep = up3 ? r2[1] : r2[0], give = up3 ? r2[0] : r2[1]; r1 = keep + __shfl_xor(give, 8); }
            r1 += __shfl_xor(r1, 4); r1 += __shfl_xor(r1, 2); r1 += __shfl_xor(r1, 1);
        }
        const int myu = ((lane >> 5) & 1) * 4 + ((lane >> 4) & 1) * 2 + ((lane >> 3) & 1);
        const int me = ip[p0 + myu];
        const float a = r1 * SC[(unsigned)me * 2];
        const float wl = gp[p0 + myu] * (0.5f * a * (1.f + erff(a * 0.70710678118654752f))) * SC[(unsigned)me * 2 + 1];
#pragma unroll
        for (int u = 0; u < 8; ++u) {
            const int src = ((u >> 2) & 1) * 32 + ((u >> 1) & 1) * 16 + (u & 1) * 8;
            const float wv = __int_as_float(__builtin_amdgcn_readlane(__float_as_int(wl), src));
            const unsigned uw[4] = {ur[u].x, ur[u].y, ur[u].z, ur[u].w};
            const f32x2 w2 = (f32x2){wv, wv};
#pragma unroll
            for (int q = 0; q < 4; ++q) {
                const f32x2 lo = __builtin_amdgcn_cvt_pk_f32_fp8((int)uw[q], false), hi = __builtin_amdgcn_cvt_pk_f32_fp8((int)uw[q], true);
                acc[2 * q] += w2 * lo; acc[2 * q + 1] += w2 * hi;
            }
        }
    }
    float4* xp = (float4*)(x + (size_t)t * D + lane * 16);
    const float4* gq = (const float4*)(g2b + lane * 16);
#pragma unroll
    for (int q = 0; q < 4; ++q) {
        float4 xv = xp[q]; const float4 gv = gq[q];
        xv.x += gv.x * acc[2 * q].x; xv.y += gv.y * acc[2 * q].y; xv.z += gv.z * acc[2 * q + 1].x; xv.w += gv.w * acc[2 * q + 1].y;
        xp[q] = xv;
    }
}

DI void epi_qk(f32x16 (&acc)[4][2], const float* __restrict__ gain, float scale, bf16_t* __restrict__ dst, int lane) {
    const int hh = lane >> 5;
    float gv[2][16];
#pragma unroll
    for (int nb = 0; nb < 2; ++nb)
#pragma unroll
        for (int i = 0; i < 16; ++i) gv[nb][i] = gain[nb * 32 + (i & 3) + 8 * (i >> 2) + 4 * hh] * scale;
#pragma unroll
    for (int mb = 0; mb < 4; ++mb) {
        float ss = 0.f;
#pragma unroll
        for (int nb = 0; nb < 2; ++nb)
#pragma unroll
            for (int i = 0; i < 16; ++i) ss += acc[mb][nb][i] * acc[mb][nb][i];
        ss += __shfl_xor(ss, 32);
        const float r = rsqrtf(ss * (1.f / 64.f) + EPS);
#pragma unroll
        for (int nb = 0; nb < 2; ++nb)
#pragma unroll
            for (int s = 0; s < 2; ++s) {
                const f32x16& a = acc[mb][nb];
                u32x4 o;
                o.x = pk2(a[8 * s] * r * gv[nb][8 * s], a[8 * s + 1] * r * gv[nb][8 * s + 1]);
                o.y = pk2(a[8 * s + 2] * r * gv[nb][8 * s + 2], a[8 * s + 3] * r * gv[nb][8 * s + 3]);
                o.z = pk2(a[8 * s + 4] * r * gv[nb][8 * s + 4], a[8 * s + 5] * r * gv[nb][8 * s + 5]);
                o.w = pk2(a[8 * s + 6] * r * gv[nb][8 * s + 6], a[8 * s + 7] * r * gv[nb][8 * s + 7]);
                *(u32x4*)(dst + ((unsigned)(((nb * 2 + s) * 4 + mb) * 64 + lane)) * 8) = o;
            }
    }
}
DI void epi_v(const f32x16 (&acc)[4][2], bf16_t* __restrict__ dst, int lane) {
#pragma unroll
    for (int nb = 0; nb < 2; ++nb)
#pragma unroll
        for (int mb = 0; mb < 4; ++mb)
#pragma unroll
            for (int s = 0; s < 2; ++s) {
                const f32x16& a = acc[mb][nb];
                u32x4 o; o.x = pk2(a[8 * s], a[8 * s + 1]); o.y = pk2(a[8 * s + 2], a[8 * s + 3]); o.z = pk2(a[8 * s + 4], a[8 * s + 5]); o.w = pk2(a[8 * s + 6], a[8 * s + 7]);
                *(u32x4*)(dst + ((unsigned)(((nb * 4 + mb) * 2 + s) * 64 + lane)) * 8) = o;
            }
}
DI void epi_row(const f32x16 (&acc)[4][2], bf16_t* __restrict__ dst, int ld, int lane) {
    const int r5 = lane & 31, hh = lane >> 5;
#pragma unroll
    for (int mb = 0; mb < 4; ++mb)
#pragma unroll
        for (int nb = 0; nb < 2; ++nb)
#pragma unroll
            for (int gq = 0; gq < 4; ++gq) {
                const f32x16& a = acc[mb][nb];
                u32x2 o; o.x = pk2(a[4 * gq], a[4 * gq + 1]); o.y = pk2(a[4 * gq + 2], a[4 * gq + 3]);
                *(u32x2*)(dst + (unsigned)((mb * 32 + r5) * ld + nb * 32 + 8 * gq + 4 * hh)) = o;
            }
}
DI void epi_z(const f32x16 (&acc)[4][2], bf16_t* __restrict__ dst, int lane) {
    const int r5 = lane & 31, hh = lane >> 5;
#pragma unroll
    for (int mb = 0; mb < 4; ++mb)
#pragma unroll
        for (int gq = 0; gq < 4; ++gq) {
            const f32x16 &a = acc[mb][0], &b = acc[mb][1];
            u32x2 o; o.x = pk2(a[4 * gq] * b[4 * gq], a[4 * gq + 1] * b[4 * gq + 1]); o.y = pk2(a[4 * gq + 2] * b[4 * gq + 2], a[4 * gq + 3] * b[4 * gq + 3]);
            *(u32x2*)(dst + (unsigned)((mb * 32 + r5) * 256 + 8 * gq + 4 * hh)) = o;
        }
}
DI void epi_su_park(const f32x16 (&acc)[4][2], unsigned* lds_su, int lane) {
#pragma unroll
    for (int mb = 0; mb < 4; ++mb)
#pragma unroll
        for (int nb = 0; nb < 2; ++nb)
#pragma unroll
            for (int q = 0; q < 8; ++q) lds_su[((mb * 2 + nb) * 8 + q) * 64 + lane] = pk2(acc[mb][nb][2 * q], acc[mb][nb][2 * q + 1]);
}
DI void epi_sv(f32x16 (&acc)[4][2], const bf16_t* __restrict__ SWF  , const float* __restrict__ bs_g, const unsigned* lds_su, bf16_t* __restrict__ dst, int lane) {
    const int r5 = lane & 31, hh = lane >> 5;
    bf16x8 vb[4][2][2];
#pragma unroll
    for (int mb = 0; mb < 4; ++mb) {
#pragma unroll
        for (int i = 0; i < 16; ++i) {
            float s1 = acc[mb][0][i] + acc[mb][1][i];
#pragma unroll
            for (int o = 1; o < 32; o <<= 1) s1 += __shfl_xor(s1, o);
            const float mu = s1 * (1.f / 64.f);
            const float d0 = acc[mb][0][i] - mu, d1 = acc[mb][1][i] - mu;
            float s2 = d0 * d0 + d1 * d1;
#pragma unroll
            for (int o = 1; o < 32; o <<= 1) s2 += __shfl_xor(s2, o);
            const float r = rsqrtf(s2 * (1.f / 64.f) + EPS);
            acc[mb][0][i] = d0 * r; acc[mb][1][i] = d1 * r;
        }
#pragma unroll
        for (int s = 0; s < 2; ++s)
#pragma unroll
            for (int nb = 0; nb < 2; ++nb) {
                const f32x16& a = acc[mb][nb];
                u32x4 o; o.x = pk2(a[8 * s], a[8 * s + 1]); o.y = pk2(a[8 * s + 2], a[8 * s + 3]); o.z = pk2(a[8 * s + 4], a[8 * s + 5]); o.w = pk2(a[8 * s + 6], a[8 * s + 7]);
                vb[mb][s][nb] = __builtin_bit_cast(bf16x8, o);
            }
    }
#pragma unroll
    for (int tb = 0; tb < 4; ++tb) {
        f32x16 y[2];
#pragma unroll
        for (int nb = 0; nb < 2; ++nb)
#pragma unroll
            for (int i = 0; i < 16; ++i) y[nb][i] = 0.f;
#pragma unroll
        for (int kt = 0; kt <= tb; ++kt)
#pragma unroll
            for (int s = 0; s < 2; ++s) {
                const bf16x8 wa = *(const bf16x8*)(SWF + ((unsigned)(((tb * 4 + kt) * 2 + s) * 64 + lane)) * 8);
                y[0] = MFMA32(wa, vb[kt][s][0], y[0]);
                y[1] = MFMA32(wa, vb[kt][s][1], y[1]);
            }
#pragma unroll
        for (int nb = 0; nb < 2; ++nb)
#pragma unroll
            for (int q = 0; q < 8; ++q) {
                const unsigned su2 = lds_su[((tb * 2 + nb) * 8 + q) * 64 + lane];
                const int i0 = 2 * q, i1 = 2 * q + 1;
                const int t0 = tb * 32 + (i0 & 3) + 8 * (i0 >> 2) + 4 * hh, t1 = tb * 32 + (i1 & 3) + 8 * (i1 >> 2) + 4 * hh;
                const float v0 = (y[nb][i0] + bs_g[t0]) * __uint_as_float(su2 << 16), v1 = (y[nb][i1] + bs_g[t1]) * __uint_as_float(su2 & 0xffff0000u);
                const unsigned pk = pk2(v0, v1);
                dst[(unsigned)(t0 * 256 + nb * 32 + r5)] = (bf16_t)(pk & 0xffffu);
                dst[(unsigned)(t1 * 256 + nb * 32 + r5)] = (bf16_t)(pk >> 16);
            }
    }
}

DI void conv_sguw_item(const float* __restrict__ W, bf16_t* __restrict__ SWF, int gid) {
    const int lane = gid & 63, s = (gid >> 6) & 1, kt = (gid >> 7) & 3, tb = (gid >> 9) & 3, g = gid >> 11;
    const int r = lane & 31, hh = lane >> 5, t = tb * 32 + r;
    const float* p = W + ((size_t)g * 128 + t) * 128;
    float v[8];
#pragma unroll
    for (int j = 0; j < 8; ++j) { const int sp = kt * 32 + 16 * s + 8 * (j >> 2) + 4 * hh + (j & 3); v[j] = sp <= t ? p[sp] : 0.f; }
    u32x4 o; o.x = pk2(v[0], v[1]); o.y = pk2(v[2], v[3]); o.z = pk2(v[4], v[5]); o.w = pk2(v[6], v[7]);
    *(u32x4*)(SWF + (size_t)gid * 8) = o;
}

DI int t5_bucket(int d) {
    if (d < 16) return d;
    const float lr = logf((float)d / 16.f) / logf(8.f);
    const int large = 16 + (int)(lr * 16.f);
    return large < 31 ? large : 31;
}

DI void attn_tile(const bf16_t* __restrict__ QF, const bf16_t* __restrict__ KF2, const bf16_t* __restrict__ VF, const float* bias_lds, const float* __restrict__ sink, bf16_t* __restrict__ OR, int tile, int tid) {
    const int lane = tid & 63, w = __builtin_amdgcn_readfirstlane(tid >> 6), r5 = lane & 31, hh = lane >> 5;
    const bool has_prev = (tile & 31) != 0;
    for (int task = w; task < 32; task += 8) {
        const int qh = task >> 2, qt = task & 3, kvh = qh >> 2;
        bf16x8 bq[4];
#pragma unroll
        for (int ks = 0; ks < 4; ++ks) bq[ks] = *(const bf16x8*)(QF + ((unsigned)((((tile * 8 + qh) * 4 + ks) * 4 + qt) * 64 + lane)) * 8);
        f32x16 sc[5];
#pragma unroll
        for (int jj = 0; jj < 5; ++jj) {
#pragma unroll
            for (int i = 0; i < 16; ++i) sc[jj][i] = 0.f;
            const int j = qt + jj;
            if (j >= 4 || has_prev) {
                const int st = j >= 4 ? tile : tile - 1, kt = j & 3;
#pragma unroll
                for (int ks = 0; ks < 4; ++ks) {
                    const bf16x8 ak = *(const bf16x8*)(KF2 + ((unsigned)((((st * 2 + kvh) * 4 + ks) * 4 + kt) * 64 + lane)) * 8);
                    sc[jj] = MFMA32(ak, bq[ks], sc[jj]);
                }
            }
        }
        const float* bl = bias_lds + qh * 128;
        float m = -1e30f;
#pragma unroll
        for (int jj = 0; jj < 5; ++jj) {
            const bool ex = (qt + jj >= 4) || has_prev;
#pragma unroll
            for (int i = 0; i < 16; ++i) {
                const int cr = (i & 3) + 8 * (i >> 2) + 4 * hh;
                const int dist = 128 + r5 - 32 * jj - cr;
                const bool valid = ex && dist >= 0 && dist < 128;
                const float v = valid ? sc[jj][i] + bl[dist & 127] : -1e30f;
                sc[jj][i] = v; m = fmaxf(m, v);
            }
        }
        m = fmaxf(m, __shfl_xor(m, 32));
        const float sk = sink[qh];
        m = fmaxf(m, sk);
        float l = 0.f;
#pragma unroll
        for (int jj = 0; jj < 5; ++jj)
#pragma unroll
            for (int i = 0; i < 16; ++i) { const float p = __expf(sc[jj][i] - m); sc[jj][i] = p; l += p; }
        l += __shfl_xor(l, 32);
        l += __expf(sk - m);
        const float rl = 1.f / l;
        f32x16 o[2];
#pragma unroll
        for (int dt = 0; dt < 2; ++dt)
#pragma unroll
            for (int i = 0; i < 16; ++i) o[dt][i] = 0.f;
#pragma unroll
        for (int jj = 0; jj < 5; ++jj) {
            const int j = qt + jj;
            if (j >= 4 || has_prev) {
                const int st = j >= 4 ? tile : tile - 1, kt = j & 3;
#pragma unroll
                for (int s = 0; s < 2; ++s) {
                    const f32x16& a = sc[jj];
                    u32x4 pp; pp.x = pk2(a[8 * s], a[8 * s + 1]); pp.y = pk2(a[8 * s + 2], a[8 * s + 3]); pp.z = pk2(a[8 * s + 4], a[8 * s + 5]); pp.w = pk2(a[8 * s + 6], a[8 * s + 7]);
                    const bf16x8 pb = __builtin_bit_cast(bf16x8, pp);
#pragma unroll
                    for (int dt = 0; dt < 2; ++dt) {
                        const bf16x8 va = *(const bf16x8*)(VF + ((unsigned)(((((st * 2 + kvh) * 2 + dt) * 4 + kt) * 2 + s) * 64 + lane)) * 8);
                        o[dt] = MFMA32(va, pb, o[dt]);
                    }
                }
            }
        }
        bf16_t* orow = OR + (unsigned)((tile * 128 + qt * 32 + r5) * 512 + qh * 64 + 4 * hh);
#pragma unroll
        for (int dt = 0; dt < 2; ++dt)
#pragma unroll
            for (int gq = 0; gq < 4; ++gq) {
                u32x2 ov; ov.x = pk2(o[dt][4 * gq] * rl, o[dt][4 * gq + 1] * rl); ov.y = pk2(o[dt][4 * gq + 2] * rl, o[dt][4 * gq + 3] * rl);
                *(u32x2*)(orow + dt * 32 + 8 * gq) = ov;
            }
    }
}

DI void unpack8(const u32x4 v, float (&f)[8]) {
    f[0] = __uint_as_float(v.x << 16); f[1] = __uint_as_float(v.x & 0xffff0000u); f[2] = __uint_as_float(v.y << 16); f[3] = __uint_as_float(v.y & 0xffff0000u);
    f[4] = __uint_as_float(v.z << 16); f[5] = __uint_as_float(v.z & 0xffff0000u); f[6] = __uint_as_float(v.w << 16); f[7] = __uint_as_float(v.w & 0xffff0000u);
}
DI void merge_tile(const bf16_t* __restrict__ OR, const bf16_t* __restrict__ CBR, const bf16_t* __restrict__ ZR, const bf16_t* __restrict__ YS, const float* __restrict__ cw  , const float* __restrict__ og  ,
                   bf16_t* __restrict__ mA, int tile, int tid) {
    const int lane = tid & 63, w = tid >> 6;
    for (int rr = 0; rr < 16; ++rr) {
        const int row = w * 16 + rr, t = tile * 128 + row, pos = t & (S - 1);
        float a[8], y[8];
        unpack8(*(const u32x4*)(OR + (unsigned)(t * 512 + lane * 8)), a);
        float ssa = 0.f;
#pragma unroll
        for (int q = 0; q < 8; ++q) ssa += a[q] * a[q];
        ssa = wave_sum(ssa);
        if (lane < 32) {
            const int c0 = lane * 8;
            float cb[8], z0[8], z1[8], z2[8];
            unpack8(*(const u32x4*)(CBR + (unsigned)(t * 256 + c0)), cb);
            unpack8(*(const u32x4*)(ZR + (unsigned)(t * 256 + c0)), z2);
            if (pos >= 1) unpack8(*(const u32x4*)(ZR + (unsigned)((t - 1) * 256 + c0)), z1); else { _Pragma("unroll") for (int q = 0; q < 8; ++q) z1[q] = 0.f; }
            if (pos >= 2) unpack8(*(const u32x4*)(ZR + (unsigned)((t - 2) * 256 + c0)), z0); else { _Pragma("unroll") for (int q = 0; q < 8; ++q) z0[q] = 0.f; }
#pragma unroll
            for (int q = 0; q < 8; ++q) y[q] = cb[q] * (cw[c0 + q] * z0[q] + cw[256 + c0 + q] * z1[q] + cw[512 + c0 + q] * z2[q]);
        } else {
            unpack8(*(const u32x4*)(YS + (unsigned)(t * 256 + (lane - 32) * 8)), y);
        }
        float ssy = 0.f;
#pragma unroll
        for (int q = 0; q < 8; ++q) ssy += y[q] * y[q];
#pragma unroll
        for (int o = 1; o < 32; o <<= 1) ssy += __shfl_xor(ssy, o);
        const float ra = rsqrtf(ssa * (1.f / 512.f) + EPS), ry = rsqrtf(ssy * (1.f / 256.f) + EPS);
        const int mb = row >> 5, r5 = row & 31;
        {
            const float4 g0 = *(const float4*)(og + lane * 8), g1 = *(const float4*)(og + lane * 8 + 4);
            u32x4 o; o.x = pk2(a[0] * ra * g0.x, a[1] * ra * g0.y); o.y = pk2(a[2] * ra * g0.z, a[3] * ra * g0.w); o.z = pk2(a[4] * ra * g1.x, a[5] * ra * g1.y); o.w = pk2(a[6] * ra * g1.z, a[7] * ra * g1.w);
            const int c8 = lane;
            *(u32x4*)(mA + ((unsigned)(((tile * 64 + (c8 >> 1)) * 4 + mb) * 64 + r5 + 32 * (c8 & 1))) * 8) = o;
        }
        {
            const float4 g0 = *(const float4*)(og + 512 + lane * 8), g1 = *(const float4*)(og + 512 + lane * 8 + 4);
            u32x4 o; o.x = pk2(y[0] * ry * g0.x, y[1] * ry * g0.y); o.y = pk2(y[2] * ry * g0.z, y[3] * ry * g0.w); o.z = pk2(y[4] * ry * g1.x, y[5] * ry * g1.y); o.w = pk2(y[6] * ry * g1.z, y[7] * ry * g1.w);
            const int c8 = 64 + lane;
            *(u32x4*)(mA + ((unsigned)(((tile * 64 + (c8 >> 1)) * 4 + mb) * 64 + r5 + 32 * (c8 & 1))) * 8) = o;
        }
    }
}

struct InProjOut { bf16_t *QF, *KF2, *VF, *CBR, *ZR, *YS; };
DI void inproj_tile(const bf16_t* __restrict__ At, const bf16_t* __restrict__ WF, const float* __restrict__ qg, const float* __restrict__ kg, const bf16_t* __restrict__ SWF, const float* __restrict__ sgu_b,
                    const InProjOut& O, char* lds, int tile, int tid) {
    const int lane = tid & 63, w = __builtin_amdgcn_readfirstlane(tid >> 6);
    f32x16 acc[4][2];
    {
        const int nbt0 = w * 2;
        kloop<1>(acc, At, WF + (size_t)nbt0 * 32768, WF + (size_t)(nbt0 + 1) * 32768, lds, tid, lane);
        epi_qk(acc, qg, 0.125f, O.QF + (size_t)(tile * 8 + w) * 8192, lane);
    }
    {
        const int nbt0 = 16 + w * 2;
        if (w == 2 || w == 3) {
            kloop<0>(acc, At, WF + (size_t)nbt0 * 32768, WF + (size_t)(nbt0 + 1) * 32768, lds, tid, lane);
            epi_v(acc, O.VF + (size_t)(tile * 2 + (w - 2)) * 8192, lane);
        } else {
            kloop<1>(acc, At, WF + (size_t)nbt0 * 32768, WF + (size_t)(nbt0 + 1) * 32768, lds, tid, lane);
            if (w < 2) epi_qk(acc, kg, 1.f, O.KF2 + (size_t)(tile * 2 + w) * 8192, lane);
            else epi_row(acc, O.CBR + (size_t)tile * 128 * 256 + (w - 4) * 64, 256, lane);
        }
    }
    {
        const int nbt0 = 32 + w * 2;
        kloop<1>(acc, At, WF + (size_t)nbt0 * 32768, WF + (size_t)(nbt0 + 1) * 32768, lds, tid, lane);
        epi_z(acc, O.ZR + (size_t)tile * 128 * 256 + w * 32, lane);
    }
    {
        const int nbt0 = 48 + w * 2;
        kloop<0>(acc, At, WF + (size_t)nbt0 * 32768, WF + (size_t)(nbt0 + 1) * 32768, lds, tid, lane);
        unsigned* lds_su = (unsigned*)lds;
        if (w < 4) epi_su_park(acc, lds_su + w * 4096, lane);
        __syncthreads();
        if (w >= 4) epi_sv(acc, SWF + (size_t)(w - 4) * 16384, sgu_b + (w - 4) * 128, lds_su + (w - 4) * 4096, O.YS + (size_t)tile * 128 * 256 + (w - 4) * 64, lane);
        __syncthreads();
    }
}

__global__ __launch_bounds__(256) void k_convsgu(const float* __restrict__ W, bf16_t* __restrict__ SWF) { conv_sguw_item(W, SWF, blockIdx.x * 256 + threadIdx.x); }
__global__ __launch_bounds__(512) void k_inproj(const bf16_t* __restrict__ hA, const bf16_t* __restrict__ WF, const float* __restrict__ qg, const float* __restrict__ kg, const bf16_t* __restrict__ SWF, const float* __restrict__ sgu_b, InProjOut O) {
    extern __shared__ __attribute__((aligned(16))) char lds[];
    inproj_tile(hA + (size_t)blockIdx.x * 131072, WF, qg, kg, SWF, sgu_b, O, lds, blockIdx.x, threadIdx.x);
}
__global__ __launch_bounds__(512) void k_mix(InProjOut O, bf16_t* __restrict__ OR, const float* __restrict__ rel_bias, const float* __restrict__ sink, const float* __restrict__ cw, const float* __restrict__ og, bf16_t* __restrict__ mA) {
    __shared__ float bias_lds[8 * 128];
    const int tid = threadIdx.x, tile = blockIdx.x;
    for (int i = tid; i < 1024; i += 512) { const int qh = i >> 7, dist = i & 127; bias_lds[i] = rel_bias[t5_bucket(dist) * 8 + qh]; }
    __syncthreads();
    attn_tile(O.QF, O.KF2, O.VF, bias_lds, sink, OR, tile, tid);
    __syncthreads();
    merge_tile(OR, O.CBR, O.ZR, O.YS, cw, og, mA, tile, tid);
}
__global__ __launch_bounds__(256) void k_convkeys(const float* __restrict__ K, bf16_t* __restrict__ KF) {
    conv_keys_item(K, KF, blockIdx.x * 256 + threadIdx.x);
}
__global__ __launch_bounds__(256) void k_convtab(const float* __restrict__ down, const float* __restrict__ up, unsigned char* __restrict__ TB, float* __restrict__ SC) {
    const int gw = blockIdx.x * 4 + (threadIdx.x >> 6), lane = threadIdx.x & 63;
    const int e = gw >> 1, which = gw & 1;
    conv_table_row((which ? up : down) + (size_t)e * D, TB + (size_t)e * 2048 + which * 1024, SC + e * 2 + which, lane);
}
__global__ __launch_bounds__(512) void k_route_opt(const bf16_t* __restrict__ QPF, const bf16_t* __restrict__ KF, int* __restrict__ ridx, float* __restrict__ rgate) {
    __shared__ __attribute__((aligned(16))) unsigned char lidx[8192];
    route_tile(QPF, KF, ridx, rgate, lidx, blockIdx.x, threadIdx.x);
}
__global__ __launch_bounds__(512) void k_peer_opt(const bf16_t* __restrict__ hA, const int* __restrict__ ridx, const float* __restrict__ rgate, const unsigned char* __restrict__ TB, const float* __restrict__ SC, const float* __restrict__ modl, float* __restrict__ x) {
    const int tile = blockIdx.x, w = threadIdx.x >> 6, lane = threadIdx.x & 63;
    for (int i = 0; i < 16; ++i) { const int t = tile * 128 + w * 16 + i; peer_token(hA, ridx, rgate, TB, SC, modl + (size_t)(t / S) * 6144 + 5120, x, t, lane); }
}
__global__ __launch_bounds__(256) void k_convw(const float* __restrict__ W, int N, int KB, bf16_t* __restrict__ WF, int nitems, int mode) {
    for (int gid = blockIdx.x * 256 + threadIdx.x; gid < nitems; gid += gridDim.x * 256) conv_wfrag_item(W, N, KB, WF, gid, mode);
}
__global__ __launch_bounds__(512) void k_norm_frag(const float* __restrict__ x, const float* __restrict__ g, const float* __restrict__ modl, int sh_off, int sc_off, bf16_t* __restrict__ hA) {
    __shared__ float rstd[128];
    const int tile = blockIdx.x, b = tile / 32;
    norm_to_frag(x, g, modl + (size_t)b * 6144 + sh_off, modl + (size_t)b * 6144 + sc_off, hA, rstd, tile, threadIdx.x);
}
__global__ __launch_bounds__(256) void k_rows_to_frag(const float* __restrict__ src, bf16_t* __restrict__ hA) {
    const int gid = blockIdx.x * 256 + threadIdx.x;
    const int lane = gid & 63, it = (gid >> 6) & 255, tile = gid >> 14;
    const int kb = it >> 2, mb = it & 3, row = mb * 32 + (lane & 31), k0 = kb * 16 + 8 * (lane >> 5);
    const float4* p = (const float4*)(src + ((size_t)tile * 128 + row) * D + k0);
    const float4 a = p[0], b = p[1];
    u32x4 o; o.x = pk2(a.x, a.y); o.y = pk2(a.z, a.w); o.z = pk2(b.x, b.y); o.w = pk2(b.z, b.w);
    *(u32x4*)(hA + (size_t)gid * 8) = o;
}
__global__ __launch_bounds__(512) void k_gemm_opt(const bf16_t* __restrict__ hA, const bf16_t* __restrict__ WF, int npass, int mode, float* __restrict__ C, const float* __restrict__ xin, const float* __restrict__ gate) {
    extern __shared__ __attribute__((aligned(16))) char lds[];
    const int tile = blockIdx.x, tid = threadIdx.x, lane = tid & 63, w = __builtin_amdgcn_readfirstlane(tid >> 6);
    const bf16_t* At = hA + (size_t)tile * 131072;
    for (int pass = 0; pass < npass; ++pass) {
        f32x16 acc[4][2];
        const int nbt0 = pass * 16 + w * 2;
        if (mode == 2) {
            kloop<1>(acc, At, WF + (size_t)nbt0 * 32768, WF + (size_t)(nbt0 + 1) * 32768, lds, tid, lane);
            epi_qpf(acc, (bf16_t*)C, tile, nbt0, lane);
        } else {
            kloop<0>(acc, At, WF + (size_t)nbt0 * 32768, WF + (size_t)(nbt0 + 1) * 32768, lds, tid, lane);
            if (mode == 0) epi_f32row(acc, C, tile, pass * 512 + w * 64, lane);
            else epi_resid(acc, xin, C, gate + (size_t)(tile / 32) * 6144, tile, pass * 512 + w * 64, lane);
        }
    }
}
}

extern "C" void kernel_launch(void* const* d_in, const int* in_sizes, int n_in, void* d_out, int out_size, void* d_ws, size_t ws_size, hipStream_t stream) {
    using namespace nv;
    const float* x_in = (const float*)d_in[0];
    const float* c = (const float*)d_in[1];
    const float* rel_bias = (const float*)d_in[2];
    const float* w_ada = (const float*)d_in[3];
    const float* b_ada = (const float*)d_in[4];
    const float* norm1_g = (const float*)d_in[5];
    const float* norm2_g = (const float*)d_in[6];
    const float* w_in = (const float*)d_in[7];
    const float* q_norm_g = (const float*)d_in[8];
    const float* k_norm_g = (const float*)d_in[9];
    const float* attn_sink = (const float*)d_in[10];
    const float* conv_w = (const float*)d_in[11];
    const float* sgu_w = (const float*)d_in[12];
    const float* sgu_b = (const float*)d_in[13];
    const float* out_norm_g = (const float*)d_in[14];
    const float* w_out = (const float*)d_in[15];
    const float* peer_wq = (const float*)d_in[16];
    const float* peer_sub_keys = (const float*)d_in[17];
    const float* peer_down = (const float*)d_in[18];
    const float* peer_up = (const float*)d_in[19];
    float* x = (float*)d_out;
    constexpr int NTILE_ = 256;

    const size_t MiB = 1u << 20;
    char* ws = (char*)d_ws;
    float* mod = (float*)(ws);
    float* hbuf = (float*)(ws + 1 * MiB);
    float* proj = (float*)(ws + 129 * MiB);
    float* ypre = (float*)(ws + 385 * MiB);
    int* ridx = (int*)(ws + 513 * MiB);
    float* rgate = (float*)(ws + 529 * MiB);
    op::bf16_t* WinF = (op::bf16_t*)(ws + 545 * MiB);
    op::bf16_t* WoutF = (op::bf16_t*)(ws + 561 * MiB);
    op::bf16_t* WpqF = (op::bf16_t*)(ws + 569 * MiB);
    op::bf16_t* hA = (op::bf16_t*)(ws + 585 * MiB);
    op::bf16_t* KeysF = (op::bf16_t*)(ws + 649 * MiB);
    float* SC = (float*)(ws + 651 * MiB);
    unsigned char* TB = (unsigned char*)(ws + 652 * MiB);
    op::bf16_t* SWF = (op::bf16_t*)(ws + 780 * MiB);
    op::InProjOut IO;
    {
        char* P = (char*)proj;
        IO.QF = (op::bf16_t*)(P); IO.KF2 = (op::bf16_t*)(P + 32 * MiB); IO.VF = (op::bf16_t*)(P + 40 * MiB); IO.CBR = (op::bf16_t*)(P + 48 * MiB);
        IO.ZR = (op::bf16_t*)(P + 64 * MiB); IO.YS = (op::bf16_t*)(P + 80 * MiB);
    }
    op::bf16_t* ORb = (op::bf16_t*)((char*)proj + 96 * MiB);
    op::bf16_t* QPF = (op::bf16_t*)((char*)proj + 128 * MiB);
    if (ws_size < 781 * MiB) { fprintf(stderr, "kernel_launch: workspace too small (%zu)\n", ws_size); return; }

    hipMemcpyAsync(x, x_in, (size_t)T * D * 4, hipMemcpyDeviceToDevice, stream);
    k_mod<<<dim3(24, 4), 256, 0, stream>>>(c, w_ada, b_ada, mod);
    for (int l = 0; l < DEPTH; ++l) {
        op::k_convw<<<1024, 256, 0, stream>>>(w_in + (size_t)l * D * D_IN, 2048, 64, WinF + (size_t)l * 2097152, 64 * 64 * 64, 1);
        op::k_convsgu<<<4 * 4 * 4 * 2 * 64 / 256, 256, 0, stream>>>(sgu_w + (size_t)l * 4 * 128 * 128, SWF + (size_t)l * 65536);
        op::k_convw<<<1024, 256, 0, stream>>>(w_out + (size_t)l * D * D, 1024, 64, WoutF + (size_t)l * 1048576, 32 * 64 * 64, 0);
        op::k_convw<<<1024, 256, 0, stream>>>(peer_wq + (size_t)l * D * 2048, 2048, 64, WpqF + (size_t)l * 2097152, 64 * 64 * 64, 0);
        op::k_convkeys<<<8 * 2 * 4 * 4 * 2 * 64 / 256, 256, 0, stream>>>(peer_sub_keys + (size_t)l * 8 * 2 * 128 * 128, KeysF + (size_t)l * 262144);
        op::k_convtab<<<16384 * 2 / 4, 256, 0, stream>>>(peer_down + (size_t)l * 16384 * D, peer_up + (size_t)l * 16384 * D, TB + (size_t)l * 16384 * 2048, SC + (size_t)l * 32768);
    }
    for (int l = 0; l < DEPTH; ++l) {
        const float* modl = mod + (size_t)l * 8 * 6144;
        op::k_norm_frag<<<256, 512, 0, stream>>>(x, norm1_g + l * D, modl, 0, 1024, hA);
        op::k_inproj<<<256, 512, 65536, stream>>>(hA, WinF + (size_t)l * 2097152, q_norm_g + l * 64, k_norm_g + l * 64, SWF + (size_t)l * 65536, sgu_b + l * 4 * 128, IO);
        op::k_mix<<<256, 512, 0, stream>>>(IO, ORb, rel_bias, attn_sink + l * 8, conv_w + l * 3 * 256, out_norm_g + l * D, hA);
        op::k_gemm_opt<<<256, 512, 32768, stream>>>(hA, WoutF + (size_t)l * 1048576, 2, 1, x, x, modl + 2048);
        op::k_norm_frag<<<256, 512, 0, stream>>>(x, norm2_g + l * D, modl, 3072, 4096, hA);
        op::k_gemm_opt<<<256, 512, 32768, stream>>>(hA, WpqF + (size_t)l * 2097152, 4, 2, (float*)QPF, nullptr, nullptr);
        op::k_route_opt<<<256, 512, 0, stream>>>(QPF, KeysF + (size_t)l * 262144, ridx, rgate);
        op::k_peer_opt<<<256, 512, 0, stream>>>(hA, ridx, rgate, TB + (size_t)l * 16384 * 2048, SC + (size_t)l * 32768, modl, x);
    }
}
```

```cpp
#include <hip/hip_runtime.h>
#include <cstdio>
#include <cstdint>
#include <hip/hip_cooperative_groups.h>
namespace cg = cooperative_groups;


namespace op {
#define DI __device__ __forceinline__
typedef unsigned short bf16_t;
typedef short bf16x8 __attribute__((ext_vector_type(8)));
typedef float f32x16 __attribute__((ext_vector_type(16)));
typedef float f32x2 __attribute__((ext_vector_type(2)));
typedef unsigned u32x4 __attribute__((ext_vector_type(4)));
typedef unsigned u32x2 __attribute__((ext_vector_type(2)));
typedef __bf16 bf16v2 __attribute__((ext_vector_type(2)));
constexpr int D = 1024, NB = 8, S = 4096, DEPTH = 4, T = NB * S, NTILE = T / 128;
constexpr float EPS = 1e-6f;
#define MFMA32(a, b, c) __builtin_amdgcn_mfma_f32_32x32x16_bf16((a), (b), (c), 0, 0, 0)

DI unsigned pk2(float lo, float hi) { f32x2 v = {lo, hi}; return __builtin_bit_cast(unsigned, __builtin_convertvector(v, bf16v2)); }
DI int opaque_v(int x) { asm volatile("" : "+v"(x)); return x; }
DI int opaque_s(int x) { asm volatile("" : "+s"(x)); return x; }
DI int crow(int reg, int hh) { return (reg & 3) + 8 * (reg >> 2) + 4 * hh; }
DI float wave_sum(float v) {
#pragma unroll
    for (int o = 1; o < 64; o <<= 1) v += __shfl_xor(v, o);
    return v;
}

DI int col_perm(int npos, int mode) {
    if (mode == 1 && npos >= 1024 && npos < 1536) { const int q = npos - 1024, w = q >> 6, nb = (q >> 5) & 1, r = q & 31; return (nb ? 1280 : 1024) + 32 * w + r; }
    return npos;
}
DI void conv_wfrag_item(const float* __restrict__ W, int N, int KB, bf16_t* __restrict__ WF, int gid, int mode) {
    const int l = gid & 63, kb = (gid >> 6) % KB, nbt = (gid >> 6) / KB, r = l & 31, hh = l >> 5;
    const int n = col_perm(nbt * 32 + r, mode);
    const float* p = W + (size_t)(kb * 16 + 8 * hh) * N + n;
    float v[8];
#pragma unroll
    for (int j = 0; j < 8; ++j) v[j] = p[(size_t)j * N];
    u32x4 o; o.x = pk2(v[0], v[1]); o.y = pk2(v[2], v[3]); o.z = pk2(v[4], v[5]); o.w = pk2(v[6], v[7]);
    *(u32x4*)(WF + (size_t)gid * 8) = o;
}

DI void norm_to_frag(const float* __restrict__ x, const float* __restrict__ g, const float* __restrict__ sh, const float* __restrict__ sc, bf16_t* __restrict__ hA, float* rstd_lds, int tile, int tid) {
    tid = opaque_v(tid); tile = opaque_s(tile);
    const int w = tid >> 6, lane = tid & 63;
    for (int rr = 0; rr < 16; ++rr) {
        const int row = w * 16 + rr;
        const float4* xr = (const float4*)(x + ((size_t)tile * 128 + row) * D);
        float ss = 0.f;
#pragma unroll
        for (int j = 0; j < 4; ++j) { const float4 v = xr[lane + 64 * j]; ss += v.x * v.x + v.y * v.y + v.z * v.z + v.w * v.w; }
        ss = wave_sum(ss);
        if (lane == 0) rstd_lds[row] = rsqrtf(ss * (1.f / D) + EPS);
    }
    __syncthreads();
    const int r5 = lane & 31, hh = lane >> 5;
    for (int it = w; it < 256; it += 8) {
        const int kb = it >> 2, mb = it & 3, row = mb * 32 + r5, k0 = kb * 16 + 8 * hh;
        const float4* xr = (const float4*)(x + ((size_t)tile * 128 + row) * D + k0);
        const float4 a = xr[0], b = xr[1];
        const float4 g0 = *(const float4*)(g + k0), g1 = *(const float4*)(g + k0 + 4);
        const float4 s0 = *(const float4*)(sc + k0), s1 = *(const float4*)(sc + k0 + 4);
        const float4 h0 = *(const float4*)(sh + k0), h1 = *(const float4*)(sh + k0 + 4);
        const float r = rstd_lds[row];
        u32x4 o;
        o.x = pk2(a.x * r * g0.x * (1.f + s0.x) + h0.x, a.y * r * g0.y * (1.f + s0.y) + h0.y);
        o.y = pk2(a.z * r * g0.z * (1.f + s0.z) + h0.z, a.w * r * g0.w * (1.f + s0.w) + h0.w);
        o.z = pk2(b.x * r * g1.x * (1.f + s1.x) + h1.x, b.y * r * g1.y * (1.f + s1.y) + h1.y);
        o.w = pk2(b.z * r * g1.z * (1.f + s1.z) + h1.z, b.w * r * g1.w * (1.f + s1.w) + h1.w);
        *(u32x4*)(hA + ((size_t)tile * 256 + it) * 512 + lane * 8) = o;
    }
}

template <int ORIENT>
DI void kloop(f32x16 (&acc)[4][2], const bf16_t* __restrict__ At, const bf16_t* __restrict__ W0, const bf16_t* __restrict__ W1, char* lds, int tid, int lane) {
    tid = opaque_v(tid); lane = opaque_v(lane);
#pragma unroll
    for (int mb = 0; mb < 4; ++mb)
#pragma unroll
        for (int nb = 0; nb < 2; ++nb)
#pragma unroll
            for (int i = 0; i < 16; ++i) acc[mb][nb][i] = 0.f;
    const u32x4* Ag = (const u32x4*)At + tid;
    const u32x4* W0g = (const u32x4*)W0 + lane;
    const u32x4* W1g = (const u32x4*)W1 + lane;
    u32x4 wq[4][2], ar[2];
    ar[0] = Ag[0]; ar[1] = Ag[512];
#pragma unroll
    for (int kk = 0; kk < 4; ++kk) { wq[kk][0] = W0g[kk * 64]; wq[kk][1] = W1g[kk * 64]; }
    *(u32x4*)(lds + tid * 16) = ar[0]; *(u32x4*)(lds + 8192 + tid * 16) = ar[1];
    __syncthreads();
    for (int kc = 0; kc < 16; ++kc) {
        char* cur = lds + (kc & 1) * 16384;
        char* nxt = lds + ((kc + 1) & 1) * 16384;
        const int kn = kc < 15 ? kc + 1 : 15;
        if (kc < 15) { ar[0] = Ag[(kc + 1) * 1024]; ar[1] = Ag[(kc + 1) * 1024 + 512]; }
        __builtin_amdgcn_sched_barrier(0);
#pragma unroll
        for (int kk = 0; kk < 4; ++kk) {
            bf16x8 afr[4];
#pragma unroll
            for (int mb = 0; mb < 4; ++mb) afr[mb] = *(const bf16x8*)(cur + ((kk * 4 + mb) * 64 + lane) * 16);
#pragma unroll
            for (int mb = 0; mb < 4; ++mb)
#pragma unroll
                for (int nb = 0; nb < 2; ++nb) {
                    const bf16x8 wf = __builtin_bit_cast(bf16x8, wq[kk][nb]);
                    if (ORIENT == 0) acc[mb][nb] = MFMA32(afr[mb], wf, acc[mb][nb]);
                    else acc[mb][nb] = MFMA32(wf, afr[mb], acc[mb][nb]);
                }
            wq[kk][0] = W0g[(kn * 4 + kk) * 64]; wq[kk][1] = W1g[(kn * 4 + kk) * 64];
            __builtin_amdgcn_sched_barrier(0);
        }
        if (kc < 15) { *(u32x4*)(nxt + tid * 16) = ar[0]; *(u32x4*)(nxt + 8192 + tid * 16) = ar[1]; }
        __syncthreads();
    }
}

DI void epi_f32row(const f32x16 (&acc)[4][2], float* __restrict__ C, int tile, int col0, int lane) {
    lane = opaque_v(lane);
    const int r5 = lane & 31, hh = lane >> 5;
    const unsigned boff = (unsigned)((tile * 128 + 4 * hh) * 2048 + col0 + r5);
#pragma unroll
    for (int mb = 0; mb < 4; ++mb)
#pragma unroll
        for (int nb = 0; nb < 2; ++nb)
#pragma unroll
            for (int i = 0; i < 16; ++i)
                C[boff + (unsigned)((mb * 32 + (i & 3) + 8 * (i >> 2)) * 2048 + nb * 32)] = acc[mb][nb][i];
}
DI void epi_resid(const f32x16 (&acc)[4][2], const float* __restrict__ xin, float* __restrict__ xout, const float* __restrict__ gate_b, int tile, int col0, int lane) {
    lane = opaque_v(lane);
    const int r5 = lane & 31, hh = lane >> 5;
    const unsigned boff = (unsigned)((tile * 128 + 4 * hh) * D + col0 + r5);
#pragma unroll
    for (int nb = 0; nb < 2; ++nb) {
        const float gv = gate_b[col0 + nb * 32 + r5];
#pragma unroll
        for (int mb = 0; mb < 4; ++mb)
#pragma unroll
            for (int i = 0; i < 16; ++i) {
                const unsigned o = boff + (unsigned)((mb * 32 + (i & 3) + 8 * (i >> 2)) * D + nb * 32);
                xout[o] = xin[o] + gv * acc[mb][nb][i];
            }
    }
}

DI void epi_qpf(const f32x16 (&acc)[4][2], bf16_t* __restrict__ QPF, int tile, int ft0, int lane) {
    lane = opaque_v(lane);
#pragma unroll
    for (int nb = 0; nb < 2; ++nb)
#pragma unroll
        for (int s = 0; s < 2; ++s)
#pragma unroll
            for (int mb = 0; mb < 4; ++mb) {
                const f32x16& a = acc[mb][nb];
                u32x4 o; o.x = pk2(a[8 * s], a[8 * s + 1]); o.y = pk2(a[8 * s + 2], a[8 * s + 3]); o.z = pk2(a[8 * s + 4], a[8 * s + 5]); o.w = pk2(a[8 * s + 6], a[8 * s + 7]);
                *(u32x4*)(QPF + ((unsigned)((((tile * 64 + ft0 + nb) * 2 + s) * 4 + mb) * 64 + lane)) * 8) = o;
            }
}

DI void conv_keys_item(const float* __restrict__ K, bf16_t* __restrict__ KF, int gid) {
    const int lane = gid & 63, s = (gid >> 6) & 1, nbl = (gid >> 7) & 3, nt = (gid >> 9) & 3, hp = gid >> 11;
    const int r = lane & 31, hh = lane >> 5;
    const float* p = K + ((size_t)hp * 128 + nt * 32 + r) * 128 + nbl * 32 + 16 * s + 4 * hh;
    const float4 a = *(const float4*)p, b = *(const float4*)(p + 8);
    u32x4 o; o.x = pk2(a.x, a.y); o.y = pk2(a.z, a.w); o.z = pk2(b.x, b.y); o.w = pk2(b.z, b.w);
    *(u32x4*)(KF + (size_t)gid * 8) = o;
}

DI void conv_table_row(const float* __restrict__ src, unsigned char* __restrict__ dst, float* __restrict__ sc, int lane) {
    const float4* p = (const float4*)src + lane * 4;
    float4 v[4];
    float m = 0.f;
#pragma unroll
    for (int j = 0; j < 4; ++j) { v[j] = p[j]; m = fmaxf(m, fmaxf(fmaxf(fabsf(v[j].x), fabsf(v[j].y)), fmaxf(fabsf(v[j].z), fabsf(v[j].w)))); }
#pragma unroll
    for (int o = 1; o < 64; o <<= 1) m = fmaxf(m, __shfl_xor(m, o));
    const float scale = m > 0.f ? m * (1.f / 416.f) : 1.f;
    const float inv = 1.f / scale;
    u32x4 o;
    unsigned* op = (unsigned*)&o;
#pragma unroll
    for (int j = 0; j < 4; ++j) {
        int wv = 0;
        wv = __builtin_amdgcn_cvt_pk_fp8_f32(v[j].x * inv, v[j].y * inv, wv, false);
        wv = __builtin_amdgcn_cvt_pk_fp8_f32(v[j].z * inv, v[j].w * inv, wv, true);
        op[j] = (unsigned)wv;
    }
    *(u32x4*)(dst + lane * 16) = o;
    if (lane == 0) *sc = scale;
}

DI void ce_desc(int& a, int& b) { const int mx = a > b ? a : b, mn = a > b ? b : a; a = mx; b = mn; }
DI void sort16_desc(int (&v)[16]) {
#pragma unroll
    for (int k = 2; k <= 16; k <<= 1)
#pragma unroll
        for (int j = k >> 1; j > 0; j >>= 1)
#pragma unroll
            for (int i = 0; i < 16; ++i) {
                const int l = i ^ j;
                if (l > i) { if ((i & k) == 0) ce_desc(v[i], v[l]); else ce_desc(v[l], v[i]); }
            }
}
DI void bitonic_merge16_desc(int (&v)[16]) {
#pragma unroll
    for (int j = 8; j > 0; j >>= 1)
#pragma unroll
        for (int i = 0; i < 16; ++i) { const int l = i ^ j; if (l > i) ce_desc(v[i], v[l]); }
}
DI void merge_top16(int (&a)[16], const int (&b)[16]) {
#pragma unroll
    for (int i = 0; i < 16; ++i) a[i] = a[i] > b[15 - i] ? a[i] : b[15 - i];
    bitonic_merge16_desc(a);
}
DI int f2ord(float f) { int b = __float_as_int(f); return b ^ ((b >> 31) & 0x7fffffff); }
DI float ord2f(int k) { return __int_as_float(k ^ ((k >> 31) & 0x7fffffff)); }

DI void route_tile(const bf16_t* __restrict__ QPF, const bf16_t* __restrict__ KF, int* __restrict__ ridx, float* __restrict__ rgate, unsigned char* lds_idx  , int tile, int tid) {
    tid = opaque_v(tid); tile = opaque_s(tile);
    const int lane = tid & 63, w = __builtin_amdgcn_readfirstlane(tid >> 6);
    const int r5 = lane & 31, hh = lane >> 5;
    unsigned char* myidx = lds_idx + w * 1024;
    for (int task = w; task < 32; task += 8) {
        const int h = task >> 2, tt = task & 3;
        f32x16 acc[2][4];
#pragma unroll
        for (int p = 0; p < 2; ++p)
#pragma unroll
            for (int nt = 0; nt < 4; ++nt)
#pragma unroll
                for (int i = 0; i < 16; ++i) acc[p][nt][i] = 0.f;
        {
            bf16x8 bq[2], ak[2][4];
#define ROUTE_LOAD(buf, step) do { const int p_ = (step) >> 3, ks_ = (step) & 7; \
                bq[buf] = *(const bf16x8*)(QPF + ((unsigned)((((tile * 64 + h * 8 + p_ * 4 + (ks_ >> 1)) * 2 + (ks_ & 1)) * 4 + tt) * 64 + lane)) * 8); \
                _Pragma("unroll") for (int nt = 0; nt < 4; ++nt) ak[buf][nt] = *(const bf16x8*)(KF + ((unsigned)(((((h * 2 + p_) * 4 + nt) * 8 + ks_) * 64) + lane)) * 8); } while (0)
            ROUTE_LOAD(0, 0);
#pragma unroll
            for (int step = 0; step < 16; ++step) {
                if (step < 15) ROUTE_LOAD((step + 1) & 1, step + 1);
#pragma unroll
                for (int nt = 0; nt < 4; ++nt) acc[step >> 3][nt] = MFMA32(ak[step & 1][nt], bq[step & 1], acc[step >> 3][nt]);
                __builtin_amdgcn_sched_barrier(0);
            }
#undef ROUTE_LOAD
        }
        int g[8][16];
#pragma unroll
        for (int nt = 0; nt < 4; ++nt)
#pragma unroll
            for (int i = 0; i < 16; ++i) {
                const unsigned a = __float_as_uint(acc[0][nt][i]), b = __float_as_uint(acc[1][nt][i]);
                auto sw = __builtin_amdgcn_permlane32_swap(a, b, false, false);
                const int n0 = nt * 32 + (i & 3) + 8 * (i >> 2);
                g[nt * 2 + (i >> 3)][i & 7] = (f2ord(__uint_as_float(sw[0])) & ~127) | n0;
                g[nt * 2 + (i >> 3)][8 + (i & 7)] = (f2ord(__uint_as_float(sw[1])) & ~127) | (n0 + 4);
            }
#pragma unroll
        for (int q = 0; q < 8; ++q) sort16_desc(g[q]);
        merge_top16(g[0], g[1]); merge_top16(g[2], g[3]); merge_top16(g[4], g[5]); merge_top16(g[6], g[7]);
        merge_top16(g[0], g[2]); merge_top16(g[4], g[6]);
        merge_top16(g[0], g[4]);
        {
            u32x4 pk;
            unsigned* pp = (unsigned*)&pk;
#pragma unroll
            for (int q = 0; q < 4; ++q) pp[q] = (unsigned)(g[0][4 * q] & 127) | ((unsigned)(g[0][4 * q + 1] & 127) << 8) | ((unsigned)(g[0][4 * q + 2] & 127) << 16) | ((unsigned)(g[0][4 * q + 3] & 127) << 24);
            *(u32x4*)(myidx + lane * 16) = pk;
        }
        float f0[16], f1[16];
#pragma unroll
        for (int i = 0; i < 16; ++i) {
            const unsigned a = (unsigned)g[0][i], b = a;
            auto sw = __builtin_amdgcn_permlane32_swap(a, b, false, false);
            f0[i] = ord2f((int)sw[0] & ~127); f1[i] = ord2f((int)sw[1] & ~127);
        }
        int c0[16], c1[16], c2[16], c3[16];
#pragma unroll
        for (int j = 0; j < 16; ++j) c0[j] = (f2ord(f0[0] + f1[j]) & ~255) | j;
#pragma unroll
        for (int i = 1; i < 16; ++i) c1[i - 1] = (f2ord(f0[i] + f1[0]) & ~255) | (i << 4);
        c1[15] = (int)0x80000000;
#define CK(i, j) ((f2ord(f0[i] + f1[j]) & ~255) | ((i) << 4) | (j))
        c2[0] = CK(1, 1); c2[1] = CK(1, 2); c2[2] = CK(1, 3); c2[3] = CK(1, 4); c2[4] = CK(1, 5); c2[5] = CK(1, 6); c2[6] = CK(1, 7);
        c2[7] = CK(2, 1); c2[8] = CK(2, 2); c2[9] = CK(2, 3); c2[10] = CK(2, 4);
        c2[11] = CK(3, 1); c2[12] = CK(3, 2); c2[13] = CK(3, 3);
        c2[14] = CK(4, 1); c2[15] = CK(4, 2);
        c3[0] = CK(5, 1); c3[1] = CK(6, 1); c3[2] = CK(7, 1);
#undef CK
#pragma unroll
        for (int q = 3; q < 16; ++q) c3[q] = (int)0x80000000;
        sort16_desc(c2);
        ce_desc(c3[0], c3[1]); ce_desc(c3[1], c3[2]); ce_desc(c3[0], c3[1]);
        merge_top16(c0, c1); merge_top16(c2, c3); merge_top16(c0, c2);
        float bs[16], den = 0.f;
#pragma unroll
        for (int i = 0; i < 16; ++i) { bs[i] = __expf(ord2f(c0[i] & ~255) - ord2f(c0[0] & ~255)); den += bs[i]; }
        const float rden = 1.f / den;
        asm volatile("s_waitcnt lgkmcnt(0)" ::: "memory");
        const int tok = tile * 128 + tt * 32 + r5;
#pragma unroll
        for (int q = 0; q < 8; ++q) {
            const int key = (int)__builtin_amdgcn_permlane32_swap((unsigned)c0[q], (unsigned)c0[8 + q], false, false)[0];
            const float gv = __uint_as_float(__builtin_amdgcn_permlane32_swap(__float_as_uint(bs[q]), __float_as_uint(bs[8 + q]), false, false)[0]) * rden;
            const int i = (key >> 4) & 15, j = key & 15;
            const int e = (int)myidx[r5 * 16 + i] * 128 + (int)myidx[(32 + r5) * 16 + j];
            ridx[(unsigned)(tok * 128 + h * 16 + 8 * hh + q)] = e;
            rgate[(unsigned)(tok * 128 + h * 16 + 8 * hh + q)] = gv;
        }
        asm volatile("s_waitcnt lgkmcnt(0)" ::: "memory");
    }
}

DI void peer_token(const bf16_t* __restrict__ hA, const int* __restrict__ ridx, const float* __restrict__ rgate, const unsigned char* __restrict__ TB, const float* __restrict__ SC,
                   const float* __restrict__ g2b, float* __restrict__ x, int t, int lane) {
    lane = opaque_v(lane); t = opaque_s(t);
    const int tile = t >> 7, row = t & 127, mb = row >> 5, r5 = row & 31;
    const bf16_t* hp = hA + ((unsigned)(((tile * 64 + lane) * 4 + mb) * 64 + r5)) * 8;
    const u32x4 ha = *(const u32x4*)hp, hb = *(const u32x4*)(hp + 32 * 8);
    f32x2 hv[8];
    {
        const unsigned hw[8] = {ha.x, ha.y, ha.z, ha.w, hb.x, hb.y, hb.z, hb.w};
#pragma unroll
        for (int q = 0; q < 8; ++q) { hv[q].x = __uint_as_float(hw[q] << 16); hv[q].y = __uint_as_float(hw[q] & 0xffff0000u); }
    }
    f32x2 acc[8];
#pragma unroll
    for (int q = 0; q < 8; ++q) acc[q] = (f32x2){0.f, 0.f};
    const int* ip = ridx + (unsigned)(t * 128);
    const float* gp = rgate + (unsigned)(t * 128);
    for (int p0 = 0; p0 < 128; p0 += 8) {
        int e[8];
        u32x4 dr[8], ur[8];
#pragma unroll
        for (int u = 0; u < 8; ++u) {
            e[u] = __builtin_amdgcn_readfirstlane(ip[p0 + u]);
            const unsigned char* rp = TB + (size_t)e[u] * 2048 + lane * 16;
            dr[u] = *(const u32x4*)rp; ur[u] = *(const u32x4*)(rp + 1024);
        }
        float part[8];
#pragma unroll
        for (int u = 0; u < 8; ++u) {
            const unsigned dw[4] = {dr[u].x, dr[u].y, dr[u].z, dr[u].w};
            f32x2 s2 = (f32x2){0.f, 0.f};
#pragma unroll
            for (int q = 0; q < 4; ++q) {
                const f32x2 lo = __builtin_amdgcn_cvt_pk_f32_fp8((int)dw[q], false), hi = __builtin_amdgcn_cvt_pk_f32_fp8((int)dw[q], true);
                s2 += lo * hv[2 * q]; s2 += hi * hv[2 * q + 1];
            }
            part[u] = s2.x + s2.y;
        }
        float r4[4], r2[2], r1;
        {
            const bool up = (lane & 32) != 0;
#pragma unroll
            for (int q = 0; q < 4; ++q) { const float keep = up ? part[q + 4] : part[q], give = up ? part[q] : part[q + 4]; r4[q] = keep + __shfl_xor(give, 32); }
            const bool up2 = (lane & 16) != 0;
#pragma unroll
            for (int q = 0; q < 2; ++q) { const float keep = up2 ? r4[q + 2] : r4[q], give = up2 ? r4[q] : r4[q + 2]; r2[q] = keep + __shfl_xor(give, 16); }
            const bool up3 = (lane & 8) != 0;
            { const float keep = up3 ? r2[1] : r2[0], give = up3 ? r2[0] : r2[1]; r1 = keep + __shfl_xor(give, 8); }
            r1 += __shfl_xor(r1, 4); r1 += __shfl_xor(r1, 2); r1 += __shfl_xor(r1, 1);
        }
        const int myu = ((lane >> 5) & 1) * 4 + ((lane >> 4) & 1) * 2 + ((lane >> 3) & 1);
        const int me = ip[p0 + myu];
        const float a = r1 * SC[(unsigned)me * 2];
        const float wl = gp[p0 + myu] * (0.5f * a * (1.f + erff(a * 0.70710678118654752f))) * SC[(unsigned)me * 2 + 1];
#pragma unroll
        for (int u = 0; u < 8; ++u) {
            const int src = ((u >> 2) & 1) * 32 + ((u >> 1) & 1) * 16 + (u & 1) * 8;
            const float wv = __int_as_float(__builtin_amdgcn_readlane(__float_as_int(wl), src));
            const unsigned uw[4] = {ur[u].x, ur[u].y, ur[u].z, ur[u].w};
            const f32x2 w2 = (f32x2){wv, wv};
#pragma unroll
            for (int q = 0; q < 4; ++q) {
                const f32x2 lo = __builtin_amdgcn_cvt_pk_f32_fp8((int)uw[q], false), hi = __builtin_amdgcn_cvt_pk_f32_fp8((int)uw[q], true);
                acc[2 * q] += w2 * lo; acc[2 * q + 1] += w2 * hi;
            }
        }
    }
    float4* xp = (float4*)(x + (size_t)t * D + lane * 16);
    const float4* gq = (const float4*)(g2b + lane * 16);
#pragma unroll
    for (int q = 0; q < 4; ++q) {
        float4 xv = xp[q]; const float4 gv = gq[q];
        xv.x += gv.x * acc[2 * q].x; xv.y += gv.y * acc[2 * q].y; xv.z += gv.z * acc[2 * q + 1].x; xv.w += gv.w * acc[2 * q + 1].y;
        xp[q] = xv;
    }
}

DI void epi_qk(f32x16 (&acc)[4][2], const float* __restrict__ gain, float scale, bf16_t* __restrict__ dst, int lane) {
    lane = opaque_v(lane);
    const int hh = lane >> 5;
    float gv[2][16];
#pragma unroll
    for (int nb = 0; nb < 2; ++nb)
#pragma unroll
        for (int i = 0; i < 16; ++i) gv[nb][i] = gain[nb * 32 + (i & 3) + 8 * (i >> 2) + 4 * hh] * scale;
#pragma unroll
    for (int mb = 0; mb < 4; ++mb) {
        float ss = 0.f;
#pragma unroll
        for (int nb = 0; nb < 2; ++nb)
#pragma unroll
            for (int i = 0; i < 16; ++i) ss += acc[mb][nb][i] * acc[mb][nb][i];
        ss += __shfl_xor(ss, 32);
        const float r = rsqrtf(ss * (1.f / 64.f) + EPS);
#pragma unroll
        for (int nb = 0; nb < 2; ++nb)
#pragma unroll
            for (int s = 0; s < 2; ++s) {
                const f32x16& a = acc[mb][nb];
                u32x4 o;
                o.x = pk2(a[8 * s] * r * gv[nb][8 * s], a[8 * s + 1] * r * gv[nb][8 * s + 1]);
                o.y = pk2(a[8 * s + 2] * r * gv[nb][8 * s + 2], a[8 * s + 3] * r * gv[nb][8 * s + 3]);
                o.z = pk2(a[8 * s + 4] * r * gv[nb][8 * s + 4], a[8 * s + 5] * r * gv[nb][8 * s + 5]);
                o.w = pk2(a[8 * s + 6] * r * gv[nb][8 * s + 6], a[8 * s + 7] * r * gv[nb][8 * s + 7]);
                *(u32x4*)(dst + ((unsigned)(((nb * 2 + s) * 4 + mb) * 64 + lane)) * 8) = o;
            }
    }
}
DI void epi_v(const f32x16 (&acc)[4][2], bf16_t* __restrict__ dst, int lane) {
    lane = opaque_v(lane);
#pragma unroll
    for (int nb = 0; nb < 2; ++nb)
#pragma unroll
        for (int mb = 0; mb < 4; ++mb)
#pragma unroll
            for (int s = 0; s < 2; ++s) {
                const f32x16& a = acc[mb][nb];
                u32x4 o; o.x = pk2(a[8 * s], a[8 * s + 1]); o.y = pk2(a[8 * s + 2], a[8 * s + 3]); o.z = pk2(a[8 * s + 4], a[8 * s + 5]); o.w = pk2(a[8 * s + 6], a[8 * s + 7]);
                *(u32x4*)(dst + ((unsigned)(((nb * 4 + mb) * 2 + s) * 64 + lane)) * 8) = o;
            }
}
DI void epi_row(const f32x16 (&acc)[4][2], bf16_t* __restrict__ dst, int ld, int lane) {
    lane = opaque_v(lane);
    const int r5 = lane & 31, hh = lane >> 5;
#pragma unroll
    for (int mb = 0; mb < 4; ++mb)
#pragma unroll
        for (int nb = 0; nb < 2; ++nb)
#pragma unroll
            for (int gq = 0; gq < 4; ++gq) {
                const f32x16& a = acc[mb][nb];
                u32x2 o; o.x = pk2(a[4 * gq], a[4 * gq + 1]); o.y = pk2(a[4 * gq + 2], a[4 * gq + 3]);
                *(u32x2*)(dst + (unsigned)((mb * 32 + r5) * ld + nb * 32 + 8 * gq + 4 * hh)) = o;
            }
}
DI void epi_z(const f32x16 (&acc)[4][2], bf16_t* __restrict__ dst, int lane) {
    lane = opaque_v(lane);
    const int r5 = lane & 31, hh = lane >> 5;
#pragma unroll
    for (int mb = 0; mb < 4; ++mb)
#pragma unroll
        for (int gq = 0; gq < 4; ++gq) {
            const f32x16 &a = acc[mb][0], &b = acc[mb][1];
            u32x2 o; o.x = pk2(a[4 * gq] * b[4 * gq], a[4 * gq + 1] * b[4 * gq + 1]); o.y = pk2(a[4 * gq + 2] * b[4 * gq + 2], a[4 * gq + 3] * b[4 * gq + 3]);
            *(u32x2*)(dst + (unsigned)((mb * 32 + r5) * 256 + 8 * gq + 4 * hh)) = o;
        }
}
DI void epi_su_park(const f32x16 (&acc)[4][2], unsigned* lds_su, int lane) {
    lane = opaque_v(lane);
#pragma unroll
    for (int mb = 0; mb < 4; ++mb)
#pragma unroll
        for (int nb = 0; nb < 2; ++nb)
#pragma unroll
            for (int q = 0; q < 8; ++q) lds_su[((mb * 2 + nb) * 8 + q) * 64 + lane] = pk2(acc[mb][nb][2 * q], acc[mb][nb][2 * q + 1]);
}
DI void epi_sv(f32x16 (&acc)[4][2], const bf16_t* __restrict__ SWF  , const float* __restrict__ bs_g, const unsigned* lds_su, bf16_t* __restrict__ dst, int lane) {
    lane = opaque_v(lane);
    const int r5 = lane & 31, hh = lane >> 5;
    bf16x8 vb[4][2][2];
#pragma unroll
    for (int mb = 0; mb < 4; ++mb) {
#pragma unroll
        for (int i = 0; i < 16; ++i) {
            float s1 = acc[mb][0][i] + acc[mb][1][i];
#pragma unroll
            for (int o = 1; o < 32; o <<= 1) s1 += __shfl_xor(s1, o);
            const float mu = s1 * (1.f / 64.f);
            const float d0 = acc[mb][0][i] - mu, d1 = acc[mb][1][i] - mu;
            float s2 = d0 * d0 + d1 * d1;
#pragma unroll
            for (int o = 1; o < 32; o <<= 1) s2 += __shfl_xor(s2, o);
            const float r = rsqrtf(s2 * (1.f / 64.f) + EPS);
            acc[mb][0][i] = d0 * r; acc[mb][1][i] = d1 * r;
        }
#pragma unroll
        for (int s = 0; s < 2; ++s)
#pragma unroll
            for (int nb = 0; nb < 2; ++nb) {
                const f32x16& a = acc[mb][nb];
                u32x4 o; o.x = pk2(a[8 * s], a[8 * s + 1]); o.y = pk2(a[8 * s + 2], a[8 * s + 3]); o.z = pk2(a[8 * s + 4], a[8 * s + 5]); o.w = pk2(a[8 * s + 6], a[8 * s + 7]);
                vb[mb][s][nb] = __builtin_bit_cast(bf16x8, o);
            }
    }
#pragma unroll
    for (int tb = 0; tb < 4; ++tb) {
        f32x16 y[2];
#pragma unroll
        for (int nb = 0; nb < 2; ++nb)
#pragma unroll
            for (int i = 0; i < 16; ++i) y[nb][i] = 0.f;
#pragma unroll
        for (int kt = 0; kt <= tb; ++kt)
#pragma unroll
            for (int s = 0; s < 2; ++s) {
                const bf16x8 wa = *(const bf16x8*)(SWF + ((unsigned)(((tb * 4 + kt) * 2 + s) * 64 + lane)) * 8);
                y[0] = MFMA32(wa, vb[kt][s][0], y[0]);
                y[1] = MFMA32(wa, vb[kt][s][1], y[1]);
            }
#pragma unroll
        for (int nb = 0; nb < 2; ++nb)
#pragma unroll
            for (int q = 0; q < 8; ++q) {
                const unsigned su2 = lds_su[((tb * 2 + nb) * 8 + q) * 64 + lane];
                const int i0 = 2 * q, i1 = 2 * q + 1;
                const int t0 = tb * 32 + (i0 & 3) + 8 * (i0 >> 2) + 4 * hh, t1 = tb * 32 + (i1 & 3) + 8 * (i1 >> 2) + 4 * hh;
                const float v0 = (y[nb][i0] + bs_g[t0]) * __uint_as_float(su2 << 16), v1 = (y[nb][i1] + bs_g[t1]) * __uint_as_float(su2 & 0xffff0000u);
                const unsigned pk = pk2(v0, v1);
                dst[(unsigned)(t0 * 256 + nb * 32 + r5)] = (bf16_t)(pk & 0xffffu);
                dst[(unsigned)(t1 * 256 + nb * 32 + r5)] = (bf16_t)(pk >> 16);
            }
    }
}

DI void conv_sguw_item(const float* __restrict__ W, bf16_t* __restrict__ SWF, int gid) {
    const int lane = gid & 63, s = (gid >> 6) & 1, kt = (gid >> 7) & 3, tb = (gid >> 9) & 3, g = gid >> 11;
    const int r = lane & 31, hh = lane >> 5, t = tb * 32 + r;
    const float* p = W + ((size_t)g * 128 + t) * 128;
    float v[8];
#pragma unroll
    for (int j = 0; j < 8; ++j) { const int sp = kt * 32 + 16 * s + 8 * (j >> 2) + 4 * hh + (j & 3); v[j] = sp <= t ? p[sp] : 0.f; }
    u32x4 o; o.x = pk2(v[0], v[1]); o.y = pk2(v[2], v[3]); o.z = pk2(v[4], v[5]); o.w = pk2(v[6], v[7]);
    *(u32x4*)(SWF + (size_t)gid * 8) = o;
}

DI int t5_bucket(int d) {
    if (d < 16) return d;
    const float lr = logf((float)d / 16.f) / logf(8.f);
    const int large = 16 + (int)(lr * 16.f);
    return large < 31 ? large : 31;
}

DI void attn_tile(const bf16_t* __restrict__ QF, const bf16_t* __restrict__ KF2, const bf16_t* __restrict__ VF, const float* bias_lds, const float* __restrict__ sink, bf16_t* __restrict__ OR, int tile, int tid) {
    tid = opaque_v(tid); tile = opaque_s(tile);
    const int lane = tid & 63, w = __builtin_amdgcn_readfirstlane(tid >> 6), r5 = lane & 31, hh = lane >> 5;
    const bool has_prev = (tile & 31) != 0;
    for (int task = w; task < 32; task += 8) {
        const int qh = task >> 2, qt = task & 3, kvh = qh >> 2;
        bf16x8 bq[4];
#pragma unroll
        for (int ks = 0; ks < 4; ++ks) bq[ks] = *(const bf16x8*)(QF + ((unsigned)((((tile * 8 + qh) * 4 + ks) * 4 + qt) * 64 + lane)) * 8);
        f32x16 sc[5];
#pragma unroll
        for (int jj = 0; jj < 5; ++jj) {
#pragma unroll
            for (int i = 0; i < 16; ++i) sc[jj][i] = 0.f;
            const int j = qt + jj;
            if (j >= 4 || has_prev) {
                const int st = j >= 4 ? tile : tile - 1, kt = j & 3;
#pragma unroll
                for (int ks = 0; ks < 4; ++ks) {
                    const bf16x8 ak = *(const bf16x8*)(KF2 + ((unsigned)((((st * 2 + kvh) * 4 + ks) * 4 + kt) * 64 + lane)) * 8);
                    sc[jj] = MFMA32(ak, bq[ks], sc[jj]);
                }
            }
        }
        const float* bl = bias_lds + qh * 128;
        float m = -1e30f;
#pragma unroll
        for (int jj = 0; jj < 5; ++jj) {
            const bool ex = (qt + jj >= 4) || has_prev;
#pragma unroll
            for (int i = 0; i < 16; ++i) {
                const int cr = (i & 3) + 8 * (i >> 2) + 4 * hh;
                const int dist = 128 + r5 - 32 * jj - cr;
                const bool valid = ex && dist >= 0 && dist < 128;
                const float v = valid ? sc[jj][i] + bl[dist & 127] : -1e30f;
                sc[jj][i] = v; m = fmaxf(m, v);
            }
        }
        m = fmaxf(m, __shfl_xor(m, 32));
        const float sk = sink[qh];
        m = fmaxf(m, sk);
        float l = 0.f;
#pragma unroll
        for (int jj = 0; jj < 5; ++jj)
#pragma unroll
            for (int i = 0; i < 16; ++i) { const float p = __expf(sc[jj][i] - m); sc[jj][i] = p; l += p; }
        l += __shfl_xor(l, 32);
        l += __expf(sk - m);
        const float rl = 1.f / l;
        f32x16 o[2];
#pragma unroll
        for (int dt = 0; dt < 2; ++dt)
#pragma unroll
            for (int i = 0; i < 16; ++i) o[dt][i] = 0.f;
#pragma unroll
        for (int jj = 0; jj < 5; ++jj) {
            const int j = qt + jj;
            if (j >= 4 || has_prev) {
                const int st = j >= 4 ? tile : tile - 1, kt = j & 3;
#pragma unroll
                for (int s = 0; s < 2; ++s) {
                    const f32x16& a = sc[jj];
                    u32x4 pp; pp.x = pk2(a[8 * s], a[8 * s + 1]); pp.y = pk2(a[8 * s + 2], a[8 * s + 3]); pp.z = pk2(a[8 * s + 4], a[8 * s + 5]); pp.w = pk2(a[8 * s + 6], a[8 * s + 7]);
                    const bf16x8 pb = __builtin_bit_cast(bf16x8, pp);
#pragma unroll
                    for (int dt = 0; dt < 2; ++dt) {
                        const bf16x8 va = *(const bf16x8*)(VF + ((unsigned)(((((st * 2 + kvh) * 2 + dt) * 4 + kt) * 2 + s) * 64 + lane)) * 8);
                        o[dt] = MFMA32(va, pb, o[dt]);
                    }
                }
            }
        }
        bf16_t* orow = OR + (unsigned)((tile * 128 + qt * 32 + r5) * 512 + qh * 64 + 4 * hh);
#pragma unroll
        for (int dt = 0; dt < 2; ++dt)
#pragma unroll
            for (int gq = 0; gq < 4; ++gq) {
                u32x2 ov; ov.x = pk2(o[dt][4 * gq] * rl, o[dt][4 * gq + 1] * rl); ov.y = pk2(o[dt][4 * gq + 2] * rl, o[dt][4 * gq + 3] * rl);
                *(u32x2*)(orow + dt * 32 + 8 * gq) = ov;
            }
    }
}

DI void unpack8(const u32x4 v, float (&f)[8]) {
    f[0] = __uint_as_float(v.x << 16); f[1] = __uint_as_float(v.x & 0xffff0000u); f[2] = __uint_as_float(v.y << 16); f[3] = __uint_as_float(v.y & 0xffff0000u);
    f[4] = __uint_as_float(v.z << 16); f[5] = __uint_as_float(v.z & 0xffff0000u); f[6] = __uint_as_float(v.w << 16); f[7] = __uint_as_float(v.w & 0xffff0000u);
}
DI void merge_tile(const bf16_t* __restrict__ OR, const bf16_t* __restrict__ CBR, const bf16_t* __restrict__ ZR, const bf16_t* __restrict__ YS, const float* __restrict__ cw  , const float* __restrict__ og  ,
                   bf16_t* __restrict__ mA, int tile, int tid) {
    tid = opaque_v(tid); tile = opaque_s(tile);
    const int lane = tid & 63, w = tid >> 6;
    for (int rr = 0; rr < 16; ++rr) {
        const int row = w * 16 + rr, t = tile * 128 + row, pos = t & (S - 1);
        float a[8], y[8];
        unpack8(*(const u32x4*)(OR + (unsigned)(t * 512 + lane * 8)), a);
        float ssa = 0.f;
#pragma unroll
        for (int q = 0; q < 8; ++q) ssa += a[q] * a[q];
        ssa = wave_sum(ssa);
        if (lane < 32) {
            const int c0 = lane * 8;
            float cb[8], z0[8], z1[8], z2[8];
            unpack8(*(const u32x4*)(CBR + (unsigned)(t * 256 + c0)), cb);
            unpack8(*(const u32x4*)(ZR + (unsigned)(t * 256 + c0)), z2);
            if (pos >= 1) unpack8(*(const u32x4*)(ZR + (unsigned)((t - 1) * 256 + c0)), z1); else { _Pragma("unroll") for (int q = 0; q < 8; ++q) z1[q] = 0.f; }
            if (pos >= 2) unpack8(*(const u32x4*)(ZR + (unsigned)((t - 2) * 256 + c0)), z0); else { _Pragma("unroll") for (int q = 0; q < 8; ++q) z0[q] = 0.f; }
#pragma unroll
            for (int q = 0; q < 8; ++q) y[q] = cb[q] * (cw[c0 + q] * z0[q] + cw[256 + c0 + q] * z1[q] + cw[512 + c0 + q] * z2[q]);
        } else {
            unpack8(*(const u32x4*)(YS + (unsigned)(t * 256 + (lane - 32) * 8)), y);
        }
        float ssy = 0.f;
#pragma unroll
        for (int q = 0; q < 8; ++q) ssy += y[q] * y[q];
#pragma unroll
        for (int o = 1; o < 32; o <<= 1) ssy += __shfl_xor(ssy, o);
        const float ra = rsqrtf(ssa * (1.f / 512.f) + EPS), ry = rsqrtf(ssy * (1.f / 256.f) + EPS);
        const int mb = row >> 5, r5 = row & 31;
        {
            const float4 g0 = *(const float4*)(og + lane * 8), g1 = *(const float4*)(og + lane * 8 + 4);
            u32x4 o; o.x = pk2(a[0] * ra * g0.x, a[1] * ra * g0.y); o.y = pk2(a[2] * ra * g0.z, a[3] * ra * g0.w); o.z = pk2(a[4] * ra * g1.x, a[5] * ra * g1.y); o.w = pk2(a[6] * ra * g1.z, a[7] * ra * g1.w);
            const int c8 = lane;
            *(u32x4*)(mA + ((unsigned)(((tile * 64 + (c8 >> 1)) * 4 + mb) * 64 + r5 + 32 * (c8 & 1))) * 8) = o;
        }
        {
            const float4 g0 = *(const float4*)(og + 512 + lane * 8), g1 = *(const float4*)(og + 512 + lane * 8 + 4);
            u32x4 o; o.x = pk2(y[0] * ry * g0.x, y[1] * ry * g0.y); o.y = pk2(y[2] * ry * g0.z, y[3] * ry * g0.w); o.z = pk2(y[4] * ry * g1.x, y[5] * ry * g1.y); o.w = pk2(y[6] * ry * g1.z, y[7] * ry * g1.w);
            const int c8 = 64 + lane;
            *(u32x4*)(mA + ((unsigned)(((tile * 64 + (c8 >> 1)) * 4 + mb) * 64 + r5 + 32 * (c8 & 1))) * 8) = o;
        }
    }
}

struct InProjOut { bf16_t *QF, *KF2, *VF, *CBR, *ZR, *YS; };
DI void inproj_tile(const bf16_t* __restrict__ At, const bf16_t* __restrict__ WF, const float* __restrict__ qg, const float* __restrict__ kg, const bf16_t* __restrict__ SWF, const float* __restrict__ sgu_b,
                    const InProjOut& O, char* lds, int tile, int tid) {
    tid = opaque_v(tid); tile = opaque_s(tile);
    const int lane = tid & 63, w = __builtin_amdgcn_readfirstlane(tid >> 6);
    f32x16 acc[4][2];
    {
        const int nbt0 = w * 2;
        kloop<1>(acc, At, WF + (size_t)nbt0 * 32768, WF + (size_t)(nbt0 + 1) * 32768, lds, tid, lane);
        epi_qk(acc, qg, 0.125f, O.QF + (size_t)(tile * 8 + w) * 8192, lane);
    }
    {
        const int nbt0 = 16 + w * 2;
        if (w == 2 || w == 3) {
            kloop<0>(acc, At, WF + (size_t)nbt0 * 32768, WF + (size_t)(nbt0 + 1) * 32768, lds, tid, lane);
            epi_v(acc, O.VF + (size_t)(tile * 2 + (w - 2)) * 8192, lane);
        } else {
            kloop<1>(acc, At, WF + (size_t)nbt0 * 32768, WF + (size_t)(nbt0 + 1) * 32768, lds, tid, lane);
            if (w < 2) epi_qk(acc, kg, 1.f, O.KF2 + (size_t)(tile * 2 + w) * 8192, lane);
            else epi_row(acc, O.CBR + (size_t)tile * 128 * 256 + (w - 4) * 64, 256, lane);
        }
    }
    {
        const int nbt0 = 32 + w * 2;
        kloop<1>(acc, At, WF + (size_t)nbt0 * 32768, WF + (size_t)(nbt0 + 1) * 32768, lds, tid, lane);
        epi_z(acc, O.ZR + (size_t)tile * 128 * 256 + w * 32, lane);
    }
    {
        const int nbt0 = 48 + w * 2;
        kloop<0>(acc, At, WF + (size_t)nbt0 * 32768, WF + (size_t)(nbt0 + 1) * 32768, lds, tid, lane);
        unsigned* lds_su = (unsigned*)lds;
        if (w < 4) epi_su_park(acc, lds_su + w * 4096, lane);
        __syncthreads();
        if (w >= 4) epi_sv(acc, SWF + (size_t)(w - 4) * 16384, sgu_b + (w - 4) * 128, lds_su + (w - 4) * 4096, O.YS + (size_t)tile * 128 * 256 + (w - 4) * 64, lane);
        __syncthreads();
    }
}


struct Params {
    const float *x, *c, *rel_bias, *w_ada, *b_ada, *norm1_g, *norm2_g, *w_in, *q_norm_g, *k_norm_g, *attn_sink, *conv_w, *sgu_w, *sgu_b, *out_norm_g, *w_out, *peer_wq, *peer_sub_keys, *peer_down, *peer_up;
    float* out;
    char* ws;
};
constexpr size_t MiB = 1u << 20;
constexpr size_t WS_MOD = 0;
constexpr size_t WS_MODP = 1 * MiB;
constexpr size_t WS_WIN = 13 * MiB;
constexpr size_t WS_WOUT = 29 * MiB;
constexpr size_t WS_WPQ = 37 * MiB;
constexpr size_t WS_KEYS = 53 * MiB;
constexpr size_t WS_SWF = 55 * MiB;
constexpr size_t WS_SC = 56 * MiB;
constexpr size_t WS_TB = 57 * MiB;
constexpr size_t WS_HA = 185 * MiB;
constexpr size_t WS_QF = 249 * MiB;
constexpr size_t WS_KF2 = 281 * MiB;
constexpr size_t WS_VF = 297 * MiB;
constexpr size_t WS_ZR = 313 * MiB;
constexpr size_t WS_CBR = 345 * MiB;
constexpr size_t WS_YS = 361 * MiB;
constexpr size_t WS_OR = 377 * MiB;
constexpr size_t WS_QPF = 409 * MiB;
constexpr size_t WS_RIDX = 537 * MiB;
constexpr size_t WS_RGATE = 553 * MiB;
constexpr size_t WS_END = 569 * MiB;
constexpr int LDS_BIAS = 65536, LDS_BYTES = 65536 + 4096;

__global__ __launch_bounds__(512) void hybrid_fwd(Params P) {
    extern __shared__ __attribute__((aligned(16))) char lds[];
    cg::grid_group grid = cg::this_grid();
    const int tid = threadIdx.x, lane = tid & 63, w = __builtin_amdgcn_readfirstlane(tid >> 6);
    const int nblk = gridDim.x, bid = blockIdx.x;
    char* ws = P.ws;
    float* mod = (float*)(ws + WS_MOD);
    float* modp = (float*)(ws + WS_MODP);
    bf16_t* WinF = (bf16_t*)(ws + WS_WIN); bf16_t* WoutF = (bf16_t*)(ws + WS_WOUT); bf16_t* WpqF = (bf16_t*)(ws + WS_WPQ);
    bf16_t* KeysF = (bf16_t*)(ws + WS_KEYS); bf16_t* SWF = (bf16_t*)(ws + WS_SWF);
    float* SC = (float*)(ws + WS_SC); unsigned char* TB = (unsigned char*)(ws + WS_TB);
    bf16_t* hA = (bf16_t*)(ws + WS_HA);
    bf16_t* OR = (bf16_t*)(ws + WS_OR); bf16_t* QPF = (bf16_t*)(ws + WS_QPF);
    int* ridx = (int*)(ws + WS_RIDX); float* rgate = (float*)(ws + WS_RGATE);
    float* bias_lds = (float*)(lds + LDS_BIAS);

    {
        float* ca = (float*)lds;
        for (int i = tid; i < 8192; i += 512) { const float v = P.c[i]; ca[i] = v / (1.f + __expf(-v)); }
        for (int i = tid; i < 1024; i += 512) bias_lds[i] = P.rel_bias[t5_bucket(i & 127) * 8 + (i >> 7)];
        __syncthreads();
        for (int it = bid; it < 768; it += nblk) {
            const int jc = it % 12, l = (it / 12) & 3, ks = it / 48;
            const int j = jc * 512 + tid;
            const float* wp = P.w_ada + ((size_t)l * 1024 + ks * 64) * 6144 + j;
            float acc[8];
#pragma unroll
            for (int b = 0; b < 8; ++b) acc[b] = 0.f;
#pragma unroll 4
            for (int i = 0; i < 64; ++i) {
                const float wv = wp[(size_t)i * 6144];
#pragma unroll
                for (int b = 0; b < 8; ++b) acc[b] += ca[b * 1024 + ks * 64 + i] * wv;
            }
#pragma unroll
            for (int b = 0; b < 8; ++b) modp[((size_t)(ks * 4 + l) * 8 + b) * 6144 + j] = acc[b];
        }
        const int gthreads = nblk * 512, gtid = bid * 512 + tid;
        for (int l = 0; l < DEPTH; ++l) {
            for (int g = gtid; g < 64 * 64 * 64; g += gthreads) conv_wfrag_item(P.w_in + (size_t)l * 1024 * 2048, 2048, 64, WinF + (size_t)l * 2097152, g, 1);
            for (int g = gtid; g < 32 * 64 * 64; g += gthreads) conv_wfrag_item(P.w_out + (size_t)l * 1024 * 1024, 1024, 64, WoutF + (size_t)l * 1048576, g, 0);
            for (int g = gtid; g < 64 * 64 * 64; g += gthreads) conv_wfrag_item(P.peer_wq + (size_t)l * 1024 * 2048, 2048, 64, WpqF + (size_t)l * 2097152, g, 0);
            for (int g = gtid; g < 32768; g += gthreads) conv_keys_item(P.peer_sub_keys + (size_t)l * 262144, KeysF + (size_t)l * 262144, g);
            for (int g = gtid; g < 8192; g += gthreads) conv_sguw_item(P.sgu_w + (size_t)l * 65536, SWF + (size_t)l * 65536, g);
        }
        const int gwaves = nblk * 8, gw = bid * 8 + w;
        for (int r = gw; r < DEPTH * 16384 * 2; r += gwaves) {
            const int which = r & 1, le = r >> 1;
            conv_table_row((which ? P.peer_up : P.peer_down) + (size_t)le * D, TB + (size_t)le * 2048 + which * 1024, SC + (size_t)le * 2 + which, lane);
        }
    }
    grid.sync();
    for (int tile = bid; tile < NTILE; tile += nblk) {
        const int b = tile >> 5;
        for (int l = 0; l < DEPTH; ++l)
            for (int j = tid; j < 6144; j += 512) {
                float v = P.b_ada[l * 6144 + j];
#pragma unroll
                for (int ks = 0; ks < 16; ++ks) v += modp[((size_t)(ks * 4 + l) * 8 + b) * 6144 + j];
                mod[((size_t)l * 8 + b) * 6144 + j] = v;
            }
    }
    __syncthreads();

    for (int l = 0; l < DEPTH; ++l) {
        const float* xin = l == 0 ? P.x : P.out;
        InProjOut IO;
        IO.QF = (bf16_t*)(ws + WS_QF); IO.KF2 = (bf16_t*)(ws + WS_KF2 + (size_t)(l & 1) * 8 * MiB); IO.VF = (bf16_t*)(ws + WS_VF + (size_t)(l & 1) * 8 * MiB);
        IO.CBR = (bf16_t*)(ws + WS_CBR); IO.ZR = (bf16_t*)(ws + WS_ZR + (size_t)(l & 1) * 16 * MiB); IO.YS = (bf16_t*)(ws + WS_YS);
        for (int tile = bid; tile < NTILE; tile += nblk) {
            const float* mb_ = mod + ((size_t)l * 8 + (tile >> 5)) * 6144;
            norm_to_frag(xin, P.norm1_g + l * D, mb_ + 0, mb_ + 1024, hA, (float*)lds, tile, tid);
            __syncthreads();
            inproj_tile(hA + (size_t)tile * 131072, WinF + (size_t)l * 2097152, P.q_norm_g + l * 64, P.k_norm_g + l * 64, SWF + (size_t)l * 65536, P.sgu_b + l * 512, IO, lds, tile, tid);
        }
        grid.sync();
        for (int tile = bid; tile < NTILE; tile += nblk) {
            const float* mb_ = mod + ((size_t)l * 8 + (tile >> 5)) * 6144;
            attn_tile(IO.QF, IO.KF2, IO.VF, bias_lds, P.attn_sink + l * 8, OR, tile, tid);
            __syncthreads();
            merge_tile(OR, IO.CBR, IO.ZR, IO.YS, P.conv_w + l * 768, P.out_norm_g + l * D, hA, tile, tid);
            __syncthreads();
            {
                const bf16_t* At = hA + (size_t)tile * 131072;
                const bf16_t* WF = WoutF + (size_t)l * 1048576;
                for (int pass = 0; pass < 2; ++pass) {
                    f32x16 acc[4][2];
                    const int nbt0 = pass * 16 + w * 2;
                    kloop<0>(acc, At, WF + (size_t)nbt0 * 32768, WF + (size_t)(nbt0 + 1) * 32768, lds, tid, lane);
                    epi_resid(acc, xin, P.out, mb_ + 2048, tile, pass * 512 + w * 64, lane);
                }
            }
            __syncthreads();
            norm_to_frag(P.out, P.norm2_g + l * D, mb_ + 3072, mb_ + 4096, hA, (float*)lds, tile, tid);
            __syncthreads();
            {
                const bf16_t* At = hA + (size_t)tile * 131072;
                const bf16_t* WF = WpqF + (size_t)l * 2097152;
                for (int pass = 0; pass < 4; ++pass) {
                    f32x16 acc[4][2];
                    const int nbt0 = pass * 16 + w * 2;
                    kloop<1>(acc, At, WF + (size_t)nbt0 * 32768, WF + (size_t)(nbt0 + 1) * 32768, lds, tid, lane);
                    epi_qpf(acc, QPF, tile, nbt0, lane);
                }
            }
            __syncthreads();
            route_tile(QPF, KeysF + (size_t)l * 262144, ridx, rgate, (unsigned char*)lds, tile, tid);
            __syncthreads();
            for (int i = 0; i < 16; ++i) {
                const int t = tile * 128 + w * 16 + i;
                peer_token(hA, ridx, rgate, TB + (size_t)l * 16384 * 2048, SC + (size_t)l * 32768, mb_ + 5120, P.out, t, lane);
            }
            __syncthreads();
        }
    }
}
}

extern "C" void kernel_launch(void* const* d_in, const int* in_sizes, int n_in, void* d_out, int out_size, void* d_ws, size_t ws_size, hipStream_t stream) {
    using namespace op;
    static int grid_blocks = 0;
    if (!grid_blocks) {
        int dev = 0, cus = 0, per_cu = 0;
        (void)hipGetDevice(&dev);
        (void)hipDeviceGetAttribute(&cus, hipDeviceAttributeMultiprocessorCount, dev);
        (void)hipFuncSetAttribute((const void*)hybrid_fwd, hipFuncAttributeMaxDynamicSharedMemorySize, LDS_BYTES);
        (void)hipOccupancyMaxActiveBlocksPerMultiprocessor(&per_cu, (const void*)hybrid_fwd, 512, LDS_BYTES);
        if (per_cu < 1) per_cu = 1;
        grid_blocks = cus * per_cu;
        if (grid_blocks > NTILE) grid_blocks = NTILE;
        if (ws_size < WS_END) { fprintf(stderr, "kernel_launch: workspace too small (%zu < %zu)\n", ws_size, (size_t)WS_END); grid_blocks = -1; }
    }
    if (grid_blocks < 0) return;
    Params p{};
    p.x = (const float*)d_in[0]; p.c = (const float*)d_in[1]; p.rel_bias = (const float*)d_in[2]; p.w_ada = (const float*)d_in[3]; p.b_ada = (const float*)d_in[4];
    p.norm1_g = (const float*)d_in[5]; p.norm2_g = (const float*)d_in[6]; p.w_in = (const float*)d_in[7]; p.q_norm_g = (const float*)d_in[8]; p.k_norm_g = (const float*)d_in[9];
    p.attn_sink = (const float*)d_in[10]; p.conv_w = (const float*)d_in[11]; p.sgu_w = (const float*)d_in[12]; p.sgu_b = (const float*)d_in[13]; p.out_norm_g = (const float*)d_in[14];
    p.w_out = (const float*)d_in[15]; p.peer_wq = (const float*)d_in[16]; p.peer_sub_keys = (const float*)d_in[17]; p.peer_down = (const float*)d_in[18]; p.peer_up = (const float*)d_in[19];
    p.out = (float*)d_out; p.ws = (char*)d_ws;
    void* args[] = {&p};
    hipError_t e = hipLaunchCooperativeKernel((const void*)hybrid_fwd, dim3(grid_blocks), dim3(512), args, LDS_BYTES, stream);
    if (e != hipSuccess) fprintf(stderr, "kernel_launch: cooperative launch failed: %s (grid %d)\n", hipGetErrorString(e), grid_blocks);
}
```

```cpp
#include <hip/hip_runtime.h>
#include <cstdio>
#include <cstdint>
#include <hip/hip_cooperative_groups.h>
namespace cg = cooperative_groups;


namespace op {
#define DI __device__ __forceinline__
typedef unsigned short bf16_t;
typedef short bf16x8 __attribute__((ext_vector_type(8)));
typedef float f32x16 __attribute__((ext_vector_type(16)));
typedef float f32x2 __attribute__((ext_vector_type(2)));
typedef unsigned u32x4 __attribute__((ext_vector_type(4)));
typedef unsigned u32x2 __attribute__((ext_vector_type(2)));
typedef __bf16 bf16v2 __attribute__((ext_vector_type(2)));
constexpr int D = 1024, NB = 8, S = 4096, DEPTH = 4, T = NB * S, NTILE = T / 128;
constexpr float EPS = 1e-6f;
constexpr int LDS_EPI = 32768, LDS_SSQ = 102400, LDS_RSTD1 = 110592, LDS_BIAS = 112 * 1024, LDS_BYTES = 116 * 1024;
constexpr int REP_GEMM = 1, REP_ROUTE = 1, REP_MIX = 1, REP_NORM = 1, REP_P0 = 1;
#define MFMA32(a, b, c) __builtin_amdgcn_mfma_f32_32x32x16_bf16((a), (b), (c), 0, 0, 0)

DI unsigned pk2(float lo, float hi) { f32x2 v = {lo, hi}; return __builtin_bit_cast(unsigned, __builtin_convertvector(v, bf16v2)); }
DI int opaque_v(int x) { asm volatile("" : "+v"(x)); return x; }
DI int opaque_s(int x) { asm volatile("" : "+s"(x)); return x; }
DI int crow(int reg, int hh) { return (reg & 3) + 8 * (reg >> 2) + 4 * hh; }
DI float wave_sum(float v) {
#pragma unroll
    for (int o = 1; o < 64; o <<= 1) v += __shfl_xor(v, o);
    return v;
}

DI int col_perm(int npos, int mode) {
    if (mode == 1 && npos >= 1024 && npos < 1536) { const int q = npos - 1024, w = q >> 6, nb = (q >> 5) & 1, r = q & 31; return (nb ? 1280 : 1024) + 32 * w + r; }
    return npos;
}
DI void conv_wfrag_item(const float* __restrict__ W, int N, int KB, bf16_t* __restrict__ WF, int gid, int mode) {
    const int l = gid & 63, kb = (gid >> 6) % KB, nbt = (gid >> 6) / KB, r = l & 31, hh = l >> 5;
    const int n = col_perm(nbt * 32 + r, mode);
    const float* p = W + (size_t)(kb * 16 + 8 * hh) * N + n;
    float v[8];
#pragma unroll
    for (int j = 0; j < 8; ++j) v[j] = p[(size_t)j * N];
    u32x4 o; o.x = pk2(v[0], v[1]); o.y = pk2(v[2], v[3]); o.z = pk2(v[4], v[5]); o.w = pk2(v[6], v[7]);
    *(u32x4*)(WF + (size_t)gid * 8) = o;
}

DI void norm_to_frag(const float* __restrict__ x, const float* __restrict__ g, const float* __restrict__ sh, const float* __restrict__ sc, bf16_t* __restrict__ hA, float* rstd_lds, int tile, int tid, bool have_rstd) {
    tid = opaque_v(tid); tile = opaque_s(tile);
    const int w = tid >> 6, lane = tid & 63;
    if (!have_rstd)
    for (int rr = 0; rr < 16; ++rr) {
        const int row = w * 16 + rr;
        const float4* xr = (const float4*)(x + ((size_t)tile * 128 + row) * D);
        float ss = 0.f;
#pragma unroll
        for (int j = 0; j < 4; ++j) { const float4 v = xr[lane + 64 * j]; ss += v.x * v.x + v.y * v.y + v.z * v.z + v.w * v.w; }
        ss = wave_sum(ss);
        if (lane == 0) rstd_lds[row] = rsqrtf(ss * (1.f / D) + EPS);
    }
    __syncthreads();
    const int r5 = lane & 31, hh = lane >> 5;
    for (int it = w; it < 256; it += 8) {
        const int kb = it >> 2, mb = it & 3, row = mb * 32 + r5, k0 = kb * 16 + 8 * hh;
        const float4* xr = (const float4*)(x + ((size_t)tile * 128 + row) * D + k0);
        const float4 a = xr[0], b = xr[1];
        const float4 g0 = *(const float4*)(g + k0), g1 = *(const float4*)(g + k0 + 4);
        const float4 s0 = *(const float4*)(sc + k0), s1 = *(const float4*)(sc + k0 + 4);
        const float4 h0 = *(const float4*)(sh + k0), h1 = *(const float4*)(sh + k0 + 4);
        const float r = rstd_lds[row];
        u32x4 o;
        o.x = pk2(a.x * r * g0.x * (1.f + s0.x) + h0.x, a.y * r * g0.y * (1.f + s0.y) + h0.y);
        o.y = pk2(a.z * r * g0.z * (1.f + s0.z) + h0.z, a.w * r * g0.w * (1.f + s0.w) + h0.w);
        o.z = pk2(b.x * r * g1.x * (1.f + s1.x) + h1.x, b.y * r * g1.y * (1.f + s1.y) + h1.y);
        o.w = pk2(b.z * r * g1.z * (1.f + s1.z) + h1.z, b.w * r * g1.w * (1.f + s1.w) + h1.w);
        *(u32x4*)(hA + ((size_t)tile * 256 + it) * 512 + lane * 8) = o;
    }
}

template <int ORIENT>
DI void kloop(f32x16 (&acc)[4][2], const bf16_t* __restrict__ At, const bf16_t* __restrict__ W0, const bf16_t* __restrict__ W1, char* lds, int tid, int lane) {
    tid = opaque_v(tid); lane = opaque_v(lane);
#pragma unroll
    for (int mb = 0; mb < 4; ++mb)
#pragma unroll
        for (int nb = 0; nb < 2; ++nb)
#pragma unroll
            for (int i = 0; i < 16; ++i) acc[mb][nb][i] = 0.f;
    {
    const u32x4* Ag = (const u32x4*)At + tid;
    const u32x4* W0g = (const u32x4*)W0 + lane;
    const u32x4* W1g = (const u32x4*)W1 + lane;
    u32x4 wq[4][2], ar[2];
    ar[0] = Ag[0]; ar[1] = Ag[512];
#pragma unroll
    for (int kk = 0; kk < 4; ++kk) { wq[kk][0] = W0g[kk * 64]; wq[kk][1] = W1g[kk * 64]; }
    *(u32x4*)(lds + tid * 16) = ar[0]; *(u32x4*)(lds + 8192 + tid * 16) = ar[1];
    __syncthreads();
    for (int kc = 0; kc < 16; ++kc) {
        char* cur = lds + (kc & 1) * 16384;
        char* nxt = lds + ((kc + 1) & 1) * 16384;
        const int kn = kc < 15 ? kc + 1 : 15;
        if (kc < 15) { ar[0] = Ag[(kc + 1) * 1024]; ar[1] = Ag[(kc + 1) * 1024 + 512]; }
        __builtin_amdgcn_sched_barrier(0);
#pragma unroll
        for (int kk = 0; kk < 4; ++kk) {
            bf16x8 afr[4];
#pragma unroll
            for (int mb = 0; mb < 4; ++mb) afr[mb] = *(const bf16x8*)(cur + ((kk * 4 + mb) * 64 + lane) * 16);
#pragma unroll
            for (int mb = 0; mb < 4; ++mb)
#pragma unroll
                for (int nb = 0; nb < 2; ++nb) {
                    const bf16x8 wf = __builtin_bit_cast(bf16x8, wq[kk][nb]);
                    if (ORIENT == 0) acc[mb][nb] = MFMA32(afr[mb], wf, acc[mb][nb]);
                    else acc[mb][nb] = MFMA32(wf, afr[mb], acc[mb][nb]);
                }
            wq[kk][0] = W0g[(kn * 4 + kk) * 64]; wq[kk][1] = W1g[(kn * 4 + kk) * 64];
            __builtin_amdgcn_sched_barrier(0);
        }
        if (kc < 15) { *(u32x4*)(nxt + tid * 16) = ar[0]; *(u32x4*)(nxt + 8192 + tid * 16) = ar[1]; }
        __syncthreads();
    }
    }
}

DI void epi_f32row(const f32x16 (&acc)[4][2], float* __restrict__ C, int tile, int col0, int lane) {
    lane = opaque_v(lane);
    const int r5 = lane & 31, hh = lane >> 5;
    const unsigned boff = (unsigned)((tile * 128 + 4 * hh) * 2048 + col0 + r5);
#pragma unroll
    for (int mb = 0; mb < 4; ++mb)
#pragma unroll
        for (int nb = 0; nb < 2; ++nb)
#pragma unroll
            for (int i = 0; i < 16; ++i)
                C[boff + (unsigned)((mb * 32 + (i & 3) + 8 * (i >> 2)) * 2048 + nb * 32)] = acc[mb][nb][i];
}
DI void epi_resid(const f32x16 (&acc)[4][2], const float* __restrict__ xin, float* __restrict__ xout, const float* __restrict__ gate_b, float* T  , float* ssq  , int tile, int col0, int lane) {
    lane = opaque_v(lane);
    const int r5 = lane & 31, hh = lane >> 5, rq = lane >> 4, c4 = (lane & 15) * 4;
    const float4 gv = *(const float4*)(gate_b + col0 + c4);
#pragma unroll
    for (int mb = 0; mb < 4; ++mb) {
#pragma unroll
        for (int nb = 0; nb < 2; ++nb)
#pragma unroll
            for (int i = 0; i < 16; ++i) T[((i & 3) + 8 * (i >> 2) + 4 * hh) * 68 + nb * 32 + r5] = acc[mb][nb][i];
        asm volatile("s_waitcnt lgkmcnt(0)" ::: "memory");
#pragma unroll
        for (int j = 0; j < 8; ++j) {
            const int row = rq + 4 * j;
            const float4 v = *(const float4*)(T + row * 68 + c4);
            const unsigned o = (unsigned)((tile * 128 + mb * 32 + row) * D + col0 + c4);
            float4 xv = *(const float4*)(xin + o);
            xv.x += gv.x * v.x; xv.y += gv.y * v.y; xv.z += gv.z * v.z; xv.w += gv.w * v.w;
            *(float4*)(xout + o) = xv;
            float ss = xv.x * xv.x + xv.y * xv.y + xv.z * xv.z + xv.w * xv.w;
            ss += __shfl_xor(ss, 1); ss += __shfl_xor(ss, 2); ss += __shfl_xor(ss, 4); ss += __shfl_xor(ss, 8);
            if ((lane & 15) == 0) ssq[mb * 32 + row] = ss;
        }
        asm volatile("s_waitcnt lgkmcnt(0)" ::: "memory");
    }
}

DI void epi_qpf(const f32x16 (&acc)[4][2], bf16_t* __restrict__ QPF, int tile, int ft0, int lane) {
    lane = opaque_v(lane);
#pragma unroll
    for (int nb = 0; nb < 2; ++nb)
#pragma unroll
        for (int s = 0; s < 2; ++s)
#pragma unroll
            for (int mb = 0; mb < 4; ++mb) {
                const f32x16& a = acc[mb][nb];
                u32x4 o; o.x = pk2(a[8 * s], a[8 * s + 1]); o.y = pk2(a[8 * s + 2], a[8 * s + 3]); o.z = pk2(a[8 * s + 4], a[8 * s + 5]); o.w = pk2(a[8 * s + 6], a[8 * s + 7]);
                *(u32x4*)(QPF + ((unsigned)((((tile * 64 + ft0 + nb) * 2 + s) * 4 + mb) * 64 + lane)) * 8) = o;
            }
}

DI void conv_keys_item(const float* __restrict__ K, bf16_t* __restrict__ KF, int gid) {
    const int lane = gid & 63, s = (gid >> 6) & 1, nbl = (gid >> 7) & 3, nt = (gid >> 9) & 3, hp = gid >> 11;
    const int r = lane & 31, hh = lane >> 5;
    const float* p = K + ((size_t)hp * 128 + nt * 32 + r) * 128 + nbl * 32 + 16 * s + 4 * hh;
    const float4 a = *(const float4*)p, b = *(const float4*)(p + 8);
    u32x4 o; o.x = pk2(a.x, a.y); o.y = pk2(a.z, a.w); o.z = pk2(b.x, b.y); o.w = pk2(b.z, b.w);
    *(u32x4*)(KF + (size_t)gid * 8) = o;
}

DI void conv_table_row(const float* __restrict__ src, unsigned char* __restrict__ dst, float* __restrict__ sc, int lane) {
    const float4* p = (const float4*)src + lane * 4;
    float4 v[4];
    float m = 0.f;
#pragma unroll
    for (int j = 0; j < 4; ++j) { v[j] = p[j]; m = fmaxf(m, fmaxf(fmaxf(fabsf(v[j].x), fabsf(v[j].y)), fmaxf(fabsf(v[j].z), fabsf(v[j].w)))); }
#pragma unroll
    for (int o = 1; o < 64; o <<= 1) m = fmaxf(m, __shfl_xor(m, o));
    const float scale = m > 0.f ? m * (1.f / 6.f) : 1.f;
    const float inv = 1.f / scale;
    u32x2 o;
    unsigned* op = (unsigned*)&o;
#pragma unroll
    for (int j = 0; j < 2; ++j) {
        unsigned wv = 0;
        wv = __builtin_amdgcn_cvt_scalef32_pk_fp4_f32(wv, v[2 * j].x * inv, v[2 * j].y * inv, 1.0f, 0);
        wv = __builtin_amdgcn_cvt_scalef32_pk_fp4_f32(wv, v[2 * j].z * inv, v[2 * j].w * inv, 1.0f, 1);
        wv = __builtin_amdgcn_cvt_scalef32_pk_fp4_f32(wv, v[2 * j + 1].x * inv, v[2 * j + 1].y * inv, 1.0f, 2);
        wv = __builtin_amdgcn_cvt_scalef32_pk_fp4_f32(wv, v[2 * j + 1].z * inv, v[2 * j + 1].w * inv, 1.0f, 3);
        op[j] = wv;
    }
    *(u32x2*)(dst + lane * 8) = o;
    if (lane == 0) *sc = scale;
}

DI void ce_desc(int& a, int& b) { const int mx = a > b ? a : b, mn = a > b ? b : a; a = mx; b = mn; }
DI void sort16_desc(int (&v)[16]) {
#pragma unroll
    for (int k = 2; k <= 16; k <<= 1)
#pragma unroll
        for (int j = k >> 1; j > 0; j >>= 1)
#pragma unroll
            for (int i = 0; i < 16; ++i) {
                const int l = i ^ j;
                if (l > i) { if ((i & k) == 0) ce_desc(v[i], v[l]); else ce_desc(v[l], v[i]); }
            }
}
DI void bitonic_merge16_desc(int (&v)[16]) {
#pragma unroll
    for (int j = 8; j > 0; j >>= 1)
#pragma unroll
        for (int i = 0; i < 16; ++i) { const int l = i ^ j; if (l > i) ce_desc(v[i], v[l]); }
}
DI void merge_top16(int (&a)[16], const int (&b)[16]) {
#pragma unroll
    for (int i = 0; i < 16; ++i) a[i] = a[i] > b[15 - i] ? a[i] : b[15 - i];
    bitonic_merge16_desc(a);
}
DI int f2ord(float f) { int b = __float_as_int(f); return b ^ ((b >> 31) & 0x7fffffff); }
DI float ord2f(int k) { return __int_as_float(k ^ ((k >> 31) & 0x7fffffff)); }

DI void route_tile(const bf16_t* __restrict__ QPF, const bf16_t* __restrict__ KF, int* __restrict__ ridx, float* __restrict__ rgate, unsigned char* lds_idx  , int tile, int tid) {
    tid = opaque_v(tid); tile = opaque_s(tile);
    const int lane = tid & 63, w = __builtin_amdgcn_readfirstlane(tid >> 6);
    const int r5 = lane & 31, hh = lane >> 5;
    unsigned char* myidx = lds_idx + w * 1024;
    for (int task = w; task < 32; task += 8) {
        const int h = task >> 2, tt = task & 3;
        f32x16 acc[2][4];
#pragma unroll
        for (int p = 0; p < 2; ++p)
#pragma unroll
            for (int nt = 0; nt < 4; ++nt)
#pragma unroll
                for (int i = 0; i < 16; ++i) acc[p][nt][i] = 0.f;
        {
            bf16x8 bq[2], ak[2][4];
#define ROUTE_LOAD(buf, step) do { const int p_ = (step) >> 3, ks_ = (step) & 7; \
                bq[buf] = *(const bf16x8*)(QPF + ((unsigned)((((tile * 64 + h * 8 + p_ * 4 + (ks_ >> 1)) * 2 + (ks_ & 1)) * 4 + tt) * 64 + lane)) * 8); \
                _Pragma("unroll") for (int nt = 0; nt < 4; ++nt) ak[buf][nt] = *(const bf16x8*)(KF + ((unsigned)(((((h * 2 + p_) * 4 + nt) * 8 + ks_) * 64) + lane)) * 8); } while (0)
            ROUTE_LOAD(0, 0);
#pragma unroll
            for (int step = 0; step < 16; ++step) {
                if (step < 15) ROUTE_LOAD((step + 1) & 1, step + 1);
#pragma unroll
                for (int nt = 0; nt < 4; ++nt) acc[step >> 3][nt] = MFMA32(ak[step & 1][nt], bq[step & 1], acc[step >> 3][nt]);
                __builtin_amdgcn_sched_barrier(0);
            }
#undef ROUTE_LOAD
        }
        int g[8][16];
#pragma unroll
        for (int nt = 0; nt < 4; ++nt)
#pragma unroll
            for (int i = 0; i < 16; ++i) {
                const unsigned a = __float_as_uint(acc[0][nt][i]), b = __float_as_uint(acc[1][nt][i]);
                auto sw = __builtin_amdgcn_permlane32_swap(a, b, false, false);
                const int n0 = nt * 32 + (i & 3) + 8 * (i >> 2);
                g[nt * 2 + (i >> 3)][i & 7] = (f2ord(__uint_as_float(sw[0])) & ~127) | n0;
                g[nt * 2 + (i >> 3)][8 + (i & 7)] = (f2ord(__uint_as_float(sw[1])) & ~127) | (n0 + 4);
            }
#pragma unroll
        for (int q = 0; q < 8; ++q) sort16_desc(g[q]);
        merge_top16(g[0], g[1]); merge_top16(g[2], g[3]); merge_top16(g[4], g[5]); merge_top16(g[6], g[7]);
        merge_top16(g[0], g[2]); merge_top16(g[4], g[6]);
        merge_top16(g[0], g[4]);
        {
            u32x4 pk;
            unsigned* pp = (unsigned*)&pk;
#pragma unroll
            for (int q = 0; q < 4; ++q) pp[q] = (unsigned)(g[0][4 * q] & 127) | ((unsigned)(g[0][4 * q + 1] & 127) << 8) | ((unsigned)(g[0][4 * q + 2] & 127) << 16) | ((unsigned)(g[0][4 * q + 3] & 127) << 24);
            *(u32x4*)(myidx + lane * 16) = pk;
        }
        float f0[16], f1[16];
#pragma unroll
        for (int i = 0; i < 16; ++i) {
            const unsigned a = (unsigned)g[0][i], b = a;
            auto sw = __builtin_amdgcn_permlane32_swap(a, b, false, false);
            f0[i] = ord2f((int)sw[0] & ~127); f1[i] = ord2f((int)sw[1] & ~127);
        }
        int c0[16], c1[16], c2[16], c3[16];
#pragma unroll
        for (int j = 0; j < 16; ++j) c0[j] = (f2ord(f0[0] + f1[j]) & ~255) | j;
#pragma unroll
        for (int i = 1; i < 16; ++i) c1[i - 1] = (f2ord(f0[i] + f1[0]) & ~255) | (i << 4);
        c1[15] = (int)0x80000000;
#define CK(i, j) ((f2ord(f0[i] + f1[j]) & ~255) | ((i) << 4) | (j))
        c2[0] = CK(1, 1); c2[1] = CK(1, 2); c2[2] = CK(1, 3); c2[3] = CK(1, 4); c2[4] = CK(1, 5); c2[5] = CK(1, 6); c2[6] = CK(1, 7);
        c2[7] = CK(2, 1); c2[8] = CK(2, 2); c2[9] = CK(2, 3); c2[10] = CK(2, 4);
        c2[11] = CK(3, 1); c2[12] = CK(3, 2); c2[13] = CK(3, 3);
        c2[14] = CK(4, 1); c2[15] = CK(4, 2);
        c3[0] = CK(5, 1); c3[1] = CK(6, 1); c3[2] = CK(7, 1);
#undef CK
#pragma unroll
        for (int q = 3; q < 16; ++q) c3[q] = (int)0x80000000;
        sort16_desc(c2);
        ce_desc(c3[0], c3[1]); ce_desc(c3[1], c3[2]); ce_desc(c3[0], c3[1]);
        merge_top16(c0, c1); merge_top16(c2, c3); merge_top16(c0, c2);
        float bs[16], den = 0.f;
#pragma unroll
        for (int i = 0; i < 16; ++i) { bs[i] = __expf(ord2f(c0[i] & ~255) - ord2f(c0[0] & ~255)); den += bs[i]; }
        const float rden = 1.f / den;
        asm volatile("s_waitcnt lgkmcnt(0)" ::: "memory");
        const int tok = tile * 128 + tt * 32 + r5;
#pragma unroll
        for (int q = 0; q < 8; ++q) {
            const int key = (int)__builtin_amdgcn_permlane32_swap((unsigned)c0[q], (unsigned)c0[8 + q], false, false)[0];
            const float gv = __uint_as_float(__builtin_amdgcn_permlane32_swap(__float_as_uint(bs[q]), __float_as_uint(bs[8 + q]), false, false)[0]) * rden;
            const int i = (key >> 4) & 15, j = key & 15;
            const int e = (int)myidx[r5 * 16 + i] * 128 + (int)myidx[(32 + r5) * 16 + j];
            ridx[(unsigned)(tok * 128 + h * 16 + 8 * hh + q)] = e;
            rgate[(unsigned)(tok * 128 + h * 16 + 8 * hh + q)] = gv;
        }
        asm volatile("s_waitcnt lgkmcnt(0)" ::: "memory");
    }
}

DI void unpack_h2(const bf16_t* __restrict__ hA, int t, int lane, f32x2 (&hv)[8]) {
    const int tile = t >> 7, row = t & 127, mb = row >> 5, r5 = row & 31;
    const bf16_t* hp = hA + ((unsigned)(((tile * 64 + lane) * 4 + mb) * 64 + r5)) * 8;
    const u32x4 ha = *(const u32x4*)hp, hb = *(const u32x4*)(hp + 32 * 8);
    const unsigned hw[8] = {ha.x, ha.y, ha.z, ha.w, hb.x, hb.y, hb.z, hb.w};
#pragma unroll
    for (int q = 0; q < 8; ++q) { hv[q].x = __uint_as_float(hw[q] << 16); hv[q].y = __uint_as_float(hw[q] & 0xffff0000u); }
}
constexpr int NSLICE = 1, SLICE_EXPERTS = 16384 / NSLICE;
constexpr int PL_SEID = 0, PL_SWGT = 32768, PL_OFFS = 98304, PL_SORT = 99328, PL_END = 103424;
DI void sort_token(const int* __restrict__ ridx, const float* __restrict__ rgate, char* lds, int t, int tloc, int w, int lane) {
    lane = opaque_v(lane); t = opaque_s(t);
    unsigned short* seid = (unsigned short*)(lds + PL_SEID) + tloc * 128;
    float* swgt = (float*)(lds + PL_SWGT) + tloc * 128;
    int* kl = (int*)(lds + PL_SORT) + w * 128;
    const int e0 = ridx[(unsigned)(t * 128 + lane)], e1 = ridx[(unsigned)(t * 128 + 64 + lane)];
    const float g0 = rgate[(unsigned)(t * 128 + lane)], g1 = rgate[(unsigned)(t * 128 + 64 + lane)];
    const int k0 = (e0 << 7) | lane, k1 = (e1 << 7) | (64 + lane);
    kl[lane] = k0; kl[64 + lane] = k1;
    asm volatile("s_waitcnt lgkmcnt(0)" ::: "memory");
    int r0 = 0, r1 = 0;
#pragma unroll 8
    for (int j = 0; j < 128; j += 4) {
        const int4 kk = *(const int4*)(kl + j);
        r0 += (kk.x < k0) + (kk.y < k0) + (kk.z < k0) + (kk.w < k0);
        r1 += (kk.x < k1) + (kk.y < k1) + (kk.z < k1) + (kk.w < k1);
    }
    seid[r0] = (unsigned short)e0; swgt[r0] = g0;
    seid[r1] = (unsigned short)e1; swgt[r1] = g1;
    unsigned c[7];
#pragma unroll
    for (int i = 0; i < 7; ++i) { const int bnd = SLICE_EXPERTS * (i + 1); c[i] = (unsigned)(__popcll(__ballot(e0 < bnd)) + __popcll(__ballot(e1 < bnd))); }
    if (lane == 0) { u32x2 o; o.x = c[0] | (c[1] << 8) | (c[2] << 16) | (c[3] << 24); o.y = c[4] | (c[5] << 8) | (c[6] << 16) | (128u << 24); ((u32x2*)(lds + PL_OFFS))[tloc] = o; }
    asm volatile("s_waitcnt lgkmcnt(0)" ::: "memory");
}
DI void seg_bounds(const char* lds, int tloc, int s, int& start, int& end) {
    const u32x2 ov = ((const u32x2*)(lds + PL_OFFS))[tloc];
    const unsigned long long o64 = (unsigned long long)(unsigned)__builtin_amdgcn_readfirstlane((int)ov.x) | ((unsigned long long)(unsigned)__builtin_amdgcn_readfirstlane((int)ov.y) << 32);
    end = s == NSLICE - 1 ? 128 : (int)((o64 >> (8 * s)) & 255u);
    start = s ? (int)((o64 >> (8 * (s - 1))) & 255u) : 0;
}
DI void peer_down_wave(const bf16_t* __restrict__ hA, char* lds, const unsigned char* __restrict__ TBd, const float* __restrict__ SC, int tile, int w, int lane, int srot) {
    lane = opaque_v(lane);
    const int myu = ((lane >> 5) & 1) * 8 + ((lane >> 4) & 1) * 4 + ((lane >> 3) & 1) * 2 + ((lane >> 2) & 1);
    for (int ss = 0; ss < NSLICE; ++ss) {
        const int s = (ss + srot) % NSLICE;
        for (int tl = 0; tl < 16; ++tl) {
            const int tloc = w * 16 + tl, t = tile * 128 + tloc;
            int start, end;
            seg_bounds(lds, tloc, s, start, end);
            if (start >= end) continue;
            f32x2 hv[8];
            unpack_h2(hA, t, lane, hv);
            const unsigned short* ip = (const unsigned short*)(lds + PL_SEID) + tloc * 128;
            float* gp = (float*)(lds + PL_SWGT) + tloc * 128;
            for (int c0 = start; c0 < end; c0 += 64) {
                const int ev = ip[min(c0 + lane, end - 1)];
                const int cend = min(end - c0, 64);
                for (int p = 0; p < cend; p += 16) {
                    u32x2 dr[16];
#pragma unroll
                    for (int u = 0; u < 16; ++u) {
                        const int e = __builtin_amdgcn_readlane(ev, min(p + u, cend - 1));
                        dr[u] = *(const u32x2*)(TBd + (size_t)(unsigned)e * 512 + lane * 8);
                    }
                    float part[16];
#pragma unroll
                    for (int u = 0; u < 16; ++u) {
                        const unsigned dw[2] = {dr[u].x, dr[u].y};
                        f32x2 s2 = (f32x2){0.f, 0.f};
#pragma unroll
                        for (int q = 0; q < 2; ++q) {
                            s2 += __builtin_amdgcn_cvt_scalef32_pk_f32_fp4(dw[q], 1.0f, 0) * hv[4 * q];
                            s2 += __builtin_amdgcn_cvt_scalef32_pk_f32_fp4(dw[q], 1.0f, 1) * hv[4 * q + 1];
                            s2 += __builtin_amdgcn_cvt_scalef32_pk_f32_fp4(dw[q], 1.0f, 2) * hv[4 * q + 2];
                            s2 += __builtin_amdgcn_cvt_scalef32_pk_f32_fp4(dw[q], 1.0f, 3) * hv[4 * q + 3];
                        }
                        part[u] = s2.x + s2.y;
                    }
                    float r8[8], r4[4], r2[2], r1;
                    {
                        const bool b5 = (lane & 32) != 0, b4 = (lane & 16) != 0, b3 = (lane & 8) != 0, b2 = (lane & 4) != 0;
#pragma unroll
                        for (int q = 0; q < 8; ++q) { const float keep = b5 ? part[q + 8] : part[q], give = b5 ? part[q] : part[q + 8]; r8[q] = keep + __shfl_xor(give, 32); }
#pragma unroll
                        for (int q = 0; q < 4; ++q) { const float keep = b4 ? r8[q + 4] : r8[q], give = b4 ? r8[q] : r8[q + 4]; r4[q] = keep + __shfl_xor(give, 16); }
#pragma unroll
                        for (int q = 0; q < 2; ++q) { const float keep = b3 ? r4[q + 2] : r4[q], give = b3 ? r4[q] : r4[q + 2]; r2[q] = keep + __shfl_xor(give, 8); }
                        { const float keep = b2 ? r2[1] : r2[0], give = b2 ? r2[0] : r2[1]; r1 = keep + __shfl_xor(give, 4); }
                        r1 += __shfl_xor(r1, 2); r1 += __shfl_xor(r1, 1);
                    }
                    const int pi = c0 + p + myu;
                    if ((lane & 3) == 0 && p + myu < cend) {
                        const int me = ip[pi];
                        const float a = r1 * SC[(unsigned)me * 2];
                        gp[pi] = gp[pi] * (0.5f * a * (1.f + erff(a * 0.70710678118654752f))) * SC[(unsigned)me * 2 + 1];
                    }
                }
            }
        }
    }
}
DI void peer_up_wave(char* lds, const unsigned char* __restrict__ TBu, const float* __restrict__ g2b, float* __restrict__ x, int tile, int w, int lane, int srot) {
    lane = opaque_v(lane);
    for (int r = 0; r < 2; ++r) {
        f32x2 acc[8][8];
#pragma unroll
        for (int k = 0; k < 8; ++k)
#pragma unroll
            for (int q = 0; q < 8; ++q) acc[k][q] = (f32x2){0.f, 0.f};
        for (int ss = 0; ss < NSLICE; ++ss) {
            const int s = (ss + srot) % NSLICE;
#pragma unroll
            for (int k = 0; k < 8; ++k) {
                const int tloc = w * 16 + r * 8 + k;
                int start, end;
                seg_bounds(lds, tloc, s, start, end);
                const unsigned short* ip = (const unsigned short*)(lds + PL_SEID) + tloc * 128;
                const float* gp = (const float*)(lds + PL_SWGT) + tloc * 128;
                for (int c0 = start; c0 < end; c0 += 64) {
                    const int li = min(c0 + lane, end - 1);
                    const int ev = ip[li];
                    const float wl = gp[li];
                    const int cend = min(end - c0, 64);
                    for (int p = 0; p < cend; p += 8) {
                        u32x2 ur[8]; float wv[8];
#pragma unroll
                        for (int u = 0; u < 8; ++u) {
                            const int sl = min(p + u, cend - 1);
                            const int e = __builtin_amdgcn_readlane(ev, sl);
                            const float wr = __int_as_float(__builtin_amdgcn_readlane(__float_as_int(wl), sl));
                            wv[u] = (p + u < cend) ? wr : 0.f;
                            ur[u] = *(const u32x2*)(TBu + (size_t)(unsigned)e * 512 + lane * 8);
                        }
#pragma unroll
                        for (int u = 0; u < 8; ++u) {
                            const unsigned uw[2] = {ur[u].x, ur[u].y};
                            const f32x2 w2 = (f32x2){wv[u], wv[u]};
#pragma unroll
                            for (int q = 0; q < 2; ++q) {
                                acc[k][4 * q] += w2 * __builtin_amdgcn_cvt_scalef32_pk_f32_fp4(uw[q], 1.0f, 0);
                                acc[k][4 * q + 1] += w2 * __builtin_amdgcn_cvt_scalef32_pk_f32_fp4(uw[q], 1.0f, 1);
                                acc[k][4 * q + 2] += w2 * __builtin_amdgcn_cvt_scalef32_pk_f32_fp4(uw[q], 1.0f, 2);
                                acc[k][4 * q + 3] += w2 * __builtin_amdgcn_cvt_scalef32_pk_f32_fp4(uw[q], 1.0f, 3);
                            }
                        }
                    }
                }
            }
        }
#pragma unroll
        for (int k = 0; k < 8; ++k) {
            const int t = tile * 128 + w * 16 + r * 8 + k;
            float4* xp = (float4*)(x + (size_t)t * D + lane * 16);
            const float4* gq = (const float4*)(g2b + lane * 16);
            float ssx = 0.f;
#pragma unroll
            for (int q = 0; q < 4; ++q) {
                float4 xv = xp[q]; const float4 gv = gq[q];
                xv.x += gv.x * acc[k][2 * q].x; xv.y += gv.y * acc[k][2 * q].y; xv.z += gv.z * acc[k][2 * q + 1].x; xv.w += gv.w * acc[k][2 * q + 1].y;
                xp[q] = xv;
                ssx += xv.x * xv.x + xv.y * xv.y + xv.z * xv.z + xv.w * xv.w;
            }
            ssx = wave_sum(ssx);
            if (lane == 0) ((float*)(lds + LDS_RSTD1))[w * 16 + r * 8 + k] = rsqrtf(ssx * (1.f / D) + EPS);
        }
    }
}

DI void epi_qk(f32x16 (&acc)[4][2], const float* __restrict__ gain, float scale, bf16_t* __restrict__ dst, int lane) {
    lane = opaque_v(lane);
    const int hh = lane >> 5;
    float gv[2][16];
#pragma unroll
    for (int nb = 0; nb < 2; ++nb)
#pragma unroll
        for (int i = 0; i < 16; ++i) gv[nb][i] = gain[nb * 32 + (i & 3) + 8 * (i >> 2) + 4 * hh] * scale;
#pragma unroll
    for (int mb = 0; mb < 4; ++mb) {
        float ss = 0.f;
#pragma unroll
        for (int nb = 0; nb < 2; ++nb)
#pragma unroll
            for (int i = 0; i < 16; ++i) ss += acc[mb][nb][i] * acc[mb][nb][i];
        ss += __shfl_xor(ss, 32);
        const float r = rsqrtf(ss * (1.f / 64.f) + EPS);
#pragma unroll
        for (int nb = 0; nb < 2; ++nb)
#pragma unroll
            for (int s = 0; s < 2; ++s) {
                const f32x16& a = acc[mb][nb];
                u32x4 o;
                o.x = pk2(a[8 * s] * r * gv[nb][8 * s], a[8 * s + 1] * r * gv[nb][8 * s + 1]);
                o.y = pk2(a[8 * s + 2] * r * gv[nb][8 * s + 2], a[8 * s + 3] * r * gv[nb][8 * s + 3]);
                o.z = pk2(a[8 * s + 4] * r * gv[nb][8 * s + 4], a[8 * s + 5] * r * gv[nb][8 * s + 5]);
                o.w = pk2(a[8 * s + 6] * r * gv[nb][8 * s + 6], a[8 * s + 7] * r * gv[nb][8 * s + 7]);
                *(u32x4*)(dst + ((unsigned)(((nb * 2 + s) * 4 + mb) * 64 + lane)) * 8) = o;
            }
    }
}
DI void epi_v(const f32x16 (&acc)[4][2], bf16_t* __restrict__ dst, int lane) {
    lane = opaque_v(lane);
#pragma unroll
    for (int nb = 0; nb < 2; ++nb)
#pragma unroll
        for (int mb = 0; mb < 4; ++mb)
#pragma unroll
            for (int s = 0; s < 2; ++s) {
                const f32x16& a = acc[mb][nb];
                u32x4 o; o.x = pk2(a[8 * s], a[8 * s + 1]); o.y = pk2(a[8 * s + 2], a[8 * s + 3]); o.z = pk2(a[8 * s + 4], a[8 * s + 5]); o.w = pk2(a[8 * s + 6], a[8 * s + 7]);
                *(u32x4*)(dst + ((unsigned)(((nb * 4 + mb) * 2 + s) * 64 + lane)) * 8) = o;
            }
}
DI void epi_row(const f32x16 (&acc)[4][2], bf16_t* __restrict__ dst, int ld, int lane) {
    lane = opaque_v(lane);
    const int r5 = lane & 31, hh = lane >> 5;
#pragma unroll
    for (int mb = 0; mb < 4; ++mb)
#pragma unroll
        for (int nb = 0; nb < 2; ++nb)
#pragma unroll
            for (int gq = 0; gq < 4; ++gq) {
                const f32x16& a = acc[mb][nb];
                u32x2 o; o.x = pk2(a[4 * gq], a[4 * gq + 1]); o.y = pk2(a[4 * gq + 2], a[4 * gq + 3]);
                *(u32x2*)(dst + (unsigned)((mb * 32 + r5) * ld + nb * 32 + 8 * gq + 4 * hh)) = o;
            }
}
DI void epi_z(const f32x16 (&acc)[4][2], bf16_t* __restrict__ dst, int lane) {
    lane = opaque_v(lane);
    const int r5 = lane & 31, hh = lane >> 5;
#pragma unroll
    for (int mb = 0; mb < 4; ++mb)
#pragma unroll
        for (int gq = 0; gq < 4; ++gq) {
            const f32x16 &a = acc[mb][0], &b = acc[mb][1];
            u32x2 o; o.x = pk2(a[4 * gq] * b[4 * gq], a[4 * gq + 1] * b[4 * gq + 1]); o.y = pk2(a[4 * gq + 2] * b[4 * gq + 2], a[4 * gq + 3] * b[4 * gq + 3]);
            *(u32x2*)(dst + (unsigned)((mb * 32 + r5) * 256 + 8 * gq + 4 * hh)) = o;
        }
}
DI void epi_su_park(const f32x16 (&acc)[4][2], unsigned* lds_su, int lane) {
    lane = opaque_v(lane);
#pragma unroll
    for (int mb = 0; mb < 4; ++mb)
#pragma unroll
        for (int nb = 0; nb < 2; ++nb)
#pragma unroll
            for (int q = 0; q < 8; ++q) lds_su[((mb * 2 + nb) * 8 + q) * 64 + lane] = pk2(acc[mb][nb][2 * q], acc[mb][nb][2 * q + 1]);
}
DI void epi_sv(f32x16 (&acc)[4][2], const bf16_t* __restrict__ SWF  , const float* __restrict__ bs_g, const unsigned* lds_su, bf16_t* __restrict__ dst, int lane) {
    lane = opaque_v(lane);
    const int r5 = lane & 31, hh = lane >> 5;
    bf16x8 vb[4][2][2];
#pragma unroll
    for (int mb = 0; mb < 4; ++mb) {
#pragma unroll
        for (int i = 0; i < 16; ++i) {
            float s1 = acc[mb][0][i] + acc[mb][1][i];
#pragma unroll
            for (int o = 1; o < 32; o <<= 1) s1 += __shfl_xor(s1, o);
            const float mu = s1 * (1.f / 64.f);
            const float d0 = acc[mb][0][i] - mu, d1 = acc[mb][1][i] - mu;
            float s2 = d0 * d0 + d1 * d1;
#pragma unroll
            for (int o = 1; o < 32; o <<= 1) s2 += __shfl_xor(s2, o);
            const float r = rsqrtf(s2 * (1.f / 64.f) + EPS);
            acc[mb][0][i] = d0 * r; acc[mb][1][i] = d1 * r;
        }
#pragma unroll
        for (int s = 0; s < 2; ++s)
#pragma unroll
            for (int nb = 0; nb < 2; ++nb) {
                const f32x16& a = acc[mb][nb];
                u32x4 o; o.x = pk2(a[8 * s], a[8 * s + 1]); o.y = pk2(a[8 * s + 2], a[8 * s + 3]); o.z = pk2(a[8 * s + 4], a[8 * s + 5]); o.w = pk2(a[8 * s + 6], a[8 * s + 7]);
                vb[mb][s][nb] = __builtin_bit_cast(bf16x8, o);
            }
    }
#pragma unroll
    for (int tb = 0; tb < 4; ++tb) {
        f32x16 y[2];
#pragma unroll
        for (int nb = 0; nb < 2; ++nb)
#pragma unroll
            for (int i = 0; i < 16; ++i) y[nb][i] = 0.f;
#pragma unroll
        for (int kt = 0; kt <= tb; ++kt)
#pragma unroll
            for (int s = 0; s < 2; ++s) {
                const bf16x8 wa = *(const bf16x8*)(SWF + ((unsigned)(((tb * 4 + kt) * 2 + s) * 64 + lane)) * 8);
                y[0] = MFMA32(wa, vb[kt][s][0], y[0]);
                y[1] = MFMA32(wa, vb[kt][s][1], y[1]);
            }
#pragma unroll
        for (int nb = 0; nb < 2; ++nb)
#pragma unroll
            for (int q = 0; q < 8; ++q) {
                const unsigned su2 = lds_su[((tb * 2 + nb) * 8 + q) * 64 + lane];
                const int i0 = 2 * q, i1 = 2 * q + 1;
                const int t0 = tb * 32 + (i0 & 3) + 8 * (i0 >> 2) + 4 * hh, t1 = tb * 32 + (i1 & 3) + 8 * (i1 >> 2) + 4 * hh;
                const float v0 = (y[nb][i0] + bs_g[t0]) * __uint_as_float(su2 << 16), v1 = (y[nb][i1] + bs_g[t1]) * __uint_as_float(su2 & 0xffff0000u);
                const unsigned pk = pk2(v0, v1);
                dst[(unsigned)(t0 * 256 + nb * 32 + r5)] = (bf16_t)(pk & 0xffffu);
                dst[(unsigned)(t1 * 256 + nb * 32 + r5)] = (bf16_t)(pk >> 16);
            }
    }
}

DI void conv_sguw_item(const float* __restrict__ W, bf16_t* __restrict__ SWF, int gid) {
    const int lane = gid & 63, s = (gid >> 6) & 1, kt = (gid >> 7) & 3, tb = (gid >> 9) & 3, g = gid >> 11;
    const int r = lane & 31, hh = lane >> 5, t = tb * 32 + r;
    const float* p = W + ((size_t)g * 128 + t) * 128;
    float v[8];
#pragma unroll
    for (int j = 0; j < 8; ++j) { const int sp = kt * 32 + 16 * s + 8 * (j >> 2) + 4 * hh + (j & 3); v[j] = sp <= t ? p[sp] : 0.f; }
    u32x4 o; o.x = pk2(v[0], v[1]); o.y = pk2(v[2], v[3]); o.z = pk2(v[4], v[5]); o.w = pk2(v[6], v[7]);
    *(u32x4*)(SWF + (size_t)gid * 8) = o;
}

DI int t5_bucket(int d) {
    if (d < 16) return d;
    const float lr = logf((float)d / 16.f) / logf(8.f);
    const int large = 16 + (int)(lr * 16.f);
    return large < 31 ? large : 31;
}

DI void attn_tile(const bf16_t* __restrict__ QF, const bf16_t* __restrict__ KF2, const bf16_t* __restrict__ VF, const float* bias_lds, const float* __restrict__ sink, bf16_t* __restrict__ OR, int tile, int tid) {
    tid = opaque_v(tid); tile = opaque_s(tile);
    const int lane = tid & 63, w = __builtin_amdgcn_readfirstlane(tid >> 6), r5 = lane & 31, hh = lane >> 5;
    const bool has_prev = (tile & 31) != 0;
    for (int task = w; task < 32; task += 8) {
        const int qh = task >> 2, qt = task & 3, kvh = qh >> 2;
        bf16x8 bq[4];
#pragma unroll
        for (int ks = 0; ks < 4; ++ks) bq[ks] = *(const bf16x8*)(QF + ((unsigned)((((tile * 8 + qh) * 4 + ks) * 4 + qt) * 64 + lane)) * 8);
        f32x16 sc[5];
#pragma unroll
        for (int jj = 0; jj < 5; ++jj) {
#pragma unroll
            for (int i = 0; i < 16; ++i) sc[jj][i] = 0.f;
            const int j = qt + jj;
            if (j >= 4 || has_prev) {
                const int st = j >= 4 ? tile : tile - 1, kt = j & 3;
#pragma unroll
                for (int ks = 0; ks < 4; ++ks) {
                    const bf16x8 ak = *(const bf16x8*)(KF2 + ((unsigned)((((st * 2 + kvh) * 4 + ks) * 4 + kt) * 64 + lane)) * 8);
                    sc[jj] = MFMA32(ak, bq[ks], sc[jj]);
                }
            }
        }
        const float* bl = bias_lds + qh * 128;
        float m = -1e30f;
#pragma unroll
        for (int jj = 0; jj < 5; ++jj) {
            const bool ex = (qt + jj >= 4) || has_prev;
#pragma unroll
            for (int i = 0; i < 16; ++i) {
                const int cr = (i & 3) + 8 * (i >> 2) + 4 * hh;
                const int dist = 128 + r5 - 32 * jj - cr;
                const bool valid = ex && dist >= 0 && dist < 128;
                const float v = valid ? sc[jj][i] + bl[dist & 127] : -1e30f;
                sc[jj][i] = v; m = fmaxf(m, v);
            }
        }
        m = fmaxf(m, __shfl_xor(m, 32));
        const float sk = sink[qh];
        m = fmaxf(m, sk);
        float l = 0.f;
#pragma unroll
        for (int jj = 0; jj < 5; ++jj)
#pragma unroll
            for (int i = 0; i < 16; ++i) { const float p = __expf(sc[jj][i] - m); sc[jj][i] = p; l += p; }
        l += __shfl_xor(l, 32);
        l += __expf(sk - m);
        const float rl = 1.f / l;
        f32x16 o[2];
#pragma unroll
        for (int dt = 0; dt < 2; ++dt)
#pragma unroll
            for (int i = 0; i < 16; ++i) o[dt][i] = 0.f;
#pragma unroll
        for (int jj = 0; jj < 5; ++jj) {
            const int j = qt + jj;
            if (j >= 4 || has_prev) {
                const int st = j >= 4 ? tile : tile - 1, kt = j & 3;
#pragma unroll
                for (int s = 0; s < 2; ++s) {
                    const f32x16& a = sc[jj];
                    u32x4 pp; pp.x = pk2(a[8 * s], a[8 * s + 1]); pp.y = pk2(a[8 * s + 2], a[8 * s + 3]); pp.z = pk2(a[8 * s + 4], a[8 * s + 5]); pp.w = pk2(a[8 * s + 6], a[8 * s + 7]);
                    const bf16x8 pb = __builtin_bit_cast(bf16x8, pp);
#pragma unroll
                    for (int dt = 0; dt < 2; ++dt) {
                        const bf16x8 va = *(const bf16x8*)(VF + ((unsigned)(((((st * 2 + kvh) * 2 + dt) * 4 + kt) * 2 + s) * 64 + lane)) * 8);
                        o[dt] = MFMA32(va, pb, o[dt]);
                    }
                }
            }
        }
        bf16_t* orow = OR + (unsigned)((tile * 128 + qt * 32 + r5) * 512 + qh * 64 + 4 * hh);
#pragma unroll
        for (int dt = 0; dt < 2; ++dt)
#pragma unroll
            for (int gq = 0; gq < 4; ++gq) {
                u32x2 ov; ov.x = pk2(o[dt][4 * gq] * rl, o[dt][4 * gq + 1] * rl); ov.y = pk2(o[dt][4 * gq + 2] * rl, o[dt][4 * gq + 3] * rl);
                *(u32x2*)(orow + dt * 32 + 8 * gq) = ov;
            }
    }
}

DI void unpack8(const u32x4 v, float (&f)[8]) {
    f[0] = __uint_as_float(v.x << 16); f[1] = __uint_as_float(v.x & 0xffff0000u); f[2] = __uint_as_float(v.y << 16); f[3] = __uint_as_float(v.y & 0xffff0000u);
    f[4] = __uint_as_float(v.z << 16); f[5] = __uint_as_float(v.z & 0xffff0000u); f[6] = __uint_as_float(v.w << 16); f[7] = __uint_as_float(v.w & 0xffff0000u);
}
DI void merge_tile(const bf16_t* __restrict__ OR, const bf16_t* __restrict__ CBR, const bf16_t* __restrict__ ZR, const bf16_t* __restrict__ YS, const float* __restrict__ cw  , const float* __restrict__ og  ,
                   bf16_t* __restrict__ mA, int tile, int tid) {
    tid = opaque_v(tid); tile = opaque_s(tile);
    const int lane = tid & 63, w = tid >> 6;
    for (int rr = 0; rr < 16; ++rr) {
        const int row = w * 16 + rr, t = tile * 128 + row, pos = t & (S - 1);
        float a[8], y[8];
        unpack8(*(const u32x4*)(OR + (unsigned)(t * 512 + lane * 8)), a);
        float ssa = 0.f;
#pragma unroll
        for (int q = 0; q < 8; ++q) ssa += a[q] * a[q];
        ssa = wave_sum(ssa);
        if (lane < 32) {
            const int c0 = lane * 8;
            float cb[8], z0[8], z1[8], z2[8];
            unpack8(*(const u32x4*)(CBR + (unsigned)(t * 256 + c0)), cb);
            unpack8(*(const u32x4*)(ZR + (unsigned)(t * 256 + c0)), z2);
            if (pos >= 1) unpack8(*(const u32x4*)(ZR + (unsigned)((t - 1) * 256 + c0)), z1); else { _Pragma("unroll") for (int q = 0; q < 8; ++q) z1[q] = 0.f; }
            if (pos >= 2) unpack8(*(const u32x4*)(ZR + (unsigned)((t - 2) * 256 + c0)), z0); else { _Pragma("unroll") for (int q = 0; q < 8; ++q) z0[q] = 0.f; }
#pragma unroll
            for (int q = 0; q < 8; ++q) y[q] = cb[q] * (cw[c0 + q] * z0[q] + cw[256 + c0 + q] * z1[q] + cw[512 + c0 + q] * z2[q]);
        } else {
            unpack8(*(const u32x4*)(YS + (unsigned)(t * 256 + (lane - 32) * 8)), y);
        }
        float ssy = 0.f;
#pragma unroll
        for (int q = 0; q < 8; ++q) ssy += y[q] * y[q];
#pragma unroll
        for (int o = 1; o < 32; o <<= 1) ssy += __shfl_xor(ssy, o);
        const float ra = rsqrtf(ssa * (1.f / 512.f) + EPS), ry = rsqrtf(ssy * (1.f / 256.f) + EPS);
        const int mb = row >> 5, r5 = row & 31;
        {
            const float4 g0 = *(const float4*)(og + lane * 8), g1 = *(const float4*)(og + lane * 8 + 4);
            u32x4 o; o.x = pk2(a[0] * ra * g0.x, a[1] * ra * g0.y); o.y = pk2(a[2] * ra * g0.z, a[3] * ra * g0.w); o.z = pk2(a[4] * ra * g1.x, a[5] * ra * g1.y); o.w = pk2(a[6] * ra * g1.z, a[7] * ra * g1.w);
            const int c8 = lane;
            *(u32x4*)(mA + ((unsigned)(((tile * 64 + (c8 >> 1)) * 4 + mb) * 64 + r5 + 32 * (c8 & 1))) * 8) = o;
        }
        {
            const float4 g0 = *(const float4*)(og + 512 + lane * 8), g1 = *(const float4*)(og + 512 + lane * 8 + 4);
            u32x4 o; o.x = pk2(y[0] * ry * g0.x, y[1] * ry * g0.y); o.y = pk2(y[2] * ry * g0.z, y[3] * ry * g0.w); o.z = pk2(y[4] * ry * g1.x, y[5] * ry * g1.y); o.w = pk2(y[6] * ry * g1.z, y[7] * ry * g1.w);
            const int c8 = 64 + lane;
            *(u32x4*)(mA + ((unsigned)(((tile * 64 + (c8 >> 1)) * 4 + mb) * 64 + r5 + 32 * (c8 & 1))) * 8) = o;
        }
    }
}

struct InProjOut { bf16_t *QF, *KF2, *VF, *CBR, *ZR, *YS; };
DI void inproj_tile(const bf16_t* __restrict__ At, const bf16_t* __restrict__ WF, const float* __restrict__ qg, const float* __restrict__ kg, const bf16_t* __restrict__ SWF, const float* __restrict__ sgu_b,
                    const InProjOut& O, char* lds, int tile, int tid) {
    tid = opaque_v(tid); tile = opaque_s(tile);
    const int lane = tid & 63, w = __builtin_amdgcn_readfirstlane(tid >> 6);
    f32x16 acc[4][2];
    {
        const int nbt0 = w * 2;
        kloop<1>(acc, At, WF + (size_t)nbt0 * 32768, WF + (size_t)(nbt0 + 1) * 32768, lds, tid, lane);
        epi_qk(acc, qg, 0.125f, O.QF + (size_t)(tile * 8 + w) * 8192, lane);
    }
    {
        const int nbt0 = 16 + w * 2;
        if (w == 2 || w == 3) {
            kloop<0>(acc, At, WF + (size_t)nbt0 * 32768, WF + (size_t)(nbt0 + 1) * 32768, lds, tid, lane);
            epi_v(acc, O.VF + (size_t)(tile * 2 + (w - 2)) * 8192, lane);
        } else {
            kloop<1>(acc, At, WF + (size_t)nbt0 * 32768, WF + (size_t)(nbt0 + 1) * 32768, lds, tid, lane);
            if (w < 2) epi_qk(acc, kg, 1.f, O.KF2 + (size_t)(tile * 2 + w) * 8192, lane);
            else epi_row(acc, O.CBR + (size_t)tile * 128 * 256 + (w - 4) * 64, 256, lane);
        }
    }
    {
        const int nbt0 = 32 + w * 2;
        kloop<1>(acc, At, WF + (size_t)nbt0 * 32768, WF + (size_t)(nbt0 + 1) * 32768, lds, tid, lane);
        epi_z(acc, O.ZR + (size_t)tile * 128 * 256 + w * 32, lane);
    }
    {
        const int nbt0 = 48 + w * 2;
        kloop<0>(acc, At, WF + (size_t)nbt0 * 32768, WF + (size_t)(nbt0 + 1) * 32768, lds, tid, lane);
        unsigned* lds_su = (unsigned*)lds;
        if (w < 4) epi_su_park(acc, lds_su + w * 4096, lane);
        __syncthreads();
        if (w >= 4) epi_sv(acc, SWF + (size_t)(w - 4) * 16384, sgu_b + (w - 4) * 128, lds_su + (w - 4) * 4096, O.YS + (size_t)tile * 128 * 256 + (w - 4) * 64, lane);
        __syncthreads();
    }
}


struct Params {
    const float *x, *c, *rel_bias, *w_ada, *b_ada, *norm1_g, *norm2_g, *w_in, *q_norm_g, *k_norm_g, *attn_sink, *conv_w, *sgu_w, *sgu_b, *out_norm_g, *w_out, *peer_wq, *peer_sub_keys, *peer_down, *peer_up;
    float* out;
    char* ws;
};
constexpr size_t MiB = 1u << 20;
constexpr size_t WS_MOD = 0;
constexpr size_t WS_MODP = 1 * MiB;
constexpr size_t WS_WIN = 13 * MiB;
constexpr size_t WS_WOUT = 29 * MiB;
constexpr size_t WS_WPQ = 37 * MiB;
constexpr size_t WS_KEYS = 53 * MiB;
constexpr size_t WS_SWF = 55 * MiB;
constexpr size_t WS_SC = 56 * MiB;
constexpr size_t WS_TB = 57 * MiB;
constexpr size_t WS_HA = 185 * MiB;
constexpr size_t WS_QF = 249 * MiB;
constexpr size_t WS_KF2 = 281 * MiB;
constexpr size_t WS_VF = 297 * MiB;
constexpr size_t WS_ZR = 313 * MiB;
constexpr size_t WS_CBR = 345 * MiB;
constexpr size_t WS_YS = 361 * MiB;
constexpr size_t WS_OR = 377 * MiB;
constexpr size_t WS_QPF = 409 * MiB;
constexpr size_t WS_RIDX = 537 * MiB;
constexpr size_t WS_RGATE = 553 * MiB;
constexpr size_t WS_SEID = 569 * MiB;
constexpr size_t WS_SWGT = 585 * MiB;
constexpr size_t WS_OFFS = 601 * MiB;
constexpr size_t WS_END = 602 * MiB;
static_assert(PL_END <= LDS_RSTD1, "expert-phase lists overlap persistent LDS state");

__global__ __launch_bounds__(512) void hybrid_fwd(Params P) {
    extern __shared__ __attribute__((aligned(16))) char lds[];
    cg::grid_group grid = cg::this_grid();
    const int tid = threadIdx.x, lane = tid & 63, w = __builtin_amdgcn_readfirstlane(tid >> 6);
    const int nblk = gridDim.x, bid = blockIdx.x;
    char* ws = P.ws;
    float* mod = (float*)(ws + WS_MOD);
    float* modp = (float*)(ws + WS_MODP);
    bf16_t* WinF = (bf16_t*)(ws + WS_WIN); bf16_t* WoutF = (bf16_t*)(ws + WS_WOUT); bf16_t* WpqF = (bf16_t*)(ws + WS_WPQ);
    bf16_t* KeysF = (bf16_t*)(ws + WS_KEYS); bf16_t* SWF = (bf16_t*)(ws + WS_SWF);
    float* SC = (float*)(ws + WS_SC); unsigned char* TBd = (unsigned char*)(ws + WS_TB); unsigned char* TBu = TBd + 32 * MiB;
    bf16_t* hA = (bf16_t*)(ws + WS_HA);
    bf16_t* OR = (bf16_t*)(ws + WS_OR); bf16_t* QPF = (bf16_t*)(ws + WS_QPF);
    int* ridx = (int*)(ws + WS_RIDX); float* rgate = (float*)(ws + WS_RGATE);
    float* bias_lds = (float*)(lds + LDS_BIAS);

    {
        float* ca = (float*)lds;
        for (int i = tid; i < 8192; i += 512) { const float v = P.c[i]; ca[i] = v / (1.f + __expf(-v)); }
        for (int i = tid; i < 1024; i += 512) bias_lds[i] = P.rel_bias[t5_bucket(i & 127) * 8 + (i >> 7)];
        __syncthreads();
        for (int it = bid; it < 768; it += nblk) {
            const int jc = it % 12, l = (it / 12) & 3, ks = it / 48;
            const int j = jc * 512 + tid;
            const float* wp = P.w_ada + ((size_t)l * 1024 + ks * 64) * 6144 + j;
            float acc[8];
#pragma unroll
            for (int b = 0; b < 8; ++b) acc[b] = 0.f;
#pragma unroll 4
            for (int i = 0; i < 64; ++i) {
                const float wv = wp[(size_t)i * 6144];
#pragma unroll
                for (int b = 0; b < 8; ++b) acc[b] += ca[b * 1024 + ks * 64 + i] * wv;
            }
#pragma unroll
            for (int b = 0; b < 8; ++b) modp[((size_t)(ks * 4 + l) * 8 + b) * 6144 + j] = acc[b];
        }
        const int gthreads = nblk * 512, gtid = bid * 512 + tid;
        for (int rep = 0; rep < REP_P0; ++rep)
        for (int l = 0; l < DEPTH; ++l) {
            for (int g = gtid; g < 64 * 64 * 64; g += gthreads) conv_wfrag_item(P.w_in + (size_t)l * 1024 * 2048, 2048, 64, WinF + (size_t)l * 2097152, g, 1);
            for (int g = gtid; g < 32 * 64 * 64; g += gthreads) conv_wfrag_item(P.w_out + (size_t)l * 1024 * 1024, 1024, 64, WoutF + (size_t)l * 1048576, g, 0);
            for (int g = gtid; g < 64 * 64 * 64; g += gthreads) conv_wfrag_item(P.peer_wq + (size_t)l * 1024 * 2048, 2048, 64, WpqF + (size_t)l * 2097152, g, 0);
            for (int g = gtid; g < 32768; g += gthreads) conv_keys_item(P.peer_sub_keys + (size_t)l * 262144, KeysF + (size_t)l * 262144, g);
            for (int g = gtid; g < 8192; g += gthreads) conv_sguw_item(P.sgu_w + (size_t)l * 65536, SWF + (size_t)l * 65536, g);
        }
        const int gwaves = nblk * 8, gw = bid * 8 + w;
        for (int rep = 0; rep < REP_P0; ++rep)
        for (int r = gw; r < DEPTH * 16384 * 2; r += gwaves) {
            const int which = r & 1, le = r >> 1;
            conv_table_row((which ? P.peer_up : P.peer_down) + (size_t)le * D, (which ? TBu : TBd) + (size_t)le * 512, SC + (size_t)le * 2 + which, lane);
        }
    }
    grid.sync();
    for (int tile = bid; tile < NTILE; tile += nblk) {
        const int b = tile >> 5;
        for (int l = 0; l < DEPTH; ++l)
            for (int j = tid; j < 6144; j += 512) {
                float v = P.b_ada[l * 6144 + j];
#pragma unroll
                for (int ks = 0; ks < 16; ++ks) v += modp[((size_t)(ks * 4 + l) * 8 + b) * 6144 + j];
                mod[((size_t)l * 8 + b) * 6144 + j] = v;
            }
    }
    __syncthreads();

    for (int l = 0; l < DEPTH; ++l) {
        const float* xin = l == 0 ? P.x : P.out;
        InProjOut IO;
        IO.QF = (bf16_t*)(ws + WS_QF); IO.KF2 = (bf16_t*)(ws + WS_KF2 + (size_t)(l & 1) * 8 * MiB); IO.VF = (bf16_t*)(ws + WS_VF + (size_t)(l & 1) * 8 * MiB);
        IO.CBR = (bf16_t*)(ws + WS_CBR); IO.ZR = (bf16_t*)(ws + WS_ZR + (size_t)(l & 1) * 16 * MiB); IO.YS = (bf16_t*)(ws + WS_YS);
        for (int tile = bid; tile < NTILE; tile += nblk) {
            const float* mb_ = mod + ((size_t)l * 8 + (tile >> 5)) * 6144;
            const bool have1 = l > 0 && nblk == NTILE;
            if (have1) { if (tid < 128) ((float*)lds)[tid] = ((const float*)(lds + LDS_RSTD1))[tid]; __syncthreads(); }
            norm_to_frag(xin, P.norm1_g + l * D, mb_ + 0, mb_ + 1024, hA, (float*)lds, tile, tid, have1);
            __syncthreads();
            for (int rep = 0; rep < REP_GEMM; ++rep) inproj_tile(hA + (size_t)tile * 131072, WinF + (size_t)l * 2097152, P.q_norm_g + l * 64, P.k_norm_g + l * 64, SWF + (size_t)l * 65536, P.sgu_b + l * 512, IO, lds, tile, tid);
        }
        grid.sync();
        for (int tile = bid; tile < NTILE; tile += nblk) {
            const float* mb_ = mod + ((size_t)l * 8 + (tile >> 5)) * 6144;
            for (int rep = 0; rep < REP_MIX; ++rep) {
            attn_tile(IO.QF, IO.KF2, IO.VF, bias_lds, P.attn_sink + l * 8, OR, tile, tid);
            __syncthreads();
            merge_tile(OR, IO.CBR, IO.ZR, IO.YS, P.conv_w + l * 768, P.out_norm_g + l * D, hA, tile, tid);
            __syncthreads();
            }
            {
                const bf16_t* At = hA + (size_t)tile * 131072;
                const bf16_t* WF = WoutF + (size_t)l * 1048576;
                for (int pass = 0; pass < 2; ++pass) {
                    f32x16 acc[4][2];
                    const int nbt0 = pass * 16 + w * 2;
                    kloop<0>(acc, At, WF + (size_t)nbt0 * 32768, WF + (size_t)(nbt0 + 1) * 32768, lds, tid, lane);
                    epi_resid(acc, xin, P.out, mb_ + 2048, (float*)(lds + LDS_EPI) + w * 2176, (float*)(lds + LDS_SSQ) + (pass * 8 + w) * 128, tile, pass * 512 + w * 64, lane);
                }
            }
            __syncthreads();
            if (tid < 128) { const float* sq = (const float*)(lds + LDS_SSQ); float ssum = 0.f;
#pragma unroll
                for (int c = 0; c < 16; ++c) ssum += sq[c * 128 + tid];
                ((float*)lds)[tid] = rsqrtf(ssum * (1.f / D) + EPS); }
            __syncthreads();
            norm_to_frag(P.out, P.norm2_g + l * D, mb_ + 3072, mb_ + 4096, hA, (float*)lds, tile, tid, true);
            __syncthreads();
            {
                const bf16_t* At = hA + (size_t)tile * 131072;
                const bf16_t* WF = WpqF + (size_t)l * 2097152;
                for (int rep = 0; rep < REP_GEMM; ++rep)
                for (int pass = 0; pass < 4; ++pass) {
                    f32x16 acc[4][2];
                    const int nbt0 = pass * 16 + w * 2;
                    kloop<1>(acc, At, WF + (size_t)nbt0 * 32768, WF + (size_t)(nbt0 + 1) * 32768, lds, tid, lane);
                    epi_qpf(acc, QPF, tile, nbt0, lane);
                }
            }
            __syncthreads();
            for (int rep = 0; rep < REP_ROUTE; ++rep) { route_tile(QPF, KeysF + (size_t)l * 262144, ridx, rgate, (unsigned char*)lds, tile, tid); __syncthreads(); }
            for (int i = 0; i < 16; ++i) sort_token(ridx, rgate, lds, tile * 128 + w * 16 + i, w * 16 + i, w, lane);
            __syncthreads();
            peer_down_wave(hA, lds, TBd + (size_t)l * 16384 * 512, SC + (size_t)l * 32768, tile, w, lane, bid & 7);
            __syncthreads();
            peer_up_wave(lds, TBu + (size_t)l * 16384 * 512, mb_ + 5120, P.out, tile, w, lane, bid & 7);
            __syncthreads();
        }
    }
}
}

extern "C" void kernel_launch(void* const* d_in, const int* in_sizes, int n_in, void* d_out, int out_size, void* d_ws, size_t ws_size, hipStream_t stream) {
    using namespace op;
    static int grid_blocks = 0;
    if (!grid_blocks) {
        int dev = 0, cus = 0, per_cu = 0;
        (void)hipGetDevice(&dev);
        (void)hipDeviceGetAttribute(&cus, hipDeviceAttributeMultiprocessorCount, dev);
        (void)hipFuncSetAttribute((const void*)hybrid_fwd, hipFuncAttributeMaxDynamicSharedMemorySize, LDS_BYTES);
        (void)hipOccupancyMaxActiveBlocksPerMultiprocessor(&per_cu, (const void*)hybrid_fwd, 512, LDS_BYTES);
        if (per_cu < 1) per_cu = 1;
        grid_blocks = cus * per_cu;
        if (grid_blocks > NTILE) grid_blocks = NTILE;
        if (ws_size < WS_END) { fprintf(stderr, "kernel_launch: workspace too small (%zu < %zu)\n", ws_size, (size_t)WS_END); grid_blocks = -1; }
    }
    if (grid_blocks < 0) return;
    Params p{};
    p.x = (const float*)d_in[0]; p.c = (const float*)d_in[1]; p.rel_bias = (const float*)d_in[2]; p.w_ada = (const float*)d_in[3]; p.b_ada = (const float*)d_in[4];
    p.norm1_g = (const float*)d_in[5]; p.norm2_g = (const float*)d_in[6]; p.w_in = (const float*)d_in[7]; p.q_norm_g = (const float*)d_in[8]; p.k_norm_g = (const float*)d_in[9];
    p.attn_sink = (const float*)d_in[10]; p.conv_w = (const float*)d_in[11]; p.sgu_w = (const float*)d_in[12]; p.sgu_b = (const float*)d_in[13]; p.out_norm_g = (const float*)d_in[14];
    p.w_out = (const float*)d_in[15]; p.peer_wq = (const float*)d_in[16]; p.peer_sub_keys = (const float*)d_in[17]; p.peer_down = (const float*)d_in[18]; p.peer_up = (const float*)d_in[19];
    p.out = (float*)d_out; p.ws = (char*)d_ws;
    void* args[] = {&p};
    hipError_t e = hipLaunchCooperativeKernel((const void*)hybrid_fwd, dim3(grid_blocks), dim3(512), args, LDS_BYTES, stream);
    if (e != hipSuccess) fprintf(stderr, "kernel_launch: cooperative launch failed: %s (grid %d)\n", hipGetErrorString(e), grid_blocks);
}
```

```cpp
#include <hip/hip_runtime.h>
#include <cstdio>
#include <cstdint>
#include <hip/hip_cooperative_groups.h>
namespace cg = cooperative_groups;


namespace op {
#define DI __device__ __forceinline__
typedef unsigned short bf16_t;
typedef short bf16x8 __attribute__((ext_vector_type(8)));
typedef float f32x16 __attribute__((ext_vector_type(16)));
typedef float f32x2 __attribute__((ext_vector_type(2)));
typedef unsigned u32x4 __attribute__((ext_vector_type(4)));
typedef unsigned u32x2 __attribute__((ext_vector_type(2)));
typedef __bf16 bf16v2 __attribute__((ext_vector_type(2)));
constexpr int D = 1024, NB = 8, S = 4096, DEPTH = 4, T = NB * S, NTILE = T / 128;
constexpr float EPS = 1e-6f;
constexpr int LDS_EPI = 32768, LDS_SSQ = 102400, LDS_RSTD1 = 110592, LDS_BIAS = 112 * 1024, LDS_BYTES = 116 * 1024;
constexpr int REP_GEMM = 1, REP_ROUTE = 1, REP_MIX = 1, REP_NORM = 1, REP_P0 = 1;
#define MFMA32(a, b, c) __builtin_amdgcn_mfma_f32_32x32x16_bf16((a), (b), (c), 0, 0, 0)

DI unsigned pk2(float lo, float hi) { f32x2 v = {lo, hi}; return __builtin_bit_cast(unsigned, __builtin_convertvector(v, bf16v2)); }
DI int opaque_v(int x) { asm volatile("" : "+v"(x)); return x; }
DI int opaque_s(int x) { asm volatile("" : "+s"(x)); return x; }
DI int crow(int reg, int hh) { return (reg & 3) + 8 * (reg >> 2) + 4 * hh; }
DI float wave_sum(float v) {
#pragma unroll
    for (int o = 1; o < 64; o <<= 1) v += __shfl_xor(v, o);
    return v;
}

DI int col_perm(int npos, int mode) {
    if (mode == 1 && npos >= 1024 && npos < 1536) { const int q = npos - 1024, w = q >> 6, nb = (q >> 5) & 1, r = q & 31; return (nb ? 1280 : 1024) + 32 * w + r; }
    return npos;
}
DI void conv_wfrag_item(const float* __restrict__ W, int N, int KB, bf16_t* __restrict__ WF, int gid, int mode) {
    const int l = gid & 63, kb = (gid >> 6) % KB, nbt = (gid >> 6) / KB, r = l & 31, hh = l >> 5;
    const int n = col_perm(nbt * 32 + r, mode);
    const float* p = W + (size_t)(kb * 16 + 8 * hh) * N + n;
    float v[8];
#pragma unroll
    for (int j = 0; j < 8; ++j) v[j] = p[(size_t)j * N];
    u32x4 o; o.x = pk2(v[0], v[1]); o.y = pk2(v[2], v[3]); o.z = pk2(v[4], v[5]); o.w = pk2(v[6], v[7]);
    *(u32x4*)(WF + (size_t)gid * 8) = o;
}

DI void norm_to_frag(const float* __restrict__ x, const float* __restrict__ g, const float* __restrict__ sh, const float* __restrict__ sc, bf16_t* __restrict__ hA, float* rstd_lds, int tile, int tid, bool have_rstd) {
    tid = opaque_v(tid); tile = opaque_s(tile);
    const int w = tid >> 6, lane = tid & 63;
    if (!have_rstd)
    for (int rr = 0; rr < 16; ++rr) {
        const int row = w * 16 + rr;
        const float4* xr = (const float4*)(x + ((size_t)tile * 128 + row) * D);
        float ss = 0.f;
#pragma unroll
        for (int j = 0; j < 4; ++j) { const float4 v = xr[lane + 64 * j]; ss += v.x * v.x + v.y * v.y + v.z * v.z + v.w * v.w; }
        ss = wave_sum(ss);
        if (lane == 0) rstd_lds[row] = rsqrtf(ss * (1.f / D) + EPS);
    }
    __syncthreads();
    const int r5 = lane & 31, hh = lane >> 5;
    for (int it = w; it < 256; it += 8) {
        const int kb = it >> 2, mb = it & 3, row = mb * 32 + r5, k0 = kb * 16 + 8 * hh;
        const float4* xr = (const float4*)(x + ((size_t)tile * 128 + row) * D + k0);
        const float4 a = xr[0], b = xr[1];
        const float4 g0 = *(const float4*)(g + k0), g1 = *(const float4*)(g + k0 + 4);
        const float4 s0 = *(const float4*)(sc + k0), s1 = *(const float4*)(sc + k0 + 4);
        const float4 h0 = *(const float4*)(sh + k0), h1 = *(const float4*)(sh + k0 + 4);
        const float r = rstd_lds[row];
        u32x4 o;
        o.x = pk2(a.x * r * g0.x * (1.f + s0.x) + h0.x, a.y * r * g0.y * (1.f + s0.y) + h0.y);
        o.y = pk2(a.z * r * g0.z * (1.f + s0.z) + h0.z, a.w * r * g0.w * (1.f + s0.w) + h0.w);
        o.z = pk2(b.x * r * g1.x * (1.f + s1.x) + h1.x, b.y * r * g1.y * (1.f + s1.y) + h1.y);
        o.w = pk2(b.z * r * g1.z * (1.f + s1.z) + h1.z, b.w * r * g1.w * (1.f + s1.w) + h1.w);
        *(u32x4*)(hA + ((size_t)tile * 256 + it) * 512 + lane * 8) = o;
    }
}

template <int ORIENT>
DI void kloop(f32x16 (&acc)[4][2], const bf16_t* __restrict__ At, const bf16_t* __restrict__ W0, const bf16_t* __restrict__ W1, char* lds, int tid, int lane) {
    tid = opaque_v(tid); lane = opaque_v(lane);
#pragma unroll
    for (int mb = 0; mb < 4; ++mb)
#pragma unroll
        for (int nb = 0; nb < 2; ++nb)
#pragma unroll
            for (int i = 0; i < 16; ++i) acc[mb][nb][i] = 0.f;
    {
    const u32x4* Ag = (const u32x4*)At + tid;
    const u32x4* W0g = (const u32x4*)W0 + lane;
    const u32x4* W1g = (const u32x4*)W1 + lane;
    u32x4 wq[4][2], arA[2], arB[2];
    arA[0] = Ag[0]; arA[1] = Ag[512]; arB[0] = Ag[1024]; arB[1] = Ag[1024 + 512];
#pragma unroll
    for (int kk = 0; kk < 4; ++kk) { wq[kk][0] = W0g[kk * 64]; wq[kk][1] = W1g[kk * 64]; }
    *(u32x4*)(lds + tid * 16) = arA[0]; *(u32x4*)(lds + 8192 + tid * 16) = arA[1];
    __syncthreads();
#define KL_ITER(KC, ARL, ARS) do { \
        char* cur = lds + ((KC) & 1) * 16384; \
        char* nxt = lds + (((KC) + 1) & 1) * 16384; \
        const int kn = (KC) < 15 ? (KC) + 1 : 15, k2 = (KC) < 14 ? (KC) + 2 : 15; \
        ARL[0] = Ag[k2 * 1024]; ARL[1] = Ag[k2 * 1024 + 512]; \
        __builtin_amdgcn_sched_barrier(0); \
        _Pragma("unroll") for (int kk = 0; kk < 4; ++kk) { \
            bf16x8 afr[4]; \
            _Pragma("unroll") for (int mb = 0; mb < 4; ++mb) afr[mb] = *(const bf16x8*)(cur + ((kk * 4 + mb) * 64 + lane) * 16); \
            _Pragma("unroll") for (int mb = 0; mb < 4; ++mb) \
                _Pragma("unroll") for (int nb = 0; nb < 2; ++nb) { \
                    const bf16x8 wf = __builtin_bit_cast(bf16x8, wq[kk][nb]); \
                    if (ORIENT == 0) acc[mb][nb] = MFMA32(afr[mb], wf, acc[mb][nb]); \
                    else acc[mb][nb] = MFMA32(wf, afr[mb], acc[mb][nb]); \
                } \
            wq[kk][0] = W0g[(kn * 4 + kk) * 64]; wq[kk][1] = W1g[(kn * 4 + kk) * 64]; \
            __builtin_amdgcn_sched_barrier(0); \
        } \
        if ((KC) < 15) { *(u32x4*)(nxt + tid * 16) = ARS[0]; *(u32x4*)(nxt + 8192 + tid * 16) = ARS[1]; } \
        __syncthreads(); \
    } while (0)
    for (int kc = 0; kc < 16; kc += 2) { KL_ITER(kc, arA, arB); KL_ITER(kc + 1, arB, arA); }
#undef KL_ITER
    }
}

DI void epi_f32row(const f32x16 (&acc)[4][2], float* __restrict__ C, int tile, int col0, int lane) {
    lane = opaque_v(lane);
    const int r5 = lane & 31, hh = lane >> 5;
    const unsigned boff = (unsigned)((tile * 128 + 4 * hh) * 2048 + col0 + r5);
#pragma unroll
    for (int mb = 0; mb < 4; ++mb)
#pragma unroll
        for (int nb = 0; nb < 2; ++nb)
#pragma unroll
            for (int i = 0; i < 16; ++i)
                C[boff + (unsigned)((mb * 32 + (i & 3) + 8 * (i >> 2)) * 2048 + nb * 32)] = acc[mb][nb][i];
}
DI void epi_resid(const f32x16 (&acc)[4][2], const float* __restrict__ xin, float* __restrict__ xout, const float* __restrict__ gate_b, float* T  , float* ssq  , int tile, int col0, int lane) {
    lane = opaque_v(lane);
    const int r5 = lane & 31, hh = lane >> 5, rq = lane >> 4, c4 = (lane & 15) * 4;
    const float4 gv = *(const float4*)(gate_b + col0 + c4);
#pragma unroll
    for (int mb = 0; mb < 4; ++mb) {
#pragma unroll
        for (int nb = 0; nb < 2; ++nb)
#pragma unroll
            for (int i = 0; i < 16; ++i) T[((i & 3) + 8 * (i >> 2) + 4 * hh) * 68 + nb * 32 + r5] = acc[mb][nb][i];
        asm volatile("s_waitcnt lgkmcnt(0)" ::: "memory");
#pragma unroll
        for (int j = 0; j < 8; ++j) {
            const int row = rq + 4 * j;
            const float4 v = *(const float4*)(T + row * 68 + c4);
            const unsigned o = (unsigned)((tile * 128 + mb * 32 + row) * D + col0 + c4);
            float4 xv = *(const float4*)(xin + o);
            xv.x += gv.x * v.x; xv.y += gv.y * v.y; xv.z += gv.z * v.z; xv.w += gv.w * v.w;
            *(float4*)(xout + o) = xv;
            float ss = xv.x * xv.x + xv.y * xv.y + xv.z * xv.z + xv.w * xv.w;
            ss += __shfl_xor(ss, 1); ss += __shfl_xor(ss, 2); ss += __shfl_xor(ss, 4); ss += __shfl_xor(ss, 8);
            if ((lane & 15) == 0) ssq[mb * 32 + row] = ss;
        }
        asm volatile("s_waitcnt lgkmcnt(0)" ::: "memory");
    }
}

DI void epi_qpf(const f32x16 (&acc)[4][2], bf16_t* __restrict__ QPF, int tile, int ft0, int lane) {
    lane = opaque_v(lane);
#pragma unroll
    for (int nb = 0; nb < 2; ++nb)
#pragma unroll
        for (int s = 0; s < 2; ++s)
#pragma unroll
            for (int mb = 0; mb < 4; ++mb) {
                const f32x16& a = acc[mb][nb];
                u32x4 o; o.x = pk2(a[8 * s], a[8 * s + 1]); o.y = pk2(a[8 * s + 2], a[8 * s + 3]); o.z = pk2(a[8 * s + 4], a[8 * s + 5]); o.w = pk2(a[8 * s + 6], a[8 * s + 7]);
                *(u32x4*)(QPF + ((unsigned)((((tile * 64 + ft0 + nb) * 2 + s) * 4 + mb) * 64 + lane)) * 8) = o;
            }
}

DI void conv_keys_item(const float* __restrict__ K, bf16_t* __restrict__ KF, int gid) {
    const int lane = gid & 63, s = (gid >> 6) & 1, nbl = (gid >> 7) & 3, nt = (gid >> 9) & 3, hp = gid >> 11;
    const int r = lane & 31, hh = lane >> 5;
    const float* p = K + ((size_t)hp * 128 + nt * 32 + r) * 128 + nbl * 32 + 16 * s + 4 * hh;
    const float4 a = *(const float4*)p, b = *(const float4*)(p + 8);
    u32x4 o; o.x = pk2(a.x, a.y); o.y = pk2(a.z, a.w); o.z = pk2(b.x, b.y); o.w = pk2(b.z, b.w);
    *(u32x4*)(KF + (size_t)gid * 8) = o;
}

DI void conv_table_row(const float* __restrict__ src, unsigned char* __restrict__ dst, float* __restrict__ sc, int lane, bool as_int4) {
    const float4* p = (const float4*)src + lane * 4;
    float4 v[4];
    float m = 0.f;
#pragma unroll
    for (int j = 0; j < 4; ++j) { v[j] = p[j]; m = fmaxf(m, fmaxf(fmaxf(fabsf(v[j].x), fabsf(v[j].y)), fmaxf(fabsf(v[j].z), fabsf(v[j].w)))); }
#pragma unroll
    for (int o = 1; o < 64; o <<= 1) m = fmaxf(m, __shfl_xor(m, o));
    float scale = m > 0.f ? m * (1.f / 6.f) : 1.f;
    if (as_int4) {
        float ss = 0.f;
#pragma unroll
        for (int j = 0; j < 4; ++j) ss += v[j].x * v[j].x + v[j].y * v[j].y + v[j].z * v[j].z + v[j].w * v[j].w;
        ss = wave_sum(ss);
        const float sg = sqrtf(ss * (1.f / 1024.f));
        scale = fmaxf(sg * (1.f / 2.8f), m * (1.f / 16.f));
        if (!(scale > 0.f)) scale = 1.f;
    }
    const float inv = 1.f / scale;
    u32x2 o;
    unsigned* op = (unsigned*)&o;
#pragma unroll
    for (int j = 0; j < 2; ++j) {
        const float f[8] = {v[2 * j].x, v[2 * j].y, v[2 * j].z, v[2 * j].w, v[2 * j + 1].x, v[2 * j + 1].y, v[2 * j + 1].z, v[2 * j + 1].w};
        unsigned wv = 0;
        if (as_int4) {
#pragma unroll
            for (int e = 0; e < 8; ++e) { int q = __float2int_rn(f[e] * inv); q = q < -7 ? -7 : (q > 7 ? 7 : q); wv |= ((unsigned)q & 15u) << (4 * e); }
        } else {
            wv = __builtin_amdgcn_cvt_scalef32_pk_fp4_f32(wv, f[0] * inv, f[1] * inv, 1.0f, 0);
            wv = __builtin_amdgcn_cvt_scalef32_pk_fp4_f32(wv, f[2] * inv, f[3] * inv, 1.0f, 1);
            wv = __builtin_amdgcn_cvt_scalef32_pk_fp4_f32(wv, f[4] * inv, f[5] * inv, 1.0f, 2);
            wv = __builtin_amdgcn_cvt_scalef32_pk_fp4_f32(wv, f[6] * inv, f[7] * inv, 1.0f, 3);
        }
        op[j] = wv;
    }
    *(u32x2*)(dst + lane * 8) = o;
    if (lane == 0) *sc = scale;
}

DI void ce_desc(int& a, int& b) { const int mx = a > b ? a : b, mn = a > b ? b : a; a = mx; b = mn; }
DI void sort16_desc(int (&v)[16]) {
#pragma unroll
    for (int k = 2; k <= 16; k <<= 1)
#pragma unroll
        for (int j = k >> 1; j > 0; j >>= 1)
#pragma unroll
            for (int i = 0; i < 16; ++i) {
                const int l = i ^ j;
                if (l > i) { if ((i & k) == 0) ce_desc(v[i], v[l]); else ce_desc(v[l], v[i]); }
            }
}
DI void bitonic_merge16_desc(int (&v)[16]) {
#pragma unroll
    for (int j = 8; j > 0; j >>= 1)
#pragma unroll
        for (int i = 0; i < 16; ++i) { const int l = i ^ j; if (l > i) ce_desc(v[i], v[l]); }
}
DI void merge_top16(int (&a)[16], const int (&b)[16]) {
#pragma unroll
    for (int i = 0; i < 16; ++i) a[i] = a[i] > b[15 - i] ? a[i] : b[15 - i];
    bitonic_merge16_desc(a);
}
DI int f2ord(float f) { int b = __float_as_int(f); return b ^ ((b >> 31) & 0x7fffffff); }
DI float ord2f(int k) { return __int_as_float(k ^ ((k >> 31) & 0x7fffffff)); }

DI void route_tile(const bf16_t* __restrict__ QPF, const bf16_t* __restrict__ KF, int* __restrict__ ridx, float* __restrict__ rgate, unsigned char* lds_idx  , int tile, int tid) {
    tid = opaque_v(tid); tile = opaque_s(tile);
    const int lane = tid & 63, w = __builtin_amdgcn_readfirstlane(tid >> 6);
    const int r5 = lane & 31, hh = lane >> 5;
    unsigned char* myidx = lds_idx + w * 1024;
    for (int task = w; task < 32; task += 8) {
        const int h = task >> 2, tt = task & 3;
        f32x16 acc[2][4];
#pragma unroll
        for (int p = 0; p < 2; ++p)
#pragma unroll
            for (int nt = 0; nt < 4; ++nt)
#pragma unroll
                for (int i = 0; i < 16; ++i) acc[p][nt][i] = 0.f;
        {
            bf16x8 bq[2], ak[2][4];
#define ROUTE_LOAD(buf, step) do { const int p_ = (step) >> 3, ks_ = (step) & 7; \
                bq[buf] = *(const bf16x8*)(QPF + ((unsigned)((((tile * 64 + h * 8 + p_ * 4 + (ks_ >> 1)) * 2 + (ks_ & 1)) * 4 + tt) * 64 + lane)) * 8); \
                _Pragma("unroll") for (int nt = 0; nt < 4; ++nt) ak[buf][nt] = *(const bf16x8*)(KF + ((unsigned)(((((h * 2 + p_) * 4 + nt) * 8 + ks_) * 64) + lane)) * 8); } while (0)
            ROUTE_LOAD(0, 0);
#pragma unroll
            for (int step = 0; step < 16; ++step) {
                if (step < 15) ROUTE_LOAD((step + 1) & 1, step + 1);
#pragma unroll
                for (int nt = 0; nt < 4; ++nt) acc[step >> 3][nt] = MFMA32(ak[step & 1][nt], bq[step & 1], acc[step >> 3][nt]);
                __builtin_amdgcn_sched_barrier(0);
            }
#undef ROUTE_LOAD
        }
        int g[8][16];
#pragma unroll
        for (int nt = 0; nt < 4; ++nt)
#pragma unroll
            for (int i = 0; i < 16; ++i) {
                const unsigned a = __float_as_uint(acc[0][nt][i]), b = __float_as_uint(acc[1][nt][i]);
                auto sw = __builtin_amdgcn_permlane32_swap(a, b, false, false);
                const int n0 = nt * 32 + (i & 3) + 8 * (i >> 2);
                g[nt * 2 + (i >> 3)][i & 7] = (f2ord(__uint_as_float(sw[0])) & ~127) | n0;
                g[nt * 2 + (i >> 3)][8 + (i & 7)] = (f2ord(__uint_as_float(sw[1])) & ~127) | (n0 + 4);
            }
#pragma unroll
        for (int q = 0; q < 8; ++q) sort16_desc(g[q]);
        merge_top16(g[0], g[1]); merge_top16(g[2], g[3]); merge_top16(g[4], g[5]); merge_top16(g[6], g[7]);
        merge_top16(g[0], g[2]); merge_top16(g[4], g[6]);
        merge_top16(g[0], g[4]);
        {
            u32x4 pk;
            unsigned* pp = (unsigned*)&pk;
#pragma unroll
            for (int q = 0; q < 4; ++q) pp[q] = (unsigned)(g[0][4 * q] & 127) | ((unsigned)(g[0][4 * q + 1] & 127) << 8) | ((unsigned)(g[0][4 * q + 2] & 127) << 16) | ((unsigned)(g[0][4 * q + 3] & 127) << 24);
            *(u32x4*)(myidx + lane * 16) = pk;
        }
        float f0[16], f1[16];
#pragma unroll
        for (int i = 0; i < 16; ++i) {
            const unsigned a = (unsigned)g[0][i], b = a;
            auto sw = __builtin_amdgcn_permlane32_swap(a, b, false, false);
            f0[i] = ord2f((int)sw[0] & ~127); f1[i] = ord2f((int)sw[1] & ~127);
        }
        int c0[16], c1[16], c2[16], c3[16];
#pragma unroll
        for (int j = 0; j < 16; ++j) c0[j] = (f2ord(f0[0] + f1[j]) & ~255) | j;
#pragma unroll
        for (int i = 1; i < 16; ++i) c1[i - 1] = (f2ord(f0[i] + f1[0]) & ~255) | (i << 4);
        c1[15] = (int)0x80000000;
#define CK(i, j) ((f2ord(f0[i] + f1[j]) & ~255) | ((i) << 4) | (j))
        c2[0] = CK(1, 1); c2[1] = CK(1, 2); c2[2] = CK(1, 3); c2[3] = CK(1, 4); c2[4] = CK(1, 5); c2[5] = CK(1, 6); c2[6] = CK(1, 7);
        c2[7] = CK(2, 1); c2[8] = CK(2, 2); c2[9] = CK(2, 3); c2[10] = CK(2, 4);
        c2[11] = CK(3, 1); c2[12] = CK(3, 2); c2[13] = CK(3, 3);
        c2[14] = CK(4, 1); c2[15] = CK(4, 2);
        c3[0] = CK(5, 1); c3[1] = CK(6, 1); c3[2] = CK(7, 1);
#undef CK
#pragma unroll
        for (int q = 3; q < 16; ++q) c3[q] = (int)0x80000000;
        sort16_desc(c2);
        ce_desc(c3[0], c3[1]); ce_desc(c3[1], c3[2]); ce_desc(c3[0], c3[1]);
        merge_top16(c0, c1); merge_top16(c2, c3); merge_top16(c0, c2);
        float bs[16], den = 0.f;
#pragma unroll
        for (int i = 0; i < 16; ++i) { bs[i] = __expf(ord2f(c0[i] & ~255) - ord2f(c0[0] & ~255)); den += bs[i]; }
        const float rden = 1.f / den;
        asm volatile("s_waitcnt lgkmcnt(0)" ::: "memory");
        const int tok = tile * 128 + tt * 32 + r5;
#pragma unroll
        for (int q = 0; q < 8; ++q) {
            const int key = (int)__builtin_amdgcn_permlane32_swap((unsigned)c0[q], (unsigned)c0[8 + q], false, false)[0];
            const float gv = __uint_as_float(__builtin_amdgcn_permlane32_swap(__float_as_uint(bs[q]), __float_as_uint(bs[8 + q]), false, false)[0]) * rden;
            const int i = (key >> 4) & 15, j = key & 15;
            const int e = (int)myidx[r5 * 16 + i] * 128 + (int)myidx[(32 + r5) * 16 + j];
            ridx[(unsigned)(tok * 128 + h * 16 + 8 * hh + q)] = e;
            rgate[(unsigned)(tok * 128 + h * 16 + 8 * hh + q)] = gv;
        }
        asm volatile("s_waitcnt lgkmcnt(0)" ::: "memory");
    }
}

DI void unpack_h2(const bf16_t* __restrict__ hA, int t, int lane, f32x2 (&hv)[8]) {
    const int tile = t >> 7, row = t & 127, mb = row >> 5, r5 = row & 31;
    const bf16_t* hp = hA + ((unsigned)(((tile * 64 + lane) * 4 + mb) * 64 + r5)) * 8;
    const u32x4 ha = *(const u32x4*)hp, hb = *(const u32x4*)(hp + 32 * 8);
    const unsigned hw[8] = {ha.x, ha.y, ha.z, ha.w, hb.x, hb.y, hb.z, hb.w};
#pragma unroll
    for (int q = 0; q < 8; ++q) { hv[q].x = __uint_as_float(hw[q] << 16); hv[q].y = __uint_as_float(hw[q] & 0xffff0000u); }
}
constexpr int PL_SEID = 0, PL_SWGT = 32768, PL_END = 98304;
typedef _Float16 h16x2 __attribute__((ext_vector_type(2)));
DI h16x2 fp4h(unsigned w, int sel) {
    return sel == 0 ? __builtin_amdgcn_cvt_scalef32_pk_f16_fp4(w, 1.0f, 0) : sel == 1 ? __builtin_amdgcn_cvt_scalef32_pk_f16_fp4(w, 1.0f, 1)
         : sel == 2 ? __builtin_amdgcn_cvt_scalef32_pk_f16_fp4(w, 1.0f, 2) : __builtin_amdgcn_cvt_scalef32_pk_f16_fp4(w, 1.0f, 3);
}
DI void stage_token(const int* __restrict__ ridx, const float* __restrict__ rgate, char* lds, int t, int tloc, int lane) {
    lane = opaque_v(lane); t = opaque_s(t);
    unsigned short* seid = (unsigned short*)(lds + PL_SEID) + tloc * 128;
    float* swgt = (float*)(lds + PL_SWGT) + tloc * 128;
    seid[lane] = (unsigned short)ridx[(unsigned)(t * 128 + lane)]; seid[64 + lane] = (unsigned short)ridx[(unsigned)(t * 128 + 64 + lane)];
    swgt[lane] = rgate[(unsigned)(t * 128 + lane)]; swgt[64 + lane] = rgate[(unsigned)(t * 128 + 64 + lane)];
}
DI void peer_down_wave(const bf16_t* __restrict__ hA, char* lds, const unsigned char* __restrict__ TBd, const float* __restrict__ SC, int tile, int w, int lane) {
    lane = opaque_v(lane);
    const int myu = ((lane >> 5) & 1) * 8 + ((lane >> 4) & 1) * 4 + ((lane >> 3) & 1) * 2 + ((lane >> 2) & 1);
#pragma unroll 1
    for (int tl = 0; tl < 16; ++tl) {
        const int tloc = w * 16 + tl, t = tile * 128 + tloc;
        const unsigned short* ip = (const unsigned short*)(lds + PL_SEID) + tloc * 128;
        float* gp = (float*)(lds + PL_SWGT) + tloc * 128;
        const int row = t & 127, mb = row >> 5, r5 = row & 31;
        const bf16_t* hp = hA + ((unsigned)(((tile * 64 + lane) * 4 + mb) * 64 + r5)) * 8;
        const u32x4 ha = *(const u32x4*)hp, hb = *(const u32x4*)(hp + 32 * 8);
        unsigned hhi[2], hlo[2];
        float hscale;
        {
            const unsigned hw[8] = {ha.x, ha.y, ha.z, ha.w, hb.x, hb.y, hb.z, hb.w};
            float hf[16];
            float m = 0.f;
#pragma unroll
            for (int q = 0; q < 8; ++q) { hf[2 * q] = __uint_as_float(hw[q] << 16); hf[2 * q + 1] = __uint_as_float(hw[q] & 0xffff0000u); m = fmaxf(m, fmaxf(fabsf(hf[2 * q]), fabsf(hf[2 * q + 1]))); }
#pragma unroll
            for (int o = 1; o < 64; o <<= 1) m = fmaxf(m, __shfl_xor(m, o));
            hscale = m > 0.f ? m * (1.f / 119.f) : 1.f;
            const float inv = 1.f / hscale;
            hhi[0] = hhi[1] = hlo[0] = hlo[1] = 0u;
#pragma unroll
            for (int e = 0; e < 16; ++e) {
                const int hq = __float2int_rn(hf[e] * inv);
                const int lo = ((hq + 8) & 15) - 8, hi = (hq - lo) >> 4;
                hlo[e >> 3] |= ((unsigned)lo & 15u) << (4 * (e & 7));
                hhi[e >> 3] |= ((unsigned)hi & 15u) << (4 * (e & 7));
            }
        }
#pragma unroll 1
        for (int c0 = 0; c0 < 128; c0 += 64) {
            const int ev = ip[c0 + lane];
#pragma unroll 1
            for (int p = 0; p < 64; p += 16) {
                u32x2 dr[16];
#pragma unroll
                for (int u = 0; u < 16; ++u) {
                    const int e = __builtin_amdgcn_readlane(ev, p + u);
                    dr[u] = *(const u32x2*)(TBd + (size_t)(unsigned)e * 512 + lane * 8);
                }
                const int me = __shfl(ev, p + myu);
                const f32x2 scv = *(const f32x2*)(SC + (unsigned)me * 2);
                int part[16];
#pragma unroll
                for (int u = 0; u < 16; ++u) {
                    int shi = __builtin_amdgcn_sdot8((int)dr[u].x, (int)hhi[0], 0, false);
                    shi = __builtin_amdgcn_sdot8((int)dr[u].y, (int)hhi[1], shi, false);
                    int slo = __builtin_amdgcn_sdot8((int)dr[u].x, (int)hlo[0], 0, false);
                    slo = __builtin_amdgcn_sdot8((int)dr[u].y, (int)hlo[1], slo, false);
                    part[u] = shi * 16 + slo;
                }
                int r8[8], r4[4], r2[2], r1;
                {
                    const bool b5 = (lane & 32) != 0, b4 = (lane & 16) != 0, b3 = (lane & 8) != 0, b2 = (lane & 4) != 0;
#pragma unroll
                    for (int q = 0; q < 8; ++q) { const int keep = b5 ? part[q + 8] : part[q], give = b5 ? part[q] : part[q + 8]; r8[q] = keep + __shfl_xor(give, 32); }
#pragma unroll
                    for (int q = 0; q < 4; ++q) { const int keep = b4 ? r8[q + 4] : r8[q], give = b4 ? r8[q] : r8[q + 4]; r4[q] = keep + __shfl_xor(give, 16); }
#pragma unroll
                    for (int q = 0; q < 2; ++q) { const int keep = b3 ? r4[q + 2] : r4[q], give = b3 ? r4[q] : r4[q + 2]; r2[q] = keep + __shfl_xor(give, 8); }
                    { const int keep = b2 ? r2[1] : r2[0], give = b2 ? r2[0] : r2[1]; r1 = keep + __shfl_xor(give, 4); }
                    r1 += __shfl_xor(r1, 2); r1 += __shfl_xor(r1, 1);
                }
                if ((lane & 3) == 0) {
                    const float a = (float)r1 * (scv.x * hscale);
                    gp[c0 + p + myu] = gp[c0 + p + myu] * (0.5f * a * (1.f + erff(a * 0.70710678118654752f))) * scv.y;
                }
            }
        }
    }
}
DI void peer_up_wave(char* lds, const unsigned char* __restrict__ TBu, const float* __restrict__ g2b, float* __restrict__ x, int tile, int w, int lane) {
    lane = opaque_v(lane);
    for (int r = 0; r < 2; ++r) {
        h16x2 acc[8][8];
#pragma unroll
        for (int k = 0; k < 8; ++k)
#pragma unroll
            for (int q = 0; q < 8; ++q) acc[k][q] = (h16x2){(_Float16)0.f, (_Float16)0.f};
#pragma unroll
        for (int k = 0; k < 8; ++k) {
            const int tloc = w * 16 + r * 8 + k;
            const unsigned short* ip = (const unsigned short*)(lds + PL_SEID) + tloc * 128;
            const float* gp = (const float*)(lds + PL_SWGT) + tloc * 128;
    #pragma unroll 1
        for (int c0 = 0; c0 < 128; c0 += 64) {
                const int ev = ip[c0 + lane];
                const float wl = gp[c0 + lane];
    #pragma unroll 1
            for (int p = 0; p < 64; p += 16) {
                    u32x2 ur[16];
#pragma unroll
                    for (int u = 0; u < 16; ++u) {
                        const int e = __builtin_amdgcn_readlane(ev, p + u);
                        ur[u] = *(const u32x2*)(TBu + (size_t)(unsigned)e * 512 + lane * 8);
                    }
#pragma unroll
                    for (int u = 0; u < 16; ++u) {
                        const _Float16 wh = (_Float16)__int_as_float(__builtin_amdgcn_readlane(__float_as_int(wl), p + u));
                        const h16x2 w2 = (h16x2){wh, wh};
#pragma unroll
                        for (int q = 0; q < 4; ++q) { acc[k][q] = __builtin_elementwise_fma(w2, fp4h(ur[u].x, q), acc[k][q]); acc[k][4 + q] = __builtin_elementwise_fma(w2, fp4h(ur[u].y, q), acc[k][4 + q]); }
                    }
                }
            }
        }
#pragma unroll
        for (int k = 0; k < 8; ++k) {
            const int t = tile * 128 + w * 16 + r * 8 + k;
            float4* xp = (float4*)(x + (size_t)t * D + lane * 16);
            const float4* gq = (const float4*)(g2b + lane * 16);
            float ssx = 0.f;
#pragma unroll
            for (int q = 0; q < 4; ++q) {
                float4 xv = xp[q]; const float4 gv = gq[q];
                xv.x += gv.x * (float)acc[k][2 * q].x; xv.y += gv.y * (float)acc[k][2 * q].y; xv.z += gv.z * (float)acc[k][2 * q + 1].x; xv.w += gv.w * (float)acc[k][2 * q + 1].y;
                xp[q] = xv;
                ssx += xv.x * xv.x + xv.y * xv.y + xv.z * xv.z + xv.w * xv.w;
            }
            ssx = wave_sum(ssx);
            if (lane == 0) ((float*)(lds + LDS_RSTD1))[w * 16 + r * 8 + k] = rsqrtf(ssx * (1.f / D) + EPS);
        }
    }
}

DI void epi_qk(f32x16 (&acc)[4][2], const float* __restrict__ gain, float scale, bf16_t* __restrict__ dst, int lane) {
    lane = opaque_v(lane);
    const int hh = lane >> 5;
    float gv[2][16];
#pragma unroll
    for (int nb = 0; nb < 2; ++nb)
#pragma unroll
        for (int i = 0; i < 16; ++i) gv[nb][i] = gain[nb * 32 + (i & 3) + 8 * (i >> 2) + 4 * hh] * scale;
#pragma unroll
    for (int mb = 0; mb < 4; ++mb) {
        float ss = 0.f;
#pragma unroll
        for (int nb = 0; nb < 2; ++nb)
#pragma unroll
            for (int i = 0; i < 16; ++i) ss += acc[mb][nb][i] * acc[mb][nb][i];
        ss += __shfl_xor(ss, 32);
        const float r = rsqrtf(ss * (1.f / 64.f) + EPS);
#pragma unroll
        for (int nb = 0; nb < 2; ++nb)
#pragma unroll
            for (int s = 0; s < 2; ++s) {
                const f32x16& a = acc[mb][nb];
                u32x4 o;
                o.x = pk2(a[8 * s] * r * gv[nb][8 * s], a[8 * s + 1] * r * gv[nb][8 * s + 1]);
                o.y = pk2(a[8 * s + 2] * r * gv[nb][8 * s + 2], a[8 * s + 3] * r * gv[nb][8 * s + 3]);
                o.z = pk2(a[8 * s + 4] * r * gv[nb][8 * s + 4], a[8 * s + 5] * r * gv[nb][8 * s + 5]);
                o.w = pk2(a[8 * s + 6] * r * gv[nb][8 * s + 6], a[8 * s + 7] * r * gv[nb][8 * s + 7]);
                *(u32x4*)(dst + ((unsigned)(((nb * 2 + s) * 4 + mb) * 64 + lane)) * 8) = o;
            }
    }
}
DI void epi_v(const f32x16 (&acc)[4][2], bf16_t* __restrict__ dst, int lane) {
    lane = opaque_v(lane);
#pragma unroll
    for (int nb = 0; nb < 2; ++nb)
#pragma unroll
        for (int mb = 0; mb < 4; ++mb)
#pragma unroll
            for (int s = 0; s < 2; ++s) {
                const f32x16& a = acc[mb][nb];
                u32x4 o; o.x = pk2(a[8 * s], a[8 * s + 1]); o.y = pk2(a[8 * s + 2], a[8 * s + 3]); o.z = pk2(a[8 * s + 4], a[8 * s + 5]); o.w = pk2(a[8 * s + 6], a[8 * s + 7]);
                *(u32x4*)(dst + ((unsigned)(((nb * 4 + mb) * 2 + s) * 64 + lane)) * 8) = o;
            }
}
DI void epi_row(const f32x16 (&acc)[4][2], bf16_t* __restrict__ dst, int ld, int lane) {
    lane = opaque_v(lane);
    const int r5 = lane & 31, hh = lane >> 5;
#pragma unroll
    for (int mb = 0; mb < 4; ++mb)
#pragma unroll
        for (int nb = 0; nb < 2; ++nb)
#pragma unroll
            for (int gq = 0; gq < 4; ++gq) {
                const f32x16& a = acc[mb][nb];
                u32x2 o; o.x = pk2(a[4 * gq], a[4 * gq + 1]); o.y = pk2(a[4 * gq + 2], a[4 * gq + 3]);
                *(u32x2*)(dst + (unsigned)((mb * 32 + r5) * ld + nb * 32 + 8 * gq + 4 * hh)) = o;
            }
}
DI void epi_z(const f32x16 (&acc)[4][2], bf16_t* __restrict__ dst, int lane) {
    lane = opaque_v(lane);
    const int r5 = lane & 31, hh = lane >> 5;
#pragma unroll
    for (int mb = 0; mb < 4; ++mb)
#pragma unroll
        for (int gq = 0; gq < 4; ++gq) {
            const f32x16 &a = acc[mb][0], &b = acc[mb][1];
            u32x2 o; o.x = pk2(a[4 * gq] * b[4 * gq], a[4 * gq + 1] * b[4 * gq + 1]); o.y = pk2(a[4 * gq + 2] * b[4 * gq + 2], a[4 * gq + 3] * b[4 * gq + 3]);
            *(u32x2*)(dst + (unsigned)((mb * 32 + r5) * 256 + 8 * gq + 4 * hh)) = o;
        }
}
DI void epi_su_park(const f32x16 (&acc)[4][2], unsigned* lds_su, int lane) {
    lane = opaque_v(lane);
#pragma unroll
    for (int mb = 0; mb < 4; ++mb)
#pragma unroll
        for (int nb = 0; nb < 2; ++nb)
#pragma unroll
            for (int q = 0; q < 8; ++q) lds_su[((mb * 2 + nb) * 8 + q) * 64 + lane] = pk2(acc[mb][nb][2 * q], acc[mb][nb][2 * q + 1]);
}
DI void epi_sv(f32x16 (&acc)[4][2], const bf16_t* __restrict__ SWF  , const float* __restrict__ bs_g, const unsigned* lds_su, bf16_t* __restrict__ dst, int lane) {
    lane = opaque_v(lane);
    const int r5 = lane & 31, hh = lane >> 5;
    bf16x8 vb[4][2][2];
#pragma unroll
    for (int mb = 0; mb < 4; ++mb) {
#pragma unroll
        for (int i = 0; i < 16; ++i) {
            float s1 = acc[mb][0][i] + acc[mb][1][i];
#pragma unroll
            for (int o = 1; o < 32; o <<= 1) s1 += __shfl_xor(s1, o);
            const float mu = s1 * (1.f / 64.f);
            const float d0 = acc[mb][0][i] - mu, d1 = acc[mb][1][i] - mu;
            float s2 = d0 * d0 + d1 * d1;
#pragma unroll
            for (int o = 1; o < 32; o <<= 1) s2 += __shfl_xor(s2, o);
            const float r = rsqrtf(s2 * (1.f / 64.f) + EPS);
            acc[mb][0][i] = d0 * r; acc[mb][1][i] = d1 * r;
        }
#pragma unroll
        for (int s = 0; s < 2; ++s)
#pragma unroll
            for (int nb = 0; nb < 2; ++nb) {
                const f32x16& a = acc[mb][nb];
                u32x4 o; o.x = pk2(a[8 * s], a[8 * s + 1]); o.y = pk2(a[8 * s + 2], a[8 * s + 3]); o.z = pk2(a[8 * s + 4], a[8 * s + 5]); o.w = pk2(a[8 * s + 6], a[8 * s + 7]);
                vb[mb][s][nb] = __builtin_bit_cast(bf16x8, o);
            }
    }
#pragma unroll
    for (int tb = 0; tb < 4; ++tb) {
        f32x16 y[2];
#pragma unroll
        for (int nb = 0; nb < 2; ++nb)
#pragma unroll
            for (int i = 0; i < 16; ++i) y[nb][i] = 0.f;
#pragma unroll
        for (int kt = 0; kt <= tb; ++kt)
#pragma unroll
            for (int s = 0; s < 2; ++s) {
                const bf16x8 wa = *(const bf16x8*)(SWF + ((unsigned)(((tb * 4 + kt) * 2 + s) * 64 + lane)) * 8);
                y[0] = MFMA32(wa, vb[kt][s][0], y[0]);
                y[1] = MFMA32(wa, vb[kt][s][1], y[1]);
            }
#pragma unroll
        for (int nb = 0; nb < 2; ++nb)
#pragma unroll
            for (int q = 0; q < 8; ++q) {
                const unsigned su2 = lds_su[((tb * 2 + nb) * 8 + q) * 64 + lane];
                const int i0 = 2 * q, i1 = 2 * q + 1;
                const int t0 = tb * 32 + (i0 & 3) + 8 * (i0 >> 2) + 4 * hh, t1 = tb * 32 + (i1 & 3) + 8 * (i1 >> 2) + 4 * hh;
                const float v0 = (y[nb][i0] + bs_g[t0]) * __uint_as_float(su2 << 16), v1 = (y[nb][i1] + bs_g[t1]) * __uint_as_float(su2 & 0xffff0000u);
                const unsigned pk = pk2(v0, v1);
                dst[(unsigned)(t0 * 256 + nb * 32 + r5)] = (bf16_t)(pk & 0xffffu);
                dst[(unsigned)(t1 * 256 + nb * 32 + r5)] = (bf16_t)(pk >> 16);
            }
    }
}

DI void conv_sguw_item(const float* __restrict__ W, bf16_t* __restrict__ SWF, int gid) {
    const int lane = gid & 63, s = (gid >> 6) & 1, kt = (gid >> 7) & 3, tb = (gid >> 9) & 3, g = gid >> 11;
    const int r = lane & 31, hh = lane >> 5, t = tb * 32 + r;
    const float* p = W + ((size_t)g * 128 + t) * 128;
    float v[8];
#pragma unroll
    for (int j = 0; j < 8; ++j) { const int sp = kt * 32 + 16 * s + 8 * (j >> 2) + 4 * hh + (j & 3); v[j] = sp <= t ? p[sp] : 0.f; }
    u32x4 o; o.x = pk2(v[0], v[1]); o.y = pk2(v[2], v[3]); o.z = pk2(v[4], v[5]); o.w = pk2(v[6], v[7]);
    *(u32x4*)(SWF + (size_t)gid * 8) = o;
}

DI int t5_bucket(int d) {
    if (d < 16) return d;
    const float lr = logf((float)d / 16.f) / logf(8.f);
    const int large = 16 + (int)(lr * 16.f);
    return large < 31 ? large : 31;
}

DI void attn_tile(const bf16_t* __restrict__ QF, const bf16_t* __restrict__ KF2, const bf16_t* __restrict__ VF, const float* bias_lds, const float* __restrict__ sink, bf16_t* __restrict__ OR, int tile, int tid) {
    tid = opaque_v(tid); tile = opaque_s(tile);
    const int lane = tid & 63, w = __builtin_amdgcn_readfirstlane(tid >> 6), r5 = lane & 31, hh = lane >> 5;
    const bool has_prev = (tile & 31) != 0;
    for (int task = w; task < 32; task += 8) {
        const int qh = task >> 2, qt = task & 3, kvh = qh >> 2;
        bf16x8 bq[4];
#pragma unroll
        for (int ks = 0; ks < 4; ++ks) bq[ks] = *(const bf16x8*)(QF + ((unsigned)((((tile * 8 + qh) * 4 + ks) * 4 + qt) * 64 + lane)) * 8);
        f32x16 sc[5];
#pragma unroll
        for (int grp = 0; grp < 2; ++grp) {
            bf16x8 kf[3][4];
#pragma unroll
            for (int jq = 0; jq < 3; ++jq) if (grp * 3 + jq < 5) {
                const int jj = grp * 3 + jq, j = qt + jj, st = (j >= 4 || !has_prev) ? tile : tile - 1, kt = j & 3;
#pragma unroll
                for (int ks = 0; ks < 4; ++ks) kf[jq][ks] = *(const bf16x8*)(KF2 + ((unsigned)((((st * 2 + kvh) * 4 + ks) * 4 + kt) * 64 + lane)) * 8);
            }
#pragma unroll
            for (int jq = 0; jq < 3; ++jq) if (grp * 3 + jq < 5) {
                const int jj = grp * 3 + jq;
#pragma unroll
                for (int i = 0; i < 16; ++i) sc[jj][i] = 0.f;
#pragma unroll
                for (int ks = 0; ks < 4; ++ks) sc[jj] = MFMA32(kf[jq][ks], bq[ks], sc[jj]);
            }
            __builtin_amdgcn_sched_barrier(0);
        }
        bf16x8 vf[5][2][2];
#pragma unroll
        for (int jj = 0; jj < 2; ++jj) {
            const int j = qt + jj, st = (j >= 4 || !has_prev) ? tile : tile - 1, kt = j & 3;
#pragma unroll
            for (int s2 = 0; s2 < 2; ++s2)
#pragma unroll
                for (int dt = 0; dt < 2; ++dt) vf[jj][s2][dt] = *(const bf16x8*)(VF + ((unsigned)(((((st * 2 + kvh) * 2 + dt) * 4 + kt) * 2 + s2) * 64 + lane)) * 8);
        }
        const float* bl = bias_lds + qh * 128;
        float m = -1e30f;
#pragma unroll
        for (int jj = 0; jj < 5; ++jj) {
            const bool ex = (qt + jj >= 4) || has_prev;
#pragma unroll
            for (int i = 0; i < 16; ++i) {
                const int cr = (i & 3) + 8 * (i >> 2) + 4 * hh;
                const int dist = 128 + r5 - 32 * jj - cr;
                const bool valid = ex && dist >= 0 && dist < 128;
                const float v = valid ? sc[jj][i] + bl[dist & 127] : -1e30f;
                sc[jj][i] = v; m = fmaxf(m, v);
            }
        }
        m = fmaxf(m, __shfl_xor(m, 32));
        const float sk = sink[qh];
        m = fmaxf(m, sk);
        float l = 0.f;
#pragma unroll
        for (int jj = 0; jj < 5; ++jj)
#pragma unroll
            for (int i = 0; i < 16; ++i) { const float p = __expf(sc[jj][i] - m); sc[jj][i] = p; l += p; }
        l += __shfl_xor(l, 32);
        l += __expf(sk - m);
        const float rl = 1.f / l;
        f32x16 o[2];
#pragma unroll
        for (int dt = 0; dt < 2; ++dt)
#pragma unroll
            for (int i = 0; i < 16; ++i) o[dt][i] = 0.f;
        __builtin_amdgcn_sched_barrier(0);
#pragma unroll
        for (int jj = 2; jj < 5; ++jj) {
            const int j = qt + jj, st = (j >= 4 || !has_prev) ? tile : tile - 1, kt = j & 3;
#pragma unroll
            for (int s2 = 0; s2 < 2; ++s2)
#pragma unroll
                for (int dt = 0; dt < 2; ++dt) vf[jj][s2][dt] = *(const bf16x8*)(VF + ((unsigned)(((((st * 2 + kvh) * 2 + dt) * 4 + kt) * 2 + s2) * 64 + lane)) * 8);
        }
#pragma unroll
        for (int jj = 0; jj < 5; ++jj) {
#pragma unroll
            for (int s = 0; s < 2; ++s) {
                const f32x16& a = sc[jj];
                u32x4 pp; pp.x = pk2(a[8 * s], a[8 * s + 1]); pp.y = pk2(a[8 * s + 2], a[8 * s + 3]); pp.z = pk2(a[8 * s + 4], a[8 * s + 5]); pp.w = pk2(a[8 * s + 6], a[8 * s + 7]);
                const bf16x8 pb = __builtin_bit_cast(bf16x8, pp);
#pragma unroll
                for (int dt = 0; dt < 2; ++dt) o[dt] = MFMA32(vf[jj][s][dt], pb, o[dt]);
            }
        }
        bf16_t* orow = OR + (unsigned)((tile * 128 + qt * 32 + r5) * 512 + qh * 64 + 4 * hh);
#pragma unroll
        for (int dt = 0; dt < 2; ++dt)
#pragma unroll
            for (int gq = 0; gq < 4; ++gq) {
                u32x2 ov; ov.x = pk2(o[dt][4 * gq] * rl, o[dt][4 * gq + 1] * rl); ov.y = pk2(o[dt][4 * gq + 2] * rl, o[dt][4 * gq + 3] * rl);
                *(u32x2*)(orow + dt * 32 + 8 * gq) = ov;
            }
    }
}

DI void unpack8(const u32x4 v, float (&f)[8]) {
    f[0] = __uint_as_float(v.x << 16); f[1] = __uint_as_float(v.x & 0xffff0000u); f[2] = __uint_as_float(v.y << 16); f[3] = __uint_as_float(v.y & 0xffff0000u);
    f[4] = __uint_as_float(v.z << 16); f[5] = __uint_as_float(v.z & 0xffff0000u); f[6] = __uint_as_float(v.w << 16); f[7] = __uint_as_float(v.w & 0xffff0000u);
}
DI void merge_tile(const bf16_t* __restrict__ OR, const bf16_t* __restrict__ CBR, const bf16_t* __restrict__ ZR, const bf16_t* __restrict__ YS, const float* __restrict__ cw  , const float* __restrict__ og  ,
                   bf16_t* __restrict__ mA, int tile, int tid) {
    tid = opaque_v(tid); tile = opaque_s(tile);
    const int lane = tid & 63, w = tid >> 6;
    for (int rr = 0; rr < 16; ++rr) {
        const int row = w * 16 + rr, t = tile * 128 + row, pos = t & (S - 1);
        float a[8], y[8];
        unpack8(*(const u32x4*)(OR + (unsigned)(t * 512 + lane * 8)), a);
        float ssa = 0.f;
#pragma unroll
        for (int q = 0; q < 8; ++q) ssa += a[q] * a[q];
        ssa = wave_sum(ssa);
        if (lane < 32) {
            const int c0 = lane * 8;
            float cb[8], z0[8], z1[8], z2[8];
            unpack8(*(const u32x4*)(CBR + (unsigned)(t * 256 + c0)), cb);
            unpack8(*(const u32x4*)(ZR + (unsigned)(t * 256 + c0)), z2);
            if (pos >= 1) unpack8(*(const u32x4*)(ZR + (unsigned)((t - 1) * 256 + c0)), z1); else { _Pragma("unroll") for (int q = 0; q < 8; ++q) z1[q] = 0.f; }
            if (pos >= 2) unpack8(*(const u32x4*)(ZR + (unsigned)((t - 2) * 256 + c0)), z0); else { _Pragma("unroll") for (int q = 0; q < 8; ++q) z0[q] = 0.f; }
#pragma unroll
            for (int q = 0; q < 8; ++q) y[q] = cb[q] * (cw[c0 + q] * z0[q] + cw[256 + c0 + q] * z1[q] + cw[512 + c0 + q] * z2[q]);
        } else {
            unpack8(*(const u32x4*)(YS + (unsigned)(t * 256 + (lane - 32) * 8)), y);
        }
        float ssy = 0.f;
#pragma unroll
        for (int q = 0; q < 8; ++q) ssy += y[q] * y[q];
#pragma unroll
        for (int o = 1; o < 32; o <<= 1) ssy += __shfl_xor(ssy, o);
        const float ra = rsqrtf(ssa * (1.f / 512.f) + EPS), ry = rsqrtf(ssy * (1.f / 256.f) + EPS);
        const int mb = row >> 5, r5 = row & 31;
        {
            const float4 g0 = *(const float4*)(og + lane * 8), g1 = *(const float4*)(og + lane * 8 + 4);
            u32x4 o; o.x = pk2(a[0] * ra * g0.x, a[1] * ra * g0.y); o.y = pk2(a[2] * ra * g0.z, a[3] * ra * g0.w); o.z = pk2(a[4] * ra * g1.x, a[5] * ra * g1.y); o.w = pk2(a[6] * ra * g1.z, a[7] * ra * g1.w);
            const int c8 = lane;
            *(u32x4*)(mA + ((unsigned)(((tile * 64 + (c8 >> 1)) * 4 + mb) * 64 + r5 + 32 * (c8 & 1))) * 8) = o;
        }
        {
            const float4 g0 = *(const float4*)(og + 512 + lane * 8), g1 = *(const float4*)(og + 512 + lane * 8 + 4);
            u32x4 o; o.x = pk2(y[0] * ry * g0.x, y[1] * ry * g0.y); o.y = pk2(y[2] * ry * g0.z, y[3] * ry * g0.w); o.z = pk2(y[4] * ry * g1.x, y[5] * ry * g1.y); o.w = pk2(y[6] * ry * g1.z, y[7] * ry * g1.w);
            const int c8 = 64 + lane;
            *(u32x4*)(mA + ((unsigned)(((tile * 64 + (c8 >> 1)) * 4 + mb) * 64 + r5 + 32 * (c8 & 1))) * 8) = o;
        }
    }
}

struct InProjOut { bf16_t *QF, *KF2, *VF, *CBR, *ZR, *YS; };
DI void inproj_tile(const bf16_t* __restrict__ At, const bf16_t* __restrict__ WF, const float* __restrict__ qg, const float* __restrict__ kg, const bf16_t* __restrict__ SWF, const float* __restrict__ sgu_b,
                    const InProjOut& O, char* lds, int tile, int tid) {
    tid = opaque_v(tid); tile = opaque_s(tile);
    const int lane = tid & 63, w = __builtin_amdgcn_readfirstlane(tid >> 6);
    f32x16 acc[4][2];
    {
        const int nbt0 = w * 2;
        kloop<1>(acc, At, WF + (size_t)nbt0 * 32768, WF + (size_t)(nbt0 + 1) * 32768, lds, tid, lane);
        epi_qk(acc, qg, 0.125f, O.QF + (size_t)(tile * 8 + w) * 8192, lane);
    }
    {
        const int nbt0 = 16 + w * 2;
        if (w == 2 || w == 3) {
            kloop<0>(acc, At, WF + (size_t)nbt0 * 32768, WF + (size_t)(nbt0 + 1) * 32768, lds, tid, lane);
            epi_v(acc, O.VF + (size_t)(tile * 2 + (w - 2)) * 8192, lane);
        } else {
            kloop<1>(acc, At, WF + (size_t)nbt0 * 32768, WF + (size_t)(nbt0 + 1) * 32768, lds, tid, lane);
            if (w < 2) epi_qk(acc, kg, 1.f, O.KF2 + (size_t)(tile * 2 + w) * 8192, lane);
            else epi_row(acc, O.CBR + (size_t)tile * 128 * 256 + (w - 4) * 64, 256, lane);
        }
    }
    {
        const int nbt0 = 32 + w * 2;
        kloop<1>(acc, At, WF + (size_t)nbt0 * 32768, WF + (size_t)(nbt0 + 1) * 32768, lds, tid, lane);
        epi_z(acc, O.ZR + (size_t)tile * 128 * 256 + w * 32, lane);
    }
    {
        const int nbt0 = 48 + w * 2;
        kloop<0>(acc, At, WF + (size_t)nbt0 * 32768, WF + (size_t)(nbt0 + 1) * 32768, lds, tid, lane);
        unsigned* lds_su = (unsigned*)lds;
        if (w < 4) epi_su_park(acc, lds_su + w * 4096, lane);
        __syncthreads();
        if (w >= 4) epi_sv(acc, SWF + (size_t)(w - 4) * 16384, sgu_b + (w - 4) * 128, lds_su + (w - 4) * 4096, O.YS + (size_t)tile * 128 * 256 + (w - 4) * 64, lane);
        __syncthreads();
    }
}


struct Params {
    const float *x, *c, *rel_bias, *w_ada, *b_ada, *norm1_g, *norm2_g, *w_in, *q_norm_g, *k_norm_g, *attn_sink, *conv_w, *sgu_w, *sgu_b, *out_norm_g, *w_out, *peer_wq, *peer_sub_keys, *peer_down, *peer_up;
    float* out;
    char* ws;
};
constexpr size_t MiB = 1u << 20;
constexpr size_t WS_MOD = 0;
constexpr size_t WS_MODP = 1 * MiB;
constexpr size_t WS_WIN = 13 * MiB;
constexpr size_t WS_WOUT = 29 * MiB;
constexpr size_t WS_WPQ = 37 * MiB;
constexpr size_t WS_KEYS = 53 * MiB;
constexpr size_t WS_SWF = 55 * MiB;
constexpr size_t WS_SC = 56 * MiB;
constexpr size_t WS_TB = 57 * MiB;
constexpr size_t WS_HA = 185 * MiB;
constexpr size_t WS_QF = 249 * MiB;
constexpr size_t WS_KF2 = 602 * MiB;
constexpr size_t WS_VF = 634 * MiB;
constexpr size_t WS_ZR = 666 * MiB;
constexpr size_t WS_CBR = 345 * MiB;
constexpr size_t WS_YS = 361 * MiB;
constexpr size_t WS_OR = 377 * MiB;
constexpr size_t WS_QPF = 409 * MiB;
constexpr size_t WS_RIDX = 537 * MiB;
constexpr size_t WS_RGATE = 553 * MiB;
constexpr size_t WS_SEID = 569 * MiB;
constexpr size_t WS_SWGT = 585 * MiB;
constexpr size_t WS_OFFS = 601 * MiB;
constexpr size_t WS_FLAGS = 601 * MiB + 512 * 1024;
constexpr size_t WS_END = 730 * MiB;
static_assert(PL_END <= LDS_RSTD1, "expert-phase lists overlap persistent LDS state");

__global__ __launch_bounds__(512) void hybrid_fwd(Params P) {
    extern __shared__ __attribute__((aligned(16))) char lds[];
    cg::grid_group grid = cg::this_grid();
    const int tid = threadIdx.x, lane = tid & 63, w = __builtin_amdgcn_readfirstlane(tid >> 6);
    const int nblk = gridDim.x, bid = blockIdx.x;
    char* ws = P.ws;
    float* mod = (float*)(ws + WS_MOD);
    float* modp = (float*)(ws + WS_MODP);
    bf16_t* WinF = (bf16_t*)(ws + WS_WIN); bf16_t* WoutF = (bf16_t*)(ws + WS_WOUT); bf16_t* WpqF = (bf16_t*)(ws + WS_WPQ);
    bf16_t* KeysF = (bf16_t*)(ws + WS_KEYS); bf16_t* SWF = (bf16_t*)(ws + WS_SWF);
    float* SC = (float*)(ws + WS_SC); unsigned char* TBd = (unsigned char*)(ws + WS_TB); unsigned char* TBu = TBd + 32 * MiB;
    bf16_t* hA = (bf16_t*)(ws + WS_HA);
    bf16_t* OR = (bf16_t*)(ws + WS_OR); bf16_t* QPF = (bf16_t*)(ws + WS_QPF);
    int* ridx = (int*)(ws + WS_RIDX); float* rgate = (float*)(ws + WS_RGATE);
    float* bias_lds = (float*)(lds + LDS_BIAS);
    unsigned* flags = (unsigned*)(ws + WS_FLAGS);

    {
        float* ca = (float*)lds;
        for (int i = tid; i < 8192; i += 512) { const float v = P.c[i]; ca[i] = v / (1.f + __expf(-v)); }
        for (int i = tid; i < 1024; i += 512) bias_lds[i] = P.rel_bias[t5_bucket(i & 127) * 8 + (i >> 7)];
        __syncthreads();
        for (int it = bid; it < 768; it += nblk) {
            const int jc = it % 12, l = (it / 12) & 3, ks = it / 48;
            const int j = jc * 512 + tid;
            const float* wp = P.w_ada + ((size_t)l * 1024 + ks * 64) * 6144 + j;
            float acc[8];
#pragma unroll
            for (int b = 0; b < 8; ++b) acc[b] = 0.f;
#pragma unroll 4
            for (int i = 0; i < 64; ++i) {
                const float wv = wp[(size_t)i * 6144];
#pragma unroll
                for (int b = 0; b < 8; ++b) acc[b] += ca[b * 1024 + ks * 64 + i] * wv;
            }
#pragma unroll
            for (int b = 0; b < 8; ++b) modp[((size_t)(ks * 4 + l) * 8 + b) * 6144 + j] = acc[b];
        }
        const int gthreads = nblk * 512, gtid = bid * 512 + tid;
        for (int rep = 0; rep < REP_P0; ++rep)
        for (int l = 0; l < DEPTH; ++l) {
            for (int g = gtid; g < 64 * 64 * 64; g += gthreads) conv_wfrag_item(P.w_in + (size_t)l * 1024 * 2048, 2048, 64, WinF + (size_t)l * 2097152, g, 1);
            for (int g = gtid; g < 32 * 64 * 64; g += gthreads) conv_wfrag_item(P.w_out + (size_t)l * 1024 * 1024, 1024, 64, WoutF + (size_t)l * 1048576, g, 0);
            for (int g = gtid; g < 64 * 64 * 64; g += gthreads) conv_wfrag_item(P.peer_wq + (size_t)l * 1024 * 2048, 2048, 64, WpqF + (size_t)l * 2097152, g, 0);
            for (int g = gtid; g < 32768; g += gthreads) conv_keys_item(P.peer_sub_keys + (size_t)l * 262144, KeysF + (size_t)l * 262144, g);
            for (int g = gtid; g < 8192; g += gthreads) conv_sguw_item(P.sgu_w + (size_t)l * 65536, SWF + (size_t)l * 65536, g);
        }
        const int gwaves = nblk * 8, gw = bid * 8 + w;
        for (int rep = 0; rep < REP_P0; ++rep)
        for (int r = gw; r < DEPTH * 16384 * 2; r += gwaves) {
            const int which = r & 1, le = r >> 1;
            conv_table_row((which ? P.peer_up : P.peer_down) + (size_t)le * D, (which ? TBu : TBd) + (size_t)le * 512, SC + (size_t)le * 2 + which, lane, which == 0);
        }
    }
    grid.sync();
    for (int tile = bid; tile < NTILE; tile += nblk) {
        const int b = tile >> 5;
        for (int l = 0; l < DEPTH; ++l)
            for (int j = tid; j < 6144; j += 512) {
                float v = P.b_ada[l * 6144 + j];
#pragma unroll
                for (int ks = 0; ks < 16; ++ks) v += modp[((size_t)(ks * 4 + l) * 8 + b) * 6144 + j];
                mod[((size_t)l * 8 + b) * 6144 + j] = v;
            }
    }
    __syncthreads();

    for (int l = 0; l < DEPTH; ++l) {
        const float* xin = l == 0 ? P.x : P.out;
        InProjOut IO;
        IO.QF = (bf16_t*)(ws + WS_QF); IO.KF2 = (bf16_t*)(ws + WS_KF2 + (size_t)l * 8 * MiB); IO.VF = (bf16_t*)(ws + WS_VF + (size_t)l * 8 * MiB);
        IO.CBR = (bf16_t*)(ws + WS_CBR); IO.ZR = (bf16_t*)(ws + WS_ZR + (size_t)l * 16 * MiB); IO.YS = (bf16_t*)(ws + WS_YS);
        for (int tile = bid; tile < NTILE; tile += nblk) {
            const float* mb_ = mod + ((size_t)l * 8 + (tile >> 5)) * 6144;
            const bool have1 = l > 0 && nblk == NTILE;
            if (have1) { if (tid < 128) ((float*)lds)[tid] = ((const float*)(lds + LDS_RSTD1))[tid]; __syncthreads(); }
            norm_to_frag(xin, P.norm1_g + l * D, mb_ + 0, mb_ + 1024, hA, (float*)lds, tile, tid, have1);
            __syncthreads();
            for (int rep = 0; rep < REP_GEMM; ++rep) inproj_tile(hA + (size_t)tile * 131072, WinF + (size_t)l * 2097152, P.q_norm_g + l * 64, P.k_norm_g + l * 64, SWF + (size_t)l * 65536, P.sgu_b + l * 512, IO, lds, tile, tid);
            asm volatile("s_waitcnt vmcnt(0)" ::: "memory");
            __syncthreads();
            if (tid == 0) {
                __builtin_amdgcn_fence(__ATOMIC_RELEASE, "agent");
                asm volatile("s_waitcnt vmcnt(0)" ::: "memory");
                __hip_atomic_store(flags + tile, (unsigned)(l + 1), __ATOMIC_RELAXED, __HIP_MEMORY_SCOPE_AGENT);
            }
        }
        for (int tile = bid; tile < NTILE; tile += nblk) {
            const float* mb_ = mod + ((size_t)l * 8 + (tile >> 5)) * 6144;
            if ((tile & 31) != 0) {
                if (tid == 0) {
                    unsigned spins = 0;
                    while (__hip_atomic_load(flags + tile - 1, __ATOMIC_RELAXED, __HIP_MEMORY_SCOPE_AGENT) < (unsigned)(l + 1) && ++spins < (1u << 24)) __builtin_amdgcn_s_sleep(2);
                    __builtin_amdgcn_fence(__ATOMIC_ACQUIRE, "agent");
                    asm volatile("s_waitcnt vmcnt(0)" ::: "memory");
                }
                __syncthreads();
            }
            for (int rep = 0; rep < REP_MIX; ++rep) {
            attn_tile(IO.QF, IO.KF2, IO.VF, bias_lds, P.attn_sink + l * 8, OR, tile, tid);
            __syncthreads();
            merge_tile(OR, IO.CBR, IO.ZR, IO.YS, P.conv_w + l * 768, P.out_norm_g + l * D, hA, tile, tid);
            __syncthreads();
            }
            {
                const bf16_t* At = hA + (size_t)tile * 131072;
                const bf16_t* WF = WoutF + (size_t)l * 1048576;
                for (int pass = 0; pass < 2; ++pass) {
                    f32x16 acc[4][2];
                    const int nbt0 = pass * 16 + w * 2;
                    kloop<0>(acc, At, WF + (size_t)nbt0 * 32768, WF + (size_t)(nbt0 + 1) * 32768, lds, tid, lane);
                    epi_resid(acc, xin, P.out, mb_ + 2048, (float*)(lds + LDS_EPI) + w * 2176, (float*)(lds + LDS_SSQ) + (pass * 8 + w) * 128, tile, pass * 512 + w * 64, lane);
                }
            }
            __syncthreads();
            if (tid < 128) { const float* sq = (const float*)(lds + LDS_SSQ); float ssum = 0.f;
#pragma unroll
                for (int c = 0; c < 16; ++c) ssum += sq[c * 128 + tid];
                ((float*)lds)[tid] = rsqrtf(ssum * (1.f / D) + EPS); }
            __syncthreads();
            norm_to_frag(P.out, P.norm2_g + l * D, mb_ + 3072, mb_ + 4096, hA, (float*)lds, tile, tid, true);
            __syncthreads();
            {
                const bf16_t* At = hA + (size_t)tile * 131072;
                const bf16_t* WF = WpqF + (size_t)l * 2097152;
                for (int rep = 0; rep < REP_GEMM; ++rep)
                for (int pass = 0; pass < 4; ++pass) {
                    f32x16 acc[4][2];
                    const int nbt0 = pass * 16 + w * 2;
                    kloop<1>(acc, At, WF + (size_t)nbt0 * 32768, WF + (size_t)(nbt0 + 1) * 32768, lds, tid, lane);
                    epi_qpf(acc, QPF, tile, nbt0, lane);
                }
            }
            __syncthreads();
            for (int rep = 0; rep < REP_ROUTE; ++rep) { route_tile(QPF, KeysF + (size_t)l * 262144, ridx, rgate, (unsigned char*)lds, tile, tid); __syncthreads(); }
            for (int i = 0; i < 16; ++i) stage_token(ridx, rgate, lds, tile * 128 + w * 16 + i, w * 16 + i, lane);
            __syncthreads();
            peer_down_wave(hA, lds, TBd + (size_t)l * 16384 * 512, SC + (size_t)l * 32768, tile, w, lane);
            __syncthreads();
            peer_up_wave(lds, TBu + (size_t)l * 16384 * 512, mb_ + 5120, P.out, tile, w, lane);
            __syncthreads();
        }
    }
}
}

extern "C" void kernel_launch(void* const* d_in, const int* in_sizes, int n_in, void* d_out, int out_size, void* d_ws, size_t ws_size, hipStream_t stream) {
    using namespace op;
    static int grid_blocks = 0;
    if (!grid_blocks) {
        int dev = 0, cus = 0, per_cu = 0;
        (void)hipGetDevice(&dev);
        (void)hipDeviceGetAttribute(&cus, hipDeviceAttributeMultiprocessorCount, dev);
        (void)hipFuncSetAttribute((const void*)hybrid_fwd, hipFuncAttributeMaxDynamicSharedMemorySize, LDS_BYTES);
        (void)hipOccupancyMaxActiveBlocksPerMultiprocessor(&per_cu, (const void*)hybrid_fwd, 512, LDS_BYTES);
        if (per_cu < 1) per_cu = 1;
        grid_blocks = cus * per_cu;
        if (grid_blocks > NTILE) grid_blocks = NTILE;
        if (ws_size < WS_END) { fprintf(stderr, "kernel_launch: workspace too small (%zu < %zu)\n", ws_size, (size_t)WS_END); grid_blocks = -1; }
    }
    if (grid_blocks < 0) return;
    Params p{};
    p.x = (const float*)d_in[0]; p.c = (const float*)d_in[1]; p.rel_bias = (const float*)d_in[2]; p.w_ada = (const float*)d_in[3]; p.b_ada = (const float*)d_in[4];
    p.norm1_g = (const float*)d_in[5]; p.norm2_g = (const float*)d_in[6]; p.w_in = (const float*)d_in[7]; p.q_norm_g = (const float*)d_in[8]; p.k_norm_g = (const float*)d_in[9];
    p.attn_sink = (const float*)d_in[10]; p.conv_w = (const float*)d_in[11]; p.sgu_w = (const float*)d_in[12]; p.sgu_b = (const float*)d_in[13]; p.out_norm_g = (const float*)d_in[14];
    p.w_out = (const float*)d_in[15]; p.peer_wq = (const float*)d_in[16]; p.peer_sub_keys = (const float*)d_in[17]; p.peer_down = (const float*)d_in[18]; p.peer_up = (const float*)d_in[19];
    p.out = (float*)d_out; p.ws = (char*)d_ws;
    (void)hipMemsetAsync((char*)d_ws + WS_FLAGS, 0, 1024, stream);
    void* args[] = {&p};
    hipError_t e = hipLaunchCooperativeKernel((const void*)hybrid_fwd, dim3(grid_blocks), dim3(512), args, LDS_BYTES, stream);
    if (e != hipSuccess) fprintf(stderr, "kernel_launch: cooperative launch failed: %s (grid %d)\n", hipGetErrorString(e), grid_blocks);
}
```

```cpp
#include <hip/hip_runtime.h>
#include <cstdio>
#include <cstdint>
#include <hip/hip_cooperative_groups.h>
namespace cg = cooperative_groups;


namespace op {
#define DI __device__ __forceinline__
typedef unsigned short bf16_t;
typedef short bf16x8 __attribute__((ext_vector_type(8)));
typedef float f32x16 __attribute__((ext_vector_type(16)));
typedef float f32x2 __attribute__((ext_vector_type(2)));
typedef unsigned u32x4 __attribute__((ext_vector_type(4)));
typedef unsigned u32x2 __attribute__((ext_vector_type(2)));
typedef __bf16 bf16v2 __attribute__((ext_vector_type(2)));
constexpr int D = 1024, NB = 8, S = 4096, DEPTH = 4, T = NB * S, NTILE = T / 128;
constexpr float EPS = 1e-6f;
constexpr int LDS_EPI = 32768, LDS_SSQ = 102400, LDS_RSTD1 = 110592, LDS_BIAS = 112 * 1024, LDS_BYTES = 116 * 1024;
constexpr int REP_GEMM = 1, REP_ROUTE = 1, REP_MIX = 1, REP_NORM = 1, REP_P0 = 1;
#define MFMA32(a, b, c) __builtin_amdgcn_mfma_f32_32x32x16_bf16((a), (b), (c), 0, 0, 0)

DI unsigned pk2(float lo, float hi) { f32x2 v = {lo, hi}; return __builtin_bit_cast(unsigned, __builtin_convertvector(v, bf16v2)); }
DI int opaque_v(int x) { asm volatile("" : "+v"(x)); return x; }
DI int opaque_s(int x) { asm volatile("" : "+s"(x)); return x; }
DI int crow(int reg, int hh) { return (reg & 3) + 8 * (reg >> 2) + 4 * hh; }
DI float wave_sum(float v) {
#pragma unroll
    for (int o = 1; o < 64; o <<= 1) v += __shfl_xor(v, o);
    return v;
}

DI int col_perm(int npos, int mode) {
    if (mode == 1 && npos >= 1024 && npos < 1536) { const int q = npos - 1024, w = q >> 6, nb = (q >> 5) & 1, r = q & 31; return (nb ? 1280 : 1024) + 32 * w + r; }
    return npos;
}
DI void conv_wfrag_item(const float* __restrict__ W, int N, int KB, bf16_t* __restrict__ WF, int gid, int mode) {
    const int l = gid & 63, kb = (gid >> 6) % KB, nbt = (gid >> 6) / KB, r = l & 31, hh = l >> 5;
    const int n = col_perm(nbt * 32 + r, mode);
    const float* p = W + (size_t)(kb * 16 + 8 * hh) * N + n;
    float v[8];
#pragma unroll
    for (int j = 0; j < 8; ++j) v[j] = p[(size_t)j * N];
    u32x4 o; o.x = pk2(v[0], v[1]); o.y = pk2(v[2], v[3]); o.z = pk2(v[4], v[5]); o.w = pk2(v[6], v[7]);
    *(u32x4*)(WF + (size_t)gid * 8) = o;
}

DI void norm_to_frag(const float* __restrict__ x, const float* __restrict__ g, const float* __restrict__ sh, const float* __restrict__ sc, bf16_t* __restrict__ hA, float* rstd_lds, int tile, int tid, bool have_rstd) {
    tid = opaque_v(tid); tile = opaque_s(tile);
    const int w = tid >> 6, lane = tid & 63;
    float cg[16], cs[16], ch[16];
#pragma unroll
    for (int j = 0; j < 2; ++j)
#pragma unroll
        for (int q = 0; q < 2; ++q) {
            const int c = 512 * j + 8 * lane + 4 * q;
            const float4 a = *(const float4*)(g + c), b = *(const float4*)(sc + c), d = *(const float4*)(sh + c);
            cg[8 * j + 4 * q] = a.x * (1.f + b.x); cg[8 * j + 4 * q + 1] = a.y * (1.f + b.y); cg[8 * j + 4 * q + 2] = a.z * (1.f + b.z); cg[8 * j + 4 * q + 3] = a.w * (1.f + b.w);
            ch[8 * j + 4 * q] = d.x; ch[8 * j + 4 * q + 1] = d.y; ch[8 * j + 4 * q + 2] = d.z; ch[8 * j + 4 * q + 3] = d.w;
            cs[8 * j + 4 * q] = 0.f; cs[8 * j + 4 * q + 1] = 0.f; cs[8 * j + 4 * q + 2] = 0.f; cs[8 * j + 4 * q + 3] = 0.f;
        }
    (void)cs;
#pragma unroll 4
    for (int rr = 0; rr < 16; ++rr) {
        const int row = w * 16 + rr;
        const float* xr = x + ((size_t)tile * 128 + row) * D + 8 * lane;
        float v[16];
#pragma unroll
        for (int j = 0; j < 2; ++j)
#pragma unroll
            for (int q = 0; q < 2; ++q) { const float4 a = *(const float4*)(xr + 512 * j + 4 * q); v[8 * j + 4 * q] = a.x; v[8 * j + 4 * q + 1] = a.y; v[8 * j + 4 * q + 2] = a.z; v[8 * j + 4 * q + 3] = a.w; }
        float r;
        if (have_rstd) r = rstd_lds[row];
        else {
            float ss = 0.f;
#pragma unroll
            for (int e = 0; e < 16; ++e) ss += v[e] * v[e];
            r = rsqrtf(wave_sum(ss) * (1.f / D) + EPS);
        }
        bf16_t* orow = hA + ((size_t)tile * 128 + row) * D + 8 * lane;
#pragma unroll
        for (int j = 0; j < 2; ++j) {
            u32x4 o;
            o.x = pk2(v[8 * j] * r * cg[8 * j] + ch[8 * j], v[8 * j + 1] * r * cg[8 * j + 1] + ch[8 * j + 1]);
            o.y = pk2(v[8 * j + 2] * r * cg[8 * j + 2] + ch[8 * j + 2], v[8 * j + 3] * r * cg[8 * j + 3] + ch[8 * j + 3]);
            o.z = pk2(v[8 * j + 4] * r * cg[8 * j + 4] + ch[8 * j + 4], v[8 * j + 5] * r * cg[8 * j + 5] + ch[8 * j + 5]);
            o.w = pk2(v[8 * j + 6] * r * cg[8 * j + 6] + ch[8 * j + 6], v[8 * j + 7] * r * cg[8 * j + 7] + ch[8 * j + 7]);
            *(u32x4*)(orow + 512 * j) = o;
        }
    }
}

template <int ORIENT>
DI void kloop(f32x16 (&acc)[4][2], const bf16_t* __restrict__ At, const bf16_t* __restrict__ W0, const bf16_t* __restrict__ W1, char* lds, int tid, int lane) {
    tid = opaque_v(tid); lane = opaque_v(lane);
#pragma unroll
    for (int mb = 0; mb < 4; ++mb)
#pragma unroll
        for (int nb = 0; nb < 2; ++nb)
#pragma unroll
            for (int i = 0; i < 16; ++i) acc[mb][nb][i] = 0.f;
    {
    const int c8_ = (tid >> 3) & 7, rowA_ = (tid >> 6) * 8 + (tid & 7);
    const u32x4* Ag = (const u32x4*)(At + (unsigned)(rowA_ * 1024 + c8_ * 8));
    const int ldsA_ = ((((c8_ >> 1) * 4 + (rowA_ >> 5)) * 64) + (rowA_ & 31) + 32 * (c8_ & 1)) * 16;
    const u32x4* W0g = (const u32x4*)W0 + lane;
    const u32x4* W1g = (const u32x4*)W1 + lane;
    u32x4 wq[4][2], arA[2], arB[2];
    arA[0] = Ag[0]; arA[1] = Ag[8192]; arB[0] = Ag[8]; arB[1] = Ag[8 + 8192];
#pragma unroll
    for (int kk = 0; kk < 4; ++kk) { wq[kk][0] = W0g[kk * 64]; wq[kk][1] = W1g[kk * 64]; }
    *(u32x4*)(lds + ldsA_) = arA[0]; *(u32x4*)(lds + ldsA_ + 2048) = arA[1];
    __syncthreads();
#define KL_ITER(KC, ARL, ARS) do { \
        char* cur = lds + ((KC) & 1) * 16384; \
        char* nxt = lds + (((KC) + 1) & 1) * 16384; \
        const int kn = (KC) < 15 ? (KC) + 1 : 15, k2 = (KC) < 14 ? (KC) + 2 : 15; \
        ARL[0] = Ag[k2 * 8]; ARL[1] = Ag[k2 * 8 + 8192]; \
        __builtin_amdgcn_sched_barrier(0); \
        _Pragma("unroll") for (int kk = 0; kk < 4; ++kk) { \
            bf16x8 afr[4]; \
            _Pragma("unroll") for (int mb = 0; mb < 4; ++mb) afr[mb] = *(const bf16x8*)(cur + ((kk * 4 + mb) * 64 + lane) * 16); \
            _Pragma("unroll") for (int mb = 0; mb < 4; ++mb) \
                _Pragma("unroll") for (int nb = 0; nb < 2; ++nb) { \
                    const bf16x8 wf = __builtin_bit_cast(bf16x8, wq[kk][nb]); \
                    if (ORIENT == 0) acc[mb][nb] = MFMA32(afr[mb], wf, acc[mb][nb]); \
                    else acc[mb][nb] = MFMA32(wf, afr[mb], acc[mb][nb]); \
                } \
            wq[kk][0] = W0g[(kn * 4 + kk) * 64]; wq[kk][1] = W1g[(kn * 4 + kk) * 64]; \
            __builtin_amdgcn_sched_barrier(0); \
        } \
        if ((KC) < 15) { *(u32x4*)(nxt + ldsA_) = ARS[0]; *(u32x4*)(nxt + ldsA_ + 2048) = ARS[1]; } \
        __syncthreads(); \
    } while (0)
    for (int kc = 0; kc < 16; kc += 2) { KL_ITER(kc, arA, arB); KL_ITER(kc + 1, arB, arA); }
#undef KL_ITER
    }
}

DI void epi_f32row(const f32x16 (&acc)[4][2], float* __restrict__ C, int tile, int col0, int lane) {
    lane = opaque_v(lane);
    const int r5 = lane & 31, hh = lane >> 5;
    const unsigned boff = (unsigned)((tile * 128 + 4 * hh) * 2048 + col0 + r5);
#pragma unroll
    for (int mb = 0; mb < 4; ++mb)
#pragma unroll
        for (int nb = 0; nb < 2; ++nb)
#pragma unroll
            for (int i = 0; i < 16; ++i)
                C[boff + (unsigned)((mb * 32 + (i & 3) + 8 * (i >> 2)) * 2048 + nb * 32)] = acc[mb][nb][i];
}
DI void epi_resid(const f32x16 (&acc)[4][2], const float* __restrict__ xin, float* __restrict__ xout, const float* __restrict__ gate_b, float* T  , float* ssq  , int tile, int col0, int lane) {
    lane = opaque_v(lane);
    const int r5 = lane & 31, hh = lane >> 5, rq = lane >> 4, c4 = (lane & 15) * 4;
    const float4 gv = *(const float4*)(gate_b + col0 + c4);
#pragma unroll
    for (int mb = 0; mb < 4; ++mb) {
#pragma unroll
        for (int nb = 0; nb < 2; ++nb)
#pragma unroll
            for (int i = 0; i < 16; ++i) T[((i & 3) + 8 * (i >> 2) + 4 * hh) * 68 + nb * 32 + r5] = acc[mb][nb][i];
        asm volatile("s_waitcnt lgkmcnt(0)" ::: "memory");
#pragma unroll
        for (int j = 0; j < 8; ++j) {
            const int row = rq + 4 * j;
            const float4 v = *(const float4*)(T + row * 68 + c4);
            const unsigned o = (unsigned)((tile * 128 + mb * 32 + row) * D + col0 + c4);
            float4 xv = *(const float4*)(xin + o);
            xv.x += gv.x * v.x; xv.y += gv.y * v.y; xv.z += gv.z * v.z; xv.w += gv.w * v.w;
            *(float4*)(xout + o) = xv;
            float ss = xv.x * xv.x + xv.y * xv.y + xv.z * xv.z + xv.w * xv.w;
            ss += __shfl_xor(ss, 1); ss += __shfl_xor(ss, 2); ss += __shfl_xor(ss, 4); ss += __shfl_xor(ss, 8);
            if ((lane & 15) == 0) ssq[mb * 32 + row] = ss;
        }
        asm volatile("s_waitcnt lgkmcnt(0)" ::: "memory");
    }
}

DI void epi_qpf(const f32x16 (&acc)[4][2], bf16_t* __restrict__ QPF, int tile, int ft0, int lane) {
    lane = opaque_v(lane);
#pragma unroll
    for (int nb = 0; nb < 2; ++nb)
#pragma unroll
        for (int s = 0; s < 2; ++s)
#pragma unroll
            for (int mb = 0; mb < 4; ++mb) {
                const f32x16& a = acc[mb][nb];
                u32x4 o; o.x = pk2(a[8 * s], a[8 * s + 1]); o.y = pk2(a[8 * s + 2], a[8 * s + 3]); o.z = pk2(a[8 * s + 4], a[8 * s + 5]); o.w = pk2(a[8 * s + 6], a[8 * s + 7]);
                *(u32x4*)(QPF + ((unsigned)((((tile * 64 + ft0 + nb) * 2 + s) * 4 + mb) * 64 + lane)) * 8) = o;
            }
}

DI void conv_keys_item(const float* __restrict__ K, bf16_t* __restrict__ KF, int gid) {
    const int lane = gid & 63, s = (gid >> 6) & 1, nbl = (gid >> 7) & 3, nt = (gid >> 9) & 3, hp = gid >> 11;
    const int r = lane & 31, hh = lane >> 5;
    const float* p = K + ((size_t)hp * 128 + nt * 32 + r) * 128 + nbl * 32 + 16 * s + 4 * hh;
    const float4 a = *(const float4*)p, b = *(const float4*)(p + 8);
    u32x4 o; o.x = pk2(a.x, a.y); o.y = pk2(a.z, a.w); o.z = pk2(b.x, b.y); o.w = pk2(b.z, b.w);
    *(u32x4*)(KF + (size_t)gid * 8) = o;
}

DI void conv_table_row(const float* __restrict__ src, unsigned char* __restrict__ dst, float* __restrict__ sc, int lane, bool as_int4) {
    const float4* p = (const float4*)src + lane * 4;
    float4 v[4];
    float m = 0.f;
#pragma unroll
    for (int j = 0; j < 4; ++j) { v[j] = p[j]; m = fmaxf(m, fmaxf(fmaxf(fabsf(v[j].x), fabsf(v[j].y)), fmaxf(fabsf(v[j].z), fabsf(v[j].w)))); }
#pragma unroll
    for (int o = 1; o < 64; o <<= 1) m = fmaxf(m, __shfl_xor(m, o));
    float scale = m > 0.f ? m * (1.f / 6.f) : 1.f;
    if (as_int4) {
        float ss = 0.f;
#pragma unroll
        for (int j = 0; j < 4; ++j) ss += v[j].x * v[j].x + v[j].y * v[j].y + v[j].z * v[j].z + v[j].w * v[j].w;
        ss = wave_sum(ss);
        const float sg = sqrtf(ss * (1.f / 1024.f));
        scale = fmaxf(sg * (1.f / 2.8f), m * (1.f / 16.f));
        if (!(scale > 0.f)) scale = 1.f;
    }
    const float inv = 1.f / scale;
    u32x2 o;
    unsigned* op = (unsigned*)&o;
#pragma unroll
    for (int j = 0; j < 2; ++j) {
        const float f[8] = {v[2 * j].x, v[2 * j].y, v[2 * j].z, v[2 * j].w, v[2 * j + 1].x, v[2 * j + 1].y, v[2 * j + 1].z, v[2 * j + 1].w};
        unsigned wv = 0;
        if (as_int4) {
#pragma unroll
            for (int e = 0; e < 8; ++e) { int q = __float2int_rn(f[e] * inv); q = q < -7 ? -7 : (q > 7 ? 7 : q); wv |= ((unsigned)q & 15u) << (4 * e); }
        } else {
            wv = __builtin_amdgcn_cvt_scalef32_pk_fp4_f32(wv, f[0] * inv, f[1] * inv, 1.0f, 0);
            wv = __builtin_amdgcn_cvt_scalef32_pk_fp4_f32(wv, f[2] * inv, f[3] * inv, 1.0f, 1);
            wv = __builtin_amdgcn_cvt_scalef32_pk_fp4_f32(wv, f[4] * inv, f[5] * inv, 1.0f, 2);
            wv = __builtin_amdgcn_cvt_scalef32_pk_fp4_f32(wv, f[6] * inv, f[7] * inv, 1.0f, 3);
        }
        op[j] = wv;
    }
    *(u32x2*)(dst + lane * 8) = o;
    if (lane == 0) *sc = scale;
}

DI void ce_desc(int& a, int& b) { const int mx = a > b ? a : b, mn = a > b ? b : a; a = mx; b = mn; }
DI void sort16_desc(int (&v)[16]) {
#pragma unroll
    for (int k = 2; k <= 16; k <<= 1)
#pragma unroll
        for (int j = k >> 1; j > 0; j >>= 1)
#pragma unroll
            for (int i = 0; i < 16; ++i) {
                const int l = i ^ j;
                if (l > i) { if ((i & k) == 0) ce_desc(v[i], v[l]); else ce_desc(v[l], v[i]); }
            }
}
DI void bitonic_merge16_desc(int (&v)[16]) {
#pragma unroll
    for (int j = 8; j > 0; j >>= 1)
#pragma unroll
        for (int i = 0; i < 16; ++i) { const int l = i ^ j; if (l > i) ce_desc(v[i], v[l]); }
}
DI void merge_top16(int (&a)[16], const int (&b)[16]) {
#pragma unroll
    for (int i = 0; i < 16; ++i) a[i] = a[i] > b[15 - i] ? a[i] : b[15 - i];
    bitonic_merge16_desc(a);
}
DI int f2ord(float f) { int b = __float_as_int(f); return b ^ ((b >> 31) & 0x7fffffff); }
DI float ord2f(int k) { return __int_as_float(k ^ ((k >> 31) & 0x7fffffff)); }

DI void route_tile(const bf16_t* __restrict__ QPF, const bf16_t* __restrict__ KF, int* __restrict__ ridx, float* __restrict__ rgate, unsigned char* lds_idx  , int tile, int tid) {
    tid = opaque_v(tid); tile = opaque_s(tile);
    const int lane = tid & 63, w = __builtin_amdgcn_readfirstlane(tid >> 6);
    const int r5 = lane & 31, hh = lane >> 5;
    unsigned char* myidx = lds_idx + w * 1024;
    for (int task = w; task < 32; task += 8) {
        const int h = task >> 2, tt = task & 3;
        f32x16 acc[2][4];
#pragma unroll
        for (int p = 0; p < 2; ++p)
#pragma unroll
            for (int nt = 0; nt < 4; ++nt)
#pragma unroll
                for (int i = 0; i < 16; ++i) acc[p][nt][i] = 0.f;
        {
            bf16x8 bq[2], ak[2][4];
#define ROUTE_LOAD(buf, step) do { const int p_ = (step) >> 3, ks_ = (step) & 7; \
                bq[buf] = *(const bf16x8*)(QPF + ((unsigned)((((tile * 64 + h * 8 + p_ * 4 + (ks_ >> 1)) * 2 + (ks_ & 1)) * 4 + tt) * 64 + lane)) * 8); \
                _Pragma("unroll") for (int nt = 0; nt < 4; ++nt) ak[buf][nt] = *(const bf16x8*)(KF + ((unsigned)(((((h * 2 + p_) * 4 + nt) * 8 + ks_) * 64) + lane)) * 8); } while (0)
            ROUTE_LOAD(0, 0);
#pragma unroll
            for (int step = 0; step < 16; ++step) {
                if (step < 15) ROUTE_LOAD((step + 1) & 1, step + 1);
#pragma unroll
                for (int nt = 0; nt < 4; ++nt) acc[step >> 3][nt] = MFMA32(ak[step & 1][nt], bq[step & 1], acc[step >> 3][nt]);
                __builtin_amdgcn_sched_barrier(0);
            }
#undef ROUTE_LOAD
        }
        int g[8][16];
#pragma unroll
        for (int nt = 0; nt < 4; ++nt)
#pragma unroll
            for (int i = 0; i < 16; ++i) {
                const unsigned a = __float_as_uint(acc[0][nt][i]), b = __float_as_uint(acc[1][nt][i]);
                auto sw = __builtin_amdgcn_permlane32_swap(a, b, false, false);
                const int n0 = nt * 32 + (i & 3) + 8 * (i >> 2);
                g[nt * 2 + (i >> 3)][i & 7] = (f2ord(__uint_as_float(sw[0])) & ~127) | n0;
                g[nt * 2 + (i >> 3)][8 + (i & 7)] = (f2ord(__uint_as_float(sw[1])) & ~127) | (n0 + 4);
            }
#pragma unroll
        for (int q = 0; q < 8; ++q) sort16_desc(g[q]);
        merge_top16(g[0], g[1]); merge_top16(g[2], g[3]); merge_top16(g[4], g[5]); merge_top16(g[6], g[7]);
        merge_top16(g[0], g[2]); merge_top16(g[4], g[6]);
        merge_top16(g[0], g[4]);
        {
            u32x4 pk;
            unsigned* pp = (unsigned*)&pk;
#pragma unroll
            for (int q = 0; q < 4; ++q) pp[q] = (unsigned)(g[0][4 * q] & 127) | ((unsigned)(g[0][4 * q + 1] & 127) << 8) | ((unsigned)(g[0][4 * q + 2] & 127) << 16) | ((unsigned)(g[0][4 * q + 3] & 127) << 24);
            *(u32x4*)(myidx + lane * 16) = pk;
        }
        float f0[16], f1[16];
#pragma unroll
        for (int i = 0; i < 16; ++i) {
            const unsigned a = (unsigned)g[0][i], b = a;
            auto sw = __builtin_amdgcn_permlane32_swap(a, b, false, false);
            f0[i] = ord2f((int)sw[0] & ~127); f1[i] = ord2f((int)sw[1] & ~127);
        }
        int c0[16], c1[16], c2[16], c3[16];
#pragma unroll
        for (int j = 0; j < 16; ++j) c0[j] = (f2ord(f0[0] + f1[j]) & ~255) | j;
#pragma unroll
        for (int i = 1; i < 16; ++i) c1[i - 1] = (f2ord(f0[i] + f1[0]) & ~255) | (i << 4);
        c1[15] = (int)0x80000000;
#define CK(i, j) ((f2ord(f0[i] + f1[j]) & ~255) | ((i) << 4) | (j))
        c2[0] = CK(1, 1); c2[1] = CK(1, 2); c2[2] = CK(1, 3); c2[3] = CK(1, 4); c2[4] = CK(1, 5); c2[5] = CK(1, 6); c2[6] = CK(1, 7);
        c2[7] = CK(2, 1); c2[8] = CK(2, 2); c2[9] = CK(2, 3); c2[10] = CK(2, 4);
        c2[11] = CK(3, 1); c2[12] = CK(3, 2); c2[13] = CK(3, 3);
        c2[14] = CK(4, 1); c2[15] = CK(4, 2);
        c3[0] = CK(5, 1); c3[1] = CK(6, 1); c3[2] = CK(7, 1);
#undef CK
#pragma unroll
        for (int q = 3; q < 16; ++q) c3[q] = (int)0x80000000;
        sort16_desc(c2);
        ce_desc(c3[0], c3[1]); ce_desc(c3[1], c3[2]); ce_desc(c3[0], c3[1]);
        merge_top16(c0, c1); merge_top16(c2, c3); merge_top16(c0, c2);
        float bs[16], den = 0.f;
#pragma unroll
        for (int i = 0; i < 16; ++i) { bs[i] = __expf(ord2f(c0[i] & ~255) - ord2f(c0[0] & ~255)); den += bs[i]; }
        const float rden = 1.f / den;
        asm volatile("s_waitcnt lgkmcnt(0)" ::: "memory");
        const int tok = tile * 128 + tt * 32 + r5;
#pragma unroll
        for (int q = 0; q < 8; ++q) {
            const int key = (int)__builtin_amdgcn_permlane32_swap((unsigned)c0[q], (unsigned)c0[8 + q], false, false)[0];
            const float gv = __uint_as_float(__builtin_amdgcn_permlane32_swap(__float_as_uint(bs[q]), __float_as_uint(bs[8 + q]), false, false)[0]) * rden;
            const int i = (key >> 4) & 15, j = key & 15;
            const int e = (int)myidx[r5 * 16 + i] * 128 + (int)myidx[(32 + r5) * 16 + j];
            ridx[(unsigned)(tok * 128 + h * 16 + 8 * hh + q)] = e;
            rgate[(unsigned)(tok * 128 + h * 16 + 8 * hh + q)] = gv;
        }
        asm volatile("s_waitcnt lgkmcnt(0)" ::: "memory");
    }
}

DI void unpack_h2(const bf16_t* __restrict__ hA, int t, int lane, f32x2 (&hv)[8]) {
    const int tile = t >> 7, row = t & 127, mb = row >> 5, r5 = row & 31;
    const bf16_t* hp = hA + ((unsigned)(((tile * 64 + lane) * 4 + mb) * 64 + r5)) * 8;
    const u32x4 ha = *(const u32x4*)hp, hb = *(const u32x4*)(hp + 32 * 8);
    const unsigned hw[8] = {ha.x, ha.y, ha.z, ha.w, hb.x, hb.y, hb.z, hb.w};
#pragma unroll
    for (int q = 0; q < 8; ++q) { hv[q].x = __uint_as_float(hw[q] << 16); hv[q].y = __uint_as_float(hw[q] & 0xffff0000u); }
}
constexpr int PL_SEID = 0, PL_SWGT = 32768, PL_END = 98304;
typedef _Float16 h16x2 __attribute__((ext_vector_type(2)));
DI h16x2 fp4h(unsigned w, int sel) {
    return sel == 0 ? __builtin_amdgcn_cvt_scalef32_pk_f16_fp4(w, 1.0f, 0) : sel == 1 ? __builtin_amdgcn_cvt_scalef32_pk_f16_fp4(w, 1.0f, 1)
         : sel == 2 ? __builtin_amdgcn_cvt_scalef32_pk_f16_fp4(w, 1.0f, 2) : __builtin_amdgcn_cvt_scalef32_pk_f16_fp4(w, 1.0f, 3);
}
DI void stage_token(const int* __restrict__ ridx, const float* __restrict__ rgate, char* lds, int t, int tloc, int lane) {
    lane = opaque_v(lane); t = opaque_s(t);
    unsigned short* seid = (unsigned short*)(lds + PL_SEID) + tloc * 128;
    float* swgt = (float*)(lds + PL_SWGT) + tloc * 128;
    seid[lane] = (unsigned short)ridx[(unsigned)(t * 128 + lane)]; seid[64 + lane] = (unsigned short)ridx[(unsigned)(t * 128 + 64 + lane)];
    swgt[lane] = rgate[(unsigned)(t * 128 + lane)]; swgt[64 + lane] = rgate[(unsigned)(t * 128 + 64 + lane)];
}
DI void peer_down_wave(const bf16_t* __restrict__ hA, char* lds, const unsigned char* __restrict__ TBd, const float* __restrict__ SC, int tile, int w, int lane) {
    lane = opaque_v(lane);
    const int myu = ((lane >> 5) & 1) * 8 + ((lane >> 4) & 1) * 4 + ((lane >> 3) & 1) * 2 + ((lane >> 2) & 1);
#pragma unroll 1
    for (int tl = 0; tl < 16; ++tl) {
        const int tloc = w * 16 + tl, t = tile * 128 + tloc;
        const unsigned short* ip = (const unsigned short*)(lds + PL_SEID) + tloc * 128;
        float* gp = (float*)(lds + PL_SWGT) + tloc * 128;
        const int row = t & 127, mb = row >> 5, r5 = row & 31;
        const bf16_t* hp = hA + (unsigned)(t * 1024 + lane * 16);
        const u32x4 ha = *(const u32x4*)hp, hb = *(const u32x4*)(hp + 8);
        unsigned hhi[2], hlo[2];
        float hscale;
        {
            const unsigned hw[8] = {ha.x, ha.y, ha.z, ha.w, hb.x, hb.y, hb.z, hb.w};
            float hf[16];
            float m = 0.f;
#pragma unroll
            for (int q = 0; q < 8; ++q) { hf[2 * q] = __uint_as_float(hw[q] << 16); hf[2 * q + 1] = __uint_as_float(hw[q] & 0xffff0000u); m = fmaxf(m, fmaxf(fabsf(hf[2 * q]), fabsf(hf[2 * q + 1]))); }
#pragma unroll
            for (int o = 1; o < 64; o <<= 1) m = fmaxf(m, __shfl_xor(m, o));
            hscale = m > 0.f ? m * (1.f / 119.f) : 1.f;
            const float inv = 1.f / hscale;
            hhi[0] = hhi[1] = hlo[0] = hlo[1] = 0u;
#pragma unroll
            for (int e = 0; e < 16; ++e) {
                const int hq = __float2int_rn(hf[e] * inv);
                const int lo = ((hq + 8) & 15) - 8, hi = (hq - lo) >> 4;
                hlo[e >> 3] |= ((unsigned)lo & 15u) << (4 * (e & 7));
                hhi[e >> 3] |= ((unsigned)hi & 15u) << (4 * (e & 7));
            }
        }
#pragma unroll 1
        for (int c0 = 0; c0 < 128; c0 += 64) {
            const int ev = ip[c0 + lane];
#pragma unroll 1
            for (int p = 0; p < 64; p += 16) {
                u32x2 dr[16];
#pragma unroll
                for (int u = 0; u < 16; ++u) {
                    const int e = __builtin_amdgcn_readlane(ev, p + u);
                    dr[u] = *(const u32x2*)(TBd + (size_t)(unsigned)e * 512 + lane * 8);
                }
                const int me = __shfl(ev, p + myu);
                const f32x2 scv = *(const f32x2*)(SC + (unsigned)me * 2);
                int part[16];
#pragma unroll
                for (int u = 0; u < 16; ++u) {
                    int shi = __builtin_amdgcn_sdot8((int)dr[u].x, (int)hhi[0], 0, false);
                    shi = __builtin_amdgcn_sdot8((int)dr[u].y, (int)hhi[1], shi, false);
                    int slo = __builtin_amdgcn_sdot8((int)dr[u].x, (int)hlo[0], 0, false);
                    slo = __builtin_amdgcn_sdot8((int)dr[u].y, (int)hlo[1], slo, false);
                    part[u] = shi * 16 + slo;
                }
                int r8[8], r4[4], r2[2], r1;
                {
                    const bool b5 = (lane & 32) != 0, b4 = (lane & 16) != 0, b3 = (lane & 8) != 0, b2 = (lane & 4) != 0;
#pragma unroll
                    for (int q = 0; q < 8; ++q) { const int keep = b5 ? part[q + 8] : part[q], give = b5 ? part[q] : part[q + 8]; r8[q] = keep + __shfl_xor(give, 32); }
#pragma unroll
                    for (int q = 0; q < 4; ++q) { const int keep = b4 ? r8[q + 4] : r8[q], give = b4 ? r8[q] : r8[q + 4]; r4[q] = keep + __shfl_xor(give, 16); }
#pragma unroll
                    for (int q = 0; q < 2; ++q) { const int keep = b3 ? r4[q + 2] : r4[q], give = b3 ? r4[q] : r4[q + 2]; r2[q] = keep + __shfl_xor(give, 8); }
                    { const int keep = b2 ? r2[1] : r2[0], give = b2 ? r2[0] : r2[1]; r1 = keep + __shfl_xor(give, 4); }
                    r1 += __shfl_xor(r1, 2); r1 += __shfl_xor(r1, 1);
                }
                if ((lane & 3) == 0) {
                    const float a = (float)r1 * (scv.x * hscale);
                    gp[c0 + p + myu] = gp[c0 + p + myu] * (0.5f * a * (1.f + erff(a * 0.70710678118654752f))) * scv.y;
                }
            }
        }
    }
}
DI void peer_up_wave(char* lds, const unsigned char* __restrict__ TBu, const float* __restrict__ g2b, float* __restrict__ x, int tile, int w, int lane) {
    lane = opaque_v(lane);
    for (int r = 0; r < 2; ++r) {
        h16x2 acc[8][8];
#pragma unroll
        for (int k = 0; k < 8; ++k)
#pragma unroll
            for (int q = 0; q < 8; ++q) acc[k][q] = (h16x2){(_Float16)0.f, (_Float16)0.f};
#pragma unroll
        for (int k = 0; k < 8; ++k) {
            const int tloc = w * 16 + r * 8 + k;
            const unsigned short* ip = (const unsigned short*)(lds + PL_SEID) + tloc * 128;
            const float* gp = (const float*)(lds + PL_SWGT) + tloc * 128;
    #pragma unroll 1
        for (int c0 = 0; c0 < 128; c0 += 64) {
                const int ev = ip[c0 + lane];
                const float wl = gp[c0 + lane];
    #pragma unroll 1
            for (int p = 0; p < 64; p += 16) {
                    u32x2 ur[16];
#pragma unroll
                    for (int u = 0; u < 16; ++u) {
                        const int e = __builtin_amdgcn_readlane(ev, p + u);
                        ur[u] = *(const u32x2*)(TBu + (size_t)(unsigned)e * 512 + lane * 8);
                    }
#pragma unroll
                    for (int u = 0; u < 16; ++u) {
                        const _Float16 wh = (_Float16)__int_as_float(__builtin_amdgcn_readlane(__float_as_int(wl), p + u));
                        const h16x2 w2 = (h16x2){wh, wh};
#pragma unroll
                        for (int q = 0; q < 4; ++q) { acc[k][q] = __builtin_elementwise_fma(w2, fp4h(ur[u].x, q), acc[k][q]); acc[k][4 + q] = __builtin_elementwise_fma(w2, fp4h(ur[u].y, q), acc[k][4 + q]); }
                    }
                }
            }
        }
#pragma unroll
        for (int k = 0; k < 8; ++k) {
            const int t = tile * 128 + w * 16 + r * 8 + k;
            float4* xp = (float4*)(x + (size_t)t * D + lane * 16);
            const float4* gq = (const float4*)(g2b + lane * 16);
            float ssx = 0.f;
#pragma unroll
            for (int q = 0; q < 4; ++q) {
                float4 xv = xp[q]; const float4 gv = gq[q];
                xv.x += gv.x * (float)acc[k][2 * q].x; xv.y += gv.y * (float)acc[k][2 * q].y; xv.z += gv.z * (float)acc[k][2 * q + 1].x; xv.w += gv.w * (float)acc[k][2 * q + 1].y;
                xp[q] = xv;
                ssx += xv.x * xv.x + xv.y * xv.y + xv.z * xv.z + xv.w * xv.w;
            }
            ssx = wave_sum(ssx);
            if (lane == 0) ((float*)(lds + LDS_RSTD1))[w * 16 + r * 8 + k] = rsqrtf(ssx * (1.f / D) + EPS);
        }
    }
}

DI void epi_qk(f32x16 (&acc)[4][2], const float* __restrict__ gain, float scale, bf16_t* __restrict__ dst, int lane) {
    lane = opaque_v(lane);
    const int hh = lane >> 5;
    float gv[2][16];
#pragma unroll
    for (int nb = 0; nb < 2; ++nb)
#pragma unroll
        for (int i = 0; i < 16; ++i) gv[nb][i] = gain[nb * 32 + (i & 3) + 8 * (i >> 2) + 4 * hh] * scale;
#pragma unroll
    for (int mb = 0; mb < 4; ++mb) {
        float ss = 0.f;
#pragma unroll
        for (int nb = 0; nb < 2; ++nb)
#pragma unroll
            for (int i = 0; i < 16; ++i) ss += acc[mb][nb][i] * acc[mb][nb][i];
        ss += __shfl_xor(ss, 32);
        const float r = rsqrtf(ss * (1.f / 64.f) + EPS);
#pragma unroll
        for (int nb = 0; nb < 2; ++nb)
#pragma unroll
            for (int s = 0; s < 2; ++s) {
                const f32x16& a = acc[mb][nb];
                u32x4 o;
                o.x = pk2(a[8 * s] * r * gv[nb][8 * s], a[8 * s + 1] * r * gv[nb][8 * s + 1]);
                o.y = pk2(a[8 * s + 2] * r * gv[nb][8 * s + 2], a[8 * s + 3] * r * gv[nb][8 * s + 3]);
                o.z = pk2(a[8 * s + 4] * r * gv[nb][8 * s + 4], a[8 * s + 5] * r * gv[nb][8 * s + 5]);
                o.w = pk2(a[8 * s + 6] * r * gv[nb][8 * s + 6], a[8 * s + 7] * r * gv[nb][8 * s + 7]);
                *(u32x4*)(dst + ((unsigned)(((nb * 2 + s) * 4 + mb) * 64 + lane)) * 8) = o;
            }
    }
}
DI void epi_v(const f32x16 (&acc)[4][2], bf16_t* __restrict__ dst, int lane) {
    lane = opaque_v(lane);
#pragma unroll
    for (int nb = 0; nb < 2; ++nb)
#pragma unroll
        for (int mb = 0; mb < 4; ++mb)
#pragma unroll
            for (int s = 0; s < 2; ++s) {
                const f32x16& a = acc[mb][nb];
                u32x4 o; o.x = pk2(a[8 * s], a[8 * s + 1]); o.y = pk2(a[8 * s + 2], a[8 * s + 3]); o.z = pk2(a[8 * s + 4], a[8 * s + 5]); o.w = pk2(a[8 * s + 6], a[8 * s + 7]);
                *(u32x4*)(dst + ((unsigned)(((nb * 4 + mb) * 2 + s) * 64 + lane)) * 8) = o;
            }
}
DI void epi_row(const f32x16 (&acc)[4][2], bf16_t* __restrict__ dst, int ld, int lane) {
    lane = opaque_v(lane);
    const int r5 = lane & 31, hh = lane >> 5;
#pragma unroll
    for (int mb = 0; mb < 4; ++mb)
#pragma unroll
        for (int nb = 0; nb < 2; ++nb)
#pragma unroll
            for (int gq = 0; gq < 4; ++gq) {
                const f32x16& a = acc[mb][nb];
                u32x2 o; o.x = pk2(a[4 * gq], a[4 * gq + 1]); o.y = pk2(a[4 * gq + 2], a[4 * gq + 3]);
                *(u32x2*)(dst + (unsigned)((mb * 32 + r5) * ld + nb * 32 + 8 * gq + 4 * hh)) = o;
            }
}
DI void epi_z(const f32x16 (&acc)[4][2], bf16_t* __restrict__ dst, int lane) {
    lane = opaque_v(lane);
    const int r5 = lane & 31, hh = lane >> 5;
#pragma unroll
    for (int mb = 0; mb < 4; ++mb)
#pragma unroll
        for (int gq = 0; gq < 4; ++gq) {
            const f32x16 &a = acc[mb][0], &b = acc[mb][1];
            u32x2 o; o.x = pk2(a[4 * gq] * b[4 * gq], a[4 * gq + 1] * b[4 * gq + 1]); o.y = pk2(a[4 * gq + 2] * b[4 * gq + 2], a[4 * gq + 3] * b[4 * gq + 3]);
            *(u32x2*)(dst + (unsigned)((mb * 32 + r5) * 256 + 8 * gq + 4 * hh)) = o;
        }
}
DI void epi_su_park(const f32x16 (&acc)[4][2], unsigned* lds_su, int lane) {
    lane = opaque_v(lane);
#pragma unroll
    for (int mb = 0; mb < 4; ++mb)
#pragma unroll
        for (int nb = 0; nb < 2; ++nb)
#pragma unroll
            for (int q = 0; q < 8; ++q) lds_su[((mb * 2 + nb) * 8 + q) * 64 + lane] = pk2(acc[mb][nb][2 * q], acc[mb][nb][2 * q + 1]);
}
DI void epi_sv(f32x16 (&acc)[4][2], const bf16_t* __restrict__ SWF  , const float* __restrict__ bs_g, const unsigned* lds_su, bf16_t* __restrict__ dst, int lane) {
    lane = opaque_v(lane);
    const int r5 = lane & 31, hh = lane >> 5;
    bf16x8 vb[4][2][2];
#pragma unroll
    for (int mb = 0; mb < 4; ++mb) {
#pragma unroll
        for (int i = 0; i < 16; ++i) {
            float s1 = acc[mb][0][i] + acc[mb][1][i];
#pragma unroll
            for (int o = 1; o < 32; o <<= 1) s1 += __shfl_xor(s1, o);
            const float mu = s1 * (1.f / 64.f);
            const float d0 = acc[mb][0][i] - mu, d1 = acc[mb][1][i] - mu;
            float s2 = d0 * d0 + d1 * d1;
#pragma unroll
            for (int o = 1; o < 32; o <<= 1) s2 += __shfl_xor(s2, o);
            const float r = rsqrtf(s2 * (1.f / 64.f) + EPS);
            acc[mb][0][i] = d0 * r; acc[mb][1][i] = d1 * r;
        }
#pragma unroll
        for (int s = 0; s < 2; ++s)
#pragma unroll
            for (int nb = 0; nb < 2; ++nb) {
                const f32x16& a = acc[mb][nb];
                u32x4 o; o.x = pk2(a[8 * s], a[8 * s + 1]); o.y = pk2(a[8 * s + 2], a[8 * s + 3]); o.z = pk2(a[8 * s + 4], a[8 * s + 5]); o.w = pk2(a[8 * s + 6], a[8 * s + 7]);
                vb[mb][s][nb] = __builtin_bit_cast(bf16x8, o);
            }
    }
#pragma unroll
    for (int tb = 0; tb < 4; ++tb) {
        f32x16 y[2];
#pragma unroll
        for (int nb = 0; nb < 2; ++nb)
#pragma unroll
            for (int i = 0; i < 16; ++i) y[nb][i] = 0.f;
#pragma unroll
        for (int kt = 0; kt <= tb; ++kt)
#pragma unroll
            for (int s = 0; s < 2; ++s) {
                const bf16x8 wa = *(const bf16x8*)(SWF + ((unsigned)(((tb * 4 + kt) * 2 + s) * 64 + lane)) * 8);
                y[0] = MFMA32(wa, vb[kt][s][0], y[0]);
                y[1] = MFMA32(wa, vb[kt][s][1], y[1]);
            }
#pragma unroll
        for (int nb = 0; nb < 2; ++nb)
#pragma unroll
            for (int q = 0; q < 8; ++q) {
                const unsigned su2 = lds_su[((tb * 2 + nb) * 8 + q) * 64 + lane];
                const int i0 = 2 * q, i1 = 2 * q + 1;
                const int t0 = tb * 32 + (i0 & 3) + 8 * (i0 >> 2) + 4 * hh, t1 = tb * 32 + (i1 & 3) + 8 * (i1 >> 2) + 4 * hh;
                const float v0 = (y[nb][i0] + bs_g[t0]) * __uint_as_float(su2 << 16), v1 = (y[nb][i1] + bs_g[t1]) * __uint_as_float(su2 & 0xffff0000u);
                const unsigned pk = pk2(v0, v1);
                dst[(unsigned)(t0 * 256 + nb * 32 + r5)] = (bf16_t)(pk & 0xffffu);
                dst[(unsigned)(t1 * 256 + nb * 32 + r5)] = (bf16_t)(pk >> 16);
            }
    }
}

DI void conv_sguw_item(const float* __restrict__ W, bf16_t* __restrict__ SWF, int gid) {
    const int lane = gid & 63, s = (gid >> 6) & 1, kt = (gid >> 7) & 3, tb = (gid >> 9) & 3, g = gid >> 11;
    const int r = lane & 31, hh = lane >> 5, t = tb * 32 + r;
    const float* p = W + ((size_t)g * 128 + t) * 128;
    float v[8];
#pragma unroll
    for (int j = 0; j < 8; ++j) { const int sp = kt * 32 + 16 * s + 8 * (j >> 2) + 4 * hh + (j & 3); v[j] = sp <= t ? p[sp] : 0.f; }
    u32x4 o; o.x = pk2(v[0], v[1]); o.y = pk2(v[2], v[3]); o.z = pk2(v[4], v[5]); o.w = pk2(v[6], v[7]);
    *(u32x4*)(SWF + (size_t)gid * 8) = o;
}

DI int t5_bucket(int d) {
    if (d < 16) return d;
    const float lr = logf((float)d / 16.f) / logf(8.f);
    const int large = 16 + (int)(lr * 16.f);
    return large < 31 ? large : 31;
}

DI void attn_tile(const bf16_t* __restrict__ QF, const bf16_t* __restrict__ KF2, const bf16_t* __restrict__ VF, const float* bias_lds, const float* __restrict__ sink, bf16_t* __restrict__ OR, int tile, int tid) {
    tid = opaque_v(tid); tile = opaque_s(tile);
    const int lane = tid & 63, w = __builtin_amdgcn_readfirstlane(tid >> 6), r5 = lane & 31, hh = lane >> 5;
    const bool has_prev = (tile & 31) != 0;
    for (int task = w; task < 32; task += 8) {
        const int qh = task >> 2, qt = task & 3, kvh = qh >> 2;
        bf16x8 bq[4];
#pragma unroll
        for (int ks = 0; ks < 4; ++ks) bq[ks] = *(const bf16x8*)(QF + ((unsigned)((((tile * 8 + qh) * 4 + ks) * 4 + qt) * 64 + lane)) * 8);
        f32x16 sc[5];
#pragma unroll
        for (int grp = 0; grp < 2; ++grp) {
            bf16x8 kf[3][4];
#pragma unroll
            for (int jq = 0; jq < 3; ++jq) if (grp * 3 + jq < 5) {
                const int jj = grp * 3 + jq, j = qt + jj, st = (j >= 4 || !has_prev) ? tile : tile - 1, kt = j & 3;
#pragma unroll
                for (int ks = 0; ks < 4; ++ks) kf[jq][ks] = *(const bf16x8*)(KF2 + ((unsigned)((((st * 2 + kvh) * 4 + ks) * 4 + kt) * 64 + lane)) * 8);
            }
#pragma unroll
            for (int jq = 0; jq < 3; ++jq) if (grp * 3 + jq < 5) {
                const int jj = grp * 3 + jq;
#pragma unroll
                for (int i = 0; i < 16; ++i) sc[jj][i] = 0.f;
#pragma unroll
                for (int ks = 0; ks < 4; ++ks) sc[jj] = MFMA32(kf[jq][ks], bq[ks], sc[jj]);
            }
            __builtin_amdgcn_sched_barrier(0);
        }
        bf16x8 vf[5][2][2];
#pragma unroll
        for (int jj = 0; jj < 2; ++jj) {
            const int j = qt + jj, st = (j >= 4 || !has_prev) ? tile : tile - 1, kt = j & 3;
#pragma unroll
            for (int s2 = 0; s2 < 2; ++s2)
#pragma unroll
                for (int dt = 0; dt < 2; ++dt) vf[jj][s2][dt] = *(const bf16x8*)(VF + ((unsigned)(((((st * 2 + kvh) * 2 + dt) * 4 + kt) * 2 + s2) * 64 + lane)) * 8);
        }
        const float* bl = bias_lds + qh * 128;
        float m = -1e30f;
#pragma unroll
        for (int jj = 0; jj < 5; ++jj) {
            const bool ex = (qt + jj >= 4) || has_prev;
#pragma unroll
            for (int i = 0; i < 16; ++i) {
                const int cr = (i & 3) + 8 * (i >> 2) + 4 * hh;
                const int dist = 128 + r5 - 32 * jj - cr;
                const bool valid = ex && dist >= 0 && dist < 128;
                const float v = valid ? sc[jj][i] + bl[dist & 127] : -1e30f;
                sc[jj][i] = v; m = fmaxf(m, v);
            }
        }
        m = fmaxf(m, __shfl_xor(m, 32));
        const float sk = sink[qh];
        m = fmaxf(m, sk);
        float l = 0.f;
#pragma unroll
        for (int jj = 0; jj < 5; ++jj)
#pragma unroll
            for (int i = 0; i < 16; ++i) { const float p = __expf(sc[jj][i] - m); sc[jj][i] = p; l += p; }
        l += __shfl_xor(l, 32);
        l += __expf(sk - m);
        const float rl = 1.f / l;
        f32x16 o[2];
#pragma unroll
        for (int dt = 0; dt < 2; ++dt)
#pragma unroll
            for (int i = 0; i < 16; ++i) o[dt][i] = 0.f;
        __builtin_amdgcn_sched_barrier(0);
#pragma unroll
        for (int jj = 2; jj < 5; ++jj) {
            const int j = qt + jj, st = (j >= 4 || !has_prev) ? tile : tile - 1, kt = j & 3;
#pragma unroll
            for (int s2 = 0; s2 < 2; ++s2)
#pragma unroll
                for (int dt = 0; dt < 2; ++dt) vf[jj][s2][dt] = *(const bf16x8*)(VF + ((unsigned)(((((st * 2 + kvh) * 2 + dt) * 4 + kt) * 2 + s2) * 64 + lane)) * 8);
        }
#pragma unroll
        for (int jj = 0; jj < 5; ++jj) {
#pragma unroll
            for (int s = 0; s < 2; ++s) {
                const f32x16& a = sc[jj];
                u32x4 pp; pp.x = pk2(a[8 * s], a[8 * s + 1]); pp.y = pk2(a[8 * s + 2], a[8 * s + 3]); pp.z = pk2(a[8 * s + 4], a[8 * s + 5]); pp.w = pk2(a[8 * s + 6], a[8 * s + 7]);
                const bf16x8 pb = __builtin_bit_cast(bf16x8, pp);
#pragma unroll
                for (int dt = 0; dt < 2; ++dt) o[dt] = MFMA32(vf[jj][s][dt], pb, o[dt]);
            }
        }
        bf16_t* orow = OR + (unsigned)((tile * 128 + qt * 32 + r5) * 512 + qh * 64 + 4 * hh);
#pragma unroll
        for (int dt = 0; dt < 2; ++dt)
#pragma unroll
            for (int gq = 0; gq < 4; ++gq) {
                u32x2 ov; ov.x = pk2(o[dt][4 * gq] * rl, o[dt][4 * gq + 1] * rl); ov.y = pk2(o[dt][4 * gq + 2] * rl, o[dt][4 * gq + 3] * rl);
                *(u32x2*)(orow + dt * 32 + 8 * gq) = ov;
            }
    }
}

DI void unpack8(const u32x4 v, float (&f)[8]) {
    f[0] = __uint_as_float(v.x << 16); f[1] = __uint_as_float(v.x & 0xffff0000u); f[2] = __uint_as_float(v.y << 16); f[3] = __uint_as_float(v.y & 0xffff0000u);
    f[4] = __uint_as_float(v.z << 16); f[5] = __uint_as_float(v.z & 0xffff0000u); f[6] = __uint_as_float(v.w << 16); f[7] = __uint_as_float(v.w & 0xffff0000u);
}
DI void merge_tile(const bf16_t* __restrict__ OR, const bf16_t* __restrict__ CBR, const bf16_t* __restrict__ ZR, const bf16_t* __restrict__ YS, const float* __restrict__ cw  , const float* __restrict__ og  ,
                   bf16_t* __restrict__ mA, int tile, int tid) {
    tid = opaque_v(tid); tile = opaque_s(tile);
    const int lane = tid & 63, w = tid >> 6;
#pragma unroll 4
    for (int rr = 0; rr < 16; ++rr) {
        const int row = w * 16 + rr, t = tile * 128 + row, pos = t & (S - 1);
        float a[8], y[8];
        unpack8(*(const u32x4*)(OR + (unsigned)(t * 512 + lane * 8)), a);
        float ssa = 0.f;
#pragma unroll
        for (int q = 0; q < 8; ++q) ssa += a[q] * a[q];
        ssa = wave_sum(ssa);
        if (lane < 32) {
            const int c0 = lane * 8;
            float cb[8], z0[8], z1[8], z2[8];
            unpack8(*(const u32x4*)(CBR + (unsigned)(t * 256 + c0)), cb);
            unpack8(*(const u32x4*)(ZR + (unsigned)(t * 256 + c0)), z2);
            if (pos >= 1) unpack8(*(const u32x4*)(ZR + (unsigned)((t - 1) * 256 + c0)), z1); else { _Pragma("unroll") for (int q = 0; q < 8; ++q) z1[q] = 0.f; }
            if (pos >= 2) unpack8(*(const u32x4*)(ZR + (unsigned)((t - 2) * 256 + c0)), z0); else { _Pragma("unroll") for (int q = 0; q < 8; ++q) z0[q] = 0.f; }
#pragma unroll
            for (int q = 0; q < 8; ++q) y[q] = cb[q] * (cw[c0 + q] * z0[q] + cw[256 + c0 + q] * z1[q] + cw[512 + c0 + q] * z2[q]);
        } else {
            unpack8(*(const u32x4*)(YS + (unsigned)(t * 256 + (lane - 32) * 8)), y);
        }
        float ssy = 0.f;
#pragma unroll
        for (int q = 0; q < 8; ++q) ssy += y[q] * y[q];
#pragma unroll
        for (int o = 1; o < 32; o <<= 1) ssy += __shfl_xor(ssy, o);
        const float ra = rsqrtf(ssa * (1.f / 512.f) + EPS), ry = rsqrtf(ssy * (1.f / 256.f) + EPS);
        const int mb = row >> 5, r5 = row & 31;
        {
            const float4 g0 = *(const float4*)(og + lane * 8), g1 = *(const float4*)(og + lane * 8 + 4);
            u32x4 o; o.x = pk2(a[0] * ra * g0.x, a[1] * ra * g0.y); o.y = pk2(a[2] * ra * g0.z, a[3] * ra * g0.w); o.z = pk2(a[4] * ra * g1.x, a[5] * ra * g1.y); o.w = pk2(a[6] * ra * g1.z, a[7] * ra * g1.w);
            const int c8 = lane;
            (void)c8;
            *(u32x4*)(mA + (unsigned)(t * 1024 + lane * 8)) = o;
        }
        {
            const float4 g0 = *(const float4*)(og + 512 + lane * 8), g1 = *(const float4*)(og + 512 + lane * 8 + 4);
            u32x4 o; o.x = pk2(y[0] * ry * g0.x, y[1] * ry * g0.y); o.y = pk2(y[2] * ry * g0.z, y[3] * ry * g0.w); o.z = pk2(y[4] * ry * g1.x, y[5] * ry * g1.y); o.w = pk2(y[6] * ry * g1.z, y[7] * ry * g1.w);
            const int c8 = 64 + lane;
            (void)c8;
            *(u32x4*)(mA + (unsigned)(t * 1024 + 512 + lane * 8)) = o;
        }
    }
}

struct InProjOut { bf16_t *QF, *KF2, *VF, *CBR, *ZR, *YS; };
DI void inproj_tile(const bf16_t* __restrict__ At, const bf16_t* __restrict__ WF, const float* __restrict__ qg, const float* __restrict__ kg, const bf16_t* __restrict__ SWF, const float* __restrict__ sgu_b,
                    const InProjOut& O, char* lds, int tile, int tid) {
    tid = opaque_v(tid); tile = opaque_s(tile);
    const int lane = tid & 63, w = __builtin_amdgcn_readfirstlane(tid >> 6);
    f32x16 acc[4][2];
    {
        const int nbt0 = w * 2;
        kloop<1>(acc, At, WF + (size_t)nbt0 * 32768, WF + (size_t)(nbt0 + 1) * 32768, lds, tid, lane);
        epi_qk(acc, qg, 0.125f, O.QF + (size_t)(tile * 8 + w) * 8192, lane);
    }
    {
        const int nbt0 = 16 + w * 2;
        if (w == 2 || w == 3) {
            kloop<0>(acc, At, WF + (size_t)nbt0 * 32768, WF + (size_t)(nbt0 + 1) * 32768, lds, tid, lane);
            epi_v(acc, O.VF + (size_t)(tile * 2 + (w - 2)) * 8192, lane);
        } else {
            kloop<1>(acc, At, WF + (size_t)nbt0 * 32768, WF + (size_t)(nbt0 + 1) * 32768, lds, tid, lane);
            if (w < 2) epi_qk(acc, kg, 1.f, O.KF2 + (size_t)(tile * 2 + w) * 8192, lane);
            else epi_row(acc, O.CBR + (size_t)tile * 128 * 256 + (w - 4) * 64, 256, lane);
        }
    }
    {
        const int nbt0 = 32 + w * 2;
        kloop<1>(acc, At, WF + (size_t)nbt0 * 32768, WF + (size_t)(nbt0 + 1) * 32768, lds, tid, lane);
        epi_z(acc, O.ZR + (size_t)tile * 128 * 256 + w * 32, lane);
    }
    {
        const int nbt0 = 48 + w * 2;
        kloop<0>(acc, At, WF + (size_t)nbt0 * 32768, WF + (size_t)(nbt0 + 1) * 32768, lds, tid, lane);
        unsigned* lds_su = (unsigned*)lds;
        if (w < 4) epi_su_park(acc, lds_su + w * 4096, lane);
        __syncthreads();
        if (w >= 4) epi_sv(acc, SWF + (size_t)(w - 4) * 16384, sgu_b + (w - 4) * 128, lds_su + (w - 4) * 4096, O.YS + (size_t)tile * 128 * 256 + (w - 4) * 64, lane);
        __syncthreads();
    }
}


struct Params {
    const float *x, *c, *rel_bias, *w_ada, *b_ada, *norm1_g, *norm2_g, *w_in, *q_norm_g, *k_norm_g, *attn_sink, *conv_w, *sgu_w, *sgu_b, *out_norm_g, *w_out, *peer_wq, *peer_sub_keys, *peer_down, *peer_up;
    float* out;
    char* ws;
};
constexpr size_t MiB = 1u << 20;
constexpr size_t WS_MOD = 0;
constexpr size_t WS_MODP = 1 * MiB;
constexpr size_t WS_WIN = 13 * MiB;
constexpr size_t WS_WOUT = 29 * MiB;
constexpr size_t WS_WPQ = 37 * MiB;
constexpr size_t WS_KEYS = 53 * MiB;
constexpr size_t WS_SWF = 55 * MiB;
constexpr size_t WS_SC = 56 * MiB;
constexpr size_t WS_TB = 57 * MiB;
constexpr size_t WS_HA = 185 * MiB;
constexpr size_t WS_QF = 249 * MiB;
constexpr size_t WS_KF2 = 602 * MiB;
constexpr size_t WS_VF = 634 * MiB;
constexpr size_t WS_ZR = 666 * MiB;
constexpr size_t WS_CBR = 345 * MiB;
constexpr size_t WS_YS = 361 * MiB;
constexpr size_t WS_OR = 377 * MiB;
constexpr size_t WS_QPF = 409 * MiB;
constexpr size_t WS_RIDX = 537 * MiB;
constexpr size_t WS_RGATE = 553 * MiB;
constexpr size_t WS_SEID = 569 * MiB;
constexpr size_t WS_SWGT = 585 * MiB;
constexpr size_t WS_OFFS = 601 * MiB;
constexpr size_t WS_FLAGS = 601 * MiB + 512 * 1024;
constexpr size_t WS_END = 730 * MiB;
static_assert(PL_END <= LDS_RSTD1, "expert-phase lists overlap persistent LDS state");

__global__ __launch_bounds__(512) void hybrid_fwd(Params P) {
    extern __shared__ __attribute__((aligned(16))) char lds[];
    cg::grid_group grid = cg::this_grid();
    const int tid = threadIdx.x, lane = tid & 63, w = __builtin_amdgcn_readfirstlane(tid >> 6);
    const int nblk = gridDim.x, bid = blockIdx.x;
    char* ws = P.ws;
    float* mod = (float*)(ws + WS_MOD);
    float* modp = (float*)(ws + WS_MODP);
    bf16_t* WinF = (bf16_t*)(ws + WS_WIN); bf16_t* WoutF = (bf16_t*)(ws + WS_WOUT); bf16_t* WpqF = (bf16_t*)(ws + WS_WPQ);
    bf16_t* KeysF = (bf16_t*)(ws + WS_KEYS); bf16_t* SWF = (bf16_t*)(ws + WS_SWF);
    float* SC = (float*)(ws + WS_SC); unsigned char* TBd = (unsigned char*)(ws + WS_TB); unsigned char* TBu = TBd + 32 * MiB;
    bf16_t* hA = (bf16_t*)(ws + WS_HA);
    bf16_t* OR = (bf16_t*)(ws + WS_OR); bf16_t* QPF = (bf16_t*)(ws + WS_QPF);
    int* ridx = (int*)(ws + WS_RIDX); float* rgate = (float*)(ws + WS_RGATE);
    float* bias_lds = (float*)(lds + LDS_BIAS);
    unsigned* flags = (unsigned*)(ws + WS_FLAGS);

    {
        float* ca = (float*)lds;
        for (int i = tid; i < 8192; i += 512) { const float v = P.c[i]; ca[i] = v / (1.f + __expf(-v)); }
        for (int i = tid; i < 1024; i += 512) bias_lds[i] = P.rel_bias[t5_bucket(i & 127) * 8 + (i >> 7)];
        __syncthreads();
        for (int it = bid; it < 768; it += nblk) {
            const int jc = it % 12, l = (it / 12) & 3, ks = it / 48;
            const int j = jc * 512 + tid;
            const float* wp = P.w_ada + ((size_t)l * 1024 + ks * 64) * 6144 + j;
            float acc[8];
#pragma unroll
            for (int b = 0; b < 8; ++b) acc[b] = 0.f;
#pragma unroll 4
            for (int i = 0; i < 64; ++i) {
                const float wv = wp[(size_t)i * 6144];
#pragma unroll
                for (int b = 0; b < 8; ++b) acc[b] += ca[b * 1024 + ks * 64 + i] * wv;
            }
#pragma unroll
            for (int b = 0; b < 8; ++b) modp[((size_t)(ks * 4 + l) * 8 + b) * 6144 + j] = acc[b];
        }
        const int gthreads = nblk * 512, gtid = bid * 512 + tid;
        for (int rep = 0; rep < REP_P0; ++rep)
        for (int l = 0; l < DEPTH; ++l) {
            for (int g = gtid; g < 64 * 64 * 64; g += gthreads) conv_wfrag_item(P.w_in + (size_t)l * 1024 * 2048, 2048, 64, WinF + (size_t)l * 2097152, g, 1);
            for (int g = gtid; g < 32 * 64 * 64; g += gthreads) conv_wfrag_item(P.w_out + (size_t)l * 1024 * 1024, 1024, 64, WoutF + (size_t)l * 1048576, g, 0);
            for (int g = gtid; g < 64 * 64 * 64; g += gthreads) conv_wfrag_item(P.peer_wq + (size_t)l * 1024 * 2048, 2048, 64, WpqF + (size_t)l * 2097152, g, 0);
            for (int g = gtid; g < 32768; g += gthreads) conv_keys_item(P.peer_sub_keys + (size_t)l * 262144, KeysF + (size_t)l * 262144, g);
            for (int g = gtid; g < 8192; g += gthreads) conv_sguw_item(P.sgu_w + (size_t)l * 65536, SWF + (size_t)l * 65536, g);
        }
        const int gwaves = nblk * 8, gw = bid * 8 + w;
        for (int rep = 0; rep < REP_P0; ++rep)
        for (int r = gw; r < DEPTH * 16384 * 2; r += gwaves) {
            const int which = r & 1, le = r >> 1;
            conv_table_row((which ? P.peer_up : P.peer_down) + (size_t)le * D, (which ? TBu : TBd) + (size_t)le * 512, SC + (size_t)le * 2 + which, lane, which == 0);
        }
    }
    grid.sync();
    for (int tile = bid; tile < NTILE; tile += nblk) {
        const int b = tile >> 5;
        for (int l = 0; l < DEPTH; ++l)
            for (int j = tid; j < 6144; j += 512) {
                float v = P.b_ada[l * 6144 + j];
#pragma unroll
                for (int ks = 0; ks < 16; ++ks) v += modp[((size_t)(ks * 4 + l) * 8 + b) * 6144 + j];
                mod[((size_t)l * 8 + b) * 6144 + j] = v;
            }
    }
    __syncthreads();

    for (int l = 0; l < DEPTH; ++l) {
        const float* xin = l == 0 ? P.x : P.out;
        InProjOut IO;
        IO.QF = (bf16_t*)(ws + WS_QF); IO.KF2 = (bf16_t*)(ws + WS_KF2 + (size_t)l * 8 * MiB); IO.VF = (bf16_t*)(ws + WS_VF + (size_t)l * 8 * MiB);
        IO.CBR = (bf16_t*)(ws + WS_CBR); IO.ZR = (bf16_t*)(ws + WS_ZR + (size_t)l * 16 * MiB); IO.YS = (bf16_t*)(ws + WS_YS);
        for (int tile = bid; tile < NTILE; tile += nblk) {
            const float* mb_ = mod + ((size_t)l * 8 + (tile >> 5)) * 6144;
            const bool have1 = l > 0 && nblk == NTILE;
            if (have1) { if (tid < 128) ((float*)lds)[tid] = ((const float*)(lds + LDS_RSTD1))[tid]; __syncthreads(); }
            norm_to_frag(xin, P.norm1_g + l * D, mb_ + 0, mb_ + 1024, hA, (float*)lds, tile, tid, have1);
            __syncthreads();
            for (int rep = 0; rep < REP_GEMM; ++rep) inproj_tile(hA + (size_t)tile * 131072, WinF + (size_t)l * 2097152, P.q_norm_g + l * 64, P.k_norm_g + l * 64, SWF + (size_t)l * 65536, P.sgu_b + l * 512, IO, lds, tile, tid);
            asm volatile("s_waitcnt vmcnt(0)" ::: "memory");
            __syncthreads();
            if (tid == 0) {
                __builtin_amdgcn_fence(__ATOMIC_RELEASE, "agent");
                asm volatile("s_waitcnt vmcnt(0)" ::: "memory");
                __hip_atomic_store(flags + tile, (unsigned)(l + 1), __ATOMIC_RELAXED, __HIP_MEMORY_SCOPE_AGENT);
            }
        }
        for (int tile = bid; tile < NTILE; tile += nblk) {
            const float* mb_ = mod + ((size_t)l * 8 + (tile >> 5)) * 6144;
            if ((tile & 31) != 0) {
                if (tid == 0) {
                    unsigned spins = 0;
                    while (__hip_atomic_load(flags + tile - 1, __ATOMIC_RELAXED, __HIP_MEMORY_SCOPE_AGENT) < (unsigned)(l + 1) && ++spins < (1u << 24)) __builtin_amdgcn_s_sleep(2);
                    __builtin_amdgcn_fence(__ATOMIC_ACQUIRE, "agent");
                    asm volatile("s_waitcnt vmcnt(0)" ::: "memory");
                }
                __syncthreads();
            }
            for (int rep = 0; rep < REP_MIX; ++rep) {
            attn_tile(IO.QF, IO.KF2, IO.VF, bias_lds, P.attn_sink + l * 8, OR, tile, tid);
            __syncthreads();
            merge_tile(OR, IO.CBR, IO.ZR, IO.YS, P.conv_w + l * 768, P.out_norm_g + l * D, hA, tile, tid);
            __syncthreads();
            }
            {
                const bf16_t* At = hA + (size_t)tile * 131072;
                const bf16_t* WF = WoutF + (size_t)l * 1048576;
                for (int pass = 0; pass < 2; ++pass) {
                    f32x16 acc[4][2];
                    const int nbt0 = pass * 16 + w * 2;
                    kloop<0>(acc, At, WF + (size_t)nbt0 * 32768, WF + (size_t)(nbt0 + 1) * 32768, lds, tid, lane);
                    epi_resid(acc, xin, P.out, mb_ + 2048, (float*)(lds + LDS_EPI) + w * 2176, (float*)(lds + LDS_SSQ) + (pass * 8 + w) * 128, tile, pass * 512 + w * 64, lane);
                }
            }
            __syncthreads();
            if (tid < 128) { const float* sq = (const float*)(lds + LDS_SSQ); float ssum = 0.f;
#pragma unroll
                for (int c = 0; c < 16; ++c) ssum += sq[c * 128 + tid];
                ((float*)lds)[tid] = rsqrtf(ssum * (1.f / D) + EPS); }
            __syncthreads();
            norm_to_frag(P.out, P.norm2_g + l * D, mb_ + 3072, mb_ + 4096, hA, (float*)lds, tile, tid, true);
            __syncthreads();
            {
                const bf16_t* At = hA + (size_t)tile * 131072;
                const bf16_t* WF = WpqF + (size_t)l * 2097152;
                for (int rep = 0; rep < REP_GEMM; ++rep)
                for (int pass = 0; pass < 4; ++pass) {
                    f32x16 acc[4][2];
                    const int nbt0 = pass * 16 + w * 2;
                    kloop<1>(acc, At, WF + (size_t)nbt0 * 32768, WF + (size_t)(nbt0 + 1) * 32768, lds, tid, lane);
                    epi_qpf(acc, QPF, tile, nbt0, lane);
                }
            }
            __syncthreads();
            for (int rep = 0; rep < REP_ROUTE; ++rep) { route_tile(QPF, KeysF + (size_t)l * 262144, ridx, rgate, (unsigned char*)lds, tile, tid); __syncthreads(); }
#pragma unroll 4
            for (int i = 0; i < 16; ++i) stage_token(ridx, rgate, lds, tile * 128 + w * 16 + i, w * 16 + i, lane);
            __syncthreads();
            peer_down_wave(hA, lds, TBd + (size_t)l * 16384 * 512, SC + (size_t)l * 32768, tile, w, lane);
            __syncthreads();
            peer_up_wave(lds, TBu + (size_t)l * 16384 * 512, mb_ + 5120, P.out, tile, w, lane);
            __syncthreads();
        }
    }
}
}

extern "C" void kernel_launch(void* const* d_in, const int* in_sizes, int n_in, void* d_out, int out_size, void* d_ws, size_t ws_size, hipStream_t stream) {
    using namespace op;
    static int grid_blocks = 0;
    if (!grid_blocks) {
        int dev = 0, cus = 0, per_cu = 0;
        (void)hipGetDevice(&dev);
        (void)hipDeviceGetAttribute(&cus, hipDeviceAttributeMultiprocessorCount, dev);
        (void)hipFuncSetAttribute((const void*)hybrid_fwd, hipFuncAttributeMaxDynamicSharedMemorySize, LDS_BYTES);
        (void)hipOccupancyMaxActiveBlocksPerMultiprocessor(&per_cu, (const void*)hybrid_fwd, 512, LDS_BYTES);
        if (per_cu < 1) per_cu = 1;
        grid_blocks = cus * per_cu;
        if (grid_blocks > NTILE) grid_blocks = NTILE;
        if (ws_size < WS_END) { fprintf(stderr, "kernel_launch: workspace too small (%zu < %zu)\n", ws_size, (size_t)WS_END); grid_blocks = -1; }
    }
    if (grid_blocks < 0) return;
    Params p{};
    p.x = (const float*)d_in[0]; p.c = (const float*)d_in[1]; p.rel_bias = (const float*)d_in[2]; p.w_ada = (const float*)d_in[3]; p.b_ada = (const float*)d_in[4];
    p.norm1_g = (const float*)d_in[5]; p.norm2_g = (const float*)d_in[6]; p.w_in = (const float*)d_in[7]; p.q_norm_g = (const float*)d_in[8]; p.k_norm_g = (const float*)d_in[9];
    p.attn_sink = (const float*)d_in[10]; p.conv_w = (const float*)d_in[11]; p.sgu_w = (const float*)d_in[12]; p.sgu_b = (const float*)d_in[13]; p.out_norm_g = (const float*)d_in[14];
    p.w_out = (const float*)d_in[15]; p.peer_wq = (const float*)d_in[16]; p.peer_sub_keys = (const float*)d_in[17]; p.peer_down = (const float*)d_in[18]; p.peer_up = (const float*)d_in[19];
    p.out = (float*)d_out; p.ws = (char*)d_ws;
    (void)hipMemsetAsync((char*)d_ws + WS_FLAGS, 0, 1024, stream);
    void* args[] = {&p};
    hipError_t e = hipLaunchCooperativeKernel((const void*)hybrid_fwd, dim3(grid_blocks), dim3(512), args, LDS_BYTES, stream);
    if (e != hipSuccess) fprintf(stderr, "kernel_launch: cooperative launch failed: %s (grid %d)\n", hipGetErrorString(e), grid_blocks);
}
```

```cpp
#include <hip/hip_runtime.h>
#include <cstdio>
#include <cstdint>
#include <hip/hip_cooperative_groups.h>
namespace cg = cooperative_groups;


namespace op {
#define DI __device__ __forceinline__
typedef unsigned short bf16_t;
typedef short bf16x8 __attribute__((ext_vector_type(8)));
typedef float f32x16 __attribute__((ext_vector_type(16)));
typedef float f32x2 __attribute__((ext_vector_type(2)));
typedef unsigned u32x4 __attribute__((ext_vector_type(4)));
typedef unsigned u32x2 __attribute__((ext_vector_type(2)));
typedef __bf16 bf16v2 __attribute__((ext_vector_type(2)));
constexpr int D = 1024, NB = 8, S = 4096, DEPTH = 4, T = NB * S, NTILE = T / 128;
constexpr float EPS = 1e-6f;
constexpr int PL_SEID = 0, PL_SWGT = 32768, PL_END = 98304, PL_RIDX = 98304;
constexpr int LDS_EPI = 32768, LDS_SSQ = 102400, LDS_RSTD1 = 110592, LDS_BIAS = 112 * 1024, LDS_BYTES = 116 * 1024;
constexpr int REP_GEMM = 1, REP_ROUTE = 1, REP_MIX = 1, REP_NORM = 1, REP_P0 = 1;
#define MFMA32(a, b, c) __builtin_amdgcn_mfma_f32_32x32x16_bf16((a), (b), (c), 0, 0, 0)

DI unsigned pk2(float lo, float hi) { f32x2 v = {lo, hi}; return __builtin_bit_cast(unsigned, __builtin_convertvector(v, bf16v2)); }
DI int opaque_v(int x) { asm volatile("" : "+v"(x)); return x; }
DI int opaque_s(int x) { asm volatile("" : "+s"(x)); return x; }
DI int crow(int reg, int hh) { return (reg & 3) + 8 * (reg >> 2) + 4 * hh; }
DI float wave_sum(float v) {
#pragma unroll
    for (int o = 1; o < 64; o <<= 1) v += __shfl_xor(v, o);
    return v;
}

DI int col_perm(int npos, int mode) {
    if (mode == 1 && npos >= 1024 && npos < 1536) { const int q = npos - 1024, w = q >> 6, nb = (q >> 5) & 1, r = q & 31; return (nb ? 1280 : 1024) + 32 * w + r; }
    return npos;
}
DI void conv_wfrag_item(const float* __restrict__ W, int N, int KB, bf16_t* __restrict__ WF, int gid, int mode) {
    const int l = gid & 63, kb = (gid >> 6) % KB, nbt = (gid >> 6) / KB, r = l & 31, hh = l >> 5;
    const int n = col_perm(nbt * 32 + r, mode);
    const float* p = W + (size_t)(kb * 16 + 8 * hh) * N + n;
    float v[8];
#pragma unroll
    for (int j = 0; j < 8; ++j) v[j] = p[(size_t)j * N];
    u32x4 o; o.x = pk2(v[0], v[1]); o.y = pk2(v[2], v[3]); o.z = pk2(v[4], v[5]); o.w = pk2(v[6], v[7]);
    *(u32x4*)(WF + (size_t)gid * 8) = o;
}

DI void norm_to_frag(const float* __restrict__ x, const float* __restrict__ g, const float* __restrict__ sh, const float* __restrict__ sc, bf16_t* __restrict__ hA, float* rstd_lds, int tile, int tid, bool have_rstd) {
    tid = opaque_v(tid); tile = opaque_s(tile);
    const int w = tid >> 6, lane = tid & 63;
    float cg[16], cs[16], ch[16];
#pragma unroll
    for (int j = 0; j < 2; ++j)
#pragma unroll
        for (int q = 0; q < 2; ++q) {
            const int c = 512 * j + 8 * lane + 4 * q;
            const float4 a = *(const float4*)(g + c), b = *(const float4*)(sc + c), d = *(const float4*)(sh + c);
            cg[8 * j + 4 * q] = a.x * (1.f + b.x); cg[8 * j + 4 * q + 1] = a.y * (1.f + b.y); cg[8 * j + 4 * q + 2] = a.z * (1.f + b.z); cg[8 * j + 4 * q + 3] = a.w * (1.f + b.w);
            ch[8 * j + 4 * q] = d.x; ch[8 * j + 4 * q + 1] = d.y; ch[8 * j + 4 * q + 2] = d.z; ch[8 * j + 4 * q + 3] = d.w;
            cs[8 * j + 4 * q] = 0.f; cs[8 * j + 4 * q + 1] = 0.f; cs[8 * j + 4 * q + 2] = 0.f; cs[8 * j + 4 * q + 3] = 0.f;
        }
    (void)cs;
#pragma unroll 4
    for (int rr = 0; rr < 16; ++rr) {
        const int row = w * 16 + rr;
        const float* xr = x + ((size_t)tile * 128 + row) * D + 8 * lane;
        float v[16];
#pragma unroll
        for (int j = 0; j < 2; ++j)
#pragma unroll
            for (int q = 0; q < 2; ++q) { const float4 a = *(const float4*)(xr + 512 * j + 4 * q); v[8 * j + 4 * q] = a.x; v[8 * j + 4 * q + 1] = a.y; v[8 * j + 4 * q + 2] = a.z; v[8 * j + 4 * q + 3] = a.w; }
        float r;
        if (have_rstd) r = rstd_lds[row];
        else {
            float ss = 0.f;
#pragma unroll
            for (int e = 0; e < 16; ++e) ss += v[e] * v[e];
            r = rsqrtf(wave_sum(ss) * (1.f / D) + EPS);
        }
        bf16_t* orow = hA + ((size_t)tile * 128 + row) * D + 8 * lane;
#pragma unroll
        for (int j = 0; j < 2; ++j) {
            u32x4 o;
            o.x = pk2(v[8 * j] * r * cg[8 * j] + ch[8 * j], v[8 * j + 1] * r * cg[8 * j + 1] + ch[8 * j + 1]);
            o.y = pk2(v[8 * j + 2] * r * cg[8 * j + 2] + ch[8 * j + 2], v[8 * j + 3] * r * cg[8 * j + 3] + ch[8 * j + 3]);
            o.z = pk2(v[8 * j + 4] * r * cg[8 * j + 4] + ch[8 * j + 4], v[8 * j + 5] * r * cg[8 * j + 5] + ch[8 * j + 5]);
            o.w = pk2(v[8 * j + 6] * r * cg[8 * j + 6] + ch[8 * j + 6], v[8 * j + 7] * r * cg[8 * j + 7] + ch[8 * j + 7]);
            *(u32x4*)(orow + 512 * j) = o;
        }
    }
}

template <int ORIENT>
DI void kloop(f32x16 (&acc)[4][2], const bf16_t* __restrict__ At, const bf16_t* __restrict__ W0, const bf16_t* __restrict__ W1, char* lds, int tid, int lane) {
    tid = opaque_v(tid); lane = opaque_v(lane);
#pragma unroll
    for (int mb = 0; mb < 4; ++mb)
#pragma unroll
        for (int nb = 0; nb < 2; ++nb)
#pragma unroll
            for (int i = 0; i < 16; ++i) acc[mb][nb][i] = 0.f;
    {
    const int c8_ = (tid >> 3) & 7, rowA_ = (tid >> 6) * 8 + (tid & 7);
    const u32x4* Ag = (const u32x4*)(At + (unsigned)(rowA_ * 1024 + c8_ * 8));
    const int ldsA_ = ((((c8_ >> 1) * 4 + (rowA_ >> 5)) * 64) + (rowA_ & 31) + 32 * (c8_ & 1)) * 16;
    const u32x4* W0g = (const u32x4*)W0 + lane;
    const u32x4* W1g = (const u32x4*)W1 + lane;
    u32x4 wq[4][2], arA[2], arB[2];
    arA[0] = Ag[0]; arA[1] = Ag[8192]; arB[0] = Ag[8]; arB[1] = Ag[8 + 8192];
#pragma unroll
    for (int kk = 0; kk < 4; ++kk) { wq[kk][0] = W0g[kk * 64]; wq[kk][1] = W1g[kk * 64]; }
    *(u32x4*)(lds + ldsA_) = arA[0]; *(u32x4*)(lds + ldsA_ + 2048) = arA[1];
    __syncthreads();
#define KL_ITER(KC, ARL, ARS) do { \
        char* cur = lds + ((KC) & 1) * 16384; \
        char* nxt = lds + (((KC) + 1) & 1) * 16384; \
        const int kn = (KC) < 15 ? (KC) + 1 : 15, k2 = (KC) < 14 ? (KC) + 2 : 15; \
        ARL[0] = Ag[k2 * 8]; ARL[1] = Ag[k2 * 8 + 8192]; \
        __builtin_amdgcn_sched_barrier(0); \
        _Pragma("unroll") for (int kk = 0; kk < 4; ++kk) { \
            bf16x8 afr[4]; \
            _Pragma("unroll") for (int mb = 0; mb < 4; ++mb) afr[mb] = *(const bf16x8*)(cur + ((kk * 4 + mb) * 64 + lane) * 16); \
            _Pragma("unroll") for (int mb = 0; mb < 4; ++mb) \
                _Pragma("unroll") for (int nb = 0; nb < 2; ++nb) { \
                    const bf16x8 wf = __builtin_bit_cast(bf16x8, wq[kk][nb]); \
                    if (ORIENT == 0) acc[mb][nb] = MFMA32(afr[mb], wf, acc[mb][nb]); \
                    else acc[mb][nb] = MFMA32(wf, afr[mb], acc[mb][nb]); \
                } \
            wq[kk][0] = W0g[(kn * 4 + kk) * 64]; wq[kk][1] = W1g[(kn * 4 + kk) * 64]; \
            __builtin_amdgcn_sched_barrier(0); \
        } \
        if ((KC) < 15) { *(u32x4*)(nxt + ldsA_) = ARS[0]; *(u32x4*)(nxt + ldsA_ + 2048) = ARS[1]; } \
        __syncthreads(); \
    } while (0)
    for (int kc = 0; kc < 16; kc += 2) { KL_ITER(kc, arA, arB); KL_ITER(kc + 1, arB, arA); }
#undef KL_ITER
    }
}

DI void epi_f32row(const f32x16 (&acc)[4][2], float* __restrict__ C, int tile, int col0, int lane) {
    lane = opaque_v(lane);
    const int r5 = lane & 31, hh = lane >> 5;
    const unsigned boff = (unsigned)((tile * 128 + 4 * hh) * 2048 + col0 + r5);
#pragma unroll
    for (int mb = 0; mb < 4; ++mb)
#pragma unroll
        for (int nb = 0; nb < 2; ++nb)
#pragma unroll
            for (int i = 0; i < 16; ++i)
                C[boff + (unsigned)((mb * 32 + (i & 3) + 8 * (i >> 2)) * 2048 + nb * 32)] = acc[mb][nb][i];
}
DI void epi_resid(const f32x16 (&acc)[4][2], const float* __restrict__ xin, float* __restrict__ xout, const float* __restrict__ gate_b, float* T  , float* ssq  , int tile, int col0, int lane) {
    lane = opaque_v(lane);
    const int r5 = lane & 31, hh = lane >> 5, rq = lane >> 4, c4 = (lane & 15) * 4;
    const float4 gv = *(const float4*)(gate_b + col0 + c4);
#pragma unroll
    for (int mb = 0; mb < 4; ++mb) {
#pragma unroll
        for (int nb = 0; nb < 2; ++nb)
#pragma unroll
            for (int i = 0; i < 16; ++i) T[((i & 3) + 8 * (i >> 2) + 4 * hh) * 68 + nb * 32 + r5] = acc[mb][nb][i];
        asm volatile("s_waitcnt lgkmcnt(0)" ::: "memory");
#pragma unroll
        for (int j = 0; j < 8; ++j) {
            const int row = rq + 4 * j;
            const float4 v = *(const float4*)(T + row * 68 + c4);
            const unsigned o = (unsigned)((tile * 128 + mb * 32 + row) * D + col0 + c4);
            float4 xv = *(const float4*)(xin + o);
            xv.x += gv.x * v.x; xv.y += gv.y * v.y; xv.z += gv.z * v.z; xv.w += gv.w * v.w;
            *(float4*)(xout + o) = xv;
            float ss = xv.x * xv.x + xv.y * xv.y + xv.z * xv.z + xv.w * xv.w;
            ss += __shfl_xor(ss, 1); ss += __shfl_xor(ss, 2); ss += __shfl_xor(ss, 4); ss += __shfl_xor(ss, 8);
            if ((lane & 15) == 0) ssq[mb * 32 + row] = ss;
        }
        asm volatile("s_waitcnt lgkmcnt(0)" ::: "memory");
    }
}

DI void epi_qpf(const f32x16 (&acc)[4][2], bf16_t* __restrict__ QPF, int tile, int ft0, int lane) {
    lane = opaque_v(lane);
#pragma unroll
    for (int nb = 0; nb < 2; ++nb)
#pragma unroll
        for (int s = 0; s < 2; ++s)
#pragma unroll
            for (int mb = 0; mb < 4; ++mb) {
                const f32x16& a = acc[mb][nb];
                u32x4 o; o.x = pk2(a[8 * s], a[8 * s + 1]); o.y = pk2(a[8 * s + 2], a[8 * s + 3]); o.z = pk2(a[8 * s + 4], a[8 * s + 5]); o.w = pk2(a[8 * s + 6], a[8 * s + 7]);
                *(u32x4*)(QPF + ((unsigned)((((tile * 64 + ft0 + nb) * 2 + s) * 4 + mb) * 64 + lane)) * 8) = o;
            }
}

DI void conv_keys_item(const float* __restrict__ K, bf16_t* __restrict__ KF, int gid) {
    const int lane = gid & 63, s = (gid >> 6) & 1, nbl = (gid >> 7) & 3, nt = (gid >> 9) & 3, hp = gid >> 11;
    const int r = lane & 31, hh = lane >> 5;
    const float* p = K + ((size_t)hp * 128 + nt * 32 + r) * 128 + nbl * 32 + 16 * s + 4 * hh;
    const float4 a = *(const float4*)p, b = *(const float4*)(p + 8);
    u32x4 o; o.x = pk2(a.x, a.y); o.y = pk2(a.z, a.w); o.z = pk2(b.x, b.y); o.w = pk2(b.z, b.w);
    *(u32x4*)(KF + (size_t)gid * 8) = o;
}

DI void conv_table_row(const float* __restrict__ src, unsigned char* __restrict__ dst, float* __restrict__ sc, int lane, bool as_int4) {
    const float4* p = (const float4*)src + lane * 4;
    float4 v[4];
    float m = 0.f;
#pragma unroll
    for (int j = 0; j < 4; ++j) { v[j] = p[j]; m = fmaxf(m, fmaxf(fmaxf(fabsf(v[j].x), fabsf(v[j].y)), fmaxf(fabsf(v[j].z), fabsf(v[j].w)))); }
#pragma unroll
    for (int o = 1; o < 64; o <<= 1) m = fmaxf(m, __shfl_xor(m, o));
    float scale = m > 0.f ? m * (1.f / 6.f) : 1.f;
    if (as_int4) {
        float ss = 0.f;
#pragma unroll
        for (int j = 0; j < 4; ++j) ss += v[j].x * v[j].x + v[j].y * v[j].y + v[j].z * v[j].z + v[j].w * v[j].w;
        ss = wave_sum(ss);
        const float sg = sqrtf(ss * (1.f / 1024.f));
        scale = fmaxf(sg * (1.f / 2.8f), m * (1.f / 16.f));
        if (!(scale > 0.f)) scale = 1.f;
    }
    const float inv = 1.f / scale;
    u32x2 o;
    unsigned* op = (unsigned*)&o;
#pragma unroll
    for (int j = 0; j < 2; ++j) {
        const float f[8] = {v[2 * j].x, v[2 * j].y, v[2 * j].z, v[2 * j].w, v[2 * j + 1].x, v[2 * j + 1].y, v[2 * j + 1].z, v[2 * j + 1].w};
        unsigned wv = 0;
        if (as_int4) {
#pragma unroll
            for (int e = 0; e < 8; ++e) { int q = __float2int_rn(f[e] * inv); q = q < -7 ? -7 : (q > 7 ? 7 : q); wv |= ((unsigned)q & 15u) << (4 * e); }
        } else {
            wv = __builtin_amdgcn_cvt_scalef32_pk_fp4_f32(wv, f[0] * inv, f[1] * inv, 1.0f, 0);
            wv = __builtin_amdgcn_cvt_scalef32_pk_fp4_f32(wv, f[2] * inv, f[3] * inv, 1.0f, 1);
            wv = __builtin_amdgcn_cvt_scalef32_pk_fp4_f32(wv, f[4] * inv, f[5] * inv, 1.0f, 2);
            wv = __builtin_amdgcn_cvt_scalef32_pk_fp4_f32(wv, f[6] * inv, f[7] * inv, 1.0f, 3);
        }
        op[j] = wv;
    }
    *(u32x2*)(dst + lane * 8) = o;
    if (lane == 0) *sc = scale;
}

DI void ce_desc(int& a, int& b) { const int mx = a > b ? a : b, mn = a > b ? b : a; a = mx; b = mn; }
DI void sort16_desc(int (&v)[16]) {
#pragma unroll
    for (int k = 2; k <= 16; k <<= 1)
#pragma unroll
        for (int j = k >> 1; j > 0; j >>= 1)
#pragma unroll
            for (int i = 0; i < 16; ++i) {
                const int l = i ^ j;
                if (l > i) { if ((i & k) == 0) ce_desc(v[i], v[l]); else ce_desc(v[l], v[i]); }
            }
}
DI void bitonic_merge16_desc(int (&v)[16]) {
#pragma unroll
    for (int j = 8; j > 0; j >>= 1)
#pragma unroll
        for (int i = 0; i < 16; ++i) { const int l = i ^ j; if (l > i) ce_desc(v[i], v[l]); }
}
DI void merge_top16(int (&a)[16], const int (&b)[16]) {
#pragma unroll
    for (int i = 0; i < 16; ++i) a[i] = a[i] > b[15 - i] ? a[i] : b[15 - i];
    bitonic_merge16_desc(a);
}
DI int f2ord(float f) { int b = __float_as_int(f); return b ^ ((b >> 31) & 0x7fffffff); }
DI float ord2f(int k) { return __int_as_float(k ^ ((k >> 31) & 0x7fffffff)); }

DI void route_tile(const bf16_t* __restrict__ QPF, const bf16_t* __restrict__ KF, char* lds_lists, unsigned char* lds_idx  , int tile, int tid) {
    tid = opaque_v(tid); tile = opaque_s(tile);
    const int lane = tid & 63, w = __builtin_amdgcn_readfirstlane(tid >> 6);
    const int r5 = lane & 31, hh = lane >> 5;
    unsigned char* myidx = lds_idx + w * 1024;
    for (int task = w; task < 32; task += 8) {
        const int h = task >> 2, tt = task & 3;
        f32x16 acc[2][4];
#pragma unroll
        for (int p = 0; p < 2; ++p)
#pragma unroll
            for (int nt = 0; nt < 4; ++nt)
#pragma unroll
                for (int i = 0; i < 16; ++i) acc[p][nt][i] = 0.f;
        {
            bf16x8 bq[2], ak[2][4];
#define ROUTE_LOAD(buf, step) do { const int p_ = (step) >> 3, ks_ = (step) & 7; \
                bq[buf] = *(const bf16x8*)(QPF + ((unsigned)((((tile * 64 + h * 8 + p_ * 4 + (ks_ >> 1)) * 2 + (ks_ & 1)) * 4 + tt) * 64 + lane)) * 8); \
                _Pragma("unroll") for (int nt = 0; nt < 4; ++nt) ak[buf][nt] = *(const bf16x8*)(KF + ((unsigned)(((((h * 2 + p_) * 4 + nt) * 8 + ks_) * 64) + lane)) * 8); } while (0)
            ROUTE_LOAD(0, 0);
#pragma unroll
            for (int step = 0; step < 16; ++step) {
                if (step < 15) ROUTE_LOAD((step + 1) & 1, step + 1);
#pragma unroll
                for (int nt = 0; nt < 4; ++nt) acc[step >> 3][nt] = MFMA32(ak[step & 1][nt], bq[step & 1], acc[step >> 3][nt]);
                __builtin_amdgcn_sched_barrier(0);
            }
#undef ROUTE_LOAD
        }
        int g[8][16];
#pragma unroll
        for (int nt = 0; nt < 4; ++nt)
#pragma unroll
            for (int i = 0; i < 16; ++i) {
                const unsigned a = __float_as_uint(acc[0][nt][i]), b = __float_as_uint(acc[1][nt][i]);
                auto sw = __builtin_amdgcn_permlane32_swap(a, b, false, false);
                const int n0 = nt * 32 + (i & 3) + 8 * (i >> 2);
                g[nt * 2 + (i >> 3)][i & 7] = (f2ord(__uint_as_float(sw[0])) & ~127) | n0;
                g[nt * 2 + (i >> 3)][8 + (i & 7)] = (f2ord(__uint_as_float(sw[1])) & ~127) | (n0 + 4);
            }
#pragma unroll
        for (int q = 0; q < 8; ++q) sort16_desc(g[q]);
        merge_top16(g[0], g[1]); merge_top16(g[2], g[3]); merge_top16(g[4], g[5]); merge_top16(g[6], g[7]);
        merge_top16(g[0], g[2]); merge_top16(g[4], g[6]);
        merge_top16(g[0], g[4]);
        {
            u32x4 pk;
            unsigned* pp = (unsigned*)&pk;
#pragma unroll
            for (int q = 0; q < 4; ++q) pp[q] = (unsigned)(g[0][4 * q] & 127) | ((unsigned)(g[0][4 * q + 1] & 127) << 8) | ((unsigned)(g[0][4 * q + 2] & 127) << 16) | ((unsigned)(g[0][4 * q + 3] & 127) << 24);
            *(u32x4*)(myidx + lane * 16) = pk;
        }
        float f0[16], f1[16];
#pragma unroll
        for (int i = 0; i < 16; ++i) {
            const unsigned a = (unsigned)g[0][i], b = a;
            auto sw = __builtin_amdgcn_permlane32_swap(a, b, false, false);
            f0[i] = ord2f((int)sw[0] & ~127); f1[i] = ord2f((int)sw[1] & ~127);
        }
        int c0[16], c1[16], c2[16], c3[16];
#pragma unroll
        for (int j = 0; j < 16; ++j) c0[j] = (f2ord(f0[0] + f1[j]) & ~255) | j;
#pragma unroll
        for (int i = 1; i < 16; ++i) c1[i - 1] = (f2ord(f0[i] + f1[0]) & ~255) | (i << 4);
        c1[15] = (int)0x80000000;
#define CK(i, j) ((f2ord(f0[i] + f1[j]) & ~255) | ((i) << 4) | (j))
        c2[0] = CK(1, 1); c2[1] = CK(1, 2); c2[2] = CK(1, 3); c2[3] = CK(1, 4); c2[4] = CK(1, 5); c2[5] = CK(1, 6); c2[6] = CK(1, 7);
        c2[7] = CK(2, 1); c2[8] = CK(2, 2); c2[9] = CK(2, 3); c2[10] = CK(2, 4);
        c2[11] = CK(3, 1); c2[12] = CK(3, 2); c2[13] = CK(3, 3);
        c2[14] = CK(4, 1); c2[15] = CK(4, 2);
        c3[0] = CK(5, 1); c3[1] = CK(6, 1); c3[2] = CK(7, 1);
#undef CK
#pragma unroll
        for (int q = 3; q < 16; ++q) c3[q] = (int)0x80000000;
        sort16_desc(c2);
        ce_desc(c3[0], c3[1]); ce_desc(c3[1], c3[2]); ce_desc(c3[0], c3[1]);
        merge_top16(c0, c1); merge_top16(c2, c3); merge_top16(c0, c2);
        float bs[16], den = 0.f;
#pragma unroll
        for (int i = 0; i < 16; ++i) { bs[i] = __expf(ord2f(c0[i] & ~255) - ord2f(c0[0] & ~255)); den += bs[i]; }
        const float rden = 1.f / den;
        asm volatile("s_waitcnt lgkmcnt(0)" ::: "memory");
#pragma unroll
        for (int q = 0; q < 8; ++q) {
            const int key = (int)__builtin_amdgcn_permlane32_swap((unsigned)c0[q], (unsigned)c0[8 + q], false, false)[0];
            const float gv = __uint_as_float(__builtin_amdgcn_permlane32_swap(__float_as_uint(bs[q]), __float_as_uint(bs[8 + q]), false, false)[0]) * rden;
            const int i = (key >> 4) & 15, j = key & 15;
            const int e = (int)myidx[r5 * 16 + i] * 128 + (int)myidx[(32 + r5) * 16 + j];
            const int tokl = tt * 32 + r5;
            ((unsigned short*)(lds_lists + PL_SEID))[tokl * 128 + h * 16 + 8 * hh + q] = (unsigned short)e;
            ((float*)(lds_lists + PL_SWGT))[tokl * 128 + h * 16 + 8 * hh + q] = gv;
        }
        asm volatile("s_waitcnt lgkmcnt(0)" ::: "memory");
    }
}

DI void unpack_h2(const bf16_t* __restrict__ hA, int t, int lane, f32x2 (&hv)[8]) {
    const int tile = t >> 7, row = t & 127, mb = row >> 5, r5 = row & 31;
    const bf16_t* hp = hA + ((unsigned)(((tile * 64 + lane) * 4 + mb) * 64 + r5)) * 8;
    const u32x4 ha = *(const u32x4*)hp, hb = *(const u32x4*)(hp + 32 * 8);
    const unsigned hw[8] = {ha.x, ha.y, ha.z, ha.w, hb.x, hb.y, hb.z, hb.w};
#pragma unroll
    for (int q = 0; q < 8; ++q) { hv[q].x = __uint_as_float(hw[q] << 16); hv[q].y = __uint_as_float(hw[q] & 0xffff0000u); }
}
typedef _Float16 h16x2 __attribute__((ext_vector_type(2)));
DI h16x2 fp4h(unsigned w, int sel) {
    return sel == 0 ? __builtin_amdgcn_cvt_scalef32_pk_f16_fp4(w, 1.0f, 0) : sel == 1 ? __builtin_amdgcn_cvt_scalef32_pk_f16_fp4(w, 1.0f, 1)
         : sel == 2 ? __builtin_amdgcn_cvt_scalef32_pk_f16_fp4(w, 1.0f, 2) : __builtin_amdgcn_cvt_scalef32_pk_f16_fp4(w, 1.0f, 3);
}
DI void stage_token(const int* __restrict__ ridx, const float* __restrict__ rgate, char* lds, int t, int tloc, int lane) {
    lane = opaque_v(lane); t = opaque_s(t);
    unsigned short* seid = (unsigned short*)(lds + PL_SEID) + tloc * 128;
    float* swgt = (float*)(lds + PL_SWGT) + tloc * 128;
    seid[lane] = (unsigned short)ridx[(unsigned)(t * 128 + lane)]; seid[64 + lane] = (unsigned short)ridx[(unsigned)(t * 128 + 64 + lane)];
    swgt[lane] = rgate[(unsigned)(t * 128 + lane)]; swgt[64 + lane] = rgate[(unsigned)(t * 128 + 64 + lane)];
}
DI void peer_down_wave(const bf16_t* __restrict__ hA, char* lds, const unsigned char* __restrict__ TBd, const float* __restrict__ SC, int tile, int w, int lane) {
    lane = opaque_v(lane);
    const int myu = ((lane >> 5) & 1) * 8 + ((lane >> 4) & 1) * 4 + ((lane >> 3) & 1) * 2 + ((lane >> 2) & 1);
#pragma unroll 1
    for (int tl = 0; tl < 16; ++tl) {
        const int tloc = w * 16 + tl, t = tile * 128 + tloc;
        const unsigned short* ip = (const unsigned short*)(lds + PL_SEID) + tloc * 128;
        float* gp = (float*)(lds + PL_SWGT) + tloc * 128;
        const int row = t & 127, mb = row >> 5, r5 = row & 31;
        const bf16_t* hp = hA + (unsigned)(t * 1024 + lane * 16);
        const u32x4 ha = *(const u32x4*)hp, hb = *(const u32x4*)(hp + 8);
        unsigned hhi[2], hlo[2];
        float hscale;
        {
            const unsigned hw[8] = {ha.x, ha.y, ha.z, ha.w, hb.x, hb.y, hb.z, hb.w};
            float hf[16];
            float m = 0.f;
#pragma unroll
            for (int q = 0; q < 8; ++q) { hf[2 * q] = __uint_as_float(hw[q] << 16); hf[2 * q + 1] = __uint_as_float(hw[q] & 0xffff0000u); m = fmaxf(m, fmaxf(fabsf(hf[2 * q]), fabsf(hf[2 * q + 1]))); }
#pragma unroll
            for (int o = 1; o < 64; o <<= 1) m = fmaxf(m, __shfl_xor(m, o));
            hscale = m > 0.f ? m * (1.f / 119.f) : 1.f;
            const float inv = 1.f / hscale;
            hhi[0] = hhi[1] = hlo[0] = hlo[1] = 0u;
#pragma unroll
            for (int e = 0; e < 16; ++e) {
                const int hq = __float2int_rn(hf[e] * inv);
                const int lo = ((hq + 8) & 15) - 8, hi = (hq - lo) >> 4;
                hlo[e >> 3] |= ((unsigned)lo & 15u) << (4 * (e & 7));
                hhi[e >> 3] |= ((unsigned)hi & 15u) << (4 * (e & 7));
            }
        }
#pragma unroll 1
        for (int c0 = 0; c0 < 128; c0 += 64) {
            const int ev = ip[c0 + lane];
#pragma unroll 1
            for (int p = 0; p < 64; p += 16) {
                u32x2 dr[16];
#pragma unroll
                for (int u = 0; u < 16; ++u) {
                    const int e = __builtin_amdgcn_readlane(ev, p + u);
                    dr[u] = *(const u32x2*)(TBd + (size_t)(unsigned)e * 512 + lane * 8);
                }
                const int me = __shfl(ev, p + myu);
                const f32x2 scv = *(const f32x2*)(SC + (unsigned)me * 2);
                int part[16];
#pragma unroll
                for (int u = 0; u < 16; ++u) {
                    int shi = __builtin_amdgcn_sdot8((int)dr[u].x, (int)hhi[0], 0, false);
                    shi = __builtin_amdgcn_sdot8((int)dr[u].y, (int)hhi[1], shi, false);
                    int slo = __builtin_amdgcn_sdot8((int)dr[u].x, (int)hlo[0], 0, false);
                    slo = __builtin_amdgcn_sdot8((int)dr[u].y, (int)hlo[1], slo, false);
                    part[u] = shi * 16 + slo;
                }
                int r8[8], r4[4], r2[2], r1;
                {
                    const bool b5 = (lane & 32) != 0, b4 = (lane & 16) != 0, b3 = (lane & 8) != 0, b2 = (lane & 4) != 0;
#pragma unroll
                    for (int q = 0; q < 8; ++q) { const int keep = b5 ? part[q + 8] : part[q], give = b5 ? part[q] : part[q + 8]; r8[q] = keep + __shfl_xor(give, 32); }
#pragma unroll
                    for (int q = 0; q < 4; ++q) { const int keep = b4 ? r8[q + 4] : r8[q], give = b4 ? r8[q] : r8[q + 4]; r4[q] = keep + __shfl_xor(give, 16); }
#pragma unroll
                    for (int q = 0; q < 2; ++q) { const int keep = b3 ? r4[q + 2] : r4[q], give = b3 ? r4[q] : r4[q + 2]; r2[q] = keep + __shfl_xor(give, 8); }
                    { const int keep = b2 ? r2[1] : r2[0], give = b2 ? r2[0] : r2[1]; r1 = keep + __shfl_xor(give, 4); }
                    r1 += __shfl_xor(r1, 2); r1 += __shfl_xor(r1, 1);
                }
                if ((lane & 3) == 0) {
                    const float a = (float)r1 * (scv.x * hscale);
                    gp[c0 + p + myu] = gp[c0 + p + myu] * (0.5f * a * (1.f + erff(a * 0.70710678118654752f))) * scv.y;
                }
            }
        }
    }
}
DI void peer_up_wave(char* lds, const unsigned char* __restrict__ TBu, const float* __restrict__ g2b, float* __restrict__ x, int tile, int w, int lane) {
    lane = opaque_v(lane);
    for (int r = 0; r < 2; ++r) {
        h16x2 acc[8][8];
#pragma unroll
        for (int k = 0; k < 8; ++k)
#pragma unroll
            for (int q = 0; q < 8; ++q) acc[k][q] = (h16x2){(_Float16)0.f, (_Float16)0.f};
#pragma unroll
        for (int k = 0; k < 8; ++k) {
            const int tloc = w * 16 + r * 8 + k;
            const unsigned short* ip = (const unsigned short*)(lds + PL_SEID) + tloc * 128;
            const float* gp = (const float*)(lds + PL_SWGT) + tloc * 128;
    #pragma unroll 1
        for (int c0 = 0; c0 < 128; c0 += 64) {
                const int ev = ip[c0 + lane];
                const float wl = gp[c0 + lane];
    #pragma unroll 1
            for (int p = 0; p < 64; p += 16) {
                    u32x2 ur[16];
#pragma unroll
                    for (int u = 0; u < 16; ++u) {
                        const int e = __builtin_amdgcn_readlane(ev, p + u);
                        ur[u] = *(const u32x2*)(TBu + (size_t)(unsigned)e * 512 + lane * 8);
                    }
#pragma unroll
                    for (int u = 0; u < 16; ++u) {
                        const _Float16 wh = (_Float16)__int_as_float(__builtin_amdgcn_readlane(__float_as_int(wl), p + u));
                        const h16x2 w2 = (h16x2){wh, wh};
#pragma unroll
                        for (int q = 0; q < 4; ++q) { acc[k][q] = __builtin_elementwise_fma(w2, fp4h(ur[u].x, q), acc[k][q]); acc[k][4 + q] = __builtin_elementwise_fma(w2, fp4h(ur[u].y, q), acc[k][4 + q]); }
                    }
                }
            }
        }
#pragma unroll
        for (int k = 0; k < 8; ++k) {
            const int t = tile * 128 + w * 16 + r * 8 + k;
            float4* xp = (float4*)(x + (size_t)t * D + lane * 16);
            const float4* gq = (const float4*)(g2b + lane * 16);
            float ssx = 0.f;
#pragma unroll
            for (int q = 0; q < 4; ++q) {
                float4 xv = xp[q]; const float4 gv = gq[q];
                xv.x += gv.x * (float)acc[k][2 * q].x; xv.y += gv.y * (float)acc[k][2 * q].y; xv.z += gv.z * (float)acc[k][2 * q + 1].x; xv.w += gv.w * (float)acc[k][2 * q + 1].y;
                xp[q] = xv;
                ssx += xv.x * xv.x + xv.y * xv.y + xv.z * xv.z + xv.w * xv.w;
            }
            ssx = wave_sum(ssx);
            if (lane == 0) ((float*)(lds + LDS_RSTD1))[w * 16 + r * 8 + k] = rsqrtf(ssx * (1.f / D) + EPS);
        }
    }
}

DI void epi_qk(f32x16 (&acc)[4][2], const float* __restrict__ gain, float scale, bf16_t* __restrict__ dst, int lane) {
    lane = opaque_v(lane);
    const int hh = lane >> 5;
    float gv[2][16];
#pragma unroll
    for (int nb = 0; nb < 2; ++nb)
#pragma unroll
        for (int i = 0; i < 16; ++i) gv[nb][i] = gain[nb * 32 + (i & 3) + 8 * (i >> 2) + 4 * hh] * scale;
#pragma unroll
    for (int mb = 0; mb < 4; ++mb) {
        float ss = 0.f;
#pragma unroll
        for (int nb = 0; nb < 2; ++nb)
#pragma unroll
            for (int i = 0; i < 16; ++i) ss += acc[mb][nb][i] * acc[mb][nb][i];
        ss += __shfl_xor(ss, 32);
        const float r = rsqrtf(ss * (1.f / 64.f) + EPS);
#pragma unroll
        for (int nb = 0; nb < 2; ++nb)
#pragma unroll
            for (int s = 0; s < 2; ++s) {
                const f32x16& a = acc[mb][nb];
                u32x4 o;
                o.x = pk2(a[8 * s] * r * gv[nb][8 * s], a[8 * s + 1] * r * gv[nb][8 * s + 1]);
                o.y = pk2(a[8 * s + 2] * r * gv[nb][8 * s + 2], a[8 * s + 3] * r * gv[nb][8 * s + 3]);
                o.z = pk2(a[8 * s + 4] * r * gv[nb][8 * s + 4], a[8 * s + 5] * r * gv[nb][8 * s + 5]);
                o.w = pk2(a[8 * s + 6] * r * gv[nb][8 * s + 6], a[8 * s + 7] * r * gv[nb][8 * s + 7]);
                *(u32x4*)(dst + ((unsigned)(((nb * 2 + s) * 4 + mb) * 64 + lane)) * 8) = o;
            }
    }
}
DI void epi_v(const f32x16 (&acc)[4][2], bf16_t* __restrict__ dst, int lane) {
    lane = opaque_v(lane);
#pragma unroll
    for (int nb = 0; nb < 2; ++nb)
#pragma unroll
        for (int mb = 0; mb < 4; ++mb)
#pragma unroll
            for (int s = 0; s < 2; ++s) {
                const f32x16& a = acc[mb][nb];
                u32x4 o; o.x = pk2(a[8 * s], a[8 * s + 1]); o.y = pk2(a[8 * s + 2], a[8 * s + 3]); o.z = pk2(a[8 * s + 4], a[8 * s + 5]); o.w = pk2(a[8 * s + 6], a[8 * s + 7]);
                *(u32x4*)(dst + ((unsigned)(((nb * 4 + mb) * 2 + s) * 64 + lane)) * 8) = o;
            }
}
DI void epi_row(const f32x16 (&acc)[4][2], bf16_t* __restrict__ dst, int ld, int lane) {
    lane = opaque_v(lane);
    const int r5 = lane & 31, hh = lane >> 5;
#pragma unroll
    for (int mb = 0; mb < 4; ++mb)
#pragma unroll
        for (int nb = 0; nb < 2; ++nb)
#pragma unroll
            for (int gq = 0; gq < 4; ++gq) {
                const f32x16& a = acc[mb][nb];
                u32x2 o; o.x = pk2(a[4 * gq], a[4 * gq + 1]); o.y = pk2(a[4 * gq + 2], a[4 * gq + 3]);
                *(u32x2*)(dst + (unsigned)((mb * 32 + r5) * ld + nb * 32 + 8 * gq + 4 * hh)) = o;
            }
}
DI void epi_z(const f32x16 (&acc)[4][2], bf16_t* __restrict__ dst, int lane) {
    lane = opaque_v(lane);
    const int r5 = lane & 31, hh = lane >> 5;
#pragma unroll
    for (int mb = 0; mb < 4; ++mb)
#pragma unroll
        for (int gq = 0; gq < 4; ++gq) {
            const f32x16 &a = acc[mb][0], &b = acc[mb][1];
            u32x2 o; o.x = pk2(a[4 * gq] * b[4 * gq], a[4 * gq + 1] * b[4 * gq + 1]); o.y = pk2(a[4 * gq + 2] * b[4 * gq + 2], a[4 * gq + 3] * b[4 * gq + 3]);
            *(u32x2*)(dst + (unsigned)((mb * 32 + r5) * 256 + 8 * gq + 4 * hh)) = o;
        }
}
DI void epi_su_park(const f32x16 (&acc)[4][2], unsigned* lds_su, int lane) {
    lane = opaque_v(lane);
#pragma unroll
    for (int mb = 0; mb < 4; ++mb)
#pragma unroll
        for (int nb = 0; nb < 2; ++nb)
#pragma unroll
            for (int q = 0; q < 8; ++q) lds_su[((mb * 2 + nb) * 8 + q) * 64 + lane] = pk2(acc[mb][nb][2 * q], acc[mb][nb][2 * q + 1]);
}
DI void epi_sv(f32x16 (&acc)[4][2], const bf16_t* __restrict__ SWF  , const float* __restrict__ bs_g, const unsigned* lds_su, bf16_t* __restrict__ dst, int lane) {
    lane = opaque_v(lane);
    const int r5 = lane & 31, hh = lane >> 5;
    bf16x8 vb[4][2][2];
#pragma unroll
    for (int mb = 0; mb < 4; ++mb) {
#pragma unroll
        for (int i = 0; i < 16; ++i) {
            float s1 = acc[mb][0][i] + acc[mb][1][i];
#pragma unroll
            for (int o = 1; o < 32; o <<= 1) s1 += __shfl_xor(s1, o);
            const float mu = s1 * (1.f / 64.f);
            const float d0 = acc[mb][0][i] - mu, d1 = acc[mb][1][i] - mu;
            float s2 = d0 * d0 + d1 * d1;
#pragma unroll
            for (int o = 1; o < 32; o <<= 1) s2 += __shfl_xor(s2, o);
            const float r = rsqrtf(s2 * (1.f / 64.f) + EPS);
            acc[mb][0][i] = d0 * r; acc[mb][1][i] = d1 * r;
        }
#pragma unroll
        for (int s = 0; s < 2; ++s)
#pragma unroll
            for (int nb = 0; nb < 2; ++nb) {
                const f32x16& a = acc[mb][nb];
                u32x4 o; o.x = pk2(a[8 * s], a[8 * s + 1]); o.y = pk2(a[8 * s + 2], a[8 * s + 3]); o.z = pk2(a[8 * s + 4], a[8 * s + 5]); o.w = pk2(a[8 * s + 6], a[8 * s + 7]);
                vb[mb][s][nb] = __builtin_bit_cast(bf16x8, o);
            }
    }
#pragma unroll
    for (int tb = 0; tb < 4; ++tb) {
        f32x16 y[2];
#pragma unroll
        for (int nb = 0; nb < 2; ++nb)
#pragma unroll
            for (int i = 0; i < 16; ++i) y[nb][i] = 0.f;
#pragma unroll
        for (int kt = 0; kt <= tb; ++kt)
#pragma unroll
            for (int s = 0; s < 2; ++s) {
                const bf16x8 wa = *(const bf16x8*)(SWF + ((unsigned)(((tb * 4 + kt) * 2 + s) * 64 + lane)) * 8);
                y[0] = MFMA32(wa, vb[kt][s][0], y[0]);
                y[1] = MFMA32(wa, vb[kt][s][1], y[1]);
            }
#pragma unroll
        for (int nb = 0; nb < 2; ++nb)
#pragma unroll
            for (int q = 0; q < 8; ++q) {
                const unsigned su2 = lds_su[((tb * 2 + nb) * 8 + q) * 64 + lane];
                const int i0 = 2 * q, i1 = 2 * q + 1;
                const int t0 = tb * 32 + (i0 & 3) + 8 * (i0 >> 2) + 4 * hh, t1 = tb * 32 + (i1 & 3) + 8 * (i1 >> 2) + 4 * hh;
                const float v0 = (y[nb][i0] + bs_g[t0]) * __uint_as_float(su2 << 16), v1 = (y[nb][i1] + bs_g[t1]) * __uint_as_float(su2 & 0xffff0000u);
                const unsigned pk = pk2(v0, v1);
                dst[(unsigned)(t0 * 256 + nb * 32 + r5)] = (bf16_t)(pk & 0xffffu);
                dst[(unsigned)(t1 * 256 + nb * 32 + r5)] = (bf16_t)(pk >> 16);
            }
    }
}

DI void conv_sguw_item(const float* __restrict__ W, bf16_t* __restrict__ SWF, int gid) {
    const int lane = gid & 63, s = (gid >> 6) & 1, kt = (gid >> 7) & 3, tb = (gid >> 9) & 3, g = gid >> 11;
    const int r = lane & 31, hh = lane >> 5, t = tb * 32 + r;
    const float* p = W + ((size_t)g * 128 + t) * 128;
    float v[8];
#pragma unroll
    for (int j = 0; j < 8; ++j) { const int sp = kt * 32 + 16 * s + 8 * (j >> 2) + 4 * hh + (j & 3); v[j] = sp <= t ? p[sp] : 0.f; }
    u32x4 o; o.x = pk2(v[0], v[1]); o.y = pk2(v[2], v[3]); o.z = pk2(v[4], v[5]); o.w = pk2(v[6], v[7]);
    *(u32x4*)(SWF + (size_t)gid * 8) = o;
}

DI int t5_bucket(int d) {
    if (d < 16) return d;
    const float lr = logf((float)d / 16.f) / logf(8.f);
    const int large = 16 + (int)(lr * 16.f);
    return large < 31 ? large : 31;
}

DI void attn_tile(const bf16_t* __restrict__ QF, const bf16_t* __restrict__ KF2, const bf16_t* __restrict__ VF, const float* bias_lds, const float* __restrict__ sink, bf16_t* __restrict__ OR, int tile, int tid) {
    tid = opaque_v(tid); tile = opaque_s(tile);
    const int lane = tid & 63, w = __builtin_amdgcn_readfirstlane(tid >> 6), r5 = lane & 31, hh = lane >> 5;
    const bool has_prev = (tile & 31) != 0;
    for (int task = w; task < 32; task += 8) {
        const int qh = task >> 2, qt = task & 3, kvh = qh >> 2;
        bf16x8 bq[4];
#pragma unroll
        for (int ks = 0; ks < 4; ++ks) bq[ks] = *(const bf16x8*)(QF + ((unsigned)((((tile * 8 + qh) * 4 + ks) * 4 + qt) * 64 + lane)) * 8);
        f32x16 sc[5];
#pragma unroll
        for (int grp = 0; grp < 2; ++grp) {
            bf16x8 kf[3][4];
#pragma unroll
            for (int jq = 0; jq < 3; ++jq) if (grp * 3 + jq < 5) {
                const int jj = grp * 3 + jq, j = qt + jj, st = (j >= 4 || !has_prev) ? tile : tile - 1, kt = j & 3;
#pragma unroll
                for (int ks = 0; ks < 4; ++ks) kf[jq][ks] = *(const bf16x8*)(KF2 + ((unsigned)((((st * 2 + kvh) * 4 + ks) * 4 + kt) * 64 + lane)) * 8);
            }
#pragma unroll
            for (int jq = 0; jq < 3; ++jq) if (grp * 3 + jq < 5) {
                const int jj = grp * 3 + jq;
#pragma unroll
                for (int i = 0; i < 16; ++i) sc[jj][i] = 0.f;
#pragma unroll
                for (int ks = 0; ks < 4; ++ks) sc[jj] = MFMA32(kf[jq][ks], bq[ks], sc[jj]);
            }
            __builtin_amdgcn_sched_barrier(0);
        }
        bf16x8 vf[5][2][2];
#pragma unroll
        for (int jj = 0; jj < 2; ++jj) {
            const int j = qt + jj, st = (j >= 4 || !has_prev) ? tile : tile - 1, kt = j & 3;
#pragma unroll
            for (int s2 = 0; s2 < 2; ++s2)
#pragma unroll
                for (int dt = 0; dt < 2; ++dt) vf[jj][s2][dt] = *(const bf16x8*)(VF + ((unsigned)(((((st * 2 + kvh) * 2 + dt) * 4 + kt) * 2 + s2) * 64 + lane)) * 8);
        }
        const float* bl = bias_lds + qh * 128;
        float m = -1e30f;
#pragma unroll
        for (int jj = 0; jj < 5; ++jj) {
            const bool ex = (qt + jj >= 4) || has_prev;
#pragma unroll
            for (int i = 0; i < 16; ++i) {
                const int cr = (i & 3) + 8 * (i >> 2) + 4 * hh;
                const int dist = 128 + r5 - 32 * jj - cr;
                const bool valid = ex && dist >= 0 && dist < 128;
                const float v = valid ? sc[jj][i] + bl[dist & 127] : -1e30f;
                sc[jj][i] = v; m = fmaxf(m, v);
            }
        }
        m = fmaxf(m, __shfl_xor(m, 32));
        const float sk = sink[qh];
        m = fmaxf(m, sk);
        float l = 0.f;
#pragma unroll
        for (int jj = 0; jj < 5; ++jj)
#pragma unroll
            for (int i = 0; i < 16; ++i) { const float p = __expf(sc[jj][i] - m); sc[jj][i] = p; l += p; }
        l += __shfl_xor(l, 32);
        l += __expf(sk - m);
        const float rl = 1.f / l;
        f32x16 o[2];
#pragma unroll
        for (int dt = 0; dt < 2; ++dt)
#pragma unroll
            for (int i = 0; i < 16; ++i) o[dt][i] = 0.f;
        __builtin_amdgcn_sched_barrier(0);
#pragma unroll
        for (int jj = 2; jj < 5; ++jj) {
            const int j = qt + jj, st = (j >= 4 || !has_prev) ? tile : tile - 1, kt = j & 3;
#pragma unroll
            for (int s2 = 0; s2 < 2; ++s2)
#pragma unroll
                for (int dt = 0; dt < 2; ++dt) vf[jj][s2][dt] = *(const bf16x8*)(VF + ((unsigned)(((((st * 2 + kvh) * 2 + dt) * 4 + kt) * 2 + s2) * 64 + lane)) * 8);
        }
#pragma unroll
        for (int jj = 0; jj < 5; ++jj) {
#pragma unroll
            for (int s = 0; s < 2; ++s) {
                const f32x16& a = sc[jj];
                u32x4 pp; pp.x = pk2(a[8 * s], a[8 * s + 1]); pp.y = pk2(a[8 * s + 2], a[8 * s + 3]); pp.z = pk2(a[8 * s + 4], a[8 * s + 5]); pp.w = pk2(a[8 * s + 6], a[8 * s + 7]);
                const bf16x8 pb = __builtin_bit_cast(bf16x8, pp);
#pragma unroll
                for (int dt = 0; dt < 2; ++dt) o[dt] = MFMA32(vf[jj][s][dt], pb, o[dt]);
            }
        }
        bf16_t* orow = OR + (unsigned)((tile * 128 + qt * 32 + r5) * 512 + qh * 64 + 4 * hh);
#pragma unroll
        for (int dt = 0; dt < 2; ++dt)
#pragma unroll
            for (int gq = 0; gq < 4; ++gq) {
                u32x2 ov; ov.x = pk2(o[dt][4 * gq] * rl, o[dt][4 * gq + 1] * rl); ov.y = pk2(o[dt][4 * gq + 2] * rl, o[dt][4 * gq + 3] * rl);
                *(u32x2*)(orow + dt * 32 + 8 * gq) = ov;
            }
    }
}

DI void unpack8(const u32x4 v, float (&f)[8]) {
    f[0] = __uint_as_float(v.x << 16); f[1] = __uint_as_float(v.x & 0xffff0000u); f[2] = __uint_as_float(v.y << 16); f[3] = __uint_as_float(v.y & 0xffff0000u);
    f[4] = __uint_as_float(v.z << 16); f[5] = __uint_as_float(v.z & 0xffff0000u); f[6] = __uint_as_float(v.w << 16); f[7] = __uint_as_float(v.w & 0xffff0000u);
}
DI void merge_tile(const bf16_t* __restrict__ OR, const bf16_t* __restrict__ CBR, const bf16_t* __restrict__ ZR, const bf16_t* __restrict__ YS, const float* __restrict__ cw  , const float* __restrict__ og  ,
                   bf16_t* __restrict__ mA, int tile, int tid) {
    tid = opaque_v(tid); tile = opaque_s(tile);
    const int lane = tid & 63, w = tid >> 6;
#pragma unroll 4
    for (int rr = 0; rr < 16; ++rr) {
        const int row = w * 16 + rr, t = tile * 128 + row, pos = t & (S - 1);
        float a[8], y[8];
        unpack8(*(const u32x4*)(OR + (unsigned)(t * 512 + lane * 8)), a);
        float ssa = 0.f;
#pragma unroll
        for (int q = 0; q < 8; ++q) ssa += a[q] * a[q];
        ssa = wave_sum(ssa);
        if (lane < 32) {
            const int c0 = lane * 8;
            float cb[8], z0[8], z1[8], z2[8];
            unpack8(*(const u32x4*)(CBR + (unsigned)(t * 256 + c0)), cb);
            unpack8(*(const u32x4*)(ZR + (unsigned)(t * 256 + c0)), z2);
            if (pos >= 1) unpack8(*(const u32x4*)(ZR + (unsigned)((t - 1) * 256 + c0)), z1); else { _Pragma("unroll") for (int q = 0; q < 8; ++q) z1[q] = 0.f; }
            if (pos >= 2) unpack8(*(const u32x4*)(ZR + (unsigned)((t - 2) * 256 + c0)), z0); else { _Pragma("unroll") for (int q = 0; q < 8; ++q) z0[q] = 0.f; }
#pragma unroll
            for (int q = 0; q < 8; ++q) y[q] = cb[q] * (cw[c0 + q] * z0[q] + cw[256 + c0 + q] * z1[q] + cw[512 + c0 + q] * z2[q]);
        } else {
            unpack8(*(const u32x4*)(YS + (unsigned)(t * 256 + (lane - 32) * 8)), y);
        }
        float ssy = 0.f;
#pragma unroll
        for (int q = 0; q < 8; ++q) ssy += y[q] * y[q];
#pragma unroll
        for (int o = 1; o < 32; o <<= 1) ssy += __shfl_xor(ssy, o);
        const float ra = rsqrtf(ssa * (1.f / 512.f) + EPS), ry = rsqrtf(ssy * (1.f / 256.f) + EPS);
        const int mb = row >> 5, r5 = row & 31;
        {
            const float4 g0 = *(const float4*)(og + lane * 8), g1 = *(const float4*)(og + lane * 8 + 4);
            u32x4 o; o.x = pk2(a[0] * ra * g0.x, a[1] * ra * g0.y); o.y = pk2(a[2] * ra * g0.z, a[3] * ra * g0.w); o.z = pk2(a[4] * ra * g1.x, a[5] * ra * g1.y); o.w = pk2(a[6] * ra * g1.z, a[7] * ra * g1.w);
            const int c8 = lane;
            (void)c8;
            *(u32x4*)(mA + (unsigned)(t * 1024 + lane * 8)) = o;
        }
        {
            const float4 g0 = *(const float4*)(og + 512 + lane * 8), g1 = *(const float4*)(og + 512 + lane * 8 + 4);
            u32x4 o; o.x = pk2(y[0] * ry * g0.x, y[1] * ry * g0.y); o.y = pk2(y[2] * ry * g0.z, y[3] * ry * g0.w); o.z = pk2(y[4] * ry * g1.x, y[5] * ry * g1.y); o.w = pk2(y[6] * ry * g1.z, y[7] * ry * g1.w);
            const int c8 = 64 + lane;
            (void)c8;
            *(u32x4*)(mA + (unsigned)(t * 1024 + 512 + lane * 8)) = o;
        }
    }
}

struct InProjOut { bf16_t *QF, *KF2, *VF, *CBR, *ZR, *YS; };
DI void inproj_tile(const bf16_t* __restrict__ At, const bf16_t* __restrict__ WF, const float* __restrict__ qg, const float* __restrict__ kg, const bf16_t* __restrict__ SWF, const float* __restrict__ sgu_b,
                    const InProjOut& O, char* lds, int tile, int tid) {
    tid = opaque_v(tid); tile = opaque_s(tile);
    const int lane = tid & 63, w = __builtin_amdgcn_readfirstlane(tid >> 6);
    f32x16 acc[4][2];
    {
        const int nbt0 = w * 2;
        kloop<1>(acc, At, WF + (size_t)nbt0 * 32768, WF + (size_t)(nbt0 + 1) * 32768, lds, tid, lane);
        epi_qk(acc, qg, 0.125f, O.QF + (size_t)(tile * 8 + w) * 8192, lane);
    }
    {
        const int nbt0 = 16 + w * 2;
        if (w == 2 || w == 3) {
            kloop<0>(acc, At, WF + (size_t)nbt0 * 32768, WF + (size_t)(nbt0 + 1) * 32768, lds, tid, lane);
            epi_v(acc, O.VF + (size_t)(tile * 2 + (w - 2)) * 8192, lane);
        } else {
            kloop<1>(acc, At, WF + (size_t)nbt0 * 32768, WF + (size_t)(nbt0 + 1) * 32768, lds, tid, lane);
            if (w < 2) epi_qk(acc, kg, 1.f, O.KF2 + (size_t)(tile * 2 + w) * 8192, lane);
            else epi_row(acc, O.CBR + (size_t)tile * 128 * 256 + (w - 4) * 64, 256, lane);
        }
    }
    {
        const int nbt0 = 32 + w * 2;
        kloop<1>(acc, At, WF + (size_t)nbt0 * 32768, WF + (size_t)(nbt0 + 1) * 32768, lds, tid, lane);
        epi_z(acc, O.ZR + (size_t)tile * 128 * 256 + w * 32, lane);
    }
    {
        const int nbt0 = 48 + w * 2;
        kloop<0>(acc, At, WF + (size_t)nbt0 * 32768, WF + (size_t)(nbt0 + 1) * 32768, lds, tid, lane);
        unsigned* lds_su = (unsigned*)lds;
        if (w < 4) epi_su_park(acc, lds_su + w * 4096, lane);
        __syncthreads();
        if (w >= 4) epi_sv(acc, SWF + (size_t)(w - 4) * 16384, sgu_b + (w - 4) * 128, lds_su + (w - 4) * 4096, O.YS + (size_t)tile * 128 * 256 + (w - 4) * 64, lane);
        __syncthreads();
    }
}


struct Params {
    const float *x, *c, *rel_bias, *w_ada, *b_ada, *norm1_g, *norm2_g, *w_in, *q_norm_g, *k_norm_g, *attn_sink, *conv_w, *sgu_w, *sgu_b, *out_norm_g, *w_out, *peer_wq, *peer_sub_keys, *peer_down, *peer_up;
    float* out;
    char* ws;
};
constexpr size_t MiB = 1u << 20;
constexpr size_t WS_MOD = 0;
constexpr size_t WS_MODP = 1 * MiB;
constexpr size_t WS_WIN = 13 * MiB;
constexpr size_t WS_WOUT = 29 * MiB;
constexpr size_t WS_WPQ = 37 * MiB;
constexpr size_t WS_KEYS = 53 * MiB;
constexpr size_t WS_SWF = 55 * MiB;
constexpr size_t WS_SC = 56 * MiB;
constexpr size_t WS_TB = 57 * MiB;
constexpr size_t WS_HA = 185 * MiB;
constexpr size_t WS_QF = 249 * MiB;
constexpr size_t WS_KF2 = 602 * MiB;
constexpr size_t WS_VF = 634 * MiB;
constexpr size_t WS_ZR = 666 * MiB;
constexpr size_t WS_CBR = 345 * MiB;
constexpr size_t WS_YS = 361 * MiB;
constexpr size_t WS_OR = 377 * MiB;
constexpr size_t WS_QPF = 409 * MiB;
constexpr size_t WS_RIDX = 537 * MiB;
constexpr size_t WS_RGATE = 553 * MiB;
constexpr size_t WS_SEID = 569 * MiB;
constexpr size_t WS_SWGT = 585 * MiB;
constexpr size_t WS_OFFS = 601 * MiB;
constexpr size_t WS_FLAGS = 601 * MiB + 512 * 1024;
constexpr size_t WS_END = 730 * MiB;
static_assert(PL_END <= LDS_RSTD1, "expert-phase lists overlap persistent LDS state");

__global__ __launch_bounds__(512) void hybrid_fwd(Params P) {
    extern __shared__ __attribute__((aligned(16))) char lds[];
    cg::grid_group grid = cg::this_grid();
    const int tid = threadIdx.x, lane = tid & 63, w = __builtin_amdgcn_readfirstlane(tid >> 6);
    const int nblk = gridDim.x, bid = blockIdx.x;
    char* ws = P.ws;
    float* mod = (float*)(ws + WS_MOD);
    float* modp = (float*)(ws + WS_MODP);
    bf16_t* WinF = (bf16_t*)(ws + WS_WIN); bf16_t* WoutF = (bf16_t*)(ws + WS_WOUT); bf16_t* WpqF = (bf16_t*)(ws + WS_WPQ);
    bf16_t* KeysF = (bf16_t*)(ws + WS_KEYS); bf16_t* SWF = (bf16_t*)(ws + WS_SWF);
    float* SC = (float*)(ws + WS_SC); unsigned char* TBd = (unsigned char*)(ws + WS_TB); unsigned char* TBu = TBd + 32 * MiB;
    bf16_t* hA = (bf16_t*)(ws + WS_HA);
    bf16_t* OR = (bf16_t*)(ws + WS_OR); bf16_t* QPF = (bf16_t*)(ws + WS_QPF);
    int* ridx = (int*)(ws + WS_RIDX); float* rgate = (float*)(ws + WS_RGATE);
    float* bias_lds = (float*)(lds + LDS_BIAS);
    unsigned* flags = (unsigned*)(ws + WS_FLAGS);

    {
        float* ca = (float*)lds;
        for (int i = tid; i < 8192; i += 512) { const float v = P.c[i]; ca[i] = v / (1.f + __expf(-v)); }
        for (int i = tid; i < 1024; i += 512) bias_lds[i] = P.rel_bias[t5_bucket(i & 127) * 8 + (i >> 7)];
        __syncthreads();
        for (int it = bid; it < 768; it += nblk) {
            const int jc = it % 12, l = (it / 12) & 3, ks = it / 48;
            const int j = jc * 512 + tid;
            const float* wp = P.w_ada + ((size_t)l * 1024 + ks * 64) * 6144 + j;
            float acc[8];
#pragma unroll
            for (int b = 0; b < 8; ++b) acc[b] = 0.f;
#pragma unroll 4
            for (int i = 0; i < 64; ++i) {
                const float wv = wp[(size_t)i * 6144];
#pragma unroll
                for (int b = 0; b < 8; ++b) acc[b] += ca[b * 1024 + ks * 64 + i] * wv;
            }
#pragma unroll
            for (int b = 0; b < 8; ++b) modp[((size_t)(ks * 4 + l) * 8 + b) * 6144 + j] = acc[b];
        }
        const int gthreads = nblk * 512, gtid = bid * 512 + tid;
        for (int rep = 0; rep < REP_P0; ++rep)
        for (int l = 0; l < DEPTH; ++l) {
            for (int g = gtid; g < 64 * 64 * 64; g += gthreads) conv_wfrag_item(P.w_in + (size_t)l * 1024 * 2048, 2048, 64, WinF + (size_t)l * 2097152, g, 1);
            for (int g = gtid; g < 32 * 64 * 64; g += gthreads) conv_wfrag_item(P.w_out + (size_t)l * 1024 * 1024, 1024, 64, WoutF + (size_t)l * 1048576, g, 0);
            for (int g = gtid; g < 64 * 64 * 64; g += gthreads) conv_wfrag_item(P.peer_wq + (size_t)l * 1024 * 2048, 2048, 64, WpqF + (size_t)l * 2097152, g, 0);
            for (int g = gtid; g < 32768; g += gthreads) conv_keys_item(P.peer_sub_keys + (size_t)l * 262144, KeysF + (size_t)l * 262144, g);
            for (int g = gtid; g < 8192; g += gthreads) conv_sguw_item(P.sgu_w + (size_t)l * 65536, SWF + (size_t)l * 65536, g);
        }
        const int gwaves = nblk * 8, gw = bid * 8 + w;
        for (int rep = 0; rep < REP_P0; ++rep)
        for (int r = gw; r < DEPTH * 16384 * 2; r += gwaves) {
            const int which = r & 1, le = r >> 1;
            conv_table_row((which ? P.peer_up : P.peer_down) + (size_t)le * D, (which ? TBu : TBd) + (size_t)le * 512, SC + (size_t)le * 2 + which, lane, which == 0);
        }
    }
    grid.sync();
    for (int tile = bid; tile < NTILE; tile += nblk) {
        const int b = tile >> 5;
        for (int l = 0; l < DEPTH; ++l)
            for (int j = tid; j < 6144; j += 512) {
                float v = P.b_ada[l * 6144 + j];
#pragma unroll
                for (int ks = 0; ks < 16; ++ks) v += modp[((size_t)(ks * 4 + l) * 8 + b) * 6144 + j];
                mod[((size_t)l * 8 + b) * 6144 + j] = v;
            }
    }
    __syncthreads();

    for (int l = 0; l < DEPTH; ++l) {
        const float* xin = l == 0 ? P.x : P.out;
        InProjOut IO;
        IO.QF = (bf16_t*)(ws + WS_QF); IO.KF2 = (bf16_t*)(ws + WS_KF2 + (size_t)l * 8 * MiB); IO.VF = (bf16_t*)(ws + WS_VF + (size_t)l * 8 * MiB);
        IO.CBR = (bf16_t*)(ws + WS_CBR); IO.ZR = (bf16_t*)(ws + WS_ZR + (size_t)l * 16 * MiB); IO.YS = (bf16_t*)(ws + WS_YS);
        for (int tile = bid; tile < NTILE; tile += nblk) {
            const float* mb_ = mod + ((size_t)l * 8 + (tile >> 5)) * 6144;
            const bool have1 = l > 0 && nblk == NTILE;
            if (have1) { if (tid < 128) ((float*)lds)[tid] = ((const float*)(lds + LDS_RSTD1))[tid]; __syncthreads(); }
            norm_to_frag(xin, P.norm1_g + l * D, mb_ + 0, mb_ + 1024, hA, (float*)lds, tile, tid, have1);
            __syncthreads();
            for (int rep = 0; rep < REP_GEMM; ++rep) inproj_tile(hA + (size_t)tile * 131072, WinF + (size_t)l * 2097152, P.q_norm_g + l * 64, P.k_norm_g + l * 64, SWF + (size_t)l * 65536, P.sgu_b + l * 512, IO, lds, tile, tid);
            asm volatile("s_waitcnt vmcnt(0)" ::: "memory");
            __syncthreads();
            if (tid == 0) {
                __builtin_amdgcn_fence(__ATOMIC_RELEASE, "agent");
                asm volatile("s_waitcnt vmcnt(0)" ::: "memory");
                __hip_atomic_store(flags + tile, (unsigned)(l + 1), __ATOMIC_RELAXED, __HIP_MEMORY_SCOPE_AGENT);
            }
        }
        for (int tile = bid; tile < NTILE; tile += nblk) {
            const float* mb_ = mod + ((size_t)l * 8 + (tile >> 5)) * 6144;
            if ((tile & 31) != 0) {
                if (tid == 0) {
                    unsigned spins = 0;
                    while (__hip_atomic_load(flags + tile - 1, __ATOMIC_RELAXED, __HIP_MEMORY_SCOPE_AGENT) < (unsigned)(l + 1) && ++spins < (1u << 24)) __builtin_amdgcn_s_sleep(2);
                    __builtin_amdgcn_fence(__ATOMIC_ACQUIRE, "agent");
                    asm volatile("s_waitcnt vmcnt(0)" ::: "memory");
                }
                __syncthreads();
            }
            for (int rep = 0; rep < REP_MIX; ++rep) {
            attn_tile(IO.QF, IO.KF2, IO.VF, bias_lds, P.attn_sink + l * 8, OR, tile, tid);
            __syncthreads();
            merge_tile(OR, IO.CBR, IO.ZR, IO.YS, P.conv_w + l * 768, P.out_norm_g + l * D, hA, tile, tid);
            __syncthreads();
            }
            {
                const bf16_t* At = hA + (size_t)tile * 131072;
                const bf16_t* WF = WoutF + (size_t)l * 1048576;
                for (int pass = 0; pass < 2; ++pass) {
                    f32x16 acc[4][2];
                    const int nbt0 = pass * 16 + w * 2;
                    kloop<0>(acc, At, WF + (size_t)nbt0 * 32768, WF + (size_t)(nbt0 + 1) * 32768, lds, tid, lane);
                    epi_resid(acc, xin, P.out, mb_ + 2048, (float*)(lds + LDS_EPI) + w * 2176, (float*)(lds + LDS_SSQ) + (pass * 8 + w) * 128, tile, pass * 512 + w * 64, lane);
                }
            }
            __syncthreads();
            if (tid < 128) { const float* sq = (const float*)(lds + LDS_SSQ); float ssum = 0.f;
#pragma unroll
                for (int c = 0; c < 16; ++c) ssum += sq[c * 128 + tid];
                ((float*)lds)[tid] = rsqrtf(ssum * (1.f / D) + EPS); }
            __syncthreads();
            norm_to_frag(P.out, P.norm2_g + l * D, mb_ + 3072, mb_ + 4096, hA, (float*)lds, tile, tid, true);
            __syncthreads();
            {
                const bf16_t* At = hA + (size_t)tile * 131072;
                const bf16_t* WF = WpqF + (size_t)l * 2097152;
                for (int rep = 0; rep < REP_GEMM; ++rep)
                for (int pass = 0; pass < 4; ++pass) {
                    f32x16 acc[4][2];
                    const int nbt0 = pass * 16 + w * 2;
                    kloop<1>(acc, At, WF + (size_t)nbt0 * 32768, WF + (size_t)(nbt0 + 1) * 32768, lds, tid, lane);
                    epi_qpf(acc, QPF, tile, nbt0, lane);
                }
            }
            __syncthreads();
            for (int rep = 0; rep < REP_ROUTE; ++rep) { route_tile(QPF, KeysF + (size_t)l * 262144, lds, (unsigned char*)lds + PL_RIDX, tile, tid); __syncthreads(); }
            peer_down_wave(hA, lds, TBd + (size_t)l * 16384 * 512, SC + (size_t)l * 32768, tile, w, lane);
            __syncthreads();
            peer_up_wave(lds, TBu + (size_t)l * 16384 * 512, mb_ + 5120, P.out, tile, w, lane);
            __syncthreads();
        }
    }
}
}

extern "C" void kernel_launch(void* const* d_in, const int* in_sizes, int n_in, void* d_out, int out_size, void* d_ws, size_t ws_size, hipStream_t stream) {
    using namespace op;
    static int grid_blocks = 0;
    if (!grid_blocks) {
        int dev = 0, cus = 0, per_cu = 0;
        (void)hipGetDevice(&dev);
        (void)hipDeviceGetAttribute(&cus, hipDeviceAttributeMultiprocessorCount, dev);
        (void)hipFuncSetAttribute((const void*)hybrid_fwd, hipFuncAttributeMaxDynamicSharedMemorySize, LDS_BYTES);
        (void)hipOccupancyMaxActiveBlocksPerMultiprocessor(&per_cu, (const void*)hybrid_fwd, 512, LDS_BYTES);
        if (per_cu < 1) per_cu = 1;
        grid_blocks = cus * per_cu;
        if (grid_blocks > NTILE) grid_blocks = NTILE;
        if (ws_size < WS_END) { fprintf(stderr, "kernel_launch: workspace too small (%zu < %zu)\n", ws_size, (size_t)WS_END); grid_blocks = -1; }
    }
    if (grid_blocks < 0) return;
    Params p{};
    p.x = (const float*)d_in[0]; p.c = (const float*)d_in[1]; p.rel_bias = (const float*)d_in[2]; p.w_ada = (const float*)d_in[3]; p.b_ada = (const float*)d_in[4];
    p.norm1_g = (const float*)d_in[5]; p.norm2_g = (const float*)d_in[6]; p.w_in = (const float*)d_in[7]; p.q_norm_g = (const float*)d_in[8]; p.k_norm_g = (const float*)d_in[9];
    p.attn_sink = (const float*)d_in[10]; p.conv_w = (const float*)d_in[11]; p.sgu_w = (const float*)d_in[12]; p.sgu_b = (const float*)d_in[13]; p.out_norm_g = (const float*)d_in[14];
    p.w_out = (const float*)d_in[15]; p.peer_wq = (const float*)d_in[16]; p.peer_sub_keys = (const float*)d_in[17]; p.peer_down = (const float*)d_in[18]; p.peer_up = (const float*)d_in[19];
    p.out = (float*)d_out; p.ws = (char*)d_ws;
    (void)hipMemsetAsync((char*)d_ws + WS_FLAGS, 0, 1024, stream);
    void* args[] = {&p};
    hipError_t e = hipLaunchCooperativeKernel((const void*)hybrid_fwd, dim3(grid_blocks), dim3(512), args, LDS_BYTES, stream);
    if (e != hipSuccess) fprintf(stderr, "kernel_launch: cooperative launch failed: %s (grid %d)\n", hipGetErrorString(e), grid_blocks);
}
```

```cpp
#include <hip/hip_runtime.h>
#include <cstdio>
#include <cstdint>
#include <hip/hip_cooperative_groups.h>
namespace cg = cooperative_groups;


namespace op {
#define DI __device__ __forceinline__
typedef unsigned short bf16_t;
typedef short bf16x8 __attribute__((ext_vector_type(8)));
typedef float f32x16 __attribute__((ext_vector_type(16)));
typedef float f32x2 __attribute__((ext_vector_type(2)));
typedef unsigned u32x4 __attribute__((ext_vector_type(4)));
typedef unsigned u32x2 __attribute__((ext_vector_type(2)));
typedef __bf16 bf16v2 __attribute__((ext_vector_type(2)));
constexpr int D = 1024, NB = 8, S = 4096, DEPTH = 4, T = NB * S, NTILE = T / 128;
constexpr float EPS = 1e-6f;
constexpr int PL_SEID = 0, PL_SWGT = 32768, PL_END = 98304, PL_RIDX = 98304;
constexpr int LDS_EPI = 32768, LDS_SSQ = 102400, LDS_RSTD1 = 110592, LDS_BIAS = 112 * 1024, LDS_BYTES = 116 * 1024;
constexpr int REP_GEMM = 1, REP_ROUTE = 1, REP_MIX = 1, REP_NORM = 1, REP_P0 = 1;
#define MFMA32(a, b, c) __builtin_amdgcn_mfma_f32_32x32x16_bf16((a), (b), (c), 0, 0, 0)

DI unsigned pk2(float lo, float hi) { f32x2 v = {lo, hi}; return __builtin_bit_cast(unsigned, __builtin_convertvector(v, bf16v2)); }
DI int opaque_v(int x) { asm volatile("" : "+v"(x)); return x; }
DI int opaque_s(int x) { asm volatile("" : "+s"(x)); return x; }
DI int crow(int reg, int hh) { return (reg & 3) + 8 * (reg >> 2) + 4 * hh; }
DI float wave_sum(float v) {
#pragma unroll
    for (int o = 1; o < 64; o <<= 1) v += __shfl_xor(v, o);
    return v;
}

DI int col_perm(int npos, int mode) {
    if (mode == 1 && npos >= 1024 && npos < 1536) { const int q = npos - 1024, w = q >> 6, nb = (q >> 5) & 1, r = q & 31; return (nb ? 1280 : 1024) + 32 * w + r; }
    return npos;
}
DI void conv_wfrag_item(const float* __restrict__ W, int N, int KB, bf16_t* __restrict__ WF, int gid, int mode) {
    const int l = gid & 63, kb = (gid >> 6) % KB, nbt = (gid >> 6) / KB, r = l & 31, hh = l >> 5;
    const int n = col_perm(nbt * 32 + r, mode);
    const float* p = W + (size_t)(kb * 16 + 8 * hh) * N + n;
    float v[8];
#pragma unroll
    for (int j = 0; j < 8; ++j) v[j] = p[(size_t)j * N];
    u32x4 o; o.x = pk2(v[0], v[1]); o.y = pk2(v[2], v[3]); o.z = pk2(v[4], v[5]); o.w = pk2(v[6], v[7]);
    *(u32x4*)(WF + (size_t)gid * 8) = o;
}

DI void norm_to_frag(const float* __restrict__ x, const float* __restrict__ g, const float* __restrict__ sh, const float* __restrict__ sc, bf16_t* __restrict__ hA, float* rstd_lds, int tile, int tid, bool have_rstd) {
    tid = opaque_v(tid); tile = opaque_s(tile);
    const int w = tid >> 6, lane = tid & 63;
    float cg[16], cs[16], ch[16];
#pragma unroll
    for (int j = 0; j < 2; ++j)
#pragma unroll
        for (int q = 0; q < 2; ++q) {
            const int c = 512 * j + 8 * lane + 4 * q;
            const float4 a = *(const float4*)(g + c), b = *(const float4*)(sc + c), d = *(const float4*)(sh + c);
            cg[8 * j + 4 * q] = a.x * (1.f + b.x); cg[8 * j + 4 * q + 1] = a.y * (1.f + b.y); cg[8 * j + 4 * q + 2] = a.z * (1.f + b.z); cg[8 * j + 4 * q + 3] = a.w * (1.f + b.w);
            ch[8 * j + 4 * q] = d.x; ch[8 * j + 4 * q + 1] = d.y; ch[8 * j + 4 * q + 2] = d.z; ch[8 * j + 4 * q + 3] = d.w;
            cs[8 * j + 4 * q] = 0.f; cs[8 * j + 4 * q + 1] = 0.f; cs[8 * j + 4 * q + 2] = 0.f; cs[8 * j + 4 * q + 3] = 0.f;
        }
    (void)cs;
#pragma unroll 4
    for (int rr = 0; rr < 16; ++rr) {
        const int row = w * 16 + rr;
        const float* xr = x + ((size_t)tile * 128 + row) * D + 8 * lane;
        float v[16];
#pragma unroll
        for (int j = 0; j < 2; ++j)
#pragma unroll
            for (int q = 0; q < 2; ++q) { const float4 a = *(const float4*)(xr + 512 * j + 4 * q); v[8 * j + 4 * q] = a.x; v[8 * j + 4 * q + 1] = a.y; v[8 * j + 4 * q + 2] = a.z; v[8 * j + 4 * q + 3] = a.w; }
        float r;
        if (have_rstd) r = rstd_lds[row];
        else {
            float ss = 0.f;
#pragma unroll
            for (int e = 0; e < 16; ++e) ss += v[e] * v[e];
            r = rsqrtf(wave_sum(ss) * (1.f / D) + EPS);
        }
        bf16_t* orow = hA + ((size_t)tile * 128 + row) * D + 8 * lane;
#pragma unroll
        for (int j = 0; j < 2; ++j) {
            u32x4 o;
            o.x = pk2(v[8 * j] * r * cg[8 * j] + ch[8 * j], v[8 * j + 1] * r * cg[8 * j + 1] + ch[8 * j + 1]);
            o.y = pk2(v[8 * j + 2] * r * cg[8 * j + 2] + ch[8 * j + 2], v[8 * j + 3] * r * cg[8 * j + 3] + ch[8 * j + 3]);
            o.z = pk2(v[8 * j + 4] * r * cg[8 * j + 4] + ch[8 * j + 4], v[8 * j + 5] * r * cg[8 * j + 5] + ch[8 * j + 5]);
            o.w = pk2(v[8 * j + 6] * r * cg[8 * j + 6] + ch[8 * j + 6], v[8 * j + 7] * r * cg[8 * j + 7] + ch[8 * j + 7]);
            *(u32x4*)(orow + 512 * j) = o;
        }
    }
}

template <int ORIENT>
DI void kloop(f32x16 (&acc)[4][2], const bf16_t* __restrict__ At, const bf16_t* __restrict__ W0, const bf16_t* __restrict__ W1, char* lds, int tid, int lane) {
    tid = opaque_v(tid); lane = opaque_v(lane);
#pragma unroll
    for (int mb = 0; mb < 4; ++mb)
#pragma unroll
        for (int nb = 0; nb < 2; ++nb)
#pragma unroll
            for (int i = 0; i < 16; ++i) acc[mb][nb][i] = 0.f;
    {
    const int c8_ = (tid >> 3) & 7, rowA_ = (tid >> 6) * 8 + (tid & 7);
    const u32x4* Ag = (const u32x4*)(At + (unsigned)(rowA_ * 1024 + c8_ * 8));
    const int ldsA_ = ((((c8_ >> 1) * 4 + (rowA_ >> 5)) * 64) + (rowA_ & 31) + 32 * (c8_ & 1)) * 16;
    const u32x4* W0g = (const u32x4*)W0 + lane;
    const u32x4* W1g = (const u32x4*)W1 + lane;
    u32x4 wq[4][2], arA[2], arB[2];
    arA[0] = Ag[0]; arA[1] = Ag[8192]; arB[0] = Ag[8]; arB[1] = Ag[8 + 8192];
#pragma unroll
    for (int kk = 0; kk < 4; ++kk) { wq[kk][0] = W0g[kk * 64]; wq[kk][1] = W1g[kk * 64]; }
    *(u32x4*)(lds + ldsA_) = arA[0]; *(u32x4*)(lds + ldsA_ + 2048) = arA[1];
    __syncthreads();
#define KL_ITER(KC, ARL, ARS) do { \
        char* cur = lds + ((KC) & 1) * 16384; \
        char* nxt = lds + (((KC) + 1) & 1) * 16384; \
        const int kn = (KC) < 15 ? (KC) + 1 : 15, k2 = (KC) < 14 ? (KC) + 2 : 15; \
        ARL[0] = Ag[k2 * 8]; ARL[1] = Ag[k2 * 8 + 8192]; \
        __builtin_amdgcn_sched_barrier(0); \
        _Pragma("unroll") for (int kk = 0; kk < 4; ++kk) { \
            bf16x8 afr[4]; \
            _Pragma("unroll") for (int mb = 0; mb < 4; ++mb) afr[mb] = *(const bf16x8*)(cur + ((kk * 4 + mb) * 64 + lane) * 16); \
            _Pragma("unroll") for (int mb = 0; mb < 4; ++mb) \
                _Pragma("unroll") for (int nb = 0; nb < 2; ++nb) { \
                    const bf16x8 wf = __builtin_bit_cast(bf16x8, wq[kk][nb]); \
                    if (ORIENT == 0) acc[mb][nb] = MFMA32(afr[mb], wf, acc[mb][nb]); \
                    else acc[mb][nb] = MFMA32(wf, afr[mb], acc[mb][nb]); \
                } \
            wq[kk][0] = W0g[(kn * 4 + kk) * 64]; wq[kk][1] = W1g[(kn * 4 + kk) * 64]; \
            __builtin_amdgcn_sched_barrier(0); \
        } \
        if ((KC) < 15) { *(u32x4*)(nxt + ldsA_) = ARS[0]; *(u32x4*)(nxt + ldsA_ + 2048) = ARS[1]; } \
        __syncthreads(); \
    } while (0)
    for (int kc = 0; kc < 16; kc += 2) { KL_ITER(kc, arA, arB); KL_ITER(kc + 1, arB, arA); }
#undef KL_ITER
    }
}

DI void epi_f32row(const f32x16 (&acc)[4][2], float* __restrict__ C, int tile, int col0, int lane) {
    lane = opaque_v(lane);
    const int r5 = lane & 31, hh = lane >> 5;
    const unsigned boff = (unsigned)((tile * 128 + 4 * hh) * 2048 + col0 + r5);
#pragma unroll
    for (int mb = 0; mb < 4; ++mb)
#pragma unroll
        for (int nb = 0; nb < 2; ++nb)
#pragma unroll
            for (int i = 0; i < 16; ++i)
                C[boff + (unsigned)((mb * 32 + (i & 3) + 8 * (i >> 2)) * 2048 + nb * 32)] = acc[mb][nb][i];
}
DI void epi_resid(const f32x16 (&acc)[4][2], const float* __restrict__ xin, float* __restrict__ xout, const float* __restrict__ gate_b, float* T  , float* ssq  , int tile, int col0, int lane) {
    lane = opaque_v(lane);
    const int r5 = lane & 31, hh = lane >> 5, rq = lane >> 4, c4 = (lane & 15) * 4;
    const float4 gv = *(const float4*)(gate_b + col0 + c4);
#pragma unroll
    for (int mb = 0; mb < 4; ++mb) {
#pragma unroll
        for (int nb = 0; nb < 2; ++nb)
#pragma unroll
            for (int i = 0; i < 16; ++i) T[((i & 3) + 8 * (i >> 2) + 4 * hh) * 68 + nb * 32 + r5] = acc[mb][nb][i];
        asm volatile("s_waitcnt lgkmcnt(0)" ::: "memory");
#pragma unroll
        for (int j = 0; j < 8; ++j) {
            const int row = rq + 4 * j;
            const float4 v = *(const float4*)(T + row * 68 + c4);
            const unsigned o = (unsigned)((tile * 128 + mb * 32 + row) * D + col0 + c4);
            float4 xv = *(const float4*)(xin + o);
            xv.x += gv.x * v.x; xv.y += gv.y * v.y; xv.z += gv.z * v.z; xv.w += gv.w * v.w;
            *(float4*)(xout + o) = xv;
            float ss = xv.x * xv.x + xv.y * xv.y + xv.z * xv.z + xv.w * xv.w;
            ss += __shfl_xor(ss, 1); ss += __shfl_xor(ss, 2); ss += __shfl_xor(ss, 4); ss += __shfl_xor(ss, 8);
            if ((lane & 15) == 0) ssq[mb * 32 + row] = ss;
        }
        asm volatile("s_waitcnt lgkmcnt(0)" ::: "memory");
    }
}

DI void epi_qpf(const f32x16 (&acc)[4][2], bf16_t* __restrict__ QPF, int tile, int ft0, int lane) {
    lane = opaque_v(lane);
#pragma unroll
    for (int nb = 0; nb < 2; ++nb)
#pragma unroll
        for (int s = 0; s < 2; ++s)
#pragma unroll
            for (int mb = 0; mb < 4; ++mb) {
                const f32x16& a = acc[mb][nb];
                u32x4 o; o.x = pk2(a[8 * s], a[8 * s + 1]); o.y = pk2(a[8 * s + 2], a[8 * s + 3]); o.z = pk2(a[8 * s + 4], a[8 * s + 5]); o.w = pk2(a[8 * s + 6], a[8 * s + 7]);
                *(u32x4*)(QPF + ((unsigned)((((tile * 64 + ft0 + nb) * 2 + s) * 4 + mb) * 64 + lane)) * 8) = o;
            }
}

DI void conv_keys_item(const float* __restrict__ K, bf16_t* __restrict__ KF, int gid) {
    const int lane = gid & 63, s = (gid >> 6) & 1, nbl = (gid >> 7) & 3, nt = (gid >> 9) & 3, hp = gid >> 11;
    const int r = lane & 31, hh = lane >> 5;
    const float* p = K + ((size_t)hp * 128 + nt * 32 + r) * 128 + nbl * 32 + 16 * s + 4 * hh;
    const float4 a = *(const float4*)p, b = *(const float4*)(p + 8);
    u32x4 o; o.x = pk2(a.x, a.y); o.y = pk2(a.z, a.w); o.z = pk2(b.x, b.y); o.w = pk2(b.z, b.w);
    *(u32x4*)(KF + (size_t)gid * 8) = o;
}

DI void conv_table_row(const float* __restrict__ src, unsigned char* __restrict__ dst, float* __restrict__ sc, int lane, bool as_int4) {
    const float4* p = (const float4*)src + lane * 4;
    float4 v[4];
    float m = 0.f;
#pragma unroll
    for (int j = 0; j < 4; ++j) { v[j] = p[j]; m = fmaxf(m, fmaxf(fmaxf(fabsf(v[j].x), fabsf(v[j].y)), fmaxf(fabsf(v[j].z), fabsf(v[j].w)))); }
#pragma unroll
    for (int o = 1; o < 64; o <<= 1) m = fmaxf(m, __shfl_xor(m, o));
    float scale = m > 0.f ? m * (1.f / 6.f) : 1.f;
    if (as_int4) {
        float ss = 0.f;
#pragma unroll
        for (int j = 0; j < 4; ++j) ss += v[j].x * v[j].x + v[j].y * v[j].y + v[j].z * v[j].z + v[j].w * v[j].w;
        ss = wave_sum(ss);
        const float sg = sqrtf(ss * (1.f / 1024.f));
        scale = fmaxf(sg * (1.f / 2.8f), m * (1.f / 16.f));
        if (!(scale > 0.f)) scale = 1.f;
    }
    const float inv = 1.f / scale;
    u32x2 o;
    unsigned* op = (unsigned*)&o;
#pragma unroll
    for (int j = 0; j < 2; ++j) {
        const float f[8] = {v[2 * j].x, v[2 * j].y, v[2 * j].z, v[2 * j].w, v[2 * j + 1].x, v[2 * j + 1].y, v[2 * j + 1].z, v[2 * j + 1].w};
        unsigned wv = 0;
        if (as_int4) {
#pragma unroll
            for (int e = 0; e < 8; ++e) { int q = __float2int_rn(f[e] * inv); q = q < -7 ? -7 : (q > 7 ? 7 : q); wv |= ((unsigned)q & 15u) << (4 * e); }
        } else {
            wv = __builtin_amdgcn_cvt_scalef32_pk_fp4_f32(wv, f[0] * inv, f[1] * inv, 1.0f, 0);
            wv = __builtin_amdgcn_cvt_scalef32_pk_fp4_f32(wv, f[2] * inv, f[3] * inv, 1.0f, 1);
            wv = __builtin_amdgcn_cvt_scalef32_pk_fp4_f32(wv, f[4] * inv, f[5] * inv, 1.0f, 2);
            wv = __builtin_amdgcn_cvt_scalef32_pk_fp4_f32(wv, f[6] * inv, f[7] * inv, 1.0f, 3);
        }
        op[j] = wv;
    }
    *(u32x2*)(dst + lane * 8) = o;
    if (lane == 0) *sc = scale;
}

DI void ce_desc(int& a, int& b) { const int mx = a > b ? a : b, mn = a > b ? b : a; a = mx; b = mn; }
DI void sort16_desc(int (&v)[16]) {
#pragma unroll
    for (int k = 2; k <= 16; k <<= 1)
#pragma unroll
        for (int j = k >> 1; j > 0; j >>= 1)
#pragma unroll
            for (int i = 0; i < 16; ++i) {
                const int l = i ^ j;
                if (l > i) { if ((i & k) == 0) ce_desc(v[i], v[l]); else ce_desc(v[l], v[i]); }
            }
}
DI void bitonic_merge16_desc(int (&v)[16]) {
#pragma unroll
    for (int j = 8; j > 0; j >>= 1)
#pragma unroll
        for (int i = 0; i < 16; ++i) { const int l = i ^ j; if (l > i) ce_desc(v[i], v[l]); }
}
DI void merge_top16(int (&a)[16], const int (&b)[16]) {
#pragma unroll
    for (int i = 0; i < 16; ++i) a[i] = a[i] > b[15 - i] ? a[i] : b[15 - i];
    bitonic_merge16_desc(a);
}
DI int f2ord(float f) { int b = __float_as_int(f); return b ^ ((b >> 31) & 0x7fffffff); }
DI float ord2f(int k) { return __int_as_float(k ^ ((k >> 31) & 0x7fffffff)); }

DI void route_tile(const bf16_t* __restrict__ QPF, const bf16_t* __restrict__ KF, char* lds_lists, unsigned char* lds_idx  , int tile, int tid) {
    tid = opaque_v(tid); tile = opaque_s(tile);
    const int lane = tid & 63, w = __builtin_amdgcn_readfirstlane(tid >> 6);
    const int r5 = lane & 31, hh = lane >> 5;
    unsigned char* myidx = lds_idx + w * 1024;
    for (int task = w; task < 32; task += 8) {
        const int h = task >> 2, tt = task & 3;
        f32x16 acc[2][4];
#pragma unroll
        for (int p = 0; p < 2; ++p)
#pragma unroll
            for (int nt = 0; nt < 4; ++nt)
#pragma unroll
                for (int i = 0; i < 16; ++i) acc[p][nt][i] = 0.f;
        {
            bf16x8 bq[2], ak[2][4];
#define ROUTE_LOAD(buf, step) do { const int p_ = (step) >> 3, ks_ = (step) & 7; \
                bq[buf] = *(const bf16x8*)(QPF + ((unsigned)((((tile * 64 + h * 8 + p_ * 4 + (ks_ >> 1)) * 2 + (ks_ & 1)) * 4 + tt) * 64 + lane)) * 8); \
                _Pragma("unroll") for (int nt = 0; nt < 4; ++nt) ak[buf][nt] = *(const bf16x8*)(KF + ((unsigned)(((((h * 2 + p_) * 4 + nt) * 8 + ks_) * 64) + lane)) * 8); } while (0)
            ROUTE_LOAD(0, 0);
#pragma unroll
            for (int step = 0; step < 16; ++step) {
                if (step < 15) ROUTE_LOAD((step + 1) & 1, step + 1);
#pragma unroll
                for (int nt = 0; nt < 4; ++nt) acc[step >> 3][nt] = MFMA32(ak[step & 1][nt], bq[step & 1], acc[step >> 3][nt]);
                __builtin_amdgcn_sched_barrier(0);
            }
#undef ROUTE_LOAD
        }
        int g[8][16];
#pragma unroll
        for (int nt = 0; nt < 4; ++nt)
#pragma unroll
            for (int i = 0; i < 16; ++i) {
                const unsigned a = __float_as_uint(acc[0][nt][i]), b = __float_as_uint(acc[1][nt][i]);
                auto sw = __builtin_amdgcn_permlane32_swap(a, b, false, false);
                const int n0 = nt * 32 + (i & 3) + 8 * (i >> 2);
                g[nt * 2 + (i >> 3)][i & 7] = (f2ord(__uint_as_float(sw[0])) & ~127) | n0;
                g[nt * 2 + (i >> 3)][8 + (i & 7)] = (f2ord(__uint_as_float(sw[1])) & ~127) | (n0 + 4);
            }
#pragma unroll
        for (int q = 0; q < 8; ++q) sort16_desc(g[q]);
        merge_top16(g[0], g[1]); merge_top16(g[2], g[3]); merge_top16(g[4], g[5]); merge_top16(g[6], g[7]);
        merge_top16(g[0], g[2]); merge_top16(g[4], g[6]);
        merge_top16(g[0], g[4]);
        {
            u32x4 pk;
            unsigned* pp = (unsigned*)&pk;
#pragma unroll
            for (int q = 0; q < 4; ++q) pp[q] = (unsigned)(g[0][4 * q] & 127) | ((unsigned)(g[0][4 * q + 1] & 127) << 8) | ((unsigned)(g[0][4 * q + 2] & 127) << 16) | ((unsigned)(g[0][4 * q + 3] & 127) << 24);
            *(u32x4*)(myidx + lane * 16) = pk;
        }
        float f0[16], f1[16];
#pragma unroll
        for (int i = 0; i < 16; ++i) {
            const unsigned a = (unsigned)g[0][i], b = a;
            auto sw = __builtin_amdgcn_permlane32_swap(a, b, false, false);
            f0[i] = ord2f((int)sw[0] & ~127); f1[i] = ord2f((int)sw[1] & ~127);
        }
        int c0[16], c1[16], c2[16], c3[16];
#pragma unroll
        for (int j = 0; j < 16; ++j) c0[j] = (f2ord(f0[0] + f1[j]) & ~255) | j;
#pragma unroll
        for (int i = 1; i < 16; ++i) c1[i - 1] = (f2ord(f0[i] + f1[0]) & ~255) | (i << 4);
        c1[15] = (int)0x80000000;
#define CK(i, j) ((f2ord(f0[i] + f1[j]) & ~255) | ((i) << 4) | (j))
        c2[0] = CK(1, 1); c2[1] = CK(1, 2); c2[2] = CK(1, 3); c2[3] = CK(1, 4); c2[4] = CK(1, 5); c2[5] = CK(1, 6); c2[6] = CK(1, 7);
        c2[7] = CK(2, 1); c2[8] = CK(2, 2); c2[9] = CK(2, 3); c2[10] = CK(2, 4);
        c2[11] = CK(3, 1); c2[12] = CK(3, 2); c2[13] = CK(3, 3);
        c2[14] = CK(4, 1); c2[15] = CK(4, 2);
        c3[0] = CK(5, 1); c3[1] = CK(6, 1); c3[2] = CK(7, 1);
#undef CK
#pragma unroll
        for (int q = 3; q < 16; ++q) c3[q] = (int)0x80000000;
        sort16_desc(c2);
        ce_desc(c3[0], c3[1]); ce_desc(c3[1], c3[2]); ce_desc(c3[0], c3[1]);
        merge_top16(c0, c1); merge_top16(c2, c3); merge_top16(c0, c2);
        float bs[16], den = 0.f;
#pragma unroll
        for (int i = 0; i < 16; ++i) { bs[i] = __expf(ord2f(c0[i] & ~255) - ord2f(c0[0] & ~255)); den += bs[i]; }
        const float rden = 1.f / den;
        asm volatile("s_waitcnt lgkmcnt(0)" ::: "memory");
#pragma unroll
        for (int q = 0; q < 8; ++q) {
            const int key = (int)__builtin_amdgcn_permlane32_swap((unsigned)c0[q], (unsigned)c0[8 + q], false, false)[0];
            const float gv = __uint_as_float(__builtin_amdgcn_permlane32_swap(__float_as_uint(bs[q]), __float_as_uint(bs[8 + q]), false, false)[0]) * rden;
            const int i = (key >> 4) & 15, j = key & 15;
            const int e = (int)myidx[r5 * 16 + i] * 128 + (int)myidx[(32 + r5) * 16 + j];
            const int tokl = tt * 32 + r5;
            ((unsigned short*)(lds_lists + PL_SEID))[tokl * 128 + h * 16 + 8 * hh + q] = (unsigned short)e;
            ((float*)(lds_lists + PL_SWGT))[tokl * 128 + h * 16 + 8 * hh + q] = gv;
        }
        asm volatile("s_waitcnt lgkmcnt(0)" ::: "memory");
    }
}

DI void unpack_h2(const bf16_t* __restrict__ hA, int t, int lane, f32x2 (&hv)[8]) {
    const int tile = t >> 7, row = t & 127, mb = row >> 5, r5 = row & 31;
    const bf16_t* hp = hA + ((unsigned)(((tile * 64 + lane) * 4 + mb) * 64 + r5)) * 8;
    const u32x4 ha = *(const u32x4*)hp, hb = *(const u32x4*)(hp + 32 * 8);
    const unsigned hw[8] = {ha.x, ha.y, ha.z, ha.w, hb.x, hb.y, hb.z, hb.w};
#pragma unroll
    for (int q = 0; q < 8; ++q) { hv[q].x = __uint_as_float(hw[q] << 16); hv[q].y = __uint_as_float(hw[q] & 0xffff0000u); }
}
typedef _Float16 h16x2 __attribute__((ext_vector_type(2)));
DI h16x2 fp4h(unsigned w, int sel) {
    return sel == 0 ? __builtin_amdgcn_cvt_scalef32_pk_f16_fp4(w, 1.0f, 0) : sel == 1 ? __builtin_amdgcn_cvt_scalef32_pk_f16_fp4(w, 1.0f, 1)
         : sel == 2 ? __builtin_amdgcn_cvt_scalef32_pk_f16_fp4(w, 1.0f, 2) : __builtin_amdgcn_cvt_scalef32_pk_f16_fp4(w, 1.0f, 3);
}
DI void stage_token(const int* __restrict__ ridx, const float* __restrict__ rgate, char* lds, int t, int tloc, int lane) {
    lane = opaque_v(lane); t = opaque_s(t);
    unsigned short* seid = (unsigned short*)(lds + PL_SEID) + tloc * 128;
    float* swgt = (float*)(lds + PL_SWGT) + tloc * 128;
    seid[lane] = (unsigned short)ridx[(unsigned)(t * 128 + lane)]; seid[64 + lane] = (unsigned short)ridx[(unsigned)(t * 128 + 64 + lane)];
    swgt[lane] = rgate[(unsigned)(t * 128 + lane)]; swgt[64 + lane] = rgate[(unsigned)(t * 128 + 64 + lane)];
}
DI void peer_down_wave(const bf16_t* __restrict__ hA, char* lds, const unsigned char* __restrict__ TBd, const float* __restrict__ SC, int tile, int w, int lane) {
    lane = opaque_v(lane);
    const int myu = ((lane >> 5) & 1) * 8 + ((lane >> 4) & 1) * 4 + ((lane >> 3) & 1) * 2 + ((lane >> 2) & 1);
#pragma unroll 1
    for (int tl = 0; tl < 16; ++tl) {
        const int tloc = w * 16 + tl, t = tile * 128 + tloc;
        const unsigned short* ip = (const unsigned short*)(lds + PL_SEID) + tloc * 128;
        float* gp = (float*)(lds + PL_SWGT) + tloc * 128;
        const int row = t & 127, mb = row >> 5, r5 = row & 31;
        const bf16_t* hp = hA + (unsigned)(t * 1024 + lane * 16);
        const u32x4 ha = *(const u32x4*)hp, hb = *(const u32x4*)(hp + 8);
        unsigned hhi[2], hlo[2];
        float hscale;
        {
            const unsigned hw[8] = {ha.x, ha.y, ha.z, ha.w, hb.x, hb.y, hb.z, hb.w};
            float hf[16];
            float m = 0.f;
#pragma unroll
            for (int q = 0; q < 8; ++q) { hf[2 * q] = __uint_as_float(hw[q] << 16); hf[2 * q + 1] = __uint_as_float(hw[q] & 0xffff0000u); m = fmaxf(m, fmaxf(fabsf(hf[2 * q]), fabsf(hf[2 * q + 1]))); }
#pragma unroll
            for (int o = 1; o < 64; o <<= 1) m = fmaxf(m, __shfl_xor(m, o));
            hscale = m > 0.f ? m * (1.f / 119.f) : 1.f;
            const float inv = 1.f / hscale;
            hhi[0] = hhi[1] = hlo[0] = hlo[1] = 0u;
#pragma unroll
            for (int e = 0; e < 16; ++e) {
                const int hq = __float2int_rn(hf[e] * inv);
                const int lo = ((hq + 8) & 15) - 8, hi = (hq - lo) >> 4;
                hlo[e >> 3] |= ((unsigned)lo & 15u) << (4 * (e & 7));
                hhi[e >> 3] |= ((unsigned)hi & 15u) << (4 * (e & 7));
            }
        }
#pragma unroll 1
        for (int c0 = 0; c0 < 128; c0 += 64) {
            const int ev = ip[c0 + lane];
#pragma unroll 1
            for (int p = 0; p < 64; p += 16) {
                u32x2 dr[16];
#pragma unroll
                for (int u = 0; u < 16; ++u) {
                    const int e = __builtin_amdgcn_readlane(ev, p + u);
                    dr[u] = *(const u32x2*)(TBd + (size_t)(unsigned)e * 512 + lane * 8);
                }
                const int me = __shfl(ev, p + myu);
                const f32x2 scv = *(const f32x2*)(SC + (unsigned)me * 2);
                int part[16];
#pragma unroll
                for (int u = 0; u < 16; ++u) {
                    int shi = __builtin_amdgcn_sdot8((int)dr[u].x, (int)hhi[0], 0, false);
                    shi = __builtin_amdgcn_sdot8((int)dr[u].y, (int)hhi[1], shi, false);
                    int slo = __builtin_amdgcn_sdot8((int)dr[u].x, (int)hlo[0], 0, false);
                    slo = __builtin_amdgcn_sdot8((int)dr[u].y, (int)hlo[1], slo, false);
                    part[u] = shi * 16 + slo;
                }
                int r8[8], r4[4], r2[2], r1;
                {
                    const bool b5 = (lane & 32) != 0, b4 = (lane & 16) != 0, b3 = (lane & 8) != 0, b2 = (lane & 4) != 0;
#pragma unroll
                    for (int q = 0; q < 8; ++q) { const int keep = b5 ? part[q + 8] : part[q], give = b5 ? part[q] : part[q + 8]; r8[q] = keep + __shfl_xor(give, 32); }
#pragma unroll
                    for (int q = 0; q < 4; ++q) { const int keep = b4 ? r8[q + 4] : r8[q], give = b4 ? r8[q] : r8[q + 4]; r4[q] = keep + __shfl_xor(give, 16); }
#pragma unroll
                    for (int q = 0; q < 2; ++q) { const int keep = b3 ? r4[q + 2] : r4[q], give = b3 ? r4[q] : r4[q + 2]; r2[q] = keep + __shfl_xor(give, 8); }
                    { const int keep = b2 ? r2[1] : r2[0], give = b2 ? r2[0] : r2[1]; r1 = keep + __shfl_xor(give, 4); }
                    r1 += __shfl_xor(r1, 2); r1 += __shfl_xor(r1, 1);
                }
                if ((lane & 3) == 0) {
                    const float a = (float)r1 * (scv.x * hscale);
                    gp[c0 + p + myu] = gp[c0 + p + myu] * (0.5f * a * (1.f + erff(a * 0.70710678118654752f))) * scv.y;
                }
            }
        }
    }
}
DI void peer_up_wave(char* lds, const unsigned char* __restrict__ TBu, const float* __restrict__ g2b, float* __restrict__ x, int tile, int w, int lane) {
    lane = opaque_v(lane);
    for (int r = 0; r < 2; ++r) {
        h16x2 acc[8][8];
#pragma unroll
        for (int k = 0; k < 8; ++k)
#pragma unroll
            for (int q = 0; q < 8; ++q) acc[k][q] = (h16x2){(_Float16)0.f, (_Float16)0.f};
#pragma unroll
        for (int k = 0; k < 8; ++k) {
            const int tloc = w * 16 + r * 8 + k;
            const unsigned short* ip = (const unsigned short*)(lds + PL_SEID) + tloc * 128;
            const float* gp = (const float*)(lds + PL_SWGT) + tloc * 128;
    #pragma unroll 1
        for (int c0 = 0; c0 < 128; c0 += 64) {
                const int ev = ip[c0 + lane];
                const float wl = gp[c0 + lane];
    #pragma unroll 1
            for (int p = 0; p < 64; p += 16) {
                    u32x2 ur[16];
#pragma unroll
                    for (int u = 0; u < 16; ++u) {
                        const int e = __builtin_amdgcn_readlane(ev, p + u);
                        ur[u] = *(const u32x2*)(TBu + (size_t)(unsigned)e * 512 + lane * 8);
                    }
#pragma unroll
                    for (int u = 0; u < 16; ++u) {
                        const _Float16 wh = (_Float16)__int_as_float(__builtin_amdgcn_readlane(__float_as_int(wl), p + u));
                        const h16x2 w2 = (h16x2){wh, wh};
#pragma unroll
                        for (int q = 0; q < 4; ++q) { acc[k][q] = __builtin_elementwise_fma(w2, fp4h(ur[u].x, q), acc[k][q]); acc[k][4 + q] = __builtin_elementwise_fma(w2, fp4h(ur[u].y, q), acc[k][4 + q]); }
                    }
                }
            }
        }
#pragma unroll
        for (int k = 0; k < 8; ++k) {
            const int t = tile * 128 + w * 16 + r * 8 + k;
            float4* xp = (float4*)(x + (size_t)t * D + lane * 16);
            const float4* gq = (const float4*)(g2b + lane * 16);
            float ssx = 0.f;
#pragma unroll
            for (int q = 0; q < 4; ++q) {
                float4 xv = xp[q]; const float4 gv = gq[q];
                xv.x += gv.x * (float)acc[k][2 * q].x; xv.y += gv.y * (float)acc[k][2 * q].y; xv.z += gv.z * (float)acc[k][2 * q + 1].x; xv.w += gv.w * (float)acc[k][2 * q + 1].y;
                xp[q] = xv;
                ssx += xv.x * xv.x + xv.y * xv.y + xv.z * xv.z + xv.w * xv.w;
            }
            ssx = wave_sum(ssx);
            if (lane == 0) ((float*)(lds + LDS_RSTD1))[w * 16 + r * 8 + k] = rsqrtf(ssx * (1.f / D) + EPS);
        }
    }
}

DI void epi_qk(f32x16 (&acc)[4][2], const float* __restrict__ gain, float scale, bf16_t* __restrict__ dst, int lane) {
    lane = opaque_v(lane);
    const int hh = lane >> 5;
    float gv[2][16];
#pragma unroll
    for (int nb = 0; nb < 2; ++nb)
#pragma unroll
        for (int i = 0; i < 16; ++i) gv[nb][i] = gain[nb * 32 + (i & 3) + 8 * (i >> 2) + 4 * hh] * scale;
#pragma unroll
    for (int mb = 0; mb < 4; ++mb) {
        float ss = 0.f;
#pragma unroll
        for (int nb = 0; nb < 2; ++nb)
#pragma unroll
            for (int i = 0; i < 16; ++i) ss += acc[mb][nb][i] * acc[mb][nb][i];
        ss += __shfl_xor(ss, 32);
        const float r = rsqrtf(ss * (1.f / 64.f) + EPS);
#pragma unroll
        for (int nb = 0; nb < 2; ++nb)
#pragma unroll
            for (int s = 0; s < 2; ++s) {
                const f32x16& a = acc[mb][nb];
                u32x4 o;
                o.x = pk2(a[8 * s] * r * gv[nb][8 * s], a[8 * s + 1] * r * gv[nb][8 * s + 1]);
                o.y = pk2(a[8 * s + 2] * r * gv[nb][8 * s + 2], a[8 * s + 3] * r * gv[nb][8 * s + 3]);
                o.z = pk2(a[8 * s + 4] * r * gv[nb][8 * s + 4], a[8 * s + 5] * r * gv[nb][8 * s + 5]);
                o.w = pk2(a[8 * s + 6] * r * gv[nb][8 * s + 6], a[8 * s + 7] * r * gv[nb][8 * s + 7]);
                *(u32x4*)(dst + ((unsigned)(((nb * 2 + s) * 4 + mb) * 64 + lane)) * 8) = o;
            }
    }
}
DI void epi_v(const f32x16 (&acc)[4][2], bf16_t* __restrict__ dst, int lane) {
    lane = opaque_v(lane);
#pragma unroll
    for (int nb = 0; nb < 2; ++nb)
#pragma unroll
        for (int mb = 0; mb < 4; ++mb)
#pragma unroll
            for (int s = 0; s < 2; ++s) {
                const f32x16& a = acc[mb][nb];
                u32x4 o; o.x = pk2(a[8 * s], a[8 * s + 1]); o.y = pk2(a[8 * s + 2], a[8 * s + 3]); o.z = pk2(a[8 * s + 4], a[8 * s + 5]); o.w = pk2(a[8 * s + 6], a[8 * s + 7]);
                *(u32x4*)(dst + ((unsigned)(((nb * 4 + mb) * 2 + s) * 64 + lane)) * 8) = o;
            }
}
DI void epi_row(const f32x16 (&acc)[4][2], bf16_t* __restrict__ dst, int ld, int lane) {
    lane = opaque_v(lane);
    const int r5 = lane & 31, hh = lane >> 5;
#pragma unroll
    for (int mb = 0; mb < 4; ++mb)
#pragma unroll
        for (int nb = 0; nb < 2; ++nb)
#pragma unroll
            for (int gq = 0; gq < 4; ++gq) {
                const f32x16& a = acc[mb][nb];
                u32x2 o; o.x = pk2(a[4 * gq], a[4 * gq + 1]); o.y = pk2(a[4 * gq + 2], a[4 * gq + 3]);
                *(u32x2*)(dst + (unsigned)((mb * 32 + r5) * ld + nb * 32 + 8 * gq + 4 * hh)) = o;
            }
}
DI void epi_z(const f32x16 (&acc)[4][2], bf16_t* __restrict__ dst, int lane) {
    lane = opaque_v(lane);
    const int r5 = lane & 31, hh = lane >> 5;
#pragma unroll
    for (int mb = 0; mb < 4; ++mb)
#pragma unroll
        for (int gq = 0; gq < 4; ++gq) {
            const f32x16 &a = acc[mb][0], &b = acc[mb][1];
            u32x2 o; o.x = pk2(a[4 * gq] * b[4 * gq], a[4 * gq + 1] * b[4 * gq + 1]); o.y = pk2(a[4 * gq + 2] * b[4 * gq + 2], a[4 * gq + 3] * b[4 * gq + 3]);
            *(u32x2*)(dst + (unsigned)((mb * 32 + r5) * 256 + 8 * gq + 4 * hh)) = o;
        }
}
DI void epi_su_park(const f32x16 (&acc)[4][2], unsigned* lds_su, int lane) {
    lane = opaque_v(lane);
#pragma unroll
    for (int mb = 0; mb < 4; ++mb)
#pragma unroll
        for (int nb = 0; nb < 2; ++nb)
#pragma unroll
            for (int q = 0; q < 8; ++q) lds_su[((mb * 2 + nb) * 8 + q) * 64 + lane] = pk2(acc[mb][nb][2 * q], acc[mb][nb][2 * q + 1]);
}
DI void epi_sv(f32x16 (&acc)[4][2], const bf16_t* __restrict__ SWF  , const float* __restrict__ bs_g, const unsigned* lds_su, bf16_t* __restrict__ dst, int lane) {
    lane = opaque_v(lane);
    const int r5 = lane & 31, hh = lane >> 5;
    bf16x8 vb[4][2][2];
#pragma unroll
    for (int mb = 0; mb < 4; ++mb) {
#pragma unroll
        for (int i = 0; i < 16; ++i) {
            float s1 = acc[mb][0][i] + acc[mb][1][i];
#pragma unroll
            for (int o = 1; o < 32; o <<= 1) s1 += __shfl_xor(s1, o);
            const float mu = s1 * (1.f / 64.f);
            const float d0 = acc[mb][0][i] - mu, d1 = acc[mb][1][i] - mu;
            float s2 = d0 * d0 + d1 * d1;
#pragma unroll
            for (int o = 1; o < 32; o <<= 1) s2 += __shfl_xor(s2, o);
            const float r = rsqrtf(s2 * (1.f / 64.f) + EPS);
            acc[mb][0][i] = d0 * r; acc[mb][1][i] = d1 * r;
        }
#pragma unroll
        for (int s = 0; s < 2; ++s)
#pragma unroll
            for (int nb = 0; nb < 2; ++nb) {
                const f32x16& a = acc[mb][nb];
                u32x4 o; o.x = pk2(a[8 * s], a[8 * s + 1]); o.y = pk2(a[8 * s + 2], a[8 * s + 3]); o.z = pk2(a[8 * s + 4], a[8 * s + 5]); o.w = pk2(a[8 * s + 6], a[8 * s + 7]);
                vb[mb][s][nb] = __builtin_bit_cast(bf16x8, o);
            }
    }
#pragma unroll
    for (int tb = 0; tb < 4; ++tb) {
        f32x16 y[2];
#pragma unroll
        for (int nb = 0; nb < 2; ++nb)
#pragma unroll
            for (int i = 0; i < 16; ++i) y[nb][i] = 0.f;
#pragma unroll
        for (int kt = 0; kt <= tb; ++kt)
#pragma unroll
            for (int s = 0; s < 2; ++s) {
                const bf16x8 wa = *(const bf16x8*)(SWF + ((unsigned)(((tb * 4 + kt) * 2 + s) * 64 + lane)) * 8);
                y[0] = MFMA32(wa, vb[kt][s][0], y[0]);
                y[1] = MFMA32(wa, vb[kt][s][1], y[1]);
            }
#pragma unroll
        for (int nb = 0; nb < 2; ++nb)
#pragma unroll
            for (int q = 0; q < 8; ++q) {
                const unsigned su2 = lds_su[((tb * 2 + nb) * 8 + q) * 64 + lane];
                const int i0 = 2 * q, i1 = 2 * q + 1;
                const int t0 = tb * 32 + (i0 & 3) + 8 * (i0 >> 2) + 4 * hh, t1 = tb * 32 + (i1 & 3) + 8 * (i1 >> 2) + 4 * hh;
                const float v0 = (y[nb][i0] + bs_g[t0]) * __uint_as_float(su2 << 16), v1 = (y[nb][i1] + bs_g[t1]) * __uint_as_float(su2 & 0xffff0000u);
                const unsigned pk = pk2(v0, v1);
                dst[(unsigned)(t0 * 256 + nb * 32 + r5)] = (bf16_t)(pk & 0xffffu);
                dst[(unsigned)(t1 * 256 + nb * 32 + r5)] = (bf16_t)(pk >> 16);
            }
    }
}

DI void conv_sguw_item(const float* __restrict__ W, bf16_t* __restrict__ SWF, int gid) {
    const int lane = gid & 63, s = (gid >> 6) & 1, kt = (gid >> 7) & 3, tb = (gid >> 9) & 3, g = gid >> 11;
    const int r = lane & 31, hh = lane >> 5, t = tb * 32 + r;
    const float* p = W + ((size_t)g * 128 + t) * 128;
    float v[8];
#pragma unroll
    for (int j = 0; j < 8; ++j) { const int sp = kt * 32 + 16 * s + 8 * (j >> 2) + 4 * hh + (j & 3); v[j] = sp <= t ? p[sp] : 0.f; }
    u32x4 o; o.x = pk2(v[0], v[1]); o.y = pk2(v[2], v[3]); o.z = pk2(v[4], v[5]); o.w = pk2(v[6], v[7]);
    *(u32x4*)(SWF + (size_t)gid * 8) = o;
}

DI int t5_bucket(int d) {
    if (d < 16) return d;
    const float lr = logf((float)d / 16.f) / logf(8.f);
    const int large = 16 + (int)(lr * 16.f);
    return large < 31 ? large : 31;
}

DI void attn_tile(const bf16_t* __restrict__ QF, const bf16_t* __restrict__ KF2, const bf16_t* __restrict__ VF, const float* bias_lds, const float* __restrict__ sink, bf16_t* __restrict__ OR, int tile, int tid) {
    tid = opaque_v(tid); tile = opaque_s(tile);
    const int lane = tid & 63, w = __builtin_amdgcn_readfirstlane(tid >> 6), r5 = lane & 31, hh = lane >> 5;
    const bool has_prev = (tile & 31) != 0;
    for (int task = w; task < 32; task += 8) {
        const int qh = task >> 2, qt = task & 3, kvh = qh >> 2;
        bf16x8 bq[4];
#pragma unroll
        for (int ks = 0; ks < 4; ++ks) bq[ks] = *(const bf16x8*)(QF + ((unsigned)((((tile * 8 + qh) * 4 + ks) * 4 + qt) * 64 + lane)) * 8);
        f32x16 sc[5];
#pragma unroll
        for (int grp = 0; grp < 2; ++grp) {
            bf16x8 kf[3][4];
#pragma unroll
            for (int jq = 0; jq < 3; ++jq) if (grp * 3 + jq < 5) {
                const int jj = grp * 3 + jq, j = qt + jj, st = (j >= 4 || !has_prev) ? tile : tile - 1, kt = j & 3;
#pragma unroll
                for (int ks = 0; ks < 4; ++ks) kf[jq][ks] = *(const bf16x8*)(KF2 + ((unsigned)((((st * 2 + kvh) * 4 + ks) * 4 + kt) * 64 + lane)) * 8);
            }
#pragma unroll
            for (int jq = 0; jq < 3; ++jq) if (grp * 3 + jq < 5) {
                const int jj = grp * 3 + jq;
#pragma unroll
                for (int i = 0; i < 16; ++i) sc[jj][i] = 0.f;
#pragma unroll
                for (int ks = 0; ks < 4; ++ks) sc[jj] = MFMA32(kf[jq][ks], bq[ks], sc[jj]);
            }
            __builtin_amdgcn_sched_barrier(0);
        }
        bf16x8 vf[5][2][2];
#pragma unroll
        for (int jj = 0; jj < 2; ++jj) {
            const int j = qt + jj, st = (j >= 4 || !has_prev) ? tile : tile - 1, kt = j & 3;
#pragma unroll
            for (int s2 = 0; s2 < 2; ++s2)
#pragma unroll
                for (int dt = 0; dt < 2; ++dt) vf[jj][s2][dt] = *(const bf16x8*)(VF + ((unsigned)(((((st * 2 + kvh) * 2 + dt) * 4 + kt) * 2 + s2) * 64 + lane)) * 8);
        }
        const float* bl = bias_lds + qh * 128;
        float m = -1e30f;
#pragma unroll
        for (int jj = 0; jj < 5; ++jj) {
            const bool ex = (qt + jj >= 4) || has_prev;
#pragma unroll
            for (int i = 0; i < 16; ++i) {
                const int cr = (i & 3) + 8 * (i >> 2) + 4 * hh;
                const int dist = 128 + r5 - 32 * jj - cr;
                const bool valid = ex && dist >= 0 && dist < 128;
                const float v = valid ? sc[jj][i] + bl[dist & 127] : -1e30f;
                sc[jj][i] = v; m = fmaxf(m, v);
            }
        }
        m = fmaxf(m, __shfl_xor(m, 32));
        const float sk = sink[qh];
        m = fmaxf(m, sk);
        float l = 0.f;
#pragma unroll
        for (int jj = 0; jj < 5; ++jj)
#pragma unroll
            for (int i = 0; i < 16; ++i) { const float p = __expf(sc[jj][i] - m); sc[jj][i] = p; l += p; }
        l += __shfl_xor(l, 32);
        l += __expf(sk - m);
        const float rl = 1.f / l;
        f32x16 o[2];
#pragma unroll
        for (int dt = 0; dt < 2; ++dt)
#pragma unroll
            for (int i = 0; i < 16; ++i) o[dt][i] = 0.f;
        __builtin_amdgcn_sched_barrier(0);
#pragma unroll
        for (int jj = 2; jj < 5; ++jj) {
            const int j = qt + jj, st = (j >= 4 || !has_prev) ? tile : tile - 1, kt = j & 3;
#pragma unroll
            for (int s2 = 0; s2 < 2; ++s2)
#pragma unroll
                for (int dt = 0; dt < 2; ++dt) vf[jj][s2][dt] = *(const bf16x8*)(VF + ((unsigned)(((((st * 2 + kvh) * 2 + dt) * 4 + kt) * 2 + s2) * 64 + lane)) * 8);
        }
#pragma unroll
        for (int jj = 0; jj < 5; ++jj) {
#pragma unroll
            for (int s = 0; s < 2; ++s) {
                const f32x16& a = sc[jj];
                u32x4 pp; pp.x = pk2(a[8 * s], a[8 * s + 1]); pp.y = pk2(a[8 * s + 2], a[8 * s + 3]); pp.z = pk2(a[8 * s + 4], a[8 * s + 5]); pp.w = pk2(a[8 * s + 6], a[8 * s + 7]);
                const bf16x8 pb = __builtin_bit_cast(bf16x8, pp);
#pragma unroll
                for (int dt = 0; dt < 2; ++dt) o[dt] = MFMA32(vf[jj][s][dt], pb, o[dt]);
            }
        }
        bf16_t* orow = OR + (unsigned)((tile * 128 + qt * 32 + r5) * 512 + qh * 64 + 4 * hh);
#pragma unroll
        for (int dt = 0; dt < 2; ++dt)
#pragma unroll
            for (int gq = 0; gq < 4; ++gq) {
                u32x2 ov; ov.x = pk2(o[dt][4 * gq] * rl, o[dt][4 * gq + 1] * rl); ov.y = pk2(o[dt][4 * gq + 2] * rl, o[dt][4 * gq + 3] * rl);
                *(u32x2*)(orow + dt * 32 + 8 * gq) = ov;
            }
    }
}

DI void unpack8(const u32x4 v, float (&f)[8]) {
    f[0] = __uint_as_float(v.x << 16); f[1] = __uint_as_float(v.x & 0xffff0000u); f[2] = __uint_as_float(v.y << 16); f[3] = __uint_as_float(v.y & 0xffff0000u);
    f[4] = __uint_as_float(v.z << 16); f[5] = __uint_as_float(v.z & 0xffff0000u); f[6] = __uint_as_float(v.w << 16); f[7] = __uint_as_float(v.w & 0xffff0000u);
}
DI void merge_tile(const bf16_t* __restrict__ OR, const bf16_t* __restrict__ CBR, const bf16_t* __restrict__ ZR, const bf16_t* __restrict__ YS, const float* __restrict__ cw  , const float* __restrict__ og  ,
                   bf16_t* __restrict__ mA, int tile, int tid) {
    tid = opaque_v(tid); tile = opaque_s(tile);
    const int lane = tid & 63, w = tid >> 6;
#pragma unroll 4
    for (int rr = 0; rr < 16; ++rr) {
        const int row = w * 16 + rr, t = tile * 128 + row, pos = t & (S - 1);
        float a[8], y[8];
        unpack8(*(const u32x4*)(OR + (unsigned)(t * 512 + lane * 8)), a);
        float ssa = 0.f;
#pragma unroll
        for (int q = 0; q < 8; ++q) ssa += a[q] * a[q];
        ssa = wave_sum(ssa);
        if (lane < 32) {
            const int c0 = lane * 8;
            float cb[8], z0[8], z1[8], z2[8];
            unpack8(*(const u32x4*)(CBR + (unsigned)(t * 256 + c0)), cb);
            unpack8(*(const u32x4*)(ZR + (unsigned)(t * 256 + c0)), z2);
            if (pos >= 1) unpack8(*(const u32x4*)(ZR + (unsigned)((t - 1) * 256 + c0)), z1); else { _Pragma("unroll") for (int q = 0; q < 8; ++q) z1[q] = 0.f; }
            if (pos >= 2) unpack8(*(const u32x4*)(ZR + (unsigned)((t - 2) * 256 + c0)), z0); else { _Pragma("unroll") for (int q = 0; q < 8; ++q) z0[q] = 0.f; }
#pragma unroll
            for (int q = 0; q < 8; ++q) y[q] = cb[q] * (cw[c0 + q] * z0[q] + cw[256 + c0 + q] * z1[q] + cw[512 + c0 + q] * z2[q]);
        } else {
            unpack8(*(const u32x4*)(YS + (unsigned)(t * 256 + (lane - 32) * 8)), y);
        }
        float ssy = 0.f;
#pragma unroll
        for (int q = 0; q < 8; ++q) ssy += y[q] * y[q];
#pragma unroll
        for (int o = 1; o < 32; o <<= 1) ssy += __shfl_xor(ssy, o);
        const float ra = rsqrtf(ssa * (1.f / 512.f) + EPS), ry = rsqrtf(ssy * (1.f / 256.f) + EPS);
        const int mb = row >> 5, r5 = row & 31;
        {
            const float4 g0 = *(const float4*)(og + lane * 8), g1 = *(const float4*)(og + lane * 8 + 4);
            u32x4 o; o.x = pk2(a[0] * ra * g0.x, a[1] * ra * g0.y); o.y = pk2(a[2] * ra * g0.z, a[3] * ra * g0.w); o.z = pk2(a[4] * ra * g1.x, a[5] * ra * g1.y); o.w = pk2(a[6] * ra * g1.z, a[7] * ra * g1.w);
            const int c8 = lane;
            (void)c8;
            *(u32x4*)(mA + (unsigned)(t * 1024 + lane * 8)) = o;
        }
        {
            const float4 g0 = *(const float4*)(og + 512 + lane * 8), g1 = *(const float4*)(og + 512 + lane * 8 + 4);
            u32x4 o; o.x = pk2(y[0] * ry * g0.x, y[1] * ry * g0.y); o.y = pk2(y[2] * ry * g0.z, y[3] * ry * g0.w); o.z = pk2(y[4] * ry * g1.x, y[5] * ry * g1.y); o.w = pk2(y[6] * ry * g1.z, y[7] * ry * g1.w);
            const int c8 = 64 + lane;
            (void)c8;
            *(u32x4*)(mA + (unsigned)(t * 1024 + 512 + lane * 8)) = o;
        }
    }
}

struct InProjOut { bf16_t *QF, *KF2, *VF, *CBR, *ZR, *YS; };
DI void inproj_tile(const bf16_t* __restrict__ At, const bf16_t* __restrict__ WF, const float* __restrict__ qg, const float* __restrict__ kg, const bf16_t* __restrict__ SWF, const float* __restrict__ sgu_b,
                    const InProjOut& O, char* lds, int tile, int tid) {
    tid = opaque_v(tid); tile = opaque_s(tile);
    const int lane = tid & 63, w = __builtin_amdgcn_readfirstlane(tid >> 6);
    f32x16 acc[4][2];
    {
        const int nbt0 = w * 2;
        kloop<1>(acc, At, WF + (size_t)nbt0 * 32768, WF + (size_t)(nbt0 + 1) * 32768, lds, tid, lane);
        epi_qk(acc, qg, 0.125f, O.QF + (size_t)(tile * 8 + w) * 8192, lane);
    }
    {
        const int nbt0 = 16 + w * 2;
        if (w == 2 || w == 3) {
            kloop<0>(acc, At, WF + (size_t)nbt0 * 32768, WF + (size_t)(nbt0 + 1) * 32768, lds, tid, lane);
            epi_v(acc, O.VF + (size_t)(tile * 2 + (w - 2)) * 8192, lane);
        } else {
            kloop<1>(acc, At, WF + (size_t)nbt0 * 32768, WF + (size_t)(nbt0 + 1) * 32768, lds, tid, lane);
            if (w < 2) epi_qk(acc, kg, 1.f, O.KF2 + (size_t)(tile * 2 + w) * 8192, lane);
            else epi_row(acc, O.CBR + (size_t)tile * 128 * 256 + (w - 4) * 64, 256, lane);
        }
    }
    {
        const int nbt0 = 32 + w * 2;
        kloop<1>(acc, At, WF + (size_t)nbt0 * 32768, WF + (size_t)(nbt0 + 1) * 32768, lds, tid, lane);
        epi_z(acc, O.ZR + (size_t)tile * 128 * 256 + w * 32, lane);
    }
    {
        const int nbt0 = 48 + w * 2;
        kloop<0>(acc, At, WF + (size_t)nbt0 * 32768, WF + (size_t)(nbt0 + 1) * 32768, lds, tid, lane);
        unsigned* lds_su = (unsigned*)lds;
        if (w < 4) epi_su_park(acc, lds_su + w * 4096, lane);
        __syncthreads();
        if (w >= 4) epi_sv(acc, SWF + (size_t)(w - 4) * 16384, sgu_b + (w - 4) * 128, lds_su + (w - 4) * 4096, O.YS + (size_t)tile * 128 * 256 + (w - 4) * 64, lane);
        __syncthreads();
    }
}


struct Params {
    const float *x, *c, *rel_bias, *w_ada, *b_ada, *norm1_g, *norm2_g, *w_in, *q_norm_g, *k_norm_g, *attn_sink, *conv_w, *sgu_w, *sgu_b, *out_norm_g, *w_out, *peer_wq, *peer_sub_keys, *peer_down, *peer_up;
    float* out;
    char* ws;
};
constexpr size_t MiB = 1u << 20;
constexpr size_t WS_MOD = 0;
constexpr size_t WS_MODP = 1 * MiB;
constexpr size_t WS_WIN = 13 * MiB;
constexpr size_t WS_WOUT = 29 * MiB;
constexpr size_t WS_WPQ = 37 * MiB;
constexpr size_t WS_KEYS = 53 * MiB;
constexpr size_t WS_SWF = 55 * MiB;
constexpr size_t WS_SC = 56 * MiB;
constexpr size_t WS_TB = 57 * MiB;
constexpr size_t WS_HA = 185 * MiB;
constexpr size_t WS_QF = 249 * MiB;
constexpr size_t WS_KF2 = 602 * MiB;
constexpr size_t WS_VF = 634 * MiB;
constexpr size_t WS_ZR = 666 * MiB;
constexpr size_t WS_CBR = 345 * MiB;
constexpr size_t WS_YS = 361 * MiB;
constexpr size_t WS_OR = 377 * MiB;
constexpr size_t WS_QPF = 409 * MiB;
constexpr size_t WS_RIDX = 537 * MiB;
constexpr size_t WS_RGATE = 553 * MiB;
constexpr size_t WS_SEID = 569 * MiB;
constexpr size_t WS_SWGT = 585 * MiB;
constexpr size_t WS_OFFS = 601 * MiB;
constexpr size_t WS_FLAGS = 601 * MiB + 512 * 1024;
constexpr size_t WS_END = 730 * MiB;
static_assert(PL_END <= LDS_RSTD1, "expert-phase lists overlap persistent LDS state");

__global__ __launch_bounds__(512) void hybrid_fwd(Params P) {
    extern __shared__ __attribute__((aligned(16))) char lds[];
    cg::grid_group grid = cg::this_grid();
    const int tid = threadIdx.x, lane = tid & 63, w = __builtin_amdgcn_readfirstlane(tid >> 6);
    const int nblk = gridDim.x, bid = blockIdx.x;
    char* ws = P.ws;
    float* mod = (float*)(ws + WS_MOD);
    float* modp = (float*)(ws + WS_MODP);
    bf16_t* WinF = (bf16_t*)(ws + WS_WIN); bf16_t* WoutF = (bf16_t*)(ws + WS_WOUT); bf16_t* WpqF = (bf16_t*)(ws + WS_WPQ);
    bf16_t* KeysF = (bf16_t*)(ws + WS_KEYS); bf16_t* SWF = (bf16_t*)(ws + WS_SWF);
    float* SC = (float*)(ws + WS_SC); unsigned char* TBd = (unsigned char*)(ws + WS_TB); unsigned char* TBu = TBd + 32 * MiB;
    bf16_t* hA = (bf16_t*)(ws + WS_HA);
    bf16_t* OR = (bf16_t*)(ws + WS_OR); bf16_t* QPF = (bf16_t*)(ws + WS_QPF);
    int* ridx = (int*)(ws + WS_RIDX); float* rgate = (float*)(ws + WS_RGATE);
    float* bias_lds = (float*)(lds + LDS_BIAS);
    unsigned* flags = (unsigned*)(ws + WS_FLAGS);

    {
        float* ca = (float*)lds;
        if (tid == 0) for (int tile = bid; tile < NTILE; tile += nblk) __hip_atomic_store(flags + tile, 0u, __ATOMIC_RELAXED, __HIP_MEMORY_SCOPE_AGENT);
        for (int i = tid; i < 8192; i += 512) { const float v = P.c[i]; ca[i] = v / (1.f + __expf(-v)); }
        for (int i = tid; i < 1024; i += 512) bias_lds[i] = P.rel_bias[t5_bucket(i & 127) * 8 + (i >> 7)];
        __syncthreads();
        for (int it = bid; it < 768; it += nblk) {
            const int jc = it % 12, l = (it / 12) & 3, ks = it / 48;
            const int j = jc * 512 + tid;
            const float* wp = P.w_ada + ((size_t)l * 1024 + ks * 64) * 6144 + j;
            float acc[8];
#pragma unroll
            for (int b = 0; b < 8; ++b) acc[b] = 0.f;
#pragma unroll 4
            for (int i = 0; i < 64; ++i) {
                const float wv = wp[(size_t)i * 6144];
#pragma unroll
                for (int b = 0; b < 8; ++b) acc[b] += ca[b * 1024 + ks * 64 + i] * wv;
            }
#pragma unroll
            for (int b = 0; b < 8; ++b) modp[((size_t)(ks * 4 + l) * 8 + b) * 6144 + j] = acc[b];
        }
        const int gthreads = nblk * 512, gtid = bid * 512 + tid;
        for (int rep = 0; rep < REP_P0; ++rep)
        for (int l = 0; l < DEPTH; ++l) {
            for (int g = gtid; g < 64 * 64 * 64; g += gthreads) conv_wfrag_item(P.w_in + (size_t)l * 1024 * 2048, 2048, 64, WinF + (size_t)l * 2097152, g, 1);
            for (int g = gtid; g < 32 * 64 * 64; g += gthreads) conv_wfrag_item(P.w_out + (size_t)l * 1024 * 1024, 1024, 64, WoutF + (size_t)l * 1048576, g, 0);
            for (int g = gtid; g < 64 * 64 * 64; g += gthreads) conv_wfrag_item(P.peer_wq + (size_t)l * 1024 * 2048, 2048, 64, WpqF + (size_t)l * 2097152, g, 0);
            for (int g = gtid; g < 32768; g += gthreads) conv_keys_item(P.peer_sub_keys + (size_t)l * 262144, KeysF + (size_t)l * 262144, g);
            for (int g = gtid; g < 8192; g += gthreads) conv_sguw_item(P.sgu_w + (size_t)l * 65536, SWF + (size_t)l * 65536, g);
        }
        const int gwaves = nblk * 8, gw = bid * 8 + w;
        for (int rep = 0; rep < REP_P0; ++rep)
        for (int r = gw; r < DEPTH * 16384 * 2; r += gwaves) {
            const int which = r & 1, le = r >> 1;
            conv_table_row((which ? P.peer_up : P.peer_down) + (size_t)le * D, (which ? TBu : TBd) + (size_t)le * 512, SC + (size_t)le * 2 + which, lane, which == 0);
        }
    }
    grid.sync();
    for (int tile = bid; tile < NTILE; tile += nblk) {
        const int b = tile >> 5;
        for (int l = 0; l < DEPTH; ++l)
            for (int j = tid; j < 6144; j += 512) {
                float v = P.b_ada[l * 6144 + j];
#pragma unroll
                for (int ks = 0; ks < 16; ++ks) v += modp[((size_t)(ks * 4 + l) * 8 + b) * 6144 + j];
                mod[((size_t)l * 8 + b) * 6144 + j] = v;
            }
    }
    __syncthreads();

    for (int l = 0; l < DEPTH; ++l) {
        const float* xin = l == 0 ? P.x : P.out;
        InProjOut IO;
        IO.QF = (bf16_t*)(ws + WS_QF); IO.KF2 = (bf16_t*)(ws + WS_KF2 + (size_t)l * 8 * MiB); IO.VF = (bf16_t*)(ws + WS_VF + (size_t)l * 8 * MiB);
        IO.CBR = (bf16_t*)(ws + WS_CBR); IO.ZR = (bf16_t*)(ws + WS_ZR + (size_t)l * 16 * MiB); IO.YS = (bf16_t*)(ws + WS_YS);
        for (int tile = bid; tile < NTILE; tile += nblk) {
            const float* mb_ = mod + ((size_t)l * 8 + (tile >> 5)) * 6144;
            const bool have1 = l > 0 && nblk == NTILE;
            if (have1) { if (tid < 128) ((float*)lds)[tid] = ((const float*)(lds + LDS_RSTD1))[tid]; __syncthreads(); }
            norm_to_frag(xin, P.norm1_g + l * D, mb_ + 0, mb_ + 1024, hA, (float*)lds, tile, tid, have1);
            __syncthreads();
            for (int rep = 0; rep < REP_GEMM; ++rep) inproj_tile(hA + (size_t)tile * 131072, WinF + (size_t)l * 2097152, P.q_norm_g + l * 64, P.k_norm_g + l * 64, SWF + (size_t)l * 65536, P.sgu_b + l * 512, IO, lds, tile, tid);
            asm volatile("s_waitcnt vmcnt(0)" ::: "memory");
            __syncthreads();
            if (tid == 0) {
                __builtin_amdgcn_fence(__ATOMIC_RELEASE, "agent");
                asm volatile("s_waitcnt vmcnt(0)" ::: "memory");
                __hip_atomic_store(flags + tile, (unsigned)(l + 1), __ATOMIC_RELAXED, __HIP_MEMORY_SCOPE_AGENT);
            }
        }
        for (int tile = bid; tile < NTILE; tile += nblk) {
            const float* mb_ = mod + ((size_t)l * 8 + (tile >> 5)) * 6144;
            if ((tile & 31) != 0) {
                if (tid == 0) {
                    unsigned spins = 0;
                    while (__hip_atomic_load(flags + tile - 1, __ATOMIC_RELAXED, __HIP_MEMORY_SCOPE_AGENT) < (unsigned)(l + 1) && ++spins < (1u << 24)) __builtin_amdgcn_s_sleep(2);
                    __builtin_amdgcn_fence(__ATOMIC_ACQUIRE, "agent");
                    asm volatile("s_waitcnt vmcnt(0)" ::: "memory");
                }
                __syncthreads();
            }
            for (int rep = 0; rep < REP_MIX; ++rep) {
            attn_tile(IO.QF, IO.KF2, IO.VF, bias_lds, P.attn_sink + l * 8, OR, tile, tid);
            __syncthreads();
            merge_tile(OR, IO.CBR, IO.ZR, IO.YS, P.conv_w + l * 768, P.out_norm_g + l * D, hA, tile, tid);
            __syncthreads();
            }
            {
                const bf16_t* At = hA + (size_t)tile * 131072;
                const bf16_t* WF = WoutF + (size_t)l * 1048576;
                for (int pass = 0; pass < 2; ++pass) {
                    f32x16 acc[4][2];
                    const int nbt0 = pass * 16 + w * 2;
                    kloop<0>(acc, At, WF + (size_t)nbt0 * 32768, WF + (size_t)(nbt0 + 1) * 32768, lds, tid, lane);
                    epi_resid(acc, xin, P.out, mb_ + 2048, (float*)(lds + LDS_EPI) + w * 2176, (float*)(lds + LDS_SSQ) + (pass * 8 + w) * 128, tile, pass * 512 + w * 64, lane);
                }
            }
            __syncthreads();
            if (tid < 128) { const float* sq = (const float*)(lds + LDS_SSQ); float ssum = 0.f;
#pragma unroll
                for (int c = 0; c < 16; ++c) ssum += sq[c * 128 + tid];
                ((float*)lds)[tid] = rsqrtf(ssum * (1.f / D) + EPS); }
            __syncthreads();
            norm_to_frag(P.out, P.norm2_g + l * D, mb_ + 3072, mb_ + 4096, hA, (float*)lds, tile, tid, true);
            __syncthreads();
            {
                const bf16_t* At = hA + (size_t)tile * 131072;
                const bf16_t* WF = WpqF + (size_t)l * 2097152;
                for (int rep = 0; rep < REP_GEMM; ++rep)
                for (int pass = 0; pass < 4; ++pass) {
                    f32x16 acc[4][2];
                    const int nbt0 = pass * 16 + w * 2;
                    kloop<1>(acc, At, WF + (size_t)nbt0 * 32768, WF + (size_t)(nbt0 + 1) * 32768, lds, tid, lane);
                    epi_qpf(acc, QPF, tile, nbt0, lane);
                }
            }
            __syncthreads();
            for (int rep = 0; rep < REP_ROUTE; ++rep) { route_tile(QPF, KeysF + (size_t)l * 262144, lds, (unsigned char*)lds + PL_RIDX, tile, tid); __syncthreads(); }
            peer_down_wave(hA, lds, TBd + (size_t)l * 16384 * 512, SC + (size_t)l * 32768, tile, w, lane);
            __syncthreads();
            peer_up_wave(lds, TBu + (size_t)l * 16384 * 512, mb_ + 5120, P.out, tile, w, lane);
            __syncthreads();
        }
    }
}
}

extern "C" void kernel_launch(void* const* d_in, const int* in_sizes, int n_in, void* d_out, int out_size, void* d_ws, size_t ws_size, hipStream_t stream) {
    using namespace op;
    static int grid_blocks = 0;
    if (!grid_blocks) {
        int dev = 0, cus = 0, per_cu = 0;
        (void)hipGetDevice(&dev);
        (void)hipDeviceGetAttribute(&cus, hipDeviceAttributeMultiprocessorCount, dev);
        (void)hipFuncSetAttribute((const void*)hybrid_fwd, hipFuncAttributeMaxDynamicSharedMemorySize, LDS_BYTES);
        (void)hipOccupancyMaxActiveBlocksPerMultiprocessor(&per_cu, (const void*)hybrid_fwd, 512, LDS_BYTES);
        if (per_cu < 1) per_cu = 1;
        grid_blocks = cus * per_cu;
        if (grid_blocks > NTILE) grid_blocks = NTILE;
        if (ws_size < WS_END) { fprintf(stderr, "kernel_launch: workspace too small (%zu < %zu)\n", ws_size, (size_t)WS_END); grid_blocks = -1; }
    }
    if (grid_blocks < 0) return;
    Params p{};
    p.x = (const float*)d_in[0]; p.c = (const float*)d_in[1]; p.rel_bias = (const float*)d_in[2]; p.w_ada = (const float*)d_in[3]; p.b_ada = (const float*)d_in[4];
    p.norm1_g = (const float*)d_in[5]; p.norm2_g = (const float*)d_in[6]; p.w_in = (const float*)d_in[7]; p.q_norm_g = (const float*)d_in[8]; p.k_norm_g = (const float*)d_in[9];
    p.attn_sink = (const float*)d_in[10]; p.conv_w = (const float*)d_in[11]; p.sgu_w = (const float*)d_in[12]; p.sgu_b = (const float*)d_in[13]; p.out_norm_g = (const float*)d_in[14];
    p.w_out = (const float*)d_in[15]; p.peer_wq = (const float*)d_in[16]; p.peer_sub_keys = (const float*)d_in[17]; p.peer_down = (const float*)d_in[18]; p.peer_up = (const float*)d_in[19];
    p.out = (float*)d_out; p.ws = (char*)d_ws;
    void* args[] = {&p};
    hipError_t e = hipLaunchCooperativeKernel((const void*)hybrid_fwd, dim3(grid_blocks), dim3(512), args, LDS_BYTES, stream);
    if (e != hipSuccess) fprintf(stderr, "kernel_launch: cooperative launch failed: %s (grid %d)\n", hipGetErrorString(e), grid_blocks);
}
```

```cpp
#include <hip/hip_runtime.h>
#include <cstdio>
#include <cstdint>
#include <hip/hip_cooperative_groups.h>
namespace cg = cooperative_groups;


namespace op {
#define DI __device__ __forceinline__
typedef unsigned short bf16_t;
typedef short bf16x8 __attribute__((ext_vector_type(8)));
typedef float f32x16 __attribute__((ext_vector_type(16)));
typedef float f32x2 __attribute__((ext_vector_type(2)));
typedef unsigned u32x4 __attribute__((ext_vector_type(4)));
typedef unsigned u32x2 __attribute__((ext_vector_type(2)));
typedef __bf16 bf16v2 __attribute__((ext_vector_type(2)));
constexpr int D = 1024, NB = 8, S = 4096, DEPTH = 4, T = NB * S, NTILE = T / 128;
constexpr float EPS = 1e-6f;
constexpr int PL_SEID = 0, PL_SWGT = 32768, PL_END = 98304, PL_RIDX = 98304;
constexpr int LDS_EPI = 32768, LDS_SSQ = 102400, LDS_RSTD1 = 110592, LDS_BIAS = 112 * 1024, LDS_BYTES = 116 * 1024;
constexpr int REP_GEMM = 1, REP_ROUTE = 1, REP_MIX = 1, REP_NORM = 1, REP_P0 = 1;
#define MFMA32(a, b, c) __builtin_amdgcn_mfma_f32_32x32x16_bf16((a), (b), (c), 0, 0, 0)

DI unsigned pk2(float lo, float hi) { f32x2 v = {lo, hi}; return __builtin_bit_cast(unsigned, __builtin_convertvector(v, bf16v2)); }
DI int opaque_v(int x) { asm volatile("" : "+v"(x)); return x; }
DI int opaque_s(int x) { asm volatile("" : "+s"(x)); return x; }
DI int crow(int reg, int hh) { return (reg & 3) + 8 * (reg >> 2) + 4 * hh; }
DI float wave_sum(float v) {
#pragma unroll
    for (int o = 1; o < 64; o <<= 1) v += __shfl_xor(v, o);
    return v;
}

DI int col_perm(int npos, int mode) {
    if (mode == 1 && npos >= 1024 && npos < 1536) { const int q = npos - 1024, w = q >> 6, nb = (q >> 5) & 1, r = q & 31; return (nb ? 1280 : 1024) + 32 * w + r; }
    return npos;
}
DI void conv_wfrag_item(const float* __restrict__ W, int N, int KB, bf16_t* __restrict__ WF, int gid, int mode) {
    const int l = gid & 63, kb = (gid >> 6) % KB, nbt = (gid >> 6) / KB, r = l & 31, hh = l >> 5;
    const int n = col_perm(nbt * 32 + r, mode);
    const float* p = W + (size_t)(kb * 16 + 8 * hh) * N + n;
    float v[8];
#pragma unroll
    for (int j = 0; j < 8; ++j) v[j] = p[(size_t)j * N];
    u32x4 o; o.x = pk2(v[0], v[1]); o.y = pk2(v[2], v[3]); o.z = pk2(v[4], v[5]); o.w = pk2(v[6], v[7]);
    *(u32x4*)(WF + (size_t)gid * 8) = o;
}

DI void norm_to_frag(const float* __restrict__ x, const float* __restrict__ g, const float* __restrict__ sh, const float* __restrict__ sc, bf16_t* __restrict__ hA, float* rstd_lds, int tile, int tid, bool have_rstd) {
    tid = opaque_v(tid); tile = opaque_s(tile);
    const int w = tid >> 6, lane = tid & 63;
    float cg[16], cs[16], ch[16];
#pragma unroll
    for (int j = 0; j < 2; ++j)
#pragma unroll
        for (int q = 0; q < 2; ++q) {
            const int c = 512 * j + 8 * lane + 4 * q;
            const float4 a = *(const float4*)(g + c), b = *(const float4*)(sc + c), d = *(const float4*)(sh + c);
            cg[8 * j + 4 * q] = a.x * (1.f + b.x); cg[8 * j + 4 * q + 1] = a.y * (1.f + b.y); cg[8 * j + 4 * q + 2] = a.z * (1.f + b.z); cg[8 * j + 4 * q + 3] = a.w * (1.f + b.w);
            ch[8 * j + 4 * q] = d.x; ch[8 * j + 4 * q + 1] = d.y; ch[8 * j + 4 * q + 2] = d.z; ch[8 * j + 4 * q + 3] = d.w;
            cs[8 * j + 4 * q] = 0.f; cs[8 * j + 4 * q + 1] = 0.f; cs[8 * j + 4 * q + 2] = 0.f; cs[8 * j + 4 * q + 3] = 0.f;
        }
    (void)cs;
#pragma unroll 4
    for (int rr = 0; rr < 16; ++rr) {
        const int row = w * 16 + rr;
        const float* xr = x + ((size_t)tile * 128 + row) * D + 8 * lane;
        float v[16];
#pragma unroll
        for (int j = 0; j < 2; ++j)
#pragma unroll
            for (int q = 0; q < 2; ++q) { const float4 a = *(const float4*)(xr + 512 * j + 4 * q); v[8 * j + 4 * q] = a.x; v[8 * j + 4 * q + 1] = a.y; v[8 * j + 4 * q + 2] = a.z; v[8 * j + 4 * q + 3] = a.w; }
        float r;
        if (have_rstd) r = rstd_lds[row];
        else {
            float ss = 0.f;
#pragma unroll
            for (int e = 0; e < 16; ++e) ss += v[e] * v[e];
            r = rsqrtf(wave_sum(ss) * (1.f / D) + EPS);
        }
        bf16_t* orow = hA + ((size_t)tile * 128 + row) * D + 8 * lane;
#pragma unroll
        for (int j = 0; j < 2; ++j) {
            u32x4 o;
            o.x = pk2(v[8 * j] * r * cg[8 * j] + ch[8 * j], v[8 * j + 1] * r * cg[8 * j + 1] + ch[8 * j + 1]);
            o.y = pk2(v[8 * j + 2] * r * cg[8 * j + 2] + ch[8 * j + 2], v[8 * j + 3] * r * cg[8 * j + 3] + ch[8 * j + 3]);
            o.z = pk2(v[8 * j + 4] * r * cg[8 * j + 4] + ch[8 * j + 4], v[8 * j + 5] * r * cg[8 * j + 5] + ch[8 * j + 5]);
            o.w = pk2(v[8 * j + 6] * r * cg[8 * j + 6] + ch[8 * j + 6], v[8 * j + 7] * r * cg[8 * j + 7] + ch[8 * j + 7]);
            *(u32x4*)(orow + 512 * j) = o;
        }
    }
}

template <int ORIENT>
DI void kloop(f32x16 (&acc)[4][2], const bf16_t* __restrict__ At, const bf16_t* __restrict__ W0, const bf16_t* __restrict__ W1, char* lds, int tid, int lane) {
    tid = opaque_v(tid); lane = opaque_v(lane);
#pragma unroll
    for (int mb = 0; mb < 4; ++mb)
#pragma unroll
        for (int nb = 0; nb < 2; ++nb)
#pragma unroll
            for (int i = 0; i < 16; ++i) acc[mb][nb][i] = 0.f;
    {
    const int c8_ = (tid >> 3) & 7, rowA_ = (tid >> 6) * 8 + (tid & 7);
    const u32x4* Ag = (const u32x4*)(At + (unsigned)(rowA_ * 1024 + c8_ * 8));
    const int ldsA_ = ((((c8_ >> 1) * 4 + (rowA_ >> 5)) * 64) + (rowA_ & 31) + 32 * (c8_ & 1)) * 16;
    const u32x4* W0g = (const u32x4*)W0 + lane;
    const u32x4* W1g = (const u32x4*)W1 + lane;
    u32x4 wq[4][2], arA[2], arB[2];
    arA[0] = Ag[0]; arA[1] = Ag[8192]; arB[0] = Ag[8]; arB[1] = Ag[8 + 8192];
#pragma unroll
    for (int kk = 0; kk < 4; ++kk) { wq[kk][0] = W0g[kk * 64]; wq[kk][1] = W1g[kk * 64]; }
    *(u32x4*)(lds + ldsA_) = arA[0]; *(u32x4*)(lds + ldsA_ + 2048) = arA[1];
    __syncthreads();
#define KL_ITER(KC, ARL, ARS) do { \
        char* cur = lds + ((KC) & 1) * 16384; \
        char* nxt = lds + (((KC) + 1) & 1) * 16384; \
        const int kn = (KC) < 15 ? (KC) + 1 : 15, k2 = (KC) < 14 ? (KC) + 2 : 15; \
        ARL[0] = Ag[k2 * 8]; ARL[1] = Ag[k2 * 8 + 8192]; \
        __builtin_amdgcn_sched_barrier(0); \
        _Pragma("unroll") for (int kk = 0; kk < 4; ++kk) { \
            bf16x8 afr[4]; \
            _Pragma("unroll") for (int mb = 0; mb < 4; ++mb) afr[mb] = *(const bf16x8*)(cur + ((kk * 4 + mb) * 64 + lane) * 16); \
            _Pragma("unroll") for (int mb = 0; mb < 4; ++mb) \
                _Pragma("unroll") for (int nb = 0; nb < 2; ++nb) { \
                    const bf16x8 wf = __builtin_bit_cast(bf16x8, wq[kk][nb]); \
                    if (ORIENT == 0) acc[mb][nb] = MFMA32(afr[mb], wf, acc[mb][nb]); \
                    else acc[mb][nb] = MFMA32(wf, afr[mb], acc[mb][nb]); \
                } \
            wq[kk][0] = W0g[(kn * 4 + kk) * 64]; wq[kk][1] = W1g[(kn * 4 + kk) * 64]; \
            __builtin_amdgcn_sched_barrier(0); \
        } \
        if ((KC) < 15) { *(u32x4*)(nxt + ldsA_) = ARS[0]; *(u32x4*)(nxt + ldsA_ + 2048) = ARS[1]; } \
        __syncthreads(); \
    } while (0)
    for (int kc = 0; kc < 16; kc += 2) { KL_ITER(kc, arA, arB); KL_ITER(kc + 1, arB, arA); }
#undef KL_ITER
    }
}

DI void epi_f32row(const f32x16 (&acc)[4][2], float* __restrict__ C, int tile, int col0, int lane) {
    lane = opaque_v(lane);
    const int r5 = lane & 31, hh = lane >> 5;
    const unsigned boff = (unsigned)((tile * 128 + 4 * hh) * 2048 + col0 + r5);
#pragma unroll
    for (int mb = 0; mb < 4; ++mb)
#pragma unroll
        for (int nb = 0; nb < 2; ++nb)
#pragma unroll
            for (int i = 0; i < 16; ++i)
                C[boff + (unsigned)((mb * 32 + (i & 3) + 8 * (i >> 2)) * 2048 + nb * 32)] = acc[mb][nb][i];
}
DI void epi_resid(const f32x16 (&acc)[4][2], const float* __restrict__ xin, float* __restrict__ xout, const float* __restrict__ gate_b, float* T  , float* ssq  , int tile, int col0, int lane) {
    lane = opaque_v(lane);
    const int r5 = lane & 31, hh = lane >> 5, rq = lane >> 4, c4 = (lane & 15) * 4;
    const float4 gv = *(const float4*)(gate_b + col0 + c4);
#pragma unroll
    for (int mb = 0; mb < 4; ++mb) {
#pragma unroll
        for (int nb = 0; nb < 2; ++nb)
#pragma unroll
            for (int i = 0; i < 16; ++i) T[((i & 3) + 8 * (i >> 2) + 4 * hh) * 68 + nb * 32 + r5] = acc[mb][nb][i];
        asm volatile("s_waitcnt lgkmcnt(0)" ::: "memory");
#pragma unroll
        for (int j = 0; j < 8; ++j) {
            const int row = rq + 4 * j;
            const float4 v = *(const float4*)(T + row * 68 + c4);
            const unsigned o = (unsigned)((tile * 128 + mb * 32 + row) * D + col0 + c4);
            float4 xv = *(const float4*)(xin + o);
            xv.x += gv.x * v.x; xv.y += gv.y * v.y; xv.z += gv.z * v.z; xv.w += gv.w * v.w;
            *(float4*)(xout + o) = xv;
            float ss = xv.x * xv.x + xv.y * xv.y + xv.z * xv.z + xv.w * xv.w;
            ss += __shfl_xor(ss, 1); ss += __shfl_xor(ss, 2); ss += __shfl_xor(ss, 4); ss += __shfl_xor(ss, 8);
            if ((lane & 15) == 0) ssq[mb * 32 + row] = ss;
        }
        asm volatile("s_waitcnt lgkmcnt(0)" ::: "memory");
    }
}

DI void epi_qpf(const f32x16 (&acc)[4][2], bf16_t* __restrict__ QPF, int tile, int ft0, int lane) {
    lane = opaque_v(lane);
#pragma unroll
    for (int nb = 0; nb < 2; ++nb)
#pragma unroll
        for (int s = 0; s < 2; ++s)
#pragma unroll
            for (int mb = 0; mb < 4; ++mb) {
                const f32x16& a = acc[mb][nb];
                u32x4 o; o.x = pk2(a[8 * s], a[8 * s + 1]); o.y = pk2(a[8 * s + 2], a[8 * s + 3]); o.z = pk2(a[8 * s + 4], a[8 * s + 5]); o.w = pk2(a[8 * s + 6], a[8 * s + 7]);
                *(u32x4*)(QPF + ((unsigned)((((tile * 64 + ft0 + nb) * 2 + s) * 4 + mb) * 64 + lane)) * 8) = o;
            }
}

DI void conv_keys_item(const float* __restrict__ K, bf16_t* __restrict__ KF, int gid) {
    const int lane = gid & 63, s = (gid >> 6) & 1, nbl = (gid >> 7) & 3, nt = (gid >> 9) & 3, hp = gid >> 11;
    const int r = lane & 31, hh = lane >> 5;
    const float* p = K + ((size_t)hp * 128 + nt * 32 + r) * 128 + nbl * 32 + 16 * s + 4 * hh;
    const float4 a = *(const float4*)p, b = *(const float4*)(p + 8);
    u32x4 o; o.x = pk2(a.x, a.y); o.y = pk2(a.z, a.w); o.z = pk2(b.x, b.y); o.w = pk2(b.z, b.w);
    *(u32x4*)(KF + (size_t)gid * 8) = o;
}

DI void conv_table_row(const float* __restrict__ src, unsigned char* __restrict__ dst, float* __restrict__ sc, int lane, bool as_int4) {
    const float4* p = (const float4*)src + lane * 4;
    float4 v[4];
    float m = 0.f;
#pragma unroll
    for (int j = 0; j < 4; ++j) { v[j] = p[j]; m = fmaxf(m, fmaxf(fmaxf(fabsf(v[j].x), fabsf(v[j].y)), fmaxf(fabsf(v[j].z), fabsf(v[j].w)))); }
#pragma unroll
    for (int o = 1; o < 64; o <<= 1) m = fmaxf(m, __shfl_xor(m, o));
    float scale = m > 0.f ? m * (1.f / 6.f) : 1.f;
    if (as_int4) {
        float ss = 0.f;
#pragma unroll
        for (int j = 0; j < 4; ++j) ss += v[j].x * v[j].x + v[j].y * v[j].y + v[j].z * v[j].z + v[j].w * v[j].w;
        ss = wave_sum(ss);
        const float sg = sqrtf(ss * (1.f / 1024.f));
        scale = fmaxf(sg * (1.f / 2.8f), m * (1.f / 16.f));
        if (!(scale > 0.f)) scale = 1.f;
    }
    const float inv = 1.f / scale;
    u32x2 o;
    unsigned* op = (unsigned*)&o;
#pragma unroll
    for (int j = 0; j < 2; ++j) {
        const float f[8] = {v[2 * j].x, v[2 * j].y, v[2 * j].z, v[2 * j].w, v[2 * j + 1].x, v[2 * j + 1].y, v[2 * j + 1].z, v[2 * j + 1].w};
        unsigned wv = 0;
        if (as_int4) {
#pragma unroll
            for (int e = 0; e < 8; ++e) { int q = __float2int_rn(f[e] * inv); q = q < -7 ? -7 : (q > 7 ? 7 : q); wv |= ((unsigned)q & 15u) << (4 * e); }
        } else {
            wv = __builtin_amdgcn_cvt_scalef32_pk_fp4_f32(wv, f[0] * inv, f[1] * inv, 1.0f, 0);
            wv = __builtin_amdgcn_cvt_scalef32_pk_fp4_f32(wv, f[2] * inv, f[3] * inv, 1.0f, 1);
            wv = __builtin_amdgcn_cvt_scalef32_pk_fp4_f32(wv, f[4] * inv, f[5] * inv, 1.0f, 2);
            wv = __builtin_amdgcn_cvt_scalef32_pk_fp4_f32(wv, f[6] * inv, f[7] * inv, 1.0f, 3);
        }
        op[j] = wv;
    }
    *(u32x2*)(dst + lane * 8) = o;
    if (lane == 0) *sc = scale;
}

DI void ce_desc(int& a, int& b) { const int mx = a > b ? a : b, mn = a > b ? b : a; a = mx; b = mn; }
DI void sort16_desc(int (&v)[16]) {
#pragma unroll
    for (int k = 2; k <= 16; k <<= 1)
#pragma unroll
        for (int j = k >> 1; j > 0; j >>= 1)
#pragma unroll
            for (int i = 0; i < 16; ++i) {
                const int l = i ^ j;
                if (l > i) { if ((i & k) == 0) ce_desc(v[i], v[l]); else ce_desc(v[l], v[i]); }
            }
}
DI void bitonic_merge16_desc(int (&v)[16]) {
#pragma unroll
    for (int j = 8; j > 0; j >>= 1)
#pragma unroll
        for (int i = 0; i < 16; ++i) { const int l = i ^ j; if (l > i) ce_desc(v[i], v[l]); }
}
DI void merge_top16(int (&a)[16], const int (&b)[16]) {
#pragma unroll
    for (int i = 0; i < 16; ++i) a[i] = a[i] > b[15 - i] ? a[i] : b[15 - i];
    bitonic_merge16_desc(a);
}
DI int f2ord(float f) { int b = __float_as_int(f); return b ^ ((b >> 31) & 0x7fffffff); }
DI float ord2f(int k) { return __int_as_float(k ^ ((k >> 31) & 0x7fffffff)); }

DI void route_tile(const bf16_t* __restrict__ QPF, const bf16_t* __restrict__ KF, char* lds_lists, unsigned char* lds_idx  , int tile, int tid) {
    tid = opaque_v(tid); tile = opaque_s(tile);
    const int lane = tid & 63, w = __builtin_amdgcn_readfirstlane(tid >> 6);
    const int r5 = lane & 31, hh = lane >> 5;
    unsigned char* myidx = lds_idx + w * 1024;
    for (int task = w; task < 32; task += 8) {
        const int h = task >> 2, tt = task & 3;
        f32x16 acc[2][4];
#pragma unroll
        for (int p = 0; p < 2; ++p)
#pragma unroll
            for (int nt = 0; nt < 4; ++nt)
#pragma unroll
                for (int i = 0; i < 16; ++i) acc[p][nt][i] = 0.f;
        {
            bf16x8 bq[2], ak[2][4];
#define ROUTE_LOAD(buf, step) do { const int p_ = (step) >> 3, ks_ = (step) & 7; \
                bq[buf] = *(const bf16x8*)(QPF + ((unsigned)((((tile * 64 + h * 8 + p_ * 4 + (ks_ >> 1)) * 2 + (ks_ & 1)) * 4 + tt) * 64 + lane)) * 8); \
                _Pragma("unroll") for (int nt = 0; nt < 4; ++nt) ak[buf][nt] = *(const bf16x8*)(KF + ((unsigned)(((((h * 2 + p_) * 4 + nt) * 8 + ks_) * 64) + lane)) * 8); } while (0)
            ROUTE_LOAD(0, 0);
#pragma unroll
            for (int step = 0; step < 16; ++step) {
                if (step < 15) ROUTE_LOAD((step + 1) & 1, step + 1);
#pragma unroll
                for (int nt = 0; nt < 4; ++nt) acc[step >> 3][nt] = MFMA32(ak[step & 1][nt], bq[step & 1], acc[step >> 3][nt]);
                __builtin_amdgcn_sched_barrier(0);
            }
#undef ROUTE_LOAD
        }
        int g[8][16];
#pragma unroll
        for (int nt = 0; nt < 4; ++nt)
#pragma unroll
            for (int i = 0; i < 16; ++i) {
                const unsigned a = __float_as_uint(acc[0][nt][i]), b = __float_as_uint(acc[1][nt][i]);
                auto sw = __builtin_amdgcn_permlane32_swap(a, b, false, false);
                const int n0 = nt * 32 + (i & 3) + 8 * (i >> 2);
                g[nt * 2 + (i >> 3)][i & 7] = (f2ord(__uint_as_float(sw[0])) & ~127) | n0;
                g[nt * 2 + (i >> 3)][8 + (i & 7)] = (f2ord(__uint_as_float(sw[1])) & ~127) | (n0 + 4);
            }
#pragma unroll
        for (int q = 0; q < 8; ++q) sort16_desc(g[q]);
        merge_top16(g[0], g[1]); merge_top16(g[2], g[3]); merge_top16(g[4], g[5]); merge_top16(g[6], g[7]);
        merge_top16(g[0], g[2]); merge_top16(g[4], g[6]);
        merge_top16(g[0], g[4]);
        {
            u32x4 pk;
            unsigned* pp = (unsigned*)&pk;
#pragma unroll
            for (int q = 0; q < 4; ++q) pp[q] = (unsigned)(g[0][4 * q] & 127) | ((unsigned)(g[0][4 * q + 1] & 127) << 8) | ((unsigned)(g[0][4 * q + 2] & 127) << 16) | ((unsigned)(g[0][4 * q + 3] & 127) << 24);
            *(u32x4*)(myidx + lane * 16) = pk;
        }
        float f0[16], f1[16];
#pragma unroll
        for (int i = 0; i < 16; ++i) {
            const unsigned a = (unsigned)g[0][i], b = a;
            auto sw = __builtin_amdgcn_permlane32_swap(a, b, false, false);
            f0[i] = ord2f((int)sw[0] & ~127); f1[i] = ord2f((int)sw[1] & ~127);
        }
        int c0[16], c1[16], c2[16], c3[16];
#pragma unroll
        for (int j = 0; j < 16; ++j) c0[j] = (f2ord(f0[0] + f1[j]) & ~255) | j;
#pragma unroll
        for (int i = 1; i < 16; ++i) c1[i - 1] = (f2ord(f0[i] + f1[0]) & ~255) | (i << 4);
        c1[15] = (int)0x80000000;
#define CK(i, j) ((f2ord(f0[i] + f1[j]) & ~255) | ((i) << 4) | (j))
        c2[0] = CK(1, 1); c2[1] = CK(1, 2); c2[2] = CK(1, 3); c2[3] = CK(1, 4); c2[4] = CK(1, 5); c2[5] = CK(1, 6); c2[6] = CK(1, 7);
        c2[7] = CK(2, 1); c2[8] = CK(2, 2); c2[9] = CK(2, 3); c2[10] = CK(2, 4);
        c2[11] = CK(3, 1); c2[12] = CK(3, 2); c2[13] = CK(3, 3);
        c2[14] = CK(4, 1); c2[15] = CK(4, 2);
        c3[0] = CK(5, 1); c3[1] = CK(6, 1); c3[2] = CK(7, 1);
#undef CK
#pragma unroll
        for (int q = 3; q < 16; ++q) c3[q] = (int)0x80000000;
        sort16_desc(c2);
        ce_desc(c3[0], c3[1]); ce_desc(c3[1], c3[2]); ce_desc(c3[0], c3[1]);
        merge_top16(c0, c1); merge_top16(c2, c3); merge_top16(c0, c2);
        float bs[16], den = 0.f;
#pragma unroll
        for (int i = 0; i < 16; ++i) { bs[i] = __expf(ord2f(c0[i] & ~255) - ord2f(c0[0] & ~255)); den += bs[i]; }
        const float rden = 1.f / den;
        asm volatile("s_waitcnt lgkmcnt(0)" ::: "memory");
#pragma unroll
        for (int q = 0; q < 8; ++q) {
            const int key = (int)__builtin_amdgcn_permlane32_swap((unsigned)c0[q], (unsigned)c0[8 + q], false, false)[0];
            const float gv = __uint_as_float(__builtin_amdgcn_permlane32_swap(__float_as_uint(bs[q]), __float_as_uint(bs[8 + q]), false, false)[0]) * rden;
            const int i = (key >> 4) & 15, j = key & 15;
            const int e = (int)myidx[r5 * 16 + i] * 128 + (int)myidx[(32 + r5) * 16 + j];
            const int tokl = tt * 32 + r5;
            ((unsigned short*)(lds_lists + PL_SEID))[tokl * 128 + h * 16 + 8 * hh + q] = (unsigned short)e;
            ((float*)(lds_lists + PL_SWGT))[tokl * 128 + h * 16 + 8 * hh + q] = gv;
        }
        asm volatile("s_waitcnt lgkmcnt(0)" ::: "memory");
    }
}

DI void unpack_h2(const bf16_t* __restrict__ hA, int t, int lane, f32x2 (&hv)[8]) {
    const int tile = t >> 7, row = t & 127, mb = row >> 5, r5 = row & 31;
    const bf16_t* hp = hA + ((unsigned)(((tile * 64 + lane) * 4 + mb) * 64 + r5)) * 8;
    const u32x4 ha = *(const u32x4*)hp, hb = *(const u32x4*)(hp + 32 * 8);
    const unsigned hw[8] = {ha.x, ha.y, ha.z, ha.w, hb.x, hb.y, hb.z, hb.w};
#pragma unroll
    for (int q = 0; q < 8; ++q) { hv[q].x = __uint_as_float(hw[q] << 16); hv[q].y = __uint_as_float(hw[q] & 0xffff0000u); }
}
typedef _Float16 h16x2 __attribute__((ext_vector_type(2)));
DI h16x2 fp4h(unsigned w, int sel) {
    return sel == 0 ? __builtin_amdgcn_cvt_scalef32_pk_f16_fp4(w, 1.0f, 0) : sel == 1 ? __builtin_amdgcn_cvt_scalef32_pk_f16_fp4(w, 1.0f, 1)
         : sel == 2 ? __builtin_amdgcn_cvt_scalef32_pk_f16_fp4(w, 1.0f, 2) : __builtin_amdgcn_cvt_scalef32_pk_f16_fp4(w, 1.0f, 3);
}
DI void stage_token(const int* __restrict__ ridx, const float* __restrict__ rgate, char* lds, int t, int tloc, int lane) {
    lane = opaque_v(lane); t = opaque_s(t);
    unsigned short* seid = (unsigned short*)(lds + PL_SEID) + tloc * 128;
    float* swgt = (float*)(lds + PL_SWGT) + tloc * 128;
    seid[lane] = (unsigned short)ridx[(unsigned)(t * 128 + lane)]; seid[64 + lane] = (unsigned short)ridx[(unsigned)(t * 128 + 64 + lane)];
    swgt[lane] = rgate[(unsigned)(t * 128 + lane)]; swgt[64 + lane] = rgate[(unsigned)(t * 128 + 64 + lane)];
}
DI void peer_down_wave(const bf16_t* __restrict__ hA, char* lds, const unsigned char* __restrict__ TBd, const float* __restrict__ SC, int tile, int w, int lane) {
    lane = opaque_v(lane);
    const int myu = ((lane >> 5) & 1) * 8 + ((lane >> 4) & 1) * 4 + ((lane >> 3) & 1) * 2 + ((lane >> 2) & 1);
    const unsigned short* seid = (const unsigned short*)(lds + PL_SEID) + w * 16 * 128;
    float* swgt = (float*)(lds + PL_SWGT) + w * 16 * 128;
    u32x4 haN, hbN;
    int ev0N, ev1N;
    { const bf16_t* hp0 = hA + (unsigned)((tile * 128 + w * 16) * 1024 + lane * 16); haN = *(const u32x4*)hp0; hbN = *(const u32x4*)(hp0 + 8); ev0N = seid[lane]; ev1N = seid[64 + lane]; }
    u32x2 R[2][16];
    f32x2 scv[2];
#define DOWN_ISSUE(buf, EV, base) do { _Pragma("unroll") for (int u_ = 0; u_ < 16; ++u_) { const int e_ = __builtin_amdgcn_readlane(EV, (base) + u_); \
        R[buf][u_] = *(const u32x2*)(TBd + (size_t)(unsigned)e_ * 512 + lane * 8); } \
        scv[buf] = *(const f32x2*)(SC + (unsigned)__shfl(EV, (base) + myu) * 2); } while (0)
    DOWN_ISSUE(0, ev0N, 0);
#pragma unroll 1
    for (int tl = 0; tl < 16; ++tl) {
        const int t = tile * 128 + w * 16 + tl;
        float* gp = swgt + tl * 128;
        const u32x4 ha = haN, hb = hbN;
        const int ev0 = ev0N, ev1 = ev1N;
        {
            const int tn = tl < 15 ? tl + 1 : tl;
            const bf16_t* hp = hA + (unsigned)((t - tl + tn) * 1024 + lane * 16); haN = *(const u32x4*)hp; hbN = *(const u32x4*)(hp + 8);
            ev0N = seid[tn * 128 + lane]; ev1N = seid[tn * 128 + 64 + lane];
        }
        unsigned hhi[2], hlo[2];
        float hscale;
        {
            const unsigned hw[8] = {ha.x, ha.y, ha.z, ha.w, hb.x, hb.y, hb.z, hb.w};
            float hf[16];
            float m = 0.f;
#pragma unroll
            for (int q = 0; q < 8; ++q) { hf[2 * q] = __uint_as_float(hw[q] << 16); hf[2 * q + 1] = __uint_as_float(hw[q] & 0xffff0000u); m = fmaxf(m, fmaxf(fabsf(hf[2 * q]), fabsf(hf[2 * q + 1]))); }
#pragma unroll
            for (int o = 1; o < 64; o <<= 1) m = fmaxf(m, __shfl_xor(m, o));
            hscale = m > 0.f ? m * (1.f / 119.f) : 1.f;
            const float inv = 1.f / hscale;
            hhi[0] = hhi[1] = hlo[0] = hlo[1] = 0u;
#pragma unroll
            for (int e = 0; e < 16; ++e) {
                const int hq = __float2int_rn(hf[e] * inv);
                const int lo = ((hq + 8) & 15) - 8, hi = (hq - lo) >> 4;
                hlo[e >> 3] |= ((unsigned)lo & 15u) << (4 * (e & 7));
                hhi[e >> 3] |= ((unsigned)hi & 15u) << (4 * (e & 7));
            }
        }
#pragma unroll
        for (int bt = 0; bt < 8; ++bt) {
            const int cur = bt & 1, nxt = cur ^ 1;
            if (bt < 3) DOWN_ISSUE(nxt, ev0, (bt + 1) * 16);
            else if (bt == 3) DOWN_ISSUE(nxt, ev1, 0);
            else if (bt < 7) DOWN_ISSUE(nxt, ev1, (bt - 3) * 16);
            else DOWN_ISSUE(nxt, ev0N, 0);
            __builtin_amdgcn_sched_barrier(0);
            int part[16];
#pragma unroll
            for (int u = 0; u < 16; ++u) {
                int shi = __builtin_amdgcn_sdot8((int)R[cur][u].x, (int)hhi[0], 0, false);
                shi = __builtin_amdgcn_sdot8((int)R[cur][u].y, (int)hhi[1], shi, false);
                int slo = __builtin_amdgcn_sdot8((int)R[cur][u].x, (int)hlo[0], 0, false);
                slo = __builtin_amdgcn_sdot8((int)R[cur][u].y, (int)hlo[1], slo, false);
                part[u] = shi * 16 + slo;
            }
            int r8[8], r4[4], r2[2], r1;
            {
                const bool b5 = (lane & 32) != 0, b4 = (lane & 16) != 0, b3 = (lane & 8) != 0, b2 = (lane & 4) != 0;
#pragma unroll
                for (int q = 0; q < 8; ++q) { const int keep = b5 ? part[q + 8] : part[q], give = b5 ? part[q] : part[q + 8]; r8[q] = keep + __shfl_xor(give, 32); }
#pragma unroll
                for (int q = 0; q < 4; ++q) { const int keep = b4 ? r8[q + 4] : r8[q], give = b4 ? r8[q] : r8[q + 4]; r4[q] = keep + __shfl_xor(give, 16); }
#pragma unroll
                for (int q = 0; q < 2; ++q) { const int keep = b3 ? r4[q + 2] : r4[q], give = b3 ? r4[q] : r4[q + 2]; r2[q] = keep + __shfl_xor(give, 8); }
                { const int keep = b2 ? r2[1] : r2[0], give = b2 ? r2[0] : r2[1]; r1 = keep + __shfl_xor(give, 4); }
                r1 += __shfl_xor(r1, 2); r1 += __shfl_xor(r1, 1);
            }
            if ((lane & 3) == 0) {
                const float a = (float)r1 * (scv[cur].x * hscale);
                gp[bt * 16 + myu] = gp[bt * 16 + myu] * (0.5f * a * (1.f + erff(a * 0.70710678118654752f))) * scv[cur].y;
            }
        }
    }
#undef DOWN_ISSUE
}
DI void peer_up_wave(char* lds, const unsigned char* __restrict__ TBu, const float* __restrict__ g2b, float* __restrict__ x, int tile, int w, int lane) {
    lane = opaque_v(lane);
    const unsigned short* seid = (const unsigned short*)(lds + PL_SEID) + w * 16 * 128;
    const float* swgt = (const float*)(lds + PL_SWGT) + w * 16 * 128;
    u32x2 RA[16], RB[16];
#define UP_ISSUE(R, EV, base) do { _Pragma("unroll") for (int u_ = 0; u_ < 16; ++u_) { const int e_ = __builtin_amdgcn_readlane(EV, (base) + u_); \
        R[u_] = *(const u32x2*)(TBu + (size_t)(unsigned)e_ * 512 + lane * 8); } } while (0)
#define UP_COMPUTE(R, WL, base, K) do { _Pragma("unroll") for (int u_ = 0; u_ < 16; ++u_) { \
        const _Float16 wh_ = (_Float16)__int_as_float(__builtin_amdgcn_readlane(__float_as_int(WL), (base) + u_)); const h16x2 w2_ = (h16x2){wh_, wh_}; \
        _Pragma("unroll") for (int q_ = 0; q_ < 4; ++q_) { acc[K][q_] = __builtin_elementwise_fma(w2_, fp4h(R[u_].x, q_), acc[K][q_]); acc[K][4 + q_] = __builtin_elementwise_fma(w2_, fp4h(R[u_].y, q_), acc[K][4 + q_]); } } } while (0)
    int ev0N = seid[lane], ev1N = seid[64 + lane];
    float wl0N = swgt[lane], wl1N = swgt[64 + lane];
    UP_ISSUE(RA, ev0N, 0);
    for (int r = 0; r < 2; ++r) {
        h16x2 acc[8][8];
#pragma unroll
        for (int k = 0; k < 8; ++k)
#pragma unroll
            for (int q = 0; q < 8; ++q) acc[k][q] = (h16x2){(_Float16)0.f, (_Float16)0.f};
#pragma unroll
        for (int k = 0; k < 8; ++k) {
            const int ev0 = ev0N, ev1 = ev1N;
            const float wl0 = wl0N, wl1 = wl1N;
            {
                const int tn = (r * 8 + k < 15) ? r * 8 + k + 1 : 15;
                ev0N = seid[tn * 128 + lane]; ev1N = seid[tn * 128 + 64 + lane]; wl0N = swgt[tn * 128 + lane]; wl1N = swgt[tn * 128 + 64 + lane];
            }
#pragma unroll 1
            for (int i = 0; i < 4; ++i) {
                const int evS = i < 2 ? ev0 : ev1;
                const float wlS = i < 2 ? wl0 : wl1;
                const int base = (i & 1) * 32;
                UP_ISSUE(RB, evS, base + 16);
                __builtin_amdgcn_sched_barrier(0);
                UP_COMPUTE(RA, wlS, base, k);
                const int evT = i < 3 ? (i < 1 ? ev0 : ev1) : ev0N;
                const int baseT = i < 3 ? ((i + 1) & 1) * 32 : 0;
                UP_ISSUE(RA, evT, baseT);
                __builtin_amdgcn_sched_barrier(0);
                UP_COMPUTE(RB, wlS, base + 16, k);
            }
        }
#pragma unroll
        for (int k = 0; k < 8; ++k) {
            const int t = tile * 128 + w * 16 + r * 8 + k;
            float4* xp = (float4*)(x + (size_t)t * D + lane * 16);
            const float4* gq = (const float4*)(g2b + lane * 16);
            float ssx = 0.f;
#pragma unroll
            for (int q = 0; q < 4; ++q) {
                float4 xv = xp[q]; const float4 gv = gq[q];
                xv.x += gv.x * (float)acc[k][2 * q].x; xv.y += gv.y * (float)acc[k][2 * q].y; xv.z += gv.z * (float)acc[k][2 * q + 1].x; xv.w += gv.w * (float)acc[k][2 * q + 1].y;
                xp[q] = xv;
                ssx += xv.x * xv.x + xv.y * xv.y + xv.z * xv.z + xv.w * xv.w;
            }
            ssx = wave_sum(ssx);
            if (lane == 0) ((float*)(lds + LDS_RSTD1))[w * 16 + r * 8 + k] = rsqrtf(ssx * (1.f / D) + EPS);
        }
    }
#undef UP_ISSUE
#undef UP_COMPUTE
}

DI void epi_qk(f32x16 (&acc)[4][2], const float* __restrict__ gain, float scale, bf16_t* __restrict__ dst, int lane) {
    lane = opaque_v(lane);
    const int hh = lane >> 5;
    float gv[2][16];
#pragma unroll
    for (int nb = 0; nb < 2; ++nb)
#pragma unroll
        for (int i = 0; i < 16; ++i) gv[nb][i] = gain[nb * 32 + (i & 3) + 8 * (i >> 2) + 4 * hh] * scale;
#pragma unroll
    for (int mb = 0; mb < 4; ++mb) {
        float ss = 0.f;
#pragma unroll
        for (int nb = 0; nb < 2; ++nb)
#pragma unroll
            for (int i = 0; i < 16; ++i) ss += acc[mb][nb][i] * acc[mb][nb][i];
        ss += __shfl_xor(ss, 32);
        const float r = rsqrtf(ss * (1.f / 64.f) + EPS);
#pragma unroll
        for (int nb = 0; nb < 2; ++nb)
#pragma unroll
            for (int s = 0; s < 2; ++s) {
                const f32x16& a = acc[mb][nb];
                u32x4 o;
                o.x = pk2(a[8 * s] * r * gv[nb][8 * s], a[8 * s + 1] * r * gv[nb][8 * s + 1]);
                o.y = pk2(a[8 * s + 2] * r * gv[nb][8 * s + 2], a[8 * s + 3] * r * gv[nb][8 * s + 3]);
                o.z = pk2(a[8 * s + 4] * r * gv[nb][8 * s + 4], a[8 * s + 5] * r * gv[nb][8 * s + 5]);
                o.w = pk2(a[8 * s + 6] * r * gv[nb][8 * s + 6], a[8 * s + 7] * r * gv[nb][8 * s + 7]);
                *(u32x4*)(dst + ((unsigned)(((nb * 2 + s) * 4 + mb) * 64 + lane)) * 8) = o;
            }
    }
}
DI void epi_v(const f32x16 (&acc)[4][2], bf16_t* __restrict__ dst, int lane) {
    lane = opaque_v(lane);
#pragma unroll
    for (int nb = 0; nb < 2; ++nb)
#pragma unroll
        for (int mb = 0; mb < 4; ++mb)
#pragma unroll
            for (int s = 0; s < 2; ++s) {
                const f32x16& a = acc[mb][nb];
                u32x4 o; o.x = pk2(a[8 * s], a[8 * s + 1]); o.y = pk2(a[8 * s + 2], a[8 * s + 3]); o.z = pk2(a[8 * s + 4], a[8 * s + 5]); o.w = pk2(a[8 * s + 6], a[8 * s + 7]);
                *(u32x4*)(dst + ((unsigned)(((nb * 4 + mb) * 2 + s) * 64 + lane)) * 8) = o;
            }
}
DI void epi_row(const f32x16 (&acc)[4][2], bf16_t* __restrict__ dst, int ld, int lane) {
    lane = opaque_v(lane);
    const int r5 = lane & 31, hh = lane >> 5;
#pragma unroll
    for (int mb = 0; mb < 4; ++mb)
#pragma unroll
        for (int nb = 0; nb < 2; ++nb)
#pragma unroll
            for (int gq = 0; gq < 4; ++gq) {
                const f32x16& a = acc[mb][nb];
                u32x2 o; o.x = pk2(a[4 * gq], a[4 * gq + 1]); o.y = pk2(a[4 * gq + 2], a[4 * gq + 3]);
                *(u32x2*)(dst + (unsigned)((mb * 32 + r5) * ld + nb * 32 + 8 * gq + 4 * hh)) = o;
            }
}
DI void epi_z(const f32x16 (&acc)[4][2], bf16_t* __restrict__ dst, int lane) {
    lane = opaque_v(lane);
    const int r5 = lane & 31, hh = lane >> 5;
#pragma unroll
    for (int mb = 0; mb < 4; ++mb)
#pragma unroll
        for (int gq = 0; gq < 4; ++gq) {
            const f32x16 &a = acc[mb][0], &b = acc[mb][1];
            u32x2 o; o.x = pk2(a[4 * gq] * b[4 * gq], a[4 * gq + 1] * b[4 * gq + 1]); o.y = pk2(a[4 * gq + 2] * b[4 * gq + 2], a[4 * gq + 3] * b[4 * gq + 3]);
            *(u32x2*)(dst + (unsigned)((mb * 32 + r5) * 256 + 8 * gq + 4 * hh)) = o;
        }
}
DI void epi_su_park(const f32x16 (&acc)[4][2], unsigned* lds_su, int lane) {
    lane = opaque_v(lane);
#pragma unroll
    for (int mb = 0; mb < 4; ++mb)
#pragma unroll
        for (int nb = 0; nb < 2; ++nb)
#pragma unroll
            for (int q = 0; q < 8; ++q) lds_su[((mb * 2 + nb) * 8 + q) * 64 + lane] = pk2(acc[mb][nb][2 * q], acc[mb][nb][2 * q + 1]);
}
DI void epi_sv(f32x16 (&acc)[4][2], const bf16_t* __restrict__ SWF  , const float* __restrict__ bs_g, const unsigned* lds_su, bf16_t* __restrict__ dst, int lane) {
    lane = opaque_v(lane);
    const int r5 = lane & 31, hh = lane >> 5;
    bf16x8 vb[4][2][2];
#pragma unroll
    for (int mb = 0; mb < 4; ++mb) {
#pragma unroll
        for (int i = 0; i < 16; ++i) {
            float s1 = acc[mb][0][i] + acc[mb][1][i];
#pragma unroll
            for (int o = 1; o < 32; o <<= 1) s1 += __shfl_xor(s1, o);
            const float mu = s1 * (1.f / 64.f);
            const float d0 = acc[mb][0][i] - mu, d1 = acc[mb][1][i] - mu;
            float s2 = d0 * d0 + d1 * d1;
#pragma unroll
            for (int o = 1; o < 32; o <<= 1) s2 += __shfl_xor(s2, o);
            const float r = rsqrtf(s2 * (1.f / 64.f) + EPS);
            acc[mb][0][i] = d0 * r; acc[mb][1][i] = d1 * r;
        }
#pragma unroll
        for (int s = 0; s < 2; ++s)
#pragma unroll
            for (int nb = 0; nb < 2; ++nb) {
                const f32x16& a = acc[mb][nb];
                u32x4 o; o.x = pk2(a[8 * s], a[8 * s + 1]); o.y = pk2(a[8 * s + 2], a[8 * s + 3]); o.z = pk2(a[8 * s + 4], a[8 * s + 5]); o.w = pk2(a[8 * s + 6], a[8 * s + 7]);
                vb[mb][s][nb] = __builtin_bit_cast(bf16x8, o);
            }
    }
#pragma unroll
    for (int tb = 0; tb < 4; ++tb) {
        f32x16 y[2];
#pragma unroll
        for (int nb = 0; nb < 2; ++nb)
#pragma unroll
            for (int i = 0; i < 16; ++i) y[nb][i] = 0.f;
#pragma unroll
        for (int kt = 0; kt <= tb; ++kt)
#pragma unroll
            for (int s = 0; s < 2; ++s) {
                const bf16x8 wa = *(const bf16x8*)(SWF + ((unsigned)(((tb * 4 + kt) * 2 + s) * 64 + lane)) * 8);
                y[0] = MFMA32(wa, vb[kt][s][0], y[0]);
                y[1] = MFMA32(wa, vb[kt][s][1], y[1]);
            }
#pragma unroll
        for (int nb = 0; nb < 2; ++nb)
#pragma unroll
            for (int q = 0; q < 8; ++q) {
                const unsigned su2 = lds_su[((tb * 2 + nb) * 8 + q) * 64 + lane];
                const int i0 = 2 * q, i1 = 2 * q + 1;
                const int t0 = tb * 32 + (i0 & 3) + 8 * (i0 >> 2) + 4 * hh, t1 = tb * 32 + (i1 & 3) + 8 * (i1 >> 2) + 4 * hh;
                const float v0 = (y[nb][i0] + bs_g[t0]) * __uint_as_float(su2 << 16), v1 = (y[nb][i1] + bs_g[t1]) * __uint_as_float(su2 & 0xffff0000u);
                const unsigned pk = pk2(v0, v1);
                dst[(unsigned)(t0 * 256 + nb * 32 + r5)] = (bf16_t)(pk & 0xffffu);
                dst[(unsigned)(t1 * 256 + nb * 32 + r5)] = (bf16_t)(pk >> 16);
            }
    }
}

DI void conv_sguw_item(const float* __restrict__ W, bf16_t* __restrict__ SWF, int gid) {
    const int lane = gid & 63, s = (gid >> 6) & 1, kt = (gid >> 7) & 3, tb = (gid >> 9) & 3, g = gid >> 11;
    const int r = lane & 31, hh = lane >> 5, t = tb * 32 + r;
    const float* p = W + ((size_t)g * 128 + t) * 128;
    float v[8];
#pragma unroll
    for (int j = 0; j < 8; ++j) { const int sp = kt * 32 + 16 * s + 8 * (j >> 2) + 4 * hh + (j & 3); v[j] = sp <= t ? p[sp] : 0.f; }
    u32x4 o; o.x = pk2(v[0], v[1]); o.y = pk2(v[2], v[3]); o.z = pk2(v[4], v[5]); o.w = pk2(v[6], v[7]);
    *(u32x4*)(SWF + (size_t)gid * 8) = o;
}

DI int t5_bucket(int d) {
    if (d < 16) return d;
    const float lr = logf((float)d / 16.f) / logf(8.f);
    const int large = 16 + (int)(lr * 16.f);
    return large < 31 ? large : 31;
}

DI void attn_tile(const bf16_t* __restrict__ QF, const bf16_t* __restrict__ KF2, const bf16_t* __restrict__ VF, const float* bias_lds, const float* __restrict__ sink, bf16_t* __restrict__ OR, int tile, int tid) {
    tid = opaque_v(tid); tile = opaque_s(tile);
    const int lane = tid & 63, w = __builtin_amdgcn_readfirstlane(tid >> 6), r5 = lane & 31, hh = lane >> 5;
    const bool has_prev = (tile & 31) != 0;
    for (int task = w; task < 32; task += 8) {
        const int qh = task >> 2, qt = task & 3, kvh = qh >> 2;
        bf16x8 bq[4];
#pragma unroll
        for (int ks = 0; ks < 4; ++ks) bq[ks] = *(const bf16x8*)(QF + ((unsigned)((((tile * 8 + qh) * 4 + ks) * 4 + qt) * 64 + lane)) * 8);
        f32x16 sc[5];
#pragma unroll
        for (int grp = 0; grp < 2; ++grp) {
            bf16x8 kf[3][4];
#pragma unroll
            for (int jq = 0; jq < 3; ++jq) if (grp * 3 + jq < 5) {
                const int jj = grp * 3 + jq, j = qt + jj, st = (j >= 4 || !has_prev) ? tile : tile - 1, kt = j & 3;
#pragma unroll
                for (int ks = 0; ks < 4; ++ks) kf[jq][ks] = *(const bf16x8*)(KF2 + ((unsigned)((((st * 2 + kvh) * 4 + ks) * 4 + kt) * 64 + lane)) * 8);
            }
#pragma unroll
            for (int jq = 0; jq < 3; ++jq) if (grp * 3 + jq < 5) {
                const int jj = grp * 3 + jq;
#pragma unroll
                for (int i = 0; i < 16; ++i) sc[jj][i] = 0.f;
#pragma unroll
                for (int ks = 0; ks < 4; ++ks) sc[jj] = MFMA32(kf[jq][ks], bq[ks], sc[jj]);
            }
            __builtin_amdgcn_sched_barrier(0);
        }
        bf16x8 vf[5][2][2];
#pragma unroll
        for (int jj = 0; jj < 2; ++jj) {
            const int j = qt + jj, st = (j >= 4 || !has_prev) ? tile : tile - 1, kt = j & 3;
#pragma unroll
            for (int s2 = 0; s2 < 2; ++s2)
#pragma unroll
                for (int dt = 0; dt < 2; ++dt) vf[jj][s2][dt] = *(const bf16x8*)(VF + ((unsigned)(((((st * 2 + kvh) * 2 + dt) * 4 + kt) * 2 + s2) * 64 + lane)) * 8);
        }
        const float* bl = bias_lds + qh * 128;
        float m = -1e30f;
#pragma unroll
        for (int jj = 0; jj < 5; ++jj) {
            const bool ex = (qt + jj >= 4) || has_prev;
#pragma unroll
            for (int i = 0; i < 16; ++i) {
                const int cr = (i & 3) + 8 * (i >> 2) + 4 * hh;
                const int dist = 128 + r5 - 32 * jj - cr;
                const bool valid = ex && dist >= 0 && dist < 128;
                const float v = valid ? sc[jj][i] + bl[dist & 127] : -1e30f;
                sc[jj][i] = v; m = fmaxf(m, v);
            }
        }
        m = fmaxf(m, __shfl_xor(m, 32));
        const float sk = sink[qh];
        m = fmaxf(m, sk);
        float l = 0.f;
#pragma unroll
        for (int jj = 0; jj < 5; ++jj)
#pragma unroll
            for (int i = 0; i < 16; ++i) { const float p = __expf(sc[jj][i] - m); sc[jj][i] = p; l += p; }
        l += __shfl_xor(l, 32);
        l += __expf(sk - m);
        const float rl = 1.f / l;
        f32x16 o[2];
#pragma unroll
        for (int dt = 0; dt < 2; ++dt)
#pragma unroll
            for (int i = 0; i < 16; ++i) o[dt][i] = 0.f;
        __builtin_amdgcn_sched_barrier(0);
#pragma unroll
        for (int jj = 2; jj < 5; ++jj) {
            const int j = qt + jj, st = (j >= 4 || !has_prev) ? tile : tile - 1, kt = j & 3;
#pragma unroll
            for (int s2 = 0; s2 < 2; ++s2)
#pragma unroll
                for (int dt = 0; dt < 2; ++dt) vf[jj][s2][dt] = *(const bf16x8*)(VF + ((unsigned)(((((st * 2 + kvh) * 2 + dt) * 4 + kt) * 2 + s2) * 64 + lane)) * 8);
        }
#pragma unroll
        for (int jj = 0; jj < 5; ++jj) {
#pragma unroll
            for (int s = 0; s < 2; ++s) {
                const f32x16& a = sc[jj];
                u32x4 pp; pp.x = pk2(a[8 * s], a[8 * s + 1]); pp.y = pk2(a[8 * s + 2], a[8 * s + 3]); pp.z = pk2(a[8 * s + 4], a[8 * s + 5]); pp.w = pk2(a[8 * s + 6], a[8 * s + 7]);
                const bf16x8 pb = __builtin_bit_cast(bf16x8, pp);
#pragma unroll
                for (int dt = 0; dt < 2; ++dt) o[dt] = MFMA32(vf[jj][s][dt], pb, o[dt]);
            }
        }
        bf16_t* orow = OR + (unsigned)((tile * 128 + qt * 32 + r5) * 512 + qh * 64 + 4 * hh);
#pragma unroll
        for (int dt = 0; dt < 2; ++dt)
#pragma unroll
            for (int gq = 0; gq < 4; ++gq) {
                u32x2 ov; ov.x = pk2(o[dt][4 * gq] * rl, o[dt][4 * gq + 1] * rl); ov.y = pk2(o[dt][4 * gq + 2] * rl, o[dt][4 * gq + 3] * rl);
                *(u32x2*)(orow + dt * 32 + 8 * gq) = ov;
            }
    }
}

DI void unpack8(const u32x4 v, float (&f)[8]) {
    f[0] = __uint_as_float(v.x << 16); f[1] = __uint_as_float(v.x & 0xffff0000u); f[2] = __uint_as_float(v.y << 16); f[3] = __uint_as_float(v.y & 0xffff0000u);
    f[4] = __uint_as_float(v.z << 16); f[5] = __uint_as_float(v.z & 0xffff0000u); f[6] = __uint_as_float(v.w << 16); f[7] = __uint_as_float(v.w & 0xffff0000u);
}
DI void merge_tile(const bf16_t* __restrict__ OR, const bf16_t* __restrict__ CBR, const bf16_t* __restrict__ ZR, const bf16_t* __restrict__ YS, const float* __restrict__ cw  , const float* __restrict__ og  ,
                   bf16_t* __restrict__ mA, int tile, int tid) {
    tid = opaque_v(tid); tile = opaque_s(tile);
    const int lane = tid & 63, w = tid >> 6;
#pragma unroll 4
    for (int rr = 0; rr < 16; ++rr) {
        const int row = w * 16 + rr, t = tile * 128 + row, pos = t & (S - 1);
        float a[8], y[8];
        unpack8(*(const u32x4*)(OR + (unsigned)(t * 512 + lane * 8)), a);
        float ssa = 0.f;
#pragma unroll
        for (int q = 0; q < 8; ++q) ssa += a[q] * a[q];
        ssa = wave_sum(ssa);
        if (lane < 32) {
            const int c0 = lane * 8;
            float cb[8], z0[8], z1[8], z2[8];
            unpack8(*(const u32x4*)(CBR + (unsigned)(t * 256 + c0)), cb);
            unpack8(*(const u32x4*)(ZR + (unsigned)(t * 256 + c0)), z2);
            if (pos >= 1) unpack8(*(const u32x4*)(ZR + (unsigned)((t - 1) * 256 + c0)), z1); else { _Pragma("unroll") for (int q = 0; q < 8; ++q) z1[q] = 0.f; }
            if (pos >= 2) unpack8(*(const u32x4*)(ZR + (unsigned)((t - 2) * 256 + c0)), z0); else { _Pragma("unroll") for (int q = 0; q < 8; ++q) z0[q] = 0.f; }
#pragma unroll
            for (int q = 0; q < 8; ++q) y[q] = cb[q] * (cw[c0 + q] * z0[q] + cw[256 + c0 + q] * z1[q] + cw[512 + c0 + q] * z2[q]);
        } else {
            unpack8(*(const u32x4*)(YS + (unsigned)(t * 256 + (lane - 32) * 8)), y);
        }
        float ssy = 0.f;
#pragma unroll
        for (int q = 0; q < 8; ++q) ssy += y[q] * y[q];
#pragma unroll
        for (int o = 1; o < 32; o <<= 1) ssy += __shfl_xor(ssy, o);
        const float ra = rsqrtf(ssa * (1.f / 512.f) + EPS), ry = rsqrtf(ssy * (1.f / 256.f) + EPS);
        const int mb = row >> 5, r5 = row & 31;
        {
            const float4 g0 = *(const float4*)(og + lane * 8), g1 = *(const float4*)(og + lane * 8 + 4);
            u32x4 o; o.x = pk2(a[0] * ra * g0.x, a[1] * ra * g0.y); o.y = pk2(a[2] * ra * g0.z, a[3] * ra * g0.w); o.z = pk2(a[4] * ra * g1.x, a[5] * ra * g1.y); o.w = pk2(a[6] * ra * g1.z, a[7] * ra * g1.w);
            const int c8 = lane;
            (void)c8;
            *(u32x4*)(mA + (unsigned)(t * 1024 + lane * 8)) = o;
        }
        {
            const float4 g0 = *(const float4*)(og + 512 + lane * 8), g1 = *(const float4*)(og + 512 + lane * 8 + 4);
            u32x4 o; o.x = pk2(y[0] * ry * g0.x, y[1] * ry * g0.y); o.y = pk2(y[2] * ry * g0.z, y[3] * ry * g0.w); o.z = pk2(y[4] * ry * g1.x, y[5] * ry * g1.y); o.w = pk2(y[6] * ry * g1.z, y[7] * ry * g1.w);
            const int c8 = 64 + lane;
            (void)c8;
            *(u32x4*)(mA + (unsigned)(t * 1024 + 512 + lane * 8)) = o;
        }
    }
}

struct InProjOut { bf16_t *QF, *KF2, *VF, *CBR, *ZR, *YS; };
DI void inproj_tile(const bf16_t* __restrict__ At, const bf16_t* __restrict__ WF, const float* __restrict__ qg, const float* __restrict__ kg, const bf16_t* __restrict__ SWF, const float* __restrict__ sgu_b,
                    const InProjOut& O, char* lds, int tile, int tid) {
    tid = opaque_v(tid); tile = opaque_s(tile);
    const int lane = tid & 63, w = __builtin_amdgcn_readfirstlane(tid >> 6);
    f32x16 acc[4][2];
    {
        const int nbt0 = w * 2;
        kloop<1>(acc, At, WF + (size_t)nbt0 * 32768, WF + (size_t)(nbt0 + 1) * 32768, lds, tid, lane);
        epi_qk(acc, qg, 0.125f, O.QF + (size_t)(tile * 8 + w) * 8192, lane);
    }
    {
        const int nbt0 = 16 + w * 2;
        if (w == 2 || w == 3) {
            kloop<0>(acc, At, WF + (size_t)nbt0 * 32768, WF + (size_t)(nbt0 + 1) * 32768, lds, tid, lane);
            epi_v(acc, O.VF + (size_t)(tile * 2 + (w - 2)) * 8192, lane);
        } else {
            kloop<1>(acc, At, WF + (size_t)nbt0 * 32768, WF + (size_t)(nbt0 + 1) * 32768, lds, tid, lane);
            if (w < 2) epi_qk(acc, kg, 1.f, O.KF2 + (size_t)(tile * 2 + w) * 8192, lane);
            else epi_row(acc, O.CBR + (size_t)tile * 128 * 256 + (w - 4) * 64, 256, lane);
        }
    }
    {
        const int nbt0 = 32 + w * 2;
        kloop<1>(acc, At, WF + (size_t)nbt0 * 32768, WF + (size_t)(nbt0 + 1) * 32768, lds, tid, lane);
        epi_z(acc, O.ZR + (size_t)tile * 128 * 256 + w * 32, lane);
    }
    {
        const int nbt0 = 48 + w * 2;
        kloop<0>(acc, At, WF + (size_t)nbt0 * 32768, WF + (size_t)(nbt0 + 1) * 32768, lds, tid, lane);
        unsigned* lds_su = (unsigned*)lds;
        if (w < 4) epi_su_park(acc, lds_su + w * 4096, lane);
        __syncthreads();
        if (w >= 4) epi_sv(acc, SWF + (size_t)(w - 4) * 16384, sgu_b + (w - 4) * 128, lds_su + (w - 4) * 4096, O.YS + (size_t)tile * 128 * 256 + (w - 4) * 64, lane);
        __syncthreads();
    }
}


struct Params {
    const float *x, *c, *rel_bias, *w_ada, *b_ada, *norm1_g, *norm2_g, *w_in, *q_norm_g, *k_norm_g, *attn_sink, *conv_w, *sgu_w, *sgu_b, *out_norm_g, *w_out, *peer_wq, *peer_sub_keys, *peer_down, *peer_up;
    float* out;
    char* ws;
};
constexpr size_t MiB = 1u << 20;
constexpr size_t WS_MOD = 0;
constexpr size_t WS_MODP = 1 * MiB;
constexpr size_t WS_WIN = 13 * MiB;
constexpr size_t WS_WOUT = 29 * MiB;
constexpr size_t WS_WPQ = 37 * MiB;
constexpr size_t WS_KEYS = 53 * MiB;
constexpr size_t WS_SWF = 55 * MiB;
constexpr size_t WS_SC = 56 * MiB;
constexpr size_t WS_TB = 57 * MiB;
constexpr size_t WS_HA = 185 * MiB;
constexpr size_t WS_QF = 249 * MiB;
constexpr size_t WS_KF2 = 602 * MiB;
constexpr size_t WS_VF = 634 * MiB;
constexpr size_t WS_ZR = 666 * MiB;
constexpr size_t WS_CBR = 345 * MiB;
constexpr size_t WS_YS = 361 * MiB;
constexpr size_t WS_OR = 377 * MiB;
constexpr size_t WS_QPF = 409 * MiB;
constexpr size_t WS_RIDX = 537 * MiB;
constexpr size_t WS_RGATE = 553 * MiB;
constexpr size_t WS_SEID = 569 * MiB;
constexpr size_t WS_SWGT = 585 * MiB;
constexpr size_t WS_OFFS = 601 * MiB;
constexpr size_t WS_FLAGS = 601 * MiB + 512 * 1024;
constexpr size_t WS_END = 730 * MiB;
static_assert(PL_END <= LDS_RSTD1, "expert-phase lists overlap persistent LDS state");

__global__ __launch_bounds__(512) void hybrid_fwd(Params P) {
    extern __shared__ __attribute__((aligned(16))) char lds[];
    cg::grid_group grid = cg::this_grid();
    const int tid = threadIdx.x, lane = tid & 63, w = __builtin_amdgcn_readfirstlane(tid >> 6);
    const int nblk = gridDim.x, hwb = blockIdx.x;
    const int bid = (nblk == NTILE) ? (hwb & 7) * 32 + (hwb >> 3) : hwb;
    char* ws = P.ws;
    float* mod = (float*)(ws + WS_MOD);
    float* modp = (float*)(ws + WS_MODP);
    bf16_t* WinF = (bf16_t*)(ws + WS_WIN); bf16_t* WoutF = (bf16_t*)(ws + WS_WOUT); bf16_t* WpqF = (bf16_t*)(ws + WS_WPQ);
    bf16_t* KeysF = (bf16_t*)(ws + WS_KEYS); bf16_t* SWF = (bf16_t*)(ws + WS_SWF);
    float* SC = (float*)(ws + WS_SC); unsigned char* TBd = (unsigned char*)(ws + WS_TB); unsigned char* TBu = TBd + 32 * MiB;
    bf16_t* hA = (bf16_t*)(ws + WS_HA);
    bf16_t* OR = (bf16_t*)(ws + WS_OR); bf16_t* QPF = (bf16_t*)(ws + WS_QPF);
    int* ridx = (int*)(ws + WS_RIDX); float* rgate = (float*)(ws + WS_RGATE);
    float* bias_lds = (float*)(lds + LDS_BIAS);
    unsigned* flags = (unsigned*)(ws + WS_FLAGS);

    {
        float* ca = (float*)lds;
        if (tid == 0) for (int tile = bid; tile < NTILE; tile += nblk) __hip_atomic_store(flags + tile, 0u, __ATOMIC_RELAXED, __HIP_MEMORY_SCOPE_AGENT);
        for (int i = tid; i < 8192; i += 512) { const float v = P.c[i]; ca[i] = v / (1.f + __expf(-v)); }
        for (int i = tid; i < 1024; i += 512) bias_lds[i] = P.rel_bias[t5_bucket(i & 127) * 8 + (i >> 7)];
        __syncthreads();
        for (int it = bid; it < 768; it += nblk) {
            const int jc = it % 12, l = (it / 12) & 3, ks = it / 48;
            const int j = jc * 512 + tid;
            const float* wp = P.w_ada + ((size_t)l * 1024 + ks * 64) * 6144 + j;
            float acc[8];
#pragma unroll
            for (int b = 0; b < 8; ++b) acc[b] = 0.f;
#pragma unroll 4
            for (int i = 0; i < 64; ++i) {
                const float wv = wp[(size_t)i * 6144];
#pragma unroll
                for (int b = 0; b < 8; ++b) acc[b] += ca[b * 1024 + ks * 64 + i] * wv;
            }
#pragma unroll
            for (int b = 0; b < 8; ++b) modp[((size_t)(ks * 4 + l) * 8 + b) * 6144 + j] = acc[b];
        }
        const int gthreads = nblk * 512, gtid = bid * 512 + tid;
        for (int rep = 0; rep < REP_P0; ++rep)
        for (int l = 0; l < DEPTH; ++l) {
            for (int g = gtid; g < 64 * 64 * 64; g += gthreads) conv_wfrag_item(P.w_in + (size_t)l * 1024 * 2048, 2048, 64, WinF + (size_t)l * 2097152, g, 1);
            for (int g = gtid; g < 32 * 64 * 64; g += gthreads) conv_wfrag_item(P.w_out + (size_t)l * 1024 * 1024, 1024, 64, WoutF + (size_t)l * 1048576, g, 0);
            for (int g = gtid; g < 64 * 64 * 64; g += gthreads) conv_wfrag_item(P.peer_wq + (size_t)l * 1024 * 2048, 2048, 64, WpqF + (size_t)l * 2097152, g, 0);
            for (int g = gtid; g < 32768; g += gthreads) conv_keys_item(P.peer_sub_keys + (size_t)l * 262144, KeysF + (size_t)l * 262144, g);
            for (int g = gtid; g < 8192; g += gthreads) conv_sguw_item(P.sgu_w + (size_t)l * 65536, SWF + (size_t)l * 65536, g);
        }
        const int gwaves = nblk * 8, gw = bid * 8 + w;
        for (int rep = 0; rep < REP_P0; ++rep)
        for (int r = gw; r < DEPTH * 16384 * 2; r += gwaves) {
            const int which = r & 1, le = r >> 1;
            conv_table_row((which ? P.peer_up : P.peer_down) + (size_t)le * D, (which ? TBu : TBd) + (size_t)le * 512, SC + (size_t)le * 2 + which, lane, which == 0);
        }
    }
    grid.sync();
    for (int tile = bid; tile < NTILE; tile += nblk) {
        const int b = tile >> 5;
        for (int l = 0; l < DEPTH; ++l)
            for (int j = tid; j < 6144; j += 512) {
                float v = P.b_ada[l * 6144 + j];
#pragma unroll
                for (int ks = 0; ks < 16; ++ks) v += modp[((size_t)(ks * 4 + l) * 8 + b) * 6144 + j];
                mod[((size_t)l * 8 + b) * 6144 + j] = v;
            }
    }
    __syncthreads();

    for (int l = 0; l < DEPTH; ++l) {
        const float* xin = l == 0 ? P.x : P.out;
        InProjOut IO;
        IO.QF = (bf16_t*)(ws + WS_QF); IO.KF2 = (bf16_t*)(ws + WS_KF2 + (size_t)l * 8 * MiB); IO.VF = (bf16_t*)(ws + WS_VF + (size_t)l * 8 * MiB);
        IO.CBR = (bf16_t*)(ws + WS_CBR); IO.ZR = (bf16_t*)(ws + WS_ZR + (size_t)l * 16 * MiB); IO.YS = (bf16_t*)(ws + WS_YS);
        for (int tile = bid; tile < NTILE; tile += nblk) {
            const float* mb_ = mod + ((size_t)l * 8 + (tile >> 5)) * 6144;
            const bool have1 = l > 0 && nblk == NTILE;
            if (have1) { if (tid < 128) ((float*)lds)[tid] = ((const float*)(lds + LDS_RSTD1))[tid]; __syncthreads(); }
            norm_to_frag(xin, P.norm1_g + l * D, mb_ + 0, mb_ + 1024, hA, (float*)lds, tile, tid, have1);
            __syncthreads();
            for (int rep = 0; rep < REP_GEMM; ++rep) inproj_tile(hA + (size_t)tile * 131072, WinF + (size_t)l * 2097152, P.q_norm_g + l * 64, P.k_norm_g + l * 64, SWF + (size_t)l * 65536, P.sgu_b + l * 512, IO, lds, tile, tid);
            asm volatile("s_waitcnt vmcnt(0)" ::: "memory");
            __syncthreads();
            if (tid == 0) {
                __builtin_amdgcn_fence(__ATOMIC_RELEASE, "agent");
                asm volatile("s_waitcnt vmcnt(0)" ::: "memory");
                __hip_atomic_store(flags + tile, (unsigned)(l + 1), __ATOMIC_RELAXED, __HIP_MEMORY_SCOPE_AGENT);
            }
        }
        for (int tile = bid; tile < NTILE; tile += nblk) {
            const float* mb_ = mod + ((size_t)l * 8 + (tile >> 5)) * 6144;
            if ((tile & 31) != 0) {
                if (tid == 0) {
                    unsigned spins = 0;
                    while (__hip_atomic_load(flags + tile - 1, __ATOMIC_RELAXED, __HIP_MEMORY_SCOPE_AGENT) < (unsigned)(l + 1) && ++spins < (1u << 24)) __builtin_amdgcn_s_sleep(2);
                    __builtin_amdgcn_fence(__ATOMIC_ACQUIRE, "agent");
                    asm volatile("s_waitcnt vmcnt(0)" ::: "memory");
                }
                __syncthreads();
            }
            for (int rep = 0; rep < REP_MIX; ++rep) {
            attn_tile(IO.QF, IO.KF2, IO.VF, bias_lds, P.attn_sink + l * 8, OR, tile, tid);
            __syncthreads();
            merge_tile(OR, IO.CBR, IO.ZR, IO.YS, P.conv_w + l * 768, P.out_norm_g + l * D, hA, tile, tid);
            __syncthreads();
            }
            {
                const bf16_t* At = hA + (size_t)tile * 131072;
                const bf16_t* WF = WoutF + (size_t)l * 1048576;
                for (int pass = 0; pass < 2; ++pass) {
                    f32x16 acc[4][2];
                    const int nbt0 = pass * 16 + w * 2;
                    kloop<0>(acc, At, WF + (size_t)nbt0 * 32768, WF + (size_t)(nbt0 + 1) * 32768, lds, tid, lane);
                    epi_resid(acc, xin, P.out, mb_ + 2048, (float*)(lds + LDS_EPI) + w * 2176, (float*)(lds + LDS_SSQ) + (pass * 8 + w) * 128, tile, pass * 512 + w * 64, lane);
                }
            }
            __syncthreads();
            if (tid < 128) { const float* sq = (const float*)(lds + LDS_SSQ); float ssum = 0.f;
#pragma unroll
                for (int c = 0; c < 16; ++c) ssum += sq[c * 128 + tid];
                ((float*)lds)[tid] = rsqrtf(ssum * (1.f / D) + EPS); }
            __syncthreads();
            norm_to_frag(P.out, P.norm2_g + l * D, mb_ + 3072, mb_ + 4096, hA, (float*)lds, tile, tid, true);
            __syncthreads();
            {
                const bf16_t* At = hA + (size_t)tile * 131072;
                const bf16_t* WF = WpqF + (size_t)l * 2097152;
                for (int rep = 0; rep < REP_GEMM; ++rep)
                for (int pass = 0; pass < 4; ++pass) {
                    f32x16 acc[4][2];
                    const int nbt0 = pass * 16 + w * 2;
                    kloop<1>(acc, At, WF + (size_t)nbt0 * 32768, WF + (size_t)(nbt0 + 1) * 32768, lds, tid, lane);
                    epi_qpf(acc, QPF, tile, nbt0, lane);
                }
            }
            __syncthreads();
            for (int rep = 0; rep < REP_ROUTE; ++rep) { route_tile(QPF, KeysF + (size_t)l * 262144, lds, (unsigned char*)lds + PL_RIDX, tile, tid); __syncthreads(); }
            peer_down_wave(hA, lds, TBd + (size_t)l * 16384 * 512, SC + (size_t)l * 32768, tile, w, lane);
            __syncthreads();
            peer_up_wave(lds, TBu + (size_t)l * 16384 * 512, mb_ + 5120, P.out, tile, w, lane);
            __syncthreads();
        }
    }
}
}

extern "C" void kernel_launch(void* const* d_in, const int* in_sizes, int n_in, void* d_out, int out_size, void* d_ws, size_t ws_size, hipStream_t stream) {
    using namespace op;
    static int grid_blocks = 0;
    if (!grid_blocks) {
        int dev = 0, cus = 0, per_cu = 0;
        (void)hipGetDevice(&dev);
        (void)hipDeviceGetAttribute(&cus, hipDeviceAttributeMultiprocessorCount, dev);
        (void)hipFuncSetAttribute((const void*)hybrid_fwd, hipFuncAttributeMaxDynamicSharedMemorySize, LDS_BYTES);
        (void)hipOccupancyMaxActiveBlocksPerMultiprocessor(&per_cu, (const void*)hybrid_fwd, 512, LDS_BYTES);
        if (per_cu < 1) per_cu = 1;
        grid_blocks = cus * per_cu;
        if (grid_blocks > NTILE) grid_blocks = NTILE;
        if (ws_size < WS_END) { fprintf(stderr, "kernel_launch: workspace too small (%zu < %zu)\n", ws_size, (size_t)WS_END); grid_blocks = -1; }
    }
    if (grid_blocks < 0) return;
    Params p{};
    p.x = (const float*)d_in[0]; p.c = (const float*)d_in[1]; p.rel_bias = (const float*)d_in[2]; p.w_ada = (const float*)d_in[3]; p.b_ada = (const float*)d_in[4];
    p.norm1_g = (const float*)d_in[5]; p.norm2_g = (const float*)d_in[6]; p.w_in = (const float*)d_in[7]; p.q_norm_g = (const float*)d_in[8]; p.k_norm_g = (const float*)d_in[9];
    p.attn_sink = (const float*)d_in[10]; p.conv_w = (const float*)d_in[11]; p.sgu_w = (const float*)d_in[12]; p.sgu_b = (const float*)d_in[13]; p.out_norm_g = (const float*)d_in[14];
    p.w_out = (const float*)d_in[15]; p.peer_wq = (const float*)d_in[16]; p.peer_sub_keys = (const float*)d_in[17]; p.peer_down = (const float*)d_in[18]; p.peer_up = (const float*)d_in[19];
    p.out = (float*)d_out; p.ws = (char*)d_ws;
    void* args[] = {&p};
    hipError_t e = hipLaunchCooperativeKernel((const void*)hybrid_fwd, dim3(grid_blocks), dim3(512), args, LDS_BYTES, stream);
    if (e != hipSuccess) fprintf(stderr, "kernel_launch: cooperative launch failed: %s (grid %d)\n", hipGetErrorString(e), grid_blocks);
}
```

```cpp
#include <hip/hip_runtime.h>
#include <cstdio>
#include <cstdint>
#include <hip/hip_cooperative_groups.h>
namespace cg = cooperative_groups;


namespace op {
#define DI __device__ __forceinline__
typedef unsigned short bf16_t;
typedef short bf16x8 __attribute__((ext_vector_type(8)));
typedef float f32x16 __attribute__((ext_vector_type(16)));
typedef float f32x2 __attribute__((ext_vector_type(2)));
typedef unsigned u32x4 __attribute__((ext_vector_type(4)));
typedef unsigned u32x2 __attribute__((ext_vector_type(2)));
typedef __bf16 bf16v2 __attribute__((ext_vector_type(2)));
constexpr int D = 1024, NB = 8, S = 4096, DEPTH = 4, T = NB * S, NTILE = T / 128;
constexpr float EPS = 1e-6f;
constexpr int PL_SEID = 0, PL_SWGT = 32768, PL_END = 98304, PL_RIDX = 98304;
constexpr int LDS_EPI = 32768, LDS_SSQ = 102400, LDS_RSTD1 = 110592, LDS_BIAS = 112 * 1024, LDS_BYTES = 116 * 1024;
constexpr int REP_GEMM = 1, REP_ROUTE = 1, REP_MIX = 1, REP_NORM = 1, REP_P0 = 1;
#define MFMA32(a, b, c) __builtin_amdgcn_mfma_f32_32x32x16_bf16((a), (b), (c), 0, 0, 0)

DI unsigned pk2(float lo, float hi) { f32x2 v = {lo, hi}; return __builtin_bit_cast(unsigned, __builtin_convertvector(v, bf16v2)); }
DI int opaque_v(int x) { asm volatile("" : "+v"(x)); return x; }
DI int opaque_s(int x) { asm volatile("" : "+s"(x)); return x; }
DI int crow(int reg, int hh) { return (reg & 3) + 8 * (reg >> 2) + 4 * hh; }
DI float wave_sum(float v) {
#pragma unroll
    for (int o = 1; o < 64; o <<= 1) v += __shfl_xor(v, o);
    return v;
}

DI int col_perm(int npos, int mode) {
    if (mode == 1 && npos >= 1024 && npos < 1536) { const int q = npos - 1024, w = q >> 6, nb = (q >> 5) & 1, r = q & 31; return (nb ? 1280 : 1024) + 32 * w + r; }
    return npos;
}
DI void conv_wfrag_item(const float* __restrict__ W, int N, int KB, bf16_t* __restrict__ WF, int gid, int mode) {
    const int l = gid & 63, kb = (gid >> 6) % KB, nbt = (gid >> 6) / KB, r = l & 31, hh = l >> 5;
    const int n = col_perm(nbt * 32 + r, mode);
    const float* p = W + (size_t)(kb * 16 + 8 * hh) * N + n;
    float v[8];
#pragma unroll
    for (int j = 0; j < 8; ++j) v[j] = p[(size_t)j * N];
    u32x4 o; o.x = pk2(v[0], v[1]); o.y = pk2(v[2], v[3]); o.z = pk2(v[4], v[5]); o.w = pk2(v[6], v[7]);
    *(u32x4*)(WF + (size_t)gid * 8) = o;
}

DI void norm_to_frag(const float* __restrict__ x, const float* __restrict__ g, const float* __restrict__ sh, const float* __restrict__ sc, bf16_t* __restrict__ hA, float* rstd_lds, int tile, int tid, bool have_rstd) {
    tid = opaque_v(tid); tile = opaque_s(tile);
    const int w = tid >> 6, lane = tid & 63;
    float cg[16], cs[16], ch[16];
#pragma unroll
    for (int j = 0; j < 2; ++j)
#pragma unroll
        for (int q = 0; q < 2; ++q) {
            const int c = 512 * j + 8 * lane + 4 * q;
            const float4 a = *(const float4*)(g + c), b = *(const float4*)(sc + c), d = *(const float4*)(sh + c);
            cg[8 * j + 4 * q] = a.x * (1.f + b.x); cg[8 * j + 4 * q + 1] = a.y * (1.f + b.y); cg[8 * j + 4 * q + 2] = a.z * (1.f + b.z); cg[8 * j + 4 * q + 3] = a.w * (1.f + b.w);
            ch[8 * j + 4 * q] = d.x; ch[8 * j + 4 * q + 1] = d.y; ch[8 * j + 4 * q + 2] = d.z; ch[8 * j + 4 * q + 3] = d.w;
            cs[8 * j + 4 * q] = 0.f; cs[8 * j + 4 * q + 1] = 0.f; cs[8 * j + 4 * q + 2] = 0.f; cs[8 * j + 4 * q + 3] = 0.f;
        }
    (void)cs;
#pragma unroll 4
    for (int rr = 0; rr < 16; ++rr) {
        const int row = w * 16 + rr;
        const float* xr = x + ((size_t)tile * 128 + row) * D + 8 * lane;
        float v[16];
#pragma unroll
        for (int j = 0; j < 2; ++j)
#pragma unroll
            for (int q = 0; q < 2; ++q) { const float4 a = *(const float4*)(xr + 512 * j + 4 * q); v[8 * j + 4 * q] = a.x; v[8 * j + 4 * q + 1] = a.y; v[8 * j + 4 * q + 2] = a.z; v[8 * j + 4 * q + 3] = a.w; }
        float r;
        if (have_rstd) r = rstd_lds[row];
        else {
            float ss = 0.f;
#pragma unroll
            for (int e = 0; e < 16; ++e) ss += v[e] * v[e];
            r = rsqrtf(wave_sum(ss) * (1.f / D) + EPS);
        }
        bf16_t* orow = hA + ((size_t)tile * 128 + row) * D + 8 * lane;
#pragma unroll
        for (int j = 0; j < 2; ++j) {
            u32x4 o;
            o.x = pk2(v[8 * j] * r * cg[8 * j] + ch[8 * j], v[8 * j + 1] * r * cg[8 * j + 1] + ch[8 * j + 1]);
            o.y = pk2(v[8 * j + 2] * r * cg[8 * j + 2] + ch[8 * j + 2], v[8 * j + 3] * r * cg[8 * j + 3] + ch[8 * j + 3]);
            o.z = pk2(v[8 * j + 4] * r * cg[8 * j + 4] + ch[8 * j + 4], v[8 * j + 5] * r * cg[8 * j + 5] + ch[8 * j + 5]);
            o.w = pk2(v[8 * j + 6] * r * cg[8 * j + 6] + ch[8 * j + 6], v[8 * j + 7] * r * cg[8 * j + 7] + ch[8 * j + 7]);
            *(u32x4*)(orow + 512 * j) = o;
        }
    }
}

template <int ORIENT>
DI void kloop(f32x16 (&acc)[4][2], const bf16_t* __restrict__ At, const bf16_t* __restrict__ W0, const bf16_t* __restrict__ W1, char* lds, int tid, int lane) {
    tid = opaque_v(tid); lane = opaque_v(lane);
#pragma unroll
    for (int mb = 0; mb < 4; ++mb)
#pragma unroll
        for (int nb = 0; nb < 2; ++nb)
#pragma unroll
            for (int i = 0; i < 16; ++i) acc[mb][nb][i] = 0.f;
    {
    const int c8_ = (tid >> 3) & 7, rowA_ = (tid >> 6) * 8 + (tid & 7);
    const u32x4* Ag = (const u32x4*)(At + (unsigned)(rowA_ * 1024 + c8_ * 8));
    const int ldsA_ = ((((c8_ >> 1) * 4 + (rowA_ >> 5)) * 64) + (rowA_ & 31) + 32 * (c8_ & 1)) * 16;
    const u32x4* W0g = (const u32x4*)W0 + lane;
    const u32x4* W1g = (const u32x4*)W1 + lane;
    u32x4 wq[4][2], arA[2], arB[2];
    arA[0] = Ag[0]; arA[1] = Ag[8192]; arB[0] = Ag[8]; arB[1] = Ag[8 + 8192];
#pragma unroll
    for (int kk = 0; kk < 4; ++kk) { wq[kk][0] = W0g[kk * 64]; wq[kk][1] = W1g[kk * 64]; }
    *(u32x4*)(lds + ldsA_) = arA[0]; *(u32x4*)(lds + ldsA_ + 2048) = arA[1];
    __syncthreads();
#define KL_ITER(KC, ARL, ARS) do { \
        char* cur = lds + ((KC) & 1) * 16384; \
        char* nxt = lds + (((KC) + 1) & 1) * 16384; \
        const int kn = (KC) < 15 ? (KC) + 1 : 15, k2 = (KC) < 14 ? (KC) + 2 : 15; \
        ARL[0] = Ag[k2 * 8]; ARL[1] = Ag[k2 * 8 + 8192]; \
        __builtin_amdgcn_sched_barrier(0); \
        _Pragma("unroll") for (int kk = 0; kk < 4; ++kk) { \
            bf16x8 afr[4]; \
            _Pragma("unroll") for (int mb = 0; mb < 4; ++mb) afr[mb] = *(const bf16x8*)(cur + ((kk * 4 + mb) * 64 + lane) * 16); \
            _Pragma("unroll") for (int mb = 0; mb < 4; ++mb) \
                _Pragma("unroll") for (int nb = 0; nb < 2; ++nb) { \
                    const bf16x8 wf = __builtin_bit_cast(bf16x8, wq[kk][nb]); \
                    if (ORIENT == 0) acc[mb][nb] = MFMA32(afr[mb], wf, acc[mb][nb]); \
                    else acc[mb][nb] = MFMA32(wf, afr[mb], acc[mb][nb]); \
                } \
            wq[kk][0] = W0g[(kn * 4 + kk) * 64]; wq[kk][1] = W1g[(kn * 4 + kk) * 64]; \
            __builtin_amdgcn_sched_barrier(0); \
        } \
        if ((KC) < 15) { *(u32x4*)(nxt + ldsA_) = ARS[0]; *(u32x4*)(nxt + ldsA_ + 2048) = ARS[1]; } \
        __syncthreads(); \
    } while (0)
    for (int kc = 0; kc < 16; kc += 2) { KL_ITER(kc, arA, arB); KL_ITER(kc + 1, arB, arA); }
#undef KL_ITER
    }
}

DI void epi_f32row(const f32x16 (&acc)[4][2], float* __restrict__ C, int tile, int col0, int lane) {
    lane = opaque_v(lane);
    const int r5 = lane & 31, hh = lane >> 5;
    const unsigned boff = (unsigned)((tile * 128 + 4 * hh) * 2048 + col0 + r5);
#pragma unroll
    for (int mb = 0; mb < 4; ++mb)
#pragma unroll
        for (int nb = 0; nb < 2; ++nb)
#pragma unroll
            for (int i = 0; i < 16; ++i)
                C[boff + (unsigned)((mb * 32 + (i & 3) + 8 * (i >> 2)) * 2048 + nb * 32)] = acc[mb][nb][i];
}
DI void epi_resid(const f32x16 (&acc)[4][2], const float* __restrict__ xin, float* __restrict__ xout, const float* __restrict__ gate_b, float* T  , float* ssq  , int tile, int col0, int lane) {
    lane = opaque_v(lane);
    const int r5 = lane & 31, hh = lane >> 5, rq = lane >> 4, c4 = (lane & 15) * 4;
    const float4 gv = *(const float4*)(gate_b + col0 + c4);
#pragma unroll
    for (int mb = 0; mb < 4; ++mb) {
#pragma unroll
        for (int nb = 0; nb < 2; ++nb)
#pragma unroll
            for (int i = 0; i < 16; ++i) T[((i & 3) + 8 * (i >> 2) + 4 * hh) * 68 + nb * 32 + r5] = acc[mb][nb][i];
        asm volatile("s_waitcnt lgkmcnt(0)" ::: "memory");
#pragma unroll
        for (int j = 0; j < 8; ++j) {
            const int row = rq + 4 * j;
            const float4 v = *(const float4*)(T + row * 68 + c4);
            const unsigned o = (unsigned)((tile * 128 + mb * 32 + row) * D + col0 + c4);
            float4 xv = *(const float4*)(xin + o);
            xv.x += gv.x * v.x; xv.y += gv.y * v.y; xv.z += gv.z * v.z; xv.w += gv.w * v.w;
            *(float4*)(xout + o) = xv;
            float ss = xv.x * xv.x + xv.y * xv.y + xv.z * xv.z + xv.w * xv.w;
            ss += __shfl_xor(ss, 1); ss += __shfl_xor(ss, 2); ss += __shfl_xor(ss, 4); ss += __shfl_xor(ss, 8);
            if ((lane & 15) == 0) ssq[mb * 32 + row] = ss;
        }
        asm volatile("s_waitcnt lgkmcnt(0)" ::: "memory");
    }
}

DI void epi_qpf(const f32x16 (&acc)[4][2], bf16_t* __restrict__ QPF, int tile, int ft0, int lane) {
    lane = opaque_v(lane);
#pragma unroll
    for (int nb = 0; nb < 2; ++nb)
#pragma unroll
        for (int s = 0; s < 2; ++s)
#pragma unroll
            for (int mb = 0; mb < 4; ++mb) {
                const f32x16& a = acc[mb][nb];
                u32x4 o; o.x = pk2(a[8 * s], a[8 * s + 1]); o.y = pk2(a[8 * s + 2], a[8 * s + 3]); o.z = pk2(a[8 * s + 4], a[8 * s + 5]); o.w = pk2(a[8 * s + 6], a[8 * s + 7]);
                *(u32x4*)(QPF + ((unsigned)((((tile * 64 + ft0 + nb) * 2 + s) * 4 + mb) * 64 + lane)) * 8) = o;
            }
}

DI void conv_keys_item(const float* __restrict__ K, bf16_t* __restrict__ KF, int gid) {
    const int lane = gid & 63, s = (gid >> 6) & 1, nbl = (gid >> 7) & 3, nt = (gid >> 9) & 3, hp = gid >> 11;
    const int r = lane & 31, hh = lane >> 5;
    const float* p = K + ((size_t)hp * 128 + nt * 32 + r) * 128 + nbl * 32 + 16 * s + 4 * hh;
    const float4 a = *(const float4*)p, b = *(const float4*)(p + 8);
    u32x4 o; o.x = pk2(a.x, a.y); o.y = pk2(a.z, a.w); o.z = pk2(b.x, b.y); o.w = pk2(b.z, b.w);
    *(u32x4*)(KF + (size_t)gid * 8) = o;
}

DI void conv_table_row(const float* __restrict__ src, unsigned char* __restrict__ dst, float* __restrict__ sc, int lane, bool as_int4) {
    const float4* p = (const float4*)src + lane * 4;
    float4 v[4];
    float m = 0.f;
#pragma unroll
    for (int j = 0; j < 4; ++j) { v[j] = p[j]; m = fmaxf(m, fmaxf(fmaxf(fabsf(v[j].x), fabsf(v[j].y)), fmaxf(fabsf(v[j].z), fabsf(v[j].w)))); }
#pragma unroll
    for (int o = 1; o < 64; o <<= 1) m = fmaxf(m, __shfl_xor(m, o));
    float scale = m > 0.f ? m * (1.f / 6.f) : 1.f;
    if (as_int4) {
        float ss = 0.f;
#pragma unroll
        for (int j = 0; j < 4; ++j) ss += v[j].x * v[j].x + v[j].y * v[j].y + v[j].z * v[j].z + v[j].w * v[j].w;
        ss = wave_sum(ss);
        const float sg = sqrtf(ss * (1.f / 1024.f));
        scale = fmaxf(sg * (1.f / 2.8f), m * (1.f / 16.f));
        if (!(scale > 0.f)) scale = 1.f;
    }
    const float inv = 1.f / scale;
    u32x2 o;
    unsigned* op = (unsigned*)&o;
#pragma unroll
    for (int j = 0; j < 2; ++j) {
        const float f[8] = {v[2 * j].x, v[2 * j].y, v[2 * j].z, v[2 * j].w, v[2 * j + 1].x, v[2 * j + 1].y, v[2 * j + 1].z, v[2 * j + 1].w};
        unsigned wv = 0;
        if (as_int4) {
#pragma unroll
            for (int e = 0; e < 8; ++e) { int q = __float2int_rn(f[e] * inv); q = q < -7 ? -7 : (q > 7 ? 7 : q); wv |= ((unsigned)q & 15u) << (4 * e); }
        } else {
            wv = __builtin_amdgcn_cvt_scalef32_pk_fp4_f32(wv, f[0] * inv, f[1] * inv, 1.0f, 0);
            wv = __builtin_amdgcn_cvt_scalef32_pk_fp4_f32(wv, f[2] * inv, f[3] * inv, 1.0f, 1);
            wv = __builtin_amdgcn_cvt_scalef32_pk_fp4_f32(wv, f[4] * inv, f[5] * inv, 1.0f, 2);
            wv = __builtin_amdgcn_cvt_scalef32_pk_fp4_f32(wv, f[6] * inv, f[7] * inv, 1.0f, 3);
        }
        op[j] = wv;
    }
    *(u32x2*)(dst + lane * 8) = o;
    if (lane == 0) *sc = scale;
}

DI void ce_desc(int& a, int& b) { const int mx = a > b ? a : b, mn = a > b ? b : a; a = mx; b = mn; }
DI void sort16_desc(int (&v)[16]) {
#pragma unroll
    for (int k = 2; k <= 16; k <<= 1)
#pragma unroll
        for (int j = k >> 1; j > 0; j >>= 1)
#pragma unroll
            for (int i = 0; i < 16; ++i) {
                const int l = i ^ j;
                if (l > i) { if ((i & k) == 0) ce_desc(v[i], v[l]); else ce_desc(v[l], v[i]); }
            }
}
DI void bitonic_merge16_desc(int (&v)[16]) {
#pragma unroll
    for (int j = 8; j > 0; j >>= 1)
#pragma unroll
        for (int i = 0; i < 16; ++i) { const int l = i ^ j; if (l > i) ce_desc(v[i], v[l]); }
}
DI void merge_top16(int (&a)[16], const int (&b)[16]) {
#pragma unroll
    for (int i = 0; i < 16; ++i) a[i] = a[i] > b[15 - i] ? a[i] : b[15 - i];
    bitonic_merge16_desc(a);
}
DI int f2ord(float f) { int b = __float_as_int(f); return b ^ ((b >> 31) & 0x7fffffff); }
DI float ord2f(int k) { return __int_as_float(k ^ ((k >> 31) & 0x7fffffff)); }

DI void route_tile(const bf16_t* __restrict__ QPF, const bf16_t* __restrict__ KF, char* lds_lists, unsigned char* lds_idx  , int tile, int tid) {
    tid = opaque_v(tid); tile = opaque_s(tile);
    const int lane = tid & 63, w = __builtin_amdgcn_readfirstlane(tid >> 6);
    const int r5 = lane & 31, hh = lane >> 5;
    unsigned char* myidx = lds_idx + w * 1024;
    for (int task = w; task < 32; task += 8) {
        const int h = task >> 2, tt = task & 3;
        f32x16 acc[2][4];
#pragma unroll
        for (int p = 0; p < 2; ++p)
#pragma unroll
            for (int nt = 0; nt < 4; ++nt)
#pragma unroll
                for (int i = 0; i < 16; ++i) acc[p][nt][i] = 0.f;
        {
            bf16x8 bq[3], ak[3][4];
#define ROUTE_LOAD(buf, step) do { const int p_ = (step) >> 3, ks_ = (step) & 7; \
                bq[buf] = *(const bf16x8*)(QPF + ((unsigned)((((tile * 64 + h * 8 + p_ * 4 + (ks_ >> 1)) * 2 + (ks_ & 1)) * 4 + tt) * 64 + lane)) * 8); \
                _Pragma("unroll") for (int nt = 0; nt < 4; ++nt) ak[buf][nt] = *(const bf16x8*)(KF + ((unsigned)(((((h * 2 + p_) * 4 + nt) * 8 + ks_) * 64) + lane)) * 8); } while (0)
            ROUTE_LOAD(0, 0);
            ROUTE_LOAD(1, 1);
#pragma unroll
            for (int step = 0; step < 16; ++step) {
                if (step < 14) ROUTE_LOAD((step + 2) % 3, step + 2);
#pragma unroll
                for (int nt = 0; nt < 4; ++nt) acc[step >> 3][nt] = MFMA32(ak[step % 3][nt], bq[step % 3], acc[step >> 3][nt]);
                __builtin_amdgcn_sched_barrier(0);
            }
#undef ROUTE_LOAD
        }
        int g[8][16];
#pragma unroll
        for (int nt = 0; nt < 4; ++nt)
#pragma unroll
            for (int i = 0; i < 16; ++i) {
                const unsigned a = __float_as_uint(acc[0][nt][i]), b = __float_as_uint(acc[1][nt][i]);
                auto sw = __builtin_amdgcn_permlane32_swap(a, b, false, false);
                const int n0 = nt * 32 + (i & 3) + 8 * (i >> 2);
                g[nt * 2 + (i >> 3)][i & 7] = (f2ord(__uint_as_float(sw[0])) & ~127) | n0;
                g[nt * 2 + (i >> 3)][8 + (i & 7)] = (f2ord(__uint_as_float(sw[1])) & ~127) | (n0 + 4);
            }
#pragma unroll
        for (int q = 0; q < 8; ++q) sort16_desc(g[q]);
        merge_top16(g[0], g[1]); merge_top16(g[2], g[3]); merge_top16(g[4], g[5]); merge_top16(g[6], g[7]);
        merge_top16(g[0], g[2]); merge_top16(g[4], g[6]);
        merge_top16(g[0], g[4]);
        {
            u32x4 pk;
            unsigned* pp = (unsigned*)&pk;
#pragma unroll
            for (int q = 0; q < 4; ++q) pp[q] = (unsigned)(g[0][4 * q] & 127) | ((unsigned)(g[0][4 * q + 1] & 127) << 8) | ((unsigned)(g[0][4 * q + 2] & 127) << 16) | ((unsigned)(g[0][4 * q + 3] & 127) << 24);
            *(u32x4*)(myidx + lane * 16) = pk;
        }
        float f0[16], f1[16];
#pragma unroll
        for (int i = 0; i < 16; ++i) {
            const unsigned a = (unsigned)g[0][i], b = a;
            auto sw = __builtin_amdgcn_permlane32_swap(a, b, false, false);
            f0[i] = ord2f((int)sw[0] & ~127); f1[i] = ord2f((int)sw[1] & ~127);
        }
        int c0[16], c1[16], c2[16], c3[16];
#pragma unroll
        for (int j = 0; j < 16; ++j) c0[j] = (f2ord(f0[0] + f1[j]) & ~255) | j;
#pragma unroll
        for (int i = 1; i < 16; ++i) c1[i - 1] = (f2ord(f0[i] + f1[0]) & ~255) | (i << 4);
        c1[15] = (int)0x80000000;
#define CK(i, j) ((f2ord(f0[i] + f1[j]) & ~255) | ((i) << 4) | (j))
        c2[0] = CK(1, 1); c2[1] = CK(1, 2); c2[2] = CK(1, 3); c2[3] = CK(1, 4); c2[4] = CK(1, 5); c2[5] = CK(1, 6); c2[6] = CK(1, 7);
        c2[7] = CK(2, 1); c2[8] = CK(2, 2); c2[9] = CK(2, 3); c2[10] = CK(2, 4);
        c2[11] = CK(3, 1); c2[12] = CK(3, 2); c2[13] = CK(3, 3);
        c2[14] = CK(4, 1); c2[15] = CK(4, 2);
        c3[0] = CK(5, 1); c3[1] = CK(6, 1); c3[2] = CK(7, 1);
#undef CK
#pragma unroll
        for (int q = 3; q < 16; ++q) c3[q] = (int)0x80000000;
        sort16_desc(c2);
        ce_desc(c3[0], c3[1]); ce_desc(c3[1], c3[2]); ce_desc(c3[0], c3[1]);
        merge_top16(c0, c1); merge_top16(c2, c3); merge_top16(c0, c2);
        float bs[16], den = 0.f;
#pragma unroll
        for (int i = 0; i < 16; ++i) { bs[i] = __expf(ord2f(c0[i] & ~255) - ord2f(c0[0] & ~255)); den += bs[i]; }
        const float rden = 1.f / den;
        asm volatile("s_waitcnt lgkmcnt(0)" ::: "memory");
#pragma unroll
        for (int q = 0; q < 8; ++q) {
            const int key = (int)__builtin_amdgcn_permlane32_swap((unsigned)c0[q], (unsigned)c0[8 + q], false, false)[0];
            const float gv = __uint_as_float(__builtin_amdgcn_permlane32_swap(__float_as_uint(bs[q]), __float_as_uint(bs[8 + q]), false, false)[0]) * rden;
            const int i = (key >> 4) & 15, j = key & 15;
            const int e = (int)myidx[r5 * 16 + i] * 128 + (int)myidx[(32 + r5) * 16 + j];
            const int tokl = tt * 32 + r5;
            ((unsigned short*)(lds_lists + PL_SEID))[tokl * 128 + h * 16 + 8 * hh + q] = (unsigned short)e;
            ((float*)(lds_lists + PL_SWGT))[tokl * 128 + h * 16 + 8 * hh + q] = gv;
        }
        asm volatile("s_waitcnt lgkmcnt(0)" ::: "memory");
    }
}

DI void unpack_h2(const bf16_t* __restrict__ hA, int t, int lane, f32x2 (&hv)[8]) {
    const int tile = t >> 7, row = t & 127, mb = row >> 5, r5 = row & 31;
    const bf16_t* hp = hA + ((unsigned)(((tile * 64 + lane) * 4 + mb) * 64 + r5)) * 8;
    const u32x4 ha = *(const u32x4*)hp, hb = *(const u32x4*)(hp + 32 * 8);
    const unsigned hw[8] = {ha.x, ha.y, ha.z, ha.w, hb.x, hb.y, hb.z, hb.w};
#pragma unroll
    for (int q = 0; q < 8; ++q) { hv[q].x = __uint_as_float(hw[q] << 16); hv[q].y = __uint_as_float(hw[q] & 0xffff0000u); }
}
typedef _Float16 h16x2 __attribute__((ext_vector_type(2)));
DI h16x2 fp4h(unsigned w, int sel) {
    return sel == 0 ? __builtin_amdgcn_cvt_scalef32_pk_f16_fp4(w, 1.0f, 0) : sel == 1 ? __builtin_amdgcn_cvt_scalef32_pk_f16_fp4(w, 1.0f, 1)
         : sel == 2 ? __builtin_amdgcn_cvt_scalef32_pk_f16_fp4(w, 1.0f, 2) : __builtin_amdgcn_cvt_scalef32_pk_f16_fp4(w, 1.0f, 3);
}
DI void stage_token(const int* __restrict__ ridx, const float* __restrict__ rgate, char* lds, int t, int tloc, int lane) {
    lane = opaque_v(lane); t = opaque_s(t);
    unsigned short* seid = (unsigned short*)(lds + PL_SEID) + tloc * 128;
    float* swgt = (float*)(lds + PL_SWGT) + tloc * 128;
    seid[lane] = (unsigned short)ridx[(unsigned)(t * 128 + lane)]; seid[64 + lane] = (unsigned short)ridx[(unsigned)(t * 128 + 64 + lane)];
    swgt[lane] = rgate[(unsigned)(t * 128 + lane)]; swgt[64 + lane] = rgate[(unsigned)(t * 128 + 64 + lane)];
}
DI void peer_down_wave(const bf16_t* __restrict__ hA, char* lds, const unsigned char* __restrict__ TBd, const float* __restrict__ SC, int tile, int w, int lane) {
    lane = opaque_v(lane);
    const int myu = ((lane >> 5) & 1) * 8 + ((lane >> 4) & 1) * 4 + ((lane >> 3) & 1) * 2 + ((lane >> 2) & 1);
    const unsigned short* seid = (const unsigned short*)(lds + PL_SEID) + w * 16 * 128;
    float* swgt = (float*)(lds + PL_SWGT) + w * 16 * 128;
    u32x4 haN, hbN;
    int ev0N, ev1N;
    { const bf16_t* hp0 = hA + (unsigned)((tile * 128 + w * 16) * 1024 + lane * 16); haN = *(const u32x4*)hp0; hbN = *(const u32x4*)(hp0 + 8); ev0N = seid[lane]; ev1N = seid[64 + lane]; }
    u32x2 R[2][16];
    f32x2 scv[2];
#define DOWN_ISSUE(buf, EV, base) do { _Pragma("unroll") for (int u_ = 0; u_ < 16; ++u_) { const int e_ = __builtin_amdgcn_readlane(EV, (base) + u_); \
        R[buf][u_] = *(const u32x2*)(TBd + (size_t)(unsigned)e_ * 512 + lane * 8); } \
        scv[buf] = *(const f32x2*)(SC + (unsigned)__shfl(EV, (base) + myu) * 2); } while (0)
    DOWN_ISSUE(0, ev0N, 0);
#pragma unroll 1
    for (int tl = 0; tl < 16; ++tl) {
        const int t = tile * 128 + w * 16 + tl;
        float* gp = swgt + tl * 128;
        const u32x4 ha = haN, hb = hbN;
        const int ev0 = ev0N, ev1 = ev1N;
        {
            const int tn = tl < 15 ? tl + 1 : tl;
            const bf16_t* hp = hA + (unsigned)((t - tl + tn) * 1024 + lane * 16); haN = *(const u32x4*)hp; hbN = *(const u32x4*)(hp + 8);
            ev0N = seid[tn * 128 + lane]; ev1N = seid[tn * 128 + 64 + lane];
        }
        unsigned hhi[2], hlo[2];
        float hscale;
        {
            const unsigned hw[8] = {ha.x, ha.y, ha.z, ha.w, hb.x, hb.y, hb.z, hb.w};
            float hf[16];
            float m = 0.f;
#pragma unroll
            for (int q = 0; q < 8; ++q) { hf[2 * q] = __uint_as_float(hw[q] << 16); hf[2 * q + 1] = __uint_as_float(hw[q] & 0xffff0000u); m = fmaxf(m, fmaxf(fabsf(hf[2 * q]), fabsf(hf[2 * q + 1]))); }
#pragma unroll
            for (int o = 1; o < 64; o <<= 1) m = fmaxf(m, __shfl_xor(m, o));
            hscale = m > 0.f ? m * (1.f / 119.f) : 1.f;
            const float inv = 1.f / hscale;
            hhi[0] = hhi[1] = hlo[0] = hlo[1] = 0u;
#pragma unroll
            for (int e = 0; e < 16; ++e) {
                const int hq = __float2int_rn(hf[e] * inv);
                const int lo = ((hq + 8) & 15) - 8, hi = (hq - lo) >> 4;
                hlo[e >> 3] |= ((unsigned)lo & 15u) << (4 * (e & 7));
                hhi[e >> 3] |= ((unsigned)hi & 15u) << (4 * (e & 7));
            }
        }
#pragma unroll
        for (int bt = 0; bt < 8; ++bt) {
            const int cur = bt & 1, nxt = cur ^ 1;
            if (bt < 3) DOWN_ISSUE(nxt, ev0, (bt + 1) * 16);
            else if (bt == 3) DOWN_ISSUE(nxt, ev1, 0);
            else if (bt < 7) DOWN_ISSUE(nxt, ev1, (bt - 3) * 16);
            else DOWN_ISSUE(nxt, ev0N, 0);
            __builtin_amdgcn_sched_barrier(0);
            int part[16];
#pragma unroll
            for (int u = 0; u < 16; ++u) {
                int shi = __builtin_amdgcn_sdot8((int)R[cur][u].x, (int)hhi[0], 0, false);
                shi = __builtin_amdgcn_sdot8((int)R[cur][u].y, (int)hhi[1], shi, false);
                int slo = __builtin_amdgcn_sdot8((int)R[cur][u].x, (int)hlo[0], 0, false);
                slo = __builtin_amdgcn_sdot8((int)R[cur][u].y, (int)hlo[1], slo, false);
                part[u] = shi * 16 + slo;
            }
            int r8[8], r4[4], r2[2], r1;
            {
                const bool b5 = (lane & 32) != 0, b4 = (lane & 16) != 0, b3 = (lane & 8) != 0, b2 = (lane & 4) != 0;
#pragma unroll
                for (int q = 0; q < 8; ++q) { const int keep = b5 ? part[q + 8] : part[q], give = b5 ? part[q] : part[q + 8]; r8[q] = keep + __shfl_xor(give, 32); }
#pragma unroll
                for (int q = 0; q < 4; ++q) { const int keep = b4 ? r8[q + 4] : r8[q], give = b4 ? r8[q] : r8[q + 4]; r4[q] = keep + __shfl_xor(give, 16); }
#pragma unroll
                for (int q = 0; q < 2; ++q) { const int keep = b3 ? r4[q + 2] : r4[q], give = b3 ? r4[q] : r4[q + 2]; r2[q] = keep + __shfl_xor(give, 8); }
                { const int keep = b2 ? r2[1] : r2[0], give = b2 ? r2[0] : r2[1]; r1 = keep + __shfl_xor(give, 4); }
                r1 += __shfl_xor(r1, 2); r1 += __shfl_xor(r1, 1);
            }
            if ((lane & 3) == 0) {
                const float a = (float)r1 * (scv[cur].x * hscale);
                gp[bt * 16 + myu] = gp[bt * 16 + myu] * (0.5f * a * (1.f + erff(a * 0.70710678118654752f))) * scv[cur].y;
            }
        }
    }
#undef DOWN_ISSUE
}
DI void peer_up_wave(char* lds, const unsigned char* __restrict__ TBu, const float* __restrict__ g2b, float* __restrict__ x, int tile, int w, int lane) {
    lane = opaque_v(lane);
    const unsigned short* seid = (const unsigned short*)(lds + PL_SEID) + w * 16 * 128;
    const float* swgt = (const float*)(lds + PL_SWGT) + w * 16 * 128;
    u32x2 RA[16], RB[16];
#define UP_ISSUE(R, EV, base) do { _Pragma("unroll") for (int u_ = 0; u_ < 16; ++u_) { const int e_ = __builtin_amdgcn_readlane(EV, (base) + u_); \
        R[u_] = *(const u32x2*)(TBu + (size_t)(unsigned)e_ * 512 + lane * 8); } } while (0)
#define UP_COMPUTE(R, WL, base, K) do { _Pragma("unroll") for (int u_ = 0; u_ < 16; ++u_) { \
        const _Float16 wh_ = (_Float16)__int_as_float(__builtin_amdgcn_readlane(__float_as_int(WL), (base) + u_)); const h16x2 w2_ = (h16x2){wh_, wh_}; \
        _Pragma("unroll") for (int q_ = 0; q_ < 4; ++q_) { acc[K][q_] = __builtin_elementwise_fma(w2_, fp4h(R[u_].x, q_), acc[K][q_]); acc[K][4 + q_] = __builtin_elementwise_fma(w2_, fp4h(R[u_].y, q_), acc[K][4 + q_]); } } } while (0)
    int ev0N = seid[lane], ev1N = seid[64 + lane];
    float wl0N = swgt[lane], wl1N = swgt[64 + lane];
    UP_ISSUE(RA, ev0N, 0);
    for (int r = 0; r < 2; ++r) {
        h16x2 acc[8][8];
#pragma unroll
        for (int k = 0; k < 8; ++k)
#pragma unroll
            for (int q = 0; q < 8; ++q) acc[k][q] = (h16x2){(_Float16)0.f, (_Float16)0.f};
#pragma unroll
        for (int k = 0; k < 8; ++k) {
            const int ev0 = ev0N, ev1 = ev1N;
            const float wl0 = wl0N, wl1 = wl1N;
            {
                const int tn = (r * 8 + k < 15) ? r * 8 + k + 1 : 15;
                ev0N = seid[tn * 128 + lane]; ev1N = seid[tn * 128 + 64 + lane]; wl0N = swgt[tn * 128 + lane]; wl1N = swgt[tn * 128 + 64 + lane];
            }
#pragma unroll 1
            for (int i = 0; i < 4; ++i) {
                const int evS = i < 2 ? ev0 : ev1;
                const float wlS = i < 2 ? wl0 : wl1;
                const int base = (i & 1) * 32;
                UP_ISSUE(RB, evS, base + 16);
                __builtin_amdgcn_sched_barrier(0);
                UP_COMPUTE(RA, wlS, base, k);
                const int evT = i < 3 ? (i < 1 ? ev0 : ev1) : ev0N;
                const int baseT = i < 3 ? ((i + 1) & 1) * 32 : 0;
                UP_ISSUE(RA, evT, baseT);
                __builtin_amdgcn_sched_barrier(0);
                UP_COMPUTE(RB, wlS, base + 16, k);
            }
        }
#pragma unroll
        for (int k = 0; k < 8; ++k) {
            const int t = tile * 128 + w * 16 + r * 8 + k;
            float4* xp = (float4*)(x + (size_t)t * D + lane * 16);
            const float4* gq = (const float4*)(g2b + lane * 16);
            float ssx = 0.f;
#pragma unroll
            for (int q = 0; q < 4; ++q) {
                float4 xv = xp[q]; const float4 gv = gq[q];
                xv.x += gv.x * (float)acc[k][2 * q].x; xv.y += gv.y * (float)acc[k][2 * q].y; xv.z += gv.z * (float)acc[k][2 * q + 1].x; xv.w += gv.w * (float)acc[k][2 * q + 1].y;
                xp[q] = xv;
                ssx += xv.x * xv.x + xv.y * xv.y + xv.z * xv.z + xv.w * xv.w;
            }
            ssx = wave_sum(ssx);
            if (lane == 0) ((float*)(lds + LDS_RSTD1))[w * 16 + r * 8 + k] = rsqrtf(ssx * (1.f / D) + EPS);
        }
    }
#undef UP_ISSUE
#undef UP_COMPUTE
}

DI void epi_qk(f32x16 (&acc)[4][2], const float* __restrict__ gain, float scale, bf16_t* __restrict__ dst, int lane) {
    lane = opaque_v(lane);
    const int hh = lane >> 5;
    float gv[2][16];
#pragma unroll
    for (int nb = 0; nb < 2; ++nb)
#pragma unroll
        for (int i = 0; i < 16; ++i) gv[nb][i] = gain[nb * 32 + (i & 3) + 8 * (i >> 2) + 4 * hh] * scale;
#pragma unroll
    for (int mb = 0; mb < 4; ++mb) {
        float ss = 0.f;
#pragma unroll
        for (int nb = 0; nb < 2; ++nb)
#pragma unroll
            for (int i = 0; i < 16; ++i) ss += acc[mb][nb][i] * acc[mb][nb][i];
        ss += __shfl_xor(ss, 32);
        const float r = rsqrtf(ss * (1.f / 64.f) + EPS);
#pragma unroll
        for (int nb = 0; nb < 2; ++nb)
#pragma unroll
            for (int s = 0; s < 2; ++s) {
                const f32x16& a = acc[mb][nb];
                u32x4 o;
                o.x = pk2(a[8 * s] * r * gv[nb][8 * s], a[8 * s + 1] * r * gv[nb][8 * s + 1]);
                o.y = pk2(a[8 * s + 2] * r * gv[nb][8 * s + 2], a[8 * s + 3] * r * gv[nb][8 * s + 3]);
                o.z = pk2(a[8 * s + 4] * r * gv[nb][8 * s + 4], a[8 * s + 5] * r * gv[nb][8 * s + 5]);
                o.w = pk2(a[8 * s + 6] * r * gv[nb][8 * s + 6], a[8 * s + 7] * r * gv[nb][8 * s + 7]);
                *(u32x4*)(dst + ((unsigned)(((nb * 2 + s) * 4 + mb) * 64 + lane)) * 8) = o;
            }
    }
}
DI void epi_v(const f32x16 (&acc)[4][2], bf16_t* __restrict__ dst, int lane) {
    lane = opaque_v(lane);
#pragma unroll
    for (int nb = 0; nb < 2; ++nb)
#pragma unroll
        for (int mb = 0; mb < 4; ++mb)
#pragma unroll
            for (int s = 0; s < 2; ++s) {
                const f32x16& a = acc[mb][nb];
                u32x4 o; o.x = pk2(a[8 * s], a[8 * s + 1]); o.y = pk2(a[8 * s + 2], a[8 * s + 3]); o.z = pk2(a[8 * s + 4], a[8 * s + 5]); o.w = pk2(a[8 * s + 6], a[8 * s + 7]);
                *(u32x4*)(dst + ((unsigned)(((nb * 4 + mb) * 2 + s) * 64 + lane)) * 8) = o;
            }
}
DI void epi_row(const f32x16 (&acc)[4][2], bf16_t* __restrict__ dst, int ld, int lane) {
    lane = opaque_v(lane);
    const int r5 = lane & 31, hh = lane >> 5;
#pragma unroll
    for (int mb = 0; mb < 4; ++mb)
#pragma unroll
        for (int nb = 0; nb < 2; ++nb)
#pragma unroll
            for (int gq = 0; gq < 4; ++gq) {
                const f32x16& a = acc[mb][nb];
                u32x2 o; o.x = pk2(a[4 * gq], a[4 * gq + 1]); o.y = pk2(a[4 * gq + 2], a[4 * gq + 3]);
                *(u32x2*)(dst + (unsigned)((mb * 32 + r5) * ld + nb * 32 + 8 * gq + 4 * hh)) = o;
            }
}
DI void epi_z(const f32x16 (&acc)[4][2], bf16_t* __restrict__ dst, int lane) {
    lane = opaque_v(lane);
    const int r5 = lane & 31, hh = lane >> 5;
#pragma unroll
    for (int mb = 0; mb < 4; ++mb)
#pragma unroll
        for (int gq = 0; gq < 4; ++gq) {
            const f32x16 &a = acc[mb][0], &b = acc[mb][1];
            u32x2 o; o.x = pk2(a[4 * gq] * b[4 * gq], a[4 * gq + 1] * b[4 * gq + 1]); o.y = pk2(a[4 * gq + 2] * b[4 * gq + 2], a[4 * gq + 3] * b[4 * gq + 3]);
            *(u32x2*)(dst + (unsigned)((mb * 32 + r5) * 256 + 8 * gq + 4 * hh)) = o;
        }
}
DI void epi_su_park(const f32x16 (&acc)[4][2], unsigned* lds_su, int lane) {
    lane = opaque_v(lane);
#pragma unroll
    for (int mb = 0; mb < 4; ++mb)
#pragma unroll
        for (int nb = 0; nb < 2; ++nb)
#pragma unroll
            for (int q = 0; q < 8; ++q) lds_su[((mb * 2 + nb) * 8 + q) * 64 + lane] = pk2(acc[mb][nb][2 * q], acc[mb][nb][2 * q + 1]);
}
DI void epi_sv(f32x16 (&acc)[4][2], const bf16_t* __restrict__ SWF  , const float* __restrict__ bs_g, const unsigned* lds_su, bf16_t* __restrict__ dst, int lane) {
    lane = opaque_v(lane);
    const int r5 = lane & 31, hh = lane >> 5;
    bf16x8 vb[4][2][2];
#pragma unroll
    for (int mb = 0; mb < 4; ++mb) {
#pragma unroll
        for (int i = 0; i < 16; ++i) {
            float s1 = acc[mb][0][i] + acc[mb][1][i];
#pragma unroll
            for (int o = 1; o < 32; o <<= 1) s1 += __shfl_xor(s1, o);
            const float mu = s1 * (1.f / 64.f);
            const float d0 = acc[mb][0][i] - mu, d1 = acc[mb][1][i] - mu;
            float s2 = d0 * d0 + d1 * d1;
#pragma unroll
            for (int o = 1; o < 32; o <<= 1) s2 += __shfl_xor(s2, o);
            const float r = rsqrtf(s2 * (1.f / 64.f) + EPS);
            acc[mb][0][i] = d0 * r; acc[mb][1][i] = d1 * r;
        }
#pragma unroll
        for (int s = 0; s < 2; ++s)
#pragma unroll
            for (int nb = 0; nb < 2; ++nb) {
                const f32x16& a = acc[mb][nb];
                u32x4 o; o.x = pk2(a[8 * s], a[8 * s + 1]); o.y = pk2(a[8 * s + 2], a[8 * s + 3]); o.z = pk2(a[8 * s + 4], a[8 * s + 5]); o.w = pk2(a[8 * s + 6], a[8 * s + 7]);
                vb[mb][s][nb] = __builtin_bit_cast(bf16x8, o);
            }
    }
#pragma unroll
    for (int tb = 0; tb < 4; ++tb) {
        f32x16 y[2];
#pragma unroll
        for (int nb = 0; nb < 2; ++nb)
#pragma unroll
            for (int i = 0; i < 16; ++i) y[nb][i] = 0.f;
#pragma unroll
        for (int kt = 0; kt <= tb; ++kt)
#pragma unroll
            for (int s = 0; s < 2; ++s) {
                const bf16x8 wa = *(const bf16x8*)(SWF + ((unsigned)(((tb * 4 + kt) * 2 + s) * 64 + lane)) * 8);
                y[0] = MFMA32(wa, vb[kt][s][0], y[0]);
                y[1] = MFMA32(wa, vb[kt][s][1], y[1]);
            }
#pragma unroll
        for (int nb = 0; nb < 2; ++nb)
#pragma unroll
            for (int q = 0; q < 8; ++q) {
                const unsigned su2 = lds_su[((tb * 2 + nb) * 8 + q) * 64 + lane];
                const int i0 = 2 * q, i1 = 2 * q + 1;
                const int t0 = tb * 32 + (i0 & 3) + 8 * (i0 >> 2) + 4 * hh, t1 = tb * 32 + (i1 & 3) + 8 * (i1 >> 2) + 4 * hh;
                const float v0 = (y[nb][i0] + bs_g[t0]) * __uint_as_float(su2 << 16), v1 = (y[nb][i1] + bs_g[t1]) * __uint_as_float(su2 & 0xffff0000u);
                const unsigned pk = pk2(v0, v1);
                dst[(unsigned)(t0 * 256 + nb * 32 + r5)] = (bf16_t)(pk & 0xffffu);
                dst[(unsigned)(t1 * 256 + nb * 32 + r5)] = (bf16_t)(pk >> 16);
            }
    }
}

DI void conv_sguw_item(const float* __restrict__ W, bf16_t* __restrict__ SWF, int gid) {
    const int lane = gid & 63, s = (gid >> 6) & 1, kt = (gid >> 7) & 3, tb = (gid >> 9) & 3, g = gid >> 11;
    const int r = lane & 31, hh = lane >> 5, t = tb * 32 + r;
    const float* p = W + ((size_t)g * 128 + t) * 128;
    float v[8];
#pragma unroll
    for (int j = 0; j < 8; ++j) { const int sp = kt * 32 + 16 * s + 8 * (j >> 2) + 4 * hh + (j & 3); v[j] = sp <= t ? p[sp] : 0.f; }
    u32x4 o; o.x = pk2(v[0], v[1]); o.y = pk2(v[2], v[3]); o.z = pk2(v[4], v[5]); o.w = pk2(v[6], v[7]);
    *(u32x4*)(SWF + (size_t)gid * 8) = o;
}

DI int t5_bucket(int d) {
    if (d < 16) return d;
    const float lr = logf((float)d / 16.f) / logf(8.f);
    const int large = 16 + (int)(lr * 16.f);
    return large < 31 ? large : 31;
}

DI void attn_tile(const bf16_t* __restrict__ QF, const bf16_t* __restrict__ KF2, const bf16_t* __restrict__ VF, const float* bias_lds, const float* __restrict__ sink, bf16_t* __restrict__ OR, int tile, int tid) {
    tid = opaque_v(tid); tile = opaque_s(tile);
    const int lane = tid & 63, w = __builtin_amdgcn_readfirstlane(tid >> 6), r5 = lane & 31, hh = lane >> 5;
    const bool has_prev = (tile & 31) != 0;
    for (int task = w; task < 32; task += 8) {
        const int qh = task >> 2, qt = task & 3, kvh = qh >> 2;
        bf16x8 bq[4];
#pragma unroll
        for (int ks = 0; ks < 4; ++ks) bq[ks] = *(const bf16x8*)(QF + ((unsigned)((((tile * 8 + qh) * 4 + ks) * 4 + qt) * 64 + lane)) * 8);
        f32x16 sc[5];
#pragma unroll
        for (int grp = 0; grp < 2; ++grp) {
            bf16x8 kf[3][4];
#pragma unroll
            for (int jq = 0; jq < 3; ++jq) if (grp * 3 + jq < 5) {
                const int jj = grp * 3 + jq, j = qt + jj, st = (j >= 4 || !has_prev) ? tile : tile - 1, kt = j & 3;
#pragma unroll
                for (int ks = 0; ks < 4; ++ks) kf[jq][ks] = *(const bf16x8*)(KF2 + ((unsigned)((((st * 2 + kvh) * 4 + ks) * 4 + kt) * 64 + lane)) * 8);
            }
#pragma unroll
            for (int jq = 0; jq < 3; ++jq) if (grp * 3 + jq < 5) {
                const int jj = grp * 3 + jq;
#pragma unroll
                for (int i = 0; i < 16; ++i) sc[jj][i] = 0.f;
#pragma unroll
                for (int ks = 0; ks < 4; ++ks) sc[jj] = MFMA32(kf[jq][ks], bq[ks], sc[jj]);
            }
            __builtin_amdgcn_sched_barrier(0);
        }
        bf16x8 vf[5][2][2];
#pragma unroll
        for (int jj = 0; jj < 2; ++jj) {
            const int j = qt + jj, st = (j >= 4 || !has_prev) ? tile : tile - 1, kt = j & 3;
#pragma unroll
            for (int s2 = 0; s2 < 2; ++s2)
#pragma unroll
                for (int dt = 0; dt < 2; ++dt) vf[jj][s2][dt] = *(const bf16x8*)(VF + ((unsigned)(((((st * 2 + kvh) * 2 + dt) * 4 + kt) * 2 + s2) * 64 + lane)) * 8);
        }
        const float* bl = bias_lds + qh * 128;
        float m = -1e30f;
#pragma unroll
        for (int jj = 0; jj < 5; ++jj) {
            const bool ex = (qt + jj >= 4) || has_prev;
#pragma unroll
            for (int i = 0; i < 16; ++i) {
                const int cr = (i & 3) + 8 * (i >> 2) + 4 * hh;
                const int dist = 128 + r5 - 32 * jj - cr;
                const bool valid = ex && dist >= 0 && dist < 128;
                const float v = valid ? sc[jj][i] + bl[dist & 127] : -1e30f;
                sc[jj][i] = v; m = fmaxf(m, v);
            }
        }
        m = fmaxf(m, __shfl_xor(m, 32));
        const float sk = sink[qh];
        m = fmaxf(m, sk);
        float l = 0.f;
#pragma unroll
        for (int jj = 0; jj < 5; ++jj)
#pragma unroll
            for (int i = 0; i < 16; ++i) { const float p = __expf(sc[jj][i] - m); sc[jj][i] = p; l += p; }
        l += __shfl_xor(l, 32);
        l += __expf(sk - m);
        const float rl = 1.f / l;
        f32x16 o[2];
#pragma unroll
        for (int dt = 0; dt < 2; ++dt)
#pragma unroll
            for (int i = 0; i < 16; ++i) o[dt][i] = 0.f;
        __builtin_amdgcn_sched_barrier(0);
#pragma unroll
        for (int jj = 2; jj < 5; ++jj) {
            const int j = qt + jj, st = (j >= 4 || !has_prev) ? tile : tile - 1, kt = j & 3;
#pragma unroll
            for (int s2 = 0; s2 < 2; ++s2)
#pragma unroll
                for (int dt = 0; dt < 2; ++dt) vf[jj][s2][dt] = *(const bf16x8*)(VF + ((unsigned)(((((st * 2 + kvh) * 2 + dt) * 4 + kt) * 2 + s2) * 64 + lane)) * 8);
        }
#pragma unroll
        for (int jj = 0; jj < 5; ++jj) {
#pragma unroll
            for (int s = 0; s < 2; ++s) {
                const f32x16& a = sc[jj];
                u32x4 pp; pp.x = pk2(a[8 * s], a[8 * s + 1]); pp.y = pk2(a[8 * s + 2], a[8 * s + 3]); pp.z = pk2(a[8 * s + 4], a[8 * s + 5]); pp.w = pk2(a[8 * s + 6], a[8 * s + 7]);
                const bf16x8 pb = __builtin_bit_cast(bf16x8, pp);
#pragma unroll
                for (int dt = 0; dt < 2; ++dt) o[dt] = MFMA32(vf[jj][s][dt], pb, o[dt]);
            }
        }
        bf16_t* orow = OR + (unsigned)((tile * 128 + qt * 32 + r5) * 512 + qh * 64 + 4 * hh);
#pragma unroll
        for (int dt = 0; dt < 2; ++dt)
#pragma unroll
            for (int gq = 0; gq < 4; ++gq) {
                u32x2 ov; ov.x = pk2(o[dt][4 * gq] * rl, o[dt][4 * gq + 1] * rl); ov.y = pk2(o[dt][4 * gq + 2] * rl, o[dt][4 * gq + 3] * rl);
                *(u32x2*)(orow + dt * 32 + 8 * gq) = ov;
            }
    }
}

DI void unpack8(const u32x4 v, float (&f)[8]) {
    f[0] = __uint_as_float(v.x << 16); f[1] = __uint_as_float(v.x & 0xffff0000u); f[2] = __uint_as_float(v.y << 16); f[3] = __uint_as_float(v.y & 0xffff0000u);
    f[4] = __uint_as_float(v.z << 16); f[5] = __uint_as_float(v.z & 0xffff0000u); f[6] = __uint_as_float(v.w << 16); f[7] = __uint_as_float(v.w & 0xffff0000u);
}
DI void merge_tile(const bf16_t* __restrict__ OR, const bf16_t* __restrict__ CBR, const bf16_t* __restrict__ ZR, const bf16_t* __restrict__ YS, const float* __restrict__ cw  , const float* __restrict__ og  ,
                   bf16_t* __restrict__ mA, int tile, int tid) {
    tid = opaque_v(tid); tile = opaque_s(tile);
    const int lane = tid & 63, w = tid >> 6;
#pragma unroll 4
    for (int rr = 0; rr < 16; ++rr) {
        const int row = w * 16 + rr, t = tile * 128 + row, pos = t & (S - 1);
        float a[8], y[8];
        unpack8(*(const u32x4*)(OR + (unsigned)(t * 512 + lane * 8)), a);
        float ssa = 0.f;
#pragma unroll
        for (int q = 0; q < 8; ++q) ssa += a[q] * a[q];
        ssa = wave_sum(ssa);
        if (lane < 32) {
            const int c0 = lane * 8;
            float cb[8], z0[8], z1[8], z2[8];
            unpack8(*(const u32x4*)(CBR + (unsigned)(t * 256 + c0)), cb);
            unpack8(*(const u32x4*)(ZR + (unsigned)(t * 256 + c0)), z2);
            if (pos >= 1) unpack8(*(const u32x4*)(ZR + (unsigned)((t - 1) * 256 + c0)), z1); else { _Pragma("unroll") for (int q = 0; q < 8; ++q) z1[q] = 0.f; }
            if (pos >= 2) unpack8(*(const u32x4*)(ZR + (unsigned)((t - 2) * 256 + c0)), z0); else { _Pragma("unroll") for (int q = 0; q < 8; ++q) z0[q] = 0.f; }
#pragma unroll
            for (int q = 0; q < 8; ++q) y[q] = cb[q] * (cw[c0 + q] * z0[q] + cw[256 + c0 + q] * z1[q] + cw[512 + c0 + q] * z2[q]);
        } else {
            unpack8(*(const u32x4*)(YS + (unsigned)(t * 256 + (lane - 32) * 8)), y);
        }
        float ssy = 0.f;
#pragma unroll
        for (int q = 0; q < 8; ++q) ssy += y[q] * y[q];
#pragma unroll
        for (int o = 1; o < 32; o <<= 1) ssy += __shfl_xor(ssy, o);
        const float ra = rsqrtf(ssa * (1.f / 512.f) + EPS), ry = rsqrtf(ssy * (1.f / 256.f) + EPS);
        const int mb = row >> 5, r5 = row & 31;
        {
            const float4 g0 = *(const float4*)(og + lane * 8), g1 = *(const float4*)(og + lane * 8 + 4);
            u32x4 o; o.x = pk2(a[0] * ra * g0.x, a[1] * ra * g0.y); o.y = pk2(a[2] * ra * g0.z, a[3] * ra * g0.w); o.z = pk2(a[4] * ra * g1.x, a[5] * ra * g1.y); o.w = pk2(a[6] * ra * g1.z, a[7] * ra * g1.w);
            const int c8 = lane;
            (void)c8;
            *(u32x4*)(mA + (unsigned)(t * 1024 + lane * 8)) = o;
        }
        {
            const float4 g0 = *(const float4*)(og + 512 + lane * 8), g1 = *(const float4*)(og + 512 + lane * 8 + 4);
            u32x4 o; o.x = pk2(y[0] * ry * g0.x, y[1] * ry * g0.y); o.y = pk2(y[2] * ry * g0.z, y[3] * ry * g0.w); o.z = pk2(y[4] * ry * g1.x, y[5] * ry * g1.y); o.w = pk2(y[6] * ry * g1.z, y[7] * ry * g1.w);
            const int c8 = 64 + lane;
            (void)c8;
            *(u32x4*)(mA + (unsigned)(t * 1024 + 512 + lane * 8)) = o;
        }
    }
}

struct InProjOut { bf16_t *QF, *KF2, *VF, *CBR, *ZR, *YS; };
DI void inproj_tile(const bf16_t* __restrict__ At, const bf16_t* __restrict__ WF, const float* __restrict__ qg, const float* __restrict__ kg, const bf16_t* __restrict__ SWF, const float* __restrict__ sgu_b,
                    const InProjOut& O, char* lds, int tile, int tid) {
    tid = opaque_v(tid); tile = opaque_s(tile);
    const int lane = tid & 63, w = __builtin_amdgcn_readfirstlane(tid >> 6);
    f32x16 acc[4][2];
    {
        const int nbt0 = w * 2;
        kloop<1>(acc, At, WF + (size_t)nbt0 * 32768, WF + (size_t)(nbt0 + 1) * 32768, lds, tid, lane);
        epi_qk(acc, qg, 0.125f, O.QF + (size_t)(tile * 8 + w) * 8192, lane);
    }
    {
        const int nbt0 = 16 + w * 2;
        if (w == 2 || w == 3) {
            kloop<0>(acc, At, WF + (size_t)nbt0 * 32768, WF + (size_t)(nbt0 + 1) * 32768, lds, tid, lane);
            epi_v(acc, O.VF + (size_t)(tile * 2 + (w - 2)) * 8192, lane);
        } else {
            kloop<1>(acc, At, WF + (size_t)nbt0 * 32768, WF + (size_t)(nbt0 + 1) * 32768, lds, tid, lane);
            if (w < 2) epi_qk(acc, kg, 1.f, O.KF2 + (size_t)(tile * 2 + w) * 8192, lane);
            else epi_row(acc, O.CBR + (size_t)tile * 128 * 256 + (w - 4) * 64, 256, lane);
        }
    }
    {
        const int nbt0 = 32 + w * 2;
        kloop<1>(acc, At, WF + (size_t)nbt0 * 32768, WF + (size_t)(nbt0 + 1) * 32768, lds, tid, lane);
        epi_z(acc, O.ZR + (size_t)tile * 128 * 256 + w * 32, lane);
    }
    {
        const int nbt0 = 48 + w * 2;
        kloop<0>(acc, At, WF + (size_t)nbt0 * 32768, WF + (size_t)(nbt0 + 1) * 32768, lds, tid, lane);
        unsigned* lds_su = (unsigned*)lds;
        if (w < 4) epi_su_park(acc, lds_su + w * 4096, lane);
        __syncthreads();
        if (w >= 4) epi_sv(acc, SWF + (size_t)(w - 4) * 16384, sgu_b + (w - 4) * 128, lds_su + (w - 4) * 4096, O.YS + (size_t)tile * 128 * 256 + (w - 4) * 64, lane);
        __syncthreads();
    }
}


struct Params {
    const float *x, *c, *rel_bias, *w_ada, *b_ada, *norm1_g, *norm2_g, *w_in, *q_norm_g, *k_norm_g, *attn_sink, *conv_w, *sgu_w, *sgu_b, *out_norm_g, *w_out, *peer_wq, *peer_sub_keys, *peer_down, *peer_up;
    float* out;
    char* ws;
};
constexpr size_t MiB = 1u << 20;
constexpr size_t WS_MOD = 0;
constexpr size_t WS_MODP = 1 * MiB;
constexpr size_t WS_WIN = 13 * MiB;
constexpr size_t WS_WOUT = 29 * MiB;
constexpr size_t WS_WPQ = 37 * MiB;
constexpr size_t WS_KEYS = 53 * MiB;
constexpr size_t WS_SWF = 55 * MiB;
constexpr size_t WS_SC = 56 * MiB;
constexpr size_t WS_TB = 57 * MiB;
constexpr size_t WS_HA = 185 * MiB;
constexpr size_t WS_QF = 249 * MiB;
constexpr size_t WS_KF2 = 602 * MiB;
constexpr size_t WS_VF = 634 * MiB;
constexpr size_t WS_ZR = 666 * MiB;
constexpr size_t WS_CBR = 345 * MiB;
constexpr size_t WS_YS = 361 * MiB;
constexpr size_t WS_OR = 377 * MiB;
constexpr size_t WS_QPF = 409 * MiB;
constexpr size_t WS_RIDX = 537 * MiB;
constexpr size_t WS_RGATE = 553 * MiB;
constexpr size_t WS_SEID = 569 * MiB;
constexpr size_t WS_SWGT = 585 * MiB;
constexpr size_t WS_OFFS = 601 * MiB;
constexpr size_t WS_FLAGS = 601 * MiB + 512 * 1024;
constexpr size_t WS_END = 730 * MiB;
static_assert(PL_END <= LDS_RSTD1, "expert-phase lists overlap persistent LDS state");

__global__ __launch_bounds__(512) void hybrid_fwd(Params P) {
    extern __shared__ __attribute__((aligned(16))) char lds[];
    cg::grid_group grid = cg::this_grid();
    const int tid = threadIdx.x, lane = tid & 63, w = __builtin_amdgcn_readfirstlane(tid >> 6);
    const int nblk = gridDim.x, hwb = blockIdx.x;
    const int bid = (nblk == NTILE) ? (hwb & 7) * 32 + (hwb >> 3) : hwb;
    char* ws = P.ws;
    float* mod = (float*)(ws + WS_MOD);
    float* modp = (float*)(ws + WS_MODP);
    bf16_t* WinF = (bf16_t*)(ws + WS_WIN); bf16_t* WoutF = (bf16_t*)(ws + WS_WOUT); bf16_t* WpqF = (bf16_t*)(ws + WS_WPQ);
    bf16_t* KeysF = (bf16_t*)(ws + WS_KEYS); bf16_t* SWF = (bf16_t*)(ws + WS_SWF);
    float* SC = (float*)(ws + WS_SC); unsigned char* TBd = (unsigned char*)(ws + WS_TB); unsigned char* TBu = TBd + 32 * MiB;
    bf16_t* hA = (bf16_t*)(ws + WS_HA);
    bf16_t* OR = (bf16_t*)(ws + WS_OR); bf16_t* QPF = (bf16_t*)(ws + WS_QPF);
    int* ridx = (int*)(ws + WS_RIDX); float* rgate = (float*)(ws + WS_RGATE);
    float* bias_lds = (float*)(lds + LDS_BIAS);
    unsigned* flags = (unsigned*)(ws + WS_FLAGS);

    {
        float* ca = (float*)lds;
        if (tid == 0) for (int tile = bid; tile < NTILE; tile += nblk) __hip_atomic_store(flags + tile, 0u, __ATOMIC_RELAXED, __HIP_MEMORY_SCOPE_AGENT);
        for (int i = tid; i < 8192; i += 512) { const float v = P.c[i]; ca[i] = v / (1.f + __expf(-v)); }
        for (int i = tid; i < 1024; i += 512) bias_lds[i] = P.rel_bias[t5_bucket(i & 127) * 8 + (i >> 7)];
        __syncthreads();
        for (int it = bid; it < 768; it += nblk) {
            const int jc = it % 12, l = (it / 12) & 3, ks = it / 48;
            const int j = jc * 512 + tid;
            const float* wp = P.w_ada + ((size_t)l * 1024 + ks * 64) * 6144 + j;
            float acc[8];
#pragma unroll
            for (int b = 0; b < 8; ++b) acc[b] = 0.f;
#pragma unroll 4
            for (int i = 0; i < 64; ++i) {
                const float wv = wp[(size_t)i * 6144];
#pragma unroll
                for (int b = 0; b < 8; ++b) acc[b] += ca[b * 1024 + ks * 64 + i] * wv;
            }
#pragma unroll
            for (int b = 0; b < 8; ++b) modp[((size_t)(ks * 4 + l) * 8 + b) * 6144 + j] = acc[b];
        }
        const int gthreads = nblk * 512, gtid = bid * 512 + tid;
        for (int rep = 0; rep < REP_P0; ++rep)
        for (int l = 0; l < DEPTH; ++l) {
            for (int g = gtid; g < 64 * 64 * 64; g += gthreads) conv_wfrag_item(P.w_in + (size_t)l * 1024 * 2048, 2048, 64, WinF + (size_t)l * 2097152, g, 1);
            for (int g = gtid; g < 32 * 64 * 64; g += gthreads) conv_wfrag_item(P.w_out + (size_t)l * 1024 * 1024, 1024, 64, WoutF + (size_t)l * 1048576, g, 0);
            for (int g = gtid; g < 64 * 64 * 64; g += gthreads) conv_wfrag_item(P.peer_wq + (size_t)l * 1024 * 2048, 2048, 64, WpqF + (size_t)l * 2097152, g, 0);
            for (int g = gtid; g < 32768; g += gthreads) conv_keys_item(P.peer_sub_keys + (size_t)l * 262144, KeysF + (size_t)l * 262144, g);
            for (int g = gtid; g < 8192; g += gthreads) conv_sguw_item(P.sgu_w + (size_t)l * 65536, SWF + (size_t)l * 65536, g);
        }
        const int gwaves = nblk * 8, gw = bid * 8 + w;
        for (int rep = 0; rep < REP_P0; ++rep)
        for (int r = gw; r < DEPTH * 16384 * 2; r += gwaves) {
            const int which = r & 1, le = r >> 1;
            conv_table_row((which ? P.peer_up : P.peer_down) + (size_t)le * D, (which ? TBu : TBd) + (size_t)le * 512, SC + (size_t)le * 2 + which, lane, which == 0);
        }
    }
    grid.sync();
    for (int tile = bid; tile < NTILE; tile += nblk) {
        const int b = tile >> 5;
        for (int l = 0; l < DEPTH; ++l)
            for (int j = tid; j < 6144; j += 512) {
                float v = P.b_ada[l * 6144 + j];
#pragma unroll
                for (int ks = 0; ks < 16; ++ks) v += modp[((size_t)(ks * 4 + l) * 8 + b) * 6144 + j];
                mod[((size_t)l * 8 + b) * 6144 + j] = v;
            }
    }
    __syncthreads();

    for (int l = 0; l < DEPTH; ++l) {
        const float* xin = l == 0 ? P.x : P.out;
        InProjOut IO;
        IO.QF = (bf16_t*)(ws + WS_QF); IO.KF2 = (bf16_t*)(ws + WS_KF2 + (size_t)l * 8 * MiB); IO.VF = (bf16_t*)(ws + WS_VF + (size_t)l * 8 * MiB);
        IO.CBR = (bf16_t*)(ws + WS_CBR); IO.ZR = (bf16_t*)(ws + WS_ZR + (size_t)l * 16 * MiB); IO.YS = (bf16_t*)(ws + WS_YS);
        for (int tile = bid; tile < NTILE; tile += nblk) {
            const float* mb_ = mod + ((size_t)l * 8 + (tile >> 5)) * 6144;
            const bool have1 = l > 0 && nblk == NTILE;
            if (have1) { if (tid < 128) ((float*)lds)[tid] = ((const float*)(lds + LDS_RSTD1))[tid]; __syncthreads(); }
            norm_to_frag(xin, P.norm1_g + l * D, mb_ + 0, mb_ + 1024, hA, (float*)lds, tile, tid, have1);
            __syncthreads();
            for (int rep = 0; rep < REP_GEMM; ++rep) inproj_tile(hA + (size_t)tile * 131072, WinF + (size_t)l * 2097152, P.q_norm_g + l * 64, P.k_norm_g + l * 64, SWF + (size_t)l * 65536, P.sgu_b + l * 512, IO, lds, tile, tid);
            asm volatile("s_waitcnt vmcnt(0)" ::: "memory");
            __syncthreads();
            if (tid == 0) {
                __builtin_amdgcn_fence(__ATOMIC_RELEASE, "agent");
                asm volatile("s_waitcnt vmcnt(0)" ::: "memory");
                __hip_atomic_store(flags + tile, (unsigned)(l + 1), __ATOMIC_RELAXED, __HIP_MEMORY_SCOPE_AGENT);
            }
        }
        for (int tile = bid; tile < NTILE; tile += nblk) {
            const float* mb_ = mod + ((size_t)l * 8 + (tile >> 5)) * 6144;
            if ((tile & 31) != 0) {
                if (tid == 0) {
                    unsigned spins = 0;
                    while (__hip_atomic_load(flags + tile - 1, __ATOMIC_RELAXED, __HIP_MEMORY_SCOPE_AGENT) < (unsigned)(l + 1) && ++spins < (1u << 24)) __builtin_amdgcn_s_sleep(2);
                    __builtin_amdgcn_fence(__ATOMIC_ACQUIRE, "agent");
                    asm volatile("s_waitcnt vmcnt(0)" ::: "memory");
                }
                __syncthreads();
            }
            for (int rep = 0; rep < REP_MIX; ++rep) {
            attn_tile(IO.QF, IO.KF2, IO.VF, bias_lds, P.attn_sink + l * 8, OR, tile, tid);
            __syncthreads();
            merge_tile(OR, IO.CBR, IO.ZR, IO.YS, P.conv_w + l * 768, P.out_norm_g + l * D, hA, tile, tid);
            __syncthreads();
            }
            {
                const bf16_t* At = hA + (size_t)tile * 131072;
                const bf16_t* WF = WoutF + (size_t)l * 1048576;
                for (int pass = 0; pass < 2; ++pass) {
                    f32x16 acc[4][2];
                    const int nbt0 = pass * 16 + w * 2;
                    kloop<0>(acc, At, WF + (size_t)nbt0 * 32768, WF + (size_t)(nbt0 + 1) * 32768, lds, tid, lane);
                    epi_resid(acc, xin, P.out, mb_ + 2048, (float*)(lds + LDS_EPI) + w * 2176, (float*)(lds + LDS_SSQ) + (pass * 8 + w) * 128, tile, pass * 512 + w * 64, lane);
                }
            }
            __syncthreads();
            if (tid < 128) { const float* sq = (const float*)(lds + LDS_SSQ); float ssum = 0.f;
#pragma unroll
                for (int c = 0; c < 16; ++c) ssum += sq[c * 128 + tid];
                ((float*)lds)[tid] = rsqrtf(ssum * (1.f / D) + EPS); }
            __syncthreads();
            norm_to_frag(P.out, P.norm2_g + l * D, mb_ + 3072, mb_ + 4096, hA, (float*)lds, tile, tid, true);
            __syncthreads();
            {
                const bf16_t* At = hA + (size_t)tile * 131072;
                const bf16_t* WF = WpqF + (size_t)l * 2097152;
                for (int rep = 0; rep < REP_GEMM; ++rep)
                for (int pass = 0; pass < 4; ++pass) {
                    f32x16 acc[4][2];
                    const int nbt0 = pass * 16 + w * 2;
                    kloop<1>(acc, At, WF + (size_t)nbt0 * 32768, WF + (size_t)(nbt0 + 1) * 32768, lds, tid, lane);
                    epi_qpf(acc, QPF, tile, nbt0, lane);
                }
            }
            __syncthreads();
            for (int rep = 0; rep < REP_ROUTE; ++rep) { route_tile(QPF, KeysF + (size_t)l * 262144, lds, (unsigned char*)lds + PL_RIDX, tile, tid); __syncthreads(); }
            peer_down_wave(hA, lds, TBd + (size_t)l * 16384 * 512, SC + (size_t)l * 32768, tile, w, lane);
            __syncthreads();
            peer_up_wave(lds, TBu + (size_t)l * 16384 * 512, mb_ + 5120, P.out, tile, w, lane);
            __syncthreads();
        }
    }
}
}

extern "C" void kernel_launch(void* const* d_in, const int* in_sizes, int n_in, void* d_out, int out_size, void* d_ws, size_t ws_size, hipStream_t stream) {
    using namespace op;
    static int grid_blocks = 0;
    if (!grid_blocks) {
        int dev = 0, cus = 0, per_cu = 0;
        (void)hipGetDevice(&dev);
        (void)hipDeviceGetAttribute(&cus, hipDeviceAttributeMultiprocessorCount, dev);
        (void)hipFuncSetAttribute((const void*)hybrid_fwd, hipFuncAttributeMaxDynamicSharedMemorySize, LDS_BYTES);
        (void)hipOccupancyMaxActiveBlocksPerMultiprocessor(&per_cu, (const void*)hybrid_fwd, 512, LDS_BYTES);
        if (per_cu < 1) per_cu = 1;
        grid_blocks = cus * per_cu;
        if (grid_blocks > NTILE) grid_blocks = NTILE;
        if (ws_size < WS_END) { fprintf(stderr, "kernel_launch: workspace too small (%zu < %zu)\n", ws_size, (size_t)WS_END); grid_blocks = -1; }
    }
    if (grid_blocks < 0) return;
    Params p{};
    p.x = (const float*)d_in[0]; p.c = (const float*)d_in[1]; p.rel_bias = (const float*)d_in[2]; p.w_ada = (const float*)d_in[3]; p.b_ada = (const float*)d_in[4];
    p.norm1_g = (const float*)d_in[5]; p.norm2_g = (const float*)d_in[6]; p.w_in = (const float*)d_in[7]; p.q_norm_g = (const float*)d_in[8]; p.k_norm_g = (const float*)d_in[9];
    p.attn_sink = (const float*)d_in[10]; p.conv_w = (const float*)d_in[11]; p.sgu_w = (const float*)d_in[12]; p.sgu_b = (const float*)d_in[13]; p.out_norm_g = (const float*)d_in[14];
    p.w_out = (const float*)d_in[15]; p.peer_wq = (const float*)d_in[16]; p.peer_sub_keys = (const float*)d_in[17]; p.peer_down = (const float*)d_in[18]; p.peer_up = (const float*)d_in[19];
    p.out = (float*)d_out; p.ws = (char*)d_ws;
    void* args[] = {&p};
    hipError_t e = hipLaunchCooperativeKernel((const void*)hybrid_fwd, dim3(grid_blocks), dim3(512), args, LDS_BYTES, stream);
    if (e != hipSuccess) fprintf(stderr, "kernel_launch: cooperative launch failed: %s (grid %d)\n", hipGetErrorString(e), grid_blocks);
}
```

```cpp
#include <hip/hip_runtime.h>
#include <cstdio>
#include <cstdint>
#include <hip/hip_cooperative_groups.h>
namespace cg = cooperative_groups;


namespace op {
#define DI __device__ __forceinline__
typedef unsigned short bf16_t;
typedef short bf16x8 __attribute__((ext_vector_type(8)));
typedef float f32x16 __attribute__((ext_vector_type(16)));
typedef float f32x2 __attribute__((ext_vector_type(2)));
typedef unsigned u32x4 __attribute__((ext_vector_type(4)));
typedef unsigned u32x2 __attribute__((ext_vector_type(2)));
typedef __bf16 bf16v2 __attribute__((ext_vector_type(2)));
constexpr int D = 1024, NB = 8, S = 4096, DEPTH = 4, T = NB * S, NTILE = T / 128;
constexpr float EPS = 1e-6f;
constexpr int PL_SEID = 0, PL_SWGT = 32768, PL_END = 98304, PL_RIDX = 98304;
constexpr int LDS_EPI = 32768, LDS_SSQ = 102400, LDS_RSTD1 = 110592, LDS_BIAS = 112 * 1024, LDS_BYTES = 116 * 1024;
constexpr int REP_GEMM = 1, REP_ROUTE = 1, REP_MIX = 1, REP_NORM = 1, REP_P0 = 1;
#define MFMA32(a, b, c) __builtin_amdgcn_mfma_f32_32x32x16_bf16((a), (b), (c), 0, 0, 0)

DI unsigned pk2(float lo, float hi) { f32x2 v = {lo, hi}; return __builtin_bit_cast(unsigned, __builtin_convertvector(v, bf16v2)); }
DI int opaque_v(int x) { asm volatile("" : "+v"(x)); return x; }
DI int opaque_s(int x) { asm volatile("" : "+s"(x)); return x; }
DI int crow(int reg, int hh) { return (reg & 3) + 8 * (reg >> 2) + 4 * hh; }
DI float wave_sum(float v) {
#pragma unroll
    for (int o = 1; o < 64; o <<= 1) v += __shfl_xor(v, o);
    return v;
}

DI int col_perm(int npos, int mode) {
    if (mode == 1 && npos >= 1024 && npos < 1536) { const int q = npos - 1024, w = q >> 6, nb = (q >> 5) & 1, r = q & 31; return (nb ? 1280 : 1024) + 32 * w + r; }
    return npos;
}
DI void conv_wfrag_item(const float* __restrict__ W, int N, int KB, bf16_t* __restrict__ WF, int gid, int mode) {
    const int l = gid & 63, kb = (gid >> 6) % KB, nbt = (gid >> 6) / KB, r = l & 31, hh = l >> 5;
    const int n = col_perm(nbt * 32 + r, mode);
    const float* p = W + (size_t)(kb * 16 + 8 * hh) * N + n;
    float v[8];
#pragma unroll
    for (int j = 0; j < 8; ++j) v[j] = p[(size_t)j * N];
    u32x4 o; o.x = pk2(v[0], v[1]); o.y = pk2(v[2], v[3]); o.z = pk2(v[4], v[5]); o.w = pk2(v[6], v[7]);
    *(u32x4*)(WF + (size_t)gid * 8) = o;
}

DI void norm_to_frag(const float* __restrict__ x, const float* __restrict__ g, const float* __restrict__ sh, const float* __restrict__ sc, bf16_t* __restrict__ hA, float* rstd_lds, int tile, int tid, bool have_rstd) {
    tid = opaque_v(tid); tile = opaque_s(tile);
    const int w = tid >> 6, lane = tid & 63;
    float cg[16], cs[16], ch[16];
#pragma unroll
    for (int j = 0; j < 2; ++j)
#pragma unroll
        for (int q = 0; q < 2; ++q) {
            const int c = 512 * j + 8 * lane + 4 * q;
            const float4 a = *(const float4*)(g + c), b = *(const float4*)(sc + c), d = *(const float4*)(sh + c);
            cg[8 * j + 4 * q] = a.x * (1.f + b.x); cg[8 * j + 4 * q + 1] = a.y * (1.f + b.y); cg[8 * j + 4 * q + 2] = a.z * (1.f + b.z); cg[8 * j + 4 * q + 3] = a.w * (1.f + b.w);
            ch[8 * j + 4 * q] = d.x; ch[8 * j + 4 * q + 1] = d.y; ch[8 * j + 4 * q + 2] = d.z; ch[8 * j + 4 * q + 3] = d.w;
            cs[8 * j + 4 * q] = 0.f; cs[8 * j + 4 * q + 1] = 0.f; cs[8 * j + 4 * q + 2] = 0.f; cs[8 * j + 4 * q + 3] = 0.f;
        }
    (void)cs;
#pragma unroll 4
    for (int rr = 0; rr < 16; ++rr) {
        const int row = w * 16 + rr;
        const float* xr = x + ((size_t)tile * 128 + row) * D + 8 * lane;
        float v[16];
#pragma unroll
        for (int j = 0; j < 2; ++j)
#pragma unroll
            for (int q = 0; q < 2; ++q) { const float4 a = *(const float4*)(xr + 512 * j + 4 * q); v[8 * j + 4 * q] = a.x; v[8 * j + 4 * q + 1] = a.y; v[8 * j + 4 * q + 2] = a.z; v[8 * j + 4 * q + 3] = a.w; }
        float r;
        if (have_rstd) r = rstd_lds[row];
        else {
            float ss = 0.f;
#pragma unroll
            for (int e = 0; e < 16; ++e) ss += v[e] * v[e];
            r = rsqrtf(wave_sum(ss) * (1.f / D) + EPS);
        }
        bf16_t* orow = hA + ((size_t)tile * 128 + row) * D + 8 * lane;
#pragma unroll
        for (int j = 0; j < 2; ++j) {
            u32x4 o;
            o.x = pk2(v[8 * j] * r * cg[8 * j] + ch[8 * j], v[8 * j + 1] * r * cg[8 * j + 1] + ch[8 * j + 1]);
            o.y = pk2(v[8 * j + 2] * r * cg[8 * j + 2] + ch[8 * j + 2], v[8 * j + 3] * r * cg[8 * j + 3] + ch[8 * j + 3]);
            o.z = pk2(v[8 * j + 4] * r * cg[8 * j + 4] + ch[8 * j + 4], v[8 * j + 5] * r * cg[8 * j + 5] + ch[8 * j + 5]);
            o.w = pk2(v[8 * j + 6] * r * cg[8 * j + 6] + ch[8 * j + 6], v[8 * j + 7] * r * cg[8 * j + 7] + ch[8 * j + 7]);
            *(u32x4*)(orow + 512 * j) = o;
        }
    }
}

template <int ORIENT>
DI void kloop(f32x16 (&acc)[4][2], const bf16_t* __restrict__ At, const bf16_t* __restrict__ W0, const bf16_t* __restrict__ W1, char* lds, int tid, int lane) {
    tid = opaque_v(tid); lane = opaque_v(lane);
#pragma unroll
    for (int mb = 0; mb < 4; ++mb)
#pragma unroll
        for (int nb = 0; nb < 2; ++nb)
#pragma unroll
            for (int i = 0; i < 16; ++i) acc[mb][nb][i] = 0.f;
    {
    const int c8_ = (tid >> 3) & 7, rowA_ = (tid >> 6) * 8 + (tid & 7);
    const u32x4* Ag = (const u32x4*)(At + (unsigned)(rowA_ * 1024 + c8_ * 8));
    const int ldsA_ = ((((c8_ >> 1) * 4 + (rowA_ >> 5)) * 64) + (rowA_ & 31) + 32 * (c8_ & 1)) * 16;
    const u32x4* W0g = (const u32x4*)W0 + lane;
    const u32x4* W1g = (const u32x4*)W1 + lane;
    u32x4 wq[4][2], arA[2], arB[2];
    arA[0] = Ag[0]; arA[1] = Ag[8192]; arB[0] = Ag[8]; arB[1] = Ag[8 + 8192];
#pragma unroll
    for (int kk = 0; kk < 4; ++kk) { wq[kk][0] = W0g[kk * 64]; wq[kk][1] = W1g[kk * 64]; }
    *(u32x4*)(lds + ldsA_) = arA[0]; *(u32x4*)(lds + ldsA_ + 2048) = arA[1];
    __syncthreads();
#define KL_ITER(KC, ARL, ARS) do { \
        char* cur = lds + ((KC) & 1) * 16384; \
        char* nxt = lds + (((KC) + 1) & 1) * 16384; \
        const int kn = (KC) < 15 ? (KC) + 1 : 15, k2 = (KC) < 14 ? (KC) + 2 : 15; \
        ARL[0] = Ag[k2 * 8]; ARL[1] = Ag[k2 * 8 + 8192]; \
        __builtin_amdgcn_sched_barrier(0); \
        _Pragma("unroll") for (int kk = 0; kk < 4; ++kk) { \
            bf16x8 afr[4]; \
            _Pragma("unroll") for (int mb = 0; mb < 4; ++mb) afr[mb] = *(const bf16x8*)(cur + ((kk * 4 + mb) * 64 + lane) * 16); \
            _Pragma("unroll") for (int mb = 0; mb < 4; ++mb) \
                _Pragma("unroll") for (int nb = 0; nb < 2; ++nb) { \
                    const bf16x8 wf = __builtin_bit_cast(bf16x8, wq[kk][nb]); \
                    if (ORIENT == 0) acc[mb][nb] = MFMA32(afr[mb], wf, acc[mb][nb]); \
                    else acc[mb][nb] = MFMA32(wf, afr[mb], acc[mb][nb]); \
                } \
            if ((KC) < 15) { wq[kk][0] = W0g[(kn * 4 + kk) * 64]; wq[kk][1] = W1g[(kn * 4 + kk) * 64]; } \
            __builtin_amdgcn_sched_barrier(0); \
        } \
        if ((KC) < 15) { *(u32x4*)(nxt + ldsA_) = ARS[0]; *(u32x4*)(nxt + ldsA_ + 2048) = ARS[1]; } \
        __syncthreads(); \
    } while (0)
    for (int kc = 0; kc < 16; kc += 2) { KL_ITER(kc, arA, arB); KL_ITER(kc + 1, arB, arA); }
#undef KL_ITER
    }
}

DI void epi_f32row(const f32x16 (&acc)[4][2], float* __restrict__ C, int tile, int col0, int lane) {
    lane = opaque_v(lane);
    const int r5 = lane & 31, hh = lane >> 5;
    const unsigned boff = (unsigned)((tile * 128 + 4 * hh) * 2048 + col0 + r5);
#pragma unroll
    for (int mb = 0; mb < 4; ++mb)
#pragma unroll
        for (int nb = 0; nb < 2; ++nb)
#pragma unroll
            for (int i = 0; i < 16; ++i)
                C[boff + (unsigned)((mb * 32 + (i & 3) + 8 * (i >> 2)) * 2048 + nb * 32)] = acc[mb][nb][i];
}
DI void epi_resid(const f32x16 (&acc)[4][2], const float* __restrict__ xin, float* __restrict__ xout, const float* __restrict__ gate_b, float* T  , float* ssq  , int tile, int col0, int lane) {
    lane = opaque_v(lane);
    const int r5 = lane & 31, hh = lane >> 5, rq = lane >> 4, c4 = (lane & 15) * 4;
    const float4 gv = *(const float4*)(gate_b + col0 + c4);
#pragma unroll
    for (int mb = 0; mb < 4; ++mb) {
#pragma unroll
        for (int nb = 0; nb < 2; ++nb)
#pragma unroll
            for (int i = 0; i < 16; ++i) T[((i & 3) + 8 * (i >> 2) + 4 * hh) * 68 + nb * 32 + r5] = acc[mb][nb][i];
        asm volatile("s_waitcnt lgkmcnt(0)" ::: "memory");
#pragma unroll
        for (int j = 0; j < 8; ++j) {
            const int row = rq + 4 * j;
            const float4 v = *(const float4*)(T + row * 68 + c4);
            const unsigned o = (unsigned)((tile * 128 + mb * 32 + row) * D + col0 + c4);
            float4 xv = *(const float4*)(xin + o);
            xv.x += gv.x * v.x; xv.y += gv.y * v.y; xv.z += gv.z * v.z; xv.w += gv.w * v.w;
            *(float4*)(xout + o) = xv;
            float ss = xv.x * xv.x + xv.y * xv.y + xv.z * xv.z + xv.w * xv.w;
            ss += __shfl_xor(ss, 1); ss += __shfl_xor(ss, 2); ss += __shfl_xor(ss, 4); ss += __shfl_xor(ss, 8);
            if ((lane & 15) == 0) ssq[mb * 32 + row] = ss;
        }
        asm volatile("s_waitcnt lgkmcnt(0)" ::: "memory");
    }
}

DI void epi_qpf(const f32x16 (&acc)[4][2], bf16_t* __restrict__ QPF, int tile, int ft0, int lane) {
    lane = opaque_v(lane);
#pragma unroll
    for (int nb = 0; nb < 2; ++nb)
#pragma unroll
        for (int s = 0; s < 2; ++s)
#pragma unroll
            for (int mb = 0; mb < 4; ++mb) {
                const f32x16& a = acc[mb][nb];
                u32x4 o; o.x = pk2(a[8 * s], a[8 * s + 1]); o.y = pk2(a[8 * s + 2], a[8 * s + 3]); o.z = pk2(a[8 * s + 4], a[8 * s + 5]); o.w = pk2(a[8 * s + 6], a[8 * s + 7]);
                *(u32x4*)(QPF + ((unsigned)((((tile * 64 + ft0 + nb) * 2 + s) * 4 + mb) * 64 + lane)) * 8) = o;
            }
}

DI void conv_keys_item(const float* __restrict__ K, bf16_t* __restrict__ KF, int gid) {
    const int lane = gid & 63, s = (gid >> 6) & 1, nbl = (gid >> 7) & 3, nt = (gid >> 9) & 3, hp = gid >> 11;
    const int r = lane & 31, hh = lane >> 5;
    const float* p = K + ((size_t)hp * 128 + nt * 32 + r) * 128 + nbl * 32 + 16 * s + 4 * hh;
    const float4 a = *(const float4*)p, b = *(const float4*)(p + 8);
    u32x4 o; o.x = pk2(a.x, a.y); o.y = pk2(a.z, a.w); o.z = pk2(b.x, b.y); o.w = pk2(b.z, b.w);
    *(u32x4*)(KF + (size_t)gid * 8) = o;
}

DI void conv_table_row(const float* __restrict__ src, unsigned char* __restrict__ dst, float* __restrict__ sc, int lane, bool as_int4) {
    const float4* p = (const float4*)src + lane * 4;
    float4 v[4];
    float m = 0.f;
#pragma unroll
    for (int j = 0; j < 4; ++j) { v[j] = p[j]; m = fmaxf(m, fmaxf(fmaxf(fabsf(v[j].x), fabsf(v[j].y)), fmaxf(fabsf(v[j].z), fabsf(v[j].w)))); }
#pragma unroll
    for (int o = 1; o < 64; o <<= 1) m = fmaxf(m, __shfl_xor(m, o));
    float scale = m > 0.f ? m * (1.f / 6.f) : 1.f;
    if (as_int4) {
        float ss = 0.f;
#pragma unroll
        for (int j = 0; j < 4; ++j) ss += v[j].x * v[j].x + v[j].y * v[j].y + v[j].z * v[j].z + v[j].w * v[j].w;
        ss = wave_sum(ss);
        const float sg = sqrtf(ss * (1.f / 1024.f));
        scale = fmaxf(sg * (1.f / 2.8f), m * (1.f / 16.f));
        if (!(scale > 0.f)) scale = 1.f;
    }
    const float inv = 1.f / scale;
    u32x2 o;
    unsigned* op = (unsigned*)&o;
#pragma unroll
    for (int j = 0; j < 2; ++j) {
        const float f[8] = {v[2 * j].x, v[2 * j].y, v[2 * j].z, v[2 * j].w, v[2 * j + 1].x, v[2 * j + 1].y, v[2 * j + 1].z, v[2 * j + 1].w};
        unsigned wv = 0;
        if (as_int4) {
#pragma unroll
            for (int e = 0; e < 8; ++e) { int q = __float2int_rn(f[e] * inv); q = q < -7 ? -7 : (q > 7 ? 7 : q); wv |= ((unsigned)q & 15u) << (4 * e); }
        } else {
            wv = __builtin_amdgcn_cvt_scalef32_pk_fp4_f32(wv, f[0] * inv, f[1] * inv, 1.0f, 0);
            wv = __builtin_amdgcn_cvt_scalef32_pk_fp4_f32(wv, f[2] * inv, f[3] * inv, 1.0f, 1);
            wv = __builtin_amdgcn_cvt_scalef32_pk_fp4_f32(wv, f[4] * inv, f[5] * inv, 1.0f, 2);
            wv = __builtin_amdgcn_cvt_scalef32_pk_fp4_f32(wv, f[6] * inv, f[7] * inv, 1.0f, 3);
        }
        op[j] = wv;
    }
    *(u32x2*)(dst + lane * 8) = o;
    if (lane == 0) *sc = scale;
}

DI void ce_desc(int& a, int& b) { const int mx = a > b ? a : b, mn = a > b ? b : a; a = mx; b = mn; }
DI void sort16_desc(int (&v)[16]) {
#pragma unroll
    for (int k = 2; k <= 16; k <<= 1)
#pragma unroll
        for (int j = k >> 1; j > 0; j >>= 1)
#pragma unroll
            for (int i = 0; i < 16; ++i) {
                const int l = i ^ j;
                if (l > i) { if ((i & k) == 0) ce_desc(v[i], v[l]); else ce_desc(v[l], v[i]); }
            }
}
DI void bitonic_merge16_desc(int (&v)[16]) {
#pragma unroll
    for (int j = 8; j > 0; j >>= 1)
#pragma unroll
        for (int i = 0; i < 16; ++i) { const int l = i ^ j; if (l > i) ce_desc(v[i], v[l]); }
}
DI void merge_top16(int (&a)[16], const int (&b)[16]) {
#pragma unroll
    for (int i = 0; i < 16; ++i) a[i] = a[i] > b[15 - i] ? a[i] : b[15 - i];
    bitonic_merge16_desc(a);
}
DI int f2ord(float f) { int b = __float_as_int(f); return b ^ ((b >> 31) & 0x7fffffff); }
DI float ord2f(int k) { return __int_as_float(k ^ ((k >> 31) & 0x7fffffff)); }

DI void route_tile(const bf16_t* __restrict__ QPF, const bf16_t* __restrict__ KF, char* lds_lists, unsigned char* lds_idx  , int tile, int tid) {
    tid = opaque_v(tid); tile = opaque_s(tile);
    const int lane = tid & 63, w = __builtin_amdgcn_readfirstlane(tid >> 6);
    const int r5 = lane & 31, hh = lane >> 5;
    unsigned char* myidx = lds_idx + w * 1024;
    for (int task = w; task < 32; task += 8) {
        const int h = task >> 2, tt = task & 3;
        f32x16 acc[2][4];
#pragma unroll
        for (int p = 0; p < 2; ++p)
#pragma unroll
            for (int nt = 0; nt < 4; ++nt)
#pragma unroll
                for (int i = 0; i < 16; ++i) acc[p][nt][i] = 0.f;
        {
            bf16x8 bq[3], ak[3][4];
#define ROUTE_LOAD(buf, step) do { const int p_ = (step) >> 3, ks_ = (step) & 7; \
                bq[buf] = *(const bf16x8*)(QPF + ((unsigned)((((tile * 64 + h * 8 + p_ * 4 + (ks_ >> 1)) * 2 + (ks_ & 1)) * 4 + tt) * 64 + lane)) * 8); \
                _Pragma("unroll") for (int nt = 0; nt < 4; ++nt) ak[buf][nt] = *(const bf16x8*)(KF + ((unsigned)(((((h * 2 + p_) * 4 + nt) * 8 + ks_) * 64) + lane)) * 8); } while (0)
            ROUTE_LOAD(0, 0);
            ROUTE_LOAD(1, 1);
#pragma unroll
            for (int step = 0; step < 16; ++step) {
                if (step < 14) ROUTE_LOAD((step + 2) % 3, step + 2);
#pragma unroll
                for (int nt = 0; nt < 4; ++nt) acc[step >> 3][nt] = MFMA32(ak[step % 3][nt], bq[step % 3], acc[step >> 3][nt]);
                __builtin_amdgcn_sched_barrier(0);
            }
#undef ROUTE_LOAD
        }
        int g[8][16];
#pragma unroll
        for (int nt = 0; nt < 4; ++nt)
#pragma unroll
            for (int i = 0; i < 16; ++i) {
                const unsigned a = __float_as_uint(acc[0][nt][i]), b = __float_as_uint(acc[1][nt][i]);
                auto sw = __builtin_amdgcn_permlane32_swap(a, b, false, false);
                const int n0 = nt * 32 + (i & 3) + 8 * (i >> 2);
                g[nt * 2 + (i >> 3)][i & 7] = (f2ord(__uint_as_float(sw[0])) & ~127) | n0;
                g[nt * 2 + (i >> 3)][8 + (i & 7)] = (f2ord(__uint_as_float(sw[1])) & ~127) | (n0 + 4);
            }
#pragma unroll
        for (int q = 0; q < 8; ++q) sort16_desc(g[q]);
        merge_top16(g[0], g[1]); merge_top16(g[2], g[3]); merge_top16(g[4], g[5]); merge_top16(g[6], g[7]);
        merge_top16(g[0], g[2]); merge_top16(g[4], g[6]);
        merge_top16(g[0], g[4]);
        {
            u32x4 pk;
            unsigned* pp = (unsigned*)&pk;
#pragma unroll
            for (int q = 0; q < 4; ++q) pp[q] = (unsigned)(g[0][4 * q] & 127) | ((unsigned)(g[0][4 * q + 1] & 127) << 8) | ((unsigned)(g[0][4 * q + 2] & 127) << 16) | ((unsigned)(g[0][4 * q + 3] & 127) << 24);
            *(u32x4*)(myidx + lane * 16) = pk;
        }
        float f0[16], f1[16];
#pragma unroll
        for (int i = 0; i < 16; ++i) {
            const unsigned a = (unsigned)g[0][i], b = a;
            auto sw = __builtin_amdgcn_permlane32_swap(a, b, false, false);
            f0[i] = ord2f((int)sw[0] & ~127); f1[i] = ord2f((int)sw[1] & ~127);
        }
        int c0[16], c1[16], c2[16], c3[16];
#pragma unroll
        for (int j = 0; j < 16; ++j) c0[j] = (f2ord(f0[0] + f1[j]) & ~255) | j;
#pragma unroll
        for (int i = 1; i < 16; ++i) c1[i - 1] = (f2ord(f0[i] + f1[0]) & ~255) | (i << 4);
        c1[15] = (int)0x80000000;
#define CK(i, j) ((f2ord(f0[i] + f1[j]) & ~255) | ((i) << 4) | (j))
        c2[0] = CK(1, 1); c2[1] = CK(1, 2); c2[2] = CK(1, 3); c2[3] = CK(1, 4); c2[4] = CK(1, 5); c2[5] = CK(1, 6); c2[6] = CK(1, 7);
        c2[7] = CK(2, 1); c2[8] = CK(2, 2); c2[9] = CK(2, 3); c2[10] = CK(2, 4);
        c2[11] = CK(3, 1); c2[12] = CK(3, 2); c2[13] = CK(3, 3);
        c2[14] = CK(4, 1); c2[15] = CK(4, 2);
        c3[0] = CK(5, 1); c3[1] = CK(6, 1); c3[2] = CK(7, 1);
#undef CK
#pragma unroll
        for (int q = 3; q < 16; ++q) c3[q] = (int)0x80000000;
        sort16_desc(c2);
        ce_desc(c3[0], c3[1]); ce_desc(c3[1], c3[2]); ce_desc(c3[0], c3[1]);
        merge_top16(c0, c1); merge_top16(c2, c3); merge_top16(c0, c2);
        float bs[16], den = 0.f;
#pragma unroll
        for (int i = 0; i < 16; ++i) { bs[i] = __expf(ord2f(c0[i] & ~255) - ord2f(c0[0] & ~255)); den += bs[i]; }
        const float rden = 1.f / den;
        asm volatile("s_waitcnt lgkmcnt(0)" ::: "memory");
#pragma unroll
        for (int q = 0; q < 8; ++q) {
            const int key = (int)__builtin_amdgcn_permlane32_swap((unsigned)c0[q], (unsigned)c0[8 + q], false, false)[0];
            const float gv = __uint_as_float(__builtin_amdgcn_permlane32_swap(__float_as_uint(bs[q]), __float_as_uint(bs[8 + q]), false, false)[0]) * rden;
            const int i = (key >> 4) & 15, j = key & 15;
            const int e = (int)myidx[r5 * 16 + i] * 128 + (int)myidx[(32 + r5) * 16 + j];
            const int tokl = tt * 32 + r5;
            ((unsigned short*)(lds_lists + PL_SEID))[tokl * 128 + h * 16 + 8 * hh + q] = (unsigned short)e;
            ((float*)(lds_lists + PL_SWGT))[tokl * 128 + h * 16 + 8 * hh + q] = gv;
        }
        asm volatile("s_waitcnt lgkmcnt(0)" ::: "memory");
    }
}

DI void unpack_h2(const bf16_t* __restrict__ hA, int t, int lane, f32x2 (&hv)[8]) {
    const int tile = t >> 7, row = t & 127, mb = row >> 5, r5 = row & 31;
    const bf16_t* hp = hA + ((unsigned)(((tile * 64 + lane) * 4 + mb) * 64 + r5)) * 8;
    const u32x4 ha = *(const u32x4*)hp, hb = *(const u32x4*)(hp + 32 * 8);
    const unsigned hw[8] = {ha.x, ha.y, ha.z, ha.w, hb.x, hb.y, hb.z, hb.w};
#pragma unroll
    for (int q = 0; q < 8; ++q) { hv[q].x = __uint_as_float(hw[q] << 16); hv[q].y = __uint_as_float(hw[q] & 0xffff0000u); }
}
typedef _Float16 h16x2 __attribute__((ext_vector_type(2)));
DI h16x2 fp4h(unsigned w, int sel) {
    return sel == 0 ? __builtin_amdgcn_cvt_scalef32_pk_f16_fp4(w, 1.0f, 0) : sel == 1 ? __builtin_amdgcn_cvt_scalef32_pk_f16_fp4(w, 1.0f, 1)
         : sel == 2 ? __builtin_amdgcn_cvt_scalef32_pk_f16_fp4(w, 1.0f, 2) : __builtin_amdgcn_cvt_scalef32_pk_f16_fp4(w, 1.0f, 3);
}
DI void stage_token(const int* __restrict__ ridx, const float* __restrict__ rgate, char* lds, int t, int tloc, int lane) {
    lane = opaque_v(lane); t = opaque_s(t);
    unsigned short* seid = (unsigned short*)(lds + PL_SEID) + tloc * 128;
    float* swgt = (float*)(lds + PL_SWGT) + tloc * 128;
    seid[lane] = (unsigned short)ridx[(unsigned)(t * 128 + lane)]; seid[64 + lane] = (unsigned short)ridx[(unsigned)(t * 128 + 64 + lane)];
    swgt[lane] = rgate[(unsigned)(t * 128 + lane)]; swgt[64 + lane] = rgate[(unsigned)(t * 128 + 64 + lane)];
}
DI void peer_down_wave(const bf16_t* __restrict__ hA, char* lds, const unsigned char* __restrict__ TBd, const float* __restrict__ SC, int tile, int w, int lane) {
    lane = opaque_v(lane);
    const int myu = ((lane >> 5) & 1) * 8 + ((lane >> 4) & 1) * 4 + ((lane >> 3) & 1) * 2 + ((lane >> 2) & 1);
    const unsigned short* seid = (const unsigned short*)(lds + PL_SEID) + w * 16 * 128;
    float* swgt = (float*)(lds + PL_SWGT) + w * 16 * 128;
    u32x4 haN, hbN;
    int ev0N, ev1N;
    { const bf16_t* hp0 = hA + (unsigned)((tile * 128 + w * 16) * 1024 + lane * 16); haN = *(const u32x4*)hp0; hbN = *(const u32x4*)(hp0 + 8); ev0N = seid[lane]; ev1N = seid[64 + lane]; }
    u32x2 R[2][16];
    f32x2 scv[2];
#define DOWN_ISSUE(buf, EV, base) do { _Pragma("unroll") for (int u_ = 0; u_ < 16; ++u_) { const int e_ = __builtin_amdgcn_readlane(EV, (base) + u_); \
        R[buf][u_] = *(const u32x2*)(TBd + (size_t)(unsigned)e_ * 512 + lane * 8); } \
        scv[buf] = *(const f32x2*)(SC + (unsigned)__shfl(EV, (base) + myu) * 2); } while (0)
    DOWN_ISSUE(0, ev0N, 0);
#pragma unroll 1
    for (int tl = 0; tl < 16; ++tl) {
        const int t = tile * 128 + w * 16 + tl;
        float* gp = swgt + tl * 128;
        const u32x4 ha = haN, hb = hbN;
        const int ev0 = ev0N, ev1 = ev1N;
        {
            const int tn = tl < 15 ? tl + 1 : tl;
            const bf16_t* hp = hA + (unsigned)((t - tl + tn) * 1024 + lane * 16); haN = *(const u32x4*)hp; hbN = *(const u32x4*)(hp + 8);
            ev0N = seid[tn * 128 + lane]; ev1N = seid[tn * 128 + 64 + lane];
        }
        unsigned hhi[2], hlo[2];
        float hscale;
        {
            const unsigned hw[8] = {ha.x, ha.y, ha.z, ha.w, hb.x, hb.y, hb.z, hb.w};
            float hf[16];
            float m = 0.f;
#pragma unroll
            for (int q = 0; q < 8; ++q) { hf[2 * q] = __uint_as_float(hw[q] << 16); hf[2 * q + 1] = __uint_as_float(hw[q] & 0xffff0000u); m = fmaxf(m, fmaxf(fabsf(hf[2 * q]), fabsf(hf[2 * q + 1]))); }
#pragma unroll
            for (int o = 1; o < 64; o <<= 1) m = fmaxf(m, __shfl_xor(m, o));
            hscale = m > 0.f ? m * (1.f / 119.f) : 1.f;
            const float inv = 1.f / hscale;
            hhi[0] = hhi[1] = hlo[0] = hlo[1] = 0u;
#pragma unroll
            for (int e = 0; e < 16; ++e) {
                const int hq = __float2int_rn(hf[e] * inv);
                const int lo = ((hq + 8) & 15) - 8, hi = (hq - lo) >> 4;
                hlo[e >> 3] |= ((unsigned)lo & 15u) << (4 * (e & 7));
                hhi[e >> 3] |= ((unsigned)hi & 15u) << (4 * (e & 7));
            }
        }
#pragma unroll
        for (int bt = 0; bt < 8; ++bt) {
            const int cur = bt & 1, nxt = cur ^ 1;
            if (bt < 3) DOWN_ISSUE(nxt, ev0, (bt + 1) * 16);
            else if (bt == 3) DOWN_ISSUE(nxt, ev1, 0);
            else if (bt < 7) DOWN_ISSUE(nxt, ev1, (bt - 3) * 16);
            else DOWN_ISSUE(nxt, ev0N, 0);
            __builtin_amdgcn_sched_barrier(0);
            int part[16];
#pragma unroll
            for (int u = 0; u < 16; ++u) {
                int shi = __builtin_amdgcn_sdot8((int)R[cur][u].x, (int)hhi[0], 0, false);
                shi = __builtin_amdgcn_sdot8((int)R[cur][u].y, (int)hhi[1], shi, false);
                int slo = __builtin_amdgcn_sdot8((int)R[cur][u].x, (int)hlo[0], 0, false);
                slo = __builtin_amdgcn_sdot8((int)R[cur][u].y, (int)hlo[1], slo, false);
                part[u] = shi * 16 + slo;
            }
            int r8[8], r4[4], r2[2], r1;
            {
                const bool b5 = (lane & 32) != 0, b4 = (lane & 16) != 0, b3 = (lane & 8) != 0, b2 = (lane & 4) != 0;
#pragma unroll
                for (int q = 0; q < 8; ++q) { const int keep = b5 ? part[q + 8] : part[q], give = b5 ? part[q] : part[q + 8]; r8[q] = keep + __shfl_xor(give, 32); }
#pragma unroll
                for (int q = 0; q < 4; ++q) { const int keep = b4 ? r8[q + 4] : r8[q], give = b4 ? r8[q] : r8[q + 4]; r4[q] = keep + __shfl_xor(give, 16); }
#pragma unroll
                for (int q = 0; q < 2; ++q) { const int keep = b3 ? r4[q + 2] : r4[q], give = b3 ? r4[q] : r4[q + 2]; r2[q] = keep + __shfl_xor(give, 8); }
                { const int keep = b2 ? r2[1] : r2[0], give = b2 ? r2[0] : r2[1]; r1 = keep + __shfl_xor(give, 4); }
                r1 += __shfl_xor(r1, 2); r1 += __shfl_xor(r1, 1);
            }
            if ((lane & 3) == 0) {
                const float a = (float)r1 * (scv[cur].x * hscale);
                gp[bt * 16 + myu] = gp[bt * 16 + myu] * (0.5f * a * (1.f + erff(a * 0.70710678118654752f))) * scv[cur].y;
            }
        }
    }
#undef DOWN_ISSUE
}
DI void peer_up_wave(char* lds, const unsigned char* __restrict__ TBu, const float* __restrict__ g2b, float* __restrict__ x, int tile, int w, int lane) {
    lane = opaque_v(lane);
    const unsigned short* seid = (const unsigned short*)(lds + PL_SEID) + w * 16 * 128;
    const float* swgt = (const float*)(lds + PL_SWGT) + w * 16 * 128;
    u32x2 RA[16], RB[16];
#define UP_ISSUE(R, EV, base) do { _Pragma("unroll") for (int u_ = 0; u_ < 16; ++u_) { const int e_ = __builtin_amdgcn_readlane(EV, (base) + u_); \
        R[u_] = *(const u32x2*)(TBu + (size_t)(unsigned)e_ * 512 + lane * 8); } } while (0)
#define UP_COMPUTE(R, WL, base, K) do { _Pragma("unroll") for (int u_ = 0; u_ < 16; ++u_) { \
        const _Float16 wh_ = (_Float16)__int_as_float(__builtin_amdgcn_readlane(__float_as_int(WL), (base) + u_)); const h16x2 w2_ = (h16x2){wh_, wh_}; \
        _Pragma("unroll") for (int q_ = 0; q_ < 4; ++q_) { acc[K][q_] = __builtin_elementwise_fma(w2_, fp4h(R[u_].x, q_), acc[K][q_]); acc[K][4 + q_] = __builtin_elementwise_fma(w2_, fp4h(R[u_].y, q_), acc[K][4 + q_]); } } } while (0)
    int ev0N = seid[lane], ev1N = seid[64 + lane];
    float wl0N = swgt[lane], wl1N = swgt[64 + lane];
    UP_ISSUE(RA, ev0N, 0);
    for (int r = 0; r < 2; ++r) {
        h16x2 acc[8][8];
#pragma unroll
        for (int k = 0; k < 8; ++k)
#pragma unroll
            for (int q = 0; q < 8; ++q) acc[k][q] = (h16x2){(_Float16)0.f, (_Float16)0.f};
#pragma unroll
        for (int k = 0; k < 8; ++k) {
            const int ev0 = ev0N, ev1 = ev1N;
            const float wl0 = wl0N, wl1 = wl1N;
            {
                const int tn = (r * 8 + k < 15) ? r * 8 + k + 1 : 15;
                ev0N = seid[tn * 128 + lane]; ev1N = seid[tn * 128 + 64 + lane]; wl0N = swgt[tn * 128 + lane]; wl1N = swgt[tn * 128 + 64 + lane];
            }
#pragma unroll 1
            for (int i = 0; i < 4; ++i) {
                const int evS = i < 2 ? ev0 : ev1;
                const float wlS = i < 2 ? wl0 : wl1;
                const int base = (i & 1) * 32;
                UP_ISSUE(RB, evS, base + 16);
                __builtin_amdgcn_sched_barrier(0);
                UP_COMPUTE(RA, wlS, base, k);
                const int evT = i < 3 ? (i < 1 ? ev0 : ev1) : ev0N;
                const int baseT = i < 3 ? ((i + 1) & 1) * 32 : 0;
                UP_ISSUE(RA, evT, baseT);
                __builtin_amdgcn_sched_barrier(0);
                UP_COMPUTE(RB, wlS, base + 16, k);
            }
        }
#pragma unroll
        for (int k = 0; k < 8; ++k) {
            const int t = tile * 128 + w * 16 + r * 8 + k;
            float4* xp = (float4*)(x + (size_t)t * D + lane * 16);
            const float4* gq = (const float4*)(g2b + lane * 16);
            float ssx = 0.f;
#pragma unroll
            for (int q = 0; q < 4; ++q) {
                float4 xv = xp[q]; const float4 gv = gq[q];
                xv.x += gv.x * (float)acc[k][2 * q].x; xv.y += gv.y * (float)acc[k][2 * q].y; xv.z += gv.z * (float)acc[k][2 * q + 1].x; xv.w += gv.w * (float)acc[k][2 * q + 1].y;
                xp[q] = xv;
                ssx += xv.x * xv.x + xv.y * xv.y + xv.z * xv.z + xv.w * xv.w;
            }
            ssx = wave_sum(ssx);
            if (lane == 0) ((float*)(lds + LDS_RSTD1))[w * 16 + r * 8 + k] = rsqrtf(ssx * (1.f / D) + EPS);
        }
    }
#undef UP_ISSUE
#undef UP_COMPUTE
}

DI void epi_qk(f32x16 (&acc)[4][2], const float* __restrict__ gain, float scale, bf16_t* __restrict__ dst, int lane) {
    lane = opaque_v(lane);
    const int hh = lane >> 5;
    float gv[2][16];
#pragma unroll
    for (int nb = 0; nb < 2; ++nb)
#pragma unroll
        for (int i = 0; i < 16; ++i) gv[nb][i] = gain[nb * 32 + (i & 3) + 8 * (i >> 2) + 4 * hh] * scale;
#pragma unroll
    for (int mb = 0; mb < 4; ++mb) {
        float ss = 0.f;
#pragma unroll
        for (int nb = 0; nb < 2; ++nb)
#pragma unroll
            for (int i = 0; i < 16; ++i) ss += acc[mb][nb][i] * acc[mb][nb][i];
        ss += __shfl_xor(ss, 32);
        const float r = rsqrtf(ss * (1.f / 64.f) + EPS);
#pragma unroll
        for (int nb = 0; nb < 2; ++nb)
#pragma unroll
            for (int s = 0; s < 2; ++s) {
                const f32x16& a = acc[mb][nb];
                u32x4 o;
                o.x = pk2(a[8 * s] * r * gv[nb][8 * s], a[8 * s + 1] * r * gv[nb][8 * s + 1]);
                o.y = pk2(a[8 * s + 2] * r * gv[nb][8 * s + 2], a[8 * s + 3] * r * gv[nb][8 * s + 3]);
                o.z = pk2(a[8 * s + 4] * r * gv[nb][8 * s + 4], a[8 * s + 5] * r * gv[nb][8 * s + 5]);
                o.w = pk2(a[8 * s + 6] * r * gv[nb][8 * s + 6], a[8 * s + 7] * r * gv[nb][8 * s + 7]);
                *(u32x4*)(dst + ((unsigned)(((nb * 2 + s) * 4 + mb) * 64 + lane)) * 8) = o;
            }
    }
}
DI void epi_v(const f32x16 (&acc)[4][2], bf16_t* __restrict__ dst, int lane) {
    lane = opaque_v(lane);
#pragma unroll
    for (int nb = 0; nb < 2; ++nb)
#pragma unroll
        for (int mb = 0; mb < 4; ++mb)
#pragma unroll
            for (int s = 0; s < 2; ++s) {
                const f32x16& a = acc[mb][nb];
                u32x4 o; o.x = pk2(a[8 * s], a[8 * s + 1]); o.y = pk2(a[8 * s + 2], a[8 * s + 3]); o.z = pk2(a[8 * s + 4], a[8 * s + 5]); o.w = pk2(a[8 * s + 6], a[8 * s + 7]);
                *(u32x4*)(dst + ((unsigned)(((nb * 4 + mb) * 2 + s) * 64 + lane)) * 8) = o;
            }
}
DI void epi_row(const f32x16 (&acc)[4][2], bf16_t* __restrict__ dst, int ld, int lane) {
    lane = opaque_v(lane);
    const int r5 = lane & 31, hh = lane >> 5;
#pragma unroll
    for (int mb = 0; mb < 4; ++mb)
#pragma unroll
        for (int nb = 0; nb < 2; ++nb)
#pragma unroll
            for (int gq = 0; gq < 4; ++gq) {
                const f32x16& a = acc[mb][nb];
                u32x2 o; o.x = pk2(a[4 * gq], a[4 * gq + 1]); o.y = pk2(a[4 * gq + 2], a[4 * gq + 3]);
                *(u32x2*)(dst + (unsigned)((mb * 32 + r5) * ld + nb * 32 + 8 * gq + 4 * hh)) = o;
            }
}
DI void epi_z(const f32x16 (&acc)[4][2], bf16_t* __restrict__ dst, int lane) {
    lane = opaque_v(lane);
    const int r5 = lane & 31, hh = lane >> 5;
#pragma unroll
    for (int mb = 0; mb < 4; ++mb)
#pragma unroll
        for (int gq = 0; gq < 4; ++gq) {
            const f32x16 &a = acc[mb][0], &b = acc[mb][1];
            u32x2 o; o.x = pk2(a[4 * gq] * b[4 * gq], a[4 * gq + 1] * b[4 * gq + 1]); o.y = pk2(a[4 * gq + 2] * b[4 * gq + 2], a[4 * gq + 3] * b[4 * gq + 3]);
            *(u32x2*)(dst + (unsigned)((mb * 32 + r5) * 256 + 8 * gq + 4 * hh)) = o;
        }
}
DI void epi_su_park(const f32x16 (&acc)[4][2], unsigned* lds_su, int lane) {
    lane = opaque_v(lane);
#pragma unroll
    for (int mb = 0; mb < 4; ++mb)
#pragma unroll
        for (int nb = 0; nb < 2; ++nb)
#pragma unroll
            for (int q = 0; q < 8; ++q) lds_su[((mb * 2 + nb) * 8 + q) * 64 + lane] = pk2(acc[mb][nb][2 * q], acc[mb][nb][2 * q + 1]);
}
DI void epi_sv(f32x16 (&acc)[4][2], const bf16_t* __restrict__ SWF  , const float* __restrict__ bs_g, const unsigned* lds_su, bf16_t* __restrict__ dst, int lane) {
    lane = opaque_v(lane);
    const int r5 = lane & 31, hh = lane >> 5;
    bf16x8 vb[4][2][2];
#pragma unroll
    for (int mb = 0; mb < 4; ++mb) {
#pragma unroll
        for (int i = 0; i < 16; ++i) {
            float s1 = acc[mb][0][i] + acc[mb][1][i];
#pragma unroll
            for (int o = 1; o < 32; o <<= 1) s1 += __shfl_xor(s1, o);
            const float mu = s1 * (1.f / 64.f);
            const float d0 = acc[mb][0][i] - mu, d1 = acc[mb][1][i] - mu;
            float s2 = d0 * d0 + d1 * d1;
#pragma unroll
            for (int o = 1; o < 32; o <<= 1) s2 += __shfl_xor(s2, o);
            const float r = rsqrtf(s2 * (1.f / 64.f) + EPS);
            acc[mb][0][i] = d0 * r; acc[mb][1][i] = d1 * r;
        }
#pragma unroll
        for (int s = 0; s < 2; ++s)
#pragma unroll
            for (int nb = 0; nb < 2; ++nb) {
                const f32x16& a = acc[mb][nb];
                u32x4 o; o.x = pk2(a[8 * s], a[8 * s + 1]); o.y = pk2(a[8 * s + 2], a[8 * s + 3]); o.z = pk2(a[8 * s + 4], a[8 * s + 5]); o.w = pk2(a[8 * s + 6], a[8 * s + 7]);
                vb[mb][s][nb] = __builtin_bit_cast(bf16x8, o);
            }
    }
#pragma unroll
    for (int tb = 0; tb < 4; ++tb) {
        f32x16 y[2];
#pragma unroll
        for (int nb = 0; nb < 2; ++nb)
#pragma unroll
            for (int i = 0; i < 16; ++i) y[nb][i] = 0.f;
#pragma unroll
        for (int kt = 0; kt <= tb; ++kt)
#pragma unroll
            for (int s = 0; s < 2; ++s) {
                const bf16x8 wa = *(const bf16x8*)(SWF + ((unsigned)(((tb * 4 + kt) * 2 + s) * 64 + lane)) * 8);
                y[0] = MFMA32(wa, vb[kt][s][0], y[0]);
                y[1] = MFMA32(wa, vb[kt][s][1], y[1]);
            }
#pragma unroll
        for (int nb = 0; nb < 2; ++nb)
#pragma unroll
            for (int q = 0; q < 8; ++q) {
                const unsigned su2 = lds_su[((tb * 2 + nb) * 8 + q) * 64 + lane];
                const int i0 = 2 * q, i1 = 2 * q + 1;
                const int t0 = tb * 32 + (i0 & 3) + 8 * (i0 >> 2) + 4 * hh, t1 = tb * 32 + (i1 & 3) + 8 * (i1 >> 2) + 4 * hh;
                const float v0 = (y[nb][i0] + bs_g[t0]) * __uint_as_float(su2 << 16), v1 = (y[nb][i1] + bs_g[t1]) * __uint_as_float(su2 & 0xffff0000u);
                const unsigned pk = pk2(v0, v1);
                dst[(unsigned)(t0 * 256 + nb * 32 + r5)] = (bf16_t)(pk & 0xffffu);
                dst[(unsigned)(t1 * 256 + nb * 32 + r5)] = (bf16_t)(pk >> 16);
            }
    }
}

DI void conv_sguw_item(const float* __restrict__ W, bf16_t* __restrict__ SWF, int gid) {
    const int lane = gid & 63, s = (gid >> 6) & 1, kt = (gid >> 7) & 3, tb = (gid >> 9) & 3, g = gid >> 11;
    const int r = lane & 31, hh = lane >> 5, t = tb * 32 + r;
    const float* p = W + ((size_t)g * 128 + t) * 128;
    float v[8];
#pragma unroll
    for (int j = 0; j < 8; ++j) { const int sp = kt * 32 + 16 * s + 8 * (j >> 2) + 4 * hh + (j & 3); v[j] = sp <= t ? p[sp] : 0.f; }
    u32x4 o; o.x = pk2(v[0], v[1]); o.y = pk2(v[2], v[3]); o.z = pk2(v[4], v[5]); o.w = pk2(v[6], v[7]);
    *(u32x4*)(SWF + (size_t)gid * 8) = o;
}

DI int t5_bucket(int d) {
    if (d < 16) return d;
    const float lr = logf((float)d / 16.f) / logf(8.f);
    const int large = 16 + (int)(lr * 16.f);
    return large < 31 ? large : 31;
}

DI void attn_tile(const bf16_t* __restrict__ QF, const bf16_t* __restrict__ KF2, const bf16_t* __restrict__ VF, const float* bias_lds, const float* __restrict__ sink, bf16_t* __restrict__ OR, int tile, int tid) {
    tid = opaque_v(tid); tile = opaque_s(tile);
    const int lane = tid & 63, w = __builtin_amdgcn_readfirstlane(tid >> 6), r5 = lane & 31, hh = lane >> 5;
    const bool has_prev = (tile & 31) != 0;
    for (int task = w; task < 32; task += 8) {
        const int qh = task >> 2, qt = task & 3, kvh = qh >> 2;
        bf16x8 bq[4];
#pragma unroll
        for (int ks = 0; ks < 4; ++ks) bq[ks] = *(const bf16x8*)(QF + ((unsigned)((((tile * 8 + qh) * 4 + ks) * 4 + qt) * 64 + lane)) * 8);
        f32x16 sc[5];
#pragma unroll
        for (int grp = 0; grp < 2; ++grp) {
            bf16x8 kf[3][4];
#pragma unroll
            for (int jq = 0; jq < 3; ++jq) if (grp * 3 + jq < 5) {
                const int jj = grp * 3 + jq, j = qt + jj, st = (j >= 4 || !has_prev) ? tile : tile - 1, kt = j & 3;
#pragma unroll
                for (int ks = 0; ks < 4; ++ks) kf[jq][ks] = *(const bf16x8*)(KF2 + ((unsigned)((((st * 2 + kvh) * 4 + ks) * 4 + kt) * 64 + lane)) * 8);
            }
#pragma unroll
            for (int jq = 0; jq < 3; ++jq) if (grp * 3 + jq < 5) {
                const int jj = grp * 3 + jq;
#pragma unroll
                for (int i = 0; i < 16; ++i) sc[jj][i] = 0.f;
#pragma unroll
                for (int ks = 0; ks < 4; ++ks) sc[jj] = MFMA32(kf[jq][ks], bq[ks], sc[jj]);
            }
            __builtin_amdgcn_sched_barrier(0);
        }
        bf16x8 vf[5][2][2];
#pragma unroll
        for (int jj = 0; jj < 2; ++jj) {
            const int j = qt + jj, st = (j >= 4 || !has_prev) ? tile : tile - 1, kt = j & 3;
#pragma unroll
            for (int s2 = 0; s2 < 2; ++s2)
#pragma unroll
                for (int dt = 0; dt < 2; ++dt) vf[jj][s2][dt] = *(const bf16x8*)(VF + ((unsigned)(((((st * 2 + kvh) * 2 + dt) * 4 + kt) * 2 + s2) * 64 + lane)) * 8);
        }
        const float* bl = bias_lds + qh * 128;
        float m = -1e30f;
#pragma unroll
        for (int jj = 0; jj < 5; ++jj) {
            const bool ex = (qt + jj >= 4) || has_prev;
#pragma unroll
            for (int i = 0; i < 16; ++i) {
                const int cr = (i & 3) + 8 * (i >> 2) + 4 * hh;
                const int dist = 128 + r5 - 32 * jj - cr;
                const bool valid = ex && dist >= 0 && dist < 128;
                const float v = valid ? sc[jj][i] + bl[dist & 127] : -1e30f;
                sc[jj][i] = v; m = fmaxf(m, v);
            }
        }
        m = fmaxf(m, __shfl_xor(m, 32));
        const float sk = sink[qh];
        m = fmaxf(m, sk);
        float l = 0.f;
#pragma unroll
        for (int jj = 0; jj < 5; ++jj)
#pragma unroll
            for (int i = 0; i < 16; ++i) { const float p = __expf(sc[jj][i] - m); sc[jj][i] = p; l += p; }
        l += __shfl_xor(l, 32);
        l += __expf(sk - m);
        const float rl = 1.f / l;
        f32x16 o[2];
#pragma unroll
        for (int dt = 0; dt < 2; ++dt)
#pragma unroll
            for (int i = 0; i < 16; ++i) o[dt][i] = 0.f;
        __builtin_amdgcn_sched_barrier(0);
#pragma unroll
        for (int jj = 2; jj < 5; ++jj) {
            const int j = qt + jj, st = (j >= 4 || !has_prev) ? tile : tile - 1, kt = j & 3;
#pragma unroll
            for (int s2 = 0; s2 < 2; ++s2)
#pragma unroll
                for (int dt = 0; dt < 2; ++dt) vf[jj][s2][dt] = *(const bf16x8*)(VF + ((unsigned)(((((st * 2 + kvh) * 2 + dt) * 4 + kt) * 2 + s2) * 64 + lane)) * 8);
        }
#pragma unroll
        for (int jj = 0; jj < 5; ++jj) {
#pragma unroll
            for (int s = 0; s < 2; ++s) {
                const f32x16& a = sc[jj];
                u32x4 pp; pp.x = pk2(a[8 * s], a[8 * s + 1]); pp.y = pk2(a[8 * s + 2], a[8 * s + 3]); pp.z = pk2(a[8 * s + 4], a[8 * s + 5]); pp.w = pk2(a[8 * s + 6], a[8 * s + 7]);
                const bf16x8 pb = __builtin_bit_cast(bf16x8, pp);
#pragma unroll
                for (int dt = 0; dt < 2; ++dt) o[dt] = MFMA32(vf[jj][s][dt], pb, o[dt]);
            }
        }
        bf16_t* orow = OR + (unsigned)((tile * 128 + qt * 32 + r5) * 512 + qh * 64 + 4 * hh);
#pragma unroll
        for (int dt = 0; dt < 2; ++dt)
#pragma unroll
            for (int gq = 0; gq < 4; ++gq) {
                u32x2 ov; ov.x = pk2(o[dt][4 * gq] * rl, o[dt][4 * gq + 1] * rl); ov.y = pk2(o[dt][4 * gq + 2] * rl, o[dt][4 * gq + 3] * rl);
                *(u32x2*)(orow + dt * 32 + 8 * gq) = ov;
            }
    }
}

DI void unpack8(const u32x4 v, float (&f)[8]) {
    f[0] = __uint_as_float(v.x << 16); f[1] = __uint_as_float(v.x & 0xffff0000u); f[2] = __uint_as_float(v.y << 16); f[3] = __uint_as_float(v.y & 0xffff0000u);
    f[4] = __uint_as_float(v.z << 16); f[5] = __uint_as_float(v.z & 0xffff0000u); f[6] = __uint_as_float(v.w << 16); f[7] = __uint_as_float(v.w & 0xffff0000u);
}
DI void merge_tile(const bf16_t* __restrict__ OR, const bf16_t* __restrict__ CBR, const bf16_t* __restrict__ ZR, const bf16_t* __restrict__ YS, const float* __restrict__ cw  , const float* __restrict__ og  ,
                   bf16_t* __restrict__ mA, int tile, int tid) {
    tid = opaque_v(tid); tile = opaque_s(tile);
    const int lane = tid & 63, w = tid >> 6;
#pragma unroll 4
    for (int rr = 0; rr < 16; ++rr) {
        const int row = w * 16 + rr, t = tile * 128 + row, pos = t & (S - 1);
        float a[8], y[8];
        unpack8(*(const u32x4*)(OR + (unsigned)(t * 512 + lane * 8)), a);
        float ssa = 0.f;
#pragma unroll
        for (int q = 0; q < 8; ++q) ssa += a[q] * a[q];
        ssa = wave_sum(ssa);
        if (lane < 32) {
            const int c0 = lane * 8;
            float cb[8], z0[8], z1[8], z2[8];
            unpack8(*(const u32x4*)(CBR + (unsigned)(t * 256 + c0)), cb);
            unpack8(*(const u32x4*)(ZR + (unsigned)(t * 256 + c0)), z2);
            if (pos >= 1) unpack8(*(const u32x4*)(ZR + (unsigned)((t - 1) * 256 + c0)), z1); else { _Pragma("unroll") for (int q = 0; q < 8; ++q) z1[q] = 0.f; }
            if (pos >= 2) unpack8(*(const u32x4*)(ZR + (unsigned)((t - 2) * 256 + c0)), z0); else { _Pragma("unroll") for (int q = 0; q < 8; ++q) z0[q] = 0.f; }
#pragma unroll
            for (int q = 0; q < 8; ++q) y[q] = cb[q] * (cw[c0 + q] * z0[q] + cw[256 + c0 + q] * z1[q] + cw[512 + c0 + q] * z2[q]);
        } else {
            unpack8(*(const u32x4*)(YS + (unsigned)(t * 256 + (lane - 32) * 8)), y);
        }
        float ssy = 0.f;
#pragma unroll
        for (int q = 0; q < 8; ++q) ssy += y[q] * y[q];
#pragma unroll
        for (int o = 1; o < 32; o <<= 1) ssy += __shfl_xor(ssy, o);
        const float ra = rsqrtf(ssa * (1.f / 512.f) + EPS), ry = rsqrtf(ssy * (1.f / 256.f) + EPS);
        const int mb = row >> 5, r5 = row & 31;
        {
            const float4 g0 = *(const float4*)(og + lane * 8), g1 = *(const float4*)(og + lane * 8 + 4);
            u32x4 o; o.x = pk2(a[0] * ra * g0.x, a[1] * ra * g0.y); o.y = pk2(a[2] * ra * g0.z, a[3] * ra * g0.w); o.z = pk2(a[4] * ra * g1.x, a[5] * ra * g1.y); o.w = pk2(a[6] * ra * g1.z, a[7] * ra * g1.w);
            const int c8 = lane;
            (void)c8;
            *(u32x4*)(mA + (unsigned)(t * 1024 + lane * 8)) = o;
        }
        {
            const float4 g0 = *(const float4*)(og + 512 + lane * 8), g1 = *(const float4*)(og + 512 + lane * 8 + 4);
            u32x4 o; o.x = pk2(y[0] * ry * g0.x, y[1] * ry * g0.y); o.y = pk2(y[2] * ry * g0.z, y[3] * ry * g0.w); o.z = pk2(y[4] * ry * g1.x, y[5] * ry * g1.y); o.w = pk2(y[6] * ry * g1.z, y[7] * ry * g1.w);
            const int c8 = 64 + lane;
            (void)c8;
            *(u32x4*)(mA + (unsigned)(t * 1024 + 512 + lane * 8)) = o;
        }
    }
}

struct InProjOut { bf16_t *QF, *KF2, *VF, *CBR, *ZR, *YS; };
DI void inproj_tile(const bf16_t* __restrict__ At, const bf16_t* __restrict__ WF, const float* __restrict__ qg, const float* __restrict__ kg, const bf16_t* __restrict__ SWF, const float* __restrict__ sgu_b,
                    const InProjOut& O, char* lds, int tile, int tid) {
    tid = opaque_v(tid); tile = opaque_s(tile);
    const int lane = tid & 63, w = __builtin_amdgcn_readfirstlane(tid >> 6);
    f32x16 acc[4][2];
    {
        const int nbt0 = w * 2;
        kloop<1>(acc, At, WF + (size_t)nbt0 * 32768, WF + (size_t)(nbt0 + 1) * 32768, lds, tid, lane);
        epi_qk(acc, qg, 0.125f, O.QF + (size_t)(tile * 8 + w) * 8192, lane);
    }
    {
        const int nbt0 = 16 + w * 2;
        if (w == 2 || w == 3) {
            kloop<0>(acc, At, WF + (size_t)nbt0 * 32768, WF + (size_t)(nbt0 + 1) * 32768, lds, tid, lane);
            epi_v(acc, O.VF + (size_t)(tile * 2 + (w - 2)) * 8192, lane);
        } else {
            kloop<1>(acc, At, WF + (size_t)nbt0 * 32768, WF + (size_t)(nbt0 + 1) * 32768, lds, tid, lane);
            if (w < 2) epi_qk(acc, kg, 1.f, O.KF2 + (size_t)(tile * 2 + w) * 8192, lane);
            else epi_row(acc, O.CBR + (size_t)tile * 128 * 256 + (w - 4) * 64, 256, lane);
        }
    }
    {
        const int nbt0 = 32 + w * 2;
        kloop<1>(acc, At, WF + (size_t)nbt0 * 32768, WF + (size_t)(nbt0 + 1) * 32768, lds, tid, lane);
        epi_z(acc, O.ZR + (size_t)tile * 128 * 256 + w * 32, lane);
    }
    {
        const int nbt0 = 48 + w * 2;
        kloop<0>(acc, At, WF + (size_t)nbt0 * 32768, WF + (size_t)(nbt0 + 1) * 32768, lds, tid, lane);
        unsigned* lds_su = (unsigned*)lds;
        if (w < 4) epi_su_park(acc, lds_su + w * 4096, lane);
        __syncthreads();
        if (w >= 4) epi_sv(acc, SWF + (size_t)(w - 4) * 16384, sgu_b + (w - 4) * 128, lds_su + (w - 4) * 4096, O.YS + (size_t)tile * 128 * 256 + (w - 4) * 64, lane);
        __syncthreads();
    }
}


struct Params {
    const float *x, *c, *rel_bias, *w_ada, *b_ada, *norm1_g, *norm2_g, *w_in, *q_norm_g, *k_norm_g, *attn_sink, *conv_w, *sgu_w, *sgu_b, *out_norm_g, *w_out, *peer_wq, *peer_sub_keys, *peer_down, *peer_up;
    float* out;
    char* ws;
};
constexpr size_t MiB = 1u << 20;
constexpr size_t WS_MOD = 0;
constexpr size_t WS_MODP = 1 * MiB;
constexpr size_t WS_WIN = 13 * MiB;
constexpr size_t WS_WOUT = 29 * MiB;
constexpr size_t WS_WPQ = 37 * MiB;
constexpr size_t WS_KEYS = 53 * MiB;
constexpr size_t WS_SWF = 55 * MiB;
constexpr size_t WS_SC = 56 * MiB;
constexpr size_t WS_TB = 57 * MiB;
constexpr size_t WS_HA = 185 * MiB;
constexpr size_t WS_QF = 249 * MiB;
constexpr size_t WS_KF2 = 602 * MiB;
constexpr size_t WS_VF = 634 * MiB;
constexpr size_t WS_ZR = 666 * MiB;
constexpr size_t WS_CBR = 345 * MiB;
constexpr size_t WS_YS = 361 * MiB;
constexpr size_t WS_OR = 377 * MiB;
constexpr size_t WS_QPF = 409 * MiB;
constexpr size_t WS_RIDX = 537 * MiB;
constexpr size_t WS_RGATE = 553 * MiB;
constexpr size_t WS_SEID = 569 * MiB;
constexpr size_t WS_SWGT = 585 * MiB;
constexpr size_t WS_OFFS = 601 * MiB;
constexpr size_t WS_FLAGS = 601 * MiB + 512 * 1024;
constexpr size_t WS_END = 730 * MiB;
static_assert(PL_END <= LDS_RSTD1, "expert-phase lists overlap persistent LDS state");

__global__ __launch_bounds__(512) void hybrid_fwd(Params P) {
    extern __shared__ __attribute__((aligned(16))) char lds[];
    cg::grid_group grid = cg::this_grid();
    const int tid = threadIdx.x, lane = tid & 63, w = __builtin_amdgcn_readfirstlane(tid >> 6);
    const int nblk = gridDim.x, hwb = blockIdx.x;
    const int bid = (nblk == NTILE) ? (hwb & 7) * 32 + (hwb >> 3) : hwb;
    char* ws = P.ws;
    float* mod = (float*)(ws + WS_MOD);
    float* modp = (float*)(ws + WS_MODP);
    bf16_t* WinF = (bf16_t*)(ws + WS_WIN); bf16_t* WoutF = (bf16_t*)(ws + WS_WOUT); bf16_t* WpqF = (bf16_t*)(ws + WS_WPQ);
    bf16_t* KeysF = (bf16_t*)(ws + WS_KEYS); bf16_t* SWF = (bf16_t*)(ws + WS_SWF);
    float* SC = (float*)(ws + WS_SC); unsigned char* TBd = (unsigned char*)(ws + WS_TB); unsigned char* TBu = TBd + 32 * MiB;
    bf16_t* hA = (bf16_t*)(ws + WS_HA);
    bf16_t* OR = (bf16_t*)(ws + WS_OR); bf16_t* QPF = (bf16_t*)(ws + WS_QPF);
    int* ridx = (int*)(ws + WS_RIDX); float* rgate = (float*)(ws + WS_RGATE);
    float* bias_lds = (float*)(lds + LDS_BIAS);
    unsigned* flags = (unsigned*)(ws + WS_FLAGS);

    {
        float* ca = (float*)lds;
        if (tid == 0) for (int tile = bid; tile < NTILE; tile += nblk) __hip_atomic_store(flags + tile, 0u, __ATOMIC_RELAXED, __HIP_MEMORY_SCOPE_AGENT);
        for (int i = tid; i < 8192; i += 512) { const float v = P.c[i]; ca[i] = v / (1.f + __expf(-v)); }
        for (int i = tid; i < 1024; i += 512) bias_lds[i] = P.rel_bias[t5_bucket(i & 127) * 8 + (i >> 7)];
        __syncthreads();
        for (int it = bid; it < 768; it += nblk) {
            const int jc = it % 12, l = (it / 12) & 3, ks = it / 48;
            const int j = jc * 512 + tid;
            const float* wp = P.w_ada + ((size_t)l * 1024 + ks * 64) * 6144 + j;
            float acc[8];
#pragma unroll
            for (int b = 0; b < 8; ++b) acc[b] = 0.f;
#pragma unroll 4
            for (int i = 0; i < 64; ++i) {
                const float wv = wp[(size_t)i * 6144];
#pragma unroll
                for (int b = 0; b < 8; ++b) acc[b] += ca[b * 1024 + ks * 64 + i] * wv;
            }
#pragma unroll
            for (int b = 0; b < 8; ++b) modp[((size_t)(ks * 4 + l) * 8 + b) * 6144 + j] = acc[b];
        }
        const int gthreads = nblk * 512, gtid = bid * 512 + tid;
        for (int rep = 0; rep < REP_P0; ++rep)
        for (int l = 0; l < DEPTH; ++l) {
            for (int g = gtid; g < 64 * 64 * 64; g += gthreads) conv_wfrag_item(P.w_in + (size_t)l * 1024 * 2048, 2048, 64, WinF + (size_t)l * 2097152, g, 1);
            for (int g = gtid; g < 32 * 64 * 64; g += gthreads) conv_wfrag_item(P.w_out + (size_t)l * 1024 * 1024, 1024, 64, WoutF + (size_t)l * 1048576, g, 0);
            for (int g = gtid; g < 64 * 64 * 64; g += gthreads) conv_wfrag_item(P.peer_wq + (size_t)l * 1024 * 2048, 2048, 64, WpqF + (size_t)l * 2097152, g, 0);
            for (int g = gtid; g < 32768; g += gthreads) conv_keys_item(P.peer_sub_keys + (size_t)l * 262144, KeysF + (size_t)l * 262144, g);
            for (int g = gtid; g < 8192; g += gthreads) conv_sguw_item(P.sgu_w + (size_t)l * 65536, SWF + (size_t)l * 65536, g);
        }
        const int gwaves = nblk * 8, gw = bid * 8 + w;
        for (int rep = 0; rep < REP_P0; ++rep)
        for (int r = gw; r < DEPTH * 16384 * 2; r += gwaves) {
            const int which = r & 1, le = r >> 1;
            conv_table_row((which ? P.peer_up : P.peer_down) + (size_t)le * D, (which ? TBu : TBd) + (size_t)le * 512, SC + (size_t)le * 2 + which, lane, which == 0);
        }
    }
    grid.sync();
    for (int tile = bid; tile < NTILE; tile += nblk) {
        const int b = tile >> 5;
        for (int l = 0; l < DEPTH; ++l)
            for (int j = tid; j < 6144; j += 512) {
                float v = P.b_ada[l * 6144 + j];
#pragma unroll
                for (int ks = 0; ks < 16; ++ks) v += modp[((size_t)(ks * 4 + l) * 8 + b) * 6144 + j];
                mod[((size_t)l * 8 + b) * 6144 + j] = v;
            }
    }
    __syncthreads();

    for (int l = 0; l < DEPTH; ++l) {
        const float* xin = l == 0 ? P.x : P.out;
        InProjOut IO;
        IO.QF = (bf16_t*)(ws + WS_QF); IO.KF2 = (bf16_t*)(ws + WS_KF2 + (size_t)l * 8 * MiB); IO.VF = (bf16_t*)(ws + WS_VF + (size_t)l * 8 * MiB);
        IO.CBR = (bf16_t*)(ws + WS_CBR); IO.ZR = (bf16_t*)(ws + WS_ZR + (size_t)l * 16 * MiB); IO.YS = (bf16_t*)(ws + WS_YS);
        for (int tile = bid; tile < NTILE; tile += nblk) {
            const float* mb_ = mod + ((size_t)l * 8 + (tile >> 5)) * 6144;
            const bool have1 = l > 0 && nblk == NTILE;
            if (have1) { if (tid < 128) ((float*)lds)[tid] = ((const float*)(lds + LDS_RSTD1))[tid]; __syncthreads(); }
            norm_to_frag(xin, P.norm1_g + l * D, mb_ + 0, mb_ + 1024, hA, (float*)lds, tile, tid, have1);
            __syncthreads();
            for (int rep = 0; rep < REP_GEMM; ++rep) inproj_tile(hA + (size_t)tile * 131072, WinF + (size_t)l * 2097152, P.q_norm_g + l * 64, P.k_norm_g + l * 64, SWF + (size_t)l * 65536, P.sgu_b + l * 512, IO, lds, tile, tid);
            asm volatile("s_waitcnt vmcnt(0)" ::: "memory");
            __syncthreads();
            if (tid == 0) {
                __builtin_amdgcn_fence(__ATOMIC_RELEASE, "agent");
                asm volatile("s_waitcnt vmcnt(0)" ::: "memory");
                __hip_atomic_store(flags + tile, (unsigned)(l + 1), __ATOMIC_RELAXED, __HIP_MEMORY_SCOPE_AGENT);
            }
        }
        for (int tile = bid; tile < NTILE; tile += nblk) {
            const float* mb_ = mod + ((size_t)l * 8 + (tile >> 5)) * 6144;
            if ((tile & 31) != 0) {
                if (tid == 0) {
                    unsigned spins = 0;
                    while (__hip_atomic_load(flags + tile - 1, __ATOMIC_RELAXED, __HIP_MEMORY_SCOPE_AGENT) < (unsigned)(l + 1) && ++spins < (1u << 24)) __builtin_amdgcn_s_sleep(2);
                    __builtin_amdgcn_fence(__ATOMIC_ACQUIRE, "agent");
                    asm volatile("s_waitcnt vmcnt(0)" ::: "memory");
                }
                __syncthreads();
            }
            for (int rep = 0; rep < REP_MIX; ++rep) {
            attn_tile(IO.QF, IO.KF2, IO.VF, bias_lds, P.attn_sink + l * 8, OR, tile, tid);
            __syncthreads();
            merge_tile(OR, IO.CBR, IO.ZR, IO.YS, P.conv_w + l * 768, P.out_norm_g + l * D, hA, tile, tid);
            __syncthreads();
            }
            {
                const bf16_t* At = hA + (size_t)tile * 131072;
                const bf16_t* WF = WoutF + (size_t)l * 1048576;
                for (int pass = 0; pass < 2; ++pass) {
                    f32x16 acc[4][2];
                    const int nbt0 = pass * 16 + w * 2;
                    kloop<0>(acc, At, WF + (size_t)nbt0 * 32768, WF + (size_t)(nbt0 + 1) * 32768, lds, tid, lane);
                    epi_resid(acc, xin, P.out, mb_ + 2048, (float*)(lds + LDS_EPI) + w * 2176, (float*)(lds + LDS_SSQ) + (pass * 8 + w) * 128, tile, pass * 512 + w * 64, lane);
                }
            }
            __syncthreads();
            if (tid < 128) { const float* sq = (const float*)(lds + LDS_SSQ); float ssum = 0.f;
#pragma unroll
                for (int c = 0; c < 16; ++c) ssum += sq[c * 128 + tid];
                ((float*)lds)[tid] = rsqrtf(ssum * (1.f / D) + EPS); }
            __syncthreads();
            norm_to_frag(P.out, P.norm2_g + l * D, mb_ + 3072, mb_ + 4096, hA, (float*)lds, tile, tid, true);
            __syncthreads();
            {
                const bf16_t* At = hA + (size_t)tile * 131072;
                const bf16_t* WF = WpqF + (size_t)l * 2097152;
                for (int rep = 0; rep < REP_GEMM; ++rep)
                for (int pass = 0; pass < 4; ++pass) {
                    f32x16 acc[4][2];
                    const int nbt0 = pass * 16 + w * 2;
                    kloop<1>(acc, At, WF + (size_t)nbt0 * 32768, WF + (size_t)(nbt0 + 1) * 32768, lds, tid, lane);
                    epi_qpf(acc, QPF, tile, nbt0, lane);
                }
            }
            __syncthreads();
            for (int rep = 0; rep < REP_ROUTE; ++rep) { route_tile(QPF, KeysF + (size_t)l * 262144, lds, (unsigned char*)lds + PL_RIDX, tile, tid); __syncthreads(); }
            peer_down_wave(hA, lds, TBd + (size_t)l * 16384 * 512, SC + (size_t)l * 32768, tile, w, lane);
            __syncthreads();
            peer_up_wave(lds, TBu + (size_t)l * 16384 * 512, mb_ + 5120, P.out, tile, w, lane);
            __syncthreads();
        }
    }
}
}

extern "C" void kernel_launch(void* const* d_in, const int* in_sizes, int n_in, void* d_out, int out_size, void* d_ws, size_t ws_size, hipStream_t stream) {
    using namespace op;
    static int grid_blocks = 0;
    if (!grid_blocks) {
        int dev = 0, cus = 0, per_cu = 0;
        (void)hipGetDevice(&dev);
        (void)hipDeviceGetAttribute(&cus, hipDeviceAttributeMultiprocessorCount, dev);
        (void)hipFuncSetAttribute((const void*)hybrid_fwd, hipFuncAttributeMaxDynamicSharedMemorySize, LDS_BYTES);
        (void)hipOccupancyMaxActiveBlocksPerMultiprocessor(&per_cu, (const void*)hybrid_fwd, 512, LDS_BYTES);
        if (per_cu < 1) per_cu = 1;
        grid_blocks = cus * per_cu;
        if (grid_blocks > NTILE) grid_blocks = NTILE;
        if (ws_size < WS_END) { fprintf(stderr, "kernel_launch: workspace too small (%zu < %zu)\n", ws_size, (size_t)WS_END); grid_blocks = -1; }
    }
    if (grid_blocks < 0) return;
    Params p{};
    p.x = (const float*)d_in[0]; p.c = (const float*)d_in[1]; p.rel_bias = (const float*)d_in[2]; p.w_ada = (const float*)d_in[3]; p.b_ada = (const float*)d_in[4];
    p.norm1_g = (const float*)d_in[5]; p.norm2_g = (const float*)d_in[6]; p.w_in = (const float*)d_in[7]; p.q_norm_g = (const float*)d_in[8]; p.k_norm_g = (const float*)d_in[9];
    p.attn_sink = (const float*)d_in[10]; p.conv_w = (const float*)d_in[11]; p.sgu_w = (const float*)d_in[12]; p.sgu_b = (const float*)d_in[13]; p.out_norm_g = (const float*)d_in[14];
    p.w_out = (const float*)d_in[15]; p.peer_wq = (const float*)d_in[16]; p.peer_sub_keys = (const float*)d_in[17]; p.peer_down = (const float*)d_in[18]; p.peer_up = (const float*)d_in[19];
    p.out = (float*)d_out; p.ws = (char*)d_ws;
    void* args[] = {&p};
    hipError_t e = hipLaunchCooperativeKernel((const void*)hybrid_fwd, dim3(grid_blocks), dim3(512), args, LDS_BYTES, stream);
    if (e != hipSuccess) fprintf(stderr, "kernel_launch: cooperative launch failed: %s (grid %d)\n", hipGetErrorString(e), grid_blocks);
}
```

```cpp
#include <hip/hip_runtime.h>
#include <cstdio>
#include <cstdint>
#include <hip/hip_cooperative_groups.h>
namespace cg = cooperative_groups;


namespace op {
#define DI __device__ __forceinline__
typedef unsigned short bf16_t;
typedef short bf16x8 __attribute__((ext_vector_type(8)));
typedef float f32x16 __attribute__((ext_vector_type(16)));
typedef float f32x2 __attribute__((ext_vector_type(2)));
typedef unsigned u32x4 __attribute__((ext_vector_type(4)));
typedef unsigned u32x2 __attribute__((ext_vector_type(2)));
typedef __bf16 bf16v2 __attribute__((ext_vector_type(2)));
constexpr int D = 1024, NB = 8, S = 4096, DEPTH = 4, T = NB * S, NTILE = T / 128;
constexpr float EPS = 1e-6f;
constexpr int PL_SEID = 0, PL_SWGT = 32768, PL_END = 98304, PL_RIDX = 98304;
constexpr int LDS_EPI = 32768, LDS_SSQ = 102400, LDS_RSTD1 = 110592, LDS_BIAS = 112 * 1024, LDS_BYTES = 116 * 1024;
constexpr int REP_GEMM = 1, REP_ROUTE = 1, REP_MIX = 1, REP_NORM = 1, REP_P0 = 1;
#define MFMA32(a, b, c) __builtin_amdgcn_mfma_f32_32x32x16_bf16((a), (b), (c), 0, 0, 0)

DI unsigned pk2(float lo, float hi) { f32x2 v = {lo, hi}; return __builtin_bit_cast(unsigned, __builtin_convertvector(v, bf16v2)); }
DI int opaque_v(int x) { asm volatile("" : "+v"(x)); return x; }
DI int opaque_s(int x) { asm volatile("" : "+s"(x)); return x; }
DI int crow(int reg, int hh) { return (reg & 3) + 8 * (reg >> 2) + 4 * hh; }
DI float wave_sum(float v) {
#pragma unroll
    for (int o = 1; o < 64; o <<= 1) v += __shfl_xor(v, o);
    return v;
}

DI int col_perm(int npos, int mode) {
    if (mode == 1 && npos >= 1024 && npos < 1536) { const int q = npos - 1024, w = q >> 6, nb = (q >> 5) & 1, r = q & 31; return (nb ? 1280 : 1024) + 32 * w + r; }
    return npos;
}
DI void conv_wfrag_item(const float* __restrict__ W, int N, int KB, bf16_t* __restrict__ WF, int gid, int mode) {
    const int l = gid & 63, kb = (gid >> 6) % KB, nbt = (gid >> 6) / KB, r = l & 31, hh = l >> 5;
    const int n = col_perm(nbt * 32 + r, mode);
    const float* p = W + (size_t)(kb * 16 + 8 * hh) * N + n;
    float v[8];
#pragma unroll
    for (int j = 0; j < 8; ++j) v[j] = p[(size_t)j * N];
    u32x4 o; o.x = pk2(v[0], v[1]); o.y = pk2(v[2], v[3]); o.z = pk2(v[4], v[5]); o.w = pk2(v[6], v[7]);
    *(u32x4*)(WF + (size_t)gid * 8) = o;
}

DI void norm_to_frag(const float* __restrict__ x, const float* __restrict__ g, const float* __restrict__ sh, const float* __restrict__ sc, bf16_t* __restrict__ hA, float* rstd_lds, int tile, int tid, bool have_rstd) {
    tid = opaque_v(tid); tile = opaque_s(tile);
    const int w = tid >> 6, lane = tid & 63;
    float cg[16], cs[16], ch[16];
#pragma unroll
    for (int j = 0; j < 2; ++j)
#pragma unroll
        for (int q = 0; q < 2; ++q) {
            const int c = 512 * j + 8 * lane + 4 * q;
            const float4 a = *(const float4*)(g + c), b = *(const float4*)(sc + c), d = *(const float4*)(sh + c);
            cg[8 * j + 4 * q] = a.x * (1.f + b.x); cg[8 * j + 4 * q + 1] = a.y * (1.f + b.y); cg[8 * j + 4 * q + 2] = a.z * (1.f + b.z); cg[8 * j + 4 * q + 3] = a.w * (1.f + b.w);
            ch[8 * j + 4 * q] = d.x; ch[8 * j + 4 * q + 1] = d.y; ch[8 * j + 4 * q + 2] = d.z; ch[8 * j + 4 * q + 3] = d.w;
            cs[8 * j + 4 * q] = 0.f; cs[8 * j + 4 * q + 1] = 0.f; cs[8 * j + 4 * q + 2] = 0.f; cs[8 * j + 4 * q + 3] = 0.f;
        }
    (void)cs;
#pragma unroll 4
    for (int rr = 0; rr < 16; ++rr) {
        const int row = w * 16 + rr;
        const float* xr = x + ((size_t)tile * 128 + row) * D + 8 * lane;
        float v[16];
#pragma unroll
        for (int j = 0; j < 2; ++j)
#pragma unroll
            for (int q = 0; q < 2; ++q) { const float4 a = *(const float4*)(xr + 512 * j + 4 * q); v[8 * j + 4 * q] = a.x; v[8 * j + 4 * q + 1] = a.y; v[8 * j + 4 * q + 2] = a.z; v[8 * j + 4 * q + 3] = a.w; }
        float r;
        if (have_rstd) r = rstd_lds[row];
        else {
            float ss = 0.f;
#pragma unroll
            for (int e = 0; e < 16; ++e) ss += v[e] * v[e];
            r = rsqrtf(wave_sum(ss) * (1.f / D) + EPS);
        }
        bf16_t* orow = hA + ((size_t)tile * 128 + row) * D + 8 * lane;
#pragma unroll
        for (int j = 0; j < 2; ++j) {
            u32x4 o;
            o.x = pk2(v[8 * j] * r * cg[8 * j] + ch[8 * j], v[8 * j + 1] * r * cg[8 * j + 1] + ch[8 * j + 1]);
            o.y = pk2(v[8 * j + 2] * r * cg[8 * j + 2] + ch[8 * j + 2], v[8 * j + 3] * r * cg[8 * j + 3] + ch[8 * j + 3]);
            o.z = pk2(v[8 * j + 4] * r * cg[8 * j + 4] + ch[8 * j + 4], v[8 * j + 5] * r * cg[8 * j + 5] + ch[8 * j + 5]);
            o.w = pk2(v[8 * j + 6] * r * cg[8 * j + 6] + ch[8 * j + 6], v[8 * j + 7] * r * cg[8 * j + 7] + ch[8 * j + 7]);
            *(u32x4*)(orow + 512 * j) = o;
        }
    }
}

template <int ORIENT>
DI void kloop(f32x16 (&acc)[4][2], const bf16_t* __restrict__ At, const bf16_t* __restrict__ W0, const bf16_t* __restrict__ W1, char* lds, int tid, int lane) {
    tid = opaque_v(tid); lane = opaque_v(lane);
#pragma unroll
    for (int mb = 0; mb < 4; ++mb)
#pragma unroll
        for (int nb = 0; nb < 2; ++nb)
#pragma unroll
            for (int i = 0; i < 16; ++i) acc[mb][nb][i] = 0.f;
    {
    const int c8_ = (tid >> 3) & 7, rowA_ = (tid >> 6) * 8 + (tid & 7);
    const u32x4* Ag = (const u32x4*)(At + (unsigned)(rowA_ * 1024 + c8_ * 8));
    const int ldsA_ = ((((c8_ >> 1) * 4 + (rowA_ >> 5)) * 64) + (rowA_ & 31) + 32 * (c8_ & 1)) * 16;
    const u32x4* W0g = (const u32x4*)W0 + lane;
    const u32x4* W1g = (const u32x4*)W1 + lane;
    u32x4 wq[4][2], arA[2], arB[2];
    arA[0] = Ag[0]; arA[1] = Ag[8192]; arB[0] = Ag[8]; arB[1] = Ag[8 + 8192];
#pragma unroll
    for (int kk = 0; kk < 4; ++kk) { wq[kk][0] = W0g[kk * 64]; wq[kk][1] = W1g[kk * 64]; }
    *(u32x4*)(lds + ldsA_) = arA[0]; *(u32x4*)(lds + ldsA_ + 2048) = arA[1];
    __syncthreads();
#define KL_ITER(KC, ARL, ARS) do { \
        char* cur = lds + ((KC) & 1) * 16384; \
        char* nxt = lds + (((KC) + 1) & 1) * 16384; \
        const int kn = (KC) < 15 ? (KC) + 1 : 15, k2 = (KC) < 14 ? (KC) + 2 : 15; \
        if ((KC) < 14) { ARL[0] = Ag[k2 * 8]; ARL[1] = Ag[k2 * 8 + 8192]; } \
        __builtin_amdgcn_sched_barrier(0); \
        _Pragma("unroll") for (int kk = 0; kk < 4; ++kk) { \
            bf16x8 afr[4]; \
            _Pragma("unroll") for (int mb = 0; mb < 4; ++mb) afr[mb] = *(const bf16x8*)(cur + ((kk * 4 + mb) * 64 + lane) * 16); \
            _Pragma("unroll") for (int mb = 0; mb < 4; ++mb) \
                _Pragma("unroll") for (int nb = 0; nb < 2; ++nb) { \
                    const bf16x8 wf = __builtin_bit_cast(bf16x8, wq[kk][nb]); \
                    if (ORIENT == 0) acc[mb][nb] = MFMA32(afr[mb], wf, acc[mb][nb]); \
                    else acc[mb][nb] = MFMA32(wf, afr[mb], acc[mb][nb]); \
                } \
            if ((KC) < 15) { wq[kk][0] = W0g[(kn * 4 + kk) * 64]; wq[kk][1] = W1g[(kn * 4 + kk) * 64]; } \
            __builtin_amdgcn_sched_barrier(0); \
        } \
        if ((KC) < 15) { *(u32x4*)(nxt + ldsA_) = ARS[0]; *(u32x4*)(nxt + ldsA_ + 2048) = ARS[1]; } \
        __syncthreads(); \
    } while (0)
    for (int kc = 0; kc < 16; kc += 2) { KL_ITER(kc, arA, arB); KL_ITER(kc + 1, arB, arA); }
#undef KL_ITER
    }
}

DI void epi_f32row(const f32x16 (&acc)[4][2], float* __restrict__ C, int tile, int col0, int lane) {
    lane = opaque_v(lane);
    const int r5 = lane & 31, hh = lane >> 5;
    const unsigned boff = (unsigned)((tile * 128 + 4 * hh) * 2048 + col0 + r5);
#pragma unroll
    for (int mb = 0; mb < 4; ++mb)
#pragma unroll
        for (int nb = 0; nb < 2; ++nb)
#pragma unroll
            for (int i = 0; i < 16; ++i)
                C[boff + (unsigned)((mb * 32 + (i & 3) + 8 * (i >> 2)) * 2048 + nb * 32)] = acc[mb][nb][i];
}
DI void epi_resid(const f32x16 (&acc)[4][2], const float* __restrict__ xin, float* __restrict__ xout, const float* __restrict__ gate_b, float* T  , float* ssq  , int tile, int col0, int lane) {
    lane = opaque_v(lane);
    const int r5 = lane & 31, hh = lane >> 5, rq = lane >> 4, c4 = (lane & 15) * 4;
    const float4 gv = *(const float4*)(gate_b + col0 + c4);
#pragma unroll
    for (int mb = 0; mb < 4; ++mb) {
#pragma unroll
        for (int nb = 0; nb < 2; ++nb)
#pragma unroll
            for (int i = 0; i < 16; ++i) T[((i & 3) + 8 * (i >> 2) + 4 * hh) * 68 + nb * 32 + r5] = acc[mb][nb][i];
        asm volatile("s_waitcnt lgkmcnt(0)" ::: "memory");
#pragma unroll
        for (int j = 0; j < 8; ++j) {
            const int row = rq + 4 * j;
            const float4 v = *(const float4*)(T + row * 68 + c4);
            const unsigned o = (unsigned)((tile * 128 + mb * 32 + row) * D + col0 + c4);
            float4 xv = *(const float4*)(xin + o);
            xv.x += gv.x * v.x; xv.y += gv.y * v.y; xv.z += gv.z * v.z; xv.w += gv.w * v.w;
            *(float4*)(xout + o) = xv;
            float ss = xv.x * xv.x + xv.y * xv.y + xv.z * xv.z + xv.w * xv.w;
            ss += __shfl_xor(ss, 1); ss += __shfl_xor(ss, 2); ss += __shfl_xor(ss, 4); ss += __shfl_xor(ss, 8);
            if ((lane & 15) == 0) ssq[mb * 32 + row] = ss;
        }
        asm volatile("s_waitcnt lgkmcnt(0)" ::: "memory");
    }
}

DI void epi_qpf(const f32x16 (&acc)[4][2], bf16_t* __restrict__ QPF, int tile, int ft0, int lane) {
    lane = opaque_v(lane);
#pragma unroll
    for (int nb = 0; nb < 2; ++nb)
#pragma unroll
        for (int s = 0; s < 2; ++s)
#pragma unroll
            for (int mb = 0; mb < 4; ++mb) {
                const f32x16& a = acc[mb][nb];
                u32x4 o; o.x = pk2(a[8 * s], a[8 * s + 1]); o.y = pk2(a[8 * s + 2], a[8 * s + 3]); o.z = pk2(a[8 * s + 4], a[8 * s + 5]); o.w = pk2(a[8 * s + 6], a[8 * s + 7]);
                *(u32x4*)(QPF + ((unsigned)((((tile * 64 + ft0 + nb) * 2 + s) * 4 + mb) * 64 + lane)) * 8) = o;
            }
}

DI void conv_keys_item(const float* __restrict__ K, bf16_t* __restrict__ KF, int gid) {
    const int lane = gid & 63, s = (gid >> 6) & 1, nbl = (gid >> 7) & 3, nt = (gid >> 9) & 3, hp = gid >> 11;
    const int r = lane & 31, hh = lane >> 5;
    const float* p = K + ((size_t)hp * 128 + nt * 32 + r) * 128 + nbl * 32 + 16 * s + 4 * hh;
    const float4 a = *(const float4*)p, b = *(const float4*)(p + 8);
    u32x4 o; o.x = pk2(a.x, a.y); o.y = pk2(a.z, a.w); o.z = pk2(b.x, b.y); o.w = pk2(b.z, b.w);
    *(u32x4*)(KF + (size_t)gid * 8) = o;
}

DI void conv_table_row(const float* __restrict__ src, unsigned char* __restrict__ dst, float* __restrict__ sc, int lane, bool as_int4) {
    const float4* p = (const float4*)src + lane * 4;
    float4 v[4];
    float m = 0.f;
#pragma unroll
    for (int j = 0; j < 4; ++j) { v[j] = p[j]; m = fmaxf(m, fmaxf(fmaxf(fabsf(v[j].x), fabsf(v[j].y)), fmaxf(fabsf(v[j].z), fabsf(v[j].w)))); }
#pragma unroll
    for (int o = 1; o < 64; o <<= 1) m = fmaxf(m, __shfl_xor(m, o));
    float scale = m > 0.f ? m * (1.f / 6.f) : 1.f;
    if (as_int4) {
        float ss = 0.f;
#pragma unroll
        for (int j = 0; j < 4; ++j) ss += v[j].x * v[j].x + v[j].y * v[j].y + v[j].z * v[j].z + v[j].w * v[j].w;
        ss = wave_sum(ss);
        const float sg = sqrtf(ss * (1.f / 1024.f));
        scale = fmaxf(sg * (1.f / 2.8f), m * (1.f / 16.f));
        if (!(scale > 0.f)) scale = 1.f;
    }
    const float inv = 1.f / scale;
    u32x2 o;
    unsigned* op = (unsigned*)&o;
#pragma unroll
    for (int j = 0; j < 2; ++j) {
        const float f[8] = {v[2 * j].x, v[2 * j].y, v[2 * j].z, v[2 * j].w, v[2 * j + 1].x, v[2 * j + 1].y, v[2 * j + 1].z, v[2 * j + 1].w};
        unsigned wv = 0;
        if (as_int4) {
#pragma unroll
            for (int e = 0; e < 8; ++e) { int q = __float2int_rn(f[e] * inv); q = q < -7 ? -7 : (q > 7 ? 7 : q); wv |= ((unsigned)q & 15u) << (4 * e); }
        } else {
            wv = __builtin_amdgcn_cvt_scalef32_pk_fp4_f32(wv, f[0] * inv, f[1] * inv, 1.0f, 0);
            wv = __builtin_amdgcn_cvt_scalef32_pk_fp4_f32(wv, f[2] * inv, f[3] * inv, 1.0f, 1);
            wv = __builtin_amdgcn_cvt_scalef32_pk_fp4_f32(wv, f[4] * inv, f[5] * inv, 1.0f, 2);
            wv = __builtin_amdgcn_cvt_scalef32_pk_fp4_f32(wv, f[6] * inv, f[7] * inv, 1.0f, 3);
        }
        op[j] = wv;
    }
    *(u32x2*)(dst + lane * 8) = o;
    if (lane == 0) *sc = scale;
}

DI void ce_desc(int& a, int& b) { const int mx = a > b ? a : b, mn = a > b ? b : a; a = mx; b = mn; }
DI void sort16_desc(int (&v)[16]) {
#pragma unroll
    for (int k = 2; k <= 16; k <<= 1)
#pragma unroll
        for (int j = k >> 1; j > 0; j >>= 1)
#pragma unroll
            for (int i = 0; i < 16; ++i) {
                const int l = i ^ j;
                if (l > i) { if ((i & k) == 0) ce_desc(v[i], v[l]); else ce_desc(v[l], v[i]); }
            }
}
DI void bitonic_merge16_desc(int (&v)[16]) {
#pragma unroll
    for (int j = 8; j > 0; j >>= 1)
#pragma unroll
        for (int i = 0; i < 16; ++i) { const int l = i ^ j; if (l > i) ce_desc(v[i], v[l]); }
}
DI void merge_top16(int (&a)[16], const int (&b)[16]) {
#pragma unroll
    for (int i = 0; i < 16; ++i) a[i] = a[i] > b[15 - i] ? a[i] : b[15 - i];
    bitonic_merge16_desc(a);
}
DI int f2ord(float f) { int b = __float_as_int(f); return b ^ ((b >> 31) & 0x7fffffff); }
DI float ord2f(int k) { return __int_as_float(k ^ ((k >> 31) & 0x7fffffff)); }

DI void route_tile(const bf16_t* __restrict__ QPF, const bf16_t* __restrict__ KF, char* lds_lists, unsigned char* lds_idx  , int tile, int tid) {
    tid = opaque_v(tid); tile = opaque_s(tile);
    const int lane = tid & 63, w = __builtin_amdgcn_readfirstlane(tid >> 6);
    const int r5 = lane & 31, hh = lane >> 5;
    unsigned char* myidx = lds_idx + w * 1024;
    for (int task = w; task < 32; task += 8) {
        const int h = task >> 2, tt = task & 3;
        f32x16 acc[2][4];
#pragma unroll
        for (int p = 0; p < 2; ++p)
#pragma unroll
            for (int nt = 0; nt < 4; ++nt)
#pragma unroll
                for (int i = 0; i < 16; ++i) acc[p][nt][i] = 0.f;
        {
            bf16x8 bq[3], ak[3][4];
#define ROUTE_LOAD(buf, step) do { const int p_ = (step) >> 3, ks_ = (step) & 7; \
                bq[buf] = *(const bf16x8*)(QPF + ((unsigned)((((tile * 64 + h * 8 + p_ * 4 + (ks_ >> 1)) * 2 + (ks_ & 1)) * 4 + tt) * 64 + lane)) * 8); \
                _Pragma("unroll") for (int nt = 0; nt < 4; ++nt) ak[buf][nt] = *(const bf16x8*)(KF + ((unsigned)(((((h * 2 + p_) * 4 + nt) * 8 + ks_) * 64) + lane)) * 8); } while (0)
            ROUTE_LOAD(0, 0);
            ROUTE_LOAD(1, 1);
#pragma unroll
            for (int step = 0; step < 16; ++step) {
                if (step < 14) ROUTE_LOAD((step + 2) % 3, step + 2);
#pragma unroll
                for (int nt = 0; nt < 4; ++nt) acc[step >> 3][nt] = MFMA32(ak[step % 3][nt], bq[step % 3], acc[step >> 3][nt]);
                __builtin_amdgcn_sched_barrier(0);
            }
#undef ROUTE_LOAD
        }
        int g[8][16];
#pragma unroll
        for (int nt = 0; nt < 4; ++nt)
#pragma unroll
            for (int i = 0; i < 16; ++i) {
                const unsigned a = __float_as_uint(acc[0][nt][i]), b = __float_as_uint(acc[1][nt][i]);
                auto sw = __builtin_amdgcn_permlane32_swap(a, b, false, false);
                const int n0 = nt * 32 + (i & 3) + 8 * (i >> 2);
                g[nt * 2 + (i >> 3)][i & 7] = (f2ord(__uint_as_float(sw[0])) & ~127) | n0;
                g[nt * 2 + (i >> 3)][8 + (i & 7)] = (f2ord(__uint_as_float(sw[1])) & ~127) | (n0 + 4);
            }
#pragma unroll
        for (int q = 0; q < 8; ++q) sort16_desc(g[q]);
        merge_top16(g[0], g[1]); merge_top16(g[2], g[3]); merge_top16(g[4], g[5]); merge_top16(g[6], g[7]);
        merge_top16(g[0], g[2]); merge_top16(g[4], g[6]);
        merge_top16(g[0], g[4]);
        {
            u32x4 pk;
            unsigned* pp = (unsigned*)&pk;
#pragma unroll
            for (int q = 0; q < 4; ++q) pp[q] = (unsigned)(g[0][4 * q] & 127) | ((unsigned)(g[0][4 * q + 1] & 127) << 8) | ((unsigned)(g[0][4 * q + 2] & 127) << 16) | ((unsigned)(g[0][4 * q + 3] & 127) << 24);
            *(u32x4*)(myidx + lane * 16) = pk;
        }
        float f0[16], f1[16];
#pragma unroll
        for (int i = 0; i < 16; ++i) {
            const unsigned a = (unsigned)g[0][i], b = a;
            auto sw = __builtin_amdgcn_permlane32_swap(a, b, false, false);
            f0[i] = ord2f((int)sw[0] & ~127); f1[i] = ord2f((int)sw[1] & ~127);
        }
        int c0[16], c1[16], c2[16], c3[16];
#pragma unroll
        for (int j = 0; j < 16; ++j) c0[j] = (f2ord(f0[0] + f1[j]) & ~255) | j;
#pragma unroll
        for (int i = 1; i < 16; ++i) c1[i - 1] = (f2ord(f0[i] + f1[0]) & ~255) | (i << 4);
        c1[15] = (int)0x80000000;
#define CK(i, j) ((f2ord(f0[i] + f1[j]) & ~255) | ((i) << 4) | (j))
        c2[0] = CK(1, 1); c2[1] = CK(1, 2); c2[2] = CK(1, 3); c2[3] = CK(1, 4); c2[4] = CK(1, 5); c2[5] = CK(1, 6); c2[6] = CK(1, 7);
        c2[7] = CK(2, 1); c2[8] = CK(2, 2); c2[9] = CK(2, 3); c2[10] = CK(2, 4);
        c2[11] = CK(3, 1); c2[12] = CK(3, 2); c2[13] = CK(3, 3);
        c2[14] = CK(4, 1); c2[15] = CK(4, 2);
        c3[0] = CK(5, 1); c3[1] = CK(6, 1); c3[2] = CK(7, 1);
#undef CK
#pragma unroll
        for (int q = 3; q < 16; ++q) c3[q] = (int)0x80000000;
        sort16_desc(c2);
        ce_desc(c3[0], c3[1]); ce_desc(c3[1], c3[2]); ce_desc(c3[0], c3[1]);
        merge_top16(c0, c1); merge_top16(c2, c3); merge_top16(c0, c2);
        float bs[16], den = 0.f;
#pragma unroll
        for (int i = 0; i < 16; ++i) { bs[i] = __expf(ord2f(c0[i] & ~255) - ord2f(c0[0] & ~255)); den += bs[i]; }
        const float rden = 1.f / den;
        asm volatile("s_waitcnt lgkmcnt(0)" ::: "memory");
#pragma unroll
        for (int q = 0; q < 8; ++q) {
            const int key = (int)__builtin_amdgcn_permlane32_swap((unsigned)c0[q], (unsigned)c0[8 + q], false, false)[0];
            const float gv = __uint_as_float(__builtin_amdgcn_permlane32_swap(__float_as_uint(bs[q]), __float_as_uint(bs[8 + q]), false, false)[0]) * rden;
            const int i = (key >> 4) & 15, j = key & 15;
            const int e = (int)myidx[r5 * 16 + i] * 128 + (int)myidx[(32 + r5) * 16 + j];
            const int tokl = tt * 32 + r5;
            ((unsigned short*)(lds_lists + PL_SEID))[tokl * 128 + h * 16 + 8 * hh + q] = (unsigned short)e;
            ((float*)(lds_lists + PL_SWGT))[tokl * 128 + h * 16 + 8 * hh + q] = gv;
        }
        asm volatile("s_waitcnt lgkmcnt(0)" ::: "memory");
    }
}

DI void unpack_h2(const bf16_t* __restrict__ hA, int t, int lane, f32x2 (&hv)[8]) {
    const int tile = t >> 7, row = t & 127, mb = row >> 5, r5 = row & 31;
    const bf16_t* hp = hA + ((unsigned)(((tile * 64 + lane) * 4 + mb) * 64 + r5)) * 8;
    const u32x4 ha = *(const u32x4*)hp, hb = *(const u32x4*)(hp + 32 * 8);
    const unsigned hw[8] = {ha.x, ha.y, ha.z, ha.w, hb.x, hb.y, hb.z, hb.w};
#pragma unroll
    for (int q = 0; q < 8; ++q) { hv[q].x = __uint_as_float(hw[q] << 16); hv[q].y = __uint_as_float(hw[q] & 0xffff0000u); }
}
typedef _Float16 h16x2 __attribute__((ext_vector_type(2)));
DI h16x2 fp4h(unsigned w, int sel) {
    return sel == 0 ? __builtin_amdgcn_cvt_scalef32_pk_f16_fp4(w, 1.0f, 0) : sel == 1 ? __builtin_amdgcn_cvt_scalef32_pk_f16_fp4(w, 1.0f, 1)
         : sel == 2 ? __builtin_amdgcn_cvt_scalef32_pk_f16_fp4(w, 1.0f, 2) : __builtin_amdgcn_cvt_scalef32_pk_f16_fp4(w, 1.0f, 3);
}
DI void stage_token(const int* __restrict__ ridx, const float* __restrict__ rgate, char* lds, int t, int tloc, int lane) {
    lane = opaque_v(lane); t = opaque_s(t);
    unsigned short* seid = (unsigned short*)(lds + PL_SEID) + tloc * 128;
    float* swgt = (float*)(lds + PL_SWGT) + tloc * 128;
    seid[lane] = (unsigned short)ridx[(unsigned)(t * 128 + lane)]; seid[64 + lane] = (unsigned short)ridx[(unsigned)(t * 128 + 64 + lane)];
    swgt[lane] = rgate[(unsigned)(t * 128 + lane)]; swgt[64 + lane] = rgate[(unsigned)(t * 128 + 64 + lane)];
}
DI void peer_down_wave(const bf16_t* __restrict__ hA, char* lds, const unsigned char* __restrict__ TBd, const float* __restrict__ SC, int tile, int w, int lane) {
    lane = opaque_v(lane);
    const int myu = ((lane >> 5) & 1) * 8 + ((lane >> 4) & 1) * 4 + ((lane >> 3) & 1) * 2 + ((lane >> 2) & 1);
    const unsigned short* seid = (const unsigned short*)(lds + PL_SEID) + w * 16 * 128;
    float* swgt = (float*)(lds + PL_SWGT) + w * 16 * 128;
    u32x4 haN, hbN;
    int ev0N, ev1N;
    { const bf16_t* hp0 = hA + (unsigned)((tile * 128 + w * 16) * 1024 + lane * 16); haN = *(const u32x4*)hp0; hbN = *(const u32x4*)(hp0 + 8); ev0N = seid[lane]; ev1N = seid[64 + lane]; }
    u32x2 R[2][16];
    f32x2 scv[2];
#define DOWN_ISSUE(buf, EV, base) do { _Pragma("unroll") for (int u_ = 0; u_ < 16; ++u_) { const int e_ = __builtin_amdgcn_readlane(EV, (base) + u_); \
        R[buf][u_] = *(const u32x2*)(TBd + (size_t)(unsigned)e_ * 512 + lane * 8); } \
        scv[buf] = *(const f32x2*)(SC + (unsigned)__shfl(EV, (base) + myu) * 2); } while (0)
    DOWN_ISSUE(0, ev0N, 0);
#pragma unroll 1
    for (int tl = 0; tl < 16; ++tl) {
        const int t = tile * 128 + w * 16 + tl;
        float* gp = swgt + tl * 128;
        const u32x4 ha = haN, hb = hbN;
        const int ev0 = ev0N, ev1 = ev1N;
        {
            const int tn = tl < 15 ? tl + 1 : tl;
            const bf16_t* hp = hA + (unsigned)((t - tl + tn) * 1024 + lane * 16); haN = *(const u32x4*)hp; hbN = *(const u32x4*)(hp + 8);
            ev0N = seid[tn * 128 + lane]; ev1N = seid[tn * 128 + 64 + lane];
        }
        unsigned hhi[2], hlo[2];
        float hscale;
        {
            const unsigned hw[8] = {ha.x, ha.y, ha.z, ha.w, hb.x, hb.y, hb.z, hb.w};
            float hf[16];
            float m = 0.f;
#pragma unroll
            for (int q = 0; q < 8; ++q) { hf[2 * q] = __uint_as_float(hw[q] << 16); hf[2 * q + 1] = __uint_as_float(hw[q] & 0xffff0000u); m = fmaxf(m, fmaxf(fabsf(hf[2 * q]), fabsf(hf[2 * q + 1]))); }
#pragma unroll
            for (int o = 1; o < 64; o <<= 1) m = fmaxf(m, __shfl_xor(m, o));
            hscale = m > 0.f ? m * (1.f / 119.f) : 1.f;
            const float inv = 1.f / hscale;
            hhi[0] = hhi[1] = hlo[0] = hlo[1] = 0u;
#pragma unroll
            for (int e = 0; e < 16; ++e) {
                const int hq = __float2int_rn(hf[e] * inv);
                const int lo = ((hq + 8) & 15) - 8, hi = (hq - lo) >> 4;
                hlo[e >> 3] |= ((unsigned)lo & 15u) << (4 * (e & 7));
                hhi[e >> 3] |= ((unsigned)hi & 15u) << (4 * (e & 7));
            }
        }
#pragma unroll
        for (int bt = 0; bt < 8; ++bt) {
            const int cur = bt & 1, nxt = cur ^ 1;
            if (bt < 3) DOWN_ISSUE(nxt, ev0, (bt + 1) * 16);
            else if (bt == 3) DOWN_ISSUE(nxt, ev1, 0);
            else if (bt < 7) DOWN_ISSUE(nxt, ev1, (bt - 3) * 16);
            else DOWN_ISSUE(nxt, ev0N, 0);
            __builtin_amdgcn_sched_barrier(0);
            int part[16];
#pragma unroll
            for (int u = 0; u < 16; ++u) {
                int shi = __builtin_amdgcn_sdot8((int)R[cur][u].x, (int)hhi[0], 0, false);
                shi = __builtin_amdgcn_sdot8((int)R[cur][u].y, (int)hhi[1], shi, false);
                int slo = __builtin_amdgcn_sdot8((int)R[cur][u].x, (int)hlo[0], 0, false);
                slo = __builtin_amdgcn_sdot8((int)R[cur][u].y, (int)hlo[1], slo, false);
                part[u] = shi * 16 + slo;
            }
            int r8[8], r4[4], r2[2], r1;
            {
                const bool b5 = (lane & 32) != 0, b4 = (lane & 16) != 0, b3 = (lane & 8) != 0, b2 = (lane & 4) != 0;
#pragma unroll
                for (int q = 0; q < 8; ++q) { const int keep = b5 ? part[q + 8] : part[q], give = b5 ? part[q] : part[q + 8]; r8[q] = keep + __shfl_xor(give, 32); }
#pragma unroll
                for (int q = 0; q < 4; ++q) { const int keep = b4 ? r8[q + 4] : r8[q], give = b4 ? r8[q] : r8[q + 4]; r4[q] = keep + __shfl_xor(give, 16); }
#pragma unroll
                for (int q = 0; q < 2; ++q) { const int keep = b3 ? r4[q + 2] : r4[q], give = b3 ? r4[q] : r4[q + 2]; r2[q] = keep + __shfl_xor(give, 8); }
                { const int keep = b2 ? r2[1] : r2[0], give = b2 ? r2[0] : r2[1]; r1 = keep + __shfl_xor(give, 4); }
                r1 += __shfl_xor(r1, 2); r1 += __shfl_xor(r1, 1);
            }
            if ((lane & 3) == 0) {
                const float a = (float)r1 * (scv[cur].x * hscale);
                gp[bt * 16 + myu] = gp[bt * 16 + myu] * (0.5f * a * (1.f + erff(a * 0.70710678118654752f))) * scv[cur].y;
            }
        }
    }
#undef DOWN_ISSUE
}
DI void peer_up_wave(char* lds, const unsigned char* __restrict__ TBu, const float* __restrict__ g2b, float* __restrict__ x, int tile, int w, int lane) {
    lane = opaque_v(lane);
    const unsigned short* seid = (const unsigned short*)(lds + PL_SEID) + w * 16 * 128;
    const float* swgt = (const float*)(lds + PL_SWGT) + w * 16 * 128;
    u32x2 RA[16], RB[16];
#define UP_ISSUE(R, EV, base) do { _Pragma("unroll") for (int u_ = 0; u_ < 16; ++u_) { const int e_ = __builtin_amdgcn_readlane(EV, (base) + u_); \
        R[u_] = *(const u32x2*)(TBu + (size_t)(unsigned)e_ * 512 + lane * 8); } } while (0)
#define UP_COMPUTE(R, WL, base, K) do { _Pragma("unroll") for (int u_ = 0; u_ < 16; ++u_) { \
        const _Float16 wh_ = (_Float16)__int_as_float(__builtin_amdgcn_readlane(__float_as_int(WL), (base) + u_)); const h16x2 w2_ = (h16x2){wh_, wh_}; \
        _Pragma("unroll") for (int q_ = 0; q_ < 4; ++q_) { acc[K][q_] = __builtin_elementwise_fma(w2_, fp4h(R[u_].x, q_), acc[K][q_]); acc[K][4 + q_] = __builtin_elementwise_fma(w2_, fp4h(R[u_].y, q_), acc[K][4 + q_]); } } } while (0)
    int ev0N = seid[lane], ev1N = seid[64 + lane];
    float wl0N = swgt[lane], wl1N = swgt[64 + lane];
    UP_ISSUE(RA, ev0N, 0);
    for (int r = 0; r < 2; ++r) {
        h16x2 acc[8][8];
#pragma unroll
        for (int k = 0; k < 8; ++k)
#pragma unroll
            for (int q = 0; q < 8; ++q) acc[k][q] = (h16x2){(_Float16)0.f, (_Float16)0.f};
#pragma unroll
        for (int k = 0; k < 8; ++k) {
            const int ev0 = ev0N, ev1 = ev1N;
            const float wl0 = wl0N, wl1 = wl1N;
            {
                const int tn = (r * 8 + k < 15) ? r * 8 + k + 1 : 15;
                ev0N = seid[tn * 128 + lane]; ev1N = seid[tn * 128 + 64 + lane]; wl0N = swgt[tn * 128 + lane]; wl1N = swgt[tn * 128 + 64 + lane];
            }
#pragma unroll 1
            for (int i = 0; i < 4; ++i) {
                const int evS = i < 2 ? ev0 : ev1;
                const float wlS = i < 2 ? wl0 : wl1;
                const int base = (i & 1) * 32;
                UP_ISSUE(RB, evS, base + 16);
                __builtin_amdgcn_sched_barrier(0);
                UP_COMPUTE(RA, wlS, base, k);
                const int evT = i < 3 ? (i < 1 ? ev0 : ev1) : ev0N;
                const int baseT = i < 3 ? ((i + 1) & 1) * 32 : 0;
                UP_ISSUE(RA, evT, baseT);
                __builtin_amdgcn_sched_barrier(0);
                UP_COMPUTE(RB, wlS, base + 16, k);
            }
        }
#pragma unroll
        for (int k = 0; k < 8; ++k) {
            const int t = tile * 128 + w * 16 + r * 8 + k;
            float4* xp = (float4*)(x + (size_t)t * D + lane * 16);
            const float4* gq = (const float4*)(g2b + lane * 16);
            float ssx = 0.f;
#pragma unroll
            for (int q = 0; q < 4; ++q) {
                float4 xv = xp[q]; const float4 gv = gq[q];
                xv.x += gv.x * (float)acc[k][2 * q].x; xv.y += gv.y * (float)acc[k][2 * q].y; xv.z += gv.z * (float)acc[k][2 * q + 1].x; xv.w += gv.w * (float)acc[k][2 * q + 1].y;
                xp[q] = xv;
                ssx += xv.x * xv.x + xv.y * xv.y + xv.z * xv.z + xv.w * xv.w;
            }
            ssx = wave_sum(ssx);
            if (lane == 0) ((float*)(lds + LDS_RSTD1))[w * 16 + r * 8 + k] = rsqrtf(ssx * (1.f / D) + EPS);
        }
    }
#undef UP_ISSUE
#undef UP_COMPUTE
}

DI void epi_qk(f32x16 (&acc)[4][2], const float* __restrict__ gain, float scale, bf16_t* __restrict__ dst, int lane) {
    lane = opaque_v(lane);
    const int hh = lane >> 5;
    float gv[2][16];
#pragma unroll
    for (int nb = 0; nb < 2; ++nb)
#pragma unroll
        for (int i = 0; i < 16; ++i) gv[nb][i] = gain[nb * 32 + (i & 3) + 8 * (i >> 2) + 4 * hh] * scale;
#pragma unroll
    for (int mb = 0; mb < 4; ++mb) {
        float ss = 0.f;
#pragma unroll
        for (int nb = 0; nb < 2; ++nb)
#pragma unroll
            for (int i = 0; i < 16; ++i) ss += acc[mb][nb][i] * acc[mb][nb][i];
        ss += __shfl_xor(ss, 32);
        const float r = rsqrtf(ss * (1.f / 64.f) + EPS);
#pragma unroll
        for (int nb = 0; nb < 2; ++nb)
#pragma unroll
            for (int s = 0; s < 2; ++s) {
                const f32x16& a = acc[mb][nb];
                u32x4 o;
                o.x = pk2(a[8 * s] * r * gv[nb][8 * s], a[8 * s + 1] * r * gv[nb][8 * s + 1]);
                o.y = pk2(a[8 * s + 2] * r * gv[nb][8 * s + 2], a[8 * s + 3] * r * gv[nb][8 * s + 3]);
                o.z = pk2(a[8 * s + 4] * r * gv[nb][8 * s + 4], a[8 * s + 5] * r * gv[nb][8 * s + 5]);
                o.w = pk2(a[8 * s + 6] * r * gv[nb][8 * s + 6], a[8 * s + 7] * r * gv[nb][8 * s + 7]);
                *(u32x4*)(dst + ((unsigned)(((nb * 2 + s) * 4 + mb) * 64 + lane)) * 8) = o;
            }
    }
}
DI void epi_v(const f32x16 (&acc)[4][2], bf16_t* __restrict__ dst, int lane) {
    lane = opaque_v(lane);
#pragma unroll
    for (int nb = 0; nb < 2; ++nb)
#pragma unroll
        for (int mb = 0; mb < 4; ++mb)
#pragma unroll
            for (int s = 0; s < 2; ++s) {
                const f32x16& a = acc[mb][nb];
                u32x4 o; o.x = pk2(a[8 * s], a[8 * s + 1]); o.y = pk2(a[8 * s + 2], a[8 * s + 3]); o.z = pk2(a[8 * s + 4], a[8 * s + 5]); o.w = pk2(a[8 * s + 6], a[8 * s + 7]);
                *(u32x4*)(dst + ((unsigned)(((nb * 4 + mb) * 2 + s) * 64 + lane)) * 8) = o;
            }
}
DI void epi_row(const f32x16 (&acc)[4][2], bf16_t* __restrict__ dst, int ld, int lane) {
    lane = opaque_v(lane);
    const int r5 = lane & 31, hh = lane >> 5;
#pragma unroll
    for (int mb = 0; mb < 4; ++mb)
#pragma unroll
        for (int nb = 0; nb < 2; ++nb)
#pragma unroll
            for (int gq = 0; gq < 4; ++gq) {
                const f32x16& a = acc[mb][nb];
                u32x2 o; o.x = pk2(a[4 * gq], a[4 * gq + 1]); o.y = pk2(a[4 * gq + 2], a[4 * gq + 3]);
                *(u32x2*)(dst + (unsigned)((mb * 32 + r5) * ld + nb * 32 + 8 * gq + 4 * hh)) = o;
            }
}
DI void epi_z(const f32x16 (&acc)[4][2], bf16_t* __restrict__ dst, int lane) {
    lane = opaque_v(lane);
    const int r5 = lane & 31, hh = lane >> 5;
#pragma unroll
    for (int mb = 0; mb < 4; ++mb)
#pragma unroll
        for (int gq = 0; gq < 4; ++gq) {
            const f32x16 &a = acc[mb][0], &b = acc[mb][1];
            u32x2 o; o.x = pk2(a[4 * gq] * b[4 * gq], a[4 * gq + 1] * b[4 * gq + 1]); o.y = pk2(a[4 * gq + 2] * b[4 * gq + 2], a[4 * gq + 3] * b[4 * gq + 3]);
            *(u32x2*)(dst + (unsigned)((mb * 32 + r5) * 256 + 8 * gq + 4 * hh)) = o;
        }
}
DI void epi_su_park(const f32x16 (&acc)[4][2], unsigned* lds_su, int lane) {
    lane = opaque_v(lane);
#pragma unroll
    for (int mb = 0; mb < 4; ++mb)
#pragma unroll
        for (int nb = 0; nb < 2; ++nb)
#pragma unroll
            for (int q = 0; q < 8; ++q) lds_su[((mb * 2 + nb) * 8 + q) * 64 + lane] = pk2(acc[mb][nb][2 * q], acc[mb][nb][2 * q + 1]);
}
DI void epi_sv(f32x16 (&acc)[4][2], const bf16_t* __restrict__ SWF  , const float* __restrict__ bs_g, const unsigned* lds_su, bf16_t* __restrict__ dst, int lane) {
    lane = opaque_v(lane);
    const int r5 = lane & 31, hh = lane >> 5;
    bf16x8 vb[4][2][2];
#pragma unroll
    for (int mb = 0; mb < 4; ++mb) {
#pragma unroll
        for (int i = 0; i < 16; ++i) {
            float s1 = acc[mb][0][i] + acc[mb][1][i];
#pragma unroll
            for (int o = 1; o < 32; o <<= 1) s1 += __shfl_xor(s1, o);
            const float mu = s1 * (1.f / 64.f);
            const float d0 = acc[mb][0][i] - mu, d1 = acc[mb][1][i] - mu;
            float s2 = d0 * d0 + d1 * d1;
#pragma unroll
            for (int o = 1; o < 32; o <<= 1) s2 += __shfl_xor(s2, o);
            const float r = rsqrtf(s2 * (1.f / 64.f) + EPS);
            acc[mb][0][i] = d0 * r; acc[mb][1][i] = d1 * r;
        }
#pragma unroll
        for (int s = 0; s < 2; ++s)
#pragma unroll
            for (int nb = 0; nb < 2; ++nb) {
                const f32x16& a = acc[mb][nb];
                u32x4 o; o.x = pk2(a[8 * s], a[8 * s + 1]); o.y = pk2(a[8 * s + 2], a[8 * s + 3]); o.z = pk2(a[8 * s + 4], a[8 * s + 5]); o.w = pk2(a[8 * s + 6], a[8 * s + 7]);
                vb[mb][s][nb] = __builtin_bit_cast(bf16x8, o);
            }
    }
#pragma unroll
    for (int tb = 0; tb < 4; ++tb) {
        f32x16 y[2];
#pragma unroll
        for (int nb = 0; nb < 2; ++nb)
#pragma unroll
            for (int i = 0; i < 16; ++i) y[nb][i] = 0.f;
#pragma unroll
        for (int kt = 0; kt <= tb; ++kt)
#pragma unroll
            for (int s = 0; s < 2; ++s) {
                const bf16x8 wa = *(const bf16x8*)(SWF + ((unsigned)(((tb * 4 + kt) * 2 + s) * 64 + lane)) * 8);
                y[0] = MFMA32(wa, vb[kt][s][0], y[0]);
                y[1] = MFMA32(wa, vb[kt][s][1], y[1]);
            }
#pragma unroll
        for (int nb = 0; nb < 2; ++nb)
#pragma unroll
            for (int q = 0; q < 8; ++q) {
                const unsigned su2 = lds_su[((tb * 2 + nb) * 8 + q) * 64 + lane];
                const int i0 = 2 * q, i1 = 2 * q + 1;
                const int t0 = tb * 32 + (i0 & 3) + 8 * (i0 >> 2) + 4 * hh, t1 = tb * 32 + (i1 & 3) + 8 * (i1 >> 2) + 4 * hh;
                const float v0 = (y[nb][i0] + bs_g[t0]) * __uint_as_float(su2 << 16), v1 = (y[nb][i1] + bs_g[t1]) * __uint_as_float(su2 & 0xffff0000u);
                const unsigned pk = pk2(v0, v1);
                dst[(unsigned)(t0 * 256 + nb * 32 + r5)] = (bf16_t)(pk & 0xffffu);
                dst[(unsigned)(t1 * 256 + nb * 32 + r5)] = (bf16_t)(pk >> 16);
            }
    }
}

DI void conv_sguw_item(const float* __restrict__ W, bf16_t* __restrict__ SWF, int gid) {
    const int lane = gid & 63, s = (gid >> 6) & 1, kt = (gid >> 7) & 3, tb = (gid >> 9) & 3, g = gid >> 11;
    const int r = lane & 31, hh = lane >> 5, t = tb * 32 + r;
    const float* p = W + ((size_t)g * 128 + t) * 128;
    float v[8];
#pragma unroll
    for (int j = 0; j < 8; ++j) { const int sp = kt * 32 + 16 * s + 8 * (j >> 2) + 4 * hh + (j & 3); v[j] = sp <= t ? p[sp] : 0.f; }
    u32x4 o; o.x = pk2(v[0], v[1]); o.y = pk2(v[2], v[3]); o.z = pk2(v[4], v[5]); o.w = pk2(v[6], v[7]);
    *(u32x4*)(SWF + (size_t)gid * 8) = o;
}

DI int t5_bucket(int d) {
    if (d < 16) return d;
    const float lr = logf((float)d / 16.f) / logf(8.f);
    const int large = 16 + (int)(lr * 16.f);
    return large < 31 ? large : 31;
}

DI void attn_tile(const bf16_t* __restrict__ QF, const bf16_t* __restrict__ KF2, const bf16_t* __restrict__ VF, const float* bias_lds, const float* __restrict__ sink, bf16_t* __restrict__ OR, int tile, int tid) {
    tid = opaque_v(tid); tile = opaque_s(tile);
    const int lane = tid & 63, w = __builtin_amdgcn_readfirstlane(tid >> 6), r5 = lane & 31, hh = lane >> 5;
    const bool has_prev = (tile & 31) != 0;
    for (int task = w; task < 32; task += 8) {
        const int qh = task >> 2, qt = task & 3, kvh = qh >> 2;
        bf16x8 bq[4];
#pragma unroll
        for (int ks = 0; ks < 4; ++ks) bq[ks] = *(const bf16x8*)(QF + ((unsigned)((((tile * 8 + qh) * 4 + ks) * 4 + qt) * 64 + lane)) * 8);
        f32x16 sc[5];
#pragma unroll
        for (int grp = 0; grp < 2; ++grp) {
            bf16x8 kf[3][4];
#pragma unroll
            for (int jq = 0; jq < 3; ++jq) if (grp * 3 + jq < 5) {
                const int jj = grp * 3 + jq, j = qt + jj, st = (j >= 4 || !has_prev) ? tile : tile - 1, kt = j & 3;
#pragma unroll
                for (int ks = 0; ks < 4; ++ks) kf[jq][ks] = *(const bf16x8*)(KF2 + ((unsigned)((((st * 2 + kvh) * 4 + ks) * 4 + kt) * 64 + lane)) * 8);
            }
#pragma unroll
            for (int jq = 0; jq < 3; ++jq) if (grp * 3 + jq < 5) {
                const int jj = grp * 3 + jq;
#pragma unroll
                for (int i = 0; i < 16; ++i) sc[jj][i] = 0.f;
#pragma unroll
                for (int ks = 0; ks < 4; ++ks) sc[jj] = MFMA32(kf[jq][ks], bq[ks], sc[jj]);
            }
            __builtin_amdgcn_sched_barrier(0);
        }
        bf16x8 vf[5][2][2];
#pragma unroll
        for (int jj = 0; jj < 2; ++jj) {
            const int j = qt + jj, st = (j >= 4 || !has_prev) ? tile : tile - 1, kt = j & 3;
#pragma unroll
            for (int s2 = 0; s2 < 2; ++s2)
#pragma unroll
                for (int dt = 0; dt < 2; ++dt) vf[jj][s2][dt] = *(const bf16x8*)(VF + ((unsigned)(((((st * 2 + kvh) * 2 + dt) * 4 + kt) * 2 + s2) * 64 + lane)) * 8);
        }
        const float* bl = bias_lds + qh * 128;
        float m = -1e30f;
#pragma unroll
        for (int jj = 0; jj < 5; ++jj) {
            const bool ex = (qt + jj >= 4) || has_prev;
#pragma unroll
            for (int i = 0; i < 16; ++i) {
                const int cr = (i & 3) + 8 * (i >> 2) + 4 * hh;
                const int dist = 128 + r5 - 32 * jj - cr;
                const bool valid = ex && dist >= 0 && dist < 128;
                const float v = valid ? sc[jj][i] + bl[dist & 127] : -1e30f;
                sc[jj][i] = v; m = fmaxf(m, v);
            }
        }
        m = fmaxf(m, __shfl_xor(m, 32));
        const float sk = sink[qh];
        m = fmaxf(m, sk);
        float l = 0.f;
#pragma unroll
        for (int jj = 0; jj < 5; ++jj)
#pragma unroll
            for (int i = 0; i < 16; ++i) { const float p = __expf(sc[jj][i] - m); sc[jj][i] = p; l += p; }
        l += __shfl_xor(l, 32);
        l += __expf(sk - m);
        const float rl = 1.f / l;
        f32x16 o[2];
#pragma unroll
        for (int dt = 0; dt < 2; ++dt)
#pragma unroll
            for (int i = 0; i < 16; ++i) o[dt][i] = 0.f;
        __builtin_amdgcn_sched_barrier(0);
#pragma unroll
        for (int jj = 2; jj < 5; ++jj) {
            const int j = qt + jj, st = (j >= 4 || !has_prev) ? tile : tile - 1, kt = j & 3;
#pragma unroll
            for (int s2 = 0; s2 < 2; ++s2)
#pragma unroll
                for (int dt = 0; dt < 2; ++dt) vf[jj][s2][dt] = *(const bf16x8*)(VF + ((unsigned)(((((st * 2 + kvh) * 2 + dt) * 4 + kt) * 2 + s2) * 64 + lane)) * 8);
        }
#pragma unroll
        for (int jj = 0; jj < 5; ++jj) {
#pragma unroll
            for (int s = 0; s < 2; ++s) {
                const f32x16& a = sc[jj];
                u32x4 pp; pp.x = pk2(a[8 * s], a[8 * s + 1]); pp.y = pk2(a[8 * s + 2], a[8 * s + 3]); pp.z = pk2(a[8 * s + 4], a[8 * s + 5]); pp.w = pk2(a[8 * s + 6], a[8 * s + 7]);
                const bf16x8 pb = __builtin_bit_cast(bf16x8, pp);
#pragma unroll
                for (int dt = 0; dt < 2; ++dt) o[dt] = MFMA32(vf[jj][s][dt], pb, o[dt]);
            }
        }
        bf16_t* orow = OR + (unsigned)((tile * 128 + qt * 32 + r5) * 512 + qh * 64 + 4 * hh);
#pragma unroll
        for (int dt = 0; dt < 2; ++dt)
#pragma unroll
            for (int gq = 0; gq < 4; ++gq) {
                u32x2 ov; ov.x = pk2(o[dt][4 * gq] * rl, o[dt][4 * gq + 1] * rl); ov.y = pk2(o[dt][4 * gq + 2] * rl, o[dt][4 * gq + 3] * rl);
                *(u32x2*)(orow + dt * 32 + 8 * gq) = ov;
            }
    }
}

DI void unpack8(const u32x4 v, float (&f)[8]) {
    f[0] = __uint_as_float(v.x << 16); f[1] = __uint_as_float(v.x & 0xffff0000u); f[2] = __uint_as_float(v.y << 16); f[3] = __uint_as_float(v.y & 0xffff0000u);
    f[4] = __uint_as_float(v.z << 16); f[5] = __uint_as_float(v.z & 0xffff0000u); f[6] = __uint_as_float(v.w << 16); f[7] = __uint_as_float(v.w & 0xffff0000u);
}
DI void merge_tile(const bf16_t* __restrict__ OR, const bf16_t* __restrict__ CBR, const bf16_t* __restrict__ ZR, const bf16_t* __restrict__ YS, const float* __restrict__ cw  , const float* __restrict__ og  ,
                   bf16_t* __restrict__ mA, int tile, int tid) {
    tid = opaque_v(tid); tile = opaque_s(tile);
    const int lane = tid & 63, w = tid >> 6;
#pragma unroll 4
    for (int rr = 0; rr < 16; ++rr) {
        const int row = w * 16 + rr, t = tile * 128 + row, pos = t & (S - 1);
        float a[8], y[8];
        unpack8(*(const u32x4*)(OR + (unsigned)(t * 512 + lane * 8)), a);
        float ssa = 0.f;
#pragma unroll
        for (int q = 0; q < 8; ++q) ssa += a[q] * a[q];
        ssa = wave_sum(ssa);
        if (lane < 32) {
            const int c0 = lane * 8;
            float cb[8], z0[8], z1[8], z2[8];
            unpack8(*(const u32x4*)(CBR + (unsigned)(t * 256 + c0)), cb);
            unpack8(*(const u32x4*)(ZR + (unsigned)(t * 256 + c0)), z2);
            if (pos >= 1) unpack8(*(const u32x4*)(ZR + (unsigned)((t - 1) * 256 + c0)), z1); else { _Pragma("unroll") for (int q = 0; q < 8; ++q) z1[q] = 0.f; }
            if (pos >= 2) unpack8(*(const u32x4*)(ZR + (unsigned)((t - 2) * 256 + c0)), z0); else { _Pragma("unroll") for (int q = 0; q < 8; ++q) z0[q] = 0.f; }
#pragma unroll
            for (int q = 0; q < 8; ++q) y[q] = cb[q] * (cw[c0 + q] * z0[q] + cw[256 + c0 + q] * z1[q] + cw[512 + c0 + q] * z2[q]);
        } else {
            unpack8(*(const u32x4*)(YS + (unsigned)(t * 256 + (lane - 32) * 8)), y);
        }
        float ssy = 0.f;
#pragma unroll
        for (int q = 0; q < 8; ++q) ssy += y[q] * y[q];
#pragma unroll
        for (int o = 1; o < 32; o <<= 1) ssy += __shfl_xor(ssy, o);
        const float ra = rsqrtf(ssa * (1.f / 512.f) + EPS), ry = rsqrtf(ssy * (1.f / 256.f) + EPS);
        const int mb = row >> 5, r5 = row & 31;
        {
            const float4 g0 = *(const float4*)(og + lane * 8), g1 = *(const float4*)(og + lane * 8 + 4);
            u32x4 o; o.x = pk2(a[0] * ra * g0.x, a[1] * ra * g0.y); o.y = pk2(a[2] * ra * g0.z, a[3] * ra * g0.w); o.z = pk2(a[4] * ra * g1.x, a[5] * ra * g1.y); o.w = pk2(a[6] * ra * g1.z, a[7] * ra * g1.w);
            const int c8 = lane;
            (void)c8;
            *(u32x4*)(mA + (unsigned)(t * 1024 + lane * 8)) = o;
        }
        {
            const float4 g0 = *(const float4*)(og + 512 + lane * 8), g1 = *(const float4*)(og + 512 + lane * 8 + 4);
            u32x4 o; o.x = pk2(y[0] * ry * g0.x, y[1] * ry * g0.y); o.y = pk2(y[2] * ry * g0.z, y[3] * ry * g0.w); o.z = pk2(y[4] * ry * g1.x, y[5] * ry * g1.y); o.w = pk2(y[6] * ry * g1.z, y[7] * ry * g1.w);
            const int c8 = 64 + lane;
            (void)c8;
            *(u32x4*)(mA + (unsigned)(t * 1024 + 512 + lane * 8)) = o;
        }
    }
}

struct InProjOut { bf16_t *QF, *KF2, *VF, *CBR, *ZR, *YS; };
DI void inproj_tile(const bf16_t* __restrict__ At, const bf16_t* __restrict__ WF, const float* __restrict__ qg, const float* __restrict__ kg, const bf16_t* __restrict__ SWF, const float* __restrict__ sgu_b,
                    const InProjOut& O, char* lds, int tile, int tid) {
    tid = opaque_v(tid); tile = opaque_s(tile);
    const int lane = tid & 63, w = __builtin_amdgcn_readfirstlane(tid >> 6);
    f32x16 acc[4][2];
    {
        const int nbt0 = w * 2;
        kloop<1>(acc, At, WF + (size_t)nbt0 * 32768, WF + (size_t)(nbt0 + 1) * 32768, lds, tid, lane);
        epi_qk(acc, qg, 0.125f, O.QF + (size_t)(tile * 8 + w) * 8192, lane);
    }
    {
        const int nbt0 = 16 + w * 2;
        if (w == 2 || w == 3) {
            kloop<0>(acc, At, WF + (size_t)nbt0 * 32768, WF + (size_t)(nbt0 + 1) * 32768, lds, tid, lane);
            epi_v(acc, O.VF + (size_t)(tile * 2 + (w - 2)) * 8192, lane);
        } else {
            kloop<1>(acc, At, WF + (size_t)nbt0 * 32768, WF + (size_t)(nbt0 + 1) * 32768, lds, tid, lane);
            if (w < 2) epi_qk(acc, kg, 1.f, O.KF2 + (size_t)(tile * 2 + w) * 8192, lane);
            else epi_row(acc, O.CBR + (size_t)tile * 128 * 256 + (w - 4) * 64, 256, lane);
        }
    }
    {
        const int nbt0 = 32 + w * 2;
        kloop<1>(acc, At, WF + (size_t)nbt0 * 32768, WF + (size_t)(nbt0 + 1) * 32768, lds, tid, lane);
        epi_z(acc, O.ZR + (size_t)tile * 128 * 256 + w * 32, lane);
    }
    {
        const int nbt0 = 48 + w * 2;
        kloop<0>(acc, At, WF + (size_t)nbt0 * 32768, WF + (size_t)(nbt0 + 1) * 32768, lds, tid, lane);
        unsigned* lds_su = (unsigned*)lds;
        if (w < 4) epi_su_park(acc, lds_su + w * 4096, lane);
        __syncthreads();
        if (w >= 4) epi_sv(acc, SWF + (size_t)(w - 4) * 16384, sgu_b + (w - 4) * 128, lds_su + (w - 4) * 4096, O.YS + (size_t)tile * 128 * 256 + (w - 4) * 64, lane);
        __syncthreads();
    }
}


struct Params {
    const float *x, *c, *rel_bias, *w_ada, *b_ada, *norm1_g, *norm2_g, *w_in, *q_norm_g, *k_norm_g, *attn_sink, *conv_w, *sgu_w, *sgu_b, *out_norm_g, *w_out, *peer_wq, *peer_sub_keys, *peer_down, *peer_up;
    float* out;
    char* ws;
};
constexpr size_t MiB = 1u << 20;
constexpr size_t WS_MOD = 0;
constexpr size_t WS_MODP = 1 * MiB;
constexpr size_t WS_WIN = 13 * MiB;
constexpr size_t WS_WOUT = 29 * MiB;
constexpr size_t WS_WPQ = 37 * MiB;
constexpr size_t WS_KEYS = 53 * MiB;
constexpr size_t WS_SWF = 55 * MiB;
constexpr size_t WS_SC = 56 * MiB;
constexpr size_t WS_TB = 57 * MiB;
constexpr size_t WS_HA = 185 * MiB;
constexpr size_t WS_QF = 249 * MiB;
constexpr size_t WS_KF2 = 602 * MiB;
constexpr size_t WS_VF = 634 * MiB;
constexpr size_t WS_ZR = 666 * MiB;
constexpr size_t WS_CBR = 345 * MiB;
constexpr size_t WS_YS = 361 * MiB;
constexpr size_t WS_OR = 377 * MiB;
constexpr size_t WS_QPF = 409 * MiB;
constexpr size_t WS_RIDX = 537 * MiB;
constexpr size_t WS_RGATE = 553 * MiB;
constexpr size_t WS_SEID = 569 * MiB;
constexpr size_t WS_SWGT = 585 * MiB;
constexpr size_t WS_OFFS = 601 * MiB;
constexpr size_t WS_FLAGS = 601 * MiB + 512 * 1024;
constexpr size_t WS_END = 730 * MiB;
static_assert(PL_END <= LDS_RSTD1, "expert-phase lists overlap persistent LDS state");

__global__ __launch_bounds__(512) void hybrid_fwd(Params P) {
    extern __shared__ __attribute__((aligned(16))) char lds[];
    cg::grid_group grid = cg::this_grid();
    const int tid = threadIdx.x, lane = tid & 63, w = __builtin_amdgcn_readfirstlane(tid >> 6);
    const int nblk = gridDim.x, hwb = blockIdx.x;
    const int bid = (nblk == NTILE) ? (hwb & 7) * 32 + (hwb >> 3) : hwb;
    char* ws = P.ws;
    float* mod = (float*)(ws + WS_MOD);
    float* modp = (float*)(ws + WS_MODP);
    bf16_t* WinF = (bf16_t*)(ws + WS_WIN); bf16_t* WoutF = (bf16_t*)(ws + WS_WOUT); bf16_t* WpqF = (bf16_t*)(ws + WS_WPQ);
    bf16_t* KeysF = (bf16_t*)(ws + WS_KEYS); bf16_t* SWF = (bf16_t*)(ws + WS_SWF);
    float* SC = (float*)(ws + WS_SC); unsigned char* TBd = (unsigned char*)(ws + WS_TB); unsigned char* TBu = TBd + 32 * MiB;
    bf16_t* hA = (bf16_t*)(ws + WS_HA);
    bf16_t* OR = (bf16_t*)(ws + WS_OR); bf16_t* QPF = (bf16_t*)(ws + WS_QPF);
    int* ridx = (int*)(ws + WS_RIDX); float* rgate = (float*)(ws + WS_RGATE);
    float* bias_lds = (float*)(lds + LDS_BIAS);
    unsigned* flags = (unsigned*)(ws + WS_FLAGS);

    {
        float* ca = (float*)lds;
        if (tid == 0) for (int tile = bid; tile < NTILE; tile += nblk) __hip_atomic_store(flags + tile, 0u, __ATOMIC_RELAXED, __HIP_MEMORY_SCOPE_AGENT);
        for (int i = tid; i < 8192; i += 512) { const float v = P.c[i]; ca[i] = v / (1.f + __expf(-v)); }
        for (int i = tid; i < 1024; i += 512) bias_lds[i] = P.rel_bias[t5_bucket(i & 127) * 8 + (i >> 7)];
        __syncthreads();
        for (int it = bid; it < 768; it += nblk) {
            const int jc = it % 12, l = (it / 12) & 3, ks = it / 48;
            const int j = jc * 512 + tid;
            const float* wp = P.w_ada + ((size_t)l * 1024 + ks * 64) * 6144 + j;
            float acc[8];
#pragma unroll
            for (int b = 0; b < 8; ++b) acc[b] = 0.f;
#pragma unroll 4
            for (int i = 0; i < 64; ++i) {
                const float wv = wp[(size_t)i * 6144];
#pragma unroll
                for (int b = 0; b < 8; ++b) acc[b] += ca[b * 1024 + ks * 64 + i] * wv;
            }
#pragma unroll
            for (int b = 0; b < 8; ++b) modp[((size_t)(ks * 4 + l) * 8 + b) * 6144 + j] = acc[b];
        }
        const int gthreads = nblk * 512, gtid = bid * 512 + tid;
        for (int rep = 0; rep < REP_P0; ++rep)
        for (int l = 0; l < DEPTH; ++l) {
            for (int g = gtid; g < 64 * 64 * 64; g += gthreads) conv_wfrag_item(P.w_in + (size_t)l * 1024 * 2048, 2048, 64, WinF + (size_t)l * 2097152, g, 1);
            for (int g = gtid; g < 32 * 64 * 64; g += gthreads) conv_wfrag_item(P.w_out + (size_t)l * 1024 * 1024, 1024, 64, WoutF + (size_t)l * 1048576, g, 0);
            for (int g = gtid; g < 64 * 64 * 64; g += gthreads) conv_wfrag_item(P.peer_wq + (size_t)l * 1024 * 2048, 2048, 64, WpqF + (size_t)l * 2097152, g, 0);
            for (int g = gtid; g < 32768; g += gthreads) conv_keys_item(P.peer_sub_keys + (size_t)l * 262144, KeysF + (size_t)l * 262144, g);
            for (int g = gtid; g < 8192; g += gthreads) conv_sguw_item(P.sgu_w + (size_t)l * 65536, SWF + (size_t)l * 65536, g);
        }
        const int gwaves = nblk * 8, gw = bid * 8 + w;
        for (int rep = 0; rep < REP_P0; ++rep)
        for (int r = gw; r < DEPTH * 16384 * 2; r += gwaves) {
            const int which = r & 1, le = r >> 1;
            conv_table_row((which ? P.peer_up : P.peer_down) + (size_t)le * D, (which ? TBu : TBd) + (size_t)le * 512, SC + (size_t)le * 2 + which, lane, which == 0);
        }
    }
    grid.sync();
    for (int tile = bid; tile < NTILE; tile += nblk) {
        const int b = tile >> 5;
        for (int l = 0; l < DEPTH; ++l)
            for (int j = tid; j < 6144; j += 512) {
                float v = P.b_ada[l * 6144 + j];
#pragma unroll
                for (int ks = 0; ks < 16; ++ks) v += modp[((size_t)(ks * 4 + l) * 8 + b) * 6144 + j];
                mod[((size_t)l * 8 + b) * 6144 + j] = v;
            }
    }
    __syncthreads();

    for (int l = 0; l < DEPTH; ++l) {
        const float* xin = l == 0 ? P.x : P.out;
        InProjOut IO;
        IO.QF = (bf16_t*)(ws + WS_QF); IO.KF2 = (bf16_t*)(ws + WS_KF2 + (size_t)l * 8 * MiB); IO.VF = (bf16_t*)(ws + WS_VF + (size_t)l * 8 * MiB);
        IO.CBR = (bf16_t*)(ws + WS_CBR); IO.ZR = (bf16_t*)(ws + WS_ZR + (size_t)l * 16 * MiB); IO.YS = (bf16_t*)(ws + WS_YS);
        for (int tile = bid; tile < NTILE; tile += nblk) {
            const float* mb_ = mod + ((size_t)l * 8 + (tile >> 5)) * 6144;
            const bool have1 = l > 0 && nblk == NTILE;
            if (have1) { if (tid < 128) ((float*)lds)[tid] = ((const float*)(lds + LDS_RSTD1))[tid]; __syncthreads(); }
            norm_to_frag(xin, P.norm1_g + l * D, mb_ + 0, mb_ + 1024, hA, (float*)lds, tile, tid, have1);
            __syncthreads();
            for (int rep = 0; rep < REP_GEMM; ++rep) inproj_tile(hA + (size_t)tile * 131072, WinF + (size_t)l * 2097152, P.q_norm_g + l * 64, P.k_norm_g + l * 64, SWF + (size_t)l * 65536, P.sgu_b + l * 512, IO, lds, tile, tid);
            asm volatile("s_waitcnt vmcnt(0)" ::: "memory");
            __syncthreads();
            if (tid == 0) {
                __builtin_amdgcn_fence(__ATOMIC_RELEASE, "agent");
                asm volatile("s_waitcnt vmcnt(0)" ::: "memory");
                __hip_atomic_store(flags + tile, (unsigned)(l + 1), __ATOMIC_RELAXED, __HIP_MEMORY_SCOPE_AGENT);
            }
        }
        for (int tile = bid; tile < NTILE; tile += nblk) {
            const float* mb_ = mod + ((size_t)l * 8 + (tile >> 5)) * 6144;
            if ((tile & 31) != 0) {
                if (tid == 0) {
                    unsigned spins = 0;
                    while (__hip_atomic_load(flags + tile - 1, __ATOMIC_RELAXED, __HIP_MEMORY_SCOPE_AGENT) < (unsigned)(l + 1) && ++spins < (1u << 24)) __builtin_amdgcn_s_sleep(2);
                    __builtin_amdgcn_fence(__ATOMIC_ACQUIRE, "agent");
                    asm volatile("s_waitcnt vmcnt(0)" ::: "memory");
                }
                __syncthreads();
            }
            for (int rep = 0; rep < REP_MIX; ++rep) {
            attn_tile(IO.QF, IO.KF2, IO.VF, bias_lds, P.attn_sink + l * 8, OR, tile, tid);
            __syncthreads();
            merge_tile(OR, IO.CBR, IO.ZR, IO.YS, P.conv_w + l * 768, P.out_norm_g + l * D, hA, tile, tid);
            __syncthreads();
            }
            {
                const bf16_t* At = hA + (size_t)tile * 131072;
                const bf16_t* WF = WoutF + (size_t)l * 1048576;
                for (int pass = 0; pass < 2; ++pass) {
                    f32x16 acc[4][2];
                    const int nbt0 = pass * 16 + w * 2;
                    kloop<0>(acc, At, WF + (size_t)nbt0 * 32768, WF + (size_t)(nbt0 + 1) * 32768, lds, tid, lane);
                    epi_resid(acc, xin, P.out, mb_ + 2048, (float*)(lds + LDS_EPI) + w * 2176, (float*)(lds + LDS_SSQ) + (pass * 8 + w) * 128, tile, pass * 512 + w * 64, lane);
                }
            }
            __syncthreads();
            if (tid < 128) { const float* sq = (const float*)(lds + LDS_SSQ); float ssum = 0.f;
#pragma unroll
                for (int c = 0; c < 16; ++c) ssum += sq[c * 128 + tid];
                ((float*)lds)[tid] = rsqrtf(ssum * (1.f / D) + EPS); }
            __syncthreads();
            norm_to_frag(P.out, P.norm2_g + l * D, mb_ + 3072, mb_ + 4096, hA, (float*)lds, tile, tid, true);
            __syncthreads();
            {
                const bf16_t* At = hA + (size_t)tile * 131072;
                const bf16_t* WF = WpqF + (size_t)l * 2097152;
                for (int rep = 0; rep < REP_GEMM; ++rep)
                for (int pass = 0; pass < 4; ++pass) {
                    f32x16 acc[4][2];
                    const int nbt0 = pass * 16 + w * 2;
                    kloop<1>(acc, At, WF + (size_t)nbt0 * 32768, WF + (size_t)(nbt0 + 1) * 32768, lds, tid, lane);
                    epi_qpf(acc, QPF, tile, nbt0, lane);
                }
            }
            __syncthreads();
            for (int rep = 0; rep < REP_ROUTE; ++rep) { route_tile(QPF, KeysF + (size_t)l * 262144, lds, (unsigned char*)lds + PL_RIDX, tile, tid); __syncthreads(); }
            peer_down_wave(hA, lds, TBd + (size_t)l * 16384 * 512, SC + (size_t)l * 32768, tile, w, lane);
            __syncthreads();
            peer_up_wave(lds, TBu + (size_t)l * 16384 * 512, mb_ + 5120, P.out, tile, w, lane);
            __syncthreads();
        }
    }
}
}

extern "C" void kernel_launch(void* const* d_in, const int* in_sizes, int n_in, void* d_out, int out_size, void* d_ws, size_t ws_size, hipStream_t stream) {
    using namespace op;
    static int grid_blocks = 0;
    if (!grid_blocks) {
        int dev = 0, cus = 0, per_cu = 0;
        (void)hipGetDevice(&dev);
        (void)hipDeviceGetAttribute(&cus, hipDeviceAttributeMultiprocessorCount, dev);
        (void)hipFuncSetAttribute((const void*)hybrid_fwd, hipFuncAttributeMaxDynamicSharedMemorySize, LDS_BYTES);
        (void)hipOccupancyMaxActiveBlocksPerMultiprocessor(&per_cu, (const void*)hybrid_fwd, 512, LDS_BYTES);
        if (per_cu < 1) per_cu = 1;
        grid_blocks = cus * per_cu;
        if (grid_blocks > NTILE) grid_blocks = NTILE;
        if (ws_size < WS_END) { fprintf(stderr, "kernel_launch: workspace too small (%zu < %zu)\n", ws_size, (size_t)WS_END); grid_blocks = -1; }
    }
    if (grid_blocks < 0) return;
    Params p{};
    p.x = (const float*)d_in[0]; p.c = (const float*)d_in[1]; p.rel_bias = (const float*)d_in[2]; p.w_ada = (const float*)d_in[3]; p.b_ada = (const float*)d_in[4];
    p.norm1_g = (const float*)d_in[5]; p.norm2_g = (const float*)d_in[6]; p.w_in = (const float*)d_in[7]; p.q_norm_g = (const float*)d_in[8]; p.k_norm_g = (const float*)d_in[9];
    p.attn_sink = (const float*)d_in[10]; p.conv_w = (const float*)d_in[11]; p.sgu_w = (const float*)d_in[12]; p.sgu_b = (const float*)d_in[13]; p.out_norm_g = (const float*)d_in[14];
    p.w_out = (const float*)d_in[15]; p.peer_wq = (const float*)d_in[16]; p.peer_sub_keys = (const float*)d_in[17]; p.peer_down = (const float*)d_in[18]; p.peer_up = (const float*)d_in[19];
    p.out = (float*)d_out; p.ws = (char*)d_ws;
    void* args[] = {&p};
    hipError_t e = hipLaunchCooperativeKernel((const void*)hybrid_fwd, dim3(grid_blocks), dim3(512), args, LDS_BYTES, stream);
    if (e != hipSuccess) fprintf(stderr, "kernel_launch: cooperative launch failed: %s (grid %d)\n", hipGetErrorString(e), grid_blocks);
}
```

```cpp
#include <hip/hip_runtime.h>
#include <cstdio>
#include <cstdint>
#include <hip/hip_cooperative_groups.h>
namespace cg = cooperative_groups;


namespace op {
#define DI __device__ __forceinline__
typedef unsigned short bf16_t;
typedef short bf16x8 __attribute__((ext_vector_type(8)));
typedef float f32x16 __attribute__((ext_vector_type(16)));
typedef float f32x2 __attribute__((ext_vector_type(2)));
typedef unsigned u32x4 __attribute__((ext_vector_type(4)));
typedef unsigned u32x2 __attribute__((ext_vector_type(2)));
typedef __bf16 bf16v2 __attribute__((ext_vector_type(2)));
constexpr int D = 1024, NB = 8, S = 4096, DEPTH = 4, T = NB * S, NTILE = T / 128;
constexpr float EPS = 1e-6f;
constexpr int PL_SEID = 0, PL_SWGT = 32768, PL_END = 98304, PL_RIDX = 98304;
constexpr int LDS_EPI = 32768, LDS_SSQ = 102400, LDS_RSTD1 = 110592, LDS_BIAS = 128 * 1024, LDS_BYTES = 132 * 1024;
constexpr int REP_GEMM = 1, REP_ROUTE = 1, REP_MIX = 1, REP_NORM = 1, REP_P0 = 1;
#define MFMA32(a, b, c) __builtin_amdgcn_mfma_f32_32x32x16_bf16((a), (b), (c), 0, 0, 0)

DI unsigned pk2(float lo, float hi) { f32x2 v = {lo, hi}; return __builtin_bit_cast(unsigned, __builtin_convertvector(v, bf16v2)); }
DI int opaque_v(int x) { asm volatile("" : "+v"(x)); return x; }
DI int opaque_s(int x) { asm volatile("" : "+s"(x)); return x; }
DI int crow(int reg, int hh) { return (reg & 3) + 8 * (reg >> 2) + 4 * hh; }
DI float wave_sum(float v) {
#pragma unroll
    for (int o = 1; o < 64; o <<= 1) v += __shfl_xor(v, o);
    return v;
}

DI int col_perm(int npos, int mode) {
    if (mode == 1 && npos >= 1024 && npos < 1536) { const int q = npos - 1024, w = q >> 6, nb = (q >> 5) & 1, r = q & 31; return (nb ? 1280 : 1024) + 32 * w + r; }
    return npos;
}
DI void conv_wfrag_item(const float* __restrict__ W, int N, int KB, bf16_t* __restrict__ WF, int gid, int mode) {
    const int l = gid & 63, kb = (gid >> 6) % KB, nbt = (gid >> 6) / KB, r = l & 31, hh = l >> 5;
    const int n = col_perm(nbt * 32 + r, mode);
    const float* p = W + (size_t)(kb * 16 + 8 * hh) * N + n;
    float v[8];
#pragma unroll
    for (int j = 0; j < 8; ++j) v[j] = p[(size_t)j * N];
    u32x4 o; o.x = pk2(v[0], v[1]); o.y = pk2(v[2], v[3]); o.z = pk2(v[4], v[5]); o.w = pk2(v[6], v[7]);
    *(u32x4*)(WF + (size_t)gid * 8) = o;
}

DI void norm_to_frag(const float* __restrict__ x, const float* __restrict__ g, const float* __restrict__ sh, const float* __restrict__ sc, bf16_t* __restrict__ hA, float* rstd_lds, int tile, int tid, bool have_rstd) {
    tid = opaque_v(tid); tile = opaque_s(tile);
    const int w = tid >> 6, lane = tid & 63;
    float cg[16], cs[16], ch[16];
#pragma unroll
    for (int j = 0; j < 2; ++j)
#pragma unroll
        for (int q = 0; q < 2; ++q) {
            const int c = 512 * j + 8 * lane + 4 * q;
            const float4 a = *(const float4*)(g + c), b = *(const float4*)(sc + c), d = *(const float4*)(sh + c);
            cg[8 * j + 4 * q] = a.x * (1.f + b.x); cg[8 * j + 4 * q + 1] = a.y * (1.f + b.y); cg[8 * j + 4 * q + 2] = a.z * (1.f + b.z); cg[8 * j + 4 * q + 3] = a.w * (1.f + b.w);
            ch[8 * j + 4 * q] = d.x; ch[8 * j + 4 * q + 1] = d.y; ch[8 * j + 4 * q + 2] = d.z; ch[8 * j + 4 * q + 3] = d.w;
            cs[8 * j + 4 * q] = 0.f; cs[8 * j + 4 * q + 1] = 0.f; cs[8 * j + 4 * q + 2] = 0.f; cs[8 * j + 4 * q + 3] = 0.f;
        }
    (void)cs;
#pragma unroll 4
    for (int rr = 0; rr < 16; ++rr) {
        const int row = w * 16 + rr;
        const float* xr = x + ((size_t)tile * 128 + row) * D + 8 * lane;
        float v[16];
#pragma unroll
        for (int j = 0; j < 2; ++j)
#pragma unroll
            for (int q = 0; q < 2; ++q) { const float4 a = *(const float4*)(xr + 512 * j + 4 * q); v[8 * j + 4 * q] = a.x; v[8 * j + 4 * q + 1] = a.y; v[8 * j + 4 * q + 2] = a.z; v[8 * j + 4 * q + 3] = a.w; }
        float r;
        if (have_rstd) r = rstd_lds[row];
        else {
            float ss = 0.f;
#pragma unroll
            for (int e = 0; e < 16; ++e) ss += v[e] * v[e];
            r = rsqrtf(wave_sum(ss) * (1.f / D) + EPS);
        }
        bf16_t* orow = hA + ((size_t)tile * 128 + row) * D + 8 * lane;
#pragma unroll
        for (int j = 0; j < 2; ++j) {
            u32x4 o;
            o.x = pk2(v[8 * j] * r * cg[8 * j] + ch[8 * j], v[8 * j + 1] * r * cg[8 * j + 1] + ch[8 * j + 1]);
            o.y = pk2(v[8 * j + 2] * r * cg[8 * j + 2] + ch[8 * j + 2], v[8 * j + 3] * r * cg[8 * j + 3] + ch[8 * j + 3]);
            o.z = pk2(v[8 * j + 4] * r * cg[8 * j + 4] + ch[8 * j + 4], v[8 * j + 5] * r * cg[8 * j + 5] + ch[8 * j + 5]);
            o.w = pk2(v[8 * j + 6] * r * cg[8 * j + 6] + ch[8 * j + 6], v[8 * j + 7] * r * cg[8 * j + 7] + ch[8 * j + 7]);
            *(u32x4*)(orow + 512 * j) = o;
        }
    }
}

template <int ORIENT>
DI void kloop(f32x16 (&acc)[4][2], const bf16_t* __restrict__ At, const bf16_t* __restrict__ W0, const bf16_t* __restrict__ W1, char* lds, int tid, int lane) {
    tid = opaque_v(tid); lane = opaque_v(lane);
#pragma unroll
    for (int mb = 0; mb < 4; ++mb)
#pragma unroll
        for (int nb = 0; nb < 2; ++nb)
#pragma unroll
            for (int i = 0; i < 16; ++i) acc[mb][nb][i] = 0.f;
    {
    const int c8_ = (tid >> 3) & 7, rowA_ = (tid >> 6) * 8 + (tid & 7);
    const u32x4* Ag = (const u32x4*)(At + (unsigned)(rowA_ * 1024 + c8_ * 8));
    const int ldsA_ = ((((c8_ >> 1) * 4 + (rowA_ >> 5)) * 64) + (rowA_ & 31) + 32 * (c8_ & 1)) * 16;
    const u32x4* W0g = (const u32x4*)W0 + lane;
    const u32x4* W1g = (const u32x4*)W1 + lane;
    u32x4 wq[4][2], arA[2], arB[2];
    arA[0] = Ag[0]; arA[1] = Ag[8192]; arB[0] = Ag[8]; arB[1] = Ag[8 + 8192];
#pragma unroll
    for (int kk = 0; kk < 4; ++kk) { wq[kk][0] = W0g[kk * 64]; wq[kk][1] = W1g[kk * 64]; }
    *(u32x4*)(lds + ldsA_) = arA[0]; *(u32x4*)(lds + ldsA_ + 2048) = arA[1];
    __syncthreads();
#define KL_ITER(KC, ARL, ARS) do { \
        char* cur = lds + ((KC) & 1) * 16384; \
        char* nxt = lds + (((KC) + 1) & 1) * 16384; \
        const int kn = (KC) < 15 ? (KC) + 1 : 15, k2 = (KC) < 14 ? (KC) + 2 : 15; \
        if ((KC) < 14) { ARL[0] = Ag[k2 * 8]; ARL[1] = Ag[k2 * 8 + 8192]; } \
        __builtin_amdgcn_sched_barrier(0); \
        _Pragma("unroll") for (int kk = 0; kk < 4; ++kk) { \
            bf16x8 afr[4]; \
            _Pragma("unroll") for (int mb = 0; mb < 4; ++mb) afr[mb] = *(const bf16x8*)(cur + ((kk * 4 + mb) * 64 + lane) * 16); \
            _Pragma("unroll") for (int mb = 0; mb < 4; ++mb) \
                _Pragma("unroll") for (int nb = 0; nb < 2; ++nb) { \
                    const bf16x8 wf = __builtin_bit_cast(bf16x8, wq[kk][nb]); \
                    if (ORIENT == 0) acc[mb][nb] = MFMA32(afr[mb], wf, acc[mb][nb]); \
                    else acc[mb][nb] = MFMA32(wf, afr[mb], acc[mb][nb]); \
                } \
            if ((KC) < 15) { wq[kk][0] = W0g[(kn * 4 + kk) * 64]; wq[kk][1] = W1g[(kn * 4 + kk) * 64]; } \
            __builtin_amdgcn_sched_barrier(0); \
        } \
        if ((KC) < 15) { *(u32x4*)(nxt + ldsA_) = ARS[0]; *(u32x4*)(nxt + ldsA_ + 2048) = ARS[1]; } \
        __syncthreads(); \
    } while (0)
    for (int kc = 0; kc < 16; kc += 2) { KL_ITER(kc, arA, arB); KL_ITER(kc + 1, arB, arA); }
#undef KL_ITER
    }
}

DI void epi_f32row(const f32x16 (&acc)[4][2], float* __restrict__ C, int tile, int col0, int lane) {
    lane = opaque_v(lane);
    const int r5 = lane & 31, hh = lane >> 5;
    const unsigned boff = (unsigned)((tile * 128 + 4 * hh) * 2048 + col0 + r5);
#pragma unroll
    for (int mb = 0; mb < 4; ++mb)
#pragma unroll
        for (int nb = 0; nb < 2; ++nb)
#pragma unroll
            for (int i = 0; i < 16; ++i)
                C[boff + (unsigned)((mb * 32 + (i & 3) + 8 * (i >> 2)) * 2048 + nb * 32)] = acc[mb][nb][i];
}
DI void epi_resid(const f32x16 (&acc)[4][2], const float* __restrict__ xin, float* __restrict__ xout, const float* __restrict__ gate_b, float* T  , float* ssq  , int tile, int col0, int lane) {
    lane = opaque_v(lane);
    const int r5 = lane & 31, hh = lane >> 5, rq = lane >> 4, c4 = (lane & 15) * 4;
    const float4 gv = *(const float4*)(gate_b + col0 + c4);
#pragma unroll
    for (int mb = 0; mb < 4; ++mb) {
#pragma unroll
        for (int nb = 0; nb < 2; ++nb)
#pragma unroll
            for (int i = 0; i < 16; ++i) T[((i & 3) + 8 * (i >> 2) + 4 * hh) * 68 + nb * 32 + r5] = acc[mb][nb][i];
        asm volatile("s_waitcnt lgkmcnt(0)" ::: "memory");
#pragma unroll
        for (int j = 0; j < 8; ++j) {
            const int row = rq + 4 * j;
            const float4 v = *(const float4*)(T + row * 68 + c4);
            const unsigned o = (unsigned)((tile * 128 + mb * 32 + row) * D + col0 + c4);
            float4 xv = *(const float4*)(xin + o);
            xv.x += gv.x * v.x; xv.y += gv.y * v.y; xv.z += gv.z * v.z; xv.w += gv.w * v.w;
            *(float4*)(xout + o) = xv;
            float ss = xv.x * xv.x + xv.y * xv.y + xv.z * xv.z + xv.w * xv.w;
            ss += __shfl_xor(ss, 1); ss += __shfl_xor(ss, 2); ss += __shfl_xor(ss, 4); ss += __shfl_xor(ss, 8);
            if ((lane & 15) == 0) ssq[mb * 32 + row] = ss;
        }
        asm volatile("s_waitcnt lgkmcnt(0)" ::: "memory");
    }
}

DI void epi_qpf(const f32x16 (&acc)[4][2], bf16_t* __restrict__ QPF, int tile, int ft0, int lane) {
    lane = opaque_v(lane);
#pragma unroll
    for (int nb = 0; nb < 2; ++nb)
#pragma unroll
        for (int s = 0; s < 2; ++s)
#pragma unroll
            for (int mb = 0; mb < 4; ++mb) {
                const f32x16& a = acc[mb][nb];
                u32x4 o; o.x = pk2(a[8 * s], a[8 * s + 1]); o.y = pk2(a[8 * s + 2], a[8 * s + 3]); o.z = pk2(a[8 * s + 4], a[8 * s + 5]); o.w = pk2(a[8 * s + 6], a[8 * s + 7]);
                *(u32x4*)(QPF + ((unsigned)((((tile * 64 + ft0 + nb) * 2 + s) * 4 + mb) * 64 + lane)) * 8) = o;
            }
}

DI void conv_keys_item(const float* __restrict__ K, bf16_t* __restrict__ KF, int gid) {
    const int lane = gid & 63, s = (gid >> 6) & 1, nbl = (gid >> 7) & 3, nt = (gid >> 9) & 3, hp = gid >> 11;
    const int r = lane & 31, hh = lane >> 5;
    const float* p = K + ((size_t)hp * 128 + nt * 32 + r) * 128 + nbl * 32 + 16 * s + 4 * hh;
    const float4 a = *(const float4*)p, b = *(const float4*)(p + 8);
    u32x4 o; o.x = pk2(a.x, a.y); o.y = pk2(a.z, a.w); o.z = pk2(b.x, b.y); o.w = pk2(b.z, b.w);
    *(u32x4*)(KF + (size_t)gid * 8) = o;
}

DI void conv_table_row(const float* __restrict__ src, unsigned char* __restrict__ dst, float* __restrict__ sc, int lane, bool as_int4) {
    const float4* p = (const float4*)src + lane * 4;
    float4 v[4];
    float m = 0.f;
#pragma unroll
    for (int j = 0; j < 4; ++j) { v[j] = p[j]; m = fmaxf(m, fmaxf(fmaxf(fabsf(v[j].x), fabsf(v[j].y)), fmaxf(fabsf(v[j].z), fabsf(v[j].w)))); }
#pragma unroll
    for (int o = 1; o < 64; o <<= 1) m = fmaxf(m, __shfl_xor(m, o));
    float scale = m > 0.f ? m * (1.f / 6.f) : 1.f;
    if (as_int4) {
        float ss = 0.f;
#pragma unroll
        for (int j = 0; j < 4; ++j) ss += v[j].x * v[j].x + v[j].y * v[j].y + v[j].z * v[j].z + v[j].w * v[j].w;
        ss = wave_sum(ss);
        const float sg = sqrtf(ss * (1.f / 1024.f));
        scale = fmaxf(sg * (1.f / 2.8f), m * (1.f / 16.f));
        if (!(scale > 0.f)) scale = 1.f;
    }
    const float inv = 1.f / scale;
    u32x2 o;
    unsigned* op = (unsigned*)&o;
#pragma unroll
    for (int j = 0; j < 2; ++j) {
        const float f[8] = {v[2 * j].x, v[2 * j].y, v[2 * j].z, v[2 * j].w, v[2 * j + 1].x, v[2 * j + 1].y, v[2 * j + 1].z, v[2 * j + 1].w};
        unsigned wv = 0;
        if (as_int4) {
#pragma unroll
            for (int e = 0; e < 8; ++e) { int q = __float2int_rn(f[e] * inv); q = q < -7 ? -7 : (q > 7 ? 7 : q); wv |= ((unsigned)q & 15u) << (4 * e); }
        } else {
            wv = __builtin_amdgcn_cvt_scalef32_pk_fp4_f32(wv, f[0] * inv, f[1] * inv, 1.0f, 0);
            wv = __builtin_amdgcn_cvt_scalef32_pk_fp4_f32(wv, f[2] * inv, f[3] * inv, 1.0f, 1);
            wv = __builtin_amdgcn_cvt_scalef32_pk_fp4_f32(wv, f[4] * inv, f[5] * inv, 1.0f, 2);
            wv = __builtin_amdgcn_cvt_scalef32_pk_fp4_f32(wv, f[6] * inv, f[7] * inv, 1.0f, 3);
        }
        op[j] = wv;
    }
    *(u32x2*)(dst + lane * 8) = o;
    if (lane == 0) *sc = scale;
}

DI void ce_desc(int& a, int& b) { const int mx = a > b ? a : b, mn = a > b ? b : a; a = mx; b = mn; }
DI void sort16_desc(int (&v)[16]) {
#pragma unroll
    for (int k = 2; k <= 16; k <<= 1)
#pragma unroll
        for (int j = k >> 1; j > 0; j >>= 1)
#pragma unroll
            for (int i = 0; i < 16; ++i) {
                const int l = i ^ j;
                if (l > i) { if ((i & k) == 0) ce_desc(v[i], v[l]); else ce_desc(v[l], v[i]); }
            }
}
DI void bitonic_merge16_desc(int (&v)[16]) {
#pragma unroll
    for (int j = 8; j > 0; j >>= 1)
#pragma unroll
        for (int i = 0; i < 16; ++i) { const int l = i ^ j; if (l > i) ce_desc(v[i], v[l]); }
}
DI void merge_top16(int (&a)[16], const int (&b)[16]) {
#pragma unroll
    for (int i = 0; i < 16; ++i) a[i] = a[i] > b[15 - i] ? a[i] : b[15 - i];
    bitonic_merge16_desc(a);
}
DI int f2ord(float f) { int b = __float_as_int(f); return b ^ ((b >> 31) & 0x7fffffff); }
DI float ord2f(int k) { return __int_as_float(k ^ ((k >> 31) & 0x7fffffff)); }

DI void route_tile(const bf16_t* __restrict__ QPF, const bf16_t* __restrict__ KF, char* lds_lists, unsigned char* lds_idx  , int tile, int tid) {
    tid = opaque_v(tid); tile = opaque_s(tile);
    const int lane = tid & 63, w = __builtin_amdgcn_readfirstlane(tid >> 6);
    const int r5 = lane & 31, hh = lane >> 5;
    unsigned char* myidx = lds_idx + w * 1024;
    for (int task = w; task < 32; task += 8) {
        const int h = task >> 2, tt = task & 3;
        f32x16 acc[2][4];
#pragma unroll
        for (int p = 0; p < 2; ++p)
#pragma unroll
            for (int nt = 0; nt < 4; ++nt)
#pragma unroll
                for (int i = 0; i < 16; ++i) acc[p][nt][i] = 0.f;
        {
            bf16x8 bq[3], ak[3][4];
#define ROUTE_LOAD(buf, step) do { const int p_ = (step) >> 3, ks_ = (step) & 7; \
                bq[buf] = *(const bf16x8*)(QPF + ((unsigned)((((tile * 64 + h * 8 + p_ * 4 + (ks_ >> 1)) * 2 + (ks_ & 1)) * 4 + tt) * 64 + lane)) * 8); \
                _Pragma("unroll") for (int nt = 0; nt < 4; ++nt) ak[buf][nt] = *(const bf16x8*)(KF + ((unsigned)(((((h * 2 + p_) * 4 + nt) * 8 + ks_) * 64) + lane)) * 8); } while (0)
            ROUTE_LOAD(0, 0);
            ROUTE_LOAD(1, 1);
#pragma unroll
            for (int step = 0; step < 16; ++step) {
                if (step < 14) ROUTE_LOAD((step + 2) % 3, step + 2);
#pragma unroll
                for (int nt = 0; nt < 4; ++nt) acc[step >> 3][nt] = MFMA32(ak[step % 3][nt], bq[step % 3], acc[step >> 3][nt]);
                __builtin_amdgcn_sched_barrier(0);
            }
#undef ROUTE_LOAD
        }
        int g[8][16];
#pragma unroll
        for (int nt = 0; nt < 4; ++nt)
#pragma unroll
            for (int i = 0; i < 16; ++i) {
                const unsigned a = __float_as_uint(acc[0][nt][i]), b = __float_as_uint(acc[1][nt][i]);
                auto sw = __builtin_amdgcn_permlane32_swap(a, b, false, false);
                const int n0 = nt * 32 + (i & 3) + 8 * (i >> 2);
                g[nt * 2 + (i >> 3)][i & 7] = (f2ord(__uint_as_float(sw[0])) & ~127) | n0;
                g[nt * 2 + (i >> 3)][8 + (i & 7)] = (f2ord(__uint_as_float(sw[1])) & ~127) | (n0 + 4);
            }
#pragma unroll
        for (int q = 0; q < 8; ++q) sort16_desc(g[q]);
        merge_top16(g[0], g[1]); merge_top16(g[2], g[3]); merge_top16(g[4], g[5]); merge_top16(g[6], g[7]);
        merge_top16(g[0], g[2]); merge_top16(g[4], g[6]);
        merge_top16(g[0], g[4]);
        {
            u32x4 pk;
            unsigned* pp = (unsigned*)&pk;
#pragma unroll
            for (int q = 0; q < 4; ++q) pp[q] = (unsigned)(g[0][4 * q] & 127) | ((unsigned)(g[0][4 * q + 1] & 127) << 8) | ((unsigned)(g[0][4 * q + 2] & 127) << 16) | ((unsigned)(g[0][4 * q + 3] & 127) << 24);
            *(u32x4*)(myidx + lane * 16) = pk;
        }
        float f0[16], f1[16];
#pragma unroll
        for (int i = 0; i < 16; ++i) {
            const unsigned a = (unsigned)g[0][i], b = a;
            auto sw = __builtin_amdgcn_permlane32_swap(a, b, false, false);
            f0[i] = ord2f((int)sw[0] & ~127); f1[i] = ord2f((int)sw[1] & ~127);
        }
        int c0[16], c1[16], c2[16], c3[16];
#pragma unroll
        for (int j = 0; j < 16; ++j) c0[j] = (f2ord(f0[0] + f1[j]) & ~255) | j;
#pragma unroll
        for (int i = 1; i < 16; ++i) c1[i - 1] = (f2ord(f0[i] + f1[0]) & ~255) | (i << 4);
        c1[15] = (int)0x80000000;
#define CK(i, j) ((f2ord(f0[i] + f1[j]) & ~255) | ((i) << 4) | (j))
        c2[0] = CK(1, 1); c2[1] = CK(1, 2); c2[2] = CK(1, 3); c2[3] = CK(1, 4); c2[4] = CK(1, 5); c2[5] = CK(1, 6); c2[6] = CK(1, 7);
        c2[7] = CK(2, 1); c2[8] = CK(2, 2); c2[9] = CK(2, 3); c2[10] = CK(2, 4);
        c2[11] = CK(3, 1); c2[12] = CK(3, 2); c2[13] = CK(3, 3);
        c2[14] = CK(4, 1); c2[15] = CK(4, 2);
        c3[0] = CK(5, 1); c3[1] = CK(6, 1); c3[2] = CK(7, 1);
#undef CK
#pragma unroll
        for (int q = 3; q < 16; ++q) c3[q] = (int)0x80000000;
        sort16_desc(c2);
        ce_desc(c3[0], c3[1]); ce_desc(c3[1], c3[2]); ce_desc(c3[0], c3[1]);
        merge_top16(c0, c1); merge_top16(c2, c3); merge_top16(c0, c2);
        float bs[16], den = 0.f;
#pragma unroll
        for (int i = 0; i < 16; ++i) { bs[i] = __expf(ord2f(c0[i] & ~255) - ord2f(c0[0] & ~255)); den += bs[i]; }
        const float rden = 1.f / den;
        asm volatile("s_waitcnt lgkmcnt(0)" ::: "memory");
#pragma unroll
        for (int q = 0; q < 8; ++q) {
            const int key = (int)__builtin_amdgcn_permlane32_swap((unsigned)c0[q], (unsigned)c0[8 + q], false, false)[0];
            const float gv = __uint_as_float(__builtin_amdgcn_permlane32_swap(__float_as_uint(bs[q]), __float_as_uint(bs[8 + q]), false, false)[0]) * rden;
            const int i = (key >> 4) & 15, j = key & 15;
            const int e = (int)myidx[r5 * 16 + i] * 128 + (int)myidx[(32 + r5) * 16 + j];
            const int tokl = tt * 32 + r5;
            ((unsigned short*)(lds_lists + PL_SEID))[tokl * 128 + h * 16 + 8 * hh + q] = (unsigned short)e;
            ((float*)(lds_lists + PL_SWGT))[tokl * 128 + h * 16 + 8 * hh + q] = gv;
        }
        asm volatile("s_waitcnt lgkmcnt(0)" ::: "memory");
    }
}

DI void unpack_h2(const bf16_t* __restrict__ hA, int t, int lane, f32x2 (&hv)[8]) {
    const int tile = t >> 7, row = t & 127, mb = row >> 5, r5 = row & 31;
    const bf16_t* hp = hA + ((unsigned)(((tile * 64 + lane) * 4 + mb) * 64 + r5)) * 8;
    const u32x4 ha = *(const u32x4*)hp, hb = *(const u32x4*)(hp + 32 * 8);
    const unsigned hw[8] = {ha.x, ha.y, ha.z, ha.w, hb.x, hb.y, hb.z, hb.w};
#pragma unroll
    for (int q = 0; q < 8; ++q) { hv[q].x = __uint_as_float(hw[q] << 16); hv[q].y = __uint_as_float(hw[q] & 0xffff0000u); }
}
typedef _Float16 h16x2 __attribute__((ext_vector_type(2)));
DI h16x2 fp4h(unsigned w, int sel) {
    return sel == 0 ? __builtin_amdgcn_cvt_scalef32_pk_f16_fp4(w, 1.0f, 0) : sel == 1 ? __builtin_amdgcn_cvt_scalef32_pk_f16_fp4(w, 1.0f, 1)
         : sel == 2 ? __builtin_amdgcn_cvt_scalef32_pk_f16_fp4(w, 1.0f, 2) : __builtin_amdgcn_cvt_scalef32_pk_f16_fp4(w, 1.0f, 3);
}
DI void stage_token(const int* __restrict__ ridx, const float* __restrict__ rgate, char* lds, int t, int tloc, int lane) {
    lane = opaque_v(lane); t = opaque_s(t);
    unsigned short* seid = (unsigned short*)(lds + PL_SEID) + tloc * 128;
    float* swgt = (float*)(lds + PL_SWGT) + tloc * 128;
    seid[lane] = (unsigned short)ridx[(unsigned)(t * 128 + lane)]; seid[64 + lane] = (unsigned short)ridx[(unsigned)(t * 128 + 64 + lane)];
    swgt[lane] = rgate[(unsigned)(t * 128 + lane)]; swgt[64 + lane] = rgate[(unsigned)(t * 128 + 64 + lane)];
}
DI void peer_down_wave(const bf16_t* __restrict__ hA, char* lds, const unsigned char* __restrict__ TBd, const float* __restrict__ SC, int tile, int w, int lane) {
    lane = opaque_v(lane);
    const int myu = ((lane >> 5) & 1) * 8 + ((lane >> 4) & 1) * 4 + ((lane >> 3) & 1) * 2 + ((lane >> 2) & 1);
    const unsigned short* seid = (const unsigned short*)(lds + PL_SEID) + w * 16 * 128;
    float* swgt = (float*)(lds + PL_SWGT) + w * 16 * 128;
    u32x4 haN, hbN;
    int ev0N, ev1N;
    { const bf16_t* hp0 = hA + (unsigned)((tile * 128 + w * 16) * 1024 + lane * 16); haN = *(const u32x4*)hp0; hbN = *(const u32x4*)(hp0 + 8); ev0N = seid[lane]; ev1N = seid[64 + lane]; }
    u32x2 R[2][16];
    f32x2 scv[2];
#define DOWN_ISSUE(buf, EV, base) do { _Pragma("unroll") for (int u_ = 0; u_ < 16; ++u_) { const int e_ = __builtin_amdgcn_readlane(EV, (base) + u_); \
        R[buf][u_] = *(const u32x2*)(TBd + (size_t)(unsigned)e_ * 512 + lane * 8); } \
        scv[buf] = *(const f32x2*)(SC + (unsigned)__shfl(EV, (base) + myu) * 2); } while (0)
    DOWN_ISSUE(0, ev0N, 0);
#pragma unroll 1
    for (int tl = 0; tl < 16; ++tl) {
        const int t = tile * 128 + w * 16 + tl;
        float* gp = swgt + tl * 128;
        const u32x4 ha = haN, hb = hbN;
        const int ev0 = ev0N, ev1 = ev1N;
        {
            const int tn = tl < 15 ? tl + 1 : tl;
            const bf16_t* hp = hA + (unsigned)((t - tl + tn) * 1024 + lane * 16); haN = *(const u32x4*)hp; hbN = *(const u32x4*)(hp + 8);
            ev0N = seid[tn * 128 + lane]; ev1N = seid[tn * 128 + 64 + lane];
        }
        unsigned hhi[2], hlo[2];
        float hscale;
        {
            const unsigned hw[8] = {ha.x, ha.y, ha.z, ha.w, hb.x, hb.y, hb.z, hb.w};
            float hf[16];
            float m = 0.f;
#pragma unroll
            for (int q = 0; q < 8; ++q) { hf[2 * q] = __uint_as_float(hw[q] << 16); hf[2 * q + 1] = __uint_as_float(hw[q] & 0xffff0000u); m = fmaxf(m, fmaxf(fabsf(hf[2 * q]), fabsf(hf[2 * q + 1]))); }
#pragma unroll
            for (int o = 1; o < 64; o <<= 1) m = fmaxf(m, __shfl_xor(m, o));
            hscale = m > 0.f ? m * (1.f / 119.f) : 1.f;
            const float inv = 1.f / hscale;
            hhi[0] = hhi[1] = hlo[0] = hlo[1] = 0u;
#pragma unroll
            for (int e = 0; e < 16; ++e) {
                const int hq = __float2int_rn(hf[e] * inv);
                const int lo = ((hq + 8) & 15) - 8, hi = (hq - lo) >> 4;
                hlo[e >> 3] |= ((unsigned)lo & 15u) << (4 * (e & 7));
                hhi[e >> 3] |= ((unsigned)hi & 15u) << (4 * (e & 7));
            }
        }
#pragma unroll
        for (int bt = 0; bt < 8; ++bt) {
            const int cur = bt & 1, nxt = cur ^ 1;
            if (bt < 3) DOWN_ISSUE(nxt, ev0, (bt + 1) * 16);
            else if (bt == 3) DOWN_ISSUE(nxt, ev1, 0);
            else if (bt < 7) DOWN_ISSUE(nxt, ev1, (bt - 3) * 16);
            else DOWN_ISSUE(nxt, ev0N, 0);
            __builtin_amdgcn_sched_barrier(0);
            int part[16];
#pragma unroll
            for (int u = 0; u < 16; ++u) {
                int shi = __builtin_amdgcn_sdot8((int)R[cur][u].x, (int)hhi[0], 0, false);
                shi = __builtin_amdgcn_sdot8((int)R[cur][u].y, (int)hhi[1], shi, false);
                int slo = __builtin_amdgcn_sdot8((int)R[cur][u].x, (int)hlo[0], 0, false);
                slo = __builtin_amdgcn_sdot8((int)R[cur][u].y, (int)hlo[1], slo, false);
                part[u] = shi * 16 + slo;
            }
            int r8[8], r4[4], r2[2], r1;
            {
                const bool b5 = (lane & 32) != 0, b4 = (lane & 16) != 0, b3 = (lane & 8) != 0, b2 = (lane & 4) != 0;
#pragma unroll
                for (int q = 0; q < 8; ++q) { const int keep = b5 ? part[q + 8] : part[q], give = b5 ? part[q] : part[q + 8]; r8[q] = keep + __shfl_xor(give, 32); }
#pragma unroll
                for (int q = 0; q < 4; ++q) { const int keep = b4 ? r8[q + 4] : r8[q], give = b4 ? r8[q] : r8[q + 4]; r4[q] = keep + __shfl_xor(give, 16); }
#pragma unroll
                for (int q = 0; q < 2; ++q) { const int keep = b3 ? r4[q + 2] : r4[q], give = b3 ? r4[q] : r4[q + 2]; r2[q] = keep + __shfl_xor(give, 8); }
                { const int keep = b2 ? r2[1] : r2[0], give = b2 ? r2[0] : r2[1]; r1 = keep + __shfl_xor(give, 4); }
                r1 += __shfl_xor(r1, 2); r1 += __shfl_xor(r1, 1);
            }
            if ((lane & 3) == 0) {
                const float a = (float)r1 * (scv[cur].x * hscale);
                gp[bt * 16 + myu] = gp[bt * 16 + myu] * (0.5f * a * (1.f + erff(a * 0.70710678118654752f))) * scv[cur].y;
            }
        }
    }
#undef DOWN_ISSUE
}
DI void peer_up_wave(char* lds, const unsigned char* __restrict__ TBu, const float* __restrict__ g2b, float* __restrict__ x, int tile, int w, int lane) {
    lane = opaque_v(lane);
    const unsigned short* seid = (const unsigned short*)(lds + PL_SEID) + w * 16 * 128;
    const float* swgt = (const float*)(lds + PL_SWGT) + w * 16 * 128;
    u32x2 RA[16], RB[16];
#define UP_ISSUE(R, EV, base) do { _Pragma("unroll") for (int u_ = 0; u_ < 16; ++u_) { const int e_ = __builtin_amdgcn_readlane(EV, (base) + u_); \
        R[u_] = *(const u32x2*)(TBu + (size_t)(unsigned)e_ * 512 + lane * 8); } } while (0)
#define UP_COMPUTE(R, WL, base, K) do { _Pragma("unroll") for (int u_ = 0; u_ < 16; ++u_) { \
        const _Float16 wh_ = (_Float16)__int_as_float(__builtin_amdgcn_readlane(__float_as_int(WL), (base) + u_)); const h16x2 w2_ = (h16x2){wh_, wh_}; \
        _Pragma("unroll") for (int q_ = 0; q_ < 4; ++q_) { acc[K][q_] = __builtin_elementwise_fma(w2_, fp4h(R[u_].x, q_), acc[K][q_]); acc[K][4 + q_] = __builtin_elementwise_fma(w2_, fp4h(R[u_].y, q_), acc[K][4 + q_]); } } } while (0)
    int ev0N = seid[lane], ev1N = seid[64 + lane];
    float wl0N = swgt[lane], wl1N = swgt[64 + lane];
    UP_ISSUE(RA, ev0N, 0);
    for (int r = 0; r < 2; ++r) {
        h16x2 acc[8][8];
#pragma unroll
        for (int k = 0; k < 8; ++k)
#pragma unroll
            for (int q = 0; q < 8; ++q) acc[k][q] = (h16x2){(_Float16)0.f, (_Float16)0.f};
#pragma unroll
        for (int k = 0; k < 8; ++k) {
            const int ev0 = ev0N, ev1 = ev1N;
            const float wl0 = wl0N, wl1 = wl1N;
            {
                const int tn = (r * 8 + k < 15) ? r * 8 + k + 1 : 15;
                ev0N = seid[tn * 128 + lane]; ev1N = seid[tn * 128 + 64 + lane]; wl0N = swgt[tn * 128 + lane]; wl1N = swgt[tn * 128 + 64 + lane];
            }
#pragma unroll 1
            for (int i = 0; i < 4; ++i) {
                const int evS = i < 2 ? ev0 : ev1;
                const float wlS = i < 2 ? wl0 : wl1;
                const int base = (i & 1) * 32;
                UP_ISSUE(RB, evS, base + 16);
                __builtin_amdgcn_sched_barrier(0);
                UP_COMPUTE(RA, wlS, base, k);
                const int evT = i < 3 ? (i < 1 ? ev0 : ev1) : ev0N;
                const int baseT = i < 3 ? ((i + 1) & 1) * 32 : 0;
                UP_ISSUE(RA, evT, baseT);
                __builtin_amdgcn_sched_barrier(0);
                UP_COMPUTE(RB, wlS, base + 16, k);
            }
        }
#pragma unroll
        for (int k = 0; k < 8; ++k) {
            const int t = tile * 128 + w * 16 + r * 8 + k;
            float4* xp = (float4*)(x + (size_t)t * D + lane * 16);
            const float4* gq = (const float4*)(g2b + lane * 16);
            float ssx = 0.f;
#pragma unroll
            for (int q = 0; q < 4; ++q) {
                float4 xv = xp[q]; const float4 gv = gq[q];
                xv.x += gv.x * (float)acc[k][2 * q].x; xv.y += gv.y * (float)acc[k][2 * q].y; xv.z += gv.z * (float)acc[k][2 * q + 1].x; xv.w += gv.w * (float)acc[k][2 * q + 1].y;
                xp[q] = xv;
                ssx += xv.x * xv.x + xv.y * xv.y + xv.z * xv.z + xv.w * xv.w;
            }
            ssx = wave_sum(ssx);
            if (lane == 0) ((float*)(lds + LDS_RSTD1))[w * 16 + r * 8 + k] = rsqrtf(ssx * (1.f / D) + EPS);
        }
    }
#undef UP_ISSUE
#undef UP_COMPUTE
}

DI void epi_qk(f32x16 (&acc)[4][2], const float* __restrict__ gain, float scale, bf16_t* __restrict__ dst, int lane) {
    lane = opaque_v(lane);
    const int hh = lane >> 5;
    float gv[2][16];
#pragma unroll
    for (int nb = 0; nb < 2; ++nb)
#pragma unroll
        for (int i = 0; i < 16; ++i) gv[nb][i] = gain[nb * 32 + (i & 3) + 8 * (i >> 2) + 4 * hh] * scale;
#pragma unroll
    for (int mb = 0; mb < 4; ++mb) {
        float ss = 0.f;
#pragma unroll
        for (int nb = 0; nb < 2; ++nb)
#pragma unroll
            for (int i = 0; i < 16; ++i) ss += acc[mb][nb][i] * acc[mb][nb][i];
        ss += __shfl_xor(ss, 32);
        const float r = rsqrtf(ss * (1.f / 64.f) + EPS);
#pragma unroll
        for (int nb = 0; nb < 2; ++nb)
#pragma unroll
            for (int s = 0; s < 2; ++s) {
                const f32x16& a = acc[mb][nb];
                u32x4 o;
                o.x = pk2(a[8 * s] * r * gv[nb][8 * s], a[8 * s + 1] * r * gv[nb][8 * s + 1]);
                o.y = pk2(a[8 * s + 2] * r * gv[nb][8 * s + 2], a[8 * s + 3] * r * gv[nb][8 * s + 3]);
                o.z = pk2(a[8 * s + 4] * r * gv[nb][8 * s + 4], a[8 * s + 5] * r * gv[nb][8 * s + 5]);
                o.w = pk2(a[8 * s + 6] * r * gv[nb][8 * s + 6], a[8 * s + 7] * r * gv[nb][8 * s + 7]);
                *(u32x4*)(dst + ((unsigned)(((nb * 2 + s) * 4 + mb) * 64 + lane)) * 8) = o;
            }
    }
}
DI void epi_v(const f32x16 (&acc)[4][2], bf16_t* __restrict__ dst, int lane) {
    lane = opaque_v(lane);
#pragma unroll
    for (int nb = 0; nb < 2; ++nb)
#pragma unroll
        for (int mb = 0; mb < 4; ++mb)
#pragma unroll
            for (int s = 0; s < 2; ++s) {
                const f32x16& a = acc[mb][nb];
                u32x4 o; o.x = pk2(a[8 * s], a[8 * s + 1]); o.y = pk2(a[8 * s + 2], a[8 * s + 3]); o.z = pk2(a[8 * s + 4], a[8 * s + 5]); o.w = pk2(a[8 * s + 6], a[8 * s + 7]);
                *(u32x4*)(dst + ((unsigned)(((nb * 4 + mb) * 2 + s) * 64 + lane)) * 8) = o;
            }
}
DI void epi_row(const f32x16 (&acc)[4][2], bf16_t* __restrict__ dst, int ld, int lane) {
    lane = opaque_v(lane);
    const int r5 = lane & 31, hh = lane >> 5;
#pragma unroll
    for (int mb = 0; mb < 4; ++mb)
#pragma unroll
        for (int nb = 0; nb < 2; ++nb)
#pragma unroll
            for (int gq = 0; gq < 4; ++gq) {
                const f32x16& a = acc[mb][nb];
                u32x2 o; o.x = pk2(a[4 * gq], a[4 * gq + 1]); o.y = pk2(a[4 * gq + 2], a[4 * gq + 3]);
                *(u32x2*)(dst + (unsigned)((mb * 32 + r5) * ld + nb * 32 + 8 * gq + 4 * hh)) = o;
            }
}
DI void epi_z(const f32x16 (&acc)[4][2], bf16_t* __restrict__ dst, int lane) {
    lane = opaque_v(lane);
    const int r5 = lane & 31, hh = lane >> 5;
#pragma unroll
    for (int mb = 0; mb < 4; ++mb)
#pragma unroll
        for (int gq = 0; gq < 4; ++gq) {
            const f32x16 &a = acc[mb][0], &b = acc[mb][1];
            u32x2 o; o.x = pk2(a[4 * gq] * b[4 * gq], a[4 * gq + 1] * b[4 * gq + 1]); o.y = pk2(a[4 * gq + 2] * b[4 * gq + 2], a[4 * gq + 3] * b[4 * gq + 3]);
            *(u32x2*)(dst + (unsigned)((mb * 32 + r5) * 256 + 8 * gq + 4 * hh)) = o;
        }
}
DI void epi_su_park(const f32x16 (&acc)[4][2], unsigned* lds_su, int lane) {
    lane = opaque_v(lane);
#pragma unroll
    for (int mb = 0; mb < 4; ++mb)
#pragma unroll
        for (int nb = 0; nb < 2; ++nb)
#pragma unroll
            for (int q = 0; q < 8; ++q) lds_su[((mb * 2 + nb) * 8 + q) * 64 + lane] = pk2(acc[mb][nb][2 * q], acc[mb][nb][2 * q + 1]);
}
DI void epi_sv(f32x16 (&acc)[4][2], const bf16_t* __restrict__ SWF  , const float* __restrict__ bs_g, const unsigned* lds_su, bf16_t* __restrict__ dst, int lane) {
    lane = opaque_v(lane);
    const int r5 = lane & 31, hh = lane >> 5;
    bf16x8 vb[4][2][2];
#pragma unroll
    for (int mb = 0; mb < 4; ++mb) {
#pragma unroll
        for (int i = 0; i < 16; ++i) {
            float s1 = acc[mb][0][i] + acc[mb][1][i];
#pragma unroll
            for (int o = 1; o < 32; o <<= 1) s1 += __shfl_xor(s1, o);
            const float mu = s1 * (1.f / 64.f);
            const float d0 = acc[mb][0][i] - mu, d1 = acc[mb][1][i] - mu;
            float s2 = d0 * d0 + d1 * d1;
#pragma unroll
            for (int o = 1; o < 32; o <<= 1) s2 += __shfl_xor(s2, o);
            const float r = rsqrtf(s2 * (1.f / 64.f) + EPS);
            acc[mb][0][i] = d0 * r; acc[mb][1][i] = d1 * r;
        }
#pragma unroll
        for (int s = 0; s < 2; ++s)
#pragma unroll
            for (int nb = 0; nb < 2; ++nb) {
                const f32x16& a = acc[mb][nb];
                u32x4 o; o.x = pk2(a[8 * s], a[8 * s + 1]); o.y = pk2(a[8 * s + 2], a[8 * s + 3]); o.z = pk2(a[8 * s + 4], a[8 * s + 5]); o.w = pk2(a[8 * s + 6], a[8 * s + 7]);
                vb[mb][s][nb] = __builtin_bit_cast(bf16x8, o);
            }
    }
#pragma unroll
    for (int tb = 0; tb < 4; ++tb) {
        f32x16 y[2];
#pragma unroll
        for (int nb = 0; nb < 2; ++nb)
#pragma unroll
            for (int i = 0; i < 16; ++i) y[nb][i] = 0.f;
#pragma unroll
        for (int kt = 0; kt <= tb; ++kt)
#pragma unroll
            for (int s = 0; s < 2; ++s) {
                const bf16x8 wa = *(const bf16x8*)(SWF + ((unsigned)(((tb * 4 + kt) * 2 + s) * 64 + lane)) * 8);
                y[0] = MFMA32(wa, vb[kt][s][0], y[0]);
                y[1] = MFMA32(wa, vb[kt][s][1], y[1]);
            }
#pragma unroll
        for (int nb = 0; nb < 2; ++nb)
#pragma unroll
            for (int q = 0; q < 8; ++q) {
                const unsigned su2 = lds_su[((tb * 2 + nb) * 8 + q) * 64 + lane];
                const int i0 = 2 * q, i1 = 2 * q + 1;
                const int t0 = tb * 32 + (i0 & 3) + 8 * (i0 >> 2) + 4 * hh, t1 = tb * 32 + (i1 & 3) + 8 * (i1 >> 2) + 4 * hh;
                const float v0 = (y[nb][i0] + bs_g[t0]) * __uint_as_float(su2 << 16), v1 = (y[nb][i1] + bs_g[t1]) * __uint_as_float(su2 & 0xffff0000u);
                const unsigned pk = pk2(v0, v1);
                dst[(unsigned)(t0 * 256 + nb * 32 + r5)] = (bf16_t)(pk & 0xffffu);
                dst[(unsigned)(t1 * 256 + nb * 32 + r5)] = (bf16_t)(pk >> 16);
            }
    }
}

DI void conv_sguw_item(const float* __restrict__ W, bf16_t* __restrict__ SWF, int gid) {
    const int lane = gid & 63, s = (gid >> 6) & 1, kt = (gid >> 7) & 3, tb = (gid >> 9) & 3, g = gid >> 11;
    const int r = lane & 31, hh = lane >> 5, t = tb * 32 + r;
    const float* p = W + ((size_t)g * 128 + t) * 128;
    float v[8];
#pragma unroll
    for (int j = 0; j < 8; ++j) { const int sp = kt * 32 + 16 * s + 8 * (j >> 2) + 4 * hh + (j & 3); v[j] = sp <= t ? p[sp] : 0.f; }
    u32x4 o; o.x = pk2(v[0], v[1]); o.y = pk2(v[2], v[3]); o.z = pk2(v[4], v[5]); o.w = pk2(v[6], v[7]);
    *(u32x4*)(SWF + (size_t)gid * 8) = o;
}

DI int t5_bucket(int d) {
    if (d < 16) return d;
    const float lr = logf((float)d / 16.f) / logf(8.f);
    const int large = 16 + (int)(lr * 16.f);
    return large < 31 ? large : 31;
}

DI void attn_tile(const bf16_t* __restrict__ QF, const bf16_t* __restrict__ KF2, const bf16_t* __restrict__ VF, char* lds, const float* bias_lds, const float* __restrict__ sink, bf16_t* __restrict__ OR, int tile, int tid) {
    tid = opaque_v(tid); tile = opaque_s(tile);
    const int lane = tid & 63, w = __builtin_amdgcn_readfirstlane(tid >> 6), r5 = lane & 31, hh = lane >> 5;
    const bool has_prev = (tile & 31) != 0;
    {
        u32x4 tmp[16];
#pragma unroll
        for (int i = 0; i < 16; ++i) {
            const int blk = w * 16 + i;
            const int isv = blk >> 6, bb = blk & 63;
            const bf16_t* src;
            if (!isv) { const int kvh = bb >> 5, ks = (bb >> 3) & 3, wt = bb & 7, st = (wt >= 4 || !has_prev) ? tile : tile - 1;
                src = KF2 + ((unsigned)((((st * 2 + kvh) * 4 + ks) * 4 + (wt & 3)) * 64 + lane)) * 8; }
            else { const int kvh = bb >> 5, dt = (bb >> 4) & 1, wt = (bb >> 1) & 7, s2 = bb & 1, st = (wt >= 4 || !has_prev) ? tile : tile - 1;
                src = VF + ((unsigned)(((((st * 2 + kvh) * 2 + dt) * 4 + (wt & 3)) * 2 + s2) * 64 + lane)) * 8; }
            tmp[i] = *(const u32x4*)src;
        }
#pragma unroll
        for (int i = 0; i < 16; ++i) *(u32x4*)(lds + (w * 16 + i) * 1024 + lane * 16) = tmp[i];
    }
    __syncthreads();
    const char* ldsK = lds, *ldsV = lds + 65536;
    for (int task = w; task < 32; task += 8) {
        const int qh = task >> 2, qt = task & 3, kvh = qh >> 2;
        bf16x8 bq[4];
#pragma unroll
        for (int ks = 0; ks < 4; ++ks) bq[ks] = *(const bf16x8*)(QF + ((unsigned)((((tile * 8 + qh) * 4 + ks) * 4 + qt) * 64 + lane)) * 8);
        f32x16 sc[5];
#pragma unroll
        for (int jj = 0; jj < 5; ++jj) {
#pragma unroll
            for (int i = 0; i < 16; ++i) sc[jj][i] = 0.f;
#pragma unroll
            for (int ks = 0; ks < 4; ++ks) {
                const bf16x8 kf = *(const bf16x8*)(ldsK + ((kvh * 4 + ks) * 8 + qt + jj) * 1024 + lane * 16);
                sc[jj] = MFMA32(kf, bq[ks], sc[jj]);
            }
        }
        const float* bl = bias_lds + qh * 128;
        float m = -1e30f;
#pragma unroll
        for (int jj = 0; jj < 5; ++jj) {
            const bool ex = (qt + jj >= 4) || has_prev;
#pragma unroll
            for (int i = 0; i < 16; ++i) {
                const int cr = (i & 3) + 8 * (i >> 2) + 4 * hh;
                const int dist = 128 + r5 - 32 * jj - cr;
                const bool valid = ex && dist >= 0 && dist < 128;
                float bv = bl[dist & 127];
                asm volatile("" : "+v"(bv));
                const float v = valid ? sc[jj][i] + bv : -1e30f;
                sc[jj][i] = v; m = fmaxf(m, v);
            }
        }
        m = fmaxf(m, __shfl_xor(m, 32));
        const float sk = sink[qh];
        m = fmaxf(m, sk);
        float l = 0.f;
#pragma unroll
        for (int jj = 0; jj < 5; ++jj)
#pragma unroll
            for (int i = 0; i < 16; ++i) { const float p = __expf(sc[jj][i] - m); sc[jj][i] = p; l += p; }
        l += __shfl_xor(l, 32);
        l += __expf(sk - m);
        const float rl = 1.f / l;
        f32x16 o[2];
#pragma unroll
        for (int dt = 0; dt < 2; ++dt)
#pragma unroll
            for (int i = 0; i < 16; ++i) o[dt][i] = 0.f;
#pragma unroll
        for (int jj = 0; jj < 5; ++jj) {
#pragma unroll
            for (int s = 0; s < 2; ++s) {
                const f32x16& a = sc[jj];
                u32x4 pp; pp.x = pk2(a[8 * s], a[8 * s + 1]); pp.y = pk2(a[8 * s + 2], a[8 * s + 3]); pp.z = pk2(a[8 * s + 4], a[8 * s + 5]); pp.w = pk2(a[8 * s + 6], a[8 * s + 7]);
                const bf16x8 pb = __builtin_bit_cast(bf16x8, pp);
#pragma unroll
                for (int dt = 0; dt < 2; ++dt) {
                    const bf16x8 vf = *(const bf16x8*)(ldsV + (((kvh * 2 + dt) * 8 + qt + jj) * 2 + s) * 1024 + lane * 16);
                    o[dt] = MFMA32(vf, pb, o[dt]);
                }
            }
        }
        bf16_t* orow = OR + (unsigned)((tile * 128 + qt * 32 + r5) * 512 + qh * 64 + 4 * hh);
#pragma unroll
        for (int dt = 0; dt < 2; ++dt)
#pragma unroll
            for (int gq = 0; gq < 4; ++gq) {
                u32x2 ov; ov.x = pk2(o[dt][4 * gq] * rl, o[dt][4 * gq + 1] * rl); ov.y = pk2(o[dt][4 * gq + 2] * rl, o[dt][4 * gq + 3] * rl);
                *(u32x2*)(orow + dt * 32 + 8 * gq) = ov;
            }
    }
}

DI void unpack8(const u32x4 v, float (&f)[8]) {
    f[0] = __uint_as_float(v.x << 16); f[1] = __uint_as_float(v.x & 0xffff0000u); f[2] = __uint_as_float(v.y << 16); f[3] = __uint_as_float(v.y & 0xffff0000u);
    f[4] = __uint_as_float(v.z << 16); f[5] = __uint_as_float(v.z & 0xffff0000u); f[6] = __uint_as_float(v.w << 16); f[7] = __uint_as_float(v.w & 0xffff0000u);
}
DI void merge_tile(const bf16_t* __restrict__ OR, const bf16_t* __restrict__ CBR, const bf16_t* __restrict__ ZR, const bf16_t* __restrict__ YS, const float* __restrict__ cw  , const float* __restrict__ og  ,
                   bf16_t* __restrict__ mA, int tile, int tid) {
    tid = opaque_v(tid); tile = opaque_s(tile);
    const int lane = tid & 63, w = tid >> 6;
    float cwv[3][8], ga[8], gb[8];
    {
        const int c0 = (lane & 31) * 8;
#pragma unroll
        for (int j = 0; j < 3; ++j) { const float4 p0 = *(const float4*)(cw + j * 256 + c0), p1 = *(const float4*)(cw + j * 256 + c0 + 4);
            cwv[j][0] = p0.x; cwv[j][1] = p0.y; cwv[j][2] = p0.z; cwv[j][3] = p0.w; cwv[j][4] = p1.x; cwv[j][5] = p1.y; cwv[j][6] = p1.z; cwv[j][7] = p1.w; }
        const float4 a0 = *(const float4*)(og + lane * 8), a1 = *(const float4*)(og + lane * 8 + 4), b0 = *(const float4*)(og + 512 + lane * 8), b1 = *(const float4*)(og + 512 + lane * 8 + 4);
        ga[0] = a0.x; ga[1] = a0.y; ga[2] = a0.z; ga[3] = a0.w; ga[4] = a1.x; ga[5] = a1.y; ga[6] = a1.z; ga[7] = a1.w;
        gb[0] = b0.x; gb[1] = b0.y; gb[2] = b0.z; gb[3] = b0.w; gb[4] = b1.x; gb[5] = b1.y; gb[6] = b1.z; gb[7] = b1.w;
    }
#pragma unroll 8
    for (int rr = 0; rr < 16; ++rr) {
        const int row = w * 16 + rr, t = tile * 128 + row, pos = t & (S - 1);
        float a[8], y[8];
        unpack8(*(const u32x4*)(OR + (unsigned)(t * 512 + lane * 8)), a);
        float ssa = 0.f;
#pragma unroll
        for (int q = 0; q < 8; ++q) ssa += a[q] * a[q];
        ssa = wave_sum(ssa);
        {
            const int c0 = (lane & 31) * 8;
            float cb[8], z0[8], z1[8], z2[8], ys[8];
            const float m1 = pos >= 1 ? 1.f : 0.f, m2 = pos >= 2 ? 1.f : 0.f;
            const int t1 = pos >= 1 ? t - 1 : t, t2 = pos >= 2 ? t - 2 : t;
            unpack8(*(const u32x4*)(CBR + (unsigned)(t * 256 + c0)), cb);
            unpack8(*(const u32x4*)(ZR + (unsigned)(t * 256 + c0)), z2);
            unpack8(*(const u32x4*)(ZR + (unsigned)(t1 * 256 + c0)), z1);
            unpack8(*(const u32x4*)(ZR + (unsigned)(t2 * 256 + c0)), z0);
            unpack8(*(const u32x4*)(YS + (unsigned)(t * 256 + c0)), ys);
#pragma unroll
            for (int q = 0; q < 8; ++q) {
                const float yc = cb[q] * (cwv[0][q] * (z0[q] * m2) + cwv[1][q] * (z1[q] * m1) + cwv[2][q] * z2[q]);
                y[q] = lane < 32 ? yc : ys[q];
            }
        }
        float ssy = 0.f;
#pragma unroll
        for (int q = 0; q < 8; ++q) ssy += y[q] * y[q];
#pragma unroll
        for (int o = 1; o < 32; o <<= 1) ssy += __shfl_xor(ssy, o);
        const float ra = rsqrtf(ssa * (1.f / 512.f) + EPS), ry = rsqrtf(ssy * (1.f / 256.f) + EPS);
        const int mb = row >> 5, r5 = row & 31;
        {
            u32x4 o; o.x = pk2(a[0] * ra * ga[0], a[1] * ra * ga[1]); o.y = pk2(a[2] * ra * ga[2], a[3] * ra * ga[3]); o.z = pk2(a[4] * ra * ga[4], a[5] * ra * ga[5]); o.w = pk2(a[6] * ra * ga[6], a[7] * ra * ga[7]);
            const int c8 = lane;
            (void)c8;
            *(u32x4*)(mA + (unsigned)(t * 1024 + lane * 8)) = o;
        }
        {
            u32x4 o; o.x = pk2(y[0] * ry * gb[0], y[1] * ry * gb[1]); o.y = pk2(y[2] * ry * gb[2], y[3] * ry * gb[3]); o.z = pk2(y[4] * ry * gb[4], y[5] * ry * gb[5]); o.w = pk2(y[6] * ry * gb[6], y[7] * ry * gb[7]);
            const int c8 = 64 + lane;
            (void)c8;
            *(u32x4*)(mA + (unsigned)(t * 1024 + 512 + lane * 8)) = o;
        }
    }
}

struct InProjOut { bf16_t *QF, *KF2, *VF, *CBR, *ZR, *YS; };
DI void inproj_tile(const bf16_t* __restrict__ At, const bf16_t* __restrict__ WF, const float* __restrict__ qg, const float* __restrict__ kg, const bf16_t* __restrict__ SWF, const float* __restrict__ sgu_b,
                    const InProjOut& O, char* lds, int tile, int tid) {
    tid = opaque_v(tid); tile = opaque_s(tile);
    const int lane = tid & 63, w = __builtin_amdgcn_readfirstlane(tid >> 6);
    f32x16 acc[4][2];
    {
        const int nbt0 = w * 2;
        kloop<1>(acc, At, WF + (size_t)nbt0 * 32768, WF + (size_t)(nbt0 + 1) * 32768, lds, tid, lane);
        epi_qk(acc, qg, 0.125f, O.QF + (size_t)(tile * 8 + w) * 8192, lane);
    }
    {
        const int nbt0 = 16 + w * 2;
        if (w == 2 || w == 3) {
            kloop<0>(acc, At, WF + (size_t)nbt0 * 32768, WF + (size_t)(nbt0 + 1) * 32768, lds, tid, lane);
            epi_v(acc, O.VF + (size_t)(tile * 2 + (w - 2)) * 8192, lane);
        } else {
            kloop<1>(acc, At, WF + (size_t)nbt0 * 32768, WF + (size_t)(nbt0 + 1) * 32768, lds, tid, lane);
            if (w < 2) epi_qk(acc, kg, 1.f, O.KF2 + (size_t)(tile * 2 + w) * 8192, lane);
            else epi_row(acc, O.CBR + (size_t)tile * 128 * 256 + (w - 4) * 64, 256, lane);
        }
    }
    {
        const int nbt0 = 32 + w * 2;
        kloop<1>(acc, At, WF + (size_t)nbt0 * 32768, WF + (size_t)(nbt0 + 1) * 32768, lds, tid, lane);
        epi_z(acc, O.ZR + (size_t)tile * 128 * 256 + w * 32, lane);
    }
    {
        const int nbt0 = 48 + w * 2;
        kloop<0>(acc, At, WF + (size_t)nbt0 * 32768, WF + (size_t)(nbt0 + 1) * 32768, lds, tid, lane);
        unsigned* lds_su = (unsigned*)lds;
        if (w < 4) epi_su_park(acc, lds_su + w * 4096, lane);
        __syncthreads();
        if (w >= 4) epi_sv(acc, SWF + (size_t)(w - 4) * 16384, sgu_b + (w - 4) * 128, lds_su + (w - 4) * 4096, O.YS + (size_t)tile * 128 * 256 + (w - 4) * 64, lane);
        __syncthreads();
    }
}


struct Params {
    const float *x, *c, *rel_bias, *w_ada, *b_ada, *norm1_g, *norm2_g, *w_in, *q_norm_g, *k_norm_g, *attn_sink, *conv_w, *sgu_w, *sgu_b, *out_norm_g, *w_out, *peer_wq, *peer_sub_keys, *peer_down, *peer_up;
    float* out;
    char* ws;
};
constexpr size_t MiB = 1u << 20;
constexpr size_t WS_MOD = 0;
constexpr size_t WS_MODP = 1 * MiB;
constexpr size_t WS_WIN = 13 * MiB;
constexpr size_t WS_WOUT = 29 * MiB;
constexpr size_t WS_WPQ = 37 * MiB;
constexpr size_t WS_KEYS = 53 * MiB;
constexpr size_t WS_SWF = 55 * MiB;
constexpr size_t WS_SC = 56 * MiB;
constexpr size_t WS_TB = 57 * MiB;
constexpr size_t WS_HA = 185 * MiB;
constexpr size_t WS_QF = 249 * MiB;
constexpr size_t WS_KF2 = 602 * MiB;
constexpr size_t WS_VF = 634 * MiB;
constexpr size_t WS_ZR = 666 * MiB;
constexpr size_t WS_CBR = 345 * MiB;
constexpr size_t WS_YS = 361 * MiB;
constexpr size_t WS_OR = 377 * MiB;
constexpr size_t WS_QPF = 409 * MiB;
constexpr size_t WS_RIDX = 537 * MiB;
constexpr size_t WS_RGATE = 553 * MiB;
constexpr size_t WS_SEID = 569 * MiB;
constexpr size_t WS_SWGT = 585 * MiB;
constexpr size_t WS_OFFS = 601 * MiB;
constexpr size_t WS_FLAGS = 601 * MiB + 512 * 1024;
constexpr size_t WS_END = 730 * MiB;
static_assert(PL_END <= LDS_RSTD1, "expert-phase lists overlap persistent LDS state");

__global__ __launch_bounds__(512) void hybrid_fwd(Params P) {
    extern __shared__ __attribute__((aligned(16))) char lds[];
    cg::grid_group grid = cg::this_grid();
    const int tid = threadIdx.x, lane = tid & 63, w = __builtin_amdgcn_readfirstlane(tid >> 6);
    const int nblk = gridDim.x, hwb = blockIdx.x;
    const int bid = (nblk == NTILE) ? (hwb & 7) * 32 + (hwb >> 3) : hwb;
    char* ws = P.ws;
    float* mod = (float*)(ws + WS_MOD);
    float* modp = (float*)(ws + WS_MODP);
    bf16_t* WinF = (bf16_t*)(ws + WS_WIN); bf16_t* WoutF = (bf16_t*)(ws + WS_WOUT); bf16_t* WpqF = (bf16_t*)(ws + WS_WPQ);
    bf16_t* KeysF = (bf16_t*)(ws + WS_KEYS); bf16_t* SWF = (bf16_t*)(ws + WS_SWF);
    float* SC = (float*)(ws + WS_SC); unsigned char* TBd = (unsigned char*)(ws + WS_TB); unsigned char* TBu = TBd + 32 * MiB;
    bf16_t* hA = (bf16_t*)(ws + WS_HA);
    bf16_t* OR = (bf16_t*)(ws + WS_OR); bf16_t* QPF = (bf16_t*)(ws + WS_QPF);
    int* ridx = (int*)(ws + WS_RIDX); float* rgate = (float*)(ws + WS_RGATE);
    float* bias_lds = (float*)(lds + LDS_BIAS);
    unsigned* flags = (unsigned*)(ws + WS_FLAGS);

    {
        float* ca = (float*)lds;
        if (tid == 0) for (int tile = bid; tile < NTILE; tile += nblk) __hip_atomic_store(flags + tile, 0u, __ATOMIC_RELAXED, __HIP_MEMORY_SCOPE_AGENT);
        for (int i = tid; i < 8192; i += 512) { const float v = P.c[i]; ca[i] = v / (1.f + __expf(-v)); }
        for (int i = tid; i < 1024; i += 512) bias_lds[i] = P.rel_bias[t5_bucket(i & 127) * 8 + (i >> 7)];
        __syncthreads();
        for (int it = bid; it < 768; it += nblk) {
            const int jc = it % 12, l = (it / 12) & 3, ks = it / 48;
            const int j = jc * 512 + tid;
            const float* wp = P.w_ada + ((size_t)l * 1024 + ks * 64) * 6144 + j;
            float acc[8];
#pragma unroll
            for (int b = 0; b < 8; ++b) acc[b] = 0.f;
#pragma unroll 4
            for (int i = 0; i < 64; ++i) {
                const float wv = wp[(size_t)i * 6144];
#pragma unroll
                for (int b = 0; b < 8; ++b) acc[b] += ca[b * 1024 + ks * 64 + i] * wv;
            }
#pragma unroll
            for (int b = 0; b < 8; ++b) modp[((size_t)(ks * 4 + l) * 8 + b) * 6144 + j] = acc[b];
        }
        const int gthreads = nblk * 512, gtid = bid * 512 + tid;
        for (int rep = 0; rep < REP_P0; ++rep)
        for (int l = 0; l < DEPTH; ++l) {
            for (int g = gtid; g < 64 * 64 * 64; g += gthreads) conv_wfrag_item(P.w_in + (size_t)l * 1024 * 2048, 2048, 64, WinF + (size_t)l * 2097152, g, 1);
            for (int g = gtid; g < 32 * 64 * 64; g += gthreads) conv_wfrag_item(P.w_out + (size_t)l * 1024 * 1024, 1024, 64, WoutF + (size_t)l * 1048576, g, 0);
            for (int g = gtid; g < 64 * 64 * 64; g += gthreads) conv_wfrag_item(P.peer_wq + (size_t)l * 1024 * 2048, 2048, 64, WpqF + (size_t)l * 2097152, g, 0);
            for (int g = gtid; g < 32768; g += gthreads) conv_keys_item(P.peer_sub_keys + (size_t)l * 262144, KeysF + (size_t)l * 262144, g);
            for (int g = gtid; g < 8192; g += gthreads) conv_sguw_item(P.sgu_w + (size_t)l * 65536, SWF + (size_t)l * 65536, g);
        }
        const int gwaves = nblk * 8, gw = bid * 8 + w;
        for (int rep = 0; rep < REP_P0; ++rep)
        for (int r = gw; r < DEPTH * 16384 * 2; r += gwaves) {
            const int which = r & 1, le = r >> 1;
            conv_table_row((which ? P.peer_up : P.peer_down) + (size_t)le * D, (which ? TBu : TBd) + (size_t)le * 512, SC + (size_t)le * 2 + which, lane, which == 0);
        }
    }
    grid.sync();
    for (int tile = bid; tile < NTILE; tile += nblk) {
        const int b = tile >> 5;
        for (int l = 0; l < DEPTH; ++l)
            for (int j = tid; j < 6144; j += 512) {
                float v = P.b_ada[l * 6144 + j];
#pragma unroll
                for (int ks = 0; ks < 16; ++ks) v += modp[((size_t)(ks * 4 + l) * 8 + b) * 6144 + j];
                mod[((size_t)l * 8 + b) * 6144 + j] = v;
            }
    }
    __syncthreads();

    for (int l = 0; l < DEPTH; ++l) {
        const float* xin = l == 0 ? P.x : P.out;
        InProjOut IO;
        IO.QF = (bf16_t*)(ws + WS_QF); IO.KF2 = (bf16_t*)(ws + WS_KF2 + (size_t)l * 8 * MiB); IO.VF = (bf16_t*)(ws + WS_VF + (size_t)l * 8 * MiB);
        IO.CBR = (bf16_t*)(ws + WS_CBR); IO.ZR = (bf16_t*)(ws + WS_ZR + (size_t)l * 16 * MiB); IO.YS = (bf16_t*)(ws + WS_YS);
        for (int tile = bid; tile < NTILE; tile += nblk) {
            const float* mb_ = mod + ((size_t)l * 8 + (tile >> 5)) * 6144;
            const bool have1 = l > 0 && nblk == NTILE;
            if (have1) { if (tid < 128) ((float*)lds)[tid] = ((const float*)(lds + LDS_RSTD1))[tid]; __syncthreads(); }
            norm_to_frag(xin, P.norm1_g + l * D, mb_ + 0, mb_ + 1024, hA, (float*)lds, tile, tid, have1);
            __syncthreads();
            for (int rep = 0; rep < REP_GEMM; ++rep) inproj_tile(hA + (size_t)tile * 131072, WinF + (size_t)l * 2097152, P.q_norm_g + l * 64, P.k_norm_g + l * 64, SWF + (size_t)l * 65536, P.sgu_b + l * 512, IO, lds, tile, tid);
            asm volatile("s_waitcnt vmcnt(0)" ::: "memory");
            __syncthreads();
            if (tid == 0) {
                __builtin_amdgcn_fence(__ATOMIC_RELEASE, "agent");
                asm volatile("s_waitcnt vmcnt(0)" ::: "memory");
                __hip_atomic_store(flags + tile, (unsigned)(l + 1), __ATOMIC_RELAXED, __HIP_MEMORY_SCOPE_AGENT);
            }
        }
        for (int tile = bid; tile < NTILE; tile += nblk) {
            const float* mb_ = mod + ((size_t)l * 8 + (tile >> 5)) * 6144;
            if ((tile & 31) != 0) {
                if (tid == 0) {
                    unsigned spins = 0;
                    while (__hip_atomic_load(flags + tile - 1, __ATOMIC_RELAXED, __HIP_MEMORY_SCOPE_AGENT) < (unsigned)(l + 1) && ++spins < (1u << 24)) __builtin_amdgcn_s_sleep(2);
                    __builtin_amdgcn_fence(__ATOMIC_ACQUIRE, "agent");
                    asm volatile("s_waitcnt vmcnt(0)" ::: "memory");
                }
                __syncthreads();
            }
            for (int rep = 0; rep < REP_MIX; ++rep) {
            attn_tile(IO.QF, IO.KF2, IO.VF, lds, bias_lds, P.attn_sink + l * 8, OR, tile, tid);
            __syncthreads();
            merge_tile(OR, IO.CBR, IO.ZR, IO.YS, P.conv_w + l * 768, P.out_norm_g + l * D, hA, tile, tid);
            __syncthreads();
            }
            {
                const bf16_t* At = hA + (size_t)tile * 131072;
                const bf16_t* WF = WoutF + (size_t)l * 1048576;
                for (int pass = 0; pass < 2; ++pass) {
                    f32x16 acc[4][2];
                    const int nbt0 = pass * 16 + w * 2;
                    kloop<0>(acc, At, WF + (size_t)nbt0 * 32768, WF + (size_t)(nbt0 + 1) * 32768, lds, tid, lane);
                    epi_resid(acc, xin, P.out, mb_ + 2048, (float*)(lds + LDS_EPI) + w * 2176, (float*)(lds + LDS_SSQ) + (pass * 8 + w) * 128, tile, pass * 512 + w * 64, lane);
                }
            }
            __syncthreads();
            if (tid < 128) { const float* sq = (const float*)(lds + LDS_SSQ); float ssum = 0.f;
#pragma unroll
                for (int c = 0; c < 16; ++c) ssum += sq[c * 128 + tid];
                ((float*)lds)[tid] = rsqrtf(ssum * (1.f / D) + EPS); }
            __syncthreads();
            norm_to_frag(P.out, P.norm2_g + l * D, mb_ + 3072, mb_ + 4096, hA, (float*)lds, tile, tid, true);
            __syncthreads();
            {
                const bf16_t* At = hA + (size_t)tile * 131072;
                const bf16_t* WF = WpqF + (size_t)l * 2097152;
                for (int rep = 0; rep < REP_GEMM; ++rep)
                for (int pass = 0; pass < 4; ++pass) {
                    f32x16 acc[4][2];
                    const int nbt0 = pass * 16 + w * 2;
                    kloop<1>(acc, At, WF + (size_t)nbt0 * 32768, WF + (size_t)(nbt0 + 1) * 32768, lds, tid, lane);
                    epi_qpf(acc, QPF, tile, nbt0, lane);
                }
            }
            __syncthreads();
            for (int rep = 0; rep < REP_ROUTE; ++rep) { route_tile(QPF, KeysF + (size_t)l * 262144, lds, (unsigned char*)lds + PL_RIDX, tile, tid); __syncthreads(); }
            peer_down_wave(hA, lds, TBd + (size_t)l * 16384 * 512, SC + (size_t)l * 32768, tile, w, lane);
            __syncthreads();
            peer_up_wave(lds, TBu + (size_t)l * 16384 * 512, mb_ + 5120, P.out, tile, w, lane);
            __syncthreads();
        }
    }
}
}

extern "C" void kernel_launch(void* const* d_in, const int* in_sizes, int n_in, void* d_out, int out_size, void* d_ws, size_t ws_size, hipStream_t stream) {
    using namespace op;
    static int grid_blocks = 0;
    if (!grid_blocks) {
        int dev = 0, cus = 0, per_cu = 0;
        (void)hipGetDevice(&dev);
        (void)hipDeviceGetAttribute(&cus, hipDeviceAttributeMultiprocessorCount, dev);
        (void)hipFuncSetAttribute((const void*)hybrid_fwd, hipFuncAttributeMaxDynamicSharedMemorySize, LDS_BYTES);
        (void)hipOccupancyMaxActiveBlocksPerMultiprocessor(&per_cu, (const void*)hybrid_fwd, 512, LDS_BYTES);
        if (per_cu < 1) per_cu = 1;
        grid_blocks = cus * per_cu;
        if (grid_blocks > NTILE) grid_blocks = NTILE;
        if (ws_size < WS_END) { fprintf(stderr, "kernel_launch: workspace too small (%zu < %zu)\n", ws_size, (size_t)WS_END); grid_blocks = -1; }
    }
    if (grid_blocks < 0) return;
    Params p{};
    p.x = (const float*)d_in[0]; p.c = (const float*)d_in[1]; p.rel_bias = (const float*)d_in[2]; p.w_ada = (const float*)d_in[3]; p.b_ada = (const float*)d_in[4];
    p.norm1_g = (const float*)d_in[5]; p.norm2_g = (const float*)d_in[6]; p.w_in = (const float*)d_in[7]; p.q_norm_g = (const float*)d_in[8]; p.k_norm_g = (const float*)d_in[9];
    p.attn_sink = (const float*)d_in[10]; p.conv_w = (const float*)d_in[11]; p.sgu_w = (const float*)d_in[12]; p.sgu_b = (const float*)d_in[13]; p.out_norm_g = (const float*)d_in[14];
    p.w_out = (const float*)d_in[15]; p.peer_wq = (const float*)d_in[16]; p.peer_sub_keys = (const float*)d_in[17]; p.peer_down = (const float*)d_in[18]; p.peer_up = (const float*)d_in[19];
    p.out = (float*)d_out; p.ws = (char*)d_ws;
    void* args[] = {&p};
    hipError_t e = hipLaunchCooperativeKernel((const void*)hybrid_fwd, dim3(grid_blocks), dim3(512), args, LDS_BYTES, stream);
    if (e != hipSuccess) fprintf(stderr, "kernel_launch: cooperative launch failed: %s (grid %d)\n", hipGetErrorString(e), grid_blocks);
}
```

```cpp
#include <hip/hip_runtime.h>
#include <cstdio>
#include <cstdint>
#include <hip/hip_cooperative_groups.h>
namespace cg = cooperative_groups;


namespace op {
#define DI __device__ __forceinline__
typedef unsigned short bf16_t;
typedef short bf16x8 __attribute__((ext_vector_type(8)));
typedef float f32x16 __attribute__((ext_vector_type(16)));
typedef float f32x2 __attribute__((ext_vector_type(2)));
typedef unsigned u32x4 __attribute__((ext_vector_type(4)));
typedef unsigned u32x2 __attribute__((ext_vector_type(2)));
typedef __bf16 bf16v2 __attribute__((ext_vector_type(2)));
constexpr int D = 1024, NB = 8, S = 4096, DEPTH = 4, T = NB * S, NTILE = T / 128;
constexpr float EPS = 1e-6f;
constexpr int PL_SEID = 0, PL_SWGT = 32768, PL_END = 98304, PL_RIDX = 98304;
constexpr int LDS_EPI = 32768, LDS_SSQ = 102400, LDS_RSTD1 = 110592, LDS_BIAS = 128 * 1024, LDS_BYTES = 132 * 1024;
constexpr int REP_GEMM = 1, REP_ROUTE = 1, REP_MIX = 1, REP_NORM = 1, REP_P0 = 1;
#define MFMA32(a, b, c) __builtin_amdgcn_mfma_f32_32x32x16_bf16((a), (b), (c), 0, 0, 0)

DI unsigned pk2(float lo, float hi) { f32x2 v = {lo, hi}; return __builtin_bit_cast(unsigned, __builtin_convertvector(v, bf16v2)); }
DI int opaque_v(int x) { asm volatile("" : "+v"(x)); return x; }
DI int opaque_s(int x) { asm volatile("" : "+s"(x)); return x; }
DI int crow(int reg, int hh) { return (reg & 3) + 8 * (reg >> 2) + 4 * hh; }
DI float wave_sum(float v) {
#pragma unroll
    for (int o = 1; o < 64; o <<= 1) v += __shfl_xor(v, o);
    return v;
}

DI int col_perm(int npos, int mode) {
    if (mode == 1 && npos >= 1024 && npos < 1536) { const int q = npos - 1024, w = q >> 6, nb = (q >> 5) & 1, r = q & 31; return (nb ? 1280 : 1024) + 32 * w + r; }
    return npos;
}
DI void conv_wfrag_item(const float* __restrict__ W, int N, int KB, bf16_t* __restrict__ WF, int gid, int mode) {
    const int l = gid & 63, kb = (gid >> 6) % KB, nbt = (gid >> 6) / KB, r = l & 31, hh = l >> 5;
    const int n = col_perm(nbt * 32 + r, mode);
    const float* p = W + (size_t)(kb * 16 + 8 * hh) * N + n;
    float v[8];
#pragma unroll
    for (int j = 0; j < 8; ++j) v[j] = p[(size_t)j * N];
    u32x4 o; o.x = pk2(v[0], v[1]); o.y = pk2(v[2], v[3]); o.z = pk2(v[4], v[5]); o.w = pk2(v[6], v[7]);
    *(u32x4*)(WF + (size_t)gid * 8) = o;
}

DI void norm_to_frag(const float* __restrict__ x, const float* __restrict__ g, const float* __restrict__ sh, const float* __restrict__ sc, bf16_t* __restrict__ hA, float* rstd_lds, int tile, int tid, bool have_rstd) {
    tid = opaque_v(tid); tile = opaque_s(tile);
    const int w = tid >> 6, lane = tid & 63;
    float cg[16], cs[16], ch[16];
#pragma unroll
    for (int j = 0; j < 2; ++j)
#pragma unroll
        for (int q = 0; q < 2; ++q) {
            const int c = 512 * j + 8 * lane + 4 * q;
            const float4 a = *(const float4*)(g + c), b = *(const float4*)(sc + c), d = *(const float4*)(sh + c);
            cg[8 * j + 4 * q] = a.x * (1.f + b.x); cg[8 * j + 4 * q + 1] = a.y * (1.f + b.y); cg[8 * j + 4 * q + 2] = a.z * (1.f + b.z); cg[8 * j + 4 * q + 3] = a.w * (1.f + b.w);
            ch[8 * j + 4 * q] = d.x; ch[8 * j + 4 * q + 1] = d.y; ch[8 * j + 4 * q + 2] = d.z; ch[8 * j + 4 * q + 3] = d.w;
            cs[8 * j + 4 * q] = 0.f; cs[8 * j + 4 * q + 1] = 0.f; cs[8 * j + 4 * q + 2] = 0.f; cs[8 * j + 4 * q + 3] = 0.f;
        }
    (void)cs;
#pragma unroll 4
    for (int rr = 0; rr < 16; ++rr) {
        const int row = w * 16 + rr;
        const float* xr = x + ((size_t)tile * 128 + row) * D + 8 * lane;
        float v[16];
#pragma unroll
        for (int j = 0; j < 2; ++j)
#pragma unroll
            for (int q = 0; q < 2; ++q) { const float4 a = *(const float4*)(xr + 512 * j + 4 * q); v[8 * j + 4 * q] = a.x; v[8 * j + 4 * q + 1] = a.y; v[8 * j + 4 * q + 2] = a.z; v[8 * j + 4 * q + 3] = a.w; }
        float r;
        if (have_rstd) r = rstd_lds[row];
        else {
            float ss = 0.f;
#pragma unroll
            for (int e = 0; e < 16; ++e) ss += v[e] * v[e];
            r = rsqrtf(wave_sum(ss) * (1.f / D) + EPS);
        }
        bf16_t* orow = hA + ((size_t)tile * 128 + row) * D + 8 * lane;
#pragma unroll
        for (int j = 0; j < 2; ++j) {
            u32x4 o;
            o.x = pk2(v[8 * j] * r * cg[8 * j] + ch[8 * j], v[8 * j + 1] * r * cg[8 * j + 1] + ch[8 * j + 1]);
            o.y = pk2(v[8 * j + 2] * r * cg[8 * j + 2] + ch[8 * j + 2], v[8 * j + 3] * r * cg[8 * j + 3] + ch[8 * j + 3]);
            o.z = pk2(v[8 * j + 4] * r * cg[8 * j + 4] + ch[8 * j + 4], v[8 * j + 5] * r * cg[8 * j + 5] + ch[8 * j + 5]);
            o.w = pk2(v[8 * j + 6] * r * cg[8 * j + 6] + ch[8 * j + 6], v[8 * j + 7] * r * cg[8 * j + 7] + ch[8 * j + 7]);
            *(u32x4*)(orow + 512 * j) = o;
        }
    }
}

template <int ORIENT>
DI void kloop(f32x16 (&acc)[4][2], const bf16_t* __restrict__ At, const bf16_t* __restrict__ W0, const bf16_t* __restrict__ W1, char* lds, int tid, int lane) {
    tid = opaque_v(tid); lane = opaque_v(lane);
#pragma unroll
    for (int mb = 0; mb < 4; ++mb)
#pragma unroll
        for (int nb = 0; nb < 2; ++nb)
#pragma unroll
            for (int i = 0; i < 16; ++i) acc[mb][nb][i] = 0.f;
    {
    const int c8_ = (tid >> 3) & 7, rowA_ = (tid >> 6) * 8 + (tid & 7);
    const u32x4* Ag = (const u32x4*)(At + (unsigned)(rowA_ * 1024 + c8_ * 8));
    const int ldsA_ = ((((c8_ >> 1) * 4 + (rowA_ >> 5)) * 64) + (rowA_ & 31) + 32 * (c8_ & 1)) * 16;
    const u32x4* W0g = (const u32x4*)W0 + lane;
    const u32x4* W1g = (const u32x4*)W1 + lane;
    u32x4 wq[4][2], arA[2], arB[2];
    arA[0] = Ag[0]; arA[1] = Ag[8192]; arB[0] = Ag[8]; arB[1] = Ag[8 + 8192];
#pragma unroll
    for (int kk = 0; kk < 4; ++kk) { wq[kk][0] = W0g[kk * 64]; wq[kk][1] = W1g[kk * 64]; }
    *(u32x4*)(lds + ldsA_) = arA[0]; *(u32x4*)(lds + ldsA_ + 2048) = arA[1];
    __syncthreads();
#define KL_ITER(KC, ARL, ARS) do { \
        char* cur = lds + ((KC) & 1) * 16384; \
        char* nxt = lds + (((KC) + 1) & 1) * 16384; \
        const int kn = (KC) < 15 ? (KC) + 1 : 15, k2 = (KC) < 14 ? (KC) + 2 : 15; \
        if ((KC) < 14) { ARL[0] = Ag[k2 * 8]; ARL[1] = Ag[k2 * 8 + 8192]; } \
        __builtin_amdgcn_sched_barrier(0); \
        _Pragma("unroll") for (int kk = 0; kk < 4; ++kk) { \
            bf16x8 afr[4]; \
            _Pragma("unroll") for (int mb = 0; mb < 4; ++mb) afr[mb] = *(const bf16x8*)(cur + ((kk * 4 + mb) * 64 + lane) * 16); \
            _Pragma("unroll") for (int mb = 0; mb < 4; ++mb) \
                _Pragma("unroll") for (int nb = 0; nb < 2; ++nb) { \
                    const bf16x8 wf = __builtin_bit_cast(bf16x8, wq[kk][nb]); \
                    if (ORIENT == 0) acc[mb][nb] = MFMA32(afr[mb], wf, acc[mb][nb]); \
                    else acc[mb][nb] = MFMA32(wf, afr[mb], acc[mb][nb]); \
                } \
            if ((KC) < 15) { wq[kk][0] = W0g[(kn * 4 + kk) * 64]; wq[kk][1] = W1g[(kn * 4 + kk) * 64]; } \
            __builtin_amdgcn_sched_barrier(0); \
        } \
        if ((KC) < 15) { *(u32x4*)(nxt + ldsA_) = ARS[0]; *(u32x4*)(nxt + ldsA_ + 2048) = ARS[1]; } \
        __syncthreads(); \
    } while (0)
    for (int kc = 0; kc < 16; kc += 2) { KL_ITER(kc, arA, arB); KL_ITER(kc + 1, arB, arA); }
#undef KL_ITER
    }
}

DI void epi_f32row(const f32x16 (&acc)[4][2], float* __restrict__ C, int tile, int col0, int lane) {
    lane = opaque_v(lane);
    const int r5 = lane & 31, hh = lane >> 5;
    const unsigned boff = (unsigned)((tile * 128 + 4 * hh) * 2048 + col0 + r5);
#pragma unroll
    for (int mb = 0; mb < 4; ++mb)
#pragma unroll
        for (int nb = 0; nb < 2; ++nb)
#pragma unroll
            for (int i = 0; i < 16; ++i)
                C[boff + (unsigned)((mb * 32 + (i & 3) + 8 * (i >> 2)) * 2048 + nb * 32)] = acc[mb][nb][i];
}
DI void epi_resid(const f32x16 (&acc)[4][2], const float* __restrict__ xin, float* __restrict__ xout, const float* __restrict__ gate_b, float* T  , float* ssq  , int tile, int col0, int lane) {
    lane = opaque_v(lane);
    const int r5 = lane & 31, hh = lane >> 5, rq = lane >> 4, c4 = (lane & 15) * 4;
    const float4 gv = *(const float4*)(gate_b + col0 + c4);
#pragma unroll
    for (int mb = 0; mb < 4; ++mb) {
#pragma unroll
        for (int nb = 0; nb < 2; ++nb)
#pragma unroll
            for (int i = 0; i < 16; ++i) T[((i & 3) + 8 * (i >> 2) + 4 * hh) * 68 + nb * 32 + r5] = acc[mb][nb][i];
        asm volatile("s_waitcnt lgkmcnt(0)" ::: "memory");
#pragma unroll
        for (int j = 0; j < 8; ++j) {
            const int row = rq + 4 * j;
            const float4 v = *(const float4*)(T + row * 68 + c4);
            const unsigned o = (unsigned)((tile * 128 + mb * 32 + row) * D + col0 + c4);
            float4 xv = *(const float4*)(xin + o);
            xv.x += gv.x * v.x; xv.y += gv.y * v.y; xv.z += gv.z * v.z; xv.w += gv.w * v.w;
            *(float4*)(xout + o) = xv;
            float ss = xv.x * xv.x + xv.y * xv.y + xv.z * xv.z + xv.w * xv.w;
            ss += __shfl_xor(ss, 1); ss += __shfl_xor(ss, 2); ss += __shfl_xor(ss, 4); ss += __shfl_xor(ss, 8);
            if ((lane & 15) == 0) ssq[mb * 32 + row] = ss;
        }
        asm volatile("s_waitcnt lgkmcnt(0)" ::: "memory");
    }
}

DI void epi_qpf(const f32x16 (&acc)[4][2], bf16_t* __restrict__ QPF, int tile, int ft0, int lane) {
    lane = opaque_v(lane);
#pragma unroll
    for (int nb = 0; nb < 2; ++nb)
#pragma unroll
        for (int s = 0; s < 2; ++s)
#pragma unroll
            for (int mb = 0; mb < 4; ++mb) {
                const f32x16& a = acc[mb][nb];
                u32x4 o; o.x = pk2(a[8 * s], a[8 * s + 1]); o.y = pk2(a[8 * s + 2], a[8 * s + 3]); o.z = pk2(a[8 * s + 4], a[8 * s + 5]); o.w = pk2(a[8 * s + 6], a[8 * s + 7]);
                *(u32x4*)(QPF + ((unsigned)((((tile * 64 + ft0 + nb) * 2 + s) * 4 + mb) * 64 + lane)) * 8) = o;
            }
}

DI void conv_keys_item(const float* __restrict__ K, bf16_t* __restrict__ KF, int gid) {
    const int lane = gid & 63, s = (gid >> 6) & 1, nbl = (gid >> 7) & 3, nt = (gid >> 9) & 3, hp = gid >> 11;
    const int r = lane & 31, hh = lane >> 5;
    const float* p = K + ((size_t)hp * 128 + nt * 32 + r) * 128 + nbl * 32 + 16 * s + 4 * hh;
    const float4 a = *(const float4*)p, b = *(const float4*)(p + 8);
    u32x4 o; o.x = pk2(a.x, a.y); o.y = pk2(a.z, a.w); o.z = pk2(b.x, b.y); o.w = pk2(b.z, b.w);
    *(u32x4*)(KF + (size_t)gid * 8) = o;
}

DI void conv_table_row(const float* __restrict__ src, unsigned char* __restrict__ dst, float* __restrict__ sc, int lane, bool as_int4) {
    const float4* p = (const float4*)src + lane * 4;
    float4 v[4];
    float m = 0.f;
#pragma unroll
    for (int j = 0; j < 4; ++j) { v[j] = p[j]; m = fmaxf(m, fmaxf(fmaxf(fabsf(v[j].x), fabsf(v[j].y)), fmaxf(fabsf(v[j].z), fabsf(v[j].w)))); }
#pragma unroll
    for (int o = 1; o < 64; o <<= 1) m = fmaxf(m, __shfl_xor(m, o));
    float scale = m > 0.f ? m * (1.f / 6.f) : 1.f;
    if (as_int4) {
        float ss = 0.f;
#pragma unroll
        for (int j = 0; j < 4; ++j) ss += v[j].x * v[j].x + v[j].y * v[j].y + v[j].z * v[j].z + v[j].w * v[j].w;
        ss = wave_sum(ss);
        const float sg = sqrtf(ss * (1.f / 1024.f));
        scale = fmaxf(sg * (1.f / 2.8f), m * (1.f / 16.f));
        if (!(scale > 0.f)) scale = 1.f;
    }
    const float inv = 1.f / scale;
    u32x2 o;
    unsigned* op = (unsigned*)&o;
#pragma unroll
    for (int j = 0; j < 2; ++j) {
        const float f[8] = {v[2 * j].x, v[2 * j].y, v[2 * j].z, v[2 * j].w, v[2 * j + 1].x, v[2 * j + 1].y, v[2 * j + 1].z, v[2 * j + 1].w};
        unsigned wv = 0;
        if (as_int4) {
#pragma unroll
            for (int e = 0; e < 8; ++e) { int q = __float2int_rn(f[e] * inv); q = q < -7 ? -7 : (q > 7 ? 7 : q); wv |= ((unsigned)q & 15u) << (4 * e); }
        } else {
            wv = __builtin_amdgcn_cvt_scalef32_pk_fp4_f32(wv, f[0] * inv, f[1] * inv, 1.0f, 0);
            wv = __builtin_amdgcn_cvt_scalef32_pk_fp4_f32(wv, f[2] * inv, f[3] * inv, 1.0f, 1);
            wv = __builtin_amdgcn_cvt_scalef32_pk_fp4_f32(wv, f[4] * inv, f[5] * inv, 1.0f, 2);
            wv = __builtin_amdgcn_cvt_scalef32_pk_fp4_f32(wv, f[6] * inv, f[7] * inv, 1.0f, 3);
        }
        op[j] = wv;
    }
    *(u32x2*)(dst + lane * 8) = o;
    if (lane == 0) *sc = scale;
}

DI void ce_desc(int& a, int& b) { const int mx = a > b ? a : b, mn = a > b ? b : a; a = mx; b = mn; }
DI void sort16_desc(int (&v)[16]) {
#pragma unroll
    for (int k = 2; k <= 16; k <<= 1)
#pragma unroll
        for (int j = k >> 1; j > 0; j >>= 1)
#pragma unroll
            for (int i = 0; i < 16; ++i) {
                const int l = i ^ j;
                if (l > i) { if ((i & k) == 0) ce_desc(v[i], v[l]); else ce_desc(v[l], v[i]); }
            }
}
DI void bitonic_merge16_desc(int (&v)[16]) {
#pragma unroll
    for (int j = 8; j > 0; j >>= 1)
#pragma unroll
        for (int i = 0; i < 16; ++i) { const int l = i ^ j; if (l > i) ce_desc(v[i], v[l]); }
}
DI void merge_top16(int (&a)[16], const int (&b)[16]) {
#pragma unroll
    for (int i = 0; i < 16; ++i) a[i] = a[i] > b[15 - i] ? a[i] : b[15 - i];
    bitonic_merge16_desc(a);
}
DI int f2ord(float f) { int b = __float_as_int(f); return b ^ ((b >> 31) & 0x7fffffff); }
DI float ord2f(int k) { return __int_as_float(k ^ ((k >> 31) & 0x7fffffff)); }

DI void route_tile(const bf16_t* __restrict__ QPF, const bf16_t* __restrict__ KF, char* lds_lists, unsigned char* lds_idx  , int tile, int tid) {
    tid = opaque_v(tid); tile = opaque_s(tile);
    const int lane = tid & 63, w = __builtin_amdgcn_readfirstlane(tid >> 6);
    const int r5 = lane & 31, hh = lane >> 5;
    unsigned char* myidx = lds_idx + w * 1024;
    for (int task = w; task < 32; task += 8) {
        const int h = task >> 2, tt = task & 3;
        f32x16 acc[2][4];
#pragma unroll
        for (int p = 0; p < 2; ++p)
#pragma unroll
            for (int nt = 0; nt < 4; ++nt)
#pragma unroll
                for (int i = 0; i < 16; ++i) acc[p][nt][i] = 0.f;
        {
            bf16x8 bq[3], ak[3][4];
#define ROUTE_LOAD(buf, step) do { const int p_ = (step) >> 3, ks_ = (step) & 7; \
                bq[buf] = *(const bf16x8*)(QPF + ((unsigned)((((tile * 64 + h * 8 + p_ * 4 + (ks_ >> 1)) * 2 + (ks_ & 1)) * 4 + tt) * 64 + lane)) * 8); \
                _Pragma("unroll") for (int nt = 0; nt < 4; ++nt) ak[buf][nt] = *(const bf16x8*)(KF + ((unsigned)(((((h * 2 + p_) * 4 + nt) * 8 + ks_) * 64) + lane)) * 8); } while (0)
            ROUTE_LOAD(0, 0);
            ROUTE_LOAD(1, 1);
#pragma unroll
            for (int step = 0; step < 16; ++step) {
                if (step < 14) ROUTE_LOAD((step + 2) % 3, step + 2);
#pragma unroll
                for (int nt = 0; nt < 4; ++nt) acc[step >> 3][nt] = MFMA32(ak[step % 3][nt], bq[step % 3], acc[step >> 3][nt]);
                __builtin_amdgcn_sched_barrier(0);
            }
#undef ROUTE_LOAD
        }
        int g[8][16];
#pragma unroll
        for (int nt = 0; nt < 4; ++nt)
#pragma unroll
            for (int i = 0; i < 16; ++i) {
                const unsigned a = __float_as_uint(acc[0][nt][i]), b = __float_as_uint(acc[1][nt][i]);
                auto sw = __builtin_amdgcn_permlane32_swap(a, b, false, false);
                const int n0 = nt * 32 + (i & 3) + 8 * (i >> 2);
                g[nt * 2 + (i >> 3)][i & 7] = (f2ord(__uint_as_float(sw[0])) & ~127) | n0;
                g[nt * 2 + (i >> 3)][8 + (i & 7)] = (f2ord(__uint_as_float(sw[1])) & ~127) | (n0 + 4);
            }
#pragma unroll
        for (int q = 0; q < 8; ++q) sort16_desc(g[q]);
        merge_top16(g[0], g[1]); merge_top16(g[2], g[3]); merge_top16(g[4], g[5]); merge_top16(g[6], g[7]);
        merge_top16(g[0], g[2]); merge_top16(g[4], g[6]);
        merge_top16(g[0], g[4]);
        {
            u32x4 pk;
            unsigned* pp = (unsigned*)&pk;
#pragma unroll
            for (int q = 0; q < 4; ++q) pp[q] = (unsigned)(g[0][4 * q] & 127) | ((unsigned)(g[0][4 * q + 1] & 127) << 8) | ((unsigned)(g[0][4 * q + 2] & 127) << 16) | ((unsigned)(g[0][4 * q + 3] & 127) << 24);
            *(u32x4*)(myidx + lane * 16) = pk;
        }
        float f0[16], f1[16];
#pragma unroll
        for (int i = 0; i < 16; ++i) {
            const unsigned a = (unsigned)g[0][i], b = a;
            auto sw = __builtin_amdgcn_permlane32_swap(a, b, false, false);
            f0[i] = ord2f((int)sw[0] & ~127); f1[i] = ord2f((int)sw[1] & ~127);
        }
        int c0[16], c1[16], c2[16], c3[16];
#pragma unroll
        for (int j = 0; j < 16; ++j) c0[j] = (f2ord(f0[0] + f1[j]) & ~255) | j;
#pragma unroll
        for (int i = 1; i < 16; ++i) c1[i - 1] = (f2ord(f0[i] + f1[0]) & ~255) | (i << 4);
        c1[15] = (int)0x80000000;
#define CK(i, j) ((f2ord(f0[i] + f1[j]) & ~255) | ((i) << 4) | (j))
        c2[0] = CK(1, 1); c2[1] = CK(1, 2); c2[2] = CK(1, 3); c2[3] = CK(1, 4); c2[4] = CK(1, 5); c2[5] = CK(1, 6); c2[6] = CK(1, 7);
        c2[7] = CK(2, 1); c2[8] = CK(2, 2); c2[9] = CK(2, 3); c2[10] = CK(2, 4);
        c2[11] = CK(3, 1); c2[12] = CK(3, 2); c2[13] = CK(3, 3);
        c2[14] = CK(4, 1); c2[15] = CK(4, 2);
        c3[0] = CK(5, 1); c3[1] = CK(6, 1); c3[2] = CK(7, 1);
#undef CK
#pragma unroll
        for (int q = 3; q < 16; ++q) c3[q] = (int)0x80000000;
        sort16_desc(c2);
        ce_desc(c3[0], c3[1]); ce_desc(c3[1], c3[2]); ce_desc(c3[0], c3[1]);
        merge_top16(c0, c1); merge_top16(c2, c3); merge_top16(c0, c2);
        float bs[16], den = 0.f;
#pragma unroll
        for (int i = 0; i < 16; ++i) { bs[i] = __expf(ord2f(c0[i] & ~255) - ord2f(c0[0] & ~255)); den += bs[i]; }
        const float rden = 1.f / den;
        asm volatile("s_waitcnt lgkmcnt(0)" ::: "memory");
#pragma unroll
        for (int q = 0; q < 8; ++q) {
            const int key = (int)__builtin_amdgcn_permlane32_swap((unsigned)c0[q], (unsigned)c0[8 + q], false, false)[0];
            const float gv = __uint_as_float(__builtin_amdgcn_permlane32_swap(__float_as_uint(bs[q]), __float_as_uint(bs[8 + q]), false, false)[0]) * rden;
            const int i = (key >> 4) & 15, j = key & 15;
            const int e = (int)myidx[r5 * 16 + i] * 128 + (int)myidx[(32 + r5) * 16 + j];
            const int tokl = tt * 32 + r5;
            ((unsigned short*)(lds_lists + PL_SEID))[tokl * 128 + h * 16 + 8 * hh + q] = (unsigned short)e;
            ((float*)(lds_lists + PL_SWGT))[tokl * 128 + h * 16 + 8 * hh + q] = gv;
        }
        asm volatile("s_waitcnt lgkmcnt(0)" ::: "memory");
    }
}

DI void unpack_h2(const bf16_t* __restrict__ hA, int t, int lane, f32x2 (&hv)[8]) {
    const int tile = t >> 7, row = t & 127, mb = row >> 5, r5 = row & 31;
    const bf16_t* hp = hA + ((unsigned)(((tile * 64 + lane) * 4 + mb) * 64 + r5)) * 8;
    const u32x4 ha = *(const u32x4*)hp, hb = *(const u32x4*)(hp + 32 * 8);
    const unsigned hw[8] = {ha.x, ha.y, ha.z, ha.w, hb.x, hb.y, hb.z, hb.w};
#pragma unroll
    for (int q = 0; q < 8; ++q) { hv[q].x = __uint_as_float(hw[q] << 16); hv[q].y = __uint_as_float(hw[q] & 0xffff0000u); }
}
typedef _Float16 h16x2 __attribute__((ext_vector_type(2)));
DI h16x2 fp4h(unsigned w, int sel) {
    return sel == 0 ? __builtin_amdgcn_cvt_scalef32_pk_f16_fp4(w, 1.0f, 0) : sel == 1 ? __builtin_amdgcn_cvt_scalef32_pk_f16_fp4(w, 1.0f, 1)
         : sel == 2 ? __builtin_amdgcn_cvt_scalef32_pk_f16_fp4(w, 1.0f, 2) : __builtin_amdgcn_cvt_scalef32_pk_f16_fp4(w, 1.0f, 3);
}
DI unsigned rowoff_lo(unsigned pr, unsigned k512, unsigned lane8) { unsigned r; asm("v_mad_u32_u16 %0, %1, %2, %3" : "=v"(r) : "v"(pr), "s"(k512), "v"(lane8)); return r; }
DI unsigned rowoff_hi(unsigned pr, unsigned k512, unsigned lane8) { unsigned r; asm("v_mad_u32_u16 %0, %1, %2, %3 op_sel:[1,0,0,0]" : "=v"(r) : "v"(pr), "s"(k512), "v"(lane8)); return r; }
DI void stage_token(const int* __restrict__ ridx, const float* __restrict__ rgate, char* lds, int t, int tloc, int lane) {
    lane = opaque_v(lane); t = opaque_s(t);
    unsigned short* seid = (unsigned short*)(lds + PL_SEID) + tloc * 128;
    float* swgt = (float*)(lds + PL_SWGT) + tloc * 128;
    seid[lane] = (unsigned short)ridx[(unsigned)(t * 128 + lane)]; seid[64 + lane] = (unsigned short)ridx[(unsigned)(t * 128 + 64 + lane)];
    swgt[lane] = rgate[(unsigned)(t * 128 + lane)]; swgt[64 + lane] = rgate[(unsigned)(t * 128 + 64 + lane)];
}
DI void peer_down_wave(const bf16_t* __restrict__ hA, char* lds, const unsigned char* __restrict__ TBd, const float* __restrict__ SC, int tile, int w, int lane) {
    lane = opaque_v(lane);
    const unsigned lane8 = (unsigned)lane * 8u;
    const int myu = ((lane >> 5) & 1) * 8 + ((lane >> 4) & 1) * 4 + ((lane >> 3) & 1) * 2 + ((lane >> 2) & 1);
    const unsigned short* seid = (const unsigned short*)(lds + PL_SEID) + w * 16 * 128;
    float* swgt = (float*)(lds + PL_SWGT) + w * 16 * 128;
    u32x4 haN, hbN;
    { const bf16_t* hp0 = hA + (unsigned)((tile * 128 + w * 16) * 1024 + lane * 16); haN = *(const u32x4*)hp0; hbN = *(const u32x4*)(hp0 + 8); }
    u32x2 R[2][16];
    f32x2 scv[2];
    u32x4 ID[2];
#define DOWN_IDS(P_) do { ID[0] = *(const u32x4*)(seid + (P_)); ID[1] = *(const u32x4*)(seid + (P_) + 8); } while (0)
#define DOWN_LOADS(buf, P_) do { _Pragma("unroll") for (int u_ = 0; u_ < 16; ++u_) { const unsigned pr_ = ID[u_ >> 3][(u_ >> 1) & 3]; \
        const unsigned off_ = (u_ & 1) ? rowoff_hi(pr_, 512u, lane8) : rowoff_lo(pr_, 512u, lane8); R[buf][u_] = *(const u32x2*)(TBd + off_); } \
        scv[buf] = *(const f32x2*)(SC + (unsigned)seid[(P_) + myu] * 2u); } while (0)
    DOWN_IDS(0); DOWN_LOADS(0, 0); DOWN_IDS(16);
#pragma unroll 1
    for (int tl = 0; tl < 16; ++tl) {
        const int t = tile * 128 + w * 16 + tl;
        float* gp = swgt + tl * 128;
        const u32x4 ha = haN, hb = hbN;
        const int tn = tl < 15 ? tl + 1 : tl;
        { const bf16_t* hp = hA + (unsigned)((t - tl + tn) * 1024 + lane * 16); haN = *(const u32x4*)hp; hbN = *(const u32x4*)(hp + 8); }
        unsigned hhi[2], hlo[2];
        float hscale;
        {
            const unsigned hw[8] = {ha.x, ha.y, ha.z, ha.w, hb.x, hb.y, hb.z, hb.w};
            float hf[16];
            float m = 0.f;
#pragma unroll
            for (int q = 0; q < 8; ++q) { hf[2 * q] = __uint_as_float(hw[q] << 16); hf[2 * q + 1] = __uint_as_float(hw[q] & 0xffff0000u); m = fmaxf(m, fmaxf(fabsf(hf[2 * q]), fabsf(hf[2 * q + 1]))); }
#pragma unroll
            for (int o = 1; o < 64; o <<= 1) m = fmaxf(m, __shfl_xor(m, o));
            hscale = m > 0.f ? m * (1.f / 119.f) : 1.f;
            const float inv = 1.f / hscale;
            hhi[0] = hhi[1] = hlo[0] = hlo[1] = 0u;
#pragma unroll
            for (int e = 0; e < 16; ++e) {
                const int hq = __float2int_rn(hf[e] * inv);
                const int lo = ((hq + 8) & 15) - 8, hi = (hq - lo) >> 4;
                hlo[e >> 3] |= ((unsigned)lo & 15u) << (4 * (e & 7));
                hhi[e >> 3] |= ((unsigned)hi & 15u) << (4 * (e & 7));
            }
        }
#pragma unroll
        for (int bt = 0; bt < 8; ++bt) {
            const int cur = bt & 1, nxt = cur ^ 1;
            const int p1 = bt < 7 ? tl * 128 + (bt + 1) * 16 : tn * 128;
            const int p2 = bt < 6 ? tl * 128 + (bt + 2) * 16 : tn * 128 + (bt - 6) * 16;
            DOWN_LOADS(nxt, p1);
            DOWN_IDS(p2);
            __builtin_amdgcn_sched_barrier(0);
            int part[16];
#pragma unroll
            for (int u = 0; u < 16; ++u) {
                int shi = __builtin_amdgcn_sdot8((int)R[cur][u].x, (int)hhi[0], 0, false);
                shi = __builtin_amdgcn_sdot8((int)R[cur][u].y, (int)hhi[1], shi, false);
                int slo = __builtin_amdgcn_sdot8((int)R[cur][u].x, (int)hlo[0], 0, false);
                slo = __builtin_amdgcn_sdot8((int)R[cur][u].y, (int)hlo[1], slo, false);
                part[u] = shi * 16 + slo;
            }
            int r8[8], r4[4], r2[2], r1;
            {
                const bool b5 = (lane & 32) != 0, b4 = (lane & 16) != 0, b3 = (lane & 8) != 0, b2 = (lane & 4) != 0;
#pragma unroll
                for (int q = 0; q < 8; ++q) { const int keep = b5 ? part[q + 8] : part[q], give = b5 ? part[q] : part[q + 8]; r8[q] = keep + __shfl_xor(give, 32); }
#pragma unroll
                for (int q = 0; q < 4; ++q) { const int keep = b4 ? r8[q + 4] : r8[q], give = b4 ? r8[q] : r8[q + 4]; r4[q] = keep + __shfl_xor(give, 16); }
#pragma unroll
                for (int q = 0; q < 2; ++q) { const int keep = b3 ? r4[q + 2] : r4[q], give = b3 ? r4[q] : r4[q + 2]; r2[q] = keep + __shfl_xor(give, 8); }
                { const int keep = b2 ? r2[1] : r2[0], give = b2 ? r2[0] : r2[1]; r1 = keep + __shfl_xor(give, 4); }
                r1 += __shfl_xor(r1, 2); r1 += __shfl_xor(r1, 1);
            }
            if ((lane & 3) == 0) {
                const float a = (float)r1 * (scv[cur].x * hscale);
                const float wv_ = gp[bt * 16 + myu] * (0.5f * a * (1.f + erff(a * 0.70710678118654752f))) * scv[cur].y;
                ((unsigned*)gp)[bt * 16 + myu] = (unsigned)__builtin_bit_cast(unsigned short, (_Float16)wv_);
            }
        }
    }
#undef DOWN_IDS
#undef DOWN_LOADS
}
DI void peer_up_wave(char* lds, const unsigned char* __restrict__ TBu, const float* __restrict__ g2b, float* __restrict__ x, int tile, int w, int lane) {
    lane = opaque_v(lane);
    const unsigned lane8 = (unsigned)lane * 8u;
    const unsigned short* seid = (const unsigned short*)(lds + PL_SEID) + w * 16 * 128;
    const unsigned* swgt = (const unsigned*)(lds + PL_SWGT) + w * 16 * 128;
    u32x2 RA[16], RB[16];
    u32x4 ID[2], WA[4], WB[4];
#define UP_IDS(P_) do { ID[0] = *(const u32x4*)(seid + (P_)); ID[1] = *(const u32x4*)(seid + (P_) + 8); } while (0)
#define UP_WTS(W, P_) do { _Pragma("unroll") for (int q_ = 0; q_ < 4; ++q_) W[q_] = *(const u32x4*)(swgt + (P_) + 4 * q_); } while (0)
#define UP_LOADS(R) do { _Pragma("unroll") for (int u_ = 0; u_ < 16; ++u_) { const unsigned pr_ = ID[u_ >> 3][(u_ >> 1) & 3]; \
        const unsigned off_ = (u_ & 1) ? rowoff_hi(pr_, 512u, lane8) : rowoff_lo(pr_, 512u, lane8); R[u_] = *(const u32x2*)(TBu + off_); } } while (0)
#define UP_COMPUTE(R, W, K) do { _Pragma("unroll") for (int u_ = 0; u_ < 16; ++u_) { \
        const unsigned wd_ = W[u_ >> 2][u_ & 3]; const h16x2 wp_ = __builtin_bit_cast(h16x2, wd_); const h16x2 w2_ = (h16x2){wp_.x, wp_.x}; \
        _Pragma("unroll") for (int q_ = 0; q_ < 4; ++q_) { acc[K][q_] = __builtin_elementwise_fma(w2_, fp4h(R[u_].x, q_), acc[K][q_]); acc[K][4 + q_] = __builtin_elementwise_fma(w2_, fp4h(R[u_].y, q_), acc[K][4 + q_]); } } } while (0)
    UP_IDS(0); UP_LOADS(RA); UP_IDS(16); UP_WTS(WA, 0);
    for (int r = 0; r < 2; ++r) {
        h16x2 acc[8][8];
#pragma unroll
        for (int k = 0; k < 8; ++k)
#pragma unroll
            for (int q = 0; q < 8; ++q) acc[k][q] = (h16x2){(_Float16)0.f, (_Float16)0.f};
#pragma unroll
        for (int k = 0; k < 8; ++k) {
            const int tk = r * 8 + k, tn = tk < 15 ? tk + 1 : 15;
#pragma unroll 1
            for (int i = 0; i < 4; ++i) {
                const int pa = tk * 128 + i * 32;
                const int pn = i < 3 ? pa + 32 : tn * 128;
                UP_LOADS(RB); UP_WTS(WB, pa + 16); UP_IDS(pn);
                __builtin_amdgcn_sched_barrier(0);
                UP_COMPUTE(RA, WA, k);
                UP_LOADS(RA); UP_WTS(WA, pn); UP_IDS(pn + 16);
                __builtin_amdgcn_sched_barrier(0);
                UP_COMPUTE(RB, WB, k);
            }
        }
#pragma unroll
        for (int k = 0; k < 8; ++k) {
            const int t = tile * 128 + w * 16 + r * 8 + k;
            float4* xp = (float4*)(x + (size_t)t * D + lane * 16);
            const float4* gq = (const float4*)(g2b + lane * 16);
            float ssx = 0.f;
#pragma unroll
            for (int q = 0; q < 4; ++q) {
                float4 xv = xp[q]; const float4 gv = gq[q];
                xv.x += gv.x * (float)acc[k][2 * q].x; xv.y += gv.y * (float)acc[k][2 * q].y; xv.z += gv.z * (float)acc[k][2 * q + 1].x; xv.w += gv.w * (float)acc[k][2 * q + 1].y;
                xp[q] = xv;
                ssx += xv.x * xv.x + xv.y * xv.y + xv.z * xv.z + xv.w * xv.w;
            }
            ssx = wave_sum(ssx);
            if (lane == 0) ((float*)(lds + LDS_RSTD1))[w * 16 + r * 8 + k] = rsqrtf(ssx * (1.f / D) + EPS);
        }
    }
#undef UP_IDS
#undef UP_WTS
#undef UP_LOADS
#undef UP_COMPUTE
}

DI void epi_qk(f32x16 (&acc)[4][2], const float* __restrict__ gain, float scale, bf16_t* __restrict__ dst, int lane) {
    lane = opaque_v(lane);
    const int hh = lane >> 5;
    float gv[2][16];
#pragma unroll
    for (int nb = 0; nb < 2; ++nb)
#pragma unroll
        for (int i = 0; i < 16; ++i) gv[nb][i] = gain[nb * 32 + (i & 3) + 8 * (i >> 2) + 4 * hh] * scale;
#pragma unroll
    for (int mb = 0; mb < 4; ++mb) {
        float ss = 0.f;
#pragma unroll
        for (int nb = 0; nb < 2; ++nb)
#pragma unroll
            for (int i = 0; i < 16; ++i) ss += acc[mb][nb][i] * acc[mb][nb][i];
        ss += __shfl_xor(ss, 32);
        const float r = rsqrtf(ss * (1.f / 64.f) + EPS);
#pragma unroll
        for (int nb = 0; nb < 2; ++nb)
#pragma unroll
            for (int s = 0; s < 2; ++s) {
                const f32x16& a = acc[mb][nb];
                u32x4 o;
                o.x = pk2(a[8 * s] * r * gv[nb][8 * s], a[8 * s + 1] * r * gv[nb][8 * s + 1]);
                o.y = pk2(a[8 * s + 2] * r * gv[nb][8 * s + 2], a[8 * s + 3] * r * gv[nb][8 * s + 3]);
                o.z = pk2(a[8 * s + 4] * r * gv[nb][8 * s + 4], a[8 * s + 5] * r * gv[nb][8 * s + 5]);
                o.w = pk2(a[8 * s + 6] * r * gv[nb][8 * s + 6], a[8 * s + 7] * r * gv[nb][8 * s + 7]);
                *(u32x4*)(dst + ((unsigned)(((nb * 2 + s) * 4 + mb) * 64 + lane)) * 8) = o;
            }
    }
}
DI void epi_v(const f32x16 (&acc)[4][2], bf16_t* __restrict__ dst, int lane) {
    lane = opaque_v(lane);
#pragma unroll
    for (int nb = 0; nb < 2; ++nb)
#pragma unroll
        for (int mb = 0; mb < 4; ++mb)
#pragma unroll
            for (int s = 0; s < 2; ++s) {
                const f32x16& a = acc[mb][nb];
                u32x4 o; o.x = pk2(a[8 * s], a[8 * s + 1]); o.y = pk2(a[8 * s + 2], a[8 * s + 3]); o.z = pk2(a[8 * s + 4], a[8 * s + 5]); o.w = pk2(a[8 * s + 6], a[8 * s + 7]);
                *(u32x4*)(dst + ((unsigned)(((nb * 4 + mb) * 2 + s) * 64 + lane)) * 8) = o;
            }
}
DI void epi_row(const f32x16 (&acc)[4][2], bf16_t* __restrict__ dst, int ld, int lane) {
    lane = opaque_v(lane);
    const int r5 = lane & 31, hh = lane >> 5;
#pragma unroll
    for (int mb = 0; mb < 4; ++mb)
#pragma unroll
        for (int nb = 0; nb < 2; ++nb)
#pragma unroll
            for (int gq = 0; gq < 4; ++gq) {
                const f32x16& a = acc[mb][nb];
                u32x2 o; o.x = pk2(a[4 * gq], a[4 * gq + 1]); o.y = pk2(a[4 * gq + 2], a[4 * gq + 3]);
                *(u32x2*)(dst + (unsigned)((mb * 32 + r5) * ld + nb * 32 + 8 * gq + 4 * hh)) = o;
            }
}
DI void epi_z(const f32x16 (&acc)[4][2], bf16_t* __restrict__ dst, int lane) {
    lane = opaque_v(lane);
    const int r5 = lane & 31, hh = lane >> 5;
#pragma unroll
    for (int mb = 0; mb < 4; ++mb)
#pragma unroll
        for (int gq = 0; gq < 4; ++gq) {
            const f32x16 &a = acc[mb][0], &b = acc[mb][1];
            u32x2 o; o.x = pk2(a[4 * gq] * b[4 * gq], a[4 * gq + 1] * b[4 * gq + 1]); o.y = pk2(a[4 * gq + 2] * b[4 * gq + 2], a[4 * gq + 3] * b[4 * gq + 3]);
            *(u32x2*)(dst + (unsigned)((mb * 32 + r5) * 256 + 8 * gq + 4 * hh)) = o;
        }
}
DI void epi_su_park(const f32x16 (&acc)[4][2], unsigned* lds_su, int lane) {
    lane = opaque_v(lane);
#pragma unroll
    for (int mb = 0; mb < 4; ++mb)
#pragma unroll
        for (int nb = 0; nb < 2; ++nb)
#pragma unroll
            for (int q = 0; q < 8; ++q) lds_su[((mb * 2 + nb) * 8 + q) * 64 + lane] = pk2(acc[mb][nb][2 * q], acc[mb][nb][2 * q + 1]);
}
DI void epi_sv(f32x16 (&acc)[4][2], const bf16_t* __restrict__ SWF  , const float* __restrict__ bs_g, const unsigned* lds_su, bf16_t* __restrict__ dst, int lane) {
    lane = opaque_v(lane);
    const int r5 = lane & 31, hh = lane >> 5;
    bf16x8 vb[4][2][2];
#pragma unroll
    for (int mb = 0; mb < 4; ++mb) {
#pragma unroll
        for (int i = 0; i < 16; ++i) {
            float s1 = acc[mb][0][i] + acc[mb][1][i];
#pragma unroll
            for (int o = 1; o < 32; o <<= 1) s1 += __shfl_xor(s1, o);
            const float mu = s1 * (1.f / 64.f);
            const float d0 = acc[mb][0][i] - mu, d1 = acc[mb][1][i] - mu;
            float s2 = d0 * d0 + d1 * d1;
#pragma unroll
            for (int o = 1; o < 32; o <<= 1) s2 += __shfl_xor(s2, o);
            const float r = rsqrtf(s2 * (1.f / 64.f) + EPS);
            acc[mb][0][i] = d0 * r; acc[mb][1][i] = d1 * r;
        }
#pragma unroll
        for (int s = 0; s < 2; ++s)
#pragma unroll
            for (int nb = 0; nb < 2; ++nb) {
                const f32x16& a = acc[mb][nb];
                u32x4 o; o.x = pk2(a[8 * s], a[8 * s + 1]); o.y = pk2(a[8 * s + 2], a[8 * s + 3]); o.z = pk2(a[8 * s + 4], a[8 * s + 5]); o.w = pk2(a[8 * s + 6], a[8 * s + 7]);
                vb[mb][s][nb] = __builtin_bit_cast(bf16x8, o);
            }
    }
#pragma unroll
    for (int tb = 0; tb < 4; ++tb) {
        f32x16 y[2];
#pragma unroll
        for (int nb = 0; nb < 2; ++nb)
#pragma unroll
            for (int i = 0; i < 16; ++i) y[nb][i] = 0.f;
#pragma unroll
        for (int kt = 0; kt <= tb; ++kt)
#pragma unroll
            for (int s = 0; s < 2; ++s) {
                const bf16x8 wa = *(const bf16x8*)(SWF + ((unsigned)(((tb * 4 + kt) * 2 + s) * 64 + lane)) * 8);
                y[0] = MFMA32(wa, vb[kt][s][0], y[0]);
                y[1] = MFMA32(wa, vb[kt][s][1], y[1]);
            }
#pragma unroll
        for (int nb = 0; nb < 2; ++nb)
#pragma unroll
            for (int q = 0; q < 8; ++q) {
                const unsigned su2 = lds_su[((tb * 2 + nb) * 8 + q) * 64 + lane];
                const int i0 = 2 * q, i1 = 2 * q + 1;
                const int t0 = tb * 32 + (i0 & 3) + 8 * (i0 >> 2) + 4 * hh, t1 = tb * 32 + (i1 & 3) + 8 * (i1 >> 2) + 4 * hh;
                const float v0 = (y[nb][i0] + bs_g[t0]) * __uint_as_float(su2 << 16), v1 = (y[nb][i1] + bs_g[t1]) * __uint_as_float(su2 & 0xffff0000u);
                const unsigned pk = pk2(v0, v1);
                dst[(unsigned)(t0 * 256 + nb * 32 + r5)] = (bf16_t)(pk & 0xffffu);
                dst[(unsigned)(t1 * 256 + nb * 32 + r5)] = (bf16_t)(pk >> 16);
            }
    }
}

DI void conv_sguw_item(const float* __restrict__ W, bf16_t* __restrict__ SWF, int gid) {
    const int lane = gid & 63, s = (gid >> 6) & 1, kt = (gid >> 7) & 3, tb = (gid >> 9) & 3, g = gid >> 11;
    const int r = lane & 31, hh = lane >> 5, t = tb * 32 + r;
    const float* p = W + ((size_t)g * 128 + t) * 128;
    float v[8];
#pragma unroll
    for (int j = 0; j < 8; ++j) { const int sp = kt * 32 + 16 * s + 8 * (j >> 2) + 4 * hh + (j & 3); v[j] = sp <= t ? p[sp] : 0.f; }
    u32x4 o; o.x = pk2(v[0], v[1]); o.y = pk2(v[2], v[3]); o.z = pk2(v[4], v[5]); o.w = pk2(v[6], v[7]);
    *(u32x4*)(SWF + (size_t)gid * 8) = o;
}

DI int t5_bucket(int d) {
    if (d < 16) return d;
    const float lr = logf((float)d / 16.f) / logf(8.f);
    const int large = 16 + (int)(lr * 16.f);
    return large < 31 ? large : 31;
}

DI void attn_tile(const bf16_t* __restrict__ QF, const bf16_t* __restrict__ KF2, const bf16_t* __restrict__ VF, char* lds, const float* bias_lds, const float* __restrict__ sink, bf16_t* __restrict__ OR, int tile, int tid) {
    tid = opaque_v(tid); tile = opaque_s(tile);
    const int lane = tid & 63, w = __builtin_amdgcn_readfirstlane(tid >> 6), r5 = lane & 31, hh = lane >> 5;
    const bool has_prev = (tile & 31) != 0;
    {
        u32x4 tmp[16];
#pragma unroll
        for (int i = 0; i < 16; ++i) {
            const int blk = w * 16 + i;
            const int isv = blk >> 6, bb = blk & 63;
            const bf16_t* src;
            if (!isv) { const int kvh = bb >> 5, ks = (bb >> 3) & 3, wt = bb & 7, st = (wt >= 4 || !has_prev) ? tile : tile - 1;
                src = KF2 + ((unsigned)((((st * 2 + kvh) * 4 + ks) * 4 + (wt & 3)) * 64 + lane)) * 8; }
            else { const int kvh = bb >> 5, dt = (bb >> 4) & 1, wt = (bb >> 1) & 7, s2 = bb & 1, st = (wt >= 4 || !has_prev) ? tile : tile - 1;
                src = VF + ((unsigned)(((((st * 2 + kvh) * 2 + dt) * 4 + (wt & 3)) * 2 + s2) * 64 + lane)) * 8; }
            tmp[i] = *(const u32x4*)src;
        }
#pragma unroll
        for (int i = 0; i < 16; ++i) *(u32x4*)(lds + (w * 16 + i) * 1024 + lane * 16) = tmp[i];
    }
    __syncthreads();
    const char* ldsK = lds, *ldsV = lds + 65536;
    for (int task = w; task < 32; task += 8) {
        const int qh = task >> 2, qt = task & 3, kvh = qh >> 2;
        bf16x8 bq[4];
#pragma unroll
        for (int ks = 0; ks < 4; ++ks) bq[ks] = *(const bf16x8*)(QF + ((unsigned)((((tile * 8 + qh) * 4 + ks) * 4 + qt) * 64 + lane)) * 8);
        f32x16 sc[5];
#pragma unroll
        for (int jj = 0; jj < 5; ++jj) {
#pragma unroll
            for (int i = 0; i < 16; ++i) sc[jj][i] = 0.f;
#pragma unroll
            for (int ks = 0; ks < 4; ++ks) {
                const bf16x8 kf = *(const bf16x8*)(ldsK + ((kvh * 4 + ks) * 8 + qt + jj) * 1024 + lane * 16);
                sc[jj] = MFMA32(kf, bq[ks], sc[jj]);
            }
        }
        const float* bl = bias_lds + qh * 128;
        float m = -1e30f;
#pragma unroll
        for (int jj = 0; jj < 5; ++jj) {
            const bool ex = (qt + jj >= 4) || has_prev;
#pragma unroll
            for (int i = 0; i < 16; ++i) {
                const int cr = (i & 3) + 8 * (i >> 2) + 4 * hh;
                const int dist = 128 + r5 - 32 * jj - cr;
                const bool valid = ex && dist >= 0 && dist < 128;
                float bv = bl[dist & 127];
                asm volatile("" : "+v"(bv));
                const float v = valid ? sc[jj][i] + bv : -1e30f;
                sc[jj][i] = v; m = fmaxf(m, v);
            }
        }
        m = fmaxf(m, __shfl_xor(m, 32));
        const float sk = sink[qh];
        m = fmaxf(m, sk);
        float l = 0.f;
#pragma unroll
        for (int jj = 0; jj < 5; ++jj)
#pragma unroll
            for (int i = 0; i < 16; ++i) { const float p = __expf(sc[jj][i] - m); sc[jj][i] = p; l += p; }
        l += __shfl_xor(l, 32);
        l += __expf(sk - m);
        const float rl = 1.f / l;
        f32x16 o[2];
#pragma unroll
        for (int dt = 0; dt < 2; ++dt)
#pragma unroll
            for (int i = 0; i < 16; ++i) o[dt][i] = 0.f;
#pragma unroll
        for (int jj = 0; jj < 5; ++jj) {
#pragma unroll
            for (int s = 0; s < 2; ++s) {
                const f32x16& a = sc[jj];
                u32x4 pp; pp.x = pk2(a[8 * s], a[8 * s + 1]); pp.y = pk2(a[8 * s + 2], a[8 * s + 3]); pp.z = pk2(a[8 * s + 4], a[8 * s + 5]); pp.w = pk2(a[8 * s + 6], a[8 * s + 7]);
                const bf16x8 pb = __builtin_bit_cast(bf16x8, pp);
#pragma unroll
                for (int dt = 0; dt < 2; ++dt) {
                    const bf16x8 vf = *(const bf16x8*)(ldsV + (((kvh * 2 + dt) * 8 + qt + jj) * 2 + s) * 1024 + lane * 16);
                    o[dt] = MFMA32(vf, pb, o[dt]);
                }
            }
        }
        bf16_t* orow = OR + (unsigned)((tile * 128 + qt * 32 + r5) * 512 + qh * 64 + 4 * hh);
#pragma unroll
        for (int dt = 0; dt < 2; ++dt)
#pragma unroll
            for (int gq = 0; gq < 4; ++gq) {
                u32x2 ov; ov.x = pk2(o[dt][4 * gq] * rl, o[dt][4 * gq + 1] * rl); ov.y = pk2(o[dt][4 * gq + 2] * rl, o[dt][4 * gq + 3] * rl);
                *(u32x2*)(orow + dt * 32 + 8 * gq) = ov;
            }
    }
}

DI void unpack8(const u32x4 v, float (&f)[8]) {
    f[0] = __uint_as_float(v.x << 16); f[1] = __uint_as_float(v.x & 0xffff0000u); f[2] = __uint_as_float(v.y << 16); f[3] = __uint_as_float(v.y & 0xffff0000u);
    f[4] = __uint_as_float(v.z << 16); f[5] = __uint_as_float(v.z & 0xffff0000u); f[6] = __uint_as_float(v.w << 16); f[7] = __uint_as_float(v.w & 0xffff0000u);
}
DI void merge_tile(const bf16_t* __restrict__ OR, const bf16_t* __restrict__ CBR, const bf16_t* __restrict__ ZR, const bf16_t* __restrict__ YS, const float* __restrict__ cw  , const float* __restrict__ og  ,
                   bf16_t* __restrict__ mA, int tile, int tid) {
    tid = opaque_v(tid); tile = opaque_s(tile);
    const int lane = tid & 63, w = tid >> 6;
    float cwv[3][8], ga[8], gb[8];
    {
        const int c0 = (lane & 31) * 8;
#pragma unroll
        for (int j = 0; j < 3; ++j) { const float4 p0 = *(const float4*)(cw + j * 256 + c0), p1 = *(const float4*)(cw + j * 256 + c0 + 4);
            cwv[j][0] = p0.x; cwv[j][1] = p0.y; cwv[j][2] = p0.z; cwv[j][3] = p0.w; cwv[j][4] = p1.x; cwv[j][5] = p1.y; cwv[j][6] = p1.z; cwv[j][7] = p1.w; }
        const float4 a0 = *(const float4*)(og + lane * 8), a1 = *(const float4*)(og + lane * 8 + 4), b0 = *(const float4*)(og + 512 + lane * 8), b1 = *(const float4*)(og + 512 + lane * 8 + 4);
        ga[0] = a0.x; ga[1] = a0.y; ga[2] = a0.z; ga[3] = a0.w; ga[4] = a1.x; ga[5] = a1.y; ga[6] = a1.z; ga[7] = a1.w;
        gb[0] = b0.x; gb[1] = b0.y; gb[2] = b0.z; gb[3] = b0.w; gb[4] = b1.x; gb[5] = b1.y; gb[6] = b1.z; gb[7] = b1.w;
    }
#pragma unroll 8
    for (int rr = 0; rr < 16; ++rr) {
        const int row = w * 16 + rr, t = tile * 128 + row, pos = t & (S - 1);
        float a[8], y[8];
        unpack8(*(const u32x4*)(OR + (unsigned)(t * 512 + lane * 8)), a);
        float ssa = 0.f;
#pragma unroll
        for (int q = 0; q < 8; ++q) ssa += a[q] * a[q];
        ssa = wave_sum(ssa);
        {
            const int c0 = (lane & 31) * 8;
            float cb[8], z0[8], z1[8], z2[8], ys[8];
            const float m1 = pos >= 1 ? 1.f : 0.f, m2 = pos >= 2 ? 1.f : 0.f;
            const int t1 = pos >= 1 ? t - 1 : t, t2 = pos >= 2 ? t - 2 : t;
            unpack8(*(const u32x4*)(CBR + (unsigned)(t * 256 + c0)), cb);
            unpack8(*(const u32x4*)(ZR + (unsigned)(t * 256 + c0)), z2);
            unpack8(*(const u32x4*)(ZR + (unsigned)(t1 * 256 + c0)), z1);
            unpack8(*(const u32x4*)(ZR + (unsigned)(t2 * 256 + c0)), z0);
            unpack8(*(const u32x4*)(YS + (unsigned)(t * 256 + c0)), ys);
#pragma unroll
            for (int q = 0; q < 8; ++q) {
                const float yc = cb[q] * (cwv[0][q] * (z0[q] * m2) + cwv[1][q] * (z1[q] * m1) + cwv[2][q] * z2[q]);
                y[q] = lane < 32 ? yc : ys[q];
            }
        }
        float ssy = 0.f;
#pragma unroll
        for (int q = 0; q < 8; ++q) ssy += y[q] * y[q];
#pragma unroll
        for (int o = 1; o < 32; o <<= 1) ssy += __shfl_xor(ssy, o);
        const float ra = rsqrtf(ssa * (1.f / 512.f) + EPS), ry = rsqrtf(ssy * (1.f / 256.f) + EPS);
        const int mb = row >> 5, r5 = row & 31;
        {
            u32x4 o; o.x = pk2(a[0] * ra * ga[0], a[1] * ra * ga[1]); o.y = pk2(a[2] * ra * ga[2], a[3] * ra * ga[3]); o.z = pk2(a[4] * ra * ga[4], a[5] * ra * ga[5]); o.w = pk2(a[6] * ra * ga[6], a[7] * ra * ga[7]);
            const int c8 = lane;
            (void)c8;
            *(u32x4*)(mA + (unsigned)(t * 1024 + lane * 8)) = o;
        }
        {
            u32x4 o; o.x = pk2(y[0] * ry * gb[0], y[1] * ry * gb[1]); o.y = pk2(y[2] * ry * gb[2], y[3] * ry * gb[3]); o.z = pk2(y[4] * ry * gb[4], y[5] * ry * gb[5]); o.w = pk2(y[6] * ry * gb[6], y[7] * ry * gb[7]);
            const int c8 = 64 + lane;
            (void)c8;
            *(u32x4*)(mA + (unsigned)(t * 1024 + 512 + lane * 8)) = o;
        }
    }
}

struct InProjOut { bf16_t *QF, *KF2, *VF, *CBR, *ZR, *YS; };
DI void inproj_tile(const bf16_t* __restrict__ At, const bf16_t* __restrict__ WF, const float* __restrict__ qg, const float* __restrict__ kg, const bf16_t* __restrict__ SWF, const float* __restrict__ sgu_b,
                    const InProjOut& O, char* lds, int tile, int tid) {
    tid = opaque_v(tid); tile = opaque_s(tile);
    const int lane = tid & 63, w = __builtin_amdgcn_readfirstlane(tid >> 6);
    f32x16 acc[4][2];
    {
        const int nbt0 = w * 2;
        kloop<1>(acc, At, WF + (size_t)nbt0 * 32768, WF + (size_t)(nbt0 + 1) * 32768, lds, tid, lane);
        epi_qk(acc, qg, 0.125f, O.QF + (size_t)(tile * 8 + w) * 8192, lane);
    }
    {
        const int nbt0 = 16 + w * 2;
        if (w == 2 || w == 3) {
            kloop<0>(acc, At, WF + (size_t)nbt0 * 32768, WF + (size_t)(nbt0 + 1) * 32768, lds, tid, lane);
            epi_v(acc, O.VF + (size_t)(tile * 2 + (w - 2)) * 8192, lane);
        } else {
            kloop<1>(acc, At, WF + (size_t)nbt0 * 32768, WF + (size_t)(nbt0 + 1) * 32768, lds, tid, lane);
            if (w < 2) epi_qk(acc, kg, 1.f, O.KF2 + (size_t)(tile * 2 + w) * 8192, lane);
            else epi_row(acc, O.CBR + (size_t)tile * 128 * 256 + (w - 4) * 64, 256, lane);
        }
    }
    {
        const int nbt0 = 32 + w * 2;
        kloop<1>(acc, At, WF + (size_t)nbt0 * 32768, WF + (size_t)(nbt0 + 1) * 32768, lds, tid, lane);
        epi_z(acc, O.ZR + (size_t)tile * 128 * 256 + w * 32, lane);
    }
    {
        const int nbt0 = 48 + w * 2;
        kloop<0>(acc, At, WF + (size_t)nbt0 * 32768, WF + (size_t)(nbt0 + 1) * 32768, lds, tid, lane);
        unsigned* lds_su = (unsigned*)lds;
        if (w < 4) epi_su_park(acc, lds_su + w * 4096, lane);
        __syncthreads();
        if (w >= 4) epi_sv(acc, SWF + (size_t)(w - 4) * 16384, sgu_b + (w - 4) * 128, lds_su + (w - 4) * 4096, O.YS + (size_t)tile * 128 * 256 + (w - 4) * 64, lane);
        __syncthreads();
    }
}


struct Params {
    const float *x, *c, *rel_bias, *w_ada, *b_ada, *norm1_g, *norm2_g, *w_in, *q_norm_g, *k_norm_g, *attn_sink, *conv_w, *sgu_w, *sgu_b, *out_norm_g, *w_out, *peer_wq, *peer_sub_keys, *peer_down, *peer_up;
    float* out;
    char* ws;
};
constexpr size_t MiB = 1u << 20;
constexpr size_t WS_MOD = 0;
constexpr size_t WS_MODP = 1 * MiB;
constexpr size_t WS_WIN = 13 * MiB;
constexpr size_t WS_WOUT = 29 * MiB;
constexpr size_t WS_WPQ = 37 * MiB;
constexpr size_t WS_KEYS = 53 * MiB;
constexpr size_t WS_SWF = 55 * MiB;
constexpr size_t WS_SC = 56 * MiB;
constexpr size_t WS_TB = 57 * MiB;
constexpr size_t WS_HA = 185 * MiB;
constexpr size_t WS_QF = 249 * MiB;
constexpr size_t WS_KF2 = 602 * MiB;
constexpr size_t WS_VF = 634 * MiB;
constexpr size_t WS_ZR = 666 * MiB;
constexpr size_t WS_CBR = 345 * MiB;
constexpr size_t WS_YS = 361 * MiB;
constexpr size_t WS_OR = 377 * MiB;
constexpr size_t WS_QPF = 409 * MiB;
constexpr size_t WS_RIDX = 537 * MiB;
constexpr size_t WS_RGATE = 553 * MiB;
constexpr size_t WS_SEID = 569 * MiB;
constexpr size_t WS_SWGT = 585 * MiB;
constexpr size_t WS_OFFS = 601 * MiB;
constexpr size_t WS_FLAGS = 601 * MiB + 512 * 1024;
constexpr size_t WS_END = 730 * MiB;
static_assert(PL_END <= LDS_RSTD1, "expert-phase lists overlap persistent LDS state");

__global__ __launch_bounds__(512) void hybrid_fwd(Params P) {
    extern __shared__ __attribute__((aligned(16))) char lds[];
    cg::grid_group grid = cg::this_grid();
    const int tid = threadIdx.x, lane = tid & 63, w = __builtin_amdgcn_readfirstlane(tid >> 6);
    const int nblk = gridDim.x, hwb = blockIdx.x;
    const int bid = (nblk == NTILE) ? (hwb & 7) * 32 + (hwb >> 3) : hwb;
    char* ws = P.ws;
    float* mod = (float*)(ws + WS_MOD);
    float* modp = (float*)(ws + WS_MODP);
    bf16_t* WinF = (bf16_t*)(ws + WS_WIN); bf16_t* WoutF = (bf16_t*)(ws + WS_WOUT); bf16_t* WpqF = (bf16_t*)(ws + WS_WPQ);
    bf16_t* KeysF = (bf16_t*)(ws + WS_KEYS); bf16_t* SWF = (bf16_t*)(ws + WS_SWF);
    float* SC = (float*)(ws + WS_SC); unsigned char* TBd = (unsigned char*)(ws + WS_TB); unsigned char* TBu = TBd + 32 * MiB;
    bf16_t* hA = (bf16_t*)(ws + WS_HA);
    bf16_t* OR = (bf16_t*)(ws + WS_OR); bf16_t* QPF = (bf16_t*)(ws + WS_QPF);
    int* ridx = (int*)(ws + WS_RIDX); float* rgate = (float*)(ws + WS_RGATE);
    float* bias_lds = (float*)(lds + LDS_BIAS);
    unsigned* flags = (unsigned*)(ws + WS_FLAGS);

    {
        float* ca = (float*)lds;
        if (tid == 0) for (int tile = bid; tile < NTILE; tile += nblk) __hip_atomic_store(flags + tile, 0u, __ATOMIC_RELAXED, __HIP_MEMORY_SCOPE_AGENT);
        for (int i = tid; i < 8192; i += 512) { const float v = P.c[i]; ca[i] = v / (1.f + __expf(-v)); }
        for (int i = tid; i < 1024; i += 512) bias_lds[i] = P.rel_bias[t5_bucket(i & 127) * 8 + (i >> 7)];
        __syncthreads();
        for (int it = bid; it < 768; it += nblk) {
            const int jc = it % 12, l = (it / 12) & 3, ks = it / 48;
            const int j = jc * 512 + tid;
            const float* wp = P.w_ada + ((size_t)l * 1024 + ks * 64) * 6144 + j;
            float acc[8];
#pragma unroll
            for (int b = 0; b < 8; ++b) acc[b] = 0.f;
#pragma unroll 4
            for (int i = 0; i < 64; ++i) {
                const float wv = wp[(size_t)i * 6144];
#pragma unroll
                for (int b = 0; b < 8; ++b) acc[b] += ca[b * 1024 + ks * 64 + i] * wv;
            }
#pragma unroll
            for (int b = 0; b < 8; ++b) modp[((size_t)(ks * 4 + l) * 8 + b) * 6144 + j] = acc[b];
        }
        const int gthreads = nblk * 512, gtid = bid * 512 + tid;
        for (int rep = 0; rep < REP_P0; ++rep)
        for (int l = 0; l < DEPTH; ++l) {
            for (int g = gtid; g < 64 * 64 * 64; g += gthreads) conv_wfrag_item(P.w_in + (size_t)l * 1024 * 2048, 2048, 64, WinF + (size_t)l * 2097152, g, 1);
            for (int g = gtid; g < 32 * 64 * 64; g += gthreads) conv_wfrag_item(P.w_out + (size_t)l * 1024 * 1024, 1024, 64, WoutF + (size_t)l * 1048576, g, 0);
            for (int g = gtid; g < 64 * 64 * 64; g += gthreads) conv_wfrag_item(P.peer_wq + (size_t)l * 1024 * 2048, 2048, 64, WpqF + (size_t)l * 2097152, g, 0);
            for (int g = gtid; g < 32768; g += gthreads) conv_keys_item(P.peer_sub_keys + (size_t)l * 262144, KeysF + (size_t)l * 262144, g);
            for (int g = gtid; g < 8192; g += gthreads) conv_sguw_item(P.sgu_w + (size_t)l * 65536, SWF + (size_t)l * 65536, g);
        }
        const int gwaves = nblk * 8, gw = bid * 8 + w;
        for (int rep = 0; rep < REP_P0; ++rep)
        for (int r = gw; r < DEPTH * 16384 * 2; r += gwaves) {
            const int which = r & 1, le = r >> 1;
            conv_table_row((which ? P.peer_up : P.peer_down) + (size_t)le * D, (which ? TBu : TBd) + (size_t)le * 512, SC + (size_t)le * 2 + which, lane, which == 0);
        }
    }
    grid.sync();
    for (int tile = bid; tile < NTILE; tile += nblk) {
        const int b = tile >> 5;
        for (int l = 0; l < DEPTH; ++l)
            for (int j = tid; j < 6144; j += 512) {
                float v = P.b_ada[l * 6144 + j];
#pragma unroll
                for (int ks = 0; ks < 16; ++ks) v += modp[((size_t)(ks * 4 + l) * 8 + b) * 6144 + j];
                mod[((size_t)l * 8 + b) * 6144 + j] = v;
            }
    }
    __syncthreads();

    for (int l = 0; l < DEPTH; ++l) {
        const float* xin = l == 0 ? P.x : P.out;
        InProjOut IO;
        IO.QF = (bf16_t*)(ws + WS_QF); IO.KF2 = (bf16_t*)(ws + WS_KF2 + (size_t)l * 8 * MiB); IO.VF = (bf16_t*)(ws + WS_VF + (size_t)l * 8 * MiB);
        IO.CBR = (bf16_t*)(ws + WS_CBR); IO.ZR = (bf16_t*)(ws + WS_ZR + (size_t)l * 16 * MiB); IO.YS = (bf16_t*)(ws + WS_YS);
        for (int tile = bid; tile < NTILE; tile += nblk) {
            const float* mb_ = mod + ((size_t)l * 8 + (tile >> 5)) * 6144;
            const bool have1 = l > 0 && nblk == NTILE;
            if (have1) { if (tid < 128) ((float*)lds)[tid] = ((const float*)(lds + LDS_RSTD1))[tid]; __syncthreads(); }
            norm_to_frag(xin, P.norm1_g + l * D, mb_ + 0, mb_ + 1024, hA, (float*)lds, tile, tid, have1);
            __syncthreads();
            for (int rep = 0; rep < REP_GEMM; ++rep) inproj_tile(hA + (size_t)tile * 131072, WinF + (size_t)l * 2097152, P.q_norm_g + l * 64, P.k_norm_g + l * 64, SWF + (size_t)l * 65536, P.sgu_b + l * 512, IO, lds, tile, tid);
            asm volatile("s_waitcnt vmcnt(0)" ::: "memory");
            __syncthreads();
            if (tid == 0) {
                __builtin_amdgcn_fence(__ATOMIC_RELEASE, "agent");
                asm volatile("s_waitcnt vmcnt(0)" ::: "memory");
                __hip_atomic_store(flags + tile, (unsigned)(l + 1), __ATOMIC_RELAXED, __HIP_MEMORY_SCOPE_AGENT);
            }
        }
        for (int tile = bid; tile < NTILE; tile += nblk) {
            const float* mb_ = mod + ((size_t)l * 8 + (tile >> 5)) * 6144;
            if ((tile & 31) != 0) {
                if (tid == 0) {
                    unsigned spins = 0;
                    while (__hip_atomic_load(flags + tile - 1, __ATOMIC_RELAXED, __HIP_MEMORY_SCOPE_AGENT) < (unsigned)(l + 1) && ++spins < (1u << 24)) __builtin_amdgcn_s_sleep(2);
                    __builtin_amdgcn_fence(__ATOMIC_ACQUIRE, "agent");
                    asm volatile("s_waitcnt vmcnt(0)" ::: "memory");
                }
                __syncthreads();
            }
            for (int rep = 0; rep < REP_MIX; ++rep) {
            attn_tile(IO.QF, IO.KF2, IO.VF, lds, bias_lds, P.attn_sink + l * 8, OR, tile, tid);
            __syncthreads();
            merge_tile(OR, IO.CBR, IO.ZR, IO.YS, P.conv_w + l * 768, P.out_norm_g + l * D, hA, tile, tid);
            __syncthreads();
            }
            {
                const bf16_t* At = hA + (size_t)tile * 131072;
                const bf16_t* WF = WoutF + (size_t)l * 1048576;
                for (int pass = 0; pass < 2; ++pass) {
                    f32x16 acc[4][2];
                    const int nbt0 = pass * 16 + w * 2;
                    kloop<0>(acc, At, WF + (size_t)nbt0 * 32768, WF + (size_t)(nbt0 + 1) * 32768, lds, tid, lane);
                    epi_resid(acc, xin, P.out, mb_ + 2048, (float*)(lds + LDS_EPI) + w * 2176, (float*)(lds + LDS_SSQ) + (pass * 8 + w) * 128, tile, pass * 512 + w * 64, lane);
                }
            }
            __syncthreads();
            if (tid < 128) { const float* sq = (const float*)(lds + LDS_SSQ); float ssum = 0.f;
#pragma unroll
                for (int c = 0; c < 16; ++c) ssum += sq[c * 128 + tid];
                ((float*)lds)[tid] = rsqrtf(ssum * (1.f / D) + EPS); }
            __syncthreads();
            norm_to_frag(P.out, P.norm2_g + l * D, mb_ + 3072, mb_ + 4096, hA, (float*)lds, tile, tid, true);
            __syncthreads();
            {
                const bf16_t* At = hA + (size_t)tile * 131072;
                const bf16_t* WF = WpqF + (size_t)l * 2097152;
                for (int rep = 0; rep < REP_GEMM; ++rep)
                for (int pass = 0; pass < 4; ++pass) {
                    f32x16 acc[4][2];
                    const int nbt0 = pass * 16 + w * 2;
                    kloop<1>(acc, At, WF + (size_t)nbt0 * 32768, WF + (size_t)(nbt0 + 1) * 32768, lds, tid, lane);
                    epi_qpf(acc, QPF, tile, nbt0, lane);
                }
            }
            __syncthreads();
            for (int rep = 0; rep < REP_ROUTE; ++rep) { route_tile(QPF, KeysF + (size_t)l * 262144, lds, (unsigned char*)lds + PL_RIDX, tile, tid); __syncthreads(); }
            peer_down_wave(hA, lds, TBd + (size_t)l * 16384 * 512, SC + (size_t)l * 32768, tile, w, lane);
            __syncthreads();
            peer_up_wave(lds, TBu + (size_t)l * 16384 * 512, mb_ + 5120, P.out, tile, w, lane);
            __syncthreads();
        }
    }
}
}

extern "C" void kernel_launch(void* const* d_in, const int* in_sizes, int n_in, void* d_out, int out_size, void* d_ws, size_t ws_size, hipStream_t stream) {
    using namespace op;
    static int grid_blocks = 0;
    if (!grid_blocks) {
        int dev = 0, cus = 0, per_cu = 0;
        (void)hipGetDevice(&dev);
        (void)hipDeviceGetAttribute(&cus, hipDeviceAttributeMultiprocessorCount, dev);
        (void)hipFuncSetAttribute((const void*)hybrid_fwd, hipFuncAttributeMaxDynamicSharedMemorySize, LDS_BYTES);
        (void)hipOccupancyMaxActiveBlocksPerMultiprocessor(&per_cu, (const void*)hybrid_fwd, 512, LDS_BYTES);
        if (per_cu < 1) per_cu = 1;
        grid_blocks = cus * per_cu;
        if (grid_blocks > NTILE) grid_blocks = NTILE;
        if (ws_size < WS_END) { fprintf(stderr, "kernel_launch: workspace too small (%zu < %zu)\n", ws_size, (size_t)WS_END); grid_blocks = -1; }
    }
    if (grid_blocks < 0) return;
    Params p{};
    p.x = (const float*)d_in[0]; p.c = (const float*)d_in[1]; p.rel_bias = (const float*)d_in[2]; p.w_ada = (const float*)d_in[3]; p.b_ada = (const float*)d_in[4];
    p.norm1_g = (const float*)d_in[5]; p.norm2_g = (const float*)d_in[6]; p.w_in = (const float*)d_in[7]; p.q_norm_g = (const float*)d_in[8]; p.k_norm_g = (const float*)d_in[9];
    p.attn_sink = (const float*)d_in[10]; p.conv_w = (const float*)d_in[11]; p.sgu_w = (const float*)d_in[12]; p.sgu_b = (const float*)d_in[13]; p.out_norm_g = (const float*)d_in[14];
    p.w_out = (const float*)d_in[15]; p.peer_wq = (const float*)d_in[16]; p.peer_sub_keys = (const float*)d_in[17]; p.peer_down = (const float*)d_in[18]; p.peer_up = (const float*)d_in[19];
    p.out = (float*)d_out; p.ws = (char*)d_ws;
    void* args[] = {&p};
    hipError_t e = hipLaunchCooperativeKernel((const void*)hybrid_fwd, dim3(grid_blocks), dim3(512), args, LDS_BYTES, stream);
    if (e != hipSuccess) fprintf(stderr, "kernel_launch: cooperative launch failed: %s (grid %d)\n", hipGetErrorString(e), grid_blocks);
}
```

```cpp
#include <hip/hip_runtime.h>
#include <cstdio>
#include <cstdint>
#include <hip/hip_cooperative_groups.h>
namespace cg = cooperative_groups;


namespace op {
#define DI __device__ __forceinline__
typedef unsigned short bf16_t;
typedef short bf16x8 __attribute__((ext_vector_type(8)));
typedef float f32x16 __attribute__((ext_vector_type(16)));
typedef float f32x2 __attribute__((ext_vector_type(2)));
typedef unsigned u32x4 __attribute__((ext_vector_type(4)));
typedef unsigned u32x2 __attribute__((ext_vector_type(2)));
typedef __bf16 bf16v2 __attribute__((ext_vector_type(2)));
constexpr int D = 1024, NB = 8, S = 4096, DEPTH = 4, T = NB * S, NTILE = T / 128;
constexpr float EPS = 1e-6f;
constexpr int PL_SEID = 0, PL_SWGT = 32768, PL_END = 98304, PL_RIDX = 98304;
constexpr int LDS_EPI = 32768, LDS_SSQ = 102400, LDS_RSTD1 = 110592, LDS_BIAS = 128 * 1024, LDS_BYTES = 132 * 1024;
constexpr int REP_GEMM = 1, REP_ROUTE = 1, REP_MIX = 1, REP_NORM = 1, REP_P0 = 1;
#define MFMA32(a, b, c) __builtin_amdgcn_mfma_f32_32x32x16_bf16((a), (b), (c), 0, 0, 0)

DI unsigned pk2(float lo, float hi) { f32x2 v = {lo, hi}; return __builtin_bit_cast(unsigned, __builtin_convertvector(v, bf16v2)); }
DI int opaque_v(int x) { asm volatile("" : "+v"(x)); return x; }
DI int opaque_s(int x) { asm volatile("" : "+s"(x)); return x; }
DI int crow(int reg, int hh) { return (reg & 3) + 8 * (reg >> 2) + 4 * hh; }
DI float wave_sum(float v) {
#pragma unroll
    for (int o = 1; o < 64; o <<= 1) v += __shfl_xor(v, o);
    return v;
}

DI int col_perm(int npos, int mode) {
    if (mode == 1 && npos >= 1024 && npos < 1536) { const int q = npos - 1024, w = q >> 6, nb = (q >> 5) & 1, r = q & 31; return (nb ? 1280 : 1024) + 32 * w + r; }
    return npos;
}
DI void conv_wfrag_item(const float* __restrict__ W, int N, int KB, bf16_t* __restrict__ WF, int gid, int mode) {
    const int l = gid & 63, kb = (gid >> 6) % KB, nbt = (gid >> 6) / KB, r = l & 31, hh = l >> 5;
    const int n = col_perm(nbt * 32 + r, mode);
    const float* p = W + (size_t)(kb * 16 + 8 * hh) * N + n;
    float v[8];
#pragma unroll
    for (int j = 0; j < 8; ++j) v[j] = p[(size_t)j * N];
    u32x4 o; o.x = pk2(v[0], v[1]); o.y = pk2(v[2], v[3]); o.z = pk2(v[4], v[5]); o.w = pk2(v[6], v[7]);
    *(u32x4*)(WF + (size_t)gid * 8) = o;
}

DI void norm_to_frag(const float* __restrict__ x, const float* __restrict__ g, const float* __restrict__ sh, const float* __restrict__ sc, bf16_t* __restrict__ hA, float* rstd_lds, int tile, int tid, bool have_rstd) {
    tid = opaque_v(tid); tile = opaque_s(tile);
    const int w = tid >> 6, lane = tid & 63;
    float cg[16], cs[16], ch[16];
#pragma unroll
    for (int j = 0; j < 2; ++j)
#pragma unroll
        for (int q = 0; q < 2; ++q) {
            const int c = 512 * j + 8 * lane + 4 * q;
            const float4 a = *(const float4*)(g + c), b = *(const float4*)(sc + c), d = *(const float4*)(sh + c);
            cg[8 * j + 4 * q] = a.x * (1.f + b.x); cg[8 * j + 4 * q + 1] = a.y * (1.f + b.y); cg[8 * j + 4 * q + 2] = a.z * (1.f + b.z); cg[8 * j + 4 * q + 3] = a.w * (1.f + b.w);
            ch[8 * j + 4 * q] = d.x; ch[8 * j + 4 * q + 1] = d.y; ch[8 * j + 4 * q + 2] = d.z; ch[8 * j + 4 * q + 3] = d.w;
            cs[8 * j + 4 * q] = 0.f; cs[8 * j + 4 * q + 1] = 0.f; cs[8 * j + 4 * q + 2] = 0.f; cs[8 * j + 4 * q + 3] = 0.f;
        }
    (void)cs;
#pragma unroll 8
    for (int rr = 0; rr < 16; ++rr) {
        const int row = w * 16 + rr;
        const float* xr = x + ((size_t)tile * 128 + row) * D + 8 * lane;
        float v[16];
#pragma unroll
        for (int j = 0; j < 2; ++j)
#pragma unroll
            for (int q = 0; q < 2; ++q) { const float4 a = *(const float4*)(xr + 512 * j + 4 * q); v[8 * j + 4 * q] = a.x; v[8 * j + 4 * q + 1] = a.y; v[8 * j + 4 * q + 2] = a.z; v[8 * j + 4 * q + 3] = a.w; }
        float r;
        if (have_rstd) r = rstd_lds[row];
        else {
            float ss = 0.f;
#pragma unroll
            for (int e = 0; e < 16; ++e) ss += v[e] * v[e];
            r = rsqrtf(wave_sum(ss) * (1.f / D) + EPS);
        }
        bf16_t* orow = hA + ((size_t)tile * 128 + row) * D + 8 * lane;
#pragma unroll
        for (int j = 0; j < 2; ++j) {
            u32x4 o;
            o.x = pk2(v[8 * j] * r * cg[8 * j] + ch[8 * j], v[8 * j + 1] * r * cg[8 * j + 1] + ch[8 * j + 1]);
            o.y = pk2(v[8 * j + 2] * r * cg[8 * j + 2] + ch[8 * j + 2], v[8 * j + 3] * r * cg[8 * j + 3] + ch[8 * j + 3]);
            o.z = pk2(v[8 * j + 4] * r * cg[8 * j + 4] + ch[8 * j + 4], v[8 * j + 5] * r * cg[8 * j + 5] + ch[8 * j + 5]);
            o.w = pk2(v[8 * j + 6] * r * cg[8 * j + 6] + ch[8 * j + 6], v[8 * j + 7] * r * cg[8 * j + 7] + ch[8 * j + 7]);
            *(u32x4*)(orow + 512 * j) = o;
        }
    }
}

template <int ORIENT>
DI void kloop(f32x16 (&acc)[4][2], const bf16_t* __restrict__ At, const bf16_t* __restrict__ W0, const bf16_t* __restrict__ W1, char* lds, int tid, int lane) {
    tid = opaque_v(tid); lane = opaque_v(lane);
#pragma unroll
    for (int mb = 0; mb < 4; ++mb)
#pragma unroll
        for (int nb = 0; nb < 2; ++nb)
#pragma unroll
            for (int i = 0; i < 16; ++i) acc[mb][nb][i] = 0.f;
    {
    const int c8_ = (tid >> 3) & 7, rowA_ = (tid >> 6) * 8 + (tid & 7);
    const u32x4* Ag = (const u32x4*)(At + (unsigned)(rowA_ * 1024 + c8_ * 8));
    const int ldsA_ = ((((c8_ >> 1) * 4 + (rowA_ >> 5)) * 64) + (rowA_ & 31) + 32 * (c8_ & 1)) * 16;
    const u32x4* W0g = (const u32x4*)W0 + lane;
    const u32x4* W1g = (const u32x4*)W1 + lane;
    u32x4 wq[4][2], arA[2], arB[2];
    arA[0] = Ag[0]; arA[1] = Ag[8192]; arB[0] = Ag[8]; arB[1] = Ag[8 + 8192];
#pragma unroll
    for (int kk = 0; kk < 4; ++kk) { wq[kk][0] = W0g[kk * 64]; wq[kk][1] = W1g[kk * 64]; }
    *(u32x4*)(lds + ldsA_) = arA[0]; *(u32x4*)(lds + ldsA_ + 2048) = arA[1];
    __syncthreads();
#define KL_ITER(KC, ARL, ARS) do { \
        char* cur = lds + ((KC) & 1) * 16384; \
        char* nxt = lds + (((KC) + 1) & 1) * 16384; \
        const int kn = (KC) < 15 ? (KC) + 1 : 15, k2 = (KC) < 14 ? (KC) + 2 : 15; \
        if ((KC) < 14) { ARL[0] = Ag[k2 * 8]; ARL[1] = Ag[k2 * 8 + 8192]; } \
        __builtin_amdgcn_sched_barrier(0); \
        _Pragma("unroll") for (int kk = 0; kk < 4; ++kk) { \
            bf16x8 afr[4]; \
            _Pragma("unroll") for (int mb = 0; mb < 4; ++mb) afr[mb] = *(const bf16x8*)(cur + ((kk * 4 + mb) * 64 + lane) * 16); \
            _Pragma("unroll") for (int mb = 0; mb < 4; ++mb) \
                _Pragma("unroll") for (int nb = 0; nb < 2; ++nb) { \
                    const bf16x8 wf = __builtin_bit_cast(bf16x8, wq[kk][nb]); \
                    if (ORIENT == 0) acc[mb][nb] = MFMA32(afr[mb], wf, acc[mb][nb]); \
                    else acc[mb][nb] = MFMA32(wf, afr[mb], acc[mb][nb]); \
                } \
            if ((KC) < 15) { wq[kk][0] = W0g[(kn * 4 + kk) * 64]; wq[kk][1] = W1g[(kn * 4 + kk) * 64]; } \
            __builtin_amdgcn_sched_barrier(0); \
        } \
        if ((KC) < 15) { *(u32x4*)(nxt + ldsA_) = ARS[0]; *(u32x4*)(nxt + ldsA_ + 2048) = ARS[1]; } \
        __syncthreads(); \
    } while (0)
    for (int kc = 0; kc < 16; kc += 2) { KL_ITER(kc, arA, arB); KL_ITER(kc + 1, arB, arA); }
#undef KL_ITER
    }
}

DI void epi_f32row(const f32x16 (&acc)[4][2], float* __restrict__ C, int tile, int col0, int lane) {
    lane = opaque_v(lane);
    const int r5 = lane & 31, hh = lane >> 5;
    const unsigned boff = (unsigned)((tile * 128 + 4 * hh) * 2048 + col0 + r5);
#pragma unroll
    for (int mb = 0; mb < 4; ++mb)
#pragma unroll
        for (int nb = 0; nb < 2; ++nb)
#pragma unroll
            for (int i = 0; i < 16; ++i)
                C[boff + (unsigned)((mb * 32 + (i & 3) + 8 * (i >> 2)) * 2048 + nb * 32)] = acc[mb][nb][i];
}
DI void epi_resid(const f32x16 (&acc)[4][2], const float* __restrict__ xin, float* __restrict__ xout, const float* __restrict__ gate_b, float* T  , float* ssq  , int tile, int col0, int lane) {
    lane = opaque_v(lane);
    const int r5 = lane & 31, hh = lane >> 5, rq = lane >> 4, c4 = (lane & 15) * 4;
    const float4 gv = *(const float4*)(gate_b + col0 + c4);
#pragma unroll
    for (int mb = 0; mb < 4; ++mb) {
#pragma unroll
        for (int nb = 0; nb < 2; ++nb)
#pragma unroll
            for (int i = 0; i < 16; ++i) T[((i & 3) + 8 * (i >> 2) + 4 * hh) * 68 + nb * 32 + r5] = acc[mb][nb][i];
        asm volatile("s_waitcnt lgkmcnt(0)" ::: "memory");
#pragma unroll
        for (int j = 0; j < 8; ++j) {
            const int row = rq + 4 * j;
            const float4 v = *(const float4*)(T + row * 68 + c4);
            const unsigned o = (unsigned)((tile * 128 + mb * 32 + row) * D + col0 + c4);
            float4 xv = *(const float4*)(xin + o);
            xv.x += gv.x * v.x; xv.y += gv.y * v.y; xv.z += gv.z * v.z; xv.w += gv.w * v.w;
            *(float4*)(xout + o) = xv;
            float ss = xv.x * xv.x + xv.y * xv.y + xv.z * xv.z + xv.w * xv.w;
            ss += __shfl_xor(ss, 1); ss += __shfl_xor(ss, 2); ss += __shfl_xor(ss, 4); ss += __shfl_xor(ss, 8);
            if ((lane & 15) == 0) ssq[mb * 32 + row] = ss;
        }
        asm volatile("s_waitcnt lgkmcnt(0)" ::: "memory");
    }
}

DI void epi_qpf(const f32x16 (&acc)[4][2], bf16_t* __restrict__ QPF, int tile, int ft0, int lane) {
    lane = opaque_v(lane);
#pragma unroll
    for (int nb = 0; nb < 2; ++nb)
#pragma unroll
        for (int s = 0; s < 2; ++s)
#pragma unroll
            for (int mb = 0; mb < 4; ++mb) {
                const f32x16& a = acc[mb][nb];
                u32x4 o; o.x = pk2(a[8 * s], a[8 * s + 1]); o.y = pk2(a[8 * s + 2], a[8 * s + 3]); o.z = pk2(a[8 * s + 4], a[8 * s + 5]); o.w = pk2(a[8 * s + 6], a[8 * s + 7]);
                *(u32x4*)(QPF + ((unsigned)((((tile * 64 + ft0 + nb) * 2 + s) * 4 + mb) * 64 + lane)) * 8) = o;
            }
}

DI void conv_keys_item(const float* __restrict__ K, bf16_t* __restrict__ KF, int gid) {
    const int lane = gid & 63, s = (gid >> 6) & 1, nbl = (gid >> 7) & 3, nt = (gid >> 9) & 3, hp = gid >> 11;
    const int r = lane & 31, hh = lane >> 5;
    const float* p = K + ((size_t)hp * 128 + nt * 32 + r) * 128 + nbl * 32 + 16 * s + 4 * hh;
    const float4 a = *(const float4*)p, b = *(const float4*)(p + 8);
    u32x4 o; o.x = pk2(a.x, a.y); o.y = pk2(a.z, a.w); o.z = pk2(b.x, b.y); o.w = pk2(b.z, b.w);
    *(u32x4*)(KF + (size_t)gid * 8) = o;
}

DI void conv_table_row(const float* __restrict__ src, unsigned char* __restrict__ dst, float* __restrict__ sc, int lane, bool as_int4) {
    const float4* p = (const float4*)src + lane * 4;
    float4 v[4];
    float m = 0.f;
#pragma unroll
    for (int j = 0; j < 4; ++j) { v[j] = p[j]; m = fmaxf(m, fmaxf(fmaxf(fabsf(v[j].x), fabsf(v[j].y)), fmaxf(fabsf(v[j].z), fabsf(v[j].w)))); }
#pragma unroll
    for (int o = 1; o < 64; o <<= 1) m = fmaxf(m, __shfl_xor(m, o));
    float scale = m > 0.f ? m * (1.f / 6.f) : 1.f;
    if (as_int4) {
        float ss = 0.f;
#pragma unroll
        for (int j = 0; j < 4; ++j) ss += v[j].x * v[j].x + v[j].y * v[j].y + v[j].z * v[j].z + v[j].w * v[j].w;
        ss = wave_sum(ss);
        const float sg = sqrtf(ss * (1.f / 1024.f));
        scale = fmaxf(sg * (1.f / 2.8f), m * (1.f / 16.f));
        if (!(scale > 0.f)) scale = 1.f;
    }
    const float inv = 1.f / scale;
    u32x2 o;
    unsigned* op = (unsigned*)&o;
#pragma unroll
    for (int j = 0; j < 2; ++j) {
        const float f[8] = {v[2 * j].x, v[2 * j].y, v[2 * j].z, v[2 * j].w, v[2 * j + 1].x, v[2 * j + 1].y, v[2 * j + 1].z, v[2 * j + 1].w};
        unsigned wv = 0;
        if (as_int4) {
#pragma unroll
            for (int e = 0; e < 8; ++e) { int q = __float2int_rn(f[e] * inv); q = q < -7 ? -7 : (q > 7 ? 7 : q); wv |= ((unsigned)q & 15u) << (4 * e); }
        } else {
            wv = __builtin_amdgcn_cvt_scalef32_pk_fp4_f32(wv, f[0] * inv, f[1] * inv, 1.0f, 0);
            wv = __builtin_amdgcn_cvt_scalef32_pk_fp4_f32(wv, f[2] * inv, f[3] * inv, 1.0f, 1);
            wv = __builtin_amdgcn_cvt_scalef32_pk_fp4_f32(wv, f[4] * inv, f[5] * inv, 1.0f, 2);
            wv = __builtin_amdgcn_cvt_scalef32_pk_fp4_f32(wv, f[6] * inv, f[7] * inv, 1.0f, 3);
        }
        op[j] = wv;
    }
    *(u32x2*)(dst + lane * 8) = o;
    if (lane == 0) *sc = scale;
}

DI void ce_desc(int& a, int& b) { const int mx = a > b ? a : b, mn = a > b ? b : a; a = mx; b = mn; }
DI void sort16_desc(int (&v)[16]) {
#pragma unroll
    for (int k = 2; k <= 16; k <<= 1)
#pragma unroll
        for (int j = k >> 1; j > 0; j >>= 1)
#pragma unroll
            for (int i = 0; i < 16; ++i) {
                const int l = i ^ j;
                if (l > i) { if ((i & k) == 0) ce_desc(v[i], v[l]); else ce_desc(v[l], v[i]); }
            }
}
DI void bitonic_merge16_desc(int (&v)[16]) {
#pragma unroll
    for (int j = 8; j > 0; j >>= 1)
#pragma unroll
        for (int i = 0; i < 16; ++i) { const int l = i ^ j; if (l > i) ce_desc(v[i], v[l]); }
}
DI void merge_top16(int (&a)[16], const int (&b)[16]) {
#pragma unroll
    for (int i = 0; i < 16; ++i) a[i] = a[i] > b[15 - i] ? a[i] : b[15 - i];
    bitonic_merge16_desc(a);
}
DI int f2ord(float f) { int b = __float_as_int(f); return b ^ ((b >> 31) & 0x7fffffff); }
DI float ord2f(int k) { return __int_as_float(k ^ ((k >> 31) & 0x7fffffff)); }

DI void route_tile(const bf16_t* __restrict__ QPF, const bf16_t* __restrict__ KF, char* lds_lists, unsigned char* lds_idx  , int tile, int tid) {
    tid = opaque_v(tid); tile = opaque_s(tile);
    const int lane = tid & 63, w = __builtin_amdgcn_readfirstlane(tid >> 6);
    const int r5 = lane & 31, hh = lane >> 5;
    unsigned char* myidx = lds_idx + w * 1024;
    for (int task = w; task < 32; task += 8) {
        const int h = task >> 2, tt = task & 3;
        f32x16 acc[2][4];
#pragma unroll
        for (int p = 0; p < 2; ++p)
#pragma unroll
            for (int nt = 0; nt < 4; ++nt)
#pragma unroll
                for (int i = 0; i < 16; ++i) acc[p][nt][i] = 0.f;
        {
            bf16x8 bq[3], ak[3][4];
#define ROUTE_LOAD(buf, step) do { const int p_ = (step) >> 3, ks_ = (step) & 7; \
                bq[buf] = *(const bf16x8*)(QPF + ((unsigned)((((tile * 64 + h * 8 + p_ * 4 + (ks_ >> 1)) * 2 + (ks_ & 1)) * 4 + tt) * 64 + lane)) * 8); \
                _Pragma("unroll") for (int nt = 0; nt < 4; ++nt) ak[buf][nt] = *(const bf16x8*)(KF + ((unsigned)(((((h * 2 + p_) * 4 + nt) * 8 + ks_) * 64) + lane)) * 8); } while (0)
            ROUTE_LOAD(0, 0);
            ROUTE_LOAD(1, 1);
#pragma unroll
            for (int step = 0; step < 16; ++step) {
                if (step < 14) ROUTE_LOAD((step + 2) % 3, step + 2);
#pragma unroll
                for (int nt = 0; nt < 4; ++nt) acc[step >> 3][nt] = MFMA32(ak[step % 3][nt], bq[step % 3], acc[step >> 3][nt]);
                __builtin_amdgcn_sched_barrier(0);
            }
#undef ROUTE_LOAD
        }
        int g[8][16];
#pragma unroll
        for (int nt = 0; nt < 4; ++nt)
#pragma unroll
            for (int i = 0; i < 16; ++i) {
                const unsigned a = __float_as_uint(acc[0][nt][i]), b = __float_as_uint(acc[1][nt][i]);
                auto sw = __builtin_amdgcn_permlane32_swap(a, b, false, false);
                const int n0 = nt * 32 + (i & 3) + 8 * (i >> 2);
                g[nt * 2 + (i >> 3)][i & 7] = (f2ord(__uint_as_float(sw[0])) & ~127) | n0;
                g[nt * 2 + (i >> 3)][8 + (i & 7)] = (f2ord(__uint_as_float(sw[1])) & ~127) | (n0 + 4);
            }
#pragma unroll
        for (int q = 0; q < 8; ++q) sort16_desc(g[q]);
        merge_top16(g[0], g[1]); merge_top16(g[2], g[3]); merge_top16(g[4], g[5]); merge_top16(g[6], g[7]);
        merge_top16(g[0], g[2]); merge_top16(g[4], g[6]);
        merge_top16(g[0], g[4]);
        {
            u32x4 pk;
            unsigned* pp = (unsigned*)&pk;
#pragma unroll
            for (int q = 0; q < 4; ++q) pp[q] = (unsigned)(g[0][4 * q] & 127) | ((unsigned)(g[0][4 * q + 1] & 127) << 8) | ((unsigned)(g[0][4 * q + 2] & 127) << 16) | ((unsigned)(g[0][4 * q + 3] & 127) << 24);
            *(u32x4*)(myidx + lane * 16) = pk;
        }
        float f0[16], f1[16];
#pragma unroll
        for (int i = 0; i < 16; ++i) {
            const unsigned a = (unsigned)g[0][i], b = a;
            auto sw = __builtin_amdgcn_permlane32_swap(a, b, false, false);
            f0[i] = ord2f((int)sw[0] & ~127); f1[i] = ord2f((int)sw[1] & ~127);
        }
        int c0[16], c1[16], c2[16], c3[16];
#pragma unroll
        for (int j = 0; j < 16; ++j) c0[j] = (f2ord(f0[0] + f1[j]) & ~255) | j;
#pragma unroll
        for (int i = 1; i < 16; ++i) c1[i - 1] = (f2ord(f0[i] + f1[0]) & ~255) | (i << 4);
        c1[15] = (int)0x80000000;
#define CK(i, j) ((f2ord(f0[i] + f1[j]) & ~255) | ((i) << 4) | (j))
        c2[0] = CK(1, 1); c2[1] = CK(1, 2); c2[2] = CK(1, 3); c2[3] = CK(1, 4); c2[4] = CK(1, 5); c2[5] = CK(1, 6); c2[6] = CK(1, 7);
        c2[7] = CK(2, 1); c2[8] = CK(2, 2); c2[9] = CK(2, 3); c2[10] = CK(2, 4);
        c2[11] = CK(3, 1); c2[12] = CK(3, 2); c2[13] = CK(3, 3);
        c2[14] = CK(4, 1); c2[15] = CK(4, 2);
        c3[0] = CK(5, 1); c3[1] = CK(6, 1); c3[2] = CK(7, 1);
#undef CK
#pragma unroll
        for (int q = 3; q < 16; ++q) c3[q] = (int)0x80000000;
        sort16_desc(c2);
        ce_desc(c3[0], c3[1]); ce_desc(c3[1], c3[2]); ce_desc(c3[0], c3[1]);
        merge_top16(c0, c1); merge_top16(c2, c3); merge_top16(c0, c2);
        float bs[16], den = 0.f;
#pragma unroll
        for (int i = 0; i < 16; ++i) { bs[i] = __expf(ord2f(c0[i] & ~255) - ord2f(c0[0] & ~255)); den += bs[i]; }
        const float rden = 1.f / den;
        asm volatile("s_waitcnt lgkmcnt(0)" ::: "memory");
#pragma unroll
        for (int q = 0; q < 8; ++q) {
            const int key = (int)__builtin_amdgcn_permlane32_swap((unsigned)c0[q], (unsigned)c0[8 + q], false, false)[0];
            const float gv = __uint_as_float(__builtin_amdgcn_permlane32_swap(__float_as_uint(bs[q]), __float_as_uint(bs[8 + q]), false, false)[0]) * rden;
            const int i = (key >> 4) & 15, j = key & 15;
            const int e = (int)myidx[r5 * 16 + i] * 128 + (int)myidx[(32 + r5) * 16 + j];
            const int tokl = tt * 32 + r5;
            ((unsigned short*)(lds_lists + PL_SEID))[tokl * 128 + h * 16 + 8 * hh + q] = (unsigned short)e;
            ((float*)(lds_lists + PL_SWGT))[tokl * 128 + h * 16 + 8 * hh + q] = gv;
        }
        asm volatile("s_waitcnt lgkmcnt(0)" ::: "memory");
    }
}

DI void unpack_h2(const bf16_t* __restrict__ hA, int t, int lane, f32x2 (&hv)[8]) {
    const int tile = t >> 7, row = t & 127, mb = row >> 5, r5 = row & 31;
    const bf16_t* hp = hA + ((unsigned)(((tile * 64 + lane) * 4 + mb) * 64 + r5)) * 8;
    const u32x4 ha = *(const u32x4*)hp, hb = *(const u32x4*)(hp + 32 * 8);
    const unsigned hw[8] = {ha.x, ha.y, ha.z, ha.w, hb.x, hb.y, hb.z, hb.w};
#pragma unroll
    for (int q = 0; q < 8; ++q) { hv[q].x = __uint_as_float(hw[q] << 16); hv[q].y = __uint_as_float(hw[q] & 0xffff0000u); }
}
typedef _Float16 h16x2 __attribute__((ext_vector_type(2)));
DI h16x2 fp4h(unsigned w, int sel) {
    return sel == 0 ? __builtin_amdgcn_cvt_scalef32_pk_f16_fp4(w, 1.0f, 0) : sel == 1 ? __builtin_amdgcn_cvt_scalef32_pk_f16_fp4(w, 1.0f, 1)
         : sel == 2 ? __builtin_amdgcn_cvt_scalef32_pk_f16_fp4(w, 1.0f, 2) : __builtin_amdgcn_cvt_scalef32_pk_f16_fp4(w, 1.0f, 3);
}
DI unsigned rowoff_lo(unsigned pr, unsigned k512, unsigned lane8) { unsigned r; asm("v_mad_u32_u16 %0, %1, %2, %3" : "=v"(r) : "v"(pr), "s"(k512), "v"(lane8)); return r; }
DI unsigned rowoff_hi(unsigned pr, unsigned k512, unsigned lane8) { unsigned r; asm("v_mad_u32_u16 %0, %1, %2, %3 op_sel:[1,0,0,0]" : "=v"(r) : "v"(pr), "s"(k512), "v"(lane8)); return r; }
DI void stage_token(const int* __restrict__ ridx, const float* __restrict__ rgate, char* lds, int t, int tloc, int lane) {
    lane = opaque_v(lane); t = opaque_s(t);
    unsigned short* seid = (unsigned short*)(lds + PL_SEID) + tloc * 128;
    float* swgt = (float*)(lds + PL_SWGT) + tloc * 128;
    seid[lane] = (unsigned short)ridx[(unsigned)(t * 128 + lane)]; seid[64 + lane] = (unsigned short)ridx[(unsigned)(t * 128 + 64 + lane)];
    swgt[lane] = rgate[(unsigned)(t * 128 + lane)]; swgt[64 + lane] = rgate[(unsigned)(t * 128 + 64 + lane)];
}
DI void peer_down_wave(const bf16_t* __restrict__ hA, char* lds, const unsigned char* __restrict__ TBd, const float* __restrict__ SC, int tile, int w, int lane) {
    lane = opaque_v(lane);
    const unsigned lane8 = (unsigned)lane * 8u;
    const int myu = ((lane >> 5) & 1) * 8 + ((lane >> 4) & 1) * 4 + ((lane >> 3) & 1) * 2 + ((lane >> 2) & 1);
    const unsigned short* seid = (const unsigned short*)(lds + PL_SEID) + w * 16 * 128;
    float* swgt = (float*)(lds + PL_SWGT) + w * 16 * 128;
    u32x4 haN, hbN;
    { const bf16_t* hp0 = hA + (unsigned)((tile * 128 + w * 16) * 1024 + lane * 16); haN = *(const u32x4*)hp0; hbN = *(const u32x4*)(hp0 + 8); }
    u32x2 R[2][16];
    f32x2 scv[2];
    u32x4 ID[2];
#define DOWN_IDS(P_) do { ID[0] = *(const u32x4*)(seid + (P_)); ID[1] = *(const u32x4*)(seid + (P_) + 8); } while (0)
#define DOWN_LOADS(buf, P_) do { _Pragma("unroll") for (int u_ = 0; u_ < 16; ++u_) { const unsigned pr_ = ID[u_ >> 3][(u_ >> 1) & 3]; \
        const unsigned off_ = (u_ & 1) ? rowoff_hi(pr_, 512u, lane8) : rowoff_lo(pr_, 512u, lane8); R[buf][u_] = *(const u32x2*)(TBd + off_); } \
        scv[buf] = *(const f32x2*)(SC + (unsigned)seid[(P_) + myu] * 2u); } while (0)
    DOWN_IDS(0); DOWN_LOADS(0, 0); DOWN_IDS(16);
#pragma unroll 1
    for (int tl = 0; tl < 16; ++tl) {
        const int t = tile * 128 + w * 16 + tl;
        float* gp = swgt + tl * 128;
        const u32x4 ha = haN, hb = hbN;
        const int tn = tl < 15 ? tl + 1 : tl;
        { const bf16_t* hp = hA + (unsigned)((t - tl + tn) * 1024 + lane * 16); haN = *(const u32x4*)hp; hbN = *(const u32x4*)(hp + 8); }
        unsigned hhi[2], hlo[2];
        float hscale;
        {
            const unsigned hw[8] = {ha.x, ha.y, ha.z, ha.w, hb.x, hb.y, hb.z, hb.w};
            float hf[16];
            float m = 0.f;
#pragma unroll
            for (int q = 0; q < 8; ++q) { hf[2 * q] = __uint_as_float(hw[q] << 16); hf[2 * q + 1] = __uint_as_float(hw[q] & 0xffff0000u); m = fmaxf(m, fmaxf(fabsf(hf[2 * q]), fabsf(hf[2 * q + 1]))); }
#pragma unroll
            for (int o = 1; o < 64; o <<= 1) m = fmaxf(m, __shfl_xor(m, o));
            hscale = m > 0.f ? m * (1.f / 119.f) : 1.f;
            const float inv = 1.f / hscale;
            hhi[0] = hhi[1] = hlo[0] = hlo[1] = 0u;
#pragma unroll
            for (int e = 0; e < 16; ++e) {
                const int hq = __float2int_rn(hf[e] * inv);
                const int lo = ((hq + 8) & 15) - 8, hi = (hq - lo) >> 4;
                hlo[e >> 3] |= ((unsigned)lo & 15u) << (4 * (e & 7));
                hhi[e >> 3] |= ((unsigned)hi & 15u) << (4 * (e & 7));
            }
        }
#pragma unroll
        for (int bt = 0; bt < 8; ++bt) {
            const int cur = bt & 1, nxt = cur ^ 1;
            const int p1 = bt < 7 ? tl * 128 + (bt + 1) * 16 : tn * 128;
            const int p2 = bt < 6 ? tl * 128 + (bt + 2) * 16 : tn * 128 + (bt - 6) * 16;
            DOWN_LOADS(nxt, p1);
            DOWN_IDS(p2);
            __builtin_amdgcn_sched_barrier(0);
            int part[16];
#pragma unroll
            for (int u = 0; u < 16; ++u) {
                int shi = __builtin_amdgcn_sdot8((int)R[cur][u].x, (int)hhi[0], 0, false);
                shi = __builtin_amdgcn_sdot8((int)R[cur][u].y, (int)hhi[1], shi, false);
                int slo = __builtin_amdgcn_sdot8((int)R[cur][u].x, (int)hlo[0], 0, false);
                slo = __builtin_amdgcn_sdot8((int)R[cur][u].y, (int)hlo[1], slo, false);
                part[u] = shi * 16 + slo;
            }
            int r8[8], r4[4], r2[2], r1;
            {
                const bool b5 = (lane & 32) != 0, b4 = (lane & 16) != 0, b3 = (lane & 8) != 0, b2 = (lane & 4) != 0;
#pragma unroll
                for (int q = 0; q < 8; ++q) { const int keep = b5 ? part[q + 8] : part[q], give = b5 ? part[q] : part[q + 8]; r8[q] = keep + __shfl_xor(give, 32); }
#pragma unroll
                for (int q = 0; q < 4; ++q) { const int keep = b4 ? r8[q + 4] : r8[q], give = b4 ? r8[q] : r8[q + 4]; r4[q] = keep + __shfl_xor(give, 16); }
#pragma unroll
                for (int q = 0; q < 2; ++q) { const int keep = b3 ? r4[q + 2] : r4[q], give = b3 ? r4[q] : r4[q + 2]; r2[q] = keep + __shfl_xor(give, 8); }
                { const int keep = b2 ? r2[1] : r2[0], give = b2 ? r2[0] : r2[1]; r1 = keep + __shfl_xor(give, 4); }
                r1 += __shfl_xor(r1, 2); r1 += __shfl_xor(r1, 1);
            }
            if ((lane & 3) == 0) {
                const float a = (float)r1 * (scv[cur].x * hscale);
                const float wv_ = gp[bt * 16 + myu] * (0.5f * a * (1.f + erff(a * 0.70710678118654752f))) * scv[cur].y;
                ((unsigned*)gp)[bt * 16 + myu] = (unsigned)__builtin_bit_cast(unsigned short, (_Float16)wv_);
            }
        }
    }
#undef DOWN_IDS
#undef DOWN_LOADS
}
DI void peer_up_wave(char* lds, const unsigned char* __restrict__ TBu, const float* __restrict__ g2b, float* __restrict__ x, int tile, int w, int lane,
                     bf16_t* __restrict__ hAn, const float* __restrict__ g1n, const float* __restrict__ sh1n, const float* __restrict__ sc1n) {
    lane = opaque_v(lane);
    const unsigned lane8 = (unsigned)lane * 8u;
    const unsigned short* seid = (const unsigned short*)(lds + PL_SEID) + w * 16 * 128;
    const unsigned* swgt = (const unsigned*)(lds + PL_SWGT) + w * 16 * 128;
    u32x2 RA[16], RB[16];
    u32x4 ID[2], WA[4], WB[4];
#define UP_IDS(P_) do { ID[0] = *(const u32x4*)(seid + (P_)); ID[1] = *(const u32x4*)(seid + (P_) + 8); } while (0)
#define UP_WTS(W, P_) do { _Pragma("unroll") for (int q_ = 0; q_ < 4; ++q_) W[q_] = *(const u32x4*)(swgt + (P_) + 4 * q_); } while (0)
#define UP_LOADS(R) do { _Pragma("unroll") for (int u_ = 0; u_ < 16; ++u_) { const unsigned pr_ = ID[u_ >> 3][(u_ >> 1) & 3]; \
        const unsigned off_ = (u_ & 1) ? rowoff_hi(pr_, 512u, lane8) : rowoff_lo(pr_, 512u, lane8); R[u_] = *(const u32x2*)(TBu + off_); } } while (0)
#define UP_COMPUTE(R, W, K) do { _Pragma("unroll") for (int u_ = 0; u_ < 16; ++u_) { \
        const unsigned wd_ = W[u_ >> 2][u_ & 3]; const h16x2 wp_ = __builtin_bit_cast(h16x2, wd_); const h16x2 w2_ = (h16x2){wp_.x, wp_.x}; \
        _Pragma("unroll") for (int q_ = 0; q_ < 4; ++q_) { acc[K][q_] = __builtin_elementwise_fma(w2_, fp4h(R[u_].x, q_), acc[K][q_]); acc[K][4 + q_] = __builtin_elementwise_fma(w2_, fp4h(R[u_].y, q_), acc[K][4 + q_]); } } } while (0)
    UP_IDS(0); UP_LOADS(RA); UP_IDS(16); UP_WTS(WA, 0);
    float4 gv[4];
#pragma unroll
    for (int q = 0; q < 4; ++q) gv[q] = ((const float4*)(g2b + lane * 16))[q];
    float4 cg[4], ch[4];
#pragma unroll
    for (int q = 0; q < 4; ++q) {
        cg[q] = (float4){0.f, 0.f, 0.f, 0.f}; ch[q] = cg[q];
        if (hAn) { const float4 a = ((const float4*)(g1n + lane * 16))[q], b = ((const float4*)(sc1n + lane * 16))[q]; ch[q] = ((const float4*)(sh1n + lane * 16))[q];
                   cg[q].x = a.x * (1.f + b.x); cg[q].y = a.y * (1.f + b.y); cg[q].z = a.z * (1.f + b.z); cg[q].w = a.w * (1.f + b.w); }
    }
#pragma unroll 1
    for (int tk = 0; tk < 16; ++tk) {
        const int tn = tk < 15 ? tk + 1 : 15;
        float4* xp = (float4*)(x + (size_t)(unsigned)((tile * 128 + w * 16 + tk) * D + lane * 16));
        float4 xv[4];
#pragma unroll
        for (int q = 0; q < 4; ++q) xv[q] = xp[q];
        h16x2 acc[1][8];
#pragma unroll
        for (int q = 0; q < 8; ++q) acc[0][q] = (h16x2){(_Float16)0.f, (_Float16)0.f};
#pragma unroll 1
        for (int i = 0; i < 4; ++i) {
            const int pa = tk * 128 + i * 32;
            const int pn = i < 3 ? pa + 32 : tn * 128;
            UP_LOADS(RB); UP_WTS(WB, pa + 16); UP_IDS(pn);
            __builtin_amdgcn_sched_barrier(0);
            UP_COMPUTE(RA, WA, 0);
            UP_LOADS(RA); UP_WTS(WA, pn); UP_IDS(pn + 16);
            __builtin_amdgcn_sched_barrier(0);
            UP_COMPUTE(RB, WB, 0);
        }
        float ssx = 0.f;
#pragma unroll
        for (int q = 0; q < 4; ++q) {
            xv[q].x += gv[q].x * (float)acc[0][2 * q].x; xv[q].y += gv[q].y * (float)acc[0][2 * q].y; xv[q].z += gv[q].z * (float)acc[0][2 * q + 1].x; xv[q].w += gv[q].w * (float)acc[0][2 * q + 1].y;
            xp[q] = xv[q];
            ssx += xv[q].x * xv[q].x + xv[q].y * xv[q].y + xv[q].z * xv[q].z + xv[q].w * xv[q].w;
        }
        ssx = wave_sum(ssx);
        if (hAn) {
            const float rs = rsqrtf(ssx * (1.f / D) + EPS);
            bf16_t* orow = hAn + (size_t)(unsigned)((tile * 128 + w * 16 + tk) * D + lane * 16);
#pragma unroll
            for (int j = 0; j < 2; ++j) {
                u32x4 o;
                o.x = pk2(xv[2 * j].x * rs * cg[2 * j].x + ch[2 * j].x, xv[2 * j].y * rs * cg[2 * j].y + ch[2 * j].y);
                o.y = pk2(xv[2 * j].z * rs * cg[2 * j].z + ch[2 * j].z, xv[2 * j].w * rs * cg[2 * j].w + ch[2 * j].w);
                o.z = pk2(xv[2 * j + 1].x * rs * cg[2 * j + 1].x + ch[2 * j + 1].x, xv[2 * j + 1].y * rs * cg[2 * j + 1].y + ch[2 * j + 1].y);
                o.w = pk2(xv[2 * j + 1].z * rs * cg[2 * j + 1].z + ch[2 * j + 1].z, xv[2 * j + 1].w * rs * cg[2 * j + 1].w + ch[2 * j + 1].w);
                *(u32x4*)(orow + 8 * j) = o;
            }
        }
    }
#undef UP_IDS
#undef UP_WTS
#undef UP_LOADS
#undef UP_COMPUTE
}

DI void epi_qk(f32x16 (&acc)[4][2], const float* __restrict__ gain, float scale, bf16_t* __restrict__ dst, int lane) {
    lane = opaque_v(lane);
    const int hh = lane >> 5;
    float gv[2][16];
#pragma unroll
    for (int nb = 0; nb < 2; ++nb)
#pragma unroll
        for (int i = 0; i < 16; ++i) gv[nb][i] = gain[nb * 32 + (i & 3) + 8 * (i >> 2) + 4 * hh] * scale;
#pragma unroll
    for (int mb = 0; mb < 4; ++mb) {
        float ss = 0.f;
#pragma unroll
        for (int nb = 0; nb < 2; ++nb)
#pragma unroll
            for (int i = 0; i < 16; ++i) ss += acc[mb][nb][i] * acc[mb][nb][i];
        ss += __shfl_xor(ss, 32);
        const float r = rsqrtf(ss * (1.f / 64.f) + EPS);
#pragma unroll
        for (int nb = 0; nb < 2; ++nb)
#pragma unroll
            for (int s = 0; s < 2; ++s) {
                const f32x16& a = acc[mb][nb];
                u32x4 o;
                o.x = pk2(a[8 * s] * r * gv[nb][8 * s], a[8 * s + 1] * r * gv[nb][8 * s + 1]);
                o.y = pk2(a[8 * s + 2] * r * gv[nb][8 * s + 2], a[8 * s + 3] * r * gv[nb][8 * s + 3]);
                o.z = pk2(a[8 * s + 4] * r * gv[nb][8 * s + 4], a[8 * s + 5] * r * gv[nb][8 * s + 5]);
                o.w = pk2(a[8 * s + 6] * r * gv[nb][8 * s + 6], a[8 * s + 7] * r * gv[nb][8 * s + 7]);
                *(u32x4*)(dst + ((unsigned)(((nb * 2 + s) * 4 + mb) * 64 + lane)) * 8) = o;
            }
    }
}
DI void epi_v(const f32x16 (&acc)[4][2], bf16_t* __restrict__ dst, int lane) {
    lane = opaque_v(lane);
#pragma unroll
    for (int nb = 0; nb < 2; ++nb)
#pragma unroll
        for (int mb = 0; mb < 4; ++mb)
#pragma unroll
            for (int s = 0; s < 2; ++s) {
                const f32x16& a = acc[mb][nb];
                u32x4 o; o.x = pk2(a[8 * s], a[8 * s + 1]); o.y = pk2(a[8 * s + 2], a[8 * s + 3]); o.z = pk2(a[8 * s + 4], a[8 * s + 5]); o.w = pk2(a[8 * s + 6], a[8 * s + 7]);
                *(u32x4*)(dst + ((unsigned)(((nb * 4 + mb) * 2 + s) * 64 + lane)) * 8) = o;
            }
}
DI void epi_row(const f32x16 (&acc)[4][2], bf16_t* __restrict__ dst, int ld, int lane) {
    lane = opaque_v(lane);
    const int r5 = lane & 31, hh = lane >> 5;
#pragma unroll
    for (int mb = 0; mb < 4; ++mb)
#pragma unroll
        for (int nb = 0; nb < 2; ++nb)
#pragma unroll
            for (int gq = 0; gq < 4; ++gq) {
                const f32x16& a = acc[mb][nb];
                u32x2 o; o.x = pk2(a[4 * gq], a[4 * gq + 1]); o.y = pk2(a[4 * gq + 2], a[4 * gq + 3]);
                *(u32x2*)(dst + (unsigned)((mb * 32 + r5) * ld + nb * 32 + 8 * gq + 4 * hh)) = o;
            }
}
DI void epi_z(const f32x16 (&acc)[4][2], bf16_t* __restrict__ dst, int lane) {
    lane = opaque_v(lane);
    const int r5 = lane & 31, hh = lane >> 5;
#pragma unroll
    for (int mb = 0; mb < 4; ++mb)
#pragma unroll
        for (int gq = 0; gq < 4; ++gq) {
            const f32x16 &a = acc[mb][0], &b = acc[mb][1];
            u32x2 o; o.x = pk2(a[4 * gq] * b[4 * gq], a[4 * gq + 1] * b[4 * gq + 1]); o.y = pk2(a[4 * gq + 2] * b[4 * gq + 2], a[4 * gq + 3] * b[4 * gq + 3]);
            *(u32x2*)(dst + (unsigned)((mb * 32 + r5) * 256 + 8 * gq + 4 * hh)) = o;
        }
}
DI void epi_su_park(const f32x16 (&acc)[4][2], unsigned* lds_su, int lane) {
    lane = opaque_v(lane);
#pragma unroll
    for (int mb = 0; mb < 4; ++mb)
#pragma unroll
        for (int nb = 0; nb < 2; ++nb)
#pragma unroll
            for (int q = 0; q < 8; ++q) lds_su[((mb * 2 + nb) * 8 + q) * 64 + lane] = pk2(acc[mb][nb][2 * q], acc[mb][nb][2 * q + 1]);
}
DI void epi_sv(f32x16 (&acc)[4][2], const bf16_t* __restrict__ SWF  , const float* __restrict__ bs_g, const unsigned* lds_su, bf16_t* __restrict__ dst, int lane) {
    lane = opaque_v(lane);
    const int r5 = lane & 31, hh = lane >> 5;
    bf16x8 vb[4][2][2];
#pragma unroll
    for (int mb = 0; mb < 4; ++mb) {
#pragma unroll
        for (int i = 0; i < 16; ++i) {
            float s1 = acc[mb][0][i] + acc[mb][1][i];
#pragma unroll
            for (int o = 1; o < 32; o <<= 1) s1 += __shfl_xor(s1, o);
            const float mu = s1 * (1.f / 64.f);
            const float d0 = acc[mb][0][i] - mu, d1 = acc[mb][1][i] - mu;
            float s2 = d0 * d0 + d1 * d1;
#pragma unroll
            for (int o = 1; o < 32; o <<= 1) s2 += __shfl_xor(s2, o);
            const float r = rsqrtf(s2 * (1.f / 64.f) + EPS);
            acc[mb][0][i] = d0 * r; acc[mb][1][i] = d1 * r;
        }
#pragma unroll
        for (int s = 0; s < 2; ++s)
#pragma unroll
            for (int nb = 0; nb < 2; ++nb) {
                const f32x16& a = acc[mb][nb];
                u32x4 o; o.x = pk2(a[8 * s], a[8 * s + 1]); o.y = pk2(a[8 * s + 2], a[8 * s + 3]); o.z = pk2(a[8 * s + 4], a[8 * s + 5]); o.w = pk2(a[8 * s + 6], a[8 * s + 7]);
                vb[mb][s][nb] = __builtin_bit_cast(bf16x8, o);
            }
    }
#pragma unroll
    for (int tb = 0; tb < 4; ++tb) {
        f32x16 y[2];
#pragma unroll
        for (int nb = 0; nb < 2; ++nb)
#pragma unroll
            for (int i = 0; i < 16; ++i) y[nb][i] = 0.f;
#pragma unroll
        for (int kt = 0; kt <= tb; ++kt)
#pragma unroll
            for (int s = 0; s < 2; ++s) {
                const bf16x8 wa = *(const bf16x8*)(SWF + ((unsigned)(((tb * 4 + kt) * 2 + s) * 64 + lane)) * 8);
                y[0] = MFMA32(wa, vb[kt][s][0], y[0]);
                y[1] = MFMA32(wa, vb[kt][s][1], y[1]);
            }
#pragma unroll
        for (int nb = 0; nb < 2; ++nb)
#pragma unroll
            for (int q = 0; q < 8; ++q) {
                const unsigned su2 = lds_su[((tb * 2 + nb) * 8 + q) * 64 + lane];
                const int i0 = 2 * q, i1 = 2 * q + 1;
                const int t0 = tb * 32 + (i0 & 3) + 8 * (i0 >> 2) + 4 * hh, t1 = tb * 32 + (i1 & 3) + 8 * (i1 >> 2) + 4 * hh;
                const float v0 = (y[nb][i0] + bs_g[t0]) * __uint_as_float(su2 << 16), v1 = (y[nb][i1] + bs_g[t1]) * __uint_as_float(su2 & 0xffff0000u);
                const unsigned pk = pk2(v0, v1);
                dst[(unsigned)(t0 * 256 + nb * 32 + r5)] = (bf16_t)(pk & 0xffffu);
                dst[(unsigned)(t1 * 256 + nb * 32 + r5)] = (bf16_t)(pk >> 16);
            }
    }
}

DI void conv_sguw_item(const float* __restrict__ W, bf16_t* __restrict__ SWF, int gid) {
    const int lane = gid & 63, s = (gid >> 6) & 1, kt = (gid >> 7) & 3, tb = (gid >> 9) & 3, g = gid >> 11;
    const int r = lane & 31, hh = lane >> 5, t = tb * 32 + r;
    const float* p = W + ((size_t)g * 128 + t) * 128;
    float v[8];
#pragma unroll
    for (int j = 0; j < 8; ++j) { const int sp = kt * 32 + 16 * s + 8 * (j >> 2) + 4 * hh + (j & 3); v[j] = sp <= t ? p[sp] : 0.f; }
    u32x4 o; o.x = pk2(v[0], v[1]); o.y = pk2(v[2], v[3]); o.z = pk2(v[4], v[5]); o.w = pk2(v[6], v[7]);
    *(u32x4*)(SWF + (size_t)gid * 8) = o;
}

DI int t5_bucket(int d) {
    if (d < 16) return d;
    const float lr = logf((float)d / 16.f) / logf(8.f);
    const int large = 16 + (int)(lr * 16.f);
    return large < 31 ? large : 31;
}

DI void attn_tile(const bf16_t* __restrict__ QF, const bf16_t* __restrict__ KF2, const bf16_t* __restrict__ VF, char* lds, const float* bias_lds, const float* __restrict__ sink, bf16_t* __restrict__ OR, int tile, int tid) {
    tid = opaque_v(tid); tile = opaque_s(tile);
    const int lane = tid & 63, w = __builtin_amdgcn_readfirstlane(tid >> 6), r5 = lane & 31, hh = lane >> 5;
    const bool has_prev = (tile & 31) != 0;
    {
        u32x4 tmp[16];
#pragma unroll
        for (int i = 0; i < 16; ++i) {
            const int blk = w * 16 + i;
            const int isv = blk >> 6, bb = blk & 63;
            const bf16_t* src;
            if (!isv) { const int kvh = bb >> 5, ks = (bb >> 3) & 3, wt = bb & 7, st = (wt >= 4 || !has_prev) ? tile : tile - 1;
                src = KF2 + ((unsigned)((((st * 2 + kvh) * 4 + ks) * 4 + (wt & 3)) * 64 + lane)) * 8; }
            else { const int kvh = bb >> 5, dt = (bb >> 4) & 1, wt = (bb >> 1) & 7, s2 = bb & 1, st = (wt >= 4 || !has_prev) ? tile : tile - 1;
                src = VF + ((unsigned)(((((st * 2 + kvh) * 2 + dt) * 4 + (wt & 3)) * 2 + s2) * 64 + lane)) * 8; }
            tmp[i] = *(const u32x4*)src;
        }
#pragma unroll
        for (int i = 0; i < 16; ++i) *(u32x4*)(lds + (w * 16 + i) * 1024 + lane * 16) = tmp[i];
    }
    __syncthreads();
    const char* ldsK = lds, *ldsV = lds + 65536;
    for (int task = w; task < 32; task += 8) {
        const int qh = task >> 2, qt = task & 3, kvh = qh >> 2;
        bf16x8 bq[4];
#pragma unroll
        for (int ks = 0; ks < 4; ++ks) bq[ks] = *(const bf16x8*)(QF + ((unsigned)((((tile * 8 + qh) * 4 + ks) * 4 + qt) * 64 + lane)) * 8);
        f32x16 sc[5];
#pragma unroll
        for (int jj = 0; jj < 5; ++jj) {
#pragma unroll
            for (int i = 0; i < 16; ++i) sc[jj][i] = 0.f;
#pragma unroll
            for (int ks = 0; ks < 4; ++ks) {
                const bf16x8 kf = *(const bf16x8*)(ldsK + ((kvh * 4 + ks) * 8 + qt + jj) * 1024 + lane * 16);
                sc[jj] = MFMA32(kf, bq[ks], sc[jj]);
            }
        }
        const float* bl = bias_lds + qh * 128;
        float m = -1e30f;
#pragma unroll
        for (int jj = 0; jj < 5; ++jj) {
            const bool ex = (qt + jj >= 4) || has_prev;
#pragma unroll
            for (int i = 0; i < 16; ++i) {
                const int cr = (i & 3) + 8 * (i >> 2) + 4 * hh;
                const int dist = 128 + r5 - 32 * jj - cr;
                const bool valid = ex && dist >= 0 && dist < 128;
                float bv = bl[dist & 127];
                asm volatile("" : "+v"(bv));
                const float v = valid ? sc[jj][i] + bv : -1e30f;
                sc[jj][i] = v; m = fmaxf(m, v);
            }
        }
        m = fmaxf(m, __shfl_xor(m, 32));
        const float sk = sink[qh];
        m = fmaxf(m, sk);
        float l = 0.f;
#pragma unroll
        for (int jj = 0; jj < 5; ++jj)
#pragma unroll
            for (int i = 0; i < 16; ++i) { const float p = __expf(sc[jj][i] - m); sc[jj][i] = p; l += p; }
        l += __shfl_xor(l, 32);
        l += __expf(sk - m);
        const float rl = 1.f / l;
        f32x16 o[2];
#pragma unroll
        for (int dt = 0; dt < 2; ++dt)
#pragma unroll
            for (int i = 0; i < 16; ++i) o[dt][i] = 0.f;
#pragma unroll
        for (int jj = 0; jj < 5; ++jj) {
#pragma unroll
            for (int s = 0; s < 2; ++s) {
                const f32x16& a = sc[jj];
                u32x4 pp; pp.x = pk2(a[8 * s], a[8 * s + 1]); pp.y = pk2(a[8 * s + 2], a[8 * s + 3]); pp.z = pk2(a[8 * s + 4], a[8 * s + 5]); pp.w = pk2(a[8 * s + 6], a[8 * s + 7]);
                const bf16x8 pb = __builtin_bit_cast(bf16x8, pp);
#pragma unroll
                for (int dt = 0; dt < 2; ++dt) {
                    const bf16x8 vf = *(const bf16x8*)(ldsV + (((kvh * 2 + dt) * 8 + qt + jj) * 2 + s) * 1024 + lane * 16);
                    o[dt] = MFMA32(vf, pb, o[dt]);
                }
            }
        }
        bf16_t* orow = OR + (unsigned)((tile * 128 + qt * 32 + r5) * 512 + qh * 64 + 4 * hh);
#pragma unroll
        for (int dt = 0; dt < 2; ++dt)
#pragma unroll
            for (int gq = 0; gq < 4; ++gq) {
                u32x2 ov; ov.x = pk2(o[dt][4 * gq] * rl, o[dt][4 * gq + 1] * rl); ov.y = pk2(o[dt][4 * gq + 2] * rl, o[dt][4 * gq + 3] * rl);
                *(u32x2*)(orow + dt * 32 + 8 * gq) = ov;
            }
    }
}

DI void unpack8(const u32x4 v, float (&f)[8]) {
    f[0] = __uint_as_float(v.x << 16); f[1] = __uint_as_float(v.x & 0xffff0000u); f[2] = __uint_as_float(v.y << 16); f[3] = __uint_as_float(v.y & 0xffff0000u);
    f[4] = __uint_as_float(v.z << 16); f[5] = __uint_as_float(v.z & 0xffff0000u); f[6] = __uint_as_float(v.w << 16); f[7] = __uint_as_float(v.w & 0xffff0000u);
}
DI void merge_tile(const bf16_t* __restrict__ OR, const bf16_t* __restrict__ CBR, const bf16_t* __restrict__ ZR, const bf16_t* __restrict__ YS, const float* __restrict__ cw  , const float* __restrict__ og  ,
                   bf16_t* __restrict__ mA, int tile, int tid) {
    tid = opaque_v(tid); tile = opaque_s(tile);
    const int lane = tid & 63, w = tid >> 6;
    float cwv[3][8], ga[8], gb[8];
    {
        const int c0 = (lane & 31) * 8;
#pragma unroll
        for (int j = 0; j < 3; ++j) { const float4 p0 = *(const float4*)(cw + j * 256 + c0), p1 = *(const float4*)(cw + j * 256 + c0 + 4);
            cwv[j][0] = p0.x; cwv[j][1] = p0.y; cwv[j][2] = p0.z; cwv[j][3] = p0.w; cwv[j][4] = p1.x; cwv[j][5] = p1.y; cwv[j][6] = p1.z; cwv[j][7] = p1.w; }
        const float4 a0 = *(const float4*)(og + lane * 8), a1 = *(const float4*)(og + lane * 8 + 4), b0 = *(const float4*)(og + 512 + lane * 8), b1 = *(const float4*)(og + 512 + lane * 8 + 4);
        ga[0] = a0.x; ga[1] = a0.y; ga[2] = a0.z; ga[3] = a0.w; ga[4] = a1.x; ga[5] = a1.y; ga[6] = a1.z; ga[7] = a1.w;
        gb[0] = b0.x; gb[1] = b0.y; gb[2] = b0.z; gb[3] = b0.w; gb[4] = b1.x; gb[5] = b1.y; gb[6] = b1.z; gb[7] = b1.w;
    }
#pragma unroll 8
    for (int rr = 0; rr < 16; ++rr) {
        const int row = w * 16 + rr, t = tile * 128 + row, pos = t & (S - 1);
        float a[8], y[8];
        unpack8(*(const u32x4*)(OR + (unsigned)(t * 512 + lane * 8)), a);
        float ssa = 0.f;
#pragma unroll
        for (int q = 0; q < 8; ++q) ssa += a[q] * a[q];
        ssa = wave_sum(ssa);
        {
            const int c0 = (lane & 31) * 8;
            float cb[8], z0[8], z1[8], z2[8], ys[8];
            const float m1 = pos >= 1 ? 1.f : 0.f, m2 = pos >= 2 ? 1.f : 0.f;
            const int t1 = pos >= 1 ? t - 1 : t, t2 = pos >= 2 ? t - 2 : t;
            unpack8(*(const u32x4*)(CBR + (unsigned)(t * 256 + c0)), cb);
            unpack8(*(const u32x4*)(ZR + (unsigned)(t * 256 + c0)), z2);
            unpack8(*(const u32x4*)(ZR + (unsigned)(t1 * 256 + c0)), z1);
            unpack8(*(const u32x4*)(ZR + (unsigned)(t2 * 256 + c0)), z0);
            unpack8(*(const u32x4*)(YS + (unsigned)(t * 256 + c0)), ys);
#pragma unroll
            for (int q = 0; q < 8; ++q) {
                const float yc = cb[q] * (cwv[0][q] * (z0[q] * m2) + cwv[1][q] * (z1[q] * m1) + cwv[2][q] * z2[q]);
                y[q] = lane < 32 ? yc : ys[q];
            }
        }
        float ssy = 0.f;
#pragma unroll
        for (int q = 0; q < 8; ++q) ssy += y[q] * y[q];
#pragma unroll
        for (int o = 1; o < 32; o <<= 1) ssy += __shfl_xor(ssy, o);
        const float ra = rsqrtf(ssa * (1.f / 512.f) + EPS), ry = rsqrtf(ssy * (1.f / 256.f) + EPS);
        const int mb = row >> 5, r5 = row & 31;
        {
            u32x4 o; o.x = pk2(a[0] * ra * ga[0], a[1] * ra * ga[1]); o.y = pk2(a[2] * ra * ga[2], a[3] * ra * ga[3]); o.z = pk2(a[4] * ra * ga[4], a[5] * ra * ga[5]); o.w = pk2(a[6] * ra * ga[6], a[7] * ra * ga[7]);
            const int c8 = lane;
            (void)c8;
            *(u32x4*)(mA + (unsigned)(t * 1024 + lane * 8)) = o;
        }
        {
            u32x4 o; o.x = pk2(y[0] * ry * gb[0], y[1] * ry * gb[1]); o.y = pk2(y[2] * ry * gb[2], y[3] * ry * gb[3]); o.z = pk2(y[4] * ry * gb[4], y[5] * ry * gb[5]); o.w = pk2(y[6] * ry * gb[6], y[7] * ry * gb[7]);
            const int c8 = 64 + lane;
            (void)c8;
            *(u32x4*)(mA + (unsigned)(t * 1024 + 512 + lane * 8)) = o;
        }
    }
}

struct InProjOut { bf16_t *QF, *KF2, *VF, *CBR, *ZR, *YS; };
DI void inproj_tile(const bf16_t* __restrict__ At, const bf16_t* __restrict__ WF, const float* __restrict__ qg, const float* __restrict__ kg, const bf16_t* __restrict__ SWF, const float* __restrict__ sgu_b,
                    const InProjOut& O, char* lds, int tile, int tid) {
    tid = opaque_v(tid); tile = opaque_s(tile);
    const int lane = tid & 63, w = __builtin_amdgcn_readfirstlane(tid >> 6);
    f32x16 acc[4][2];
    {
        const int nbt0 = w * 2;
        kloop<1>(acc, At, WF + (size_t)nbt0 * 32768, WF + (size_t)(nbt0 + 1) * 32768, lds, tid, lane);
        epi_qk(acc, qg, 0.125f, O.QF + (size_t)(tile * 8 + w) * 8192, lane);
    }
    {
        const int nbt0 = 16 + w * 2;
        if (w == 2 || w == 3) {
            kloop<0>(acc, At, WF + (size_t)nbt0 * 32768, WF + (size_t)(nbt0 + 1) * 32768, lds, tid, lane);
            epi_v(acc, O.VF + (size_t)(tile * 2 + (w - 2)) * 8192, lane);
        } else {
            kloop<1>(acc, At, WF + (size_t)nbt0 * 32768, WF + (size_t)(nbt0 + 1) * 32768, lds, tid, lane);
            if (w < 2) epi_qk(acc, kg, 1.f, O.KF2 + (size_t)(tile * 2 + w) * 8192, lane);
            else epi_row(acc, O.CBR + (size_t)tile * 128 * 256 + (w - 4) * 64, 256, lane);
        }
    }
    {
        const int nbt0 = 32 + w * 2;
        kloop<1>(acc, At, WF + (size_t)nbt0 * 32768, WF + (size_t)(nbt0 + 1) * 32768, lds, tid, lane);
        epi_z(acc, O.ZR + (size_t)tile * 128 * 256 + w * 32, lane);
    }
    {
        const int nbt0 = 48 + w * 2;
        kloop<0>(acc, At, WF + (size_t)nbt0 * 32768, WF + (size_t)(nbt0 + 1) * 32768, lds, tid, lane);
        unsigned* lds_su = (unsigned*)lds;
        if (w < 4) epi_su_park(acc, lds_su + w * 4096, lane);
        __syncthreads();
        if (w >= 4) epi_sv(acc, SWF + (size_t)(w - 4) * 16384, sgu_b + (w - 4) * 128, lds_su + (w - 4) * 4096, O.YS + (size_t)tile * 128 * 256 + (w - 4) * 64, lane);
        __syncthreads();
    }
}


struct Params {
    const float *x, *c, *rel_bias, *w_ada, *b_ada, *norm1_g, *norm2_g, *w_in, *q_norm_g, *k_norm_g, *attn_sink, *conv_w, *sgu_w, *sgu_b, *out_norm_g, *w_out, *peer_wq, *peer_sub_keys, *peer_down, *peer_up;
    float* out;
    char* ws;
};
constexpr size_t MiB = 1u << 20;
constexpr size_t WS_MOD = 0;
constexpr size_t WS_MODP = 1 * MiB;
constexpr size_t WS_WIN = 13 * MiB;
constexpr size_t WS_WOUT = 29 * MiB;
constexpr size_t WS_WPQ = 37 * MiB;
constexpr size_t WS_KEYS = 53 * MiB;
constexpr size_t WS_SWF = 55 * MiB;
constexpr size_t WS_SC = 56 * MiB;
constexpr size_t WS_TB = 57 * MiB;
constexpr size_t WS_HA = 185 * MiB;
constexpr size_t WS_QF = 249 * MiB;
constexpr size_t WS_KF2 = 602 * MiB;
constexpr size_t WS_VF = 634 * MiB;
constexpr size_t WS_ZR = 666 * MiB;
constexpr size_t WS_CBR = 345 * MiB;
constexpr size_t WS_YS = 361 * MiB;
constexpr size_t WS_OR = 377 * MiB;
constexpr size_t WS_QPF = 409 * MiB;
constexpr size_t WS_RIDX = 537 * MiB;
constexpr size_t WS_RGATE = 553 * MiB;
constexpr size_t WS_SEID = 569 * MiB;
constexpr size_t WS_SWGT = 585 * MiB;
constexpr size_t WS_OFFS = 601 * MiB;
constexpr size_t WS_FLAGS = 601 * MiB + 512 * 1024;
constexpr size_t WS_END = 730 * MiB;
static_assert(PL_END <= LDS_RSTD1, "expert-phase lists overlap persistent LDS state");

__global__ __launch_bounds__(512) void hybrid_fwd(Params P) {
    extern __shared__ __attribute__((aligned(16))) char lds[];
    cg::grid_group grid = cg::this_grid();
    const int tid = threadIdx.x, lane = tid & 63, w = __builtin_amdgcn_readfirstlane(tid >> 6);
    const int nblk = gridDim.x, hwb = blockIdx.x;
    const int bid = (nblk == NTILE) ? (hwb & 7) * 32 + (hwb >> 3) : hwb;
    char* ws = P.ws;
    float* mod = (float*)(ws + WS_MOD);
    float* modp = (float*)(ws + WS_MODP);
    bf16_t* WinF = (bf16_t*)(ws + WS_WIN); bf16_t* WoutF = (bf16_t*)(ws + WS_WOUT); bf16_t* WpqF = (bf16_t*)(ws + WS_WPQ);
    bf16_t* KeysF = (bf16_t*)(ws + WS_KEYS); bf16_t* SWF = (bf16_t*)(ws + WS_SWF);
    float* SC = (float*)(ws + WS_SC); unsigned char* TBd = (unsigned char*)(ws + WS_TB); unsigned char* TBu = TBd + 32 * MiB;
    bf16_t* hA = (bf16_t*)(ws + WS_HA);
    bf16_t* OR = (bf16_t*)(ws + WS_OR); bf16_t* QPF = (bf16_t*)(ws + WS_QPF);
    int* ridx = (int*)(ws + WS_RIDX); float* rgate = (float*)(ws + WS_RGATE);
    float* bias_lds = (float*)(lds + LDS_BIAS);
    unsigned* flags = (unsigned*)(ws + WS_FLAGS);

    {
        float* ca = (float*)lds;
        if (tid == 0) for (int tile = bid; tile < NTILE; tile += nblk) __hip_atomic_store(flags + tile, 0u, __ATOMIC_RELAXED, __HIP_MEMORY_SCOPE_AGENT);
        for (int i = tid; i < 8192; i += 512) { const float v = P.c[i]; ca[i] = v / (1.f + __expf(-v)); }
        for (int i = tid; i < 1024; i += 512) bias_lds[i] = P.rel_bias[t5_bucket(i & 127) * 8 + (i >> 7)];
        __syncthreads();
        for (int it = bid; it < 768; it += nblk) {
            const int jc = it % 12, l = (it / 12) & 3, ks = it / 48;
            const int j = jc * 512 + tid;
            const float* wp = P.w_ada + ((size_t)l * 1024 + ks * 64) * 6144 + j;
            float acc[8];
#pragma unroll
            for (int b = 0; b < 8; ++b) acc[b] = 0.f;
#pragma unroll 4
            for (int i = 0; i < 64; ++i) {
                const float wv = wp[(size_t)i * 6144];
#pragma unroll
                for (int b = 0; b < 8; ++b) acc[b] += ca[b * 1024 + ks * 64 + i] * wv;
            }
#pragma unroll
            for (int b = 0; b < 8; ++b) modp[((size_t)(ks * 4 + l) * 8 + b) * 6144 + j] = acc[b];
        }
        const int gthreads = nblk * 512, gtid = bid * 512 + tid;
        for (int rep = 0; rep < REP_P0; ++rep)
        for (int l = 0; l < DEPTH; ++l) {
            for (int g = gtid; g < 64 * 64 * 64; g += gthreads) conv_wfrag_item(P.w_in + (size_t)l * 1024 * 2048, 2048, 64, WinF + (size_t)l * 2097152, g, 1);
            for (int g = gtid; g < 32 * 64 * 64; g += gthreads) conv_wfrag_item(P.w_out + (size_t)l * 1024 * 1024, 1024, 64, WoutF + (size_t)l * 1048576, g, 0);
            for (int g = gtid; g < 64 * 64 * 64; g += gthreads) conv_wfrag_item(P.peer_wq + (size_t)l * 1024 * 2048, 2048, 64, WpqF + (size_t)l * 2097152, g, 0);
            for (int g = gtid; g < 32768; g += gthreads) conv_keys_item(P.peer_sub_keys + (size_t)l * 262144, KeysF + (size_t)l * 262144, g);
            for (int g = gtid; g < 8192; g += gthreads) conv_sguw_item(P.sgu_w + (size_t)l * 65536, SWF + (size_t)l * 65536, g);
        }
        const int gwaves = nblk * 8, gw = bid * 8 + w;
        for (int rep = 0; rep < REP_P0; ++rep)
        for (int r = gw; r < DEPTH * 16384 * 2; r += gwaves) {
            const int which = r & 1, le = r >> 1;
            conv_table_row((which ? P.peer_up : P.peer_down) + (size_t)le * D, (which ? TBu : TBd) + (size_t)le * 512, SC + (size_t)le * 2 + which, lane, which == 0);
        }
    }
    grid.sync();
    for (int tile = bid; tile < NTILE; tile += nblk) {
        const int b = tile >> 5;
        for (int l = 0; l < DEPTH; ++l)
            for (int j = tid; j < 6144; j += 512) {
                float v = P.b_ada[l * 6144 + j];
#pragma unroll
                for (int ks = 0; ks < 16; ++ks) v += modp[((size_t)(ks * 4 + l) * 8 + b) * 6144 + j];
                mod[((size_t)l * 8 + b) * 6144 + j] = v;
            }
    }
    __syncthreads();

    for (int l = 0; l < DEPTH; ++l) {
        const float* xin = l == 0 ? P.x : P.out;
        InProjOut IO;
        IO.QF = (bf16_t*)(ws + WS_QF); IO.KF2 = (bf16_t*)(ws + WS_KF2 + (size_t)l * 8 * MiB); IO.VF = (bf16_t*)(ws + WS_VF + (size_t)l * 8 * MiB);
        IO.CBR = (bf16_t*)(ws + WS_CBR); IO.ZR = (bf16_t*)(ws + WS_ZR + (size_t)l * 16 * MiB); IO.YS = (bf16_t*)(ws + WS_YS);
        for (int tile = bid; tile < NTILE; tile += nblk) {
            const float* mb_ = mod + ((size_t)l * 8 + (tile >> 5)) * 6144;
            if (l == 0) {
                norm_to_frag(xin, P.norm1_g + l * D, mb_ + 0, mb_ + 1024, hA, (float*)lds, tile, tid, false);
                __syncthreads();
            }
            for (int rep = 0; rep < REP_GEMM; ++rep) inproj_tile(hA + (size_t)tile * 131072, WinF + (size_t)l * 2097152, P.q_norm_g + l * 64, P.k_norm_g + l * 64, SWF + (size_t)l * 65536, P.sgu_b + l * 512, IO, lds, tile, tid);
            asm volatile("s_waitcnt vmcnt(0)" ::: "memory");
            __syncthreads();
            if (tid == 0) {
                __builtin_amdgcn_fence(__ATOMIC_RELEASE, "agent");
                asm volatile("s_waitcnt vmcnt(0)" ::: "memory");
                __hip_atomic_store(flags + tile, (unsigned)(l + 1), __ATOMIC_RELAXED, __HIP_MEMORY_SCOPE_AGENT);
            }
        }
        for (int tile = bid; tile < NTILE; tile += nblk) {
            const float* mb_ = mod + ((size_t)l * 8 + (tile >> 5)) * 6144;
            if ((tile & 31) != 0) {
                if (tid == 0) {
                    unsigned spins = 0;
                    while (__hip_atomic_load(flags + tile - 1, __ATOMIC_RELAXED, __HIP_MEMORY_SCOPE_AGENT) < (unsigned)(l + 1) && ++spins < (1u << 24)) __builtin_amdgcn_s_sleep(2);
                    __builtin_amdgcn_fence(__ATOMIC_ACQUIRE, "agent");
                    asm volatile("s_waitcnt vmcnt(0)" ::: "memory");
                }
                __syncthreads();
            }
            for (int rep = 0; rep < REP_MIX; ++rep) {
            attn_tile(IO.QF, IO.KF2, IO.VF, lds, bias_lds, P.attn_sink + l * 8, OR, tile, tid);
            __syncthreads();
            merge_tile(OR, IO.CBR, IO.ZR, IO.YS, P.conv_w + l * 768, P.out_norm_g + l * D, hA, tile, tid);
            __syncthreads();
            }
            {
                const bf16_t* At = hA + (size_t)tile * 131072;
                const bf16_t* WF = WoutF + (size_t)l * 1048576;
                for (int pass = 0; pass < 2; ++pass) {
                    f32x16 acc[4][2];
                    const int nbt0 = pass * 16 + w * 2;
                    kloop<0>(acc, At, WF + (size_t)nbt0 * 32768, WF + (size_t)(nbt0 + 1) * 32768, lds, tid, lane);
                    epi_resid(acc, xin, P.out, mb_ + 2048, (float*)(lds + LDS_EPI) + w * 2176, (float*)(lds + LDS_SSQ) + (pass * 8 + w) * 128, tile, pass * 512 + w * 64, lane);
                }
            }
            __syncthreads();
            if (tid < 128) { const float* sq = (const float*)(lds + LDS_SSQ); float ssum = 0.f;
#pragma unroll
                for (int c = 0; c < 16; ++c) ssum += sq[c * 128 + tid];
                ((float*)lds)[tid] = rsqrtf(ssum * (1.f / D) + EPS); }
            __syncthreads();
            norm_to_frag(P.out, P.norm2_g + l * D, mb_ + 3072, mb_ + 4096, hA, (float*)lds, tile, tid, true);
            __syncthreads();
            {
                const bf16_t* At = hA + (size_t)tile * 131072;
                const bf16_t* WF = WpqF + (size_t)l * 2097152;
                for (int rep = 0; rep < REP_GEMM; ++rep)
                for (int pass = 0; pass < 4; ++pass) {
                    f32x16 acc[4][2];
                    const int nbt0 = pass * 16 + w * 2;
                    kloop<1>(acc, At, WF + (size_t)nbt0 * 32768, WF + (size_t)(nbt0 + 1) * 32768, lds, tid, lane);
                    epi_qpf(acc, QPF, tile, nbt0, lane);
                }
            }
            __syncthreads();
            for (int rep = 0; rep < REP_ROUTE; ++rep) { route_tile(QPF, KeysF + (size_t)l * 262144, lds, (unsigned char*)lds + PL_RIDX, tile, tid); __syncthreads(); }
            peer_down_wave(hA, lds, TBd + (size_t)l * 16384 * 512, SC + (size_t)l * 32768, tile, w, lane);
            __syncthreads();
            {
                const float* mbn = mod + ((size_t)(l + 1 < DEPTH ? l + 1 : l) * 8 + (tile >> 5)) * 6144;
                peer_up_wave(lds, TBu + (size_t)l * 16384 * 512, mb_ + 5120, P.out, tile, w, lane, l + 1 < DEPTH ? hA : nullptr, P.norm1_g + (l + 1 < DEPTH ? l + 1 : l) * D, mbn + 0, mbn + 1024);
            }
            __syncthreads();
        }
    }
}
}

extern "C" void kernel_launch(void* const* d_in, const int* in_sizes, int n_in, void* d_out, int out_size, void* d_ws, size_t ws_size, hipStream_t stream) {
    using namespace op;
    static int grid_blocks = 0;
    if (!grid_blocks) {
        int dev = 0, cus = 0, per_cu = 0;
        (void)hipGetDevice(&dev);
        (void)hipDeviceGetAttribute(&cus, hipDeviceAttributeMultiprocessorCount, dev);
        (void)hipFuncSetAttribute((const void*)hybrid_fwd, hipFuncAttributeMaxDynamicSharedMemorySize, LDS_BYTES);
        (void)hipOccupancyMaxActiveBlocksPerMultiprocessor(&per_cu, (const void*)hybrid_fwd, 512, LDS_BYTES);
        if (per_cu < 1) per_cu = 1;
        grid_blocks = cus * per_cu;
        if (grid_blocks > NTILE) grid_blocks = NTILE;
        if (ws_size < WS_END) { fprintf(stderr, "kernel_launch: workspace too small (%zu < %zu)\n", ws_size, (size_t)WS_END); grid_blocks = -1; }
    }
    if (grid_blocks < 0) return;
    Params p{};
    p.x = (const float*)d_in[0]; p.c = (const float*)d_in[1]; p.rel_bias = (const float*)d_in[2]; p.w_ada = (const float*)d_in[3]; p.b_ada = (const float*)d_in[4];
    p.norm1_g = (const float*)d_in[5]; p.norm2_g = (const float*)d_in[6]; p.w_in = (const float*)d_in[7]; p.q_norm_g = (const float*)d_in[8]; p.k_norm_g = (const float*)d_in[9];
    p.attn_sink = (const float*)d_in[10]; p.conv_w = (const float*)d_in[11]; p.sgu_w = (const float*)d_in[12]; p.sgu_b = (const float*)d_in[13]; p.out_norm_g = (const float*)d_in[14];
    p.w_out = (const float*)d_in[15]; p.peer_wq = (const float*)d_in[16]; p.peer_sub_keys = (const float*)d_in[17]; p.peer_down = (const float*)d_in[18]; p.peer_up = (const float*)d_in[19];
    p.out = (float*)d_out; p.ws = (char*)d_ws;
    void* args[] = {&p};
    hipError_t e = hipLaunchCooperativeKernel((const void*)hybrid_fwd, dim3(grid_blocks), dim3(512), args, LDS_BYTES, stream);
    if (e != hipSuccess) fprintf(stderr, "kernel_launch: cooperative launch failed: %s (grid %d)\n", hipGetErrorString(e), grid_blocks);
}
```

```cpp
#include <hip/hip_runtime.h>
#include <cstdio>
#include <cstdint>
#include <hip/hip_cooperative_groups.h>
namespace cg = cooperative_groups;


namespace op {
#define DI __device__ __forceinline__
typedef unsigned short bf16_t;
typedef short bf16x8 __attribute__((ext_vector_type(8)));
typedef float f32x16 __attribute__((ext_vector_type(16)));
typedef float f32x2 __attribute__((ext_vector_type(2)));
typedef unsigned u32x4 __attribute__((ext_vector_type(4)));
typedef unsigned u32x2 __attribute__((ext_vector_type(2)));
typedef __bf16 bf16v2 __attribute__((ext_vector_type(2)));
constexpr int D = 1024, NB = 8, S = 4096, DEPTH = 4, T = NB * S, NTILE = T / 128;
constexpr float EPS = 1e-6f;
constexpr int PL_SEID = 0, PL_SWGT = 32768, PL_END = 98304, PL_RIDX = 98304;
constexpr int LDS_EPI = 32768, LDS_SSQ = 102400, LDS_RSTD1 = 110592, LDS_BIAS = 128 * 1024, LDS_BYTES = 132 * 1024;
constexpr int REP_GEMM = 1, REP_ROUTE = 1, REP_MIX = 1, REP_NORM = 1, REP_P0 = 1;
#define MFMA32(a, b, c) __builtin_amdgcn_mfma_f32_32x32x16_bf16((a), (b), (c), 0, 0, 0)

DI unsigned pk2(float lo, float hi) { f32x2 v = {lo, hi}; return __builtin_bit_cast(unsigned, __builtin_convertvector(v, bf16v2)); }
DI int opaque_v(int x) { asm volatile("" : "+v"(x)); return x; }
DI int opaque_s(int x) { asm volatile("" : "+s"(x)); return x; }
DI int crow(int reg, int hh) { return (reg & 3) + 8 * (reg >> 2) + 4 * hh; }
template <int CTRL> DI float dppf(float v) { return __int_as_float(__builtin_amdgcn_update_dpp(0, __float_as_int(v), CTRL, 0xf, 0xf, true)); }
template <int CTRL> DI int dppi(int v) { return __builtin_amdgcn_update_dpp(0, v, CTRL, 0xf, 0xf, true); }
DI float red16_sum(float v) { v += dppf<0xB1>(v); v += dppf<0x4E>(v); v += dppf<0x141>(v); v += dppf<0x140>(v); return v; }
DI float red16_max(float v) { v = fmaxf(v, dppf<0xB1>(v)); v = fmaxf(v, dppf<0x4E>(v)); v = fmaxf(v, dppf<0x141>(v)); v = fmaxf(v, dppf<0x140>(v)); return v; }
DI float x16_sum(float v) { auto s = __builtin_amdgcn_permlane16_swap(__float_as_uint(v), __float_as_uint(v), false, false); return __uint_as_float(s[0]) + __uint_as_float(s[1]); }
DI float x32_sum(float v) { auto s = __builtin_amdgcn_permlane32_swap(__float_as_uint(v), __float_as_uint(v), false, false); return __uint_as_float(s[0]) + __uint_as_float(s[1]); }
DI float x16_max(float v) { auto s = __builtin_amdgcn_permlane16_swap(__float_as_uint(v), __float_as_uint(v), false, false); return fmaxf(__uint_as_float(s[0]), __uint_as_float(s[1])); }
DI float x32_max(float v) { auto s = __builtin_amdgcn_permlane32_swap(__float_as_uint(v), __float_as_uint(v), false, false); return fmaxf(__uint_as_float(s[0]), __uint_as_float(s[1])); }
DI float red32_sum(float v) { return x16_sum(red16_sum(v)); }
DI float wave_sum(float v) { return x32_sum(x16_sum(red16_sum(v))); }
DI float wave_max(float v) { return x32_max(x16_max(red16_max(v))); }

DI int col_perm(int npos, int mode) {
    if (mode == 1 && npos >= 1024 && npos < 1536) { const int q = npos - 1024, w = q >> 6, nb = (q >> 5) & 1, r = q & 31; return (nb ? 1280 : 1024) + 32 * w + r; }
    return npos;
}
DI void conv_wfrag_item(const float* __restrict__ W, int N, int KB, bf16_t* __restrict__ WF, int gid, int mode) {
    const int l = gid & 63, kb = (gid >> 6) % KB, nbt = (gid >> 6) / KB, r = l & 31, hh = l >> 5;
    const int n = col_perm(nbt * 32 + r, mode);
    const float* p = W + (size_t)(kb * 16 + 8 * hh) * N + n;
    float v[8];
#pragma unroll
    for (int j = 0; j < 8; ++j) v[j] = p[(size_t)j * N];
    u32x4 o; o.x = pk2(v[0], v[1]); o.y = pk2(v[2], v[3]); o.z = pk2(v[4], v[5]); o.w = pk2(v[6], v[7]);
    *(u32x4*)(WF + (size_t)gid * 8) = o;
}

DI void norm_to_frag(const float* __restrict__ x, const float* __restrict__ g, const float* __restrict__ sh, const float* __restrict__ sc, bf16_t* __restrict__ hA, float* rstd_lds, int tile, int tid, bool have_rstd) {
    tid = opaque_v(tid); tile = opaque_s(tile);
    const int w = tid >> 6, lane = tid & 63;
    float cg[16], cs[16], ch[16];
#pragma unroll
    for (int j = 0; j < 2; ++j)
#pragma unroll
        for (int q = 0; q < 2; ++q) {
            const int c = 512 * j + 8 * lane + 4 * q;
            const float4 a = *(const float4*)(g + c), b = *(const float4*)(sc + c), d = *(const float4*)(sh + c);
            cg[8 * j + 4 * q] = a.x * (1.f + b.x); cg[8 * j + 4 * q + 1] = a.y * (1.f + b.y); cg[8 * j + 4 * q + 2] = a.z * (1.f + b.z); cg[8 * j + 4 * q + 3] = a.w * (1.f + b.w);
            ch[8 * j + 4 * q] = d.x; ch[8 * j + 4 * q + 1] = d.y; ch[8 * j + 4 * q + 2] = d.z; ch[8 * j + 4 * q + 3] = d.w;
            cs[8 * j + 4 * q] = 0.f; cs[8 * j + 4 * q + 1] = 0.f; cs[8 * j + 4 * q + 2] = 0.f; cs[8 * j + 4 * q + 3] = 0.f;
        }
    (void)cs;
#pragma unroll 8
    for (int rr = 0; rr < 16; ++rr) {
        const int row = w * 16 + rr;
        const float* xr = x + ((size_t)tile * 128 + row) * D + 8 * lane;
        float v[16];
#pragma unroll
        for (int j = 0; j < 2; ++j)
#pragma unroll
            for (int q = 0; q < 2; ++q) { const float4 a = *(const float4*)(xr + 512 * j + 4 * q); v[8 * j + 4 * q] = a.x; v[8 * j + 4 * q + 1] = a.y; v[8 * j + 4 * q + 2] = a.z; v[8 * j + 4 * q + 3] = a.w; }
        float r;
        if (have_rstd) r = rstd_lds[row];
        else {
            float ss = 0.f;
#pragma unroll
            for (int e = 0; e < 16; ++e) ss += v[e] * v[e];
            r = rsqrtf(wave_sum(ss) * (1.f / D) + EPS);
        }
        bf16_t* orow = hA + ((size_t)tile * 128 + row) * D + 8 * lane;
#pragma unroll
        for (int j = 0; j < 2; ++j) {
            u32x4 o;
            o.x = pk2(v[8 * j] * r * cg[8 * j] + ch[8 * j], v[8 * j + 1] * r * cg[8 * j + 1] + ch[8 * j + 1]);
            o.y = pk2(v[8 * j + 2] * r * cg[8 * j + 2] + ch[8 * j + 2], v[8 * j + 3] * r * cg[8 * j + 3] + ch[8 * j + 3]);
            o.z = pk2(v[8 * j + 4] * r * cg[8 * j + 4] + ch[8 * j + 4], v[8 * j + 5] * r * cg[8 * j + 5] + ch[8 * j + 5]);
            o.w = pk2(v[8 * j + 6] * r * cg[8 * j + 6] + ch[8 * j + 6], v[8 * j + 7] * r * cg[8 * j + 7] + ch[8 * j + 7]);
            *(u32x4*)(orow + 512 * j) = o;
        }
    }
}

template <int ORIENT>
DI void kloop(f32x16 (&acc)[4][2], const bf16_t* __restrict__ At, const bf16_t* __restrict__ W0, const bf16_t* __restrict__ W1, char* lds, int tid, int lane) {
    tid = opaque_v(tid); lane = opaque_v(lane);
#pragma unroll
    for (int mb = 0; mb < 4; ++mb)
#pragma unroll
        for (int nb = 0; nb < 2; ++nb)
#pragma unroll
            for (int i = 0; i < 16; ++i) acc[mb][nb][i] = 0.f;
    {
    const int c8_ = (tid >> 3) & 7, rowA_ = (tid >> 6) * 8 + (tid & 7);
    const u32x4* Ag = (const u32x4*)(At + (unsigned)(rowA_ * 1024 + c8_ * 8));
    const int ldsA_ = ((((c8_ >> 1) * 4 + (rowA_ >> 5)) * 64) + (rowA_ & 31) + 32 * (c8_ & 1)) * 16;
    const u32x4* W0g = (const u32x4*)W0 + lane;
    const u32x4* W1g = (const u32x4*)W1 + lane;
    u32x4 wq[4][2], arA[2], arB[2];
    arA[0] = Ag[0]; arA[1] = Ag[8192]; arB[0] = Ag[8]; arB[1] = Ag[8 + 8192];
#pragma unroll
    for (int kk = 0; kk < 4; ++kk) { wq[kk][0] = W0g[kk * 64]; wq[kk][1] = W1g[kk * 64]; }
    *(u32x4*)(lds + ldsA_) = arA[0]; *(u32x4*)(lds + ldsA_ + 2048) = arA[1];
    __syncthreads();
#define KL_ITER(KC, ARL, ARS) do { \
        char* cur = lds + ((KC) & 1) * 16384; \
        char* nxt = lds + (((KC) + 1) & 1) * 16384; \
        const int kn = (KC) < 15 ? (KC) + 1 : 15, k2 = (KC) < 14 ? (KC) + 2 : 15; \
        if ((KC) < 14) { ARL[0] = Ag[k2 * 8]; ARL[1] = Ag[k2 * 8 + 8192]; } \
        __builtin_amdgcn_sched_barrier(0); \
        _Pragma("unroll") for (int kk = 0; kk < 4; ++kk) { \
            bf16x8 afr[4]; \
            _Pragma("unroll") for (int mb = 0; mb < 4; ++mb) afr[mb] = *(const bf16x8*)(cur + ((kk * 4 + mb) * 64 + lane) * 16); \
            _Pragma("unroll") for (int mb = 0; mb < 4; ++mb) \
                _Pragma("unroll") for (int nb = 0; nb < 2; ++nb) { \
                    const bf16x8 wf = __builtin_bit_cast(bf16x8, wq[kk][nb]); \
                    if (ORIENT == 0) acc[mb][nb] = MFMA32(afr[mb], wf, acc[mb][nb]); \
                    else acc[mb][nb] = MFMA32(wf, afr[mb], acc[mb][nb]); \
                } \
            if ((KC) < 15) { wq[kk][0] = W0g[(kn * 4 + kk) * 64]; wq[kk][1] = W1g[(kn * 4 + kk) * 64]; } \
            __builtin_amdgcn_sched_barrier(0); \
        } \
        if ((KC) < 15) { *(u32x4*)(nxt + ldsA_) = ARS[0]; *(u32x4*)(nxt + ldsA_ + 2048) = ARS[1]; } \
        __syncthreads(); \
    } while (0)
    for (int kc = 0; kc < 16; kc += 2) { KL_ITER(kc, arA, arB); KL_ITER(kc + 1, arB, arA); }
#undef KL_ITER
    }
}

DI void epi_f32row(const f32x16 (&acc)[4][2], float* __restrict__ C, int tile, int col0, int lane) {
    lane = opaque_v(lane);
    const int r5 = lane & 31, hh = lane >> 5;
    const unsigned boff = (unsigned)((tile * 128 + 4 * hh) * 2048 + col0 + r5);
#pragma unroll
    for (int mb = 0; mb < 4; ++mb)
#pragma unroll
        for (int nb = 0; nb < 2; ++nb)
#pragma unroll
            for (int i = 0; i < 16; ++i)
                C[boff + (unsigned)((mb * 32 + (i & 3) + 8 * (i >> 2)) * 2048 + nb * 32)] = acc[mb][nb][i];
}
DI void epi_resid(const f32x16 (&acc)[4][2], const float* __restrict__ xin, float* __restrict__ xout, const float* __restrict__ gate_b, float* T  , float* ssq  , int tile, int col0, int lane) {
    lane = opaque_v(lane);
    const int r5 = lane & 31, hh = lane >> 5, rq = lane >> 4, c4 = (lane & 15) * 4;
    const float4 gv = *(const float4*)(gate_b + col0 + c4);
#pragma unroll
    for (int mb = 0; mb < 4; ++mb) {
#pragma unroll
        for (int nb = 0; nb < 2; ++nb)
#pragma unroll
            for (int i = 0; i < 16; ++i) T[((i & 3) + 8 * (i >> 2) + 4 * hh) * 68 + nb * 32 + r5] = acc[mb][nb][i];
        asm volatile("s_waitcnt lgkmcnt(0)" ::: "memory");
#pragma unroll
        for (int j = 0; j < 8; ++j) {
            const int row = rq + 4 * j;
            const float4 v = *(const float4*)(T + row * 68 + c4);
            const unsigned o = (unsigned)((tile * 128 + mb * 32 + row) * D + col0 + c4);
            float4 xv = *(const float4*)(xin + o);
            xv.x += gv.x * v.x; xv.y += gv.y * v.y; xv.z += gv.z * v.z; xv.w += gv.w * v.w;
            *(float4*)(xout + o) = xv;
            float ss = xv.x * xv.x + xv.y * xv.y + xv.z * xv.z + xv.w * xv.w;
            ss = red16_sum(ss);
            if ((lane & 15) == 0) ssq[mb * 32 + row] = ss;
        }
        asm volatile("s_waitcnt lgkmcnt(0)" ::: "memory");
    }
}

DI void epi_qpf(const f32x16 (&acc)[4][2], bf16_t* __restrict__ QPF, int tile, int ft0, int lane) {
    lane = opaque_v(lane);
#pragma unroll
    for (int nb = 0; nb < 2; ++nb)
#pragma unroll
        for (int s = 0; s < 2; ++s)
#pragma unroll
            for (int mb = 0; mb < 4; ++mb) {
                const f32x16& a = acc[mb][nb];
                u32x4 o; o.x = pk2(a[8 * s], a[8 * s + 1]); o.y = pk2(a[8 * s + 2], a[8 * s + 3]); o.z = pk2(a[8 * s + 4], a[8 * s + 5]); o.w = pk2(a[8 * s + 6], a[8 * s + 7]);
                *(u32x4*)(QPF + ((unsigned)((((tile * 64 + ft0 + nb) * 2 + s) * 4 + mb) * 64 + lane)) * 8) = o;
            }
}

DI void conv_keys_item(const float* __restrict__ K, bf16_t* __restrict__ KF, int gid) {
    const int lane = gid & 63, s = (gid >> 6) & 1, nbl = (gid >> 7) & 3, nt = (gid >> 9) & 3, hp = gid >> 11;
    const int r = lane & 31, hh = lane >> 5;
    const float* p = K + ((size_t)hp * 128 + nt * 32 + r) * 128 + nbl * 32 + 16 * s + 4 * hh;
    const float4 a = *(const float4*)p, b = *(const float4*)(p + 8);
    u32x4 o; o.x = pk2(a.x, a.y); o.y = pk2(a.z, a.w); o.z = pk2(b.x, b.y); o.w = pk2(b.z, b.w);
    *(u32x4*)(KF + (size_t)gid * 8) = o;
}

DI void conv_table_row(const float* __restrict__ src, unsigned char* __restrict__ dst, float* __restrict__ sc, int lane, bool as_int4) {
    const float4* p = (const float4*)src + lane * 4;
    float4 v[4];
    float m = 0.f;
#pragma unroll
    for (int j = 0; j < 4; ++j) { v[j] = p[j]; m = fmaxf(m, fmaxf(fmaxf(fabsf(v[j].x), fabsf(v[j].y)), fmaxf(fabsf(v[j].z), fabsf(v[j].w)))); }
    m = wave_max(m);
    float scale = m > 0.f ? m * (1.f / 6.f) : 1.f;
    if (as_int4) {
        float ss = 0.f;
#pragma unroll
        for (int j = 0; j < 4; ++j) ss += v[j].x * v[j].x + v[j].y * v[j].y + v[j].z * v[j].z + v[j].w * v[j].w;
        ss = wave_sum(ss);
        const float sg = sqrtf(ss * (1.f / 1024.f));
        scale = fmaxf(sg * (1.f / 2.8f), m * (1.f / 16.f));
        if (!(scale > 0.f)) scale = 1.f;
    }
    const float inv = 1.f / scale;
    u32x2 o;
    unsigned* op = (unsigned*)&o;
#pragma unroll
    for (int j = 0; j < 2; ++j) {
        const float f[8] = {v[2 * j].x, v[2 * j].y, v[2 * j].z, v[2 * j].w, v[2 * j + 1].x, v[2 * j + 1].y, v[2 * j + 1].z, v[2 * j + 1].w};
        unsigned wv = 0;
        if (as_int4) {
#pragma unroll
            for (int e = 0; e < 8; ++e) { int q = __float2int_rn(f[e] * inv); q = q < -7 ? -7 : (q > 7 ? 7 : q); wv |= ((unsigned)q & 15u) << (4 * e); }
        } else {
            wv = __builtin_amdgcn_cvt_scalef32_pk_fp4_f32(wv, f[0] * inv, f[1] * inv, 1.0f, 0);
            wv = __builtin_amdgcn_cvt_scalef32_pk_fp4_f32(wv, f[2] * inv, f[3] * inv, 1.0f, 1);
            wv = __builtin_amdgcn_cvt_scalef32_pk_fp4_f32(wv, f[4] * inv, f[5] * inv, 1.0f, 2);
            wv = __builtin_amdgcn_cvt_scalef32_pk_fp4_f32(wv, f[6] * inv, f[7] * inv, 1.0f, 3);
        }
        op[j] = wv;
    }
    *(u32x2*)(dst + lane * 8) = o;
    if (lane == 0) *sc = scale;
}

DI void ce_desc(int& a, int& b) { const int mx = a > b ? a : b, mn = a > b ? b : a; a = mx; b = mn; }
DI void sort16_desc(int (&v)[16]) {
#pragma unroll
    for (int k = 2; k <= 16; k <<= 1)
#pragma unroll
        for (int j = k >> 1; j > 0; j >>= 1)
#pragma unroll
            for (int i = 0; i < 16; ++i) {
                const int l = i ^ j;
                if (l > i) { if ((i & k) == 0) ce_desc(v[i], v[l]); else ce_desc(v[l], v[i]); }
            }
}
DI void bitonic_merge16_desc(int (&v)[16]) {
#pragma unroll
    for (int j = 8; j > 0; j >>= 1)
#pragma unroll
        for (int i = 0; i < 16; ++i) { const int l = i ^ j; if (l > i) ce_desc(v[i], v[l]); }
}
DI void merge_top16(int (&a)[16], const int (&b)[16]) {
#pragma unroll
    for (int i = 0; i < 16; ++i) a[i] = a[i] > b[15 - i] ? a[i] : b[15 - i];
    bitonic_merge16_desc(a);
}
DI int f2ord(float f) { int b = __float_as_int(f); return b ^ ((b >> 31) & 0x7fffffff); }
DI float ord2f(int k) { return __int_as_float(k ^ ((k >> 31) & 0x7fffffff)); }

DI void route_tile(const bf16_t* __restrict__ QPF, const bf16_t* __restrict__ KF, char* lds_lists, unsigned char* lds_idx  , int tile, int tid) {
    tid = opaque_v(tid); tile = opaque_s(tile);
    const int lane = tid & 63, w = __builtin_amdgcn_readfirstlane(tid >> 6);
    const int r5 = lane & 31, hh = lane >> 5;
    unsigned char* myidx = lds_idx + w * 1024;
    for (int task = w; task < 32; task += 8) {
        const int h = task >> 2, tt = task & 3;
        f32x16 acc[2][4];
#pragma unroll
        for (int p = 0; p < 2; ++p)
#pragma unroll
            for (int nt = 0; nt < 4; ++nt)
#pragma unroll
                for (int i = 0; i < 16; ++i) acc[p][nt][i] = 0.f;
        {
            bf16x8 bq[3], ak[3][4];
#define ROUTE_LOAD(buf, step) do { const int p_ = (step) >> 3, ks_ = (step) & 7; \
                bq[buf] = *(const bf16x8*)(QPF + ((unsigned)((((tile * 64 + h * 8 + p_ * 4 + (ks_ >> 1)) * 2 + (ks_ & 1)) * 4 + tt) * 64 + lane)) * 8); \
                _Pragma("unroll") for (int nt = 0; nt < 4; ++nt) ak[buf][nt] = *(const bf16x8*)(KF + ((unsigned)(((((h * 2 + p_) * 4 + nt) * 8 + ks_) * 64) + lane)) * 8); } while (0)
            ROUTE_LOAD(0, 0);
            ROUTE_LOAD(1, 1);
#pragma unroll
            for (int step = 0; step < 16; ++step) {
                if (step < 14) ROUTE_LOAD((step + 2) % 3, step + 2);
#pragma unroll
                for (int nt = 0; nt < 4; ++nt) acc[step >> 3][nt] = MFMA32(ak[step % 3][nt], bq[step % 3], acc[step >> 3][nt]);
                __builtin_amdgcn_sched_barrier(0);
            }
#undef ROUTE_LOAD
        }
        int g[8][16];
#pragma unroll
        for (int nt = 0; nt < 4; ++nt)
#pragma unroll
            for (int i = 0; i < 16; ++i) {
                const unsigned a = __float_as_uint(acc[0][nt][i]), b = __float_as_uint(acc[1][nt][i]);
                auto sw = __builtin_amdgcn_permlane32_swap(a, b, false, false);
                const int n0 = nt * 32 + (i & 3) + 8 * (i >> 2);
                g[nt * 2 + (i >> 3)][i & 7] = (f2ord(__uint_as_float(sw[0])) & ~127) | n0;
                g[nt * 2 + (i >> 3)][8 + (i & 7)] = (f2ord(__uint_as_float(sw[1])) & ~127) | (n0 + 4);
            }
#pragma unroll
        for (int q = 0; q < 8; ++q) sort16_desc(g[q]);
        merge_top16(g[0], g[1]); merge_top16(g[2], g[3]); merge_top16(g[4], g[5]); merge_top16(g[6], g[7]);
        merge_top16(g[0], g[2]); merge_top16(g[4], g[6]);
        merge_top16(g[0], g[4]);
        {
            u32x4 pk;
            unsigned* pp = (unsigned*)&pk;
#pragma unroll
            for (int q = 0; q < 4; ++q) pp[q] = (unsigned)(g[0][4 * q] & 127) | ((unsigned)(g[0][4 * q + 1] & 127) << 8) | ((unsigned)(g[0][4 * q + 2] & 127) << 16) | ((unsigned)(g[0][4 * q + 3] & 127) << 24);
            *(u32x4*)(myidx + lane * 16) = pk;
        }
        float f0[16], f1[16];
#pragma unroll
        for (int i = 0; i < 16; ++i) {
            const unsigned a = (unsigned)g[0][i], b = a;
            auto sw = __builtin_amdgcn_permlane32_swap(a, b, false, false);
            f0[i] = ord2f((int)sw[0] & ~127); f1[i] = ord2f((int)sw[1] & ~127);
        }
        int c0[16], c1[16], c2[16], c3[16];
#pragma unroll
        for (int j = 0; j < 16; ++j) c0[j] = (f2ord(f0[0] + f1[j]) & ~255) | j;
#pragma unroll
        for (int i = 1; i < 16; ++i) c1[i - 1] = (f2ord(f0[i] + f1[0]) & ~255) | (i << 4);
        c1[15] = (int)0x80000000;
#define CK(i, j) ((f2ord(f0[i] + f1[j]) & ~255) | ((i) << 4) | (j))
        c2[0] = CK(1, 1); c2[1] = CK(1, 2); c2[2] = CK(1, 3); c2[3] = CK(1, 4); c2[4] = CK(1, 5); c2[5] = CK(1, 6); c2[6] = CK(1, 7);
        c2[7] = CK(2, 1); c2[8] = CK(2, 2); c2[9] = CK(2, 3); c2[10] = CK(2, 4);
        c2[11] = CK(3, 1); c2[12] = CK(3, 2); c2[13] = CK(3, 3);
        c2[14] = CK(4, 1); c2[15] = CK(4, 2);
        c3[0] = CK(5, 1); c3[1] = CK(6, 1); c3[2] = CK(7, 1);
#undef CK
#pragma unroll
        for (int q = 3; q < 16; ++q) c3[q] = (int)0x80000000;
        sort16_desc(c2);
        ce_desc(c3[0], c3[1]); ce_desc(c3[1], c3[2]); ce_desc(c3[0], c3[1]);
        merge_top16(c0, c1); merge_top16(c2, c3); merge_top16(c0, c2);
        float bs[16], den = 0.f;
#pragma unroll
        for (int i = 0; i < 16; ++i) { bs[i] = __expf(ord2f(c0[i] & ~255) - ord2f(c0[0] & ~255)); den += bs[i]; }
        const float rden = 1.f / den;
        asm volatile("s_waitcnt lgkmcnt(0)" ::: "memory");
#pragma unroll
        for (int q = 0; q < 8; ++q) {
            const int key = (int)__builtin_amdgcn_permlane32_swap((unsigned)c0[q], (unsigned)c0[8 + q], false, false)[0];
            const float gv = __uint_as_float(__builtin_amdgcn_permlane32_swap(__float_as_uint(bs[q]), __float_as_uint(bs[8 + q]), false, false)[0]) * rden;
            const int i = (key >> 4) & 15, j = key & 15;
            const int e = (int)myidx[r5 * 16 + i] * 128 + (int)myidx[(32 + r5) * 16 + j];
            const int tokl = tt * 32 + r5;
            ((unsigned short*)(lds_lists + PL_SEID))[tokl * 128 + h * 16 + 8 * hh + q] = (unsigned short)e;
            ((float*)(lds_lists + PL_SWGT))[tokl * 128 + h * 16 + 8 * hh + q] = gv;
        }
        asm volatile("s_waitcnt lgkmcnt(0)" ::: "memory");
    }
}

DI void unpack_h2(const bf16_t* __restrict__ hA, int t, int lane, f32x2 (&hv)[8]) {
    const int tile = t >> 7, row = t & 127, mb = row >> 5, r5 = row & 31;
    const bf16_t* hp = hA + ((unsigned)(((tile * 64 + lane) * 4 + mb) * 64 + r5)) * 8;
    const u32x4 ha = *(const u32x4*)hp, hb = *(const u32x4*)(hp + 32 * 8);
    const unsigned hw[8] = {ha.x, ha.y, ha.z, ha.w, hb.x, hb.y, hb.z, hb.w};
#pragma unroll
    for (int q = 0; q < 8; ++q) { hv[q].x = __uint_as_float(hw[q] << 16); hv[q].y = __uint_as_float(hw[q] & 0xffff0000u); }
}
typedef _Float16 h16x2 __attribute__((ext_vector_type(2)));
DI h16x2 fp4h(unsigned w, int sel) {
    return sel == 0 ? __builtin_amdgcn_cvt_scalef32_pk_f16_fp4(w, 1.0f, 0) : sel == 1 ? __builtin_amdgcn_cvt_scalef32_pk_f16_fp4(w, 1.0f, 1)
         : sel == 2 ? __builtin_amdgcn_cvt_scalef32_pk_f16_fp4(w, 1.0f, 2) : __builtin_amdgcn_cvt_scalef32_pk_f16_fp4(w, 1.0f, 3);
}
DI unsigned rowoff_lo(unsigned pr, unsigned k512, unsigned lane8) { unsigned r; asm("v_mad_u32_u16 %0, %1, %2, %3" : "=v"(r) : "v"(pr), "s"(k512), "v"(lane8)); return r; }
DI unsigned rowoff_hi(unsigned pr, unsigned k512, unsigned lane8) { unsigned r; asm("v_mad_u32_u16 %0, %1, %2, %3 op_sel:[1,0,0,0]" : "=v"(r) : "v"(pr), "s"(k512), "v"(lane8)); return r; }
DI void stage_token(const int* __restrict__ ridx, const float* __restrict__ rgate, char* lds, int t, int tloc, int lane) {
    lane = opaque_v(lane); t = opaque_s(t);
    unsigned short* seid = (unsigned short*)(lds + PL_SEID) + tloc * 128;
    float* swgt = (float*)(lds + PL_SWGT) + tloc * 128;
    seid[lane] = (unsigned short)ridx[(unsigned)(t * 128 + lane)]; seid[64 + lane] = (unsigned short)ridx[(unsigned)(t * 128 + 64 + lane)];
    swgt[lane] = rgate[(unsigned)(t * 128 + lane)]; swgt[64 + lane] = rgate[(unsigned)(t * 128 + 64 + lane)];
}
DI void peer_down_wave(const bf16_t* __restrict__ hA, char* lds, const unsigned char* __restrict__ TBd, const float* __restrict__ SC, int tile, int w, int lane) {
    lane = opaque_v(lane);
    const unsigned lane8 = (unsigned)lane * 8u;
    const int myu = ((lane >> 5) & 1) * 8 + ((lane >> 4) & 1) * 4 + ((lane >> 3) & 1) * 2 + ((lane >> 2) & 1);
    const unsigned short* seid = (const unsigned short*)(lds + PL_SEID) + w * 16 * 128;
    float* swgt = (float*)(lds + PL_SWGT) + w * 16 * 128;
    u32x4 haN, hbN;
    { const bf16_t* hp0 = hA + (unsigned)((tile * 128 + w * 16) * 1024 + lane * 16); haN = *(const u32x4*)hp0; hbN = *(const u32x4*)(hp0 + 8); }
    u32x2 R[2][16];
    f32x2 scv[2];
    u32x4 ID[2];
#define DOWN_IDS(P_) do { ID[0] = *(const u32x4*)(seid + (P_)); ID[1] = *(const u32x4*)(seid + (P_) + 8); } while (0)
#define DOWN_LOADS(buf, P_) do { _Pragma("unroll") for (int u_ = 0; u_ < 16; ++u_) { const unsigned pr_ = ID[u_ >> 3][(u_ >> 1) & 3]; \
        const unsigned off_ = (u_ & 1) ? rowoff_hi(pr_, 512u, lane8) : rowoff_lo(pr_, 512u, lane8); R[buf][u_] = *(const u32x2*)(TBd + off_); } \
        scv[buf] = *(const f32x2*)(SC + (unsigned)seid[(P_) + myu] * 2u); } while (0)
    DOWN_IDS(0); DOWN_LOADS(0, 0); DOWN_IDS(16);
#pragma unroll 1
    for (int tl = 0; tl < 16; ++tl) {
        const int t = tile * 128 + w * 16 + tl;
        float* gp = swgt + tl * 128;
        const u32x4 ha = haN, hb = hbN;
        const int tn = tl < 15 ? tl + 1 : tl;
        { const bf16_t* hp = hA + (unsigned)((t - tl + tn) * 1024 + lane * 16); haN = *(const u32x4*)hp; hbN = *(const u32x4*)(hp + 8); }
        unsigned hhi[2], hlo[2];
        float hscale;
        {
            const unsigned hw[8] = {ha.x, ha.y, ha.z, ha.w, hb.x, hb.y, hb.z, hb.w};
            float hf[16];
            float m = 0.f;
#pragma unroll
            for (int q = 0; q < 8; ++q) { hf[2 * q] = __uint_as_float(hw[q] << 16); hf[2 * q + 1] = __uint_as_float(hw[q] & 0xffff0000u); m = fmaxf(m, fmaxf(fabsf(hf[2 * q]), fabsf(hf[2 * q + 1]))); }
            m = wave_max(m);
            hscale = m > 0.f ? m * (1.f / 119.f) : 1.f;
            const float inv = 1.f / hscale;
            hhi[0] = hhi[1] = hlo[0] = hlo[1] = 0u;
#pragma unroll
            for (int e = 0; e < 16; ++e) {
                const int hq = __float2int_rn(hf[e] * inv);
                const int lo = ((hq + 8) & 15) - 8, hi = (hq - lo) >> 4;
                hlo[e >> 3] |= ((unsigned)lo & 15u) << (4 * (e & 7));
                hhi[e >> 3] |= ((unsigned)hi & 15u) << (4 * (e & 7));
            }
        }
#pragma unroll
        for (int bt = 0; bt < 8; ++bt) {
            const int cur = bt & 1, nxt = cur ^ 1;
            const int p1 = bt < 7 ? tl * 128 + (bt + 1) * 16 : tn * 128;
            const int p2 = bt < 6 ? tl * 128 + (bt + 2) * 16 : tn * 128 + (bt - 6) * 16;
            DOWN_LOADS(nxt, p1);
            DOWN_IDS(p2);
            __builtin_amdgcn_sched_barrier(0);
            int part[16];
#pragma unroll
            for (int u = 0; u < 16; ++u) {
                int shi = __builtin_amdgcn_sdot8((int)R[cur][u].x, (int)hhi[0], 0, false);
                shi = __builtin_amdgcn_sdot8((int)R[cur][u].y, (int)hhi[1], shi, false);
                int slo = __builtin_amdgcn_sdot8((int)R[cur][u].x, (int)hlo[0], 0, false);
                slo = __builtin_amdgcn_sdot8((int)R[cur][u].y, (int)hlo[1], slo, false);
                part[u] = shi * 16 + slo;
            }
            int r8[8], r4[4], r2[2], r1;
            {
                const bool b3 = (lane & 8) != 0, b2 = (lane & 4) != 0;
#pragma unroll
                for (int q = 0; q < 8; ++q) { auto sw = __builtin_amdgcn_permlane32_swap((unsigned)part[q], (unsigned)part[q + 8], false, false); r8[q] = (int)sw[0] + (int)sw[1]; }
#pragma unroll
                for (int q = 0; q < 4; ++q) { auto sw = __builtin_amdgcn_permlane16_swap((unsigned)r8[q], (unsigned)r8[q + 4], false, false); r4[q] = (int)sw[0] + (int)sw[1]; }
#pragma unroll
                for (int q = 0; q < 2; ++q) { const int keep = b3 ? r4[q + 2] : r4[q], give = b3 ? r4[q] : r4[q + 2]; r2[q] = keep + dppi<0x128>(give); }
                { const int keep = b2 ? r2[1] : r2[0], give = b2 ? r2[0] : r2[1]; r1 = keep + dppi<0x141>(give); }
                r1 += dppi<0x4E>(r1); r1 += dppi<0xB1>(r1);
            }
            if ((lane & 3) == 0) {
                const float a = (float)r1 * (scv[cur].x * hscale);
                const float wv_ = gp[bt * 16 + myu] * (0.5f * a * (1.f + erff(a * 0.70710678118654752f))) * scv[cur].y;
                ((unsigned*)gp)[bt * 16 + myu] = (unsigned)__builtin_bit_cast(unsigned short, (_Float16)wv_);
            }
        }
    }
#undef DOWN_IDS
#undef DOWN_LOADS
}
DI void peer_up_wave(char* lds, const unsigned char* __restrict__ TBu, const float* __restrict__ g2b, float* __restrict__ x, int tile, int w, int lane,
                     bf16_t* __restrict__ hAn, const float* __restrict__ g1n, const float* __restrict__ sh1n, const float* __restrict__ sc1n) {
    lane = opaque_v(lane);
    const unsigned lane8 = (unsigned)lane * 8u;
    const unsigned short* seid = (const unsigned short*)(lds + PL_SEID) + w * 16 * 128;
    const unsigned* swgt = (const unsigned*)(lds + PL_SWGT) + w * 16 * 128;
    u32x2 RA[16], RB[16];
    u32x4 ID[2], WA[4], WB[4];
#define UP_IDS(P_) do { ID[0] = *(const u32x4*)(seid + (P_)); ID[1] = *(const u32x4*)(seid + (P_) + 8); } while (0)
#define UP_WTS(W, P_) do { _Pragma("unroll") for (int q_ = 0; q_ < 4; ++q_) W[q_] = *(const u32x4*)(swgt + (P_) + 4 * q_); } while (0)
#define UP_LOADS(R) do { _Pragma("unroll") for (int u_ = 0; u_ < 16; ++u_) { const unsigned pr_ = ID[u_ >> 3][(u_ >> 1) & 3]; \
        const unsigned off_ = (u_ & 1) ? rowoff_hi(pr_, 512u, lane8) : rowoff_lo(pr_, 512u, lane8); R[u_] = *(const u32x2*)(TBu + off_); } } while (0)
#define UP_COMPUTE(R, W, K) do { _Pragma("unroll") for (int u_ = 0; u_ < 16; ++u_) { \
        const unsigned wd_ = W[u_ >> 2][u_ & 3]; const h16x2 wp_ = __builtin_bit_cast(h16x2, wd_); const h16x2 w2_ = (h16x2){wp_.x, wp_.x}; \
        _Pragma("unroll") for (int q_ = 0; q_ < 4; ++q_) { acc[K][q_] = __builtin_elementwise_fma(w2_, fp4h(R[u_].x, q_), acc[K][q_]); acc[K][4 + q_] = __builtin_elementwise_fma(w2_, fp4h(R[u_].y, q_), acc[K][4 + q_]); } } } while (0)
    UP_IDS(0); UP_LOADS(RA); UP_IDS(16); UP_WTS(WA, 0);
    float4 gv[4];
#pragma unroll
    for (int q = 0; q < 4; ++q) gv[q] = ((const float4*)(g2b + lane * 16))[q];
    float4 cg[4], ch[4];
#pragma unroll
    for (int q = 0; q < 4; ++q) {
        cg[q] = (float4){0.f, 0.f, 0.f, 0.f}; ch[q] = cg[q];
        if (hAn) { const float4 a = ((const float4*)(g1n + lane * 16))[q], b = ((const float4*)(sc1n + lane * 16))[q]; ch[q] = ((const float4*)(sh1n + lane * 16))[q];
                   cg[q].x = a.x * (1.f + b.x); cg[q].y = a.y * (1.f + b.y); cg[q].z = a.z * (1.f + b.z); cg[q].w = a.w * (1.f + b.w); }
    }
#pragma unroll 1
    for (int tk = 0; tk < 16; ++tk) {
        const int tn = tk < 15 ? tk + 1 : 15;
        float4* xp = (float4*)(x + (size_t)(unsigned)((tile * 128 + w * 16 + tk) * D + lane * 16));
        float4 xv[4];
#pragma unroll
        for (int q = 0; q < 4; ++q) xv[q] = xp[q];
        h16x2 acc[1][8];
#pragma unroll
        for (int q = 0; q < 8; ++q) acc[0][q] = (h16x2){(_Float16)0.f, (_Float16)0.f};
#pragma unroll 1
        for (int i = 0; i < 4; ++i) {
            const int pa = tk * 128 + i * 32;
            const int pn = i < 3 ? pa + 32 : tn * 128;
            UP_LOADS(RB); UP_WTS(WB, pa + 16); UP_IDS(pn);
            __builtin_amdgcn_sched_barrier(0);
            UP_COMPUTE(RA, WA, 0);
            UP_LOADS(RA); UP_WTS(WA, pn); UP_IDS(pn + 16);
            __builtin_amdgcn_sched_barrier(0);
            UP_COMPUTE(RB, WB, 0);
        }
        float ssx = 0.f;
#pragma unroll
        for (int q = 0; q < 4; ++q) {
            xv[q].x += gv[q].x * (float)acc[0][2 * q].x; xv[q].y += gv[q].y * (float)acc[0][2 * q].y; xv[q].z += gv[q].z * (float)acc[0][2 * q + 1].x; xv[q].w += gv[q].w * (float)acc[0][2 * q + 1].y;
            xp[q] = xv[q];
            ssx += xv[q].x * xv[q].x + xv[q].y * xv[q].y + xv[q].z * xv[q].z + xv[q].w * xv[q].w;
        }
        ssx = wave_sum(ssx);
        if (hAn) {
            const float rs = rsqrtf(ssx * (1.f / D) + EPS);
            bf16_t* orow = hAn + (size_t)(unsigned)((tile * 128 + w * 16 + tk) * D + lane * 16);
#pragma unroll
            for (int j = 0; j < 2; ++j) {
                u32x4 o;
                o.x = pk2(xv[2 * j].x * rs * cg[2 * j].x + ch[2 * j].x, xv[2 * j].y * rs * cg[2 * j].y + ch[2 * j].y);
                o.y = pk2(xv[2 * j].z * rs * cg[2 * j].z + ch[2 * j].z, xv[2 * j].w * rs * cg[2 * j].w + ch[2 * j].w);
                o.z = pk2(xv[2 * j + 1].x * rs * cg[2 * j + 1].x + ch[2 * j + 1].x, xv[2 * j + 1].y * rs * cg[2 * j + 1].y + ch[2 * j + 1].y);
                o.w = pk2(xv[2 * j + 1].z * rs * cg[2 * j + 1].z + ch[2 * j + 1].z, xv[2 * j + 1].w * rs * cg[2 * j + 1].w + ch[2 * j + 1].w);
                *(u32x4*)(orow + 8 * j) = o;
            }
        }
    }
#undef UP_IDS
#undef UP_WTS
#undef UP_LOADS
#undef UP_COMPUTE
}

DI void epi_qk(f32x16 (&acc)[4][2], const float* __restrict__ gain, float scale, bf16_t* __restrict__ dst, int lane) {
    lane = opaque_v(lane);
    const int hh = lane >> 5;
    float gv[2][16];
#pragma unroll
    for (int nb = 0; nb < 2; ++nb)
#pragma unroll
        for (int i = 0; i < 16; ++i) gv[nb][i] = gain[nb * 32 + (i & 3) + 8 * (i >> 2) + 4 * hh] * scale;
#pragma unroll
    for (int mb = 0; mb < 4; ++mb) {
        float ss = 0.f;
#pragma unroll
        for (int nb = 0; nb < 2; ++nb)
#pragma unroll
            for (int i = 0; i < 16; ++i) ss += acc[mb][nb][i] * acc[mb][nb][i];
        ss = x32_sum(ss);
        const float r = rsqrtf(ss * (1.f / 64.f) + EPS);
#pragma unroll
        for (int nb = 0; nb < 2; ++nb)
#pragma unroll
            for (int s = 0; s < 2; ++s) {
                const f32x16& a = acc[mb][nb];
                u32x4 o;
                o.x = pk2(a[8 * s] * r * gv[nb][8 * s], a[8 * s + 1] * r * gv[nb][8 * s + 1]);
                o.y = pk2(a[8 * s + 2] * r * gv[nb][8 * s + 2], a[8 * s + 3] * r * gv[nb][8 * s + 3]);
                o.z = pk2(a[8 * s + 4] * r * gv[nb][8 * s + 4], a[8 * s + 5] * r * gv[nb][8 * s + 5]);
                o.w = pk2(a[8 * s + 6] * r * gv[nb][8 * s + 6], a[8 * s + 7] * r * gv[nb][8 * s + 7]);
                *(u32x4*)(dst + ((unsigned)(((nb * 2 + s) * 4 + mb) * 64 + lane)) * 8) = o;
            }
    }
}
DI void epi_v(const f32x16 (&acc)[4][2], bf16_t* __restrict__ dst, int lane) {
    lane = opaque_v(lane);
#pragma unroll
    for (int nb = 0; nb < 2; ++nb)
#pragma unroll
        for (int mb = 0; mb < 4; ++mb)
#pragma unroll
            for (int s = 0; s < 2; ++s) {
                const f32x16& a = acc[mb][nb];
                u32x4 o; o.x = pk2(a[8 * s], a[8 * s + 1]); o.y = pk2(a[8 * s + 2], a[8 * s + 3]); o.z = pk2(a[8 * s + 4], a[8 * s + 5]); o.w = pk2(a[8 * s + 6], a[8 * s + 7]);
                *(u32x4*)(dst + ((unsigned)(((nb * 4 + mb) * 2 + s) * 64 + lane)) * 8) = o;
            }
}
DI void epi_row(const f32x16 (&acc)[4][2], bf16_t* __restrict__ dst, int ld, int lane) {
    lane = opaque_v(lane);
    const int r5 = lane & 31, hh = lane >> 5;
#pragma unroll
    for (int mb = 0; mb < 4; ++mb)
#pragma unroll
        for (int nb = 0; nb < 2; ++nb)
#pragma unroll
            for (int gq = 0; gq < 4; ++gq) {
                const f32x16& a = acc[mb][nb];
                u32x2 o; o.x = pk2(a[4 * gq], a[4 * gq + 1]); o.y = pk2(a[4 * gq + 2], a[4 * gq + 3]);
                *(u32x2*)(dst + (unsigned)((mb * 32 + r5) * ld + nb * 32 + 8 * gq + 4 * hh)) = o;
            }
}
DI void epi_z(const f32x16 (&acc)[4][2], bf16_t* __restrict__ dst, int lane) {
    lane = opaque_v(lane);
    const int r5 = lane & 31, hh = lane >> 5;
#pragma unroll
    for (int mb = 0; mb < 4; ++mb)
#pragma unroll
        for (int gq = 0; gq < 4; ++gq) {
            const f32x16 &a = acc[mb][0], &b = acc[mb][1];
            u32x2 o; o.x = pk2(a[4 * gq] * b[4 * gq], a[4 * gq + 1] * b[4 * gq + 1]); o.y = pk2(a[4 * gq + 2] * b[4 * gq + 2], a[4 * gq + 3] * b[4 * gq + 3]);
            *(u32x2*)(dst + (unsigned)((mb * 32 + r5) * 256 + 8 * gq + 4 * hh)) = o;
        }
}
DI void epi_su_park(const f32x16 (&acc)[4][2], unsigned* lds_su, int lane) {
    lane = opaque_v(lane);
#pragma unroll
    for (int mb = 0; mb < 4; ++mb)
#pragma unroll
        for (int nb = 0; nb < 2; ++nb)
#pragma unroll
            for (int q = 0; q < 8; ++q) lds_su[((mb * 2 + nb) * 8 + q) * 64 + lane] = pk2(acc[mb][nb][2 * q], acc[mb][nb][2 * q + 1]);
}
DI void epi_sv(f32x16 (&acc)[4][2], const bf16_t* __restrict__ SWF  , const float* __restrict__ bs_g, const unsigned* lds_su, bf16_t* __restrict__ dst, int lane) {
    lane = opaque_v(lane);
    const int r5 = lane & 31, hh = lane >> 5;
    bf16x8 vb[4][2][2];
#pragma unroll
    for (int mb = 0; mb < 4; ++mb) {
#pragma unroll
        for (int i = 0; i < 16; ++i) {
            float s1 = acc[mb][0][i] + acc[mb][1][i];
            s1 = red32_sum(s1);
            const float mu = s1 * (1.f / 64.f);
            const float d0 = acc[mb][0][i] - mu, d1 = acc[mb][1][i] - mu;
            float s2 = d0 * d0 + d1 * d1;
            s2 = red32_sum(s2);
            const float r = rsqrtf(s2 * (1.f / 64.f) + EPS);
            acc[mb][0][i] = d0 * r; acc[mb][1][i] = d1 * r;
        }
#pragma unroll
        for (int s = 0; s < 2; ++s)
#pragma unroll
            for (int nb = 0; nb < 2; ++nb) {
                const f32x16& a = acc[mb][nb];
                u32x4 o; o.x = pk2(a[8 * s], a[8 * s + 1]); o.y = pk2(a[8 * s + 2], a[8 * s + 3]); o.z = pk2(a[8 * s + 4], a[8 * s + 5]); o.w = pk2(a[8 * s + 6], a[8 * s + 7]);
                vb[mb][s][nb] = __builtin_bit_cast(bf16x8, o);
            }
    }
#pragma unroll
    for (int tb = 0; tb < 4; ++tb) {
        f32x16 y[2];
#pragma unroll
        for (int nb = 0; nb < 2; ++nb)
#pragma unroll
            for (int i = 0; i < 16; ++i) y[nb][i] = 0.f;
#pragma unroll
        for (int kt = 0; kt <= tb; ++kt)
#pragma unroll
            for (int s = 0; s < 2; ++s) {
                const bf16x8 wa = *(const bf16x8*)(SWF + ((unsigned)(((tb * 4 + kt) * 2 + s) * 64 + lane)) * 8);
                y[0] = MFMA32(wa, vb[kt][s][0], y[0]);
                y[1] = MFMA32(wa, vb[kt][s][1], y[1]);
            }
#pragma unroll
        for (int nb = 0; nb < 2; ++nb)
#pragma unroll
            for (int q = 0; q < 8; ++q) {
                const unsigned su2 = lds_su[((tb * 2 + nb) * 8 + q) * 64 + lane];
                const int i0 = 2 * q, i1 = 2 * q + 1;
                const int t0 = tb * 32 + (i0 & 3) + 8 * (i0 >> 2) + 4 * hh, t1 = tb * 32 + (i1 & 3) + 8 * (i1 >> 2) + 4 * hh;
                const float v0 = (y[nb][i0] + bs_g[t0]) * __uint_as_float(su2 << 16), v1 = (y[nb][i1] + bs_g[t1]) * __uint_as_float(su2 & 0xffff0000u);
                const unsigned pk = pk2(v0, v1);
                dst[(unsigned)(t0 * 256 + nb * 32 + r5)] = (bf16_t)(pk & 0xffffu);
                dst[(unsigned)(t1 * 256 + nb * 32 + r5)] = (bf16_t)(pk >> 16);
            }
    }
}

DI void conv_sguw_item(const float* __restrict__ W, bf16_t* __restrict__ SWF, int gid) {
    const int lane = gid & 63, s = (gid >> 6) & 1, kt = (gid >> 7) & 3, tb = (gid >> 9) & 3, g = gid >> 11;
    const int r = lane & 31, hh = lane >> 5, t = tb * 32 + r;
    const float* p = W + ((size_t)g * 128 + t) * 128;
    float v[8];
#pragma unroll
    for (int j = 0; j < 8; ++j) { const int sp = kt * 32 + 16 * s + 8 * (j >> 2) + 4 * hh + (j & 3); v[j] = sp <= t ? p[sp] : 0.f; }
    u32x4 o; o.x = pk2(v[0], v[1]); o.y = pk2(v[2], v[3]); o.z = pk2(v[4], v[5]); o.w = pk2(v[6], v[7]);
    *(u32x4*)(SWF + (size_t)gid * 8) = o;
}

DI int t5_bucket(int d) {
    if (d < 16) return d;
    const float lr = logf((float)d / 16.f) / logf(8.f);
    const int large = 16 + (int)(lr * 16.f);
    return large < 31 ? large : 31;
}

DI void attn_tile(const bf16_t* __restrict__ QF, const bf16_t* __restrict__ KF2, const bf16_t* __restrict__ VF, char* lds, const float* bias_lds, const float* __restrict__ sink, bf16_t* __restrict__ OR, int tile, int tid) {
    tid = opaque_v(tid); tile = opaque_s(tile);
    const int lane = tid & 63, w = __builtin_amdgcn_readfirstlane(tid >> 6), r5 = lane & 31, hh = lane >> 5;
    const bool has_prev = (tile & 31) != 0;
    {
        u32x4 tmp[16];
#pragma unroll
        for (int i = 0; i < 16; ++i) {
            const int blk = w * 16 + i;
            const int isv = blk >> 6, bb = blk & 63;
            const bf16_t* src;
            if (!isv) { const int kvh = bb >> 5, ks = (bb >> 3) & 3, wt = bb & 7, st = (wt >= 4 || !has_prev) ? tile : tile - 1;
                src = KF2 + ((unsigned)((((st * 2 + kvh) * 4 + ks) * 4 + (wt & 3)) * 64 + lane)) * 8; }
            else { const int kvh = bb >> 5, dt = (bb >> 4) & 1, wt = (bb >> 1) & 7, s2 = bb & 1, st = (wt >= 4 || !has_prev) ? tile : tile - 1;
                src = VF + ((unsigned)(((((st * 2 + kvh) * 2 + dt) * 4 + (wt & 3)) * 2 + s2) * 64 + lane)) * 8; }
            tmp[i] = *(const u32x4*)src;
        }
#pragma unroll
        for (int i = 0; i < 16; ++i) *(u32x4*)(lds + (w * 16 + i) * 1024 + lane * 16) = tmp[i];
    }
    __syncthreads();
    const char* ldsK = lds, *ldsV = lds + 65536;
    for (int task = w; task < 32; task += 8) {
        const int qh = task >> 2, qt = task & 3, kvh = qh >> 2;
        bf16x8 bq[4];
#pragma unroll
        for (int ks = 0; ks < 4; ++ks) bq[ks] = *(const bf16x8*)(QF + ((unsigned)((((tile * 8 + qh) * 4 + ks) * 4 + qt) * 64 + lane)) * 8);
        f32x16 sc[5];
#pragma unroll
        for (int jj = 0; jj < 5; ++jj) {
#pragma unroll
            for (int i = 0; i < 16; ++i) sc[jj][i] = 0.f;
#pragma unroll
            for (int ks = 0; ks < 4; ++ks) {
                const bf16x8 kf = *(const bf16x8*)(ldsK + ((kvh * 4 + ks) * 8 + qt + jj) * 1024 + lane * 16);
                sc[jj] = MFMA32(kf, bq[ks], sc[jj]);
            }
        }
        const float* bl = bias_lds + qh * 128;
        float m = -1e30f;
#pragma unroll
        for (int jj = 0; jj < 5; ++jj) {
            const bool ex = (qt + jj >= 4) || has_prev;
#pragma unroll
            for (int i = 0; i < 16; ++i) {
                const int cr = (i & 3) + 8 * (i >> 2) + 4 * hh;
                const int dist = 128 + r5 - 32 * jj - cr;
                const bool valid = ex && dist >= 0 && dist < 128;
                float bv = bl[dist & 127];
                asm volatile("" : "+v"(bv));
                const float v = valid ? sc[jj][i] + bv : -1e30f;
                sc[jj][i] = v; m = fmaxf(m, v);
            }
        }
        m = x32_max(m);
        const float sk = sink[qh];
        m = fmaxf(m, sk);
        float l = 0.f;
#pragma unroll
        for (int jj = 0; jj < 5; ++jj)
#pragma unroll
            for (int i = 0; i < 16; ++i) { const float p = __expf(sc[jj][i] - m); sc[jj][i] = p; l += p; }
        l = x32_sum(l);
        l += __expf(sk - m);
        const float rl = 1.f / l;
        f32x16 o[2];
#pragma unroll
        for (int dt = 0; dt < 2; ++dt)
#pragma unroll
            for (int i = 0; i < 16; ++i) o[dt][i] = 0.f;
#pragma unroll
        for (int jj = 0; jj < 5; ++jj) {
#pragma unroll
            for (int s = 0; s < 2; ++s) {
                const f32x16& a = sc[jj];
                u32x4 pp; pp.x = pk2(a[8 * s], a[8 * s + 1]); pp.y = pk2(a[8 * s + 2], a[8 * s + 3]); pp.z = pk2(a[8 * s + 4], a[8 * s + 5]); pp.w = pk2(a[8 * s + 6], a[8 * s + 7]);
                const bf16x8 pb = __builtin_bit_cast(bf16x8, pp);
#pragma unroll
                for (int dt = 0; dt < 2; ++dt) {
                    const bf16x8 vf = *(const bf16x8*)(ldsV + (((kvh * 2 + dt) * 8 + qt + jj) * 2 + s) * 1024 + lane * 16);
                    o[dt] = MFMA32(vf, pb, o[dt]);
                }
            }
        }
        bf16_t* orow = OR + (unsigned)((tile * 128 + qt * 32 + r5) * 512 + qh * 64 + 4 * hh);
#pragma unroll
        for (int dt = 0; dt < 2; ++dt)
#pragma unroll
            for (int gq = 0; gq < 4; ++gq) {
                u32x2 ov; ov.x = pk2(o[dt][4 * gq] * rl, o[dt][4 * gq + 1] * rl); ov.y = pk2(o[dt][4 * gq + 2] * rl, o[dt][4 * gq + 3] * rl);
                *(u32x2*)(orow + dt * 32 + 8 * gq) = ov;
            }
    }
}

DI void unpack8(const u32x4 v, float (&f)[8]) {
    f[0] = __uint_as_float(v.x << 16); f[1] = __uint_as_float(v.x & 0xffff0000u); f[2] = __uint_as_float(v.y << 16); f[3] = __uint_as_float(v.y & 0xffff0000u);
    f[4] = __uint_as_float(v.z << 16); f[5] = __uint_as_float(v.z & 0xffff0000u); f[6] = __uint_as_float(v.w << 16); f[7] = __uint_as_float(v.w & 0xffff0000u);
}
DI void merge_tile(const bf16_t* __restrict__ OR, const bf16_t* __restrict__ CBR, const bf16_t* __restrict__ ZR, const bf16_t* __restrict__ YS, const float* __restrict__ cw  , const float* __restrict__ og  ,
                   bf16_t* __restrict__ mA, int tile, int tid) {
    tid = opaque_v(tid); tile = opaque_s(tile);
    const int lane = tid & 63, w = tid >> 6;
    float cwv[3][8], ga[8], gb[8];
    {
        const int c0 = (lane & 31) * 8;
#pragma unroll
        for (int j = 0; j < 3; ++j) { const float4 p0 = *(const float4*)(cw + j * 256 + c0), p1 = *(const float4*)(cw + j * 256 + c0 + 4);
            cwv[j][0] = p0.x; cwv[j][1] = p0.y; cwv[j][2] = p0.z; cwv[j][3] = p0.w; cwv[j][4] = p1.x; cwv[j][5] = p1.y; cwv[j][6] = p1.z; cwv[j][7] = p1.w; }
        const float4 a0 = *(const float4*)(og + lane * 8), a1 = *(const float4*)(og + lane * 8 + 4), b0 = *(const float4*)(og + 512 + lane * 8), b1 = *(const float4*)(og + 512 + lane * 8 + 4);
        ga[0] = a0.x; ga[1] = a0.y; ga[2] = a0.z; ga[3] = a0.w; ga[4] = a1.x; ga[5] = a1.y; ga[6] = a1.z; ga[7] = a1.w;
        gb[0] = b0.x; gb[1] = b0.y; gb[2] = b0.z; gb[3] = b0.w; gb[4] = b1.x; gb[5] = b1.y; gb[6] = b1.z; gb[7] = b1.w;
    }
#pragma unroll 8
    for (int rr = 0; rr < 16; ++rr) {
        const int row = w * 16 + rr, t = tile * 128 + row, pos = t & (S - 1);
        float a[8], y[8];
        unpack8(*(const u32x4*)(OR + (unsigned)(t * 512 + lane * 8)), a);
        float ssa = 0.f;
#pragma unroll
        for (int q = 0; q < 8; ++q) ssa += a[q] * a[q];
        ssa = wave_sum(ssa);
        {
            const int c0 = (lane & 31) * 8;
            float cb[8], z0[8], z1[8], z2[8], ys[8];
            const float m1 = pos >= 1 ? 1.f : 0.f, m2 = pos >= 2 ? 1.f : 0.f;
            const int t1 = pos >= 1 ? t - 1 : t, t2 = pos >= 2 ? t - 2 : t;
            unpack8(*(const u32x4*)(CBR + (unsigned)(t * 256 + c0)), cb);
            unpack8(*(const u32x4*)(ZR + (unsigned)(t * 256 + c0)), z2);
            unpack8(*(const u32x4*)(ZR + (unsigned)(t1 * 256 + c0)), z1);
            unpack8(*(const u32x4*)(ZR + (unsigned)(t2 * 256 + c0)), z0);
            unpack8(*(const u32x4*)(YS + (unsigned)(t * 256 + c0)), ys);
#pragma unroll
            for (int q = 0; q < 8; ++q) {
                const float yc = cb[q] * (cwv[0][q] * (z0[q] * m2) + cwv[1][q] * (z1[q] * m1) + cwv[2][q] * z2[q]);
                y[q] = lane < 32 ? yc : ys[q];
            }
        }
        float ssy = 0.f;
#pragma unroll
        for (int q = 0; q < 8; ++q) ssy += y[q] * y[q];
        ssy = red32_sum(ssy);
        const float ra = rsqrtf(ssa * (1.f / 512.f) + EPS), ry = rsqrtf(ssy * (1.f / 256.f) + EPS);
        const int mb = row >> 5, r5 = row & 31;
        {
            u32x4 o; o.x = pk2(a[0] * ra * ga[0], a[1] * ra * ga[1]); o.y = pk2(a[2] * ra * ga[2], a[3] * ra * ga[3]); o.z = pk2(a[4] * ra * ga[4], a[5] * ra * ga[5]); o.w = pk2(a[6] * ra * ga[6], a[7] * ra * ga[7]);
            const int c8 = lane;
            (void)c8;
            *(u32x4*)(mA + (unsigned)(t * 1024 + lane * 8)) = o;
        }
        {
            u32x4 o; o.x = pk2(y[0] * ry * gb[0], y[1] * ry * gb[1]); o.y = pk2(y[2] * ry * gb[2], y[3] * ry * gb[3]); o.z = pk2(y[4] * ry * gb[4], y[5] * ry * gb[5]); o.w = pk2(y[6] * ry * gb[6], y[7] * ry * gb[7]);
            const int c8 = 64 + lane;
            (void)c8;
            *(u32x4*)(mA + (unsigned)(t * 1024 + 512 + lane * 8)) = o;
        }
    }
}

struct InProjOut { bf16_t *QF, *KF2, *VF, *CBR, *ZR, *YS; };
DI void inproj_tile(const bf16_t* __restrict__ At, const bf16_t* __restrict__ WF, const float* __restrict__ qg, const float* __restrict__ kg, const bf16_t* __restrict__ SWF, const float* __restrict__ sgu_b,
                    const InProjOut& O, char* lds, int tile, int tid) {
    tid = opaque_v(tid); tile = opaque_s(tile);
    const int lane = tid & 63, w = __builtin_amdgcn_readfirstlane(tid >> 6);
    f32x16 acc[4][2];
    {
        const int nbt0 = w * 2;
        kloop<1>(acc, At, WF + (size_t)nbt0 * 32768, WF + (size_t)(nbt0 + 1) * 32768, lds, tid, lane);
        epi_qk(acc, qg, 0.125f, O.QF + (size_t)(tile * 8 + w) * 8192, lane);
    }
    {
        const int nbt0 = 16 + w * 2;
        if (w == 2 || w == 3) {
            kloop<0>(acc, At, WF + (size_t)nbt0 * 32768, WF + (size_t)(nbt0 + 1) * 32768, lds, tid, lane);
            epi_v(acc, O.VF + (size_t)(tile * 2 + (w - 2)) * 8192, lane);
        } else {
            kloop<1>(acc, At, WF + (size_t)nbt0 * 32768, WF + (size_t)(nbt0 + 1) * 32768, lds, tid, lane);
            if (w < 2) epi_qk(acc, kg, 1.f, O.KF2 + (size_t)(tile * 2 + w) * 8192, lane);
            else epi_row(acc, O.CBR + (size_t)tile * 128 * 256 + (w - 4) * 64, 256, lane);
        }
    }
    {
        const int nbt0 = 32 + w * 2;
        kloop<1>(acc, At, WF + (size_t)nbt0 * 32768, WF + (size_t)(nbt0 + 1) * 32768, lds, tid, lane);
        epi_z(acc, O.ZR + (size_t)tile * 128 * 256 + w * 32, lane);
    }
    {
        const int nbt0 = 48 + w * 2;
        kloop<0>(acc, At, WF + (size_t)nbt0 * 32768, WF + (size_t)(nbt0 + 1) * 32768, lds, tid, lane);
        unsigned* lds_su = (unsigned*)lds;
        if (w < 4) epi_su_park(acc, lds_su + w * 4096, lane);
        __syncthreads();
        if (w >= 4) epi_sv(acc, SWF + (size_t)(w - 4) * 16384, sgu_b + (w - 4) * 128, lds_su + (w - 4) * 4096, O.YS + (size_t)tile * 128 * 256 + (w - 4) * 64, lane);
        __syncthreads();
    }
}


struct Params {
    const float *x, *c, *rel_bias, *w_ada, *b_ada, *norm1_g, *norm2_g, *w_in, *q_norm_g, *k_norm_g, *attn_sink, *conv_w, *sgu_w, *sgu_b, *out_norm_g, *w_out, *peer_wq, *peer_sub_keys, *peer_down, *peer_up;
    float* out;
    char* ws;
};
constexpr size_t MiB = 1u << 20;
constexpr size_t WS_MOD = 0;
constexpr size_t WS_MODP = 1 * MiB;
constexpr size_t WS_WIN = 13 * MiB;
constexpr size_t WS_WOUT = 29 * MiB;
constexpr size_t WS_WPQ = 37 * MiB;
constexpr size_t WS_KEYS = 53 * MiB;
constexpr size_t WS_SWF = 55 * MiB;
constexpr size_t WS_SC = 56 * MiB;
constexpr size_t WS_TB = 57 * MiB;
constexpr size_t WS_HA = 185 * MiB;
constexpr size_t WS_QF = 249 * MiB;
constexpr size_t WS_KF2 = 602 * MiB;
constexpr size_t WS_VF = 634 * MiB;
constexpr size_t WS_ZR = 666 * MiB;
constexpr size_t WS_CBR = 345 * MiB;
constexpr size_t WS_YS = 361 * MiB;
constexpr size_t WS_OR = 377 * MiB;
constexpr size_t WS_QPF = 409 * MiB;
constexpr size_t WS_RIDX = 537 * MiB;
constexpr size_t WS_RGATE = 553 * MiB;
constexpr size_t WS_SEID = 569 * MiB;
constexpr size_t WS_SWGT = 585 * MiB;
constexpr size_t WS_OFFS = 601 * MiB;
constexpr size_t WS_FLAGS = 601 * MiB + 512 * 1024;
constexpr size_t WS_END = 730 * MiB;
static_assert(PL_END <= LDS_RSTD1, "expert-phase lists overlap persistent LDS state");

__global__ __launch_bounds__(512) void hybrid_fwd(Params P) {
    extern __shared__ __attribute__((aligned(16))) char lds[];
    cg::grid_group grid = cg::this_grid();
    const int tid = threadIdx.x, lane = tid & 63, w = __builtin_amdgcn_readfirstlane(tid >> 6);
    const int nblk = gridDim.x, hwb = blockIdx.x;
    const int bid = (nblk == NTILE) ? (hwb & 7) * 32 + (hwb >> 3) : hwb;
    char* ws = P.ws;
    float* mod = (float*)(ws + WS_MOD);
    float* modp = (float*)(ws + WS_MODP);
    bf16_t* WinF = (bf16_t*)(ws + WS_WIN); bf16_t* WoutF = (bf16_t*)(ws + WS_WOUT); bf16_t* WpqF = (bf16_t*)(ws + WS_WPQ);
    bf16_t* KeysF = (bf16_t*)(ws + WS_KEYS); bf16_t* SWF = (bf16_t*)(ws + WS_SWF);
    float* SC = (float*)(ws + WS_SC); unsigned char* TBd = (unsigned char*)(ws + WS_TB); unsigned char* TBu = TBd + 32 * MiB;
    bf16_t* hA = (bf16_t*)(ws + WS_HA);
    bf16_t* OR = (bf16_t*)(ws + WS_OR); bf16_t* QPF = (bf16_t*)(ws + WS_QPF);
    int* ridx = (int*)(ws + WS_RIDX); float* rgate = (float*)(ws + WS_RGATE);
    float* bias_lds = (float*)(lds + LDS_BIAS);
    unsigned* flags = (unsigned*)(ws + WS_FLAGS);

    {
        float* ca = (float*)lds;
        if (tid == 0) for (int tile = bid; tile < NTILE; tile += nblk) __hip_atomic_store(flags + tile, 0u, __ATOMIC_RELAXED, __HIP_MEMORY_SCOPE_AGENT);
        for (int i = tid; i < 8192; i += 512) { const float v = P.c[i]; ca[i] = v / (1.f + __expf(-v)); }
        for (int i = tid; i < 1024; i += 512) bias_lds[i] = P.rel_bias[t5_bucket(i & 127) * 8 + (i >> 7)];
        __syncthreads();
        for (int it = bid; it < 768; it += nblk) {
            const int jc = it % 12, l = (it / 12) & 3, ks = it / 48;
            const int j = jc * 512 + tid;
            const float* wp = P.w_ada + ((size_t)l * 1024 + ks * 64) * 6144 + j;
            float acc[8];
#pragma unroll
            for (int b = 0; b < 8; ++b) acc[b] = 0.f;
#pragma unroll 4
            for (int i = 0; i < 64; ++i) {
                const float wv = wp[(size_t)i * 6144];
#pragma unroll
                for (int b = 0; b < 8; ++b) acc[b] += ca[b * 1024 + ks * 64 + i] * wv;
            }
#pragma unroll
            for (int b = 0; b < 8; ++b) modp[((size_t)(ks * 4 + l) * 8 + b) * 6144 + j] = acc[b];
        }
        const int gthreads = nblk * 512, gtid = bid * 512 + tid;
        for (int rep = 0; rep < REP_P0; ++rep)
        for (int l = 0; l < DEPTH; ++l) {
            for (int g = gtid; g < 64 * 64 * 64; g += gthreads) conv_wfrag_item(P.w_in + (size_t)l * 1024 * 2048, 2048, 64, WinF + (size_t)l * 2097152, g, 1);
            for (int g = gtid; g < 32 * 64 * 64; g += gthreads) conv_wfrag_item(P.w_out + (size_t)l * 1024 * 1024, 1024, 64, WoutF + (size_t)l * 1048576, g, 0);
            for (int g = gtid; g < 64 * 64 * 64; g += gthreads) conv_wfrag_item(P.peer_wq + (size_t)l * 1024 * 2048, 2048, 64, WpqF + (size_t)l * 2097152, g, 0);
            for (int g = gtid; g < 32768; g += gthreads) conv_keys_item(P.peer_sub_keys + (size_t)l * 262144, KeysF + (size_t)l * 262144, g);
            for (int g = gtid; g < 8192; g += gthreads) conv_sguw_item(P.sgu_w + (size_t)l * 65536, SWF + (size_t)l * 65536, g);
        }
        const int gwaves = nblk * 8, gw = bid * 8 + w;
        for (int rep = 0; rep < REP_P0; ++rep)
        for (int r = gw; r < DEPTH * 16384 * 2; r += gwaves) {
            const int which = r & 1, le = r >> 1;
            conv_table_row((which ? P.peer_up : P.peer_down) + (size_t)le * D, (which ? TBu : TBd) + (size_t)le * 512, SC + (size_t)le * 2 + which, lane, which == 0);
        }
    }
    grid.sync();
    for (int tile = bid; tile < NTILE; tile += nblk) {
        const int b = tile >> 5;
        for (int l = 0; l < DEPTH; ++l)
            for (int j = tid; j < 6144; j += 512) {
                float v = P.b_ada[l * 6144 + j];
#pragma unroll
                for (int ks = 0; ks < 16; ++ks) v += modp[((size_t)(ks * 4 + l) * 8 + b) * 6144 + j];
                mod[((size_t)l * 8 + b) * 6144 + j] = v;
            }
    }
    __syncthreads();

    for (int l = 0; l < DEPTH; ++l) {
        const float* xin = l == 0 ? P.x : P.out;
        InProjOut IO;
        IO.QF = (bf16_t*)(ws + WS_QF); IO.KF2 = (bf16_t*)(ws + WS_KF2 + (size_t)l * 8 * MiB); IO.VF = (bf16_t*)(ws + WS_VF + (size_t)l * 8 * MiB);
        IO.CBR = (bf16_t*)(ws + WS_CBR); IO.ZR = (bf16_t*)(ws + WS_ZR + (size_t)l * 16 * MiB); IO.YS = (bf16_t*)(ws + WS_YS);
        for (int tile = bid; tile < NTILE; tile += nblk) {
            const float* mb_ = mod + ((size_t)l * 8 + (tile >> 5)) * 6144;
            if (l == 0) {
                norm_to_frag(xin, P.norm1_g + l * D, mb_ + 0, mb_ + 1024, hA, (float*)lds, tile, tid, false);
                __syncthreads();
            }
            for (int rep = 0; rep < REP_GEMM; ++rep) inproj_tile(hA + (size_t)tile * 131072, WinF + (size_t)l * 2097152, P.q_norm_g + l * 64, P.k_norm_g + l * 64, SWF + (size_t)l * 65536, P.sgu_b + l * 512, IO, lds, tile, tid);
            asm volatile("s_waitcnt vmcnt(0)" ::: "memory");
            __syncthreads();
            if (tid == 0) {
                __builtin_amdgcn_fence(__ATOMIC_RELEASE, "agent");
                asm volatile("s_waitcnt vmcnt(0)" ::: "memory");
                __hip_atomic_store(flags + tile, (unsigned)(l + 1), __ATOMIC_RELAXED, __HIP_MEMORY_SCOPE_AGENT);
            }
        }
        for (int tile = bid; tile < NTILE; tile += nblk) {
            const float* mb_ = mod + ((size_t)l * 8 + (tile >> 5)) * 6144;
            if ((tile & 31) != 0) {
                if (tid == 0) {
                    unsigned spins = 0;
                    while (__hip_atomic_load(flags + tile - 1, __ATOMIC_RELAXED, __HIP_MEMORY_SCOPE_AGENT) < (unsigned)(l + 1) && ++spins < (1u << 24)) __builtin_amdgcn_s_sleep(2);
                    __builtin_amdgcn_fence(__ATOMIC_ACQUIRE, "agent");
                    asm volatile("s_waitcnt vmcnt(0)" ::: "memory");
                }
                __syncthreads();
            }
            for (int rep = 0; rep < REP_MIX; ++rep) {
            attn_tile(IO.QF, IO.KF2, IO.VF, lds, bias_lds, P.attn_sink + l * 8, OR, tile, tid);
            __syncthreads();
            merge_tile(OR, IO.CBR, IO.ZR, IO.YS, P.conv_w + l * 768, P.out_norm_g + l * D, hA, tile, tid);
            __syncthreads();
            }
            {
                const bf16_t* At = hA + (size_t)tile * 131072;
                const bf16_t* WF = WoutF + (size_t)l * 1048576;
                for (int pass = 0; pass < 2; ++pass) {
                    f32x16 acc[4][2];
                    const int nbt0 = pass * 16 + w * 2;
                    kloop<0>(acc, At, WF + (size_t)nbt0 * 32768, WF + (size_t)(nbt0 + 1) * 32768, lds, tid, lane);
                    epi_resid(acc, xin, P.out, mb_ + 2048, (float*)(lds + LDS_EPI) + w * 2176, (float*)(lds + LDS_SSQ) + (pass * 8 + w) * 128, tile, pass * 512 + w * 64, lane);
                }
            }
            __syncthreads();
            if (tid < 128) { const float* sq = (const float*)(lds + LDS_SSQ); float ssum = 0.f;
#pragma unroll
                for (int c = 0; c < 16; ++c) ssum += sq[c * 128 + tid];
                ((float*)lds)[tid] = rsqrtf(ssum * (1.f / D) + EPS); }
            __syncthreads();
            norm_to_frag(P.out, P.norm2_g + l * D, mb_ + 3072, mb_ + 4096, hA, (float*)lds, tile, tid, true);
            __syncthreads();
            {
                const bf16_t* At = hA + (size_t)tile * 131072;
                const bf16_t* WF = WpqF + (size_t)l * 2097152;
                for (int rep = 0; rep < REP_GEMM; ++rep)
                for (int pass = 0; pass < 4; ++pass) {
                    f32x16 acc[4][2];
                    const int nbt0 = pass * 16 + w * 2;
                    kloop<1>(acc, At, WF + (size_t)nbt0 * 32768, WF + (size_t)(nbt0 + 1) * 32768, lds, tid, lane);
                    epi_qpf(acc, QPF, tile, nbt0, lane);
                }
            }
            __syncthreads();
            for (int rep = 0; rep < REP_ROUTE; ++rep) { route_tile(QPF, KeysF + (size_t)l * 262144, lds, (unsigned char*)lds + PL_RIDX, tile, tid); __syncthreads(); }
            peer_down_wave(hA, lds, TBd + (size_t)l * 16384 * 512, SC + (size_t)l * 32768, tile, w, lane);
            __syncthreads();
            {
                const float* mbn = mod + ((size_t)(l + 1 < DEPTH ? l + 1 : l) * 8 + (tile >> 5)) * 6144;
                peer_up_wave(lds, TBu + (size_t)l * 16384 * 512, mb_ + 5120, P.out, tile, w, lane, l + 1 < DEPTH ? hA : nullptr, P.norm1_g + (l + 1 < DEPTH ? l + 1 : l) * D, mbn + 0, mbn + 1024);
            }
            __syncthreads();
        }
    }
}
}

extern "C" void kernel_launch(void* const* d_in, const int* in_sizes, int n_in, void* d_out, int out_size, void* d_ws, size_t ws_size, hipStream_t stream) {
    using namespace op;
    static int grid_blocks = 0;
    if (!grid_blocks) {
        int dev = 0, cus = 0, per_cu = 0;
        (void)hipGetDevice(&dev);
        (void)hipDeviceGetAttribute(&cus, hipDeviceAttributeMultiprocessorCount, dev);
        (void)hipFuncSetAttribute((const void*)hybrid_fwd, hipFuncAttributeMaxDynamicSharedMemorySize, LDS_BYTES);
        (void)hipOccupancyMaxActiveBlocksPerMultiprocessor(&per_cu, (const void*)hybrid_fwd, 512, LDS_BYTES);
        if (per_cu < 1) per_cu = 1;
        grid_blocks = cus * per_cu;
        if (grid_blocks > NTILE) grid_blocks = NTILE;
        if (ws_size < WS_END) { fprintf(stderr, "kernel_launch: workspace too small (%zu < %zu)\n", ws_size, (size_t)WS_END); grid_blocks = -1; }
    }
    if (grid_blocks < 0) return;
    Params p{};
    p.x = (const float*)d_in[0]; p.c = (const float*)d_in[1]; p.rel_bias = (const float*)d_in[2]; p.w_ada = (const float*)d_in[3]; p.b_ada = (const float*)d_in[4];
    p.norm1_g = (const float*)d_in[5]; p.norm2_g = (const float*)d_in[6]; p.w_in = (const float*)d_in[7]; p.q_norm_g = (const float*)d_in[8]; p.k_norm_g = (const float*)d_in[9];
    p.attn_sink = (const float*)d_in[10]; p.conv_w = (const float*)d_in[11]; p.sgu_w = (const float*)d_in[12]; p.sgu_b = (const float*)d_in[13]; p.out_norm_g = (const float*)d_in[14];
    p.w_out = (const float*)d_in[15]; p.peer_wq = (const float*)d_in[16]; p.peer_sub_keys = (const float*)d_in[17]; p.peer_down = (const float*)d_in[18]; p.peer_up = (const float*)d_in[19];
    p.out = (float*)d_out; p.ws = (char*)d_ws;
    void* args[] = {&p};
    hipError_t e = hipLaunchCooperativeKernel((const void*)hybrid_fwd, dim3(grid_blocks), dim3(512), args, LDS_BYTES, stream);
    if (e != hipSuccess) fprintf(stderr, "kernel_launch: cooperative launch failed: %s (grid %d)\n", hipGetErrorString(e), grid_blocks);
}
```

```cpp
#include <hip/hip_runtime.h>
#include <cstdio>
#include <cstdint>
#include <hip/hip_cooperative_groups.h>
namespace cg = cooperative_groups;


namespace op {
#define DI __device__ __forceinline__
typedef unsigned short bf16_t;
typedef short bf16x8 __attribute__((ext_vector_type(8)));
typedef float f32x16 __attribute__((ext_vector_type(16)));
typedef float f32x2 __attribute__((ext_vector_type(2)));
typedef unsigned u32x4 __attribute__((ext_vector_type(4)));
typedef unsigned u32x2 __attribute__((ext_vector_type(2)));
typedef __bf16 bf16v2 __attribute__((ext_vector_type(2)));
constexpr int D = 1024, NB = 8, S = 4096, DEPTH = 4, T = NB * S, NTILE = T / 128;
constexpr float EPS = 1e-6f;
constexpr int PL_SEID = 0, PL_SWGT = 32768, PL_END = 98304, PL_RIDX = 98304;
constexpr int LDS_EPI = 32768, LDS_SSQ = 102400, LDS_RSTD1 = 110592, LDS_BIAS = 128 * 1024, LDS_BYTES = 132 * 1024;
constexpr int REP_GEMM = 1, REP_ROUTE = 1, REP_MIX = 1, REP_NORM = 1, REP_P0 = 1;
#define MFMA32(a, b, c) __builtin_amdgcn_mfma_f32_32x32x16_bf16((a), (b), (c), 0, 0, 0)

DI unsigned pk2(float lo, float hi) { f32x2 v = {lo, hi}; return __builtin_bit_cast(unsigned, __builtin_convertvector(v, bf16v2)); }
DI int opaque_v(int x) { asm volatile("" : "+v"(x)); return x; }
DI int opaque_s(int x) { asm volatile("" : "+s"(x)); return x; }
DI int crow(int reg, int hh) { return (reg & 3) + 8 * (reg >> 2) + 4 * hh; }
template <int CTRL> DI float dppf(float v) { return __int_as_float(__builtin_amdgcn_update_dpp(0, __float_as_int(v), CTRL, 0xf, 0xf, true)); }
template <int CTRL> DI int dppi(int v) { return __builtin_amdgcn_update_dpp(0, v, CTRL, 0xf, 0xf, true); }
DI float red16_sum(float v) { v += dppf<0xB1>(v); v += dppf<0x4E>(v); v += dppf<0x141>(v); v += dppf<0x140>(v); return v; }
DI float red16_max(float v) { v = fmaxf(v, dppf<0xB1>(v)); v = fmaxf(v, dppf<0x4E>(v)); v = fmaxf(v, dppf<0x141>(v)); v = fmaxf(v, dppf<0x140>(v)); return v; }
DI float x16_sum(float v) { auto s = __builtin_amdgcn_permlane16_swap(__float_as_uint(v), __float_as_uint(v), false, false); return __uint_as_float(s[0]) + __uint_as_float(s[1]); }
DI float x32_sum(float v) { auto s = __builtin_amdgcn_permlane32_swap(__float_as_uint(v), __float_as_uint(v), false, false); return __uint_as_float(s[0]) + __uint_as_float(s[1]); }
DI float x16_max(float v) { auto s = __builtin_amdgcn_permlane16_swap(__float_as_uint(v), __float_as_uint(v), false, false); return fmaxf(__uint_as_float(s[0]), __uint_as_float(s[1])); }
DI float x32_max(float v) { auto s = __builtin_amdgcn_permlane32_swap(__float_as_uint(v), __float_as_uint(v), false, false); return fmaxf(__uint_as_float(s[0]), __uint_as_float(s[1])); }
DI float red32_sum(float v) { return x16_sum(red16_sum(v)); }
DI float wave_sum(float v) { return x32_sum(x16_sum(red16_sum(v))); }
DI float wave_max(float v) { return x32_max(x16_max(red16_max(v))); }

DI int col_perm(int npos, int mode) {
    if (mode == 1 && npos >= 1024 && npos < 1536) { const int q = npos - 1024, w = q >> 6, nb = (q >> 5) & 1, r = q & 31; return (nb ? 1280 : 1024) + 32 * w + r; }
    return npos;
}
DI void conv_wfrag_item(const float* __restrict__ W, int N, int KB, bf16_t* __restrict__ WF, int gid, int mode) {
    const int l = gid & 63, kb = (gid >> 6) % KB, nbt = (gid >> 6) / KB, r = l & 31, hh = l >> 5;
    const int n = col_perm(nbt * 32 + r, mode);
    const float* p = W + (size_t)(kb * 16 + 8 * hh) * N + n;
    float v[8];
#pragma unroll
    for (int j = 0; j < 8; ++j) v[j] = p[(size_t)j * N];
    u32x4 o; o.x = pk2(v[0], v[1]); o.y = pk2(v[2], v[3]); o.z = pk2(v[4], v[5]); o.w = pk2(v[6], v[7]);
    *(u32x4*)(WF + (size_t)gid * 8) = o;
}

DI void norm_to_frag(const float* __restrict__ x, const float* __restrict__ g, const float* __restrict__ sh, const float* __restrict__ sc, bf16_t* __restrict__ hA, float* rstd_lds, int tile, int tid, bool have_rstd) {
    tid = opaque_v(tid); tile = opaque_s(tile);
    const int w = tid >> 6, lane = tid & 63;
    float cg[16], cs[16], ch[16];
#pragma unroll
    for (int j = 0; j < 2; ++j)
#pragma unroll
        for (int q = 0; q < 2; ++q) {
            const int c = 512 * j + 8 * lane + 4 * q;
            const float4 a = *(const float4*)(g + c), b = *(const float4*)(sc + c), d = *(const float4*)(sh + c);
            cg[8 * j + 4 * q] = a.x * (1.f + b.x); cg[8 * j + 4 * q + 1] = a.y * (1.f + b.y); cg[8 * j + 4 * q + 2] = a.z * (1.f + b.z); cg[8 * j + 4 * q + 3] = a.w * (1.f + b.w);
            ch[8 * j + 4 * q] = d.x; ch[8 * j + 4 * q + 1] = d.y; ch[8 * j + 4 * q + 2] = d.z; ch[8 * j + 4 * q + 3] = d.w;
            cs[8 * j + 4 * q] = 0.f; cs[8 * j + 4 * q + 1] = 0.f; cs[8 * j + 4 * q + 2] = 0.f; cs[8 * j + 4 * q + 3] = 0.f;
        }
    (void)cs;
#pragma unroll 8
    for (int rr = 0; rr < 16; ++rr) {
        const int row = w * 16 + rr;
        const float* xr = x + ((size_t)tile * 128 + row) * D + 8 * lane;
        float v[16];
#pragma unroll
        for (int j = 0; j < 2; ++j)
#pragma unroll
            for (int q = 0; q < 2; ++q) { const float4 a = *(const float4*)(xr + 512 * j + 4 * q); v[8 * j + 4 * q] = a.x; v[8 * j + 4 * q + 1] = a.y; v[8 * j + 4 * q + 2] = a.z; v[8 * j + 4 * q + 3] = a.w; }
        float r;
        if (have_rstd) r = rstd_lds[row];
        else {
            float ss = 0.f;
#pragma unroll
            for (int e = 0; e < 16; ++e) ss += v[e] * v[e];
            r = rsqrtf(wave_sum(ss) * (1.f / D) + EPS);
        }
        bf16_t* orow = hA + ((size_t)tile * 128 + row) * D + 8 * lane;
#pragma unroll
        for (int j = 0; j < 2; ++j) {
            u32x4 o;
            o.x = pk2(v[8 * j] * r * cg[8 * j] + ch[8 * j], v[8 * j + 1] * r * cg[8 * j + 1] + ch[8 * j + 1]);
            o.y = pk2(v[8 * j + 2] * r * cg[8 * j + 2] + ch[8 * j + 2], v[8 * j + 3] * r * cg[8 * j + 3] + ch[8 * j + 3]);
            o.z = pk2(v[8 * j + 4] * r * cg[8 * j + 4] + ch[8 * j + 4], v[8 * j + 5] * r * cg[8 * j + 5] + ch[8 * j + 5]);
            o.w = pk2(v[8 * j + 6] * r * cg[8 * j + 6] + ch[8 * j + 6], v[8 * j + 7] * r * cg[8 * j + 7] + ch[8 * j + 7]);
            *(u32x4*)(orow + 512 * j) = o;
        }
    }
}

template <int ORIENT>
DI void kloop(f32x16 (&acc)[4][2], const bf16_t* __restrict__ At, const bf16_t* __restrict__ W0, const bf16_t* __restrict__ W1, char* lds, int tid, int lane) {
    tid = opaque_v(tid); lane = opaque_v(lane);
#pragma unroll
    for (int mb = 0; mb < 4; ++mb)
#pragma unroll
        for (int nb = 0; nb < 2; ++nb)
#pragma unroll
            for (int i = 0; i < 16; ++i) acc[mb][nb][i] = 0.f;
    {
    const int c8_ = (tid >> 3) & 7, rowA_ = (tid >> 6) * 8 + (tid & 7);
    const u32x4* Ag = (const u32x4*)(At + (unsigned)(rowA_ * 1024 + c8_ * 8));
    const int ldsA_ = ((((c8_ >> 1) * 4 + (rowA_ >> 5)) * 64) + (rowA_ & 31) + 32 * (c8_ & 1)) * 16;
    const u32x4* W0g = (const u32x4*)W0 + lane;
    const u32x4* W1g = (const u32x4*)W1 + lane;
    u32x4 wq[4][2], arA[2], arB[2];
    arA[0] = Ag[0]; arA[1] = Ag[8192]; arB[0] = Ag[8]; arB[1] = Ag[8 + 8192];
#pragma unroll
    for (int kk = 0; kk < 4; ++kk) { wq[kk][0] = W0g[kk * 64]; wq[kk][1] = W1g[kk * 64]; }
    *(u32x4*)(lds + ldsA_) = arA[0]; *(u32x4*)(lds + ldsA_ + 2048) = arA[1];
    __syncthreads();
#define KL_ITER(KC, ARL, ARS) do { \
        char* cur = lds + ((KC) & 1) * 16384; \
        char* nxt = lds + (((KC) + 1) & 1) * 16384; \
        const int kn = (KC) < 15 ? (KC) + 1 : 15, k2 = (KC) < 14 ? (KC) + 2 : 15; \
        if ((KC) < 14) { ARL[0] = Ag[k2 * 8]; ARL[1] = Ag[k2 * 8 + 8192]; } \
        __builtin_amdgcn_sched_barrier(0); \
        bf16x8 afr[2][4]; \
        _Pragma("unroll") for (int mb = 0; mb < 4; ++mb) afr[0][mb] = *(const bf16x8*)(cur + ((0 * 4 + mb) * 64 + lane) * 16); \
        _Pragma("unroll") for (int kk = 0; kk < 4; ++kk) { \
            if (kk < 3) { _Pragma("unroll") for (int mb = 0; mb < 4; ++mb) afr[(kk + 1) & 1][mb] = *(const bf16x8*)(cur + (((kk + 1) * 4 + mb) * 64 + lane) * 16); } \
            _Pragma("unroll") for (int mb = 0; mb < 4; ++mb) \
                _Pragma("unroll") for (int nb = 0; nb < 2; ++nb) { \
                    const bf16x8 wf = __builtin_bit_cast(bf16x8, wq[kk][nb]); \
                    if (ORIENT == 0) acc[mb][nb] = MFMA32(afr[kk & 1][mb], wf, acc[mb][nb]); \
                    else acc[mb][nb] = MFMA32(wf, afr[kk & 1][mb], acc[mb][nb]); \
                } \
            if ((KC) < 15) { wq[kk][0] = W0g[(kn * 4 + kk) * 64]; wq[kk][1] = W1g[(kn * 4 + kk) * 64]; } \
            __builtin_amdgcn_sched_barrier(0); \
        } \
        if ((KC) < 15) { *(u32x4*)(nxt + ldsA_) = ARS[0]; *(u32x4*)(nxt + ldsA_ + 2048) = ARS[1]; } \
        __syncthreads(); \
    } while (0)
    for (int kc = 0; kc < 16; kc += 2) { KL_ITER(kc, arA, arB); KL_ITER(kc + 1, arB, arA); }
#undef KL_ITER
    }
}

DI void epi_f32row(const f32x16 (&acc)[4][2], float* __restrict__ C, int tile, int col0, int lane) {
    lane = opaque_v(lane);
    const int r5 = lane & 31, hh = lane >> 5;
    const unsigned boff = (unsigned)((tile * 128 + 4 * hh) * 2048 + col0 + r5);
#pragma unroll
    for (int mb = 0; mb < 4; ++mb)
#pragma unroll
        for (int nb = 0; nb < 2; ++nb)
#pragma unroll
            for (int i = 0; i < 16; ++i)
                C[boff + (unsigned)((mb * 32 + (i & 3) + 8 * (i >> 2)) * 2048 + nb * 32)] = acc[mb][nb][i];
}
DI void epi_resid(const f32x16 (&acc)[4][2], const float* __restrict__ xin, float* __restrict__ xout, const float* __restrict__ gate_b, float* T  , float* ssq  , int tile, int col0, int lane) {
    lane = opaque_v(lane);
    const int r5 = lane & 31, hh = lane >> 5, rq = lane >> 4, c4 = (lane & 15) * 4;
    const float4 gv = *(const float4*)(gate_b + col0 + c4);
#pragma unroll
    for (int mb = 0; mb < 4; ++mb) {
#pragma unroll
        for (int nb = 0; nb < 2; ++nb)
#pragma unroll
            for (int i = 0; i < 16; ++i) T[((i & 3) + 8 * (i >> 2) + 4 * hh) * 68 + nb * 32 + r5] = acc[mb][nb][i];
        asm volatile("s_waitcnt lgkmcnt(0)" ::: "memory");
#pragma unroll
        for (int j = 0; j < 8; ++j) {
            const int row = rq + 4 * j;
            const float4 v = *(const float4*)(T + row * 68 + c4);
            const unsigned o = (unsigned)((tile * 128 + mb * 32 + row) * D + col0 + c4);
            float4 xv = *(const float4*)(xin + o);
            xv.x += gv.x * v.x; xv.y += gv.y * v.y; xv.z += gv.z * v.z; xv.w += gv.w * v.w;
            *(float4*)(xout + o) = xv;
            float ss = xv.x * xv.x + xv.y * xv.y + xv.z * xv.z + xv.w * xv.w;
            ss = red16_sum(ss);
            if ((lane & 15) == 0) ssq[mb * 32 + row] = ss;
        }
        asm volatile("s_waitcnt lgkmcnt(0)" ::: "memory");
    }
}

DI void epi_qpf(const f32x16 (&acc)[4][2], bf16_t* __restrict__ QPF, int tile, int ft0, int lane) {
    lane = opaque_v(lane);
#pragma unroll
    for (int nb = 0; nb < 2; ++nb)
#pragma unroll
        for (int s = 0; s < 2; ++s)
#pragma unroll
            for (int mb = 0; mb < 4; ++mb) {
                const f32x16& a = acc[mb][nb];
                u32x4 o; o.x = pk2(a[8 * s], a[8 * s + 1]); o.y = pk2(a[8 * s + 2], a[8 * s + 3]); o.z = pk2(a[8 * s + 4], a[8 * s + 5]); o.w = pk2(a[8 * s + 6], a[8 * s + 7]);
                *(u32x4*)(QPF + ((unsigned)((((tile * 64 + ft0 + nb) * 2 + s) * 4 + mb) * 64 + lane)) * 8) = o;
            }
}

DI void conv_keys_item(const float* __restrict__ K, bf16_t* __restrict__ KF, int gid) {
    const int lane = gid & 63, s = (gid >> 6) & 1, nbl = (gid >> 7) & 3, nt = (gid >> 9) & 3, hp = gid >> 11;
    const int r = lane & 31, hh = lane >> 5;
    const float* p = K + ((size_t)hp * 128 + nt * 32 + r) * 128 + nbl * 32 + 16 * s + 4 * hh;
    const float4 a = *(const float4*)p, b = *(const float4*)(p + 8);
    u32x4 o; o.x = pk2(a.x, a.y); o.y = pk2(a.z, a.w); o.z = pk2(b.x, b.y); o.w = pk2(b.z, b.w);
    *(u32x4*)(KF + (size_t)gid * 8) = o;
}

DI void conv_table_row(const float* __restrict__ src, unsigned char* __restrict__ dst, float* __restrict__ sc, int lane, bool as_int4) {
    const float4* p = (const float4*)src + lane * 4;
    float4 v[4];
    float m = 0.f;
#pragma unroll
    for (int j = 0; j < 4; ++j) { v[j] = p[j]; m = fmaxf(m, fmaxf(fmaxf(fabsf(v[j].x), fabsf(v[j].y)), fmaxf(fabsf(v[j].z), fabsf(v[j].w)))); }
    m = wave_max(m);
    float scale = m > 0.f ? m * (1.f / 6.f) : 1.f;
    if (as_int4) {
        float ss = 0.f;
#pragma unroll
        for (int j = 0; j < 4; ++j) ss += v[j].x * v[j].x + v[j].y * v[j].y + v[j].z * v[j].z + v[j].w * v[j].w;
        ss = wave_sum(ss);
        const float sg = sqrtf(ss * (1.f / 1024.f));
        scale = fmaxf(sg * (1.f / 2.8f), m * (1.f / 16.f));
        if (!(scale > 0.f)) scale = 1.f;
    }
    const float inv = 1.f / scale;
    u32x2 o;
    unsigned* op = (unsigned*)&o;
#pragma unroll
    for (int j = 0; j < 2; ++j) {
        const float f[8] = {v[2 * j].x, v[2 * j].y, v[2 * j].z, v[2 * j].w, v[2 * j + 1].x, v[2 * j + 1].y, v[2 * j + 1].z, v[2 * j + 1].w};
        unsigned wv = 0;
        if (as_int4) {
#pragma unroll
            for (int e = 0; e < 8; ++e) { int q = __float2int_rn(f[e] * inv); q = q < -7 ? -7 : (q > 7 ? 7 : q); wv |= ((unsigned)q & 15u) << (4 * e); }
        } else {
            wv = __builtin_amdgcn_cvt_scalef32_pk_fp4_f32(wv, f[0] * inv, f[1] * inv, 1.0f, 0);
            wv = __builtin_amdgcn_cvt_scalef32_pk_fp4_f32(wv, f[2] * inv, f[3] * inv, 1.0f, 1);
            wv = __builtin_amdgcn_cvt_scalef32_pk_fp4_f32(wv, f[4] * inv, f[5] * inv, 1.0f, 2);
            wv = __builtin_amdgcn_cvt_scalef32_pk_fp4_f32(wv, f[6] * inv, f[7] * inv, 1.0f, 3);
        }
        op[j] = wv;
    }
    *(u32x2*)(dst + lane * 8) = o;
    if (lane == 0) *sc = scale;
}

DI void ce_desc(int& a, int& b) { const int mx = a > b ? a : b, mn = a > b ? b : a; a = mx; b = mn; }
DI void sort16_desc(int (&v)[16]) {
#pragma unroll
    for (int k = 2; k <= 16; k <<= 1)
#pragma unroll
        for (int j = k >> 1; j > 0; j >>= 1)
#pragma unroll
            for (int i = 0; i < 16; ++i) {
                const int l = i ^ j;
                if (l > i) { if ((i & k) == 0) ce_desc(v[i], v[l]); else ce_desc(v[l], v[i]); }
            }
}
DI void bitonic_merge16_desc(int (&v)[16]) {
#pragma unroll
    for (int j = 8; j > 0; j >>= 1)
#pragma unroll
        for (int i = 0; i < 16; ++i) { const int l = i ^ j; if (l > i) ce_desc(v[i], v[l]); }
}
DI void merge_top16(int (&a)[16], const int (&b)[16]) {
#pragma unroll
    for (int i = 0; i < 16; ++i) a[i] = a[i] > b[15 - i] ? a[i] : b[15 - i];
    bitonic_merge16_desc(a);
}
DI int f2ord(float f) { int b = __float_as_int(f); return b ^ ((b >> 31) & 0x7fffffff); }
DI float ord2f(int k) { return __int_as_float(k ^ ((k >> 31) & 0x7fffffff)); }

DI void route_tile(const bf16_t* __restrict__ QPF, const bf16_t* __restrict__ KF, char* lds_lists, unsigned char* lds_idx  , int tile, int tid) {
    tid = opaque_v(tid); tile = opaque_s(tile);
    const int lane = tid & 63, w = __builtin_amdgcn_readfirstlane(tid >> 6);
    const int r5 = lane & 31, hh = lane >> 5;
    unsigned char* myidx = lds_idx + w * 1024;
    for (int task = w; task < 32; task += 8) {
        const int h = task >> 2, tt = task & 3;
        f32x16 acc[2][4];
#pragma unroll
        for (int p = 0; p < 2; ++p)
#pragma unroll
            for (int nt = 0; nt < 4; ++nt)
#pragma unroll
                for (int i = 0; i < 16; ++i) acc[p][nt][i] = 0.f;
        {
            bf16x8 bq[3], ak[3][4];
#define ROUTE_LOAD(buf, step) do { const int p_ = (step) >> 3, ks_ = (step) & 7; \
                bq[buf] = *(const bf16x8*)(QPF + ((unsigned)((((tile * 64 + h * 8 + p_ * 4 + (ks_ >> 1)) * 2 + (ks_ & 1)) * 4 + tt) * 64 + lane)) * 8); \
                _Pragma("unroll") for (int nt = 0; nt < 4; ++nt) ak[buf][nt] = *(const bf16x8*)(KF + ((unsigned)(((((h * 2 + p_) * 4 + nt) * 8 + ks_) * 64) + lane)) * 8); } while (0)
            ROUTE_LOAD(0, 0);
            ROUTE_LOAD(1, 1);
#pragma unroll
            for (int step = 0; step < 16; ++step) {
                if (step < 14) ROUTE_LOAD((step + 2) % 3, step + 2);
#pragma unroll
                for (int nt = 0; nt < 4; ++nt) acc[step >> 3][nt] = MFMA32(ak[step % 3][nt], bq[step % 3], acc[step >> 3][nt]);
                __builtin_amdgcn_sched_barrier(0);
            }
#undef ROUTE_LOAD
        }
        int g[8][16];
#pragma unroll
        for (int nt = 0; nt < 4; ++nt)
#pragma unroll
            for (int i = 0; i < 16; ++i) {
                const unsigned a = __float_as_uint(acc[0][nt][i]), b = __float_as_uint(acc[1][nt][i]);
                auto sw = __builtin_amdgcn_permlane32_swap(a, b, false, false);
                const int n0 = nt * 32 + (i & 3) + 8 * (i >> 2);
                g[nt * 2 + (i >> 3)][i & 7] = (f2ord(__uint_as_float(sw[0])) & ~127) | n0;
                g[nt * 2 + (i >> 3)][8 + (i & 7)] = (f2ord(__uint_as_float(sw[1])) & ~127) | (n0 + 4);
            }
#pragma unroll
        for (int q = 0; q < 8; ++q) sort16_desc(g[q]);
        merge_top16(g[0], g[1]); merge_top16(g[2], g[3]); merge_top16(g[4], g[5]); merge_top16(g[6], g[7]);
        merge_top16(g[0], g[2]); merge_top16(g[4], g[6]);
        merge_top16(g[0], g[4]);
        {
            u32x4 pk;
            unsigned* pp = (unsigned*)&pk;
#pragma unroll
            for (int q = 0; q < 4; ++q) pp[q] = (unsigned)(g[0][4 * q] & 127) | ((unsigned)(g[0][4 * q + 1] & 127) << 8) | ((unsigned)(g[0][4 * q + 2] & 127) << 16) | ((unsigned)(g[0][4 * q + 3] & 127) << 24);
            *(u32x4*)(myidx + lane * 16) = pk;
        }
        float f0[16], f1[16];
#pragma unroll
        for (int i = 0; i < 16; ++i) {
            const unsigned a = (unsigned)g[0][i], b = a;
            auto sw = __builtin_amdgcn_permlane32_swap(a, b, false, false);
            f0[i] = ord2f((int)sw[0] & ~127); f1[i] = ord2f((int)sw[1] & ~127);
        }
        int c0[16], c1[16], c2[16], c3[16];
#pragma unroll
        for (int j = 0; j < 16; ++j) c0[j] = (f2ord(f0[0] + f1[j]) & ~255) | j;
#pragma unroll
        for (int i = 1; i < 16; ++i) c1[i - 1] = (f2ord(f0[i] + f1[0]) & ~255) | (i << 4);
        c1[15] = (int)0x80000000;
#define CK(i, j) ((f2ord(f0[i] + f1[j]) & ~255) | ((i) << 4) | (j))
        c2[0] = CK(1, 1); c2[1] = CK(1, 2); c2[2] = CK(1, 3); c2[3] = CK(1, 4); c2[4] = CK(1, 5); c2[5] = CK(1, 6); c2[6] = CK(1, 7);
        c2[7] = CK(2, 1); c2[8] = CK(2, 2); c2[9] = CK(2, 3); c2[10] = CK(2, 4);
        c2[11] = CK(3, 1); c2[12] = CK(3, 2); c2[13] = CK(3, 3);
        c2[14] = CK(4, 1); c2[15] = CK(4, 2);
        c3[0] = CK(5, 1); c3[1] = CK(6, 1); c3[2] = CK(7, 1);
#undef CK
#pragma unroll
        for (int q = 3; q < 16; ++q) c3[q] = (int)0x80000000;
        sort16_desc(c2);
        ce_desc(c3[0], c3[1]); ce_desc(c3[1], c3[2]); ce_desc(c3[0], c3[1]);
        merge_top16(c0, c1); merge_top16(c2, c3); merge_top16(c0, c2);
        float bs[16], den = 0.f;
#pragma unroll
        for (int i = 0; i < 16; ++i) { bs[i] = __expf(ord2f(c0[i] & ~255) - ord2f(c0[0] & ~255)); den += bs[i]; }
        const float rden = 1.f / den;
        asm volatile("s_waitcnt lgkmcnt(0)" ::: "memory");
#pragma unroll
        for (int q = 0; q < 8; ++q) {
            const int key = (int)__builtin_amdgcn_permlane32_swap((unsigned)c0[q], (unsigned)c0[8 + q], false, false)[0];
            const float gv = __uint_as_float(__builtin_amdgcn_permlane32_swap(__float_as_uint(bs[q]), __float_as_uint(bs[8 + q]), false, false)[0]) * rden;
            const int i = (key >> 4) & 15, j = key & 15;
            const int e = (int)myidx[r5 * 16 + i] * 128 + (int)myidx[(32 + r5) * 16 + j];
            const int tokl = tt * 32 + r5;
            ((unsigned short*)(lds_lists + PL_SEID))[tokl * 128 + h * 16 + 8 * hh + q] = (unsigned short)e;
            ((float*)(lds_lists + PL_SWGT))[tokl * 128 + h * 16 + 8 * hh + q] = gv;
        }
        asm volatile("s_waitcnt lgkmcnt(0)" ::: "memory");
    }
}

DI void unpack_h2(const bf16_t* __restrict__ hA, int t, int lane, f32x2 (&hv)[8]) {
    const int tile = t >> 7, row = t & 127, mb = row >> 5, r5 = row & 31;
    const bf16_t* hp = hA + ((unsigned)(((tile * 64 + lane) * 4 + mb) * 64 + r5)) * 8;
    const u32x4 ha = *(const u32x4*)hp, hb = *(const u32x4*)(hp + 32 * 8);
    const unsigned hw[8] = {ha.x, ha.y, ha.z, ha.w, hb.x, hb.y, hb.z, hb.w};
#pragma unroll
    for (int q = 0; q < 8; ++q) { hv[q].x = __uint_as_float(hw[q] << 16); hv[q].y = __uint_as_float(hw[q] & 0xffff0000u); }
}
typedef _Float16 h16x2 __attribute__((ext_vector_type(2)));
DI h16x2 fp4h(unsigned w, int sel) {
    return sel == 0 ? __builtin_amdgcn_cvt_scalef32_pk_f16_fp4(w, 1.0f, 0) : sel == 1 ? __builtin_amdgcn_cvt_scalef32_pk_f16_fp4(w, 1.0f, 1)
         : sel == 2 ? __builtin_amdgcn_cvt_scalef32_pk_f16_fp4(w, 1.0f, 2) : __builtin_amdgcn_cvt_scalef32_pk_f16_fp4(w, 1.0f, 3);
}
DI unsigned rowoff_lo(unsigned pr, unsigned k512, unsigned lane8) { unsigned r; asm("v_mad_u32_u16 %0, %1, %2, %3" : "=v"(r) : "v"(pr), "s"(k512), "v"(lane8)); return r; }
DI unsigned rowoff_hi(unsigned pr, unsigned k512, unsigned lane8) { unsigned r; asm("v_mad_u32_u16 %0, %1, %2, %3 op_sel:[1,0,0,0]" : "=v"(r) : "v"(pr), "s"(k512), "v"(lane8)); return r; }
DI int dot8z(int a, int b) { int r; asm("v_dot8_i32_i4 %0, %1, %2, 0" : "=v"(r) : "v"(a), "v"(b)); return r; }
DI void stage_token(const int* __restrict__ ridx, const float* __restrict__ rgate, char* lds, int t, int tloc, int lane) {
    lane = opaque_v(lane); t = opaque_s(t);
    unsigned short* seid = (unsigned short*)(lds + PL_SEID) + tloc * 128;
    float* swgt = (float*)(lds + PL_SWGT) + tloc * 128;
    seid[lane] = (unsigned short)ridx[(unsigned)(t * 128 + lane)]; seid[64 + lane] = (unsigned short)ridx[(unsigned)(t * 128 + 64 + lane)];
    swgt[lane] = rgate[(unsigned)(t * 128 + lane)]; swgt[64 + lane] = rgate[(unsigned)(t * 128 + 64 + lane)];
}
DI void peer_down_wave(const bf16_t* __restrict__ hA, char* lds, const unsigned char* __restrict__ TBd, const float* __restrict__ SC, int tile, int w, int lane) {
    lane = opaque_v(lane);
    const unsigned lane8 = (unsigned)lane * 8u;
    const int myu = ((lane >> 5) & 1) * 8 + ((lane >> 4) & 1) * 4 + ((lane >> 3) & 1) * 2 + ((lane >> 2) & 1);
    const unsigned short* seid = (const unsigned short*)(lds + PL_SEID) + w * 16 * 128;
    float* swgt = (float*)(lds + PL_SWGT) + w * 16 * 128;
    u32x4 haN, hbN;
    { const bf16_t* hp0 = hA + (unsigned)((tile * 128 + w * 16) * 1024 + lane * 16); haN = *(const u32x4*)hp0; hbN = *(const u32x4*)(hp0 + 8); }
    u32x2 R[2][16];
    u32x4 ID[2];
#define DOWN_IDS(P_) do { ID[0] = *(const u32x4*)(seid + (P_)); ID[1] = *(const u32x4*)(seid + (P_) + 8); } while (0)
#define DOWN_LOADS(buf, P_) do { _Pragma("unroll") for (int u_ = 0; u_ < 16; ++u_) { const unsigned pr_ = ID[u_ >> 3][(u_ >> 1) & 3]; \
        const unsigned off_ = (u_ & 1) ? rowoff_hi(pr_, 512u, lane8) : rowoff_lo(pr_, 512u, lane8); R[buf][u_] = *(const u32x2*)(TBd + off_); } } while (0)
    DOWN_IDS(0); DOWN_LOADS(0, 0); DOWN_IDS(16);
#pragma unroll 1
    for (int tl = 0; tl < 16; ++tl) {
        const int t = tile * 128 + w * 16 + tl;
        float* gp = swgt + tl * 128;
        const u32x4 ha = haN, hb = hbN;
        const int tn = tl < 15 ? tl + 1 : tl;
        const int pa_ = tl * 128 + (lane & 3) * 32 + myu;
        const f32x2 scA = *(const f32x2*)(SC + (unsigned)seid[pa_] * 2u), scB = *(const f32x2*)(SC + (unsigned)seid[pa_ + 16] * 2u);
        int rs[8];
        { const bf16_t* hp = hA + (unsigned)((t - tl + tn) * 1024 + lane * 16); haN = *(const u32x4*)hp; hbN = *(const u32x4*)(hp + 8); }
        unsigned hhi[2], hlo[2];
        float hscale;
        {
            const unsigned hw[8] = {ha.x, ha.y, ha.z, ha.w, hb.x, hb.y, hb.z, hb.w};
            float hf[16];
            float m = 0.f;
#pragma unroll
            for (int q = 0; q < 8; ++q) { hf[2 * q] = __uint_as_float(hw[q] << 16); hf[2 * q + 1] = __uint_as_float(hw[q] & 0xffff0000u); m = fmaxf(m, fmaxf(fabsf(hf[2 * q]), fabsf(hf[2 * q + 1]))); }
            m = wave_max(m);
            hscale = m > 0.f ? m * (1.f / 119.f) : 1.f;
            const float inv = 1.f / hscale;
            hhi[0] = hhi[1] = hlo[0] = hlo[1] = 0u;
#pragma unroll
            for (int e = 0; e < 16; ++e) {
                const int hq = __float2int_rn(hf[e] * inv);
                const int lo = ((hq + 8) & 15) - 8, hi = (hq - lo) >> 4;
                hlo[e >> 3] |= ((unsigned)lo & 15u) << (4 * (e & 7));
                hhi[e >> 3] |= ((unsigned)hi & 15u) << (4 * (e & 7));
            }
        }
#pragma unroll
        for (int bt = 0; bt < 8; ++bt) {
            const int cur = bt & 1, nxt = cur ^ 1;
            const int p1 = bt < 7 ? tl * 128 + (bt + 1) * 16 : tn * 128;
            const int p2 = bt < 6 ? tl * 128 + (bt + 2) * 16 : tn * 128 + (bt - 6) * 16;
            DOWN_LOADS(nxt, p1);
            DOWN_IDS(p2);
            __builtin_amdgcn_sched_barrier(0);
            int part[16];
#pragma unroll
            for (int u = 0; u < 16; ++u) {
                int shi = dot8z((int)R[cur][u].x, (int)hhi[0]);
                shi = __builtin_amdgcn_sdot8((int)R[cur][u].y, (int)hhi[1], shi, false);
                int p_ = shi << 4;
                p_ = __builtin_amdgcn_sdot8((int)R[cur][u].x, (int)hlo[0], p_, false);
                part[u] = __builtin_amdgcn_sdot8((int)R[cur][u].y, (int)hlo[1], p_, false);
            }
            int r8[8], r4[4], r2[2], r1;
            {
                const bool b3 = (lane & 8) != 0, b2 = (lane & 4) != 0;
#pragma unroll
                for (int q = 0; q < 8; ++q) { auto sw = __builtin_amdgcn_permlane32_swap((unsigned)part[q], (unsigned)part[q + 8], false, false); r8[q] = (int)sw[0] + (int)sw[1]; }
#pragma unroll
                for (int q = 0; q < 4; ++q) { auto sw = __builtin_amdgcn_permlane16_swap((unsigned)r8[q], (unsigned)r8[q + 4], false, false); r4[q] = (int)sw[0] + (int)sw[1]; }
#pragma unroll
                for (int q = 0; q < 2; ++q) { const int keep = b3 ? r4[q + 2] : r4[q], give = b3 ? r4[q] : r4[q + 2]; r2[q] = keep + dppi<0x128>(give); }
                { const int keep = b2 ? r2[1] : r2[0], give = b2 ? r2[0] : r2[1]; r1 = keep + dppi<0x141>(give); }
                r1 += dppi<0x4E>(r1); r1 += dppi<0xB1>(r1);
            }
            rs[bt] = r1;
        }
        {
            const int j_ = lane & 3;
            const int ra = j_ == 0 ? rs[0] : j_ == 1 ? rs[2] : j_ == 2 ? rs[4] : rs[6];
            const int rb = j_ == 0 ? rs[1] : j_ == 1 ? rs[3] : j_ == 2 ? rs[5] : rs[7];
            float* gq = gp + j_ * 32 + myu;
            const float a0 = (float)ra * (scA.x * hscale), a1 = (float)rb * (scB.x * hscale);
            const float w0 = gq[0] * (0.5f * a0 * (1.f + erff(a0 * 0.70710678118654752f))) * scA.y;
            const float w1 = gq[16] * (0.5f * a1 * (1.f + erff(a1 * 0.70710678118654752f))) * scB.y;
            ((unsigned*)gq)[0] = (unsigned)__builtin_bit_cast(unsigned short, (_Float16)w0);
            ((unsigned*)gq)[16] = (unsigned)__builtin_bit_cast(unsigned short, (_Float16)w1);
        }
    }
#undef DOWN_IDS
#undef DOWN_LOADS
}
DI void peer_up_wave(char* lds, const unsigned char* __restrict__ TBu, const float* __restrict__ g2b, float* __restrict__ x, int tile, int w, int lane,
                     bf16_t* __restrict__ hAn, const float* __restrict__ g1n, const float* __restrict__ sh1n, const float* __restrict__ sc1n) {
    lane = opaque_v(lane);
    const unsigned lane8 = (unsigned)lane * 8u;
    const unsigned short* seid = (const unsigned short*)(lds + PL_SEID) + w * 16 * 128;
    const unsigned* swgt = (const unsigned*)(lds + PL_SWGT) + w * 16 * 128;
    u32x2 RA[16], RB[16];
    u32x4 ID[2], WA[4], WB[4];
#define UP_IDS(P_) do { ID[0] = *(const u32x4*)(seid + (P_)); ID[1] = *(const u32x4*)(seid + (P_) + 8); } while (0)
#define UP_WTS(W, P_) do { _Pragma("unroll") for (int q_ = 0; q_ < 4; ++q_) W[q_] = *(const u32x4*)(swgt + (P_) + 4 * q_); } while (0)
#define UP_LOADS(R) do { _Pragma("unroll") for (int u_ = 0; u_ < 16; ++u_) { const unsigned pr_ = ID[u_ >> 3][(u_ >> 1) & 3]; \
        const unsigned off_ = (u_ & 1) ? rowoff_hi(pr_, 512u, lane8) : rowoff_lo(pr_, 512u, lane8); R[u_] = *(const u32x2*)(TBu + off_); } } while (0)
#define UP_COMPUTE(R, W, K) do { _Pragma("unroll") for (int u_ = 0; u_ < 16; ++u_) { \
        const unsigned wd_ = W[u_ >> 2][u_ & 3]; const h16x2 wp_ = __builtin_bit_cast(h16x2, wd_); const h16x2 w2_ = (h16x2){wp_.x, wp_.x}; \
        _Pragma("unroll") for (int q_ = 0; q_ < 4; ++q_) { acc[K][q_] = __builtin_elementwise_fma(w2_, fp4h(R[u_].x, q_), acc[K][q_]); acc[K][4 + q_] = __builtin_elementwise_fma(w2_, fp4h(R[u_].y, q_), acc[K][4 + q_]); } } } while (0)
    UP_IDS(0); UP_LOADS(RA); UP_IDS(16); UP_WTS(WA, 0);
    float4 gv[4];
#pragma unroll
    for (int q = 0; q < 4; ++q) gv[q] = ((const float4*)(g2b + lane * 16))[q];
    float4 cg[4], ch[4];
#pragma unroll
    for (int q = 0; q < 4; ++q) {
        cg[q] = (float4){0.f, 0.f, 0.f, 0.f}; ch[q] = cg[q];
        if (hAn) { const float4 a = ((const float4*)(g1n + lane * 16))[q], b = ((const float4*)(sc1n + lane * 16))[q]; ch[q] = ((const float4*)(sh1n + lane * 16))[q];
                   cg[q].x = a.x * (1.f + b.x); cg[q].y = a.y * (1.f + b.y); cg[q].z = a.z * (1.f + b.z); cg[q].w = a.w * (1.f + b.w); }
    }
#pragma unroll 1
    for (int tk = 0; tk < 16; ++tk) {
        const int tn = tk < 15 ? tk + 1 : 15;
        float4* xp = (float4*)(x + (size_t)(unsigned)((tile * 128 + w * 16 + tk) * D + lane * 16));
        float4 xv[4];
#pragma unroll
        for (int q = 0; q < 4; ++q) xv[q] = xp[q];
        h16x2 acc[1][8];
#pragma unroll
        for (int q = 0; q < 8; ++q) acc[0][q] = (h16x2){(_Float16)0.f, (_Float16)0.f};
#pragma unroll 1
        for (int i = 0; i < 4; ++i) {
            const int pa = tk * 128 + i * 32;
            const int pn = i < 3 ? pa + 32 : tn * 128;
            UP_LOADS(RB); UP_WTS(WB, pa + 16); UP_IDS(pn);
            __builtin_amdgcn_sched_barrier(0);
            UP_COMPUTE(RA, WA, 0);
            UP_LOADS(RA); UP_WTS(WA, pn); UP_IDS(pn + 16);
            __builtin_amdgcn_sched_barrier(0);
            UP_COMPUTE(RB, WB, 0);
        }
        float ssx = 0.f;
#pragma unroll
        for (int q = 0; q < 4; ++q) {
            xv[q].x += gv[q].x * (float)acc[0][2 * q].x; xv[q].y += gv[q].y * (float)acc[0][2 * q].y; xv[q].z += gv[q].z * (float)acc[0][2 * q + 1].x; xv[q].w += gv[q].w * (float)acc[0][2 * q + 1].y;
            xp[q] = xv[q];
            ssx += xv[q].x * xv[q].x + xv[q].y * xv[q].y + xv[q].z * xv[q].z + xv[q].w * xv[q].w;
        }
        ssx = wave_sum(ssx);
        if (hAn) {
            const float rs = rsqrtf(ssx * (1.f / D) + EPS);
            bf16_t* orow = hAn + (size_t)(unsigned)((tile * 128 + w * 16 + tk) * D + lane * 16);
#pragma unroll
            for (int j = 0; j < 2; ++j) {
                u32x4 o;
                o.x = pk2(xv[2 * j].x * rs * cg[2 * j].x + ch[2 * j].x, xv[2 * j].y * rs * cg[2 * j].y + ch[2 * j].y);
                o.y = pk2(xv[2 * j].z * rs * cg[2 * j].z + ch[2 * j].z, xv[2 * j].w * rs * cg[2 * j].w + ch[2 * j].w);
                o.z = pk2(xv[2 * j + 1].x * rs * cg[2 * j + 1].x + ch[2 * j + 1].x, xv[2 * j + 1].y * rs * cg[2 * j + 1].y + ch[2 * j + 1].y);
                o.w = pk2(xv[2 * j + 1].z * rs * cg[2 * j + 1].z + ch[2 * j + 1].z, xv[2 * j + 1].w * rs * cg[2 * j + 1].w + ch[2 * j + 1].w);
                *(u32x4*)(orow + 8 * j) = o;
            }
        }
    }
#undef UP_IDS
#undef UP_WTS
#undef UP_LOADS
#undef UP_COMPUTE
}

DI void epi_qk(f32x16 (&acc)[4][2], const float* __restrict__ gain, float scale, bf16_t* __restrict__ dst, int lane) {
    lane = opaque_v(lane);
    const int hh = lane >> 5;
    float gv[2][16];
#pragma unroll
    for (int nb = 0; nb < 2; ++nb)
#pragma unroll
        for (int i = 0; i < 16; ++i) gv[nb][i] = gain[nb * 32 + (i & 3) + 8 * (i >> 2) + 4 * hh] * scale;
#pragma unroll
    for (int mb = 0; mb < 4; ++mb) {
        float ss = 0.f;
#pragma unroll
        for (int nb = 0; nb < 2; ++nb)
#pragma unroll
            for (int i = 0; i < 16; ++i) ss += acc[mb][nb][i] * acc[mb][nb][i];
        ss = x32_sum(ss);
        const float r = rsqrtf(ss * (1.f / 64.f) + EPS);
#pragma unroll
        for (int nb = 0; nb < 2; ++nb)
#pragma unroll
            for (int s = 0; s < 2; ++s) {
                const f32x16& a = acc[mb][nb];
                u32x4 o;
                o.x = pk2(a[8 * s] * r * gv[nb][8 * s], a[8 * s + 1] * r * gv[nb][8 * s + 1]);
                o.y = pk2(a[8 * s + 2] * r * gv[nb][8 * s + 2], a[8 * s + 3] * r * gv[nb][8 * s + 3]);
                o.z = pk2(a[8 * s + 4] * r * gv[nb][8 * s + 4], a[8 * s + 5] * r * gv[nb][8 * s + 5]);
                o.w = pk2(a[8 * s + 6] * r * gv[nb][8 * s + 6], a[8 * s + 7] * r * gv[nb][8 * s + 7]);
                *(u32x4*)(dst + ((unsigned)(((nb * 2 + s) * 4 + mb) * 64 + lane)) * 8) = o;
            }
    }
}
DI void epi_v(const f32x16 (&acc)[4][2], bf16_t* __restrict__ dst, int lane) {
    lane = opaque_v(lane);
#pragma unroll
    for (int nb = 0; nb < 2; ++nb)
#pragma unroll
        for (int mb = 0; mb < 4; ++mb)
#pragma unroll
            for (int s = 0; s < 2; ++s) {
                const f32x16& a = acc[mb][nb];
                u32x4 o; o.x = pk2(a[8 * s], a[8 * s + 1]); o.y = pk2(a[8 * s + 2], a[8 * s + 3]); o.z = pk2(a[8 * s + 4], a[8 * s + 5]); o.w = pk2(a[8 * s + 6], a[8 * s + 7]);
                *(u32x4*)(dst + ((unsigned)(((nb * 4 + mb) * 2 + s) * 64 + lane)) * 8) = o;
            }
}
DI void epi_row(const f32x16 (&acc)[4][2], bf16_t* __restrict__ dst, int ld, int lane) {
    lane = opaque_v(lane);
    const int r5 = lane & 31, hh = lane >> 5;
#pragma unroll
    for (int mb = 0; mb < 4; ++mb)
#pragma unroll
        for (int nb = 0; nb < 2; ++nb)
#pragma unroll
            for (int gq = 0; gq < 4; ++gq) {
                const f32x16& a = acc[mb][nb];
                u32x2 o; o.x = pk2(a[4 * gq], a[4 * gq + 1]); o.y = pk2(a[4 * gq + 2], a[4 * gq + 3]);
                *(u32x2*)(dst + (unsigned)((mb * 32 + r5) * ld + nb * 32 + 8 * gq + 4 * hh)) = o;
            }
}
DI void epi_z(const f32x16 (&acc)[4][2], bf16_t* __restrict__ dst, int lane) {
    lane = opaque_v(lane);
    const int r5 = lane & 31, hh = lane >> 5;
#pragma unroll
    for (int mb = 0; mb < 4; ++mb)
#pragma unroll
        for (int gq = 0; gq < 4; ++gq) {
            const f32x16 &a = acc[mb][0], &b = acc[mb][1];
            u32x2 o; o.x = pk2(a[4 * gq] * b[4 * gq], a[4 * gq + 1] * b[4 * gq + 1]); o.y = pk2(a[4 * gq + 2] * b[4 * gq + 2], a[4 * gq + 3] * b[4 * gq + 3]);
            *(u32x2*)(dst + (unsigned)((mb * 32 + r5) * 256 + 8 * gq + 4 * hh)) = o;
        }
}
DI void epi_su_park(const f32x16 (&acc)[4][2], unsigned* lds_su, int lane) {
    lane = opaque_v(lane);
#pragma unroll
    for (int mb = 0; mb < 4; ++mb)
#pragma unroll
        for (int nb = 0; nb < 2; ++nb)
#pragma unroll
            for (int q = 0; q < 8; ++q) lds_su[((mb * 2 + nb) * 8 + q) * 64 + lane] = pk2(acc[mb][nb][2 * q], acc[mb][nb][2 * q + 1]);
}
DI void epi_sv(f32x16 (&acc)[4][2], const bf16_t* __restrict__ SWF  , const float* __restrict__ bs_g, const unsigned* lds_su, bf16_t* __restrict__ dst, int lane) {
    lane = opaque_v(lane);
    const int r5 = lane & 31, hh = lane >> 5;
    bf16x8 vb[4][2][2];
#pragma unroll
    for (int mb = 0; mb < 4; ++mb) {
#pragma unroll
        for (int i = 0; i < 16; ++i) {
            float s1 = acc[mb][0][i] + acc[mb][1][i];
            s1 = red32_sum(s1);
            const float mu = s1 * (1.f / 64.f);
            const float d0 = acc[mb][0][i] - mu, d1 = acc[mb][1][i] - mu;
            float s2 = d0 * d0 + d1 * d1;
            s2 = red32_sum(s2);
            const float r = rsqrtf(s2 * (1.f / 64.f) + EPS);
            acc[mb][0][i] = d0 * r; acc[mb][1][i] = d1 * r;
        }
#pragma unroll
        for (int s = 0; s < 2; ++s)
#pragma unroll
            for (int nb = 0; nb < 2; ++nb) {
                const f32x16& a = acc[mb][nb];
                u32x4 o; o.x = pk2(a[8 * s], a[8 * s + 1]); o.y = pk2(a[8 * s + 2], a[8 * s + 3]); o.z = pk2(a[8 * s + 4], a[8 * s + 5]); o.w = pk2(a[8 * s + 6], a[8 * s + 7]);
                vb[mb][s][nb] = __builtin_bit_cast(bf16x8, o);
            }
    }
#pragma unroll
    for (int tb = 0; tb < 4; ++tb) {
        f32x16 y[2];
#pragma unroll
        for (int nb = 0; nb < 2; ++nb)
#pragma unroll
            for (int i = 0; i < 16; ++i) y[nb][i] = 0.f;
#pragma unroll
        for (int kt = 0; kt <= tb; ++kt)
#pragma unroll
            for (int s = 0; s < 2; ++s) {
                const bf16x8 wa = *(const bf16x8*)(SWF + ((unsigned)(((tb * 4 + kt) * 2 + s) * 64 + lane)) * 8);
                y[0] = MFMA32(wa, vb[kt][s][0], y[0]);
                y[1] = MFMA32(wa, vb[kt][s][1], y[1]);
            }
#pragma unroll
        for (int nb = 0; nb < 2; ++nb)
#pragma unroll
            for (int q = 0; q < 8; ++q) {
                const unsigned su2 = lds_su[((tb * 2 + nb) * 8 + q) * 64 + lane];
                const int i0 = 2 * q, i1 = 2 * q + 1;
                const int t0 = tb * 32 + (i0 & 3) + 8 * (i0 >> 2) + 4 * hh, t1 = tb * 32 + (i1 & 3) + 8 * (i1 >> 2) + 4 * hh;
                const float v0 = (y[nb][i0] + bs_g[t0]) * __uint_as_float(su2 << 16), v1 = (y[nb][i1] + bs_g[t1]) * __uint_as_float(su2 & 0xffff0000u);
                const unsigned pk = pk2(v0, v1);
                dst[(unsigned)(t0 * 256 + nb * 32 + r5)] = (bf16_t)(pk & 0xffffu);
                dst[(unsigned)(t1 * 256 + nb * 32 + r5)] = (bf16_t)(pk >> 16);
            }
    }
}

DI void conv_sguw_item(const float* __restrict__ W, bf16_t* __restrict__ SWF, int gid) {
    const int lane = gid & 63, s = (gid >> 6) & 1, kt = (gid >> 7) & 3, tb = (gid >> 9) & 3, g = gid >> 11;
    const int r = lane & 31, hh = lane >> 5, t = tb * 32 + r;
    const float* p = W + ((size_t)g * 128 + t) * 128;
    float v[8];
#pragma unroll
    for (int j = 0; j < 8; ++j) { const int sp = kt * 32 + 16 * s + 8 * (j >> 2) + 4 * hh + (j & 3); v[j] = sp <= t ? p[sp] : 0.f; }
    u32x4 o; o.x = pk2(v[0], v[1]); o.y = pk2(v[2], v[3]); o.z = pk2(v[4], v[5]); o.w = pk2(v[6], v[7]);
    *(u32x4*)(SWF + (size_t)gid * 8) = o;
}

DI int t5_bucket(int d) {
    if (d < 16) return d;
    const float lr = logf((float)d / 16.f) / logf(8.f);
    const int large = 16 + (int)(lr * 16.f);
    return large < 31 ? large : 31;
}

DI void attn_tile(const bf16_t* __restrict__ QF, const bf16_t* __restrict__ KF2, const bf16_t* __restrict__ VF, char* lds, const float* bias_lds, const float* __restrict__ sink, bf16_t* __restrict__ OR, int tile, int tid) {
    tid = opaque_v(tid); tile = opaque_s(tile);
    const int lane = tid & 63, w = __builtin_amdgcn_readfirstlane(tid >> 6), r5 = lane & 31, hh = lane >> 5;
    const bool has_prev = (tile & 31) != 0;
    {
        u32x4 tmp[16];
#pragma unroll
        for (int i = 0; i < 16; ++i) {
            const int blk = w * 16 + i;
            const int isv = blk >> 6, bb = blk & 63;
            const bf16_t* src;
            if (!isv) { const int kvh = bb >> 5, ks = (bb >> 3) & 3, wt = bb & 7, st = (wt >= 4 || !has_prev) ? tile : tile - 1;
                src = KF2 + ((unsigned)((((st * 2 + kvh) * 4 + ks) * 4 + (wt & 3)) * 64 + lane)) * 8; }
            else { const int kvh = bb >> 5, dt = (bb >> 4) & 1, wt = (bb >> 1) & 7, s2 = bb & 1, st = (wt >= 4 || !has_prev) ? tile : tile - 1;
                src = VF + ((unsigned)(((((st * 2 + kvh) * 2 + dt) * 4 + (wt & 3)) * 2 + s2) * 64 + lane)) * 8; }
            tmp[i] = *(const u32x4*)src;
        }
#pragma unroll
        for (int i = 0; i < 16; ++i) *(u32x4*)(lds + (w * 16 + i) * 1024 + lane * 16) = tmp[i];
    }
    __syncthreads();
    const char* ldsK = lds, *ldsV = lds + 65536;
    for (int task = w; task < 32; task += 8) {
        const int qh = task >> 2, qt = task & 3, kvh = qh >> 2;
        bf16x8 bq[4];
#pragma unroll
        for (int ks = 0; ks < 4; ++ks) bq[ks] = *(const bf16x8*)(QF + ((unsigned)((((tile * 8 + qh) * 4 + ks) * 4 + qt) * 64 + lane)) * 8);
        f32x16 sc[5];
#pragma unroll
        for (int jj = 0; jj < 5; ++jj) {
#pragma unroll
            for (int i = 0; i < 16; ++i) sc[jj][i] = 0.f;
#pragma unroll
            for (int ks = 0; ks < 4; ++ks) {
                const bf16x8 kf = *(const bf16x8*)(ldsK + ((kvh * 4 + ks) * 8 + qt + jj) * 1024 + lane * 16);
                sc[jj] = MFMA32(kf, bq[ks], sc[jj]);
            }
        }
        const float* bl = bias_lds + qh * 128;
        float m = -1e30f;
#pragma unroll
        for (int jj = 0; jj < 5; ++jj) {
            const bool ex = (qt + jj >= 4) || has_prev;
#pragma unroll
            for (int i = 0; i < 16; ++i) {
                const int cr = (i & 3) + 8 * (i >> 2) + 4 * hh;
                const int dist = 128 + r5 - 32 * jj - cr;
                const bool valid = ex && dist >= 0 && dist < 128;
                float bv = bl[dist & 127];
                asm volatile("" : "+v"(bv));
                const float v = valid ? sc[jj][i] + bv : -1e30f;
                sc[jj][i] = v; m = fmaxf(m, v);
            }
        }
        m = x32_max(m);
        const float sk = sink[qh];
        m = fmaxf(m, sk);
        float l = 0.f;
#pragma unroll
        for (int jj = 0; jj < 5; ++jj)
#pragma unroll
            for (int i = 0; i < 16; ++i) { const float p = __expf(sc[jj][i] - m); sc[jj][i] = p; l += p; }
        l = x32_sum(l);
        l += __expf(sk - m);
        const float rl = 1.f / l;
        f32x16 o[2];
#pragma unroll
        for (int dt = 0; dt < 2; ++dt)
#pragma unroll
            for (int i = 0; i < 16; ++i) o[dt][i] = 0.f;
#pragma unroll
        for (int jj = 0; jj < 5; ++jj) {
#pragma unroll
            for (int s = 0; s < 2; ++s) {
                const f32x16& a = sc[jj];
                u32x4 pp; pp.x = pk2(a[8 * s], a[8 * s + 1]); pp.y = pk2(a[8 * s + 2], a[8 * s + 3]); pp.z = pk2(a[8 * s + 4], a[8 * s + 5]); pp.w = pk2(a[8 * s + 6], a[8 * s + 7]);
                const bf16x8 pb = __builtin_bit_cast(bf16x8, pp);
#pragma unroll
                for (int dt = 0; dt < 2; ++dt) {
                    const bf16x8 vf = *(const bf16x8*)(ldsV + (((kvh * 2 + dt) * 8 + qt + jj) * 2 + s) * 1024 + lane * 16);
                    o[dt] = MFMA32(vf, pb, o[dt]);
                }
            }
        }
        bf16_t* orow = OR + (unsigned)((tile * 128 + qt * 32 + r5) * 512 + qh * 64 + 4 * hh);
#pragma unroll
        for (int dt = 0; dt < 2; ++dt)
#pragma unroll
            for (int gq = 0; gq < 4; ++gq) {
                u32x2 ov; ov.x = pk2(o[dt][4 * gq] * rl, o[dt][4 * gq + 1] * rl); ov.y = pk2(o[dt][4 * gq + 2] * rl, o[dt][4 * gq + 3] * rl);
                *(u32x2*)(orow + dt * 32 + 8 * gq) = ov;
            }
    }
}

DI void unpack8(const u32x4 v, float (&f)[8]) {
    f[0] = __uint_as_float(v.x << 16); f[1] = __uint_as_float(v.x & 0xffff0000u); f[2] = __uint_as_float(v.y << 16); f[3] = __uint_as_float(v.y & 0xffff0000u);
    f[4] = __uint_as_float(v.z << 16); f[5] = __uint_as_float(v.z & 0xffff0000u); f[6] = __uint_as_float(v.w << 16); f[7] = __uint_as_float(v.w & 0xffff0000u);
}
DI void merge_tile(const bf16_t* __restrict__ OR, const bf16_t* __restrict__ CBR, const bf16_t* __restrict__ ZR, const bf16_t* __restrict__ YS, const float* __restrict__ cw  , const float* __restrict__ og  ,
                   bf16_t* __restrict__ mA, int tile, int tid) {
    tid = opaque_v(tid); tile = opaque_s(tile);
    const int lane = tid & 63, w = tid >> 6;
    float cwv[3][8], ga[8], gb[8];
    {
        const int c0 = (lane & 31) * 8;
#pragma unroll
        for (int j = 0; j < 3; ++j) { const float4 p0 = *(const float4*)(cw + j * 256 + c0), p1 = *(const float4*)(cw + j * 256 + c0 + 4);
            cwv[j][0] = p0.x; cwv[j][1] = p0.y; cwv[j][2] = p0.z; cwv[j][3] = p0.w; cwv[j][4] = p1.x; cwv[j][5] = p1.y; cwv[j][6] = p1.z; cwv[j][7] = p1.w; }
        const float4 a0 = *(const float4*)(og + lane * 8), a1 = *(const float4*)(og + lane * 8 + 4), b0 = *(const float4*)(og + 512 + lane * 8), b1 = *(const float4*)(og + 512 + lane * 8 + 4);
        ga[0] = a0.x; ga[1] = a0.y; ga[2] = a0.z; ga[3] = a0.w; ga[4] = a1.x; ga[5] = a1.y; ga[6] = a1.z; ga[7] = a1.w;
        gb[0] = b0.x; gb[1] = b0.y; gb[2] = b0.z; gb[3] = b0.w; gb[4] = b1.x; gb[5] = b1.y; gb[6] = b1.z; gb[7] = b1.w;
    }
#pragma unroll 8
    for (int rr = 0; rr < 16; ++rr) {
        const int row = w * 16 + rr, t = tile * 128 + row, pos = t & (S - 1);
        float a[8], y[8];
        unpack8(*(const u32x4*)(OR + (unsigned)(t * 512 + lane * 8)), a);
        float ssa = 0.f;
#pragma unroll
        for (int q = 0; q < 8; ++q) ssa += a[q] * a[q];
        ssa = wave_sum(ssa);
        {
            const int c0 = (lane & 31) * 8;
            float cb[8], z0[8], z1[8], z2[8], ys[8];
            const float m1 = pos >= 1 ? 1.f : 0.f, m2 = pos >= 2 ? 1.f : 0.f;
            const int t1 = pos >= 1 ? t - 1 : t, t2 = pos >= 2 ? t - 2 : t;
            unpack8(*(const u32x4*)(CBR + (unsigned)(t * 256 + c0)), cb);
            unpack8(*(const u32x4*)(ZR + (unsigned)(t * 256 + c0)), z2);
            unpack8(*(const u32x4*)(ZR + (unsigned)(t1 * 256 + c0)), z1);
            unpack8(*(const u32x4*)(ZR + (unsigned)(t2 * 256 + c0)), z0);
            unpack8(*(const u32x4*)(YS + (unsigned)(t * 256 + c0)), ys);
#pragma unroll
            for (int q = 0; q < 8; ++q) {
                const float yc = cb[q] * (cwv[0][q] * (z0[q] * m2) + cwv[1][q] * (z1[q] * m1) + cwv[2][q] * z2[q]);
                y[q] = lane < 32 ? yc : ys[q];
            }
        }
        float ssy = 0.f;
#pragma unroll
        for (int q = 0; q < 8; ++q) ssy += y[q] * y[q];
        ssy = red32_sum(ssy);
        const float ra = rsqrtf(ssa * (1.f / 512.f) + EPS), ry = rsqrtf(ssy * (1.f / 256.f) + EPS);
        const int mb = row >> 5, r5 = row & 31;
        {
            u32x4 o; o.x = pk2(a[0] * ra * ga[0], a[1] * ra * ga[1]); o.y = pk2(a[2] * ra * ga[2], a[3] * ra * ga[3]); o.z = pk2(a[4] * ra * ga[4], a[5] * ra * ga[5]); o.w = pk2(a[6] * ra * ga[6], a[7] * ra * ga[7]);
            const int c8 = lane;
            (void)c8;
            *(u32x4*)(mA + (unsigned)(t * 1024 + lane * 8)) = o;
        }
        {
            u32x4 o; o.x = pk2(y[0] * ry * gb[0], y[1] * ry * gb[1]); o.y = pk2(y[2] * ry * gb[2], y[3] * ry * gb[3]); o.z = pk2(y[4] * ry * gb[4], y[5] * ry * gb[5]); o.w = pk2(y[6] * ry * gb[6], y[7] * ry * gb[7]);
            const int c8 = 64 + lane;
            (void)c8;
            *(u32x4*)(mA + (unsigned)(t * 1024 + 512 + lane * 8)) = o;
        }
    }
}

struct InProjOut { bf16_t *QF, *KF2, *VF, *CBR, *ZR, *YS; };
DI void inproj_tile(const bf16_t* __restrict__ At, const bf16_t* __restrict__ WF, const float* __restrict__ qg, const float* __restrict__ kg, const bf16_t* __restrict__ SWF, const float* __restrict__ sgu_b,
                    const InProjOut& O, char* lds, int tile, int tid) {
    tid = opaque_v(tid); tile = opaque_s(tile);
    const int lane = tid & 63, w = __builtin_amdgcn_readfirstlane(tid >> 6);
    f32x16 acc[4][2];
    {
        const int nbt0 = w * 2;
        kloop<1>(acc, At, WF + (size_t)nbt0 * 32768, WF + (size_t)(nbt0 + 1) * 32768, lds, tid, lane);
        epi_qk(acc, qg, 0.125f, O.QF + (size_t)(tile * 8 + w) * 8192, lane);
    }
    {
        const int nbt0 = 16 + w * 2;
        if (w == 2 || w == 3) {
            kloop<0>(acc, At, WF + (size_t)nbt0 * 32768, WF + (size_t)(nbt0 + 1) * 32768, lds, tid, lane);
            epi_v(acc, O.VF + (size_t)(tile * 2 + (w - 2)) * 8192, lane);
        } else {
            kloop<1>(acc, At, WF + (size_t)nbt0 * 32768, WF + (size_t)(nbt0 + 1) * 32768, lds, tid, lane);
            if (w < 2) epi_qk(acc, kg, 1.f, O.KF2 + (size_t)(tile * 2 + w) * 8192, lane);
            else epi_row(acc, O.CBR + (size_t)tile * 128 * 256 + (w - 4) * 64, 256, lane);
        }
    }
    {
        const int nbt0 = 32 + w * 2;
        kloop<1>(acc, At, WF + (size_t)nbt0 * 32768, WF + (size_t)(nbt0 + 1) * 32768, lds, tid, lane);
        epi_z(acc, O.ZR + (size_t)tile * 128 * 256 + w * 32, lane);
    }
    {
        const int nbt0 = 48 + w * 2;
        kloop<0>(acc, At, WF + (size_t)nbt0 * 32768, WF + (size_t)(nbt0 + 1) * 32768, lds, tid, lane);
        unsigned* lds_su = (unsigned*)lds;
        if (w < 4) epi_su_park(acc, lds_su + w * 4096, lane);
        __syncthreads();
        if (w >= 4) epi_sv(acc, SWF + (size_t)(w - 4) * 16384, sgu_b + (w - 4) * 128, lds_su + (w - 4) * 4096, O.YS + (size_t)tile * 128 * 256 + (w - 4) * 64, lane);
        __syncthreads();
    }
}


struct Params {
    const float *x, *c, *rel_bias, *w_ada, *b_ada, *norm1_g, *norm2_g, *w_in, *q_norm_g, *k_norm_g, *attn_sink, *conv_w, *sgu_w, *sgu_b, *out_norm_g, *w_out, *peer_wq, *peer_sub_keys, *peer_down, *peer_up;
    float* out;
    char* ws;
};
constexpr size_t MiB = 1u << 20;
constexpr size_t WS_MOD = 0;
constexpr size_t WS_MODP = 1 * MiB;
constexpr size_t WS_WIN = 13 * MiB;
constexpr size_t WS_WOUT = 29 * MiB;
constexpr size_t WS_WPQ = 37 * MiB;
constexpr size_t WS_KEYS = 53 * MiB;
constexpr size_t WS_SWF = 55 * MiB;
constexpr size_t WS_SC = 56 * MiB;
constexpr size_t WS_TB = 57 * MiB;
constexpr size_t WS_HA = 185 * MiB;
constexpr size_t WS_QF = 249 * MiB;
constexpr size_t WS_KF2 = 602 * MiB;
constexpr size_t WS_VF = 634 * MiB;
constexpr size_t WS_ZR = 666 * MiB;
constexpr size_t WS_CBR = 345 * MiB;
constexpr size_t WS_YS = 361 * MiB;
constexpr size_t WS_OR = 377 * MiB;
constexpr size_t WS_QPF = 409 * MiB;
constexpr size_t WS_RIDX = 537 * MiB;
constexpr size_t WS_RGATE = 553 * MiB;
constexpr size_t WS_SEID = 569 * MiB;
constexpr size_t WS_SWGT = 585 * MiB;
constexpr size_t WS_OFFS = 601 * MiB;
constexpr size_t WS_FLAGS = 601 * MiB + 512 * 1024;
constexpr size_t WS_END = 730 * MiB;
static_assert(PL_END <= LDS_RSTD1, "expert-phase lists overlap persistent LDS state");

__global__ __launch_bounds__(512) void hybrid_fwd(Params P) {
    extern __shared__ __attribute__((aligned(16))) char lds[];
    cg::grid_group grid = cg::this_grid();
    const int tid = threadIdx.x, lane = tid & 63, w = __builtin_amdgcn_readfirstlane(tid >> 6);
    const int nblk = gridDim.x, hwb = blockIdx.x;
    const int bid = (nblk == NTILE) ? (hwb & 7) * 32 + (hwb >> 3) : hwb;
    char* ws = P.ws;
    float* mod = (float*)(ws + WS_MOD);
    float* modp = (float*)(ws + WS_MODP);
    bf16_t* WinF = (bf16_t*)(ws + WS_WIN); bf16_t* WoutF = (bf16_t*)(ws + WS_WOUT); bf16_t* WpqF = (bf16_t*)(ws + WS_WPQ);
    bf16_t* KeysF = (bf16_t*)(ws + WS_KEYS); bf16_t* SWF = (bf16_t*)(ws + WS_SWF);
    float* SC = (float*)(ws + WS_SC); unsigned char* TBd = (unsigned char*)(ws + WS_TB); unsigned char* TBu = TBd + 32 * MiB;
    bf16_t* hA = (bf16_t*)(ws + WS_HA);
    bf16_t* OR = (bf16_t*)(ws + WS_OR); bf16_t* QPF = (bf16_t*)(ws + WS_QPF);
    int* ridx = (int*)(ws + WS_RIDX); float* rgate = (float*)(ws + WS_RGATE);
    float* bias_lds = (float*)(lds + LDS_BIAS);
    unsigned* flags = (unsigned*)(ws + WS_FLAGS);

    {
        float* ca = (float*)lds;
        if (tid == 0) for (int tile = bid; tile < NTILE; tile += nblk) __hip_atomic_store(flags + tile, 0u, __ATOMIC_RELAXED, __HIP_MEMORY_SCOPE_AGENT);
        for (int i = tid; i < 8192; i += 512) { const float v = P.c[i]; ca[i] = v / (1.f + __expf(-v)); }
        for (int i = tid; i < 1024; i += 512) bias_lds[i] = P.rel_bias[t5_bucket(i & 127) * 8 + (i >> 7)];
        __syncthreads();
        for (int it = bid; it < 768; it += nblk) {
            const int jc = it % 12, l = (it / 12) & 3, ks = it / 48;
            const int j = jc * 512 + tid;
            const float* wp = P.w_ada + ((size_t)l * 1024 + ks * 64) * 6144 + j;
            float acc[8];
#pragma unroll
            for (int b = 0; b < 8; ++b) acc[b] = 0.f;
#pragma unroll 4
            for (int i = 0; i < 64; ++i) {
                const float wv = wp[(size_t)i * 6144];
#pragma unroll
                for (int b = 0; b < 8; ++b) acc[b] += ca[b * 1024 + ks * 64 + i] * wv;
            }
#pragma unroll
            for (int b = 0; b < 8; ++b) modp[((size_t)(ks * 4 + l) * 8 + b) * 6144 + j] = acc[b];
        }
        const int gthreads = nblk * 512, gtid = bid * 512 + tid;
        for (int rep = 0; rep < REP_P0; ++rep)
        for (int l = 0; l < DEPTH; ++l) {
            for (int g = gtid; g < 64 * 64 * 64; g += gthreads) conv_wfrag_item(P.w_in + (size_t)l * 1024 * 2048, 2048, 64, WinF + (size_t)l * 2097152, g, 1);
            for (int g = gtid; g < 32 * 64 * 64; g += gthreads) conv_wfrag_item(P.w_out + (size_t)l * 1024 * 1024, 1024, 64, WoutF + (size_t)l * 1048576, g, 0);
            for (int g = gtid; g < 64 * 64 * 64; g += gthreads) conv_wfrag_item(P.peer_wq + (size_t)l * 1024 * 2048, 2048, 64, WpqF + (size_t)l * 2097152, g, 0);
            for (int g = gtid; g < 32768; g += gthreads) conv_keys_item(P.peer_sub_keys + (size_t)l * 262144, KeysF + (size_t)l * 262144, g);
            for (int g = gtid; g < 8192; g += gthreads) conv_sguw_item(P.sgu_w + (size_t)l * 65536, SWF + (size_t)l * 65536, g);
        }
        const int gwaves = nblk * 8, gw = bid * 8 + w;
        for (int rep = 0; rep < REP_P0; ++rep)
        for (int r = gw; r < DEPTH * 16384 * 2; r += gwaves) {
            const int which = r & 1, le = r >> 1;
            conv_table_row((which ? P.peer_up : P.peer_down) + (size_t)le * D, (which ? TBu : TBd) + (size_t)le * 512, SC + (size_t)le * 2 + which, lane, which == 0);
        }
    }
    grid.sync();
    for (int tile = bid; tile < NTILE; tile += nblk) {
        const int b = tile >> 5;
        for (int l = 0; l < DEPTH; ++l)
            for (int j = tid; j < 6144; j += 512) {
                float v = P.b_ada[l * 6144 + j];
#pragma unroll
                for (int ks = 0; ks < 16; ++ks) v += modp[((size_t)(ks * 4 + l) * 8 + b) * 6144 + j];
                mod[((size_t)l * 8 + b) * 6144 + j] = v;
            }
    }
    __syncthreads();

    for (int l = 0; l < DEPTH; ++l) {
        const float* xin = l == 0 ? P.x : P.out;
        InProjOut IO;
        IO.QF = (bf16_t*)(ws + WS_QF); IO.KF2 = (bf16_t*)(ws + WS_KF2 + (size_t)l * 8 * MiB); IO.VF = (bf16_t*)(ws + WS_VF + (size_t)l * 8 * MiB);
        IO.CBR = (bf16_t*)(ws + WS_CBR); IO.ZR = (bf16_t*)(ws + WS_ZR + (size_t)l * 16 * MiB); IO.YS = (bf16_t*)(ws + WS_YS);
        for (int tile = bid; tile < NTILE; tile += nblk) {
            const float* mb_ = mod + ((size_t)l * 8 + (tile >> 5)) * 6144;
            if (l == 0) {
                norm_to_frag(xin, P.norm1_g + l * D, mb_ + 0, mb_ + 1024, hA, (float*)lds, tile, tid, false);
                __syncthreads();
            }
            for (int rep = 0; rep < REP_GEMM; ++rep) inproj_tile(hA + (size_t)tile * 131072, WinF + (size_t)l * 2097152, P.q_norm_g + l * 64, P.k_norm_g + l * 64, SWF + (size_t)l * 65536, P.sgu_b + l * 512, IO, lds, tile, tid);
            asm volatile("s_waitcnt vmcnt(0)" ::: "memory");
            __syncthreads();
            if (tid == 0) {
                __builtin_amdgcn_fence(__ATOMIC_RELEASE, "agent");
                asm volatile("s_waitcnt vmcnt(0)" ::: "memory");
                __hip_atomic_store(flags + tile, (unsigned)(l + 1), __ATOMIC_RELAXED, __HIP_MEMORY_SCOPE_AGENT);
            }
        }
        for (int tile = bid; tile < NTILE; tile += nblk) {
            const float* mb_ = mod + ((size_t)l * 8 + (tile >> 5)) * 6144;
            if ((tile & 31) != 0) {
                if (tid == 0) {
                    unsigned spins = 0;
                    while (__hip_atomic_load(flags + tile - 1, __ATOMIC_RELAXED, __HIP_MEMORY_SCOPE_AGENT) < (unsigned)(l + 1) && ++spins < (1u << 24)) __builtin_amdgcn_s_sleep(2);
                    __builtin_amdgcn_fence(__ATOMIC_ACQUIRE, "agent");
                    asm volatile("s_waitcnt vmcnt(0)" ::: "memory");
                }
                __syncthreads();
            }
            for (int rep = 0; rep < REP_MIX; ++rep) {
            attn_tile(IO.QF, IO.KF2, IO.VF, lds, bias_lds, P.attn_sink + l * 8, OR, tile, tid);
            __syncthreads();
            merge_tile(OR, IO.CBR, IO.ZR, IO.YS, P.conv_w + l * 768, P.out_norm_g + l * D, hA, tile, tid);
            __syncthreads();
            }
            {
                const bf16_t* At = hA + (size_t)tile * 131072;
                const bf16_t* WF = WoutF + (size_t)l * 1048576;
                for (int pass = 0; pass < 2; ++pass) {
                    f32x16 acc[4][2];
                    const int nbt0 = pass * 16 + w * 2;
                    kloop<0>(acc, At, WF + (size_t)nbt0 * 32768, WF + (size_t)(nbt0 + 1) * 32768, lds, tid, lane);
                    epi_resid(acc, xin, P.out, mb_ + 2048, (float*)(lds + LDS_EPI) + w * 2176, (float*)(lds + LDS_SSQ) + (pass * 8 + w) * 128, tile, pass * 512 + w * 64, lane);
                }
            }
            __syncthreads();
            if (tid < 128) { const float* sq = (const float*)(lds + LDS_SSQ); float ssum = 0.f;
#pragma unroll
                for (int c = 0; c < 16; ++c) ssum += sq[c * 128 + tid];
                ((float*)lds)[tid] = rsqrtf(ssum * (1.f / D) + EPS); }
            __syncthreads();
            norm_to_frag(P.out, P.norm2_g + l * D, mb_ + 3072, mb_ + 4096, hA, (float*)lds, tile, tid, true);
            __syncthreads();
            {
                const bf16_t* At = hA + (size_t)tile * 131072;
                const bf16_t* WF = WpqF + (size_t)l * 2097152;
                for (int rep = 0; rep < REP_GEMM; ++rep)
                for (int pass = 0; pass < 4; ++pass) {
                    f32x16 acc[4][2];
                    const int nbt0 = pass * 16 + w * 2;
                    kloop<1>(acc, At, WF + (size_t)nbt0 * 32768, WF + (size_t)(nbt0 + 1) * 32768, lds, tid, lane);
                    epi_qpf(acc, QPF, tile, nbt0, lane);
                }
            }
            __syncthreads();
            for (int rep = 0; rep < REP_ROUTE; ++rep) { route_tile(QPF, KeysF + (size_t)l * 262144, lds, (unsigned char*)lds + PL_RIDX, tile, tid); __syncthreads(); }
            peer_down_wave(hA, lds, TBd + (size_t)l * 16384 * 512, SC + (size_t)l * 32768, tile, w, lane);
            __syncthreads();
            {
                const float* mbn = mod + ((size_t)(l + 1 < DEPTH ? l + 1 : l) * 8 + (tile >> 5)) * 6144;
                peer_up_wave(lds, TBu + (size_t)l * 16384 * 512, mb_ + 5120, P.out, tile, w, lane, l + 1 < DEPTH ? hA : nullptr, P.norm1_g + (l + 1 < DEPTH ? l + 1 : l) * D, mbn + 0, mbn + 1024);
            }
            __syncthreads();
        }
    }
}
}

extern "C" void kernel_launch(void* const* d_in, const int* in_sizes, int n_in, void* d_out, int out_size, void* d_ws, size_t ws_size, hipStream_t stream) {
    using namespace op;
    static int grid_blocks = 0;
    if (!grid_blocks) {
        int dev = 0, cus = 0, per_cu = 0;
        (void)hipGetDevice(&dev);
        (void)hipDeviceGetAttribute(&cus, hipDeviceAttributeMultiprocessorCount, dev);
        (void)hipFuncSetAttribute((const void*)hybrid_fwd, hipFuncAttributeMaxDynamicSharedMemorySize, LDS_BYTES);
        (void)hipOccupancyMaxActiveBlocksPerMultiprocessor(&per_cu, (const void*)hybrid_fwd, 512, LDS_BYTES);
        if (per_cu < 1) per_cu = 1;
        grid_blocks = cus * per_cu;
        if (grid_blocks > NTILE) grid_blocks = NTILE;
        if (ws_size < WS_END) { fprintf(stderr, "kernel_launch: workspace too small (%zu < %zu)\n", ws_size, (size_t)WS_END); grid_blocks = -1; }
    }
    if (grid_blocks < 0) return;
    Params p{};
    p.x = (const float*)d_in[0]; p.c = (const float*)d_in[1]; p.rel_bias = (const float*)d_in[2]; p.w_ada = (const float*)d_in[3]; p.b_ada = (const float*)d_in[4];
    p.norm1_g = (const float*)d_in[5]; p.norm2_g = (const float*)d_in[6]; p.w_in = (const float*)d_in[7]; p.q_norm_g = (const float*)d_in[8]; p.k_norm_g = (const float*)d_in[9];
    p.attn_sink = (const float*)d_in[10]; p.conv_w = (const float*)d_in[11]; p.sgu_w = (const float*)d_in[12]; p.sgu_b = (const float*)d_in[13]; p.out_norm_g = (const float*)d_in[14];
    p.w_out = (const float*)d_in[15]; p.peer_wq = (const float*)d_in[16]; p.peer_sub_keys = (const float*)d_in[17]; p.peer_down = (const float*)d_in[18]; p.peer_up = (const float*)d_in[19];
    p.out = (float*)d_out; p.ws = (char*)d_ws;
    void* args[] = {&p};
    hipError_t e = hipLaunchCooperativeKernel((const void*)hybrid_fwd, dim3(grid_blocks), dim3(512), args, LDS_BYTES, stream);
    if (e != hipSuccess) fprintf(stderr, "kernel_launch: cooperative launch failed: %s (grid %d)\n", hipGetErrorString(e), grid_blocks);
}
```

```cpp
#include <hip/hip_runtime.h>
#include <cstdio>
#include <cstdint>
#include <hip/hip_cooperative_groups.h>
namespace cg = cooperative_groups;


namespace op {
#define DI __device__ __forceinline__
typedef unsigned short bf16_t;
typedef short bf16x8 __attribute__((ext_vector_type(8)));
typedef float f32x16 __attribute__((ext_vector_type(16)));
typedef float f32x2 __attribute__((ext_vector_type(2)));
typedef unsigned u32x4 __attribute__((ext_vector_type(4)));
typedef unsigned u32x2 __attribute__((ext_vector_type(2)));
typedef __bf16 bf16v2 __attribute__((ext_vector_type(2)));
constexpr int D = 1024, NB = 8, S = 4096, DEPTH = 4, T = NB * S, NTILE = T / 128;
constexpr float EPS = 1e-6f;
constexpr int PL_SEID = 0, PL_SWGT = 32768, PL_END = 98304, PL_RIDX = 98304;
constexpr int LDS_EPI = 32768, LDS_SSQ = 102400, LDS_RSTD1 = 110592, LDS_BIAS = 128 * 1024, LDS_BYTES = 132 * 1024;
constexpr int REP_GEMM = 1, REP_ROUTE = 1, REP_MIX = 1, REP_NORM = 1, REP_P0 = 1;
#define MFMA32(a, b, c) __builtin_amdgcn_mfma_f32_32x32x16_bf16((a), (b), (c), 0, 0, 0)

DI unsigned pk2(float lo, float hi) { f32x2 v = {lo, hi}; return __builtin_bit_cast(unsigned, __builtin_convertvector(v, bf16v2)); }
DI int opaque_v(int x) { asm volatile("" : "+v"(x)); return x; }
DI int opaque_s(int x) { asm volatile("" : "+s"(x)); return x; }
DI int crow(int reg, int hh) { return (reg & 3) + 8 * (reg >> 2) + 4 * hh; }
template <int CTRL> DI float dppf(float v) { return __int_as_float(__builtin_amdgcn_update_dpp(0, __float_as_int(v), CTRL, 0xf, 0xf, true)); }
template <int CTRL> DI int dppi(int v) { return __builtin_amdgcn_update_dpp(0, v, CTRL, 0xf, 0xf, true); }
DI float red16_sum(float v) { v += dppf<0xB1>(v); v += dppf<0x4E>(v); v += dppf<0x141>(v); v += dppf<0x140>(v); return v; }
DI float red16_max(float v) { v = fmaxf(v, dppf<0xB1>(v)); v = fmaxf(v, dppf<0x4E>(v)); v = fmaxf(v, dppf<0x141>(v)); v = fmaxf(v, dppf<0x140>(v)); return v; }
DI float x16_sum(float v) { auto s = __builtin_amdgcn_permlane16_swap(__float_as_uint(v), __float_as_uint(v), false, false); return __uint_as_float(s[0]) + __uint_as_float(s[1]); }
DI float x32_sum(float v) { auto s = __builtin_amdgcn_permlane32_swap(__float_as_uint(v), __float_as_uint(v), false, false); return __uint_as_float(s[0]) + __uint_as_float(s[1]); }
DI float x16_max(float v) { auto s = __builtin_amdgcn_permlane16_swap(__float_as_uint(v), __float_as_uint(v), false, false); return fmaxf(__uint_as_float(s[0]), __uint_as_float(s[1])); }
DI float x32_max(float v) { auto s = __builtin_amdgcn_permlane32_swap(__float_as_uint(v), __float_as_uint(v), false, false); return fmaxf(__uint_as_float(s[0]), __uint_as_float(s[1])); }
DI float red32_sum(float v) { return x16_sum(red16_sum(v)); }
DI float wave_sum(float v) { return x32_sum(x16_sum(red16_sum(v))); }
DI float wave_max(float v) { return x32_max(x16_max(red16_max(v))); }

DI int col_perm(int npos, int mode) {
    if (mode == 1 && npos >= 1024 && npos < 1536) { const int q = npos - 1024, w = q >> 6, nb = (q >> 5) & 1, r = q & 31; return (nb ? 1280 : 1024) + 32 * w + r; }
    return npos;
}
DI void conv_wfrag_item(const float* __restrict__ W, int N, int KB, bf16_t* __restrict__ WF, int gid, int mode) {
    const int l = gid & 63, kb = (gid >> 6) % KB, nbt = (gid >> 6) / KB, r = l & 31, hh = l >> 5;
    const int n = col_perm(nbt * 32 + r, mode);
    const float* p = W + (size_t)(kb * 16 + 8 * hh) * N + n;
    float v[8];
#pragma unroll
    for (int j = 0; j < 8; ++j) v[j] = p[(size_t)j * N];
    u32x4 o; o.x = pk2(v[0], v[1]); o.y = pk2(v[2], v[3]); o.z = pk2(v[4], v[5]); o.w = pk2(v[6], v[7]);
    *(u32x4*)(WF + (size_t)gid * 8) = o;
}

DI void norm_to_frag(const float* __restrict__ x, const float* __restrict__ g, const float* __restrict__ sh, const float* __restrict__ sc, bf16_t* __restrict__ hA, float* rstd_lds, int tile, int tid, bool have_rstd) {
    tid = opaque_v(tid); tile = opaque_s(tile);
    const int w = tid >> 6, lane = tid & 63;
    float cg[16], cs[16], ch[16];
#pragma unroll
    for (int j = 0; j < 2; ++j)
#pragma unroll
        for (int q = 0; q < 2; ++q) {
            const int c = 512 * j + 8 * lane + 4 * q;
            const float4 a = *(const float4*)(g + c), b = *(const float4*)(sc + c), d = *(const float4*)(sh + c);
            cg[8 * j + 4 * q] = a.x * (1.f + b.x); cg[8 * j + 4 * q + 1] = a.y * (1.f + b.y); cg[8 * j + 4 * q + 2] = a.z * (1.f + b.z); cg[8 * j + 4 * q + 3] = a.w * (1.f + b.w);
            ch[8 * j + 4 * q] = d.x; ch[8 * j + 4 * q + 1] = d.y; ch[8 * j + 4 * q + 2] = d.z; ch[8 * j + 4 * q + 3] = d.w;
            cs[8 * j + 4 * q] = 0.f; cs[8 * j + 4 * q + 1] = 0.f; cs[8 * j + 4 * q + 2] = 0.f; cs[8 * j + 4 * q + 3] = 0.f;
        }
    (void)cs;
#pragma unroll 8
    for (int rr = 0; rr < 16; ++rr) {
        const int row = w * 16 + rr;
        const float* xr = x + ((size_t)tile * 128 + row) * D + 8 * lane;
        float v[16];
#pragma unroll
        for (int j = 0; j < 2; ++j)
#pragma unroll
            for (int q = 0; q < 2; ++q) { const float4 a = *(const float4*)(xr + 512 * j + 4 * q); v[8 * j + 4 * q] = a.x; v[8 * j + 4 * q + 1] = a.y; v[8 * j + 4 * q + 2] = a.z; v[8 * j + 4 * q + 3] = a.w; }
        float r;
        if (have_rstd) r = rstd_lds[row];
        else {
            float ss = 0.f;
#pragma unroll
            for (int e = 0; e < 16; ++e) ss += v[e] * v[e];
            r = rsqrtf(wave_sum(ss) * (1.f / D) + EPS);
        }
        bf16_t* orow = hA + ((size_t)tile * 128 + row) * D + 8 * lane;
#pragma unroll
        for (int j = 0; j < 2; ++j) {
            u32x4 o;
            o.x = pk2(v[8 * j] * r * cg[8 * j] + ch[8 * j], v[8 * j + 1] * r * cg[8 * j + 1] + ch[8 * j + 1]);
            o.y = pk2(v[8 * j + 2] * r * cg[8 * j + 2] + ch[8 * j + 2], v[8 * j + 3] * r * cg[8 * j + 3] + ch[8 * j + 3]);
            o.z = pk2(v[8 * j + 4] * r * cg[8 * j + 4] + ch[8 * j + 4], v[8 * j + 5] * r * cg[8 * j + 5] + ch[8 * j + 5]);
            o.w = pk2(v[8 * j + 6] * r * cg[8 * j + 6] + ch[8 * j + 6], v[8 * j + 7] * r * cg[8 * j + 7] + ch[8 * j + 7]);
            *(u32x4*)(orow + 512 * j) = o;
        }
    }
}

template <int ORIENT>
DI void kloop(f32x16 (&acc)[4][2], const bf16_t* __restrict__ At, const bf16_t* __restrict__ W0, const bf16_t* __restrict__ W1, char* lds, int tid, int lane) {
    tid = opaque_v(tid); lane = opaque_v(lane);
#pragma unroll
    for (int mb = 0; mb < 4; ++mb)
#pragma unroll
        for (int nb = 0; nb < 2; ++nb)
#pragma unroll
            for (int i = 0; i < 16; ++i) acc[mb][nb][i] = 0.f;
    {
    const int c8_ = (tid >> 3) & 7, rowA_ = (tid >> 6) * 8 + (tid & 7);
    const u32x4* Ag = (const u32x4*)(At + (unsigned)(rowA_ * 1024 + c8_ * 8));
    const int ldsA_ = ((((c8_ >> 1) * 4 + (rowA_ >> 5)) * 64) + (rowA_ & 31) + 32 * (c8_ & 1)) * 16;
    const u32x4* W0g = (const u32x4*)W0 + lane;
    const u32x4* W1g = (const u32x4*)W1 + lane;
    u32x4 wq[4][2], arA[2], arB[2];
    arA[0] = Ag[0]; arA[1] = Ag[8192]; arB[0] = Ag[8]; arB[1] = Ag[8 + 8192];
#pragma unroll
    for (int kk = 0; kk < 4; ++kk) { wq[kk][0] = W0g[kk * 64]; wq[kk][1] = W1g[kk * 64]; }
    *(u32x4*)(lds + ldsA_) = arA[0]; *(u32x4*)(lds + ldsA_ + 2048) = arA[1];
    __syncthreads();
#define KL_ITER(KC, ARL, ARS) do { \
        char* cur = lds + ((KC) & 1) * 16384; \
        char* nxt = lds + (((KC) + 1) & 1) * 16384; \
        const int kn = (KC) < 15 ? (KC) + 1 : 15, k2 = (KC) < 14 ? (KC) + 2 : 15; \
        if ((KC) < 14) { ARL[0] = Ag[k2 * 8]; ARL[1] = Ag[k2 * 8 + 8192]; } \
        __builtin_amdgcn_sched_barrier(0); \
        bf16x8 afr[2][4]; \
        _Pragma("unroll") for (int mb = 0; mb < 4; ++mb) afr[0][mb] = *(const bf16x8*)(cur + ((0 * 4 + mb) * 64 + lane) * 16); \
        _Pragma("unroll") for (int kk = 0; kk < 4; ++kk) { \
            if (kk < 3) { _Pragma("unroll") for (int mb = 0; mb < 4; ++mb) afr[(kk + 1) & 1][mb] = *(const bf16x8*)(cur + (((kk + 1) * 4 + mb) * 64 + lane) * 16); } \
            _Pragma("unroll") for (int mb = 0; mb < 4; ++mb) \
                _Pragma("unroll") for (int nb = 0; nb < 2; ++nb) { \
                    const bf16x8 wf = __builtin_bit_cast(bf16x8, wq[kk][nb]); \
                    if (ORIENT == 0) acc[mb][nb] = MFMA32(afr[kk & 1][mb], wf, acc[mb][nb]); \
                    else acc[mb][nb] = MFMA32(wf, afr[kk & 1][mb], acc[mb][nb]); \
                } \
            if ((KC) < 15) { wq[kk][0] = W0g[(kn * 4 + kk) * 64]; wq[kk][1] = W1g[(kn * 4 + kk) * 64]; } \
            __builtin_amdgcn_sched_barrier(0); \
        } \
        if ((KC) < 15) { *(u32x4*)(nxt + ldsA_) = ARS[0]; *(u32x4*)(nxt + ldsA_ + 2048) = ARS[1]; } \
        __syncthreads(); \
    } while (0)
    for (int kc = 0; kc < 16; kc += 2) { KL_ITER(kc, arA, arB); KL_ITER(kc + 1, arB, arA); }
#undef KL_ITER
    }
}

DI void epi_f32row(const f32x16 (&acc)[4][2], float* __restrict__ C, int tile, int col0, int lane) {
    lane = opaque_v(lane);
    const int r5 = lane & 31, hh = lane >> 5;
    const unsigned boff = (unsigned)((tile * 128 + 4 * hh) * 2048 + col0 + r5);
#pragma unroll
    for (int mb = 0; mb < 4; ++mb)
#pragma unroll
        for (int nb = 0; nb < 2; ++nb)
#pragma unroll
            for (int i = 0; i < 16; ++i)
                C[boff + (unsigned)((mb * 32 + (i & 3) + 8 * (i >> 2)) * 2048 + nb * 32)] = acc[mb][nb][i];
}
DI void epi_resid(const f32x16 (&acc)[4][2], const float* __restrict__ xin, float* __restrict__ xout, const float* __restrict__ gate_b, float* T  , float* ssq  , int tile, int col0, int lane) {
    lane = opaque_v(lane);
    const int r5 = lane & 31, hh = lane >> 5, rq = lane >> 4, c4 = (lane & 15) * 4;
    const float4 gv = *(const float4*)(gate_b + col0 + c4);
#pragma unroll
    for (int mb = 0; mb < 4; ++mb) {
#pragma unroll
        for (int nb = 0; nb < 2; ++nb)
#pragma unroll
            for (int i = 0; i < 16; ++i) T[((i & 3) + 8 * (i >> 2) + 4 * hh) * 68 + nb * 32 + r5] = acc[mb][nb][i];
        asm volatile("s_waitcnt lgkmcnt(0)" ::: "memory");
#pragma unroll
        for (int j = 0; j < 8; ++j) {
            const int row = rq + 4 * j;
            const float4 v = *(const float4*)(T + row * 68 + c4);
            const unsigned o = (unsigned)((tile * 128 + mb * 32 + row) * D + col0 + c4);
            float4 xv = *(const float4*)(xin + o);
            xv.x += gv.x * v.x; xv.y += gv.y * v.y; xv.z += gv.z * v.z; xv.w += gv.w * v.w;
            *(float4*)(xout + o) = xv;
            float ss = xv.x * xv.x + xv.y * xv.y + xv.z * xv.z + xv.w * xv.w;
            ss = red16_sum(ss);
            if ((lane & 15) == 0) ssq[mb * 32 + row] = ss;
        }
        asm volatile("s_waitcnt lgkmcnt(0)" ::: "memory");
    }
}

DI void epi_qpf(const f32x16 (&acc)[4][2], bf16_t* __restrict__ QPF, int tile, int ft0, int lane) {
    lane = opaque_v(lane);
#pragma unroll
    for (int nb = 0; nb < 2; ++nb)
#pragma unroll
        for (int s = 0; s < 2; ++s)
#pragma unroll
            for (int mb = 0; mb < 4; ++mb) {
                const f32x16& a = acc[mb][nb];
                u32x4 o; o.x = pk2(a[8 * s], a[8 * s + 1]); o.y = pk2(a[8 * s + 2], a[8 * s + 3]); o.z = pk2(a[8 * s + 4], a[8 * s + 5]); o.w = pk2(a[8 * s + 6], a[8 * s + 7]);
                *(u32x4*)(QPF + ((unsigned)((((tile * 64 + ft0 + nb) * 2 + s) * 4 + mb) * 64 + lane)) * 8) = o;
            }
}

DI void conv_keys_item(const float* __restrict__ K, bf16_t* __restrict__ KF, int gid) {
    const int lane = gid & 63, s = (gid >> 6) & 1, nbl = (gid >> 7) & 3, nt = (gid >> 9) & 3, hp = gid >> 11;
    const int r = lane & 31, hh = lane >> 5;
    const float* p = K + ((size_t)hp * 128 + nt * 32 + r) * 128 + nbl * 32 + 16 * s + 4 * hh;
    const float4 a = *(const float4*)p, b = *(const float4*)(p + 8);
    u32x4 o; o.x = pk2(a.x, a.y); o.y = pk2(a.z, a.w); o.z = pk2(b.x, b.y); o.w = pk2(b.z, b.w);
    *(u32x4*)(KF + (size_t)gid * 8) = o;
}

DI void conv_table_row(const float* __restrict__ src, unsigned char* __restrict__ dst, float* __restrict__ sc, int lane, bool as_int4) {
    const float4* p = (const float4*)src + lane * 4;
    float4 v[4];
    float m = 0.f;
#pragma unroll
    for (int j = 0; j < 4; ++j) { v[j] = p[j]; m = fmaxf(m, fmaxf(fmaxf(fabsf(v[j].x), fabsf(v[j].y)), fmaxf(fabsf(v[j].z), fabsf(v[j].w)))); }
    m = wave_max(m);
    float scale = m > 0.f ? m * (1.f / 6.f) : 1.f;
    if (as_int4) {
        float ss = 0.f;
#pragma unroll
        for (int j = 0; j < 4; ++j) ss += v[j].x * v[j].x + v[j].y * v[j].y + v[j].z * v[j].z + v[j].w * v[j].w;
        ss = wave_sum(ss);
        const float sg = sqrtf(ss * (1.f / 1024.f));
        scale = fmaxf(sg * (1.f / 2.8f), m * (1.f / 16.f));
        if (!(scale > 0.f)) scale = 1.f;
    }
    const float inv = 1.f / scale;
    u32x2 o;
    unsigned* op = (unsigned*)&o;
#pragma unroll
    for (int j = 0; j < 2; ++j) {
        const float f[8] = {v[2 * j].x, v[2 * j].y, v[2 * j].z, v[2 * j].w, v[2 * j + 1].x, v[2 * j + 1].y, v[2 * j + 1].z, v[2 * j + 1].w};
        unsigned wv = 0;
        if (as_int4) {
#pragma unroll
            for (int e = 0; e < 8; ++e) { int q = __float2int_rn(f[e] * inv); q = q < -7 ? -7 : (q > 7 ? 7 : q); wv |= ((unsigned)q & 15u) << (4 * e); }
        } else {
            wv = __builtin_amdgcn_cvt_scalef32_pk_fp4_f32(wv, f[0] * inv, f[1] * inv, 1.0f, 0);
            wv = __builtin_amdgcn_cvt_scalef32_pk_fp4_f32(wv, f[2] * inv, f[3] * inv, 1.0f, 1);
            wv = __builtin_amdgcn_cvt_scalef32_pk_fp4_f32(wv, f[4] * inv, f[5] * inv, 1.0f, 2);
            wv = __builtin_amdgcn_cvt_scalef32_pk_fp4_f32(wv, f[6] * inv, f[7] * inv, 1.0f, 3);
        }
        op[j] = wv;
    }
    *(u32x2*)(dst + lane * 8) = o;
    if (lane == 0) *sc = scale;
}

DI void ce_desc(int& a, int& b) { const int mx = a > b ? a : b, mn = a > b ? b : a; a = mx; b = mn; }
DI void sort16_desc(int (&v)[16]) {
#pragma unroll
    for (int k = 2; k <= 16; k <<= 1)
#pragma unroll
        for (int j = k >> 1; j > 0; j >>= 1)
#pragma unroll
            for (int i = 0; i < 16; ++i) {
                const int l = i ^ j;
                if (l > i) { if ((i & k) == 0) ce_desc(v[i], v[l]); else ce_desc(v[l], v[i]); }
            }
}
DI void bitonic_merge16_desc(int (&v)[16]) {
#pragma unroll
    for (int j = 8; j > 0; j >>= 1)
#pragma unroll
        for (int i = 0; i < 16; ++i) { const int l = i ^ j; if (l > i) ce_desc(v[i], v[l]); }
}
DI void merge_top16(int (&a)[16], const int (&b)[16]) {
#pragma unroll
    for (int i = 0; i < 16; ++i) a[i] = a[i] > b[15 - i] ? a[i] : b[15 - i];
    bitonic_merge16_desc(a);
}
DI int f2ord(float f) { int b = __float_as_int(f); return b ^ ((b >> 31) & 0x7fffffff); }
DI float ord2f(int k) { return __int_as_float(k ^ ((k >> 31) & 0x7fffffff)); }

DI void route_tile(const bf16_t* __restrict__ QPF, const bf16_t* __restrict__ KF, char* lds_lists, unsigned char* lds_idx  , int tile, int tid) {
    tid = opaque_v(tid); tile = opaque_s(tile);
    const int lane = tid & 63, w = __builtin_amdgcn_readfirstlane(tid >> 6);
    const int r5 = lane & 31, hh = lane >> 5;
    unsigned char* myidx = lds_idx + w * 1024;
    for (int task = w; task < 32; task += 8) {
        const int h = task >> 2, tt = task & 3;
        f32x16 acc[2][4];
#pragma unroll
        for (int p = 0; p < 2; ++p)
#pragma unroll
            for (int nt = 0; nt < 4; ++nt)
#pragma unroll
                for (int i = 0; i < 16; ++i) acc[p][nt][i] = 0.f;
        {
            bf16x8 bq[3], ak[3][4];
#define ROUTE_LOAD(buf, step) do { const int p_ = (step) >> 3, ks_ = (step) & 7; \
                bq[buf] = *(const bf16x8*)(QPF + ((unsigned)((((tile * 64 + h * 8 + p_ * 4 + (ks_ >> 1)) * 2 + (ks_ & 1)) * 4 + tt) * 64 + lane)) * 8); \
                _Pragma("unroll") for (int nt = 0; nt < 4; ++nt) ak[buf][nt] = *(const bf16x8*)(KF + ((unsigned)(((((h * 2 + p_) * 4 + nt) * 8 + ks_) * 64) + lane)) * 8); } while (0)
            ROUTE_LOAD(0, 0);
            ROUTE_LOAD(1, 1);
#pragma unroll
            for (int step = 0; step < 16; ++step) {
                if (step < 14) ROUTE_LOAD((step + 2) % 3, step + 2);
#pragma unroll
                for (int nt = 0; nt < 4; ++nt) acc[step >> 3][nt] = MFMA32(ak[step % 3][nt], bq[step % 3], acc[step >> 3][nt]);
                __builtin_amdgcn_sched_barrier(0);
            }
#undef ROUTE_LOAD
        }
        int g[8][16];
#pragma unroll
        for (int nt = 0; nt < 4; ++nt)
#pragma unroll
            for (int i = 0; i < 16; ++i) {
                const unsigned a = __float_as_uint(acc[0][nt][i]), b = __float_as_uint(acc[1][nt][i]);
                auto sw = __builtin_amdgcn_permlane32_swap(a, b, false, false);
                const int n0 = nt * 32 + (i & 3) + 8 * (i >> 2);
                g[nt * 2 + (i >> 3)][i & 7] = (f2ord(__uint_as_float(sw[0])) & ~127) | n0;
                g[nt * 2 + (i >> 3)][8 + (i & 7)] = (f2ord(__uint_as_float(sw[1])) & ~127) | (n0 + 4);
            }
#pragma unroll
        for (int q = 0; q < 8; ++q) sort16_desc(g[q]);
        merge_top16(g[0], g[1]); merge_top16(g[2], g[3]); merge_top16(g[4], g[5]); merge_top16(g[6], g[7]);
        merge_top16(g[0], g[2]); merge_top16(g[4], g[6]);
        merge_top16(g[0], g[4]);
        {
            u32x4 pk;
            unsigned* pp = (unsigned*)&pk;
#pragma unroll
            for (int q = 0; q < 4; ++q) pp[q] = (unsigned)(g[0][4 * q] & 127) | ((unsigned)(g[0][4 * q + 1] & 127) << 8) | ((unsigned)(g[0][4 * q + 2] & 127) << 16) | ((unsigned)(g[0][4 * q + 3] & 127) << 24);
            *(u32x4*)(myidx + lane * 16) = pk;
        }
        float f0[16], f1[16];
#pragma unroll
        for (int i = 0; i < 16; ++i) {
            const unsigned a = (unsigned)g[0][i], b = a;
            auto sw = __builtin_amdgcn_permlane32_swap(a, b, false, false);
            f0[i] = ord2f((int)sw[0] & ~127); f1[i] = ord2f((int)sw[1] & ~127);
        }
        int c0[16], c1[16], c2[16], c3[16];
#pragma unroll
        for (int j = 0; j < 16; ++j) c0[j] = (f2ord(f0[0] + f1[j]) & ~255) | j;
#pragma unroll
        for (int i = 1; i < 16; ++i) c1[i - 1] = (f2ord(f0[i] + f1[0]) & ~255) | (i << 4);
        c1[15] = (int)0x80000000;
#define CK(i, j) ((f2ord(f0[i] + f1[j]) & ~255) | ((i) << 4) | (j))
        c2[0] = CK(1, 1); c2[1] = CK(1, 2); c2[2] = CK(1, 3); c2[3] = CK(1, 4); c2[4] = CK(1, 5); c2[5] = CK(1, 6); c2[6] = CK(1, 7);
        c2[7] = CK(2, 1); c2[8] = CK(2, 2); c2[9] = CK(2, 3); c2[10] = CK(2, 4);
        c2[11] = CK(3, 1); c2[12] = CK(3, 2); c2[13] = CK(3, 3);
        c2[14] = CK(4, 1); c2[15] = CK(4, 2);
        c3[0] = CK(5, 1); c3[1] = CK(6, 1); c3[2] = CK(7, 1);
#undef CK
#pragma unroll
        for (int q = 3; q < 16; ++q) c3[q] = (int)0x80000000;
        sort16_desc(c2);
        ce_desc(c3[0], c3[1]); ce_desc(c3[1], c3[2]); ce_desc(c3[0], c3[1]);
        merge_top16(c0, c1); merge_top16(c2, c3); merge_top16(c0, c2);
        float bs[16], den = 0.f;
#pragma unroll
        for (int i = 0; i < 16; ++i) { bs[i] = __expf(ord2f(c0[i] & ~255) - ord2f(c0[0] & ~255)); den += bs[i]; }
        const float rden = 1.f / den;
        asm volatile("s_waitcnt lgkmcnt(0)" ::: "memory");
#pragma unroll
        for (int q = 0; q < 8; ++q) {
            const int key = (int)__builtin_amdgcn_permlane32_swap((unsigned)c0[q], (unsigned)c0[8 + q], false, false)[0];
            const float gv = __uint_as_float(__builtin_amdgcn_permlane32_swap(__float_as_uint(bs[q]), __float_as_uint(bs[8 + q]), false, false)[0]) * rden;
            const int i = (key >> 4) & 15, j = key & 15;
            const int e = (int)myidx[r5 * 16 + i] * 128 + (int)myidx[(32 + r5) * 16 + j];
            const int tokl = tt * 32 + r5;
            ((unsigned short*)(lds_lists + PL_SEID))[tokl * 128 + h * 16 + 8 * hh + q] = (unsigned short)e;
            ((float*)(lds_lists + PL_SWGT))[tokl * 128 + h * 16 + 8 * hh + q] = gv;
        }
        asm volatile("s_waitcnt lgkmcnt(0)" ::: "memory");
    }
}

DI void unpack_h2(const bf16_t* __restrict__ hA, int t, int lane, f32x2 (&hv)[8]) {
    const int tile = t >> 7, row = t & 127, mb = row >> 5, r5 = row & 31;
    const bf16_t* hp = hA + ((unsigned)(((tile * 64 + lane) * 4 + mb) * 64 + r5)) * 8;
    const u32x4 ha = *(const u32x4*)hp, hb = *(const u32x4*)(hp + 32 * 8);
    const unsigned hw[8] = {ha.x, ha.y, ha.z, ha.w, hb.x, hb.y, hb.z, hb.w};
#pragma unroll
    for (int q = 0; q < 8; ++q) { hv[q].x = __uint_as_float(hw[q] << 16); hv[q].y = __uint_as_float(hw[q] & 0xffff0000u); }
}
typedef _Float16 h16x2 __attribute__((ext_vector_type(2)));
DI h16x2 fp4h(unsigned w, int sel) {
    return sel == 0 ? __builtin_amdgcn_cvt_scalef32_pk_f16_fp4(w, 1.0f, 0) : sel == 1 ? __builtin_amdgcn_cvt_scalef32_pk_f16_fp4(w, 1.0f, 1)
         : sel == 2 ? __builtin_amdgcn_cvt_scalef32_pk_f16_fp4(w, 1.0f, 2) : __builtin_amdgcn_cvt_scalef32_pk_f16_fp4(w, 1.0f, 3);
}
DI unsigned rowoff_lo(unsigned pr, unsigned k512, unsigned lane8) { unsigned r; asm("v_mad_u32_u16 %0, %1, %2, %3" : "=v"(r) : "v"(pr), "s"(k512), "v"(lane8)); return r; }
DI unsigned rowoff_hi(unsigned pr, unsigned k512, unsigned lane8) { unsigned r; asm("v_mad_u32_u16 %0, %1, %2, %3 op_sel:[1,0,0,0]" : "=v"(r) : "v"(pr), "s"(k512), "v"(lane8)); return r; }
DI int dot8z(int a, int b) { int r; asm("v_dot8_i32_i4 %0, %1, %2, 0" : "=v"(r) : "v"(a), "v"(b)); return r; }
DI void stage_token(const int* __restrict__ ridx, const float* __restrict__ rgate, char* lds, int t, int tloc, int lane) {
    lane = opaque_v(lane); t = opaque_s(t);
    unsigned short* seid = (unsigned short*)(lds + PL_SEID) + tloc * 128;
    float* swgt = (float*)(lds + PL_SWGT) + tloc * 128;
    seid[lane] = (unsigned short)ridx[(unsigned)(t * 128 + lane)]; seid[64 + lane] = (unsigned short)ridx[(unsigned)(t * 128 + 64 + lane)];
    swgt[lane] = rgate[(unsigned)(t * 128 + lane)]; swgt[64 + lane] = rgate[(unsigned)(t * 128 + 64 + lane)];
}
DI void peer_down_wave(const bf16_t* __restrict__ hA, char* lds, const unsigned char* __restrict__ TBd, const float* __restrict__ SC, int tile, int w, int lane) {
    lane = opaque_v(lane);
    const int half = lane >> 5;
    const unsigned lane16 = (unsigned)(lane & 31) * 16u;
    const int cb = (lane & 31) * 32 + half * 16;
    const int myu = 2 * (((lane >> 4) & 1) * 4 + ((lane >> 3) & 1) * 2 + ((lane >> 2) & 1)) + half;
    const unsigned short* seid = (const unsigned short*)(lds + PL_SEID) + w * 16 * 128;
    float* swgt = (float*)(lds + PL_SWGT) + w * 16 * 128;
    u32x4 haN, hbN;
    { const bf16_t* hp0 = hA + (unsigned)((tile * 128 + w * 16) * 1024 + cb); haN = *(const u32x4*)hp0; hbN = *(const u32x4*)(hp0 + 8); }
    u32x4 R[2][8];
    unsigned IDN[8];
#define DOWN_IDS(P_) do { _Pragma("unroll") for (int u_ = 0; u_ < 8; ++u_) IDN[u_] = seid[(P_) + 2 * u_ + half]; } while (0)
#define DOWN_LOADS(buf) do { _Pragma("unroll") for (int u_ = 0; u_ < 8; ++u_) R[buf][u_] = *(const u32x4*)(TBd + (IDN[u_] * 512u + lane16)); } while (0)
    DOWN_IDS(0); DOWN_LOADS(0); DOWN_IDS(16);
#pragma unroll 1
    for (int tl = 0; tl < 16; ++tl) {
        const int t = tile * 128 + w * 16 + tl;
        float* gp = swgt + tl * 128;
        const u32x4 ha = haN, hb = hbN;
        const int tn = tl < 15 ? tl + 1 : tl;
        const int pa_ = tl * 128 + (lane & 3) * 32 + myu;
        const f32x2 scA = *(const f32x2*)(SC + (unsigned)seid[pa_] * 2u), scB = *(const f32x2*)(SC + (unsigned)seid[pa_ + 16] * 2u);
        int rs[8];
        { const bf16_t* hp = hA + (unsigned)((t - tl + tn) * 1024 + cb); haN = *(const u32x4*)hp; hbN = *(const u32x4*)(hp + 8); }
        unsigned hhi[4], hlo[4];
        float hscale;
        {
            const unsigned hw[8] = {ha.x, ha.y, ha.z, ha.w, hb.x, hb.y, hb.z, hb.w};
            float hf[16];
            float m = 0.f;
#pragma unroll
            for (int q = 0; q < 8; ++q) { hf[2 * q] = __uint_as_float(hw[q] << 16); hf[2 * q + 1] = __uint_as_float(hw[q] & 0xffff0000u); m = fmaxf(m, fmaxf(fabsf(hf[2 * q]), fabsf(hf[2 * q + 1]))); }
            m = wave_max(m);
            hscale = m > 0.f ? m * (1.f / 119.f) : 1.f;
            const float inv = 1.f / hscale;
            unsigned qh[2] = {0u, 0u}, ql[2] = {0u, 0u};
#pragma unroll
            for (int e = 0; e < 16; ++e) {
                const int hq = __float2int_rn(hf[e] * inv);
                const int lo = ((hq + 8) & 15) - 8, hi = (hq - lo) >> 4;
                ql[e >> 3] |= ((unsigned)lo & 15u) << (4 * (e & 7));
                qh[e >> 3] |= ((unsigned)hi & 15u) << (4 * (e & 7));
            }
#pragma unroll
            for (int q = 0; q < 2; ++q) {
                auto sh_ = __builtin_amdgcn_permlane32_swap(qh[q], qh[q], false, false); hhi[q] = sh_[0]; hhi[2 + q] = sh_[1];
                auto sl_ = __builtin_amdgcn_permlane32_swap(ql[q], ql[q], false, false); hlo[q] = sl_[0]; hlo[2 + q] = sl_[1];
            }
        }
#pragma unroll
        for (int bt = 0; bt < 8; ++bt) {
            const int cur = bt & 1, nxt = cur ^ 1;
            const int p2 = bt < 6 ? tl * 128 + (bt + 2) * 16 : tn * 128 + (bt - 6) * 16;
            DOWN_LOADS(nxt);
            DOWN_IDS(p2);
            __builtin_amdgcn_sched_barrier(0);
            int part[8];
#pragma unroll
            for (int u = 0; u < 8; ++u) {
                const int r0_ = (int)R[cur][u].x, r1_ = (int)R[cur][u].y, r2_ = (int)R[cur][u].z, r3_ = (int)R[cur][u].w;
                int shi = dot8z(r0_, (int)hhi[0]);
                shi = __builtin_amdgcn_sdot8(r1_, (int)hhi[1], shi, false);
                shi = __builtin_amdgcn_sdot8(r2_, (int)hhi[2], shi, false);
                shi = __builtin_amdgcn_sdot8(r3_, (int)hhi[3], shi, false);
                int p_ = shi << 4;
                p_ = __builtin_amdgcn_sdot8(r0_, (int)hlo[0], p_, false);
                p_ = __builtin_amdgcn_sdot8(r1_, (int)hlo[1], p_, false);
                p_ = __builtin_amdgcn_sdot8(r2_, (int)hlo[2], p_, false);
                part[u] = __builtin_amdgcn_sdot8(r3_, (int)hlo[3], p_, false);
            }
            int r4[4], r2[2], r1;
            {
                const bool b3 = (lane & 8) != 0, b2 = (lane & 4) != 0;
#pragma unroll
                for (int q = 0; q < 4; ++q) { auto sw = __builtin_amdgcn_permlane16_swap((unsigned)part[q], (unsigned)part[q + 4], false, false); r4[q] = (int)sw[0] + (int)sw[1]; }
#pragma unroll
                for (int q = 0; q < 2; ++q) { const int keep = b3 ? r4[q + 2] : r4[q], give = b3 ? r4[q] : r4[q + 2]; r2[q] = keep + dppi<0x128>(give); }
                { const int keep = b2 ? r2[1] : r2[0], give = b2 ? r2[0] : r2[1]; r1 = keep + dppi<0x141>(give); }
                r1 += dppi<0x4E>(r1); r1 += dppi<0xB1>(r1);
            }
            rs[bt] = r1;
        }
        {
            const int j_ = lane & 3;
            const int ra = j_ == 0 ? rs[0] : j_ == 1 ? rs[2] : j_ == 2 ? rs[4] : rs[6];
            const int rb = j_ == 0 ? rs[1] : j_ == 1 ? rs[3] : j_ == 2 ? rs[5] : rs[7];
            float* gq = gp + j_ * 32 + myu;
            const float a0 = (float)ra * (scA.x * hscale), a1 = (float)rb * (scB.x * hscale);
            const float w0 = gq[0] * (0.5f * a0 * (1.f + erff(a0 * 0.70710678118654752f))) * scA.y;
            const float w1 = gq[16] * (0.5f * a1 * (1.f + erff(a1 * 0.70710678118654752f))) * scB.y;
            ((unsigned*)gq)[0] = (unsigned)__builtin_bit_cast(unsigned short, (_Float16)w0);
            ((unsigned*)gq)[16] = (unsigned)__builtin_bit_cast(unsigned short, (_Float16)w1);
        }
    }
#undef DOWN_IDS
#undef DOWN_LOADS
}
DI void peer_up_wave(char* lds, const unsigned char* __restrict__ TBu, const float* __restrict__ g2b, float* __restrict__ x, int tile, int w, int lane,
                     bf16_t* __restrict__ hAn, const float* __restrict__ g1n, const float* __restrict__ sh1n, const float* __restrict__ sc1n) {
    lane = opaque_v(lane);
    const int half = lane >> 5;
    const unsigned lane16 = (unsigned)(lane & 31) * 16u;
    const int cb = (lane & 31) * 32 + half * 16;
    const unsigned short* seid = (const unsigned short*)(lds + PL_SEID) + w * 16 * 128 + half;
    const unsigned* swgt = (const unsigned*)(lds + PL_SWGT) + w * 16 * 128 + half;
    u32x4 RA[8], RB[8];
    unsigned IDN[8], WA[8], WB[8];
#define UP_IDS(P_) do { _Pragma("unroll") for (int u_ = 0; u_ < 8; ++u_) IDN[u_] = seid[(P_) + 2 * u_]; } while (0)
#define UP_WTS(W, P_) do { _Pragma("unroll") for (int u_ = 0; u_ < 8; ++u_) W[u_] = swgt[(P_) + 2 * u_]; } while (0)
#define UP_LOADS(R) do { _Pragma("unroll") for (int u_ = 0; u_ < 8; ++u_) R[u_] = *(const u32x4*)(TBu + (IDN[u_] * 512u + lane16)); } while (0)
#define UP_COMPUTE(R, W) do { _Pragma("unroll") for (int u_ = 0; u_ < 8; ++u_) { \
        const unsigned wd_ = W[u_]; const h16x2 wp_ = __builtin_bit_cast(h16x2, wd_); const h16x2 w2_ = (h16x2){wp_.x, wp_.x}; \
        const unsigned r0_ = R[u_].x, r1_ = R[u_].y, r2_ = R[u_].z, r3_ = R[u_].w; \
        _Pragma("unroll") for (int q_ = 0; q_ < 4; ++q_) { acc[q_] = __builtin_elementwise_fma(w2_, fp4h(r0_, q_), acc[q_]); acc[4 + q_] = __builtin_elementwise_fma(w2_, fp4h(r1_, q_), acc[4 + q_]); \
            acc[8 + q_] = __builtin_elementwise_fma(w2_, fp4h(r2_, q_), acc[8 + q_]); acc[12 + q_] = __builtin_elementwise_fma(w2_, fp4h(r3_, q_), acc[12 + q_]); } } } while (0)
    UP_IDS(0); UP_LOADS(RA); UP_IDS(16); UP_WTS(WA, 0);
    float4 gv[4];
#pragma unroll
    for (int q = 0; q < 4; ++q) gv[q] = ((const float4*)(g2b + cb))[q];
    float4 cg[4], ch[4];
#pragma unroll
    for (int q = 0; q < 4; ++q) {
        cg[q] = (float4){0.f, 0.f, 0.f, 0.f}; ch[q] = cg[q];
        if (hAn) { const float4 a = ((const float4*)(g1n + cb))[q], b = ((const float4*)(sc1n + cb))[q]; ch[q] = ((const float4*)(sh1n + cb))[q];
                   cg[q].x = a.x * (1.f + b.x); cg[q].y = a.y * (1.f + b.y); cg[q].z = a.z * (1.f + b.z); cg[q].w = a.w * (1.f + b.w); }
    }
#pragma unroll 1
    for (int tk = 0; tk < 16; ++tk) {
        const int tn = tk < 15 ? tk + 1 : 15;
        float4* xp = (float4*)(x + (size_t)(unsigned)((tile * 128 + w * 16 + tk) * D + cb));
        float4 xv[4];
#pragma unroll
        for (int q = 0; q < 4; ++q) xv[q] = xp[q];
        h16x2 acc[16];
#pragma unroll
        for (int q = 0; q < 16; ++q) acc[q] = (h16x2){(_Float16)0.f, (_Float16)0.f};
#pragma unroll 1
        for (int i = 0; i < 4; ++i) {
            const int pa = tk * 128 + i * 32;
            const int pn = i < 3 ? pa + 32 : tn * 128;
            UP_LOADS(RB); UP_WTS(WB, pa + 16); UP_IDS(pn);
            __builtin_amdgcn_sched_barrier(0);
            UP_COMPUTE(RA, WA);
            UP_LOADS(RA); UP_WTS(WA, pn); UP_IDS(pn + 16);
            __builtin_amdgcn_sched_barrier(0);
            UP_COMPUTE(RB, WB);
        }
        h16x2 tot[8];
#pragma unroll
        for (int q = 0; q < 8; ++q) {
            const unsigned a_ = __builtin_bit_cast(unsigned, acc[q]), b_ = __builtin_bit_cast(unsigned, acc[q + 8]);
            auto sw = __builtin_amdgcn_permlane32_swap(a_, b_, false, false);
            const unsigned s0_ = sw[0], s1_ = sw[1];
            tot[q] = __builtin_bit_cast(h16x2, s0_) + __builtin_bit_cast(h16x2, s1_);
        }
        float ssx = 0.f;
#pragma unroll
        for (int q = 0; q < 4; ++q) {
            xv[q].x += gv[q].x * (float)tot[2 * q].x; xv[q].y += gv[q].y * (float)tot[2 * q].y; xv[q].z += gv[q].z * (float)tot[2 * q + 1].x; xv[q].w += gv[q].w * (float)tot[2 * q + 1].y;
            xp[q] = xv[q];
            ssx += xv[q].x * xv[q].x + xv[q].y * xv[q].y + xv[q].z * xv[q].z + xv[q].w * xv[q].w;
        }
        ssx = wave_sum(ssx);
        if (hAn) {
            const float rs = rsqrtf(ssx * (1.f / D) + EPS);
            bf16_t* orow = hAn + (size_t)(unsigned)((tile * 128 + w * 16 + tk) * D + cb);
#pragma unroll
            for (int j = 0; j < 2; ++j) {
                u32x4 o;
                o.x = pk2(xv[2 * j].x * rs * cg[2 * j].x + ch[2 * j].x, xv[2 * j].y * rs * cg[2 * j].y + ch[2 * j].y);
                o.y = pk2(xv[2 * j].z * rs * cg[2 * j].z + ch[2 * j].z, xv[2 * j].w * rs * cg[2 * j].w + ch[2 * j].w);
                o.z = pk2(xv[2 * j + 1].x * rs * cg[2 * j + 1].x + ch[2 * j + 1].x, xv[2 * j + 1].y * rs * cg[2 * j + 1].y + ch[2 * j + 1].y);
                o.w = pk2(xv[2 * j + 1].z * rs * cg[2 * j + 1].z + ch[2 * j + 1].z, xv[2 * j + 1].w * rs * cg[2 * j + 1].w + ch[2 * j + 1].w);
                *(u32x4*)(orow + 8 * j) = o;
            }
        }
    }
#undef UP_IDS
#undef UP_WTS
#undef UP_LOADS
#undef UP_COMPUTE
}

DI void epi_qk(f32x16 (&acc)[4][2], const float* __restrict__ gain, float scale, bf16_t* __restrict__ dst, int lane) {
    lane = opaque_v(lane);
    const int hh = lane >> 5;
    float gv[2][16];
#pragma unroll
    for (int nb = 0; nb < 2; ++nb)
#pragma unroll
        for (int i = 0; i < 16; ++i) gv[nb][i] = gain[nb * 32 + (i & 3) + 8 * (i >> 2) + 4 * hh] * scale;
#pragma unroll
    for (int mb = 0; mb < 4; ++mb) {
        float ss = 0.f;
#pragma unroll
        for (int nb = 0; nb < 2; ++nb)
#pragma unroll
            for (int i = 0; i < 16; ++i) ss += acc[mb][nb][i] * acc[mb][nb][i];
        ss = x32_sum(ss);
        const float r = rsqrtf(ss * (1.f / 64.f) + EPS);
#pragma unroll
        for (int nb = 0; nb < 2; ++nb)
#pragma unroll
            for (int s = 0; s < 2; ++s) {
                const f32x16& a = acc[mb][nb];
                u32x4 o;
                o.x = pk2(a[8 * s] * r * gv[nb][8 * s], a[8 * s + 1] * r * gv[nb][8 * s + 1]);
                o.y = pk2(a[8 * s + 2] * r * gv[nb][8 * s + 2], a[8 * s + 3] * r * gv[nb][8 * s + 3]);
                o.z = pk2(a[8 * s + 4] * r * gv[nb][8 * s + 4], a[8 * s + 5] * r * gv[nb][8 * s + 5]);
                o.w = pk2(a[8 * s + 6] * r * gv[nb][8 * s + 6], a[8 * s + 7] * r * gv[nb][8 * s + 7]);
                *(u32x4*)(dst + ((unsigned)(((nb * 2 + s) * 4 + mb) * 64 + lane)) * 8) = o;
            }
    }
}
DI void epi_v(const f32x16 (&acc)[4][2], bf16_t* __restrict__ dst, int lane) {
    lane = opaque_v(lane);
#pragma unroll
    for (int nb = 0; nb < 2; ++nb)
#pragma unroll
        for (int mb = 0; mb < 4; ++mb)
#pragma unroll
            for (int s = 0; s < 2; ++s) {
                const f32x16& a = acc[mb][nb];
                u32x4 o; o.x = pk2(a[8 * s], a[8 * s + 1]); o.y = pk2(a[8 * s + 2], a[8 * s + 3]); o.z = pk2(a[8 * s + 4], a[8 * s + 5]); o.w = pk2(a[8 * s + 6], a[8 * s + 7]);
                *(u32x4*)(dst + ((unsigned)(((nb * 4 + mb) * 2 + s) * 64 + lane)) * 8) = o;
            }
}
DI void epi_row(const f32x16 (&acc)[4][2], bf16_t* __restrict__ dst, int ld, int lane) {
    lane = opaque_v(lane);
    const int r5 = lane & 31, hh = lane >> 5;
#pragma unroll
    for (int mb = 0; mb < 4; ++mb)
#pragma unroll
        for (int nb = 0; nb < 2; ++nb)
#pragma unroll
            for (int gq = 0; gq < 4; ++gq) {
                const f32x16& a = acc[mb][nb];
                u32x2 o; o.x = pk2(a[4 * gq], a[4 * gq + 1]); o.y = pk2(a[4 * gq + 2], a[4 * gq + 3]);
                *(u32x2*)(dst + (unsigned)((mb * 32 + r5) * ld + nb * 32 + 8 * gq + 4 * hh)) = o;
            }
}
DI void epi_z(const f32x16 (&acc)[4][2], bf16_t* __restrict__ dst, int lane) {
    lane = opaque_v(lane);
    const int r5 = lane & 31, hh = lane >> 5;
#pragma unroll
    for (int mb = 0; mb < 4; ++mb)
#pragma unroll
        for (int gq = 0; gq < 4; ++gq) {
            const f32x16 &a = acc[mb][0], &b = acc[mb][1];
            u32x2 o; o.x = pk2(a[4 * gq] * b[4 * gq], a[4 * gq + 1] * b[4 * gq + 1]); o.y = pk2(a[4 * gq + 2] * b[4 * gq + 2], a[4 * gq + 3] * b[4 * gq + 3]);
            *(u32x2*)(dst + (unsigned)((mb * 32 + r5) * 256 + 8 * gq + 4 * hh)) = o;
        }
}
DI void epi_su_park(const f32x16 (&acc)[4][2], unsigned* lds_su, int lane) {
    lane = opaque_v(lane);
#pragma unroll
    for (int mb = 0; mb < 4; ++mb)
#pragma unroll
        for (int nb = 0; nb < 2; ++nb)
#pragma unroll
            for (int q = 0; q < 8; ++q) lds_su[((mb * 2 + nb) * 8 + q) * 64 + lane] = pk2(acc[mb][nb][2 * q], acc[mb][nb][2 * q + 1]);
}
DI void epi_sv(f32x16 (&acc)[4][2], const bf16_t* __restrict__ SWF  , const float* __restrict__ bs_g, const unsigned* lds_su, bf16_t* __restrict__ dst, int lane) {
    lane = opaque_v(lane);
    const int r5 = lane & 31, hh = lane >> 5;
    bf16x8 vb[4][2][2];
#pragma unroll
    for (int mb = 0; mb < 4; ++mb) {
#pragma unroll
        for (int i = 0; i < 16; ++i) {
            float s1 = acc[mb][0][i] + acc[mb][1][i];
            s1 = red32_sum(s1);
            const float mu = s1 * (1.f / 64.f);
            const float d0 = acc[mb][0][i] - mu, d1 = acc[mb][1][i] - mu;
            float s2 = d0 * d0 + d1 * d1;
            s2 = red32_sum(s2);
            const float r = rsqrtf(s2 * (1.f / 64.f) + EPS);
            acc[mb][0][i] = d0 * r; acc[mb][1][i] = d1 * r;
        }
#pragma unroll
        for (int s = 0; s < 2; ++s)
#pragma unroll
            for (int nb = 0; nb < 2; ++nb) {
                const f32x16& a = acc[mb][nb];
                u32x4 o; o.x = pk2(a[8 * s], a[8 * s + 1]); o.y = pk2(a[8 * s + 2], a[8 * s + 3]); o.z = pk2(a[8 * s + 4], a[8 * s + 5]); o.w = pk2(a[8 * s + 6], a[8 * s + 7]);
                vb[mb][s][nb] = __builtin_bit_cast(bf16x8, o);
            }
    }
#pragma unroll
    for (int tb = 0; tb < 4; ++tb) {
        f32x16 y[2];
#pragma unroll
        for (int nb = 0; nb < 2; ++nb)
#pragma unroll
            for (int i = 0; i < 16; ++i) y[nb][i] = 0.f;
#pragma unroll
        for (int kt = 0; kt <= tb; ++kt)
#pragma unroll
            for (int s = 0; s < 2; ++s) {
                const bf16x8 wa = *(const bf16x8*)(SWF + ((unsigned)(((tb * 4 + kt) * 2 + s) * 64 + lane)) * 8);
                y[0] = MFMA32(wa, vb[kt][s][0], y[0]);
                y[1] = MFMA32(wa, vb[kt][s][1], y[1]);
            }
#pragma unroll
        for (int nb = 0; nb < 2; ++nb)
#pragma unroll
            for (int q = 0; q < 8; ++q) {
                const unsigned su2 = lds_su[((tb * 2 + nb) * 8 + q) * 64 + lane];
                const int i0 = 2 * q, i1 = 2 * q + 1;
                const int t0 = tb * 32 + (i0 & 3) + 8 * (i0 >> 2) + 4 * hh, t1 = tb * 32 + (i1 & 3) + 8 * (i1 >> 2) + 4 * hh;
                const float v0 = (y[nb][i0] + bs_g[t0]) * __uint_as_float(su2 << 16), v1 = (y[nb][i1] + bs_g[t1]) * __uint_as_float(su2 & 0xffff0000u);
                const unsigned pk = pk2(v0, v1);
                dst[(unsigned)(t0 * 256 + nb * 32 + r5)] = (bf16_t)(pk & 0xffffu);
                dst[(unsigned)(t1 * 256 + nb * 32 + r5)] = (bf16_t)(pk >> 16);
            }
    }
}

DI void conv_sguw_item(const float* __restrict__ W, bf16_t* __restrict__ SWF, int gid) {
    const int lane = gid & 63, s = (gid >> 6) & 1, kt = (gid >> 7) & 3, tb = (gid >> 9) & 3, g = gid >> 11;
    const int r = lane & 31, hh = lane >> 5, t = tb * 32 + r;
    const float* p = W + ((size_t)g * 128 + t) * 128;
    float v[8];
#pragma unroll
    for (int j = 0; j < 8; ++j) { const int sp = kt * 32 + 16 * s + 8 * (j >> 2) + 4 * hh + (j & 3); v[j] = sp <= t ? p[sp] : 0.f; }
    u32x4 o; o.x = pk2(v[0], v[1]); o.y = pk2(v[2], v[3]); o.z = pk2(v[4], v[5]); o.w = pk2(v[6], v[7]);
    *(u32x4*)(SWF + (size_t)gid * 8) = o;
}

DI int t5_bucket(int d) {
    if (d < 16) return d;
    const float lr = logf((float)d / 16.f) / logf(8.f);
    const int large = 16 + (int)(lr * 16.f);
    return large < 31 ? large : 31;
}

DI void attn_tile(const bf16_t* __restrict__ QF, const bf16_t* __restrict__ KF2, const bf16_t* __restrict__ VF, char* lds, const float* bias_lds, const float* __restrict__ sink, bf16_t* __restrict__ OR, int tile, int tid) {
    tid = opaque_v(tid); tile = opaque_s(tile);
    const int lane = tid & 63, w = __builtin_amdgcn_readfirstlane(tid >> 6), r5 = lane & 31, hh = lane >> 5;
    const bool has_prev = (tile & 31) != 0;
    {
        u32x4 tmp[16];
#pragma unroll
        for (int i = 0; i < 16; ++i) {
            const int blk = w * 16 + i;
            const int isv = blk >> 6, bb = blk & 63;
            const bf16_t* src;
            if (!isv) { const int kvh = bb >> 5, ks = (bb >> 3) & 3, wt = bb & 7, st = (wt >= 4 || !has_prev) ? tile : tile - 1;
                src = KF2 + ((unsigned)((((st * 2 + kvh) * 4 + ks) * 4 + (wt & 3)) * 64 + lane)) * 8; }
            else { const int kvh = bb >> 5, dt = (bb >> 4) & 1, wt = (bb >> 1) & 7, s2 = bb & 1, st = (wt >= 4 || !has_prev) ? tile : tile - 1;
                src = VF + ((unsigned)(((((st * 2 + kvh) * 2 + dt) * 4 + (wt & 3)) * 2 + s2) * 64 + lane)) * 8; }
            tmp[i] = *(const u32x4*)src;
        }
#pragma unroll
        for (int i = 0; i < 16; ++i) *(u32x4*)(lds + (w * 16 + i) * 1024 + lane * 16) = tmp[i];
    }
    __syncthreads();
    const char* ldsK = lds, *ldsV = lds + 65536;
    for (int task = w; task < 32; task += 8) {
        const int qh = task >> 2, qt = task & 3, kvh = qh >> 2;
        bf16x8 bq[4];
#pragma unroll
        for (int ks = 0; ks < 4; ++ks) bq[ks] = *(const bf16x8*)(QF + ((unsigned)((((tile * 8 + qh) * 4 + ks) * 4 + qt) * 64 + lane)) * 8);
        f32x16 sc[5];
#pragma unroll
        for (int jj = 0; jj < 5; ++jj) {
#pragma unroll
            for (int i = 0; i < 16; ++i) sc[jj][i] = 0.f;
#pragma unroll
            for (int ks = 0; ks < 4; ++ks) {
                const bf16x8 kf = *(const bf16x8*)(ldsK + ((kvh * 4 + ks) * 8 + qt + jj) * 1024 + lane * 16);
                sc[jj] = MFMA32(kf, bq[ks], sc[jj]);
            }
        }
        const float* bl = bias_lds + qh * 128;
        float m = -1e30f;
#pragma unroll
        for (int jj = 0; jj < 5; ++jj) {
            const bool ex = (qt + jj >= 4) || has_prev;
#pragma unroll
            for (int i = 0; i < 16; ++i) {
                const int cr = (i & 3) + 8 * (i >> 2) + 4 * hh;
                const int dist = 128 + r5 - 32 * jj - cr;
                const bool valid = ex && dist >= 0 && dist < 128;
                float bv = bl[dist & 127];
                asm volatile("" : "+v"(bv));
                const float v = valid ? sc[jj][i] + bv : -1e30f;
                sc[jj][i] = v; m = fmaxf(m, v);
            }
        }
        m = x32_max(m);
        const float sk = sink[qh];
        m = fmaxf(m, sk);
        float l = 0.f;
#pragma unroll
        for (int jj = 0; jj < 5; ++jj)
#pragma unroll
            for (int i = 0; i < 16; ++i) { const float p = __expf(sc[jj][i] - m); sc[jj][i] = p; l += p; }
        l = x32_sum(l);
        l += __expf(sk - m);
        const float rl = 1.f / l;
        f32x16 o[2];
#pragma unroll
        for (int dt = 0; dt < 2; ++dt)
#pragma unroll
            for (int i = 0; i < 16; ++i) o[dt][i] = 0.f;
#pragma unroll
        for (int jj = 0; jj < 5; ++jj) {
#pragma unroll
            for (int s = 0; s < 2; ++s) {
                const f32x16& a = sc[jj];
                u32x4 pp; pp.x = pk2(a[8 * s], a[8 * s + 1]); pp.y = pk2(a[8 * s + 2], a[8 * s + 3]); pp.z = pk2(a[8 * s + 4], a[8 * s + 5]); pp.w = pk2(a[8 * s + 6], a[8 * s + 7]);
                const bf16x8 pb = __builtin_bit_cast(bf16x8, pp);
#pragma unroll
                for (int dt = 0; dt < 2; ++dt) {
                    const bf16x8 vf = *(const bf16x8*)(ldsV + (((kvh * 2 + dt) * 8 + qt + jj) * 2 + s) * 1024 + lane * 16);
                    o[dt] = MFMA32(vf, pb, o[dt]);
                }
            }
        }
        bf16_t* orow = OR + (unsigned)((tile * 128 + qt * 32 + r5) * 512 + qh * 64 + 4 * hh);
#pragma unroll
        for (int dt = 0; dt < 2; ++dt)
#pragma unroll
            for (int gq = 0; gq < 4; ++gq) {
                u32x2 ov; ov.x = pk2(o[dt][4 * gq] * rl, o[dt][4 * gq + 1] * rl); ov.y = pk2(o[dt][4 * gq + 2] * rl, o[dt][4 * gq + 3] * rl);
                *(u32x2*)(orow + dt * 32 + 8 * gq) = ov;
            }
    }
}

DI void unpack8(const u32x4 v, float (&f)[8]) {
    f[0] = __uint_as_float(v.x << 16); f[1] = __uint_as_float(v.x & 0xffff0000u); f[2] = __uint_as_float(v.y << 16); f[3] = __uint_as_float(v.y & 0xffff0000u);
    f[4] = __uint_as_float(v.z << 16); f[5] = __uint_as_float(v.z & 0xffff0000u); f[6] = __uint_as_float(v.w << 16); f[7] = __uint_as_float(v.w & 0xffff0000u);
}
DI void merge_tile(const bf16_t* __restrict__ OR, const bf16_t* __restrict__ CBR, const bf16_t* __restrict__ ZR, const bf16_t* __restrict__ YS, const float* __restrict__ cw  , const float* __restrict__ og  ,
                   bf16_t* __restrict__ mA, int tile, int tid) {
    tid = opaque_v(tid); tile = opaque_s(tile);
    const int lane = tid & 63, w = tid >> 6;
    float cwv[3][8], ga[8], gb[8];
    {
        const int c0 = (lane & 31) * 8;
#pragma unroll
        for (int j = 0; j < 3; ++j) { const float4 p0 = *(const float4*)(cw + j * 256 + c0), p1 = *(const float4*)(cw + j * 256 + c0 + 4);
            cwv[j][0] = p0.x; cwv[j][1] = p0.y; cwv[j][2] = p0.z; cwv[j][3] = p0.w; cwv[j][4] = p1.x; cwv[j][5] = p1.y; cwv[j][6] = p1.z; cwv[j][7] = p1.w; }
        const float4 a0 = *(const float4*)(og + lane * 8), a1 = *(const float4*)(og + lane * 8 + 4), b0 = *(const float4*)(og + 512 + lane * 8), b1 = *(const float4*)(og + 512 + lane * 8 + 4);
        ga[0] = a0.x; ga[1] = a0.y; ga[2] = a0.z; ga[3] = a0.w; ga[4] = a1.x; ga[5] = a1.y; ga[6] = a1.z; ga[7] = a1.w;
        gb[0] = b0.x; gb[1] = b0.y; gb[2] = b0.z; gb[3] = b0.w; gb[4] = b1.x; gb[5] = b1.y; gb[6] = b1.z; gb[7] = b1.w;
    }
#pragma unroll 8
    for (int rr = 0; rr < 16; ++rr) {
        const int row = w * 16 + rr, t = tile * 128 + row, pos = t & (S - 1);
        float a[8], y[8];
        unpack8(*(const u32x4*)(OR + (unsigned)(t * 512 + lane * 8)), a);
        float ssa = 0.f;
#pragma unroll
        for (int q = 0; q < 8; ++q) ssa += a[q] * a[q];
        ssa = wave_sum(ssa);
        {
            const int c0 = (lane & 31) * 8;
            float cb[8], z0[8], z1[8], z2[8], ys[8];
            const float m1 = pos >= 1 ? 1.f : 0.f, m2 = pos >= 2 ? 1.f : 0.f;
            const int t1 = pos >= 1 ? t - 1 : t, t2 = pos >= 2 ? t - 2 : t;
            unpack8(*(const u32x4*)(CBR + (unsigned)(t * 256 + c0)), cb);
            unpack8(*(const u32x4*)(ZR + (unsigned)(t * 256 + c0)), z2);
            unpack8(*(const u32x4*)(ZR + (unsigned)(t1 * 256 + c0)), z1);
            unpack8(*(const u32x4*)(ZR + (unsigned)(t2 * 256 + c0)), z0);
            unpack8(*(const u32x4*)(YS + (unsigned)(t * 256 + c0)), ys);
#pragma unroll
            for (int q = 0; q < 8; ++q) {
                const float yc = cb[q] * (cwv[0][q] * (z0[q] * m2) + cwv[1][q] * (z1[q] * m1) + cwv[2][q] * z2[q]);
                y[q] = lane < 32 ? yc : ys[q];
            }
        }
        float ssy = 0.f;
#pragma unroll
        for (int q = 0; q < 8; ++q) ssy += y[q] * y[q];
        ssy = red32_sum(ssy);
        const float ra = rsqrtf(ssa * (1.f / 512.f) + EPS), ry = rsqrtf(ssy * (1.f / 256.f) + EPS);
        const int mb = row >> 5, r5 = row & 31;
        {
            u32x4 o; o.x = pk2(a[0] * ra * ga[0], a[1] * ra * ga[1]); o.y = pk2(a[2] * ra * ga[2], a[3] * ra * ga[3]); o.z = pk2(a[4] * ra * ga[4], a[5] * ra * ga[5]); o.w = pk2(a[6] * ra * ga[6], a[7] * ra * ga[7]);
            const int c8 = lane;
            (void)c8;
            *(u32x4*)(mA + (unsigned)(t * 1024 + lane * 8)) = o;
        }
        {
            u32x4 o; o.x = pk2(y[0] * ry * gb[0], y[1] * ry * gb[1]); o.y = pk2(y[2] * ry * gb[2], y[3] * ry * gb[3]); o.z = pk2(y[4] * ry * gb[4], y[5] * ry * gb[5]); o.w = pk2(y[6] * ry * gb[6], y[7] * ry * gb[7]);
            const int c8 = 64 + lane;
            (void)c8;
            *(u32x4*)(mA + (unsigned)(t * 1024 + 512 + lane * 8)) = o;
        }
    }
}

struct InProjOut { bf16_t *QF, *KF2, *VF, *CBR, *ZR, *YS; };
DI void inproj_tile(const bf16_t* __restrict__ At, const bf16_t* __restrict__ WF, const float* __restrict__ qg, const float* __restrict__ kg, const bf16_t* __restrict__ SWF, const float* __restrict__ sgu_b,
                    const InProjOut& O, char* lds, int tile, int tid) {
    tid = opaque_v(tid); tile = opaque_s(tile);
    const int lane = tid & 63, w = __builtin_amdgcn_readfirstlane(tid >> 6);
    f32x16 acc[4][2];
    {
        const int nbt0 = w * 2;
        kloop<1>(acc, At, WF + (size_t)nbt0 * 32768, WF + (size_t)(nbt0 + 1) * 32768, lds, tid, lane);
        epi_qk(acc, qg, 0.125f, O.QF + (size_t)(tile * 8 + w) * 8192, lane);
    }
    {
        const int nbt0 = 16 + w * 2;
        if (w == 2 || w == 3) {
            kloop<0>(acc, At, WF + (size_t)nbt0 * 32768, WF + (size_t)(nbt0 + 1) * 32768, lds, tid, lane);
            epi_v(acc, O.VF + (size_t)(tile * 2 + (w - 2)) * 8192, lane);
        } else {
            kloop<1>(acc, At, WF + (size_t)nbt0 * 32768, WF + (size_t)(nbt0 + 1) * 32768, lds, tid, lane);
            if (w < 2) epi_qk(acc, kg, 1.f, O.KF2 + (size_t)(tile * 2 + w) * 8192, lane);
            else epi_row(acc, O.CBR + (size_t)tile * 128 * 256 + (w - 4) * 64, 256, lane);
        }
    }
    {
        const int nbt0 = 32 + w * 2;
        kloop<1>(acc, At, WF + (size_t)nbt0 * 32768, WF + (size_t)(nbt0 + 1) * 32768, lds, tid, lane);
        epi_z(acc, O.ZR + (size_t)tile * 128 * 256 + w * 32, lane);
    }
    {
        const int nbt0 = 48 + w * 2;
        kloop<0>(acc, At, WF + (size_t)nbt0 * 32768, WF + (size_t)(nbt0 + 1) * 32768, lds, tid, lane);
        unsigned* lds_su = (unsigned*)lds;
        if (w < 4) epi_su_park(acc, lds_su + w * 4096, lane);
        __syncthreads();
        if (w >= 4) epi_sv(acc, SWF + (size_t)(w - 4) * 16384, sgu_b + (w - 4) * 128, lds_su + (w - 4) * 4096, O.YS + (size_t)tile * 128 * 256 + (w - 4) * 64, lane);
        __syncthreads();
    }
}


struct Params {
    const float *x, *c, *rel_bias, *w_ada, *b_ada, *norm1_g, *norm2_g, *w_in, *q_norm_g, *k_norm_g, *attn_sink, *conv_w, *sgu_w, *sgu_b, *out_norm_g, *w_out, *peer_wq, *peer_sub_keys, *peer_down, *peer_up;
    float* out;
    char* ws;
};
constexpr size_t MiB = 1u << 20;
constexpr size_t WS_MOD = 0;
constexpr size_t WS_MODP = 1 * MiB;
constexpr size_t WS_WIN = 13 * MiB;
constexpr size_t WS_WOUT = 29 * MiB;
constexpr size_t WS_WPQ = 37 * MiB;
constexpr size_t WS_KEYS = 53 * MiB;
constexpr size_t WS_SWF = 55 * MiB;
constexpr size_t WS_SC = 56 * MiB;
constexpr size_t WS_TB = 57 * MiB;
constexpr size_t WS_HA = 185 * MiB;
constexpr size_t WS_QF = 249 * MiB;
constexpr size_t WS_KF2 = 602 * MiB;
constexpr size_t WS_VF = 634 * MiB;
constexpr size_t WS_ZR = 666 * MiB;
constexpr size_t WS_CBR = 345 * MiB;
constexpr size_t WS_YS = 361 * MiB;
constexpr size_t WS_OR = 377 * MiB;
constexpr size_t WS_QPF = 409 * MiB;
constexpr size_t WS_RIDX = 537 * MiB;
constexpr size_t WS_RGATE = 553 * MiB;
constexpr size_t WS_SEID = 569 * MiB;
constexpr size_t WS_SWGT = 585 * MiB;
constexpr size_t WS_OFFS = 601 * MiB;
constexpr size_t WS_FLAGS = 601 * MiB + 512 * 1024;
constexpr size_t WS_END = 730 * MiB;
static_assert(PL_END <= LDS_RSTD1, "expert-phase lists overlap persistent LDS state");

__global__ __launch_bounds__(512) void hybrid_fwd(Params P) {
    extern __shared__ __attribute__((aligned(16))) char lds[];
    cg::grid_group grid = cg::this_grid();
    const int tid = threadIdx.x, lane = tid & 63, w = __builtin_amdgcn_readfirstlane(tid >> 6);
    const int nblk = gridDim.x, hwb = blockIdx.x;
    const int bid = (nblk == NTILE) ? (hwb & 7) * 32 + (hwb >> 3) : hwb;
    char* ws = P.ws;
    float* mod = (float*)(ws + WS_MOD);
    float* modp = (float*)(ws + WS_MODP);
    bf16_t* WinF = (bf16_t*)(ws + WS_WIN); bf16_t* WoutF = (bf16_t*)(ws + WS_WOUT); bf16_t* WpqF = (bf16_t*)(ws + WS_WPQ);
    bf16_t* KeysF = (bf16_t*)(ws + WS_KEYS); bf16_t* SWF = (bf16_t*)(ws + WS_SWF);
    float* SC = (float*)(ws + WS_SC); unsigned char* TBd = (unsigned char*)(ws + WS_TB); unsigned char* TBu = TBd + 32 * MiB;
    bf16_t* hA = (bf16_t*)(ws + WS_HA);
    bf16_t* OR = (bf16_t*)(ws + WS_OR); bf16_t* QPF = (bf16_t*)(ws + WS_QPF);
    int* ridx = (int*)(ws + WS_RIDX); float* rgate = (float*)(ws + WS_RGATE);
    float* bias_lds = (float*)(lds + LDS_BIAS);
    unsigned* flags = (unsigned*)(ws + WS_FLAGS);

    {
        float* ca = (float*)lds;
        if (tid == 0) for (int tile = bid; tile < NTILE; tile += nblk) __hip_atomic_store(flags + tile, 0u, __ATOMIC_RELAXED, __HIP_MEMORY_SCOPE_AGENT);
        for (int i = tid; i < 8192; i += 512) { const float v = P.c[i]; ca[i] = v / (1.f + __expf(-v)); }
        for (int i = tid; i < 1024; i += 512) bias_lds[i] = P.rel_bias[t5_bucket(i & 127) * 8 + (i >> 7)];
        __syncthreads();
        for (int it = bid; it < 768; it += nblk) {
            const int jc = it % 12, l = (it / 12) & 3, ks = it / 48;
            const int j = jc * 512 + tid;
            const float* wp = P.w_ada + ((size_t)l * 1024 + ks * 64) * 6144 + j;
            float acc[8];
#pragma unroll
            for (int b = 0; b < 8; ++b) acc[b] = 0.f;
#pragma unroll 4
            for (int i = 0; i < 64; ++i) {
                const float wv = wp[(size_t)i * 6144];
#pragma unroll
                for (int b = 0; b < 8; ++b) acc[b] += ca[b * 1024 + ks * 64 + i] * wv;
            }
#pragma unroll
            for (int b = 0; b < 8; ++b) modp[((size_t)(ks * 4 + l) * 8 + b) * 6144 + j] = acc[b];
        }
        const int gthreads = nblk * 512, gtid = bid * 512 + tid;
        for (int rep = 0; rep < REP_P0; ++rep)
        for (int l = 0; l < DEPTH; ++l) {
            for (int g = gtid; g < 64 * 64 * 64; g += gthreads) conv_wfrag_item(P.w_in + (size_t)l * 1024 * 2048, 2048, 64, WinF + (size_t)l * 2097152, g, 1);
            for (int g = gtid; g < 32 * 64 * 64; g += gthreads) conv_wfrag_item(P.w_out + (size_t)l * 1024 * 1024, 1024, 64, WoutF + (size_t)l * 1048576, g, 0);
            for (int g = gtid; g < 64 * 64 * 64; g += gthreads) conv_wfrag_item(P.peer_wq + (size_t)l * 1024 * 2048, 2048, 64, WpqF + (size_t)l * 2097152, g, 0);
            for (int g = gtid; g < 32768; g += gthreads) conv_keys_item(P.peer_sub_keys + (size_t)l * 262144, KeysF + (size_t)l * 262144, g);
            for (int g = gtid; g < 8192; g += gthreads) conv_sguw_item(P.sgu_w + (size_t)l * 65536, SWF + (size_t)l * 65536, g);
        }
        const int gwaves = nblk * 8, gw = bid * 8 + w;
        for (int rep = 0; rep < REP_P0; ++rep)
        for (int r = gw; r < DEPTH * 16384 * 2; r += gwaves) {
            const int which = r & 1, le = r >> 1;
            conv_table_row((which ? P.peer_up : P.peer_down) + (size_t)le * D, (which ? TBu : TBd) + (size_t)le * 512, SC + (size_t)le * 2 + which, lane, which == 0);
        }
    }
    grid.sync();
    for (int tile = bid; tile < NTILE; tile += nblk) {
        const int b = tile >> 5;
        for (int l = 0; l < DEPTH; ++l)
            for (int j = tid; j < 6144; j += 512) {
                float v = P.b_ada[l * 6144 + j];
#pragma unroll
                for (int ks = 0; ks < 16; ++ks) v += modp[((size_t)(ks * 4 + l) * 8 + b) * 6144 + j];
                mod[((size_t)l * 8 + b) * 6144 + j] = v;
            }
    }
    __syncthreads();

    for (int l = 0; l < DEPTH; ++l) {
        const float* xin = l == 0 ? P.x : P.out;
        InProjOut IO;
        IO.QF = (bf16_t*)(ws + WS_QF); IO.KF2 = (bf16_t*)(ws + WS_KF2 + (size_t)l * 8 * MiB); IO.VF = (bf16_t*)(ws + WS_VF + (size_t)l * 8 * MiB);
        IO.CBR = (bf16_t*)(ws + WS_CBR); IO.ZR = (bf16_t*)(ws + WS_ZR + (size_t)l * 16 * MiB); IO.YS = (bf16_t*)(ws + WS_YS);
        for (int tile = bid; tile < NTILE; tile += nblk) {
            const float* mb_ = mod + ((size_t)l * 8 + (tile >> 5)) * 6144;
            if (l == 0) {
                norm_to_frag(xin, P.norm1_g + l * D, mb_ + 0, mb_ + 1024, hA, (float*)lds, tile, tid, false);
                __syncthreads();
            }
            for (int rep = 0; rep < REP_GEMM; ++rep) inproj_tile(hA + (size_t)tile * 131072, WinF + (size_t)l * 2097152, P.q_norm_g + l * 64, P.k_norm_g + l * 64, SWF + (size_t)l * 65536, P.sgu_b + l * 512, IO, lds, tile, tid);
            asm volatile("s_waitcnt vmcnt(0)" ::: "memory");
            __syncthreads();
            if (tid == 0) {
                __builtin_amdgcn_fence(__ATOMIC_RELEASE, "agent");
                asm volatile("s_waitcnt vmcnt(0)" ::: "memory");
                __hip_atomic_store(flags + tile, (unsigned)(l + 1), __ATOMIC_RELAXED, __HIP_MEMORY_SCOPE_AGENT);
            }
        }
        for (int tile = bid; tile < NTILE; tile += nblk) {
            const float* mb_ = mod + ((size_t)l * 8 + (tile >> 5)) * 6144;
            if ((tile & 31) != 0) {
                if (tid == 0) {
                    unsigned spins = 0;
                    while (__hip_atomic_load(flags + tile - 1, __ATOMIC_RELAXED, __HIP_MEMORY_SCOPE_AGENT) < (unsigned)(l + 1) && ++spins < (1u << 24)) __builtin_amdgcn_s_sleep(2);
                    __builtin_amdgcn_fence(__ATOMIC_ACQUIRE, "agent");
                    asm volatile("s_waitcnt vmcnt(0)" ::: "memory");
                }
                __syncthreads();
            }
            for (int rep = 0; rep < REP_MIX; ++rep) {
            attn_tile(IO.QF, IO.KF2, IO.VF, lds, bias_lds, P.attn_sink + l * 8, OR, tile, tid);
            __syncthreads();
            merge_tile(OR, IO.CBR, IO.ZR, IO.YS, P.conv_w + l * 768, P.out_norm_g + l * D, hA, tile, tid);
            __syncthreads();
            }
            {
                const bf16_t* At = hA + (size_t)tile * 131072;
                const bf16_t* WF = WoutF + (size_t)l * 1048576;
                for (int pass = 0; pass < 2; ++pass) {
                    f32x16 acc[4][2];
                    const int nbt0 = pass * 16 + w * 2;
                    kloop<0>(acc, At, WF + (size_t)nbt0 * 32768, WF + (size_t)(nbt0 + 1) * 32768, lds, tid, lane);
                    epi_resid(acc, xin, P.out, mb_ + 2048, (float*)(lds + LDS_EPI) + w * 2176, (float*)(lds + LDS_SSQ) + (pass * 8 + w) * 128, tile, pass * 512 + w * 64, lane);
                }
            }
            __syncthreads();
            if (tid < 128) { const float* sq = (const float*)(lds + LDS_SSQ); float ssum = 0.f;
#pragma unroll
                for (int c = 0; c < 16; ++c) ssum += sq[c * 128 + tid];
                ((float*)lds)[tid] = rsqrtf(ssum * (1.f / D) + EPS); }
            __syncthreads();
            norm_to_frag(P.out, P.norm2_g + l * D, mb_ + 3072, mb_ + 4096, hA, (float*)lds, tile, tid, true);
            __syncthreads();
            {
                const bf16_t* At = hA + (size_t)tile * 131072;
                const bf16_t* WF = WpqF + (size_t)l * 2097152;
                for (int rep = 0; rep < REP_GEMM; ++rep)
                for (int pass = 0; pass < 4; ++pass) {
                    f32x16 acc[4][2];
                    const int nbt0 = pass * 16 + w * 2;
                    kloop<1>(acc, At, WF + (size_t)nbt0 * 32768, WF + (size_t)(nbt0 + 1) * 32768, lds, tid, lane);
                    epi_qpf(acc, QPF, tile, nbt0, lane);
                }
            }
            __syncthreads();
            for (int rep = 0; rep < REP_ROUTE; ++rep) { route_tile(QPF, KeysF + (size_t)l * 262144, lds, (unsigned char*)lds + PL_RIDX, tile, tid); __syncthreads(); }
            peer_down_wave(hA, lds, TBd + (size_t)l * 16384 * 512, SC + (size_t)l * 32768, tile, w, lane);
            __syncthreads();
            {
                const float* mbn = mod + ((size_t)(l + 1 < DEPTH ? l + 1 : l) * 8 + (tile >> 5)) * 6144;
                peer_up_wave(lds, TBu + (size_t)l * 16384 * 512, mb_ + 5120, P.out, tile, w, lane, l + 1 < DEPTH ? hA : nullptr, P.norm1_g + (l + 1 < DEPTH ? l + 1 : l) * D, mbn + 0, mbn + 1024);
            }
            __syncthreads();
        }
    }
}
}

extern "C" void kernel_launch(void* const* d_in, const int* in_sizes, int n_in, void* d_out, int out_size, void* d_ws, size_t ws_size, hipStream_t stream) {
    using namespace op;
    static int grid_blocks = 0;
    if (!grid_blocks) {
        int dev = 0, cus = 0, per_cu = 0;
        (void)hipGetDevice(&dev);
        (void)hipDeviceGetAttribute(&cus, hipDeviceAttributeMultiprocessorCount, dev);
        (void)hipFuncSetAttribute((const void*)hybrid_fwd, hipFuncAttributeMaxDynamicSharedMemorySize, LDS_BYTES);
        (void)hipOccupancyMaxActiveBlocksPerMultiprocessor(&per_cu, (const void*)hybrid_fwd, 512, LDS_BYTES);
        if (per_cu < 1) per_cu = 1;
        grid_blocks = cus * per_cu;
        if (grid_blocks > NTILE) grid_blocks = NTILE;
        if (ws_size < WS_END) { fprintf(stderr, "kernel_launch: workspace too small (%zu < %zu)\n", ws_size, (size_t)WS_END); grid_blocks = -1; }
    }
    if (grid_blocks < 0) return;
    Params p{};
    p.x = (const float*)d_in[0]; p.c = (const float*)d_in[1]; p.rel_bias = (const float*)d_in[2]; p.w_ada = (const float*)d_in[3]; p.b_ada = (const float*)d_in[4];
    p.norm1_g = (const float*)d_in[5]; p.norm2_g = (const float*)d_in[6]; p.w_in = (const float*)d_in[7]; p.q_norm_g = (const float*)d_in[8]; p.k_norm_g = (const float*)d_in[9];
    p.attn_sink = (const float*)d_in[10]; p.conv_w = (const float*)d_in[11]; p.sgu_w = (const float*)d_in[12]; p.sgu_b = (const float*)d_in[13]; p.out_norm_g = (const float*)d_in[14];
    p.w_out = (const float*)d_in[15]; p.peer_wq = (const float*)d_in[16]; p.peer_sub_keys = (const float*)d_in[17]; p.peer_down = (const float*)d_in[18]; p.peer_up = (const float*)d_in[19];
    p.out = (float*)d_out; p.ws = (char*)d_ws;
    void* args[] = {&p};
    hipError_t e = hipLaunchCooperativeKernel((const void*)hybrid_fwd, dim3(grid_blocks), dim3(512), args, LDS_BYTES, stream);
    if (e != hipSuccess) fprintf(stderr, "kernel_launch: cooperative launch failed: %s (grid %d)\n", hipGetErrorString(e), grid_blocks);
}
```

```cpp
#include <hip/hip_runtime.h>
#include <cstdio>
#include <cstdint>
#include <hip/hip_cooperative_groups.h>
namespace cg = cooperative_groups;


namespace op {
#define DI __device__ __forceinline__
typedef unsigned short bf16_t;
typedef short bf16x8 __attribute__((ext_vector_type(8)));
typedef float f32x16 __attribute__((ext_vector_type(16)));
typedef float f32x2 __attribute__((ext_vector_type(2)));
typedef unsigned u32x4 __attribute__((ext_vector_type(4)));
typedef unsigned u32x2 __attribute__((ext_vector_type(2)));
typedef __bf16 bf16v2 __attribute__((ext_vector_type(2)));
constexpr int D = 1024, NB = 8, S = 4096, DEPTH = 4, T = NB * S, NTILE = T / 128;
constexpr float EPS = 1e-6f;
constexpr int PL_SEID = 0, PL_SWGT = 32768, PL_END = 98304, PL_RIDX = 98304;
constexpr int LDS_EPI = 32768, LDS_SSQ = 102400, LDS_RSTD1 = 110592, LDS_BIAS = 128 * 1024, LDS_BYTES = 132 * 1024;
constexpr int REP_GEMM = 1, REP_ROUTE = 1, REP_MIX = 1, REP_NORM = 1, REP_P0 = 1;
#define MFMA32(a, b, c) __builtin_amdgcn_mfma_f32_32x32x16_bf16((a), (b), (c), 0, 0, 0)

DI unsigned pk2(float lo, float hi) { f32x2 v = {lo, hi}; return __builtin_bit_cast(unsigned, __builtin_convertvector(v, bf16v2)); }
DI int opaque_v(int x) { asm volatile("" : "+v"(x)); return x; }
DI int opaque_s(int x) { asm volatile("" : "+s"(x)); return x; }
DI int crow(int reg, int hh) { return (reg & 3) + 8 * (reg >> 2) + 4 * hh; }
template <int CTRL> DI float dppf(float v) { return __int_as_float(__builtin_amdgcn_update_dpp(0, __float_as_int(v), CTRL, 0xf, 0xf, true)); }
template <int CTRL> DI int dppi(int v) { return __builtin_amdgcn_update_dpp(0, v, CTRL, 0xf, 0xf, true); }
DI float red16_sum(float v) { v += dppf<0xB1>(v); v += dppf<0x4E>(v); v += dppf<0x141>(v); v += dppf<0x140>(v); return v; }
DI float red16_max(float v) { v = fmaxf(v, dppf<0xB1>(v)); v = fmaxf(v, dppf<0x4E>(v)); v = fmaxf(v, dppf<0x141>(v)); v = fmaxf(v, dppf<0x140>(v)); return v; }
DI float x16_sum(float v) { auto s = __builtin_amdgcn_permlane16_swap(__float_as_uint(v), __float_as_uint(v), false, false); return __uint_as_float(s[0]) + __uint_as_float(s[1]); }
DI float x32_sum(float v) { auto s = __builtin_amdgcn_permlane32_swap(__float_as_uint(v), __float_as_uint(v), false, false); return __uint_as_float(s[0]) + __uint_as_float(s[1]); }
DI float x16_max(float v) { auto s = __builtin_amdgcn_permlane16_swap(__float_as_uint(v), __float_as_uint(v), false, false); return fmaxf(__uint_as_float(s[0]), __uint_as_float(s[1])); }
DI float x32_max(float v) { auto s = __builtin_amdgcn_permlane32_swap(__float_as_uint(v), __float_as_uint(v), false, false); return fmaxf(__uint_as_float(s[0]), __uint_as_float(s[1])); }
DI float red32_sum(float v) { return x16_sum(red16_sum(v)); }
DI float wave_sum(float v) { return x32_sum(x16_sum(red16_sum(v))); }
DI float wave_max(float v) { return x32_max(x16_max(red16_max(v))); }

DI int col_perm(int npos, int mode) {
    if (mode == 1 && npos >= 1024 && npos < 1536) { const int q = npos - 1024, w = q >> 6, nb = (q >> 5) & 1, r = q & 31; return (nb ? 1280 : 1024) + 32 * w + r; }
    return npos;
}
DI void conv_wfrag_item(const float* __restrict__ W, int N, int KB, bf16_t* __restrict__ WF, int gid, int mode) {
    const int l = gid & 63, kb = (gid >> 6) % KB, nbt = (gid >> 6) / KB, r = l & 31, hh = l >> 5;
    const int n = col_perm(nbt * 32 + r, mode);
    const float* p = W + (size_t)(kb * 16 + 8 * hh) * N + n;
    float v[8];
#pragma unroll
    for (int j = 0; j < 8; ++j) v[j] = p[(size_t)j * N];
    u32x4 o; o.x = pk2(v[0], v[1]); o.y = pk2(v[2], v[3]); o.z = pk2(v[4], v[5]); o.w = pk2(v[6], v[7]);
    *(u32x4*)(WF + (size_t)gid * 8) = o;
}

DI void norm_to_frag(const float* __restrict__ x, const float* __restrict__ g, const float* __restrict__ sh, const float* __restrict__ sc, bf16_t* __restrict__ hA, float* rstd_lds, int tile, int tid, bool have_rstd) {
    tid = opaque_v(tid); tile = opaque_s(tile);
    const int w = tid >> 6, lane = tid & 63;
    float cg[16], cs[16], ch[16];
#pragma unroll
    for (int j = 0; j < 2; ++j)
#pragma unroll
        for (int q = 0; q < 2; ++q) {
            const int c = 512 * j + 8 * lane + 4 * q;
            const float4 a = *(const float4*)(g + c), b = *(const float4*)(sc + c), d = *(const float4*)(sh + c);
            cg[8 * j + 4 * q] = a.x * (1.f + b.x); cg[8 * j + 4 * q + 1] = a.y * (1.f + b.y); cg[8 * j + 4 * q + 2] = a.z * (1.f + b.z); cg[8 * j + 4 * q + 3] = a.w * (1.f + b.w);
            ch[8 * j + 4 * q] = d.x; ch[8 * j + 4 * q + 1] = d.y; ch[8 * j + 4 * q + 2] = d.z; ch[8 * j + 4 * q + 3] = d.w;
            cs[8 * j + 4 * q] = 0.f; cs[8 * j + 4 * q + 1] = 0.f; cs[8 * j + 4 * q + 2] = 0.f; cs[8 * j + 4 * q + 3] = 0.f;
        }
    (void)cs;
#pragma unroll 8
    for (int rr = 0; rr < 16; ++rr) {
        const int row = w * 16 + rr;
        const float* xr = x + ((size_t)tile * 128 + row) * D + 8 * lane;
        float v[16];
#pragma unroll
        for (int j = 0; j < 2; ++j)
#pragma unroll
            for (int q = 0; q < 2; ++q) { const float4 a = *(const float4*)(xr + 512 * j + 4 * q); v[8 * j + 4 * q] = a.x; v[8 * j + 4 * q + 1] = a.y; v[8 * j + 4 * q + 2] = a.z; v[8 * j + 4 * q + 3] = a.w; }
        float r;
        if (have_rstd) r = rstd_lds[row];
        else {
            float ss = 0.f;
#pragma unroll
            for (int e = 0; e < 16; ++e) ss += v[e] * v[e];
            r = rsqrtf(wave_sum(ss) * (1.f / D) + EPS);
        }
        bf16_t* orow = hA + ((size_t)tile * 128 + row) * D + 8 * lane;
#pragma unroll
        for (int j = 0; j < 2; ++j) {
            u32x4 o;
            o.x = pk2(v[8 * j] * r * cg[8 * j] + ch[8 * j], v[8 * j + 1] * r * cg[8 * j + 1] + ch[8 * j + 1]);
            o.y = pk2(v[8 * j + 2] * r * cg[8 * j + 2] + ch[8 * j + 2], v[8 * j + 3] * r * cg[8 * j + 3] + ch[8 * j + 3]);
            o.z = pk2(v[8 * j + 4] * r * cg[8 * j + 4] + ch[8 * j + 4], v[8 * j + 5] * r * cg[8 * j + 5] + ch[8 * j + 5]);
            o.w = pk2(v[8 * j + 6] * r * cg[8 * j + 6] + ch[8 * j + 6], v[8 * j + 7] * r * cg[8 * j + 7] + ch[8 * j + 7]);
            *(u32x4*)(orow + 512 * j) = o;
        }
    }
}

template <int ORIENT>
DI void kloop(f32x16 (&acc)[4][2], const bf16_t* __restrict__ At, const bf16_t* __restrict__ W0, const bf16_t* __restrict__ W1, char* lds, int tid, int lane) {
    tid = opaque_v(tid); lane = opaque_v(lane);
#pragma unroll
    for (int mb = 0; mb < 4; ++mb)
#pragma unroll
        for (int nb = 0; nb < 2; ++nb)
#pragma unroll
            for (int i = 0; i < 16; ++i) acc[mb][nb][i] = 0.f;
    {
    const int c8_ = (tid >> 3) & 7, rowA_ = (tid >> 6) * 8 + (tid & 7);
    const u32x4* Ag = (const u32x4*)(At + (unsigned)(rowA_ * 1024 + c8_ * 8));
    const int ldsA_ = ((((c8_ >> 1) * 4 + (rowA_ >> 5)) * 64) + (rowA_ & 31) + 32 * (c8_ & 1)) * 16;
    const u32x4* W0g = (const u32x4*)W0 + lane;
    const u32x4* W1g = (const u32x4*)W1 + lane;
    u32x4 wq[4][2], arA[2], arB[2];
    arA[0] = Ag[0]; arA[1] = Ag[8192]; arB[0] = Ag[8]; arB[1] = Ag[8 + 8192];
#pragma unroll
    for (int kk = 0; kk < 4; ++kk) { wq[kk][0] = W0g[kk * 64]; wq[kk][1] = W1g[kk * 64]; }
    *(u32x4*)(lds + ldsA_) = arA[0]; *(u32x4*)(lds + ldsA_ + 2048) = arA[1];
    __syncthreads();
#define KL_ITER(KC, ARL, ARS) do { \
        char* cur = lds + ((KC) & 1) * 16384; \
        char* nxt = lds + (((KC) + 1) & 1) * 16384; \
        const int kn = (KC) < 15 ? (KC) + 1 : 15, k2 = (KC) < 14 ? (KC) + 2 : 15; \
        if ((KC) < 14) { ARL[0] = Ag[k2 * 8]; ARL[1] = Ag[k2 * 8 + 8192]; } \
        __builtin_amdgcn_sched_barrier(0); \
        bf16x8 afr[2][4]; \
        _Pragma("unroll") for (int mb = 0; mb < 4; ++mb) afr[0][mb] = *(const bf16x8*)(cur + ((0 * 4 + mb) * 64 + lane) * 16); \
        _Pragma("unroll") for (int kk = 0; kk < 4; ++kk) { \
            if (kk < 3) { _Pragma("unroll") for (int mb = 0; mb < 4; ++mb) afr[(kk + 1) & 1][mb] = *(const bf16x8*)(cur + (((kk + 1) * 4 + mb) * 64 + lane) * 16); } \
            _Pragma("unroll") for (int mb = 0; mb < 4; ++mb) \
                _Pragma("unroll") for (int nb = 0; nb < 2; ++nb) { \
                    const bf16x8 wf = __builtin_bit_cast(bf16x8, wq[kk][nb]); \
                    if (ORIENT == 0) acc[mb][nb] = MFMA32(afr[kk & 1][mb], wf, acc[mb][nb]); \
                    else acc[mb][nb] = MFMA32(wf, afr[kk & 1][mb], acc[mb][nb]); \
                } \
            if ((KC) < 15) { wq[kk][0] = W0g[(kn * 4 + kk) * 64]; wq[kk][1] = W1g[(kn * 4 + kk) * 64]; } \
            __builtin_amdgcn_sched_barrier(0); \
        } \
        if ((KC) < 15) { *(u32x4*)(nxt + ldsA_) = ARS[0]; *(u32x4*)(nxt + ldsA_ + 2048) = ARS[1]; } \
        __syncthreads(); \
    } while (0)
    for (int kc = 0; kc < 16; kc += 2) { KL_ITER(kc, arA, arB); KL_ITER(kc + 1, arB, arA); }
#undef KL_ITER
    }
}

DI void epi_f32row(const f32x16 (&acc)[4][2], float* __restrict__ C, int tile, int col0, int lane) {
    lane = opaque_v(lane);
    const int r5 = lane & 31, hh = lane >> 5;
    const unsigned boff = (unsigned)((tile * 128 + 4 * hh) * 2048 + col0 + r5);
#pragma unroll
    for (int mb = 0; mb < 4; ++mb)
#pragma unroll
        for (int nb = 0; nb < 2; ++nb)
#pragma unroll
            for (int i = 0; i < 16; ++i)
                C[boff + (unsigned)((mb * 32 + (i & 3) + 8 * (i >> 2)) * 2048 + nb * 32)] = acc[mb][nb][i];
}
DI void epi_resid(const f32x16 (&acc)[4][2], const float* __restrict__ xin, float* __restrict__ xout, const float* __restrict__ gate_b, float* T  , float* ssq  , int tile, int col0, int lane) {
    lane = opaque_v(lane);
    const int r5 = lane & 31, hh = lane >> 5, rq = lane >> 4, c4 = (lane & 15) * 4;
    const float4 gv = *(const float4*)(gate_b + col0 + c4);
#pragma unroll
    for (int mb = 0; mb < 4; ++mb) {
#pragma unroll
        for (int nb = 0; nb < 2; ++nb)
#pragma unroll
            for (int i = 0; i < 16; ++i) T[((i & 3) + 8 * (i >> 2) + 4 * hh) * 68 + nb * 32 + r5] = acc[mb][nb][i];
        asm volatile("s_waitcnt lgkmcnt(0)" ::: "memory");
#pragma unroll
        for (int j = 0; j < 8; ++j) {
            const int row = rq + 4 * j;
            const float4 v = *(const float4*)(T + row * 68 + c4);
            const unsigned o = (unsigned)((tile * 128 + mb * 32 + row) * D + col0 + c4);
            float4 xv = *(const float4*)(xin + o);
            xv.x += gv.x * v.x; xv.y += gv.y * v.y; xv.z += gv.z * v.z; xv.w += gv.w * v.w;
            *(float4*)(xout + o) = xv;
            float ss = xv.x * xv.x + xv.y * xv.y + xv.z * xv.z + xv.w * xv.w;
            ss = red16_sum(ss);
            if ((lane & 15) == 0) ssq[mb * 32 + row] = ss;
        }
        asm volatile("s_waitcnt lgkmcnt(0)" ::: "memory");
    }
}

DI void epi_qpf(const f32x16 (&acc)[4][2], bf16_t* __restrict__ QPF, int tile, int ft0, int lane) {
    lane = opaque_v(lane);
#pragma unroll
    for (int nb = 0; nb < 2; ++nb)
#pragma unroll
        for (int s = 0; s < 2; ++s)
#pragma unroll
            for (int mb = 0; mb < 4; ++mb) {
                const f32x16& a = acc[mb][nb];
                u32x4 o; o.x = pk2(a[8 * s], a[8 * s + 1]); o.y = pk2(a[8 * s + 2], a[8 * s + 3]); o.z = pk2(a[8 * s + 4], a[8 * s + 5]); o.w = pk2(a[8 * s + 6], a[8 * s + 7]);
                *(u32x4*)(QPF + ((unsigned)((((tile * 64 + ft0 + nb) * 2 + s) * 4 + mb) * 64 + lane)) * 8) = o;
            }
}

DI void conv_keys_item(const float* __restrict__ K, bf16_t* __restrict__ KF, int gid) {
    const int lane = gid & 63, s = (gid >> 6) & 1, nbl = (gid >> 7) & 3, nt = (gid >> 9) & 3, hp = gid >> 11;
    const int r = lane & 31, hh = lane >> 5;
    const float* p = K + ((size_t)hp * 128 + nt * 32 + r) * 128 + nbl * 32 + 16 * s + 4 * hh;
    const float4 a = *(const float4*)p, b = *(const float4*)(p + 8);
    u32x4 o; o.x = pk2(a.x, a.y); o.y = pk2(a.z, a.w); o.z = pk2(b.x, b.y); o.w = pk2(b.z, b.w);
    *(u32x4*)(KF + (size_t)gid * 8) = o;
}

DI void conv_table_row(const float* __restrict__ src, unsigned char* __restrict__ dst, float* __restrict__ sc, int lane, bool as_int4) {
    const float4* p = (const float4*)src + lane * 4;
    float4 v[4];
    float m = 0.f;
#pragma unroll
    for (int j = 0; j < 4; ++j) { v[j] = p[j]; m = fmaxf(m, fmaxf(fmaxf(fabsf(v[j].x), fabsf(v[j].y)), fmaxf(fabsf(v[j].z), fabsf(v[j].w)))); }
    m = wave_max(m);
    float scale = m > 0.f ? m * (1.f / 6.f) : 1.f;
    if (as_int4) {
        float ss = 0.f;
#pragma unroll
        for (int j = 0; j < 4; ++j) ss += v[j].x * v[j].x + v[j].y * v[j].y + v[j].z * v[j].z + v[j].w * v[j].w;
        ss = wave_sum(ss);
        const float sg = sqrtf(ss * (1.f / 1024.f));
        scale = fmaxf(sg * (1.f / 2.8f), m * (1.f / 16.f));
        if (!(scale > 0.f)) scale = 1.f;
    }
    const float inv = 1.f / scale;
    u32x2 o;
    unsigned* op = (unsigned*)&o;
#pragma unroll
    for (int j = 0; j < 2; ++j) {
        const float f[8] = {v[2 * j].x, v[2 * j].y, v[2 * j].z, v[2 * j].w, v[2 * j + 1].x, v[2 * j + 1].y, v[2 * j + 1].z, v[2 * j + 1].w};
        unsigned wv = 0;
        if (as_int4) {
#pragma unroll
            for (int e = 0; e < 8; ++e) { int q = __float2int_rn(f[e] * inv); q = q < -7 ? -7 : (q > 7 ? 7 : q); wv |= ((unsigned)q & 15u) << (4 * e); }
        } else {
            wv = __builtin_amdgcn_cvt_scalef32_pk_fp4_f32(wv, f[0] * inv, f[1] * inv, 1.0f, 0);
            wv = __builtin_amdgcn_cvt_scalef32_pk_fp4_f32(wv, f[2] * inv, f[3] * inv, 1.0f, 1);
            wv = __builtin_amdgcn_cvt_scalef32_pk_fp4_f32(wv, f[4] * inv, f[5] * inv, 1.0f, 2);
            wv = __builtin_amdgcn_cvt_scalef32_pk_fp4_f32(wv, f[6] * inv, f[7] * inv, 1.0f, 3);
        }
        op[j] = wv;
    }
    *(u32x2*)(dst + lane * 8) = o;
    if (lane == 0) *sc = scale;
}

DI void ce_desc(int& a, int& b) { const int mx = a > b ? a : b, mn = a > b ? b : a; a = mx; b = mn; }
DI void sort16_desc(int (&v)[16]) {
#pragma unroll
    for (int k = 2; k <= 16; k <<= 1)
#pragma unroll
        for (int j = k >> 1; j > 0; j >>= 1)
#pragma unroll
            for (int i = 0; i < 16; ++i) {
                const int l = i ^ j;
                if (l > i) { if ((i & k) == 0) ce_desc(v[i], v[l]); else ce_desc(v[l], v[i]); }
            }
}
DI void bitonic_merge16_desc(int (&v)[16]) {
#pragma unroll
    for (int j = 8; j > 0; j >>= 1)
#pragma unroll
        for (int i = 0; i < 16; ++i) { const int l = i ^ j; if (l > i) ce_desc(v[i], v[l]); }
}
DI void merge_top16(int (&a)[16], const int (&b)[16]) {
#pragma unroll
    for (int i = 0; i < 16; ++i) a[i] = a[i] > b[15 - i] ? a[i] : b[15 - i];
    bitonic_merge16_desc(a);
}
DI int f2ord(float f) { int b = __float_as_int(f); return b ^ ((b >> 31) & 0x7fffffff); }
DI float ord2f(int k) { return __int_as_float(k ^ ((k >> 31) & 0x7fffffff)); }

DI void route_tile(const bf16_t* __restrict__ QPF, const bf16_t* __restrict__ KF, char* lds_lists, unsigned char* lds_idx  , int tile, int tid) {
    tid = opaque_v(tid); tile = opaque_s(tile);
    const int lane = tid & 63, w = __builtin_amdgcn_readfirstlane(tid >> 6);
    const int r5 = lane & 31, hh = lane >> 5;
    unsigned char* myidx = lds_idx + w * 1024;
    for (int task = w; task < 32; task += 8) {
        const int h = task >> 2, tt = task & 3;
        f32x16 acc[2][4];
#pragma unroll
        for (int p = 0; p < 2; ++p)
#pragma unroll
            for (int nt = 0; nt < 4; ++nt)
#pragma unroll
                for (int i = 0; i < 16; ++i) acc[p][nt][i] = 0.f;
        {
            bf16x8 bq[3], ak[3][4];
#define ROUTE_LOAD(buf, step) do { const int p_ = (step) >> 3, ks_ = (step) & 7; \
                bq[buf] = *(const bf16x8*)(QPF + ((unsigned)((((tile * 64 + h * 8 + p_ * 4 + (ks_ >> 1)) * 2 + (ks_ & 1)) * 4 + tt) * 64 + lane)) * 8); \
                _Pragma("unroll") for (int nt = 0; nt < 4; ++nt) ak[buf][nt] = *(const bf16x8*)(KF + ((unsigned)(((((h * 2 + p_) * 4 + nt) * 8 + ks_) * 64) + lane)) * 8); } while (0)
            ROUTE_LOAD(0, 0);
            ROUTE_LOAD(1, 1);
#pragma unroll
            for (int step = 0; step < 16; ++step) {
                if (step < 14) ROUTE_LOAD((step + 2) % 3, step + 2);
#pragma unroll
                for (int nt = 0; nt < 4; ++nt) acc[step >> 3][nt] = MFMA32(ak[step % 3][nt], bq[step % 3], acc[step >> 3][nt]);
                __builtin_amdgcn_sched_barrier(0);
            }
#undef ROUTE_LOAD
        }
        int g[8][16];
#pragma unroll
        for (int nt = 0; nt < 4; ++nt)
#pragma unroll
            for (int i = 0; i < 16; ++i) {
                const unsigned a = __float_as_uint(acc[0][nt][i]), b = __float_as_uint(acc[1][nt][i]);
                auto sw = __builtin_amdgcn_permlane32_swap(a, b, false, false);
                const int n0 = nt * 32 + (i & 3) + 8 * (i >> 2);
                g[nt * 2 + (i >> 3)][i & 7] = (f2ord(__uint_as_float(sw[0])) & ~127) | n0;
                g[nt * 2 + (i >> 3)][8 + (i & 7)] = (f2ord(__uint_as_float(sw[1])) & ~127) | (n0 + 4);
            }
#pragma unroll
        for (int q = 0; q < 8; ++q) sort16_desc(g[q]);
        merge_top16(g[0], g[1]); merge_top16(g[2], g[3]); merge_top16(g[4], g[5]); merge_top16(g[6], g[7]);
        merge_top16(g[0], g[2]); merge_top16(g[4], g[6]);
        merge_top16(g[0], g[4]);
        {
            u32x4 pk;
            unsigned* pp = (unsigned*)&pk;
#pragma unroll
            for (int q = 0; q < 4; ++q) pp[q] = (unsigned)(g[0][4 * q] & 127) | ((unsigned)(g[0][4 * q + 1] & 127) << 8) | ((unsigned)(g[0][4 * q + 2] & 127) << 16) | ((unsigned)(g[0][4 * q + 3] & 127) << 24);
            *(u32x4*)(myidx + lane * 16) = pk;
        }
        float f0[16], f1[16];
#pragma unroll
        for (int i = 0; i < 16; ++i) {
            const unsigned a = (unsigned)g[0][i], b = a;
            auto sw = __builtin_amdgcn_permlane32_swap(a, b, false, false);
            f0[i] = ord2f((int)sw[0] & ~127); f1[i] = ord2f((int)sw[1] & ~127);
        }
        int c0[16], c1[16], c2[16], c3[16];
#pragma unroll
        for (int j = 0; j < 16; ++j) c0[j] = (f2ord(f0[0] + f1[j]) & ~255) | j;
#pragma unroll
        for (int i = 1; i < 16; ++i) c1[i - 1] = (f2ord(f0[i] + f1[0]) & ~255) | (i << 4);
        c1[15] = (int)0x80000000;
#define CK(i, j) ((f2ord(f0[i] + f1[j]) & ~255) | ((i) << 4) | (j))
        c2[0] = CK(1, 1); c2[1] = CK(1, 2); c2[2] = CK(1, 3); c2[3] = CK(1, 4); c2[4] = CK(1, 5); c2[5] = CK(1, 6); c2[6] = CK(1, 7);
        c2[7] = CK(2, 1); c2[8] = CK(2, 2); c2[9] = CK(2, 3); c2[10] = CK(2, 4);
        c2[11] = CK(3, 1); c2[12] = CK(3, 2); c2[13] = CK(3, 3);
        c2[14] = CK(4, 1); c2[15] = CK(4, 2);
        c3[0] = CK(5, 1); c3[1] = CK(6, 1); c3[2] = CK(7, 1);
#undef CK
#pragma unroll
        for (int q = 3; q < 16; ++q) c3[q] = (int)0x80000000;
        sort16_desc(c2);
        ce_desc(c3[0], c3[1]); ce_desc(c3[1], c3[2]); ce_desc(c3[0], c3[1]);
        merge_top16(c0, c1); merge_top16(c2, c3); merge_top16(c0, c2);
        float bs[16], den = 0.f;
#pragma unroll
        for (int i = 0; i < 16; ++i) { bs[i] = __expf(ord2f(c0[i] & ~255) - ord2f(c0[0] & ~255)); den += bs[i]; }
        const float rden = 1.f / den;
        asm volatile("s_waitcnt lgkmcnt(0)" ::: "memory");
#pragma unroll
        for (int q = 0; q < 8; ++q) {
            const int key = (int)__builtin_amdgcn_permlane32_swap((unsigned)c0[q], (unsigned)c0[8 + q], false, false)[0];
            const float gv = __uint_as_float(__builtin_amdgcn_permlane32_swap(__float_as_uint(bs[q]), __float_as_uint(bs[8 + q]), false, false)[0]) * rden;
            const int i = (key >> 4) & 15, j = key & 15;
            const int e = (int)myidx[r5 * 16 + i] * 128 + (int)myidx[(32 + r5) * 16 + j];
            const int tokl = tt * 32 + r5;
            ((unsigned short*)(lds_lists + PL_SEID))[tokl * 128 + h * 16 + 8 * hh + q] = (unsigned short)e;
            ((float*)(lds_lists + PL_SWGT))[tokl * 128 + h * 16 + 8 * hh + q] = gv;
        }
        asm volatile("s_waitcnt lgkmcnt(0)" ::: "memory");
    }
}

DI void unpack_h2(const bf16_t* __restrict__ hA, int t, int lane, f32x2 (&hv)[8]) {
    const int tile = t >> 7, row = t & 127, mb = row >> 5, r5 = row & 31;
    const bf16_t* hp = hA + ((unsigned)(((tile * 64 + lane) * 4 + mb) * 64 + r5)) * 8;
    const u32x4 ha = *(const u32x4*)hp, hb = *(const u32x4*)(hp + 32 * 8);
    const unsigned hw[8] = {ha.x, ha.y, ha.z, ha.w, hb.x, hb.y, hb.z, hb.w};
#pragma unroll
    for (int q = 0; q < 8; ++q) { hv[q].x = __uint_as_float(hw[q] << 16); hv[q].y = __uint_as_float(hw[q] & 0xffff0000u); }
}
typedef _Float16 h16x2 __attribute__((ext_vector_type(2)));
DI h16x2 fp4h(unsigned w, int sel) {
    return sel == 0 ? __builtin_amdgcn_cvt_scalef32_pk_f16_fp4(w, 1.0f, 0) : sel == 1 ? __builtin_amdgcn_cvt_scalef32_pk_f16_fp4(w, 1.0f, 1)
         : sel == 2 ? __builtin_amdgcn_cvt_scalef32_pk_f16_fp4(w, 1.0f, 2) : __builtin_amdgcn_cvt_scalef32_pk_f16_fp4(w, 1.0f, 3);
}
DI unsigned rowoff_lo(unsigned pr, unsigned k512, unsigned lane8) { unsigned r; asm("v_mad_u32_u16 %0, %1, %2, %3" : "=v"(r) : "v"(pr), "s"(k512), "v"(lane8)); return r; }
DI unsigned rowoff_hi(unsigned pr, unsigned k512, unsigned lane8) { unsigned r; asm("v_mad_u32_u16 %0, %1, %2, %3 op_sel:[1,0,0,0]" : "=v"(r) : "v"(pr), "s"(k512), "v"(lane8)); return r; }
DI int dot8z(int a, int b) { int r; asm("v_dot8_i32_i4 %0, %1, %2, 0" : "=v"(r) : "v"(a), "v"(b)); return r; }
DI void stage_token(const int* __restrict__ ridx, const float* __restrict__ rgate, char* lds, int t, int tloc, int lane) {
    lane = opaque_v(lane); t = opaque_s(t);
    unsigned short* seid = (unsigned short*)(lds + PL_SEID) + tloc * 128;
    float* swgt = (float*)(lds + PL_SWGT) + tloc * 128;
    seid[lane] = (unsigned short)ridx[(unsigned)(t * 128 + lane)]; seid[64 + lane] = (unsigned short)ridx[(unsigned)(t * 128 + 64 + lane)];
    swgt[lane] = rgate[(unsigned)(t * 128 + lane)]; swgt[64 + lane] = rgate[(unsigned)(t * 128 + 64 + lane)];
}
DI void peer_down_wave(const bf16_t* __restrict__ hA, char* lds, const unsigned char* __restrict__ TBd, const float* __restrict__ SC, int tile, int w, int lane) {
    lane = opaque_v(lane);
    const int half = lane >> 5;
    const unsigned lane16 = (unsigned)(lane & 31) * 16u;
    const int cb = (lane & 31) * 32 + half * 16;
    const int myu = 2 * (((lane >> 4) & 1) * 4 + ((lane >> 3) & 1) * 2 + ((lane >> 2) & 1)) + half;
    const unsigned short* seid = (const unsigned short*)(lds + PL_SEID) + w * 16 * 128;
    float* swgt = (float*)(lds + PL_SWGT) + w * 16 * 128;
    u32x4 haN, hbN;
    { const bf16_t* hp0 = hA + (unsigned)((tile * 128 + w * 16) * 1024 + cb); haN = *(const u32x4*)hp0; hbN = *(const u32x4*)(hp0 + 8); }
    u32x4 R[2][8];
    unsigned IDN[8];
#define DOWN_IDS(P_) do { _Pragma("unroll") for (int u_ = 0; u_ < 8; ++u_) IDN[u_] = seid[(P_) + 2 * u_ + half]; } while (0)
#define DOWN_LOADS(buf) do { _Pragma("unroll") for (int u_ = 0; u_ < 8; ++u_) R[buf][u_] = *(const u32x4*)(TBd + (IDN[u_] * 512u + lane16)); } while (0)
    DOWN_IDS(0); DOWN_LOADS(0); DOWN_IDS(16);
#pragma unroll 1
    for (int tl = 0; tl < 16; ++tl) {
        const int t = tile * 128 + w * 16 + tl;
        float* gp = swgt + tl * 128;
        const u32x4 ha = haN, hb = hbN;
        const int tn = tl < 15 ? tl + 1 : tl;
        const int pa_ = tl * 128 + (lane & 3) * 32 + myu;
        const f32x2 scA = *(const f32x2*)(SC + (unsigned)seid[pa_] * 2u), scB = *(const f32x2*)(SC + (unsigned)seid[pa_ + 16] * 2u);
        int rs[8];
        { const bf16_t* hp = hA + (unsigned)((t - tl + tn) * 1024 + cb); haN = *(const u32x4*)hp; hbN = *(const u32x4*)(hp + 8); }
        unsigned hhi[4], hlo[4];
        float hscale;
        {
            const unsigned hw[8] = {ha.x, ha.y, ha.z, ha.w, hb.x, hb.y, hb.z, hb.w};
            float hf[16];
            float m = 0.f;
#pragma unroll
            for (int q = 0; q < 8; ++q) { hf[2 * q] = __uint_as_float(hw[q] << 16); hf[2 * q + 1] = __uint_as_float(hw[q] & 0xffff0000u); m = fmaxf(m, fmaxf(fabsf(hf[2 * q]), fabsf(hf[2 * q + 1]))); }
            m = wave_max(m);
            hscale = m > 0.f ? m * (1.f / 119.f) : 1.f;
            const float inv = 1.f / hscale;
            unsigned qh[2] = {0u, 0u}, ql[2] = {0u, 0u};
#pragma unroll
            for (int e = 0; e < 16; ++e) {
                const int hq = __float2int_rn(hf[e] * inv);
                const int lo = ((hq + 8) & 15) - 8, hi = (hq - lo) >> 4;
                ql[e >> 3] |= ((unsigned)lo & 15u) << (4 * (e & 7));
                qh[e >> 3] |= ((unsigned)hi & 15u) << (4 * (e & 7));
            }
#pragma unroll
            for (int q = 0; q < 2; ++q) {
                auto sh_ = __builtin_amdgcn_permlane32_swap(qh[q], qh[q], false, false); hhi[q] = sh_[0]; hhi[2 + q] = sh_[1];
                auto sl_ = __builtin_amdgcn_permlane32_swap(ql[q], ql[q], false, false); hlo[q] = sl_[0]; hlo[2 + q] = sl_[1];
            }
        }
#pragma unroll
        for (int bt = 0; bt < 8; ++bt) {
            const int cur = bt & 1, nxt = cur ^ 1;
            const int p2 = bt < 6 ? tl * 128 + (bt + 2) * 16 : tn * 128 + (bt - 6) * 16;
            DOWN_LOADS(nxt);
            DOWN_IDS(p2);
            __builtin_amdgcn_sched_barrier(0);
            int part[8];
#pragma unroll
            for (int u = 0; u < 8; ++u) {
                const int r0_ = (int)R[cur][u].x, r1_ = (int)R[cur][u].y, r2_ = (int)R[cur][u].z, r3_ = (int)R[cur][u].w;
                int shi = dot8z(r0_, (int)hhi[0]);
                shi = __builtin_amdgcn_sdot8(r1_, (int)hhi[1], shi, false);
                shi = __builtin_amdgcn_sdot8(r2_, (int)hhi[2], shi, false);
                shi = __builtin_amdgcn_sdot8(r3_, (int)hhi[3], shi, false);
                int p_ = shi << 4;
                p_ = __builtin_amdgcn_sdot8(r0_, (int)hlo[0], p_, false);
                p_ = __builtin_amdgcn_sdot8(r1_, (int)hlo[1], p_, false);
                p_ = __builtin_amdgcn_sdot8(r2_, (int)hlo[2], p_, false);
                part[u] = __builtin_amdgcn_sdot8(r3_, (int)hlo[3], p_, false);
            }
            int r4[4], r2[2], r1;
            {
                const bool b3 = (lane & 8) != 0, b2 = (lane & 4) != 0;
#pragma unroll
                for (int q = 0; q < 4; ++q) { auto sw = __builtin_amdgcn_permlane16_swap((unsigned)part[q], (unsigned)part[q + 4], false, false); r4[q] = (int)sw[0] + (int)sw[1]; }
#pragma unroll
                for (int q = 0; q < 2; ++q) { const int keep = b3 ? r4[q + 2] : r4[q], give = b3 ? r4[q] : r4[q + 2]; r2[q] = keep + dppi<0x128>(give); }
                { const int keep = b2 ? r2[1] : r2[0], give = b2 ? r2[0] : r2[1]; r1 = keep + dppi<0x141>(give); }
                r1 += dppi<0x4E>(r1); r1 += dppi<0xB1>(r1);
            }
            rs[bt] = r1;
        }
        {
            const int j_ = lane & 3;
            const int ra = j_ == 0 ? rs[0] : j_ == 1 ? rs[2] : j_ == 2 ? rs[4] : rs[6];
            const int rb = j_ == 0 ? rs[1] : j_ == 1 ? rs[3] : j_ == 2 ? rs[5] : rs[7];
            float* gq = gp + j_ * 32 + myu;
            const float a0 = (float)ra * (scA.x * hscale), a1 = (float)rb * (scB.x * hscale);
            const float w0 = gq[0] * (0.5f * a0 * (1.f + erff(a0 * 0.70710678118654752f))) * scA.y;
            const float w1 = gq[16] * (0.5f * a1 * (1.f + erff(a1 * 0.70710678118654752f))) * scB.y;
            ((unsigned*)gq)[0] = (unsigned)__builtin_bit_cast(unsigned short, (_Float16)w0);
            ((unsigned*)gq)[16] = (unsigned)__builtin_bit_cast(unsigned short, (_Float16)w1);
        }
    }
#undef DOWN_IDS
#undef DOWN_LOADS
}
DI void peer_up_wave(char* lds, const unsigned char* __restrict__ TBu, const float* __restrict__ g2b, float* __restrict__ x, int tile, int w, int lane,
                     bf16_t* __restrict__ hAn, const float* __restrict__ g1n, const float* __restrict__ sh1n, const float* __restrict__ sc1n) {
    lane = opaque_v(lane);
    const int half = lane >> 5;
    const unsigned lane16 = (unsigned)(lane & 31) * 16u;
    const int cb = (lane & 31) * 32 + half * 16;
    const unsigned short* seid = (const unsigned short*)(lds + PL_SEID) + w * 16 * 128 + half;
    const unsigned* swgt = (const unsigned*)(lds + PL_SWGT) + w * 16 * 128 + half;
    u32x4 RA[8], RB[8];
    unsigned IDN[8], WA[8], WB[8];
#define UP_IDS(P_) do { _Pragma("unroll") for (int u_ = 0; u_ < 8; ++u_) IDN[u_] = seid[(P_) + 2 * u_]; } while (0)
#define UP_WTS(W, P_) do { _Pragma("unroll") for (int u_ = 0; u_ < 8; ++u_) W[u_] = swgt[(P_) + 2 * u_]; } while (0)
#define UP_LOADS(R) do { _Pragma("unroll") for (int u_ = 0; u_ < 8; ++u_) R[u_] = *(const u32x4*)(TBu + (IDN[u_] * 512u + lane16)); } while (0)
#define UP_COMPUTE(R, W) do { _Pragma("unroll") for (int u_ = 0; u_ < 8; ++u_) { \
        const unsigned wd_ = W[u_]; const h16x2 wp_ = __builtin_bit_cast(h16x2, wd_); const h16x2 w2_ = (h16x2){wp_.x, wp_.x}; \
        const unsigned r0_ = R[u_].x, r1_ = R[u_].y, r2_ = R[u_].z, r3_ = R[u_].w; \
        _Pragma("unroll") for (int q_ = 0; q_ < 4; ++q_) { acc[q_] = __builtin_elementwise_fma(w2_, fp4h(r0_, q_), acc[q_]); acc[4 + q_] = __builtin_elementwise_fma(w2_, fp4h(r1_, q_), acc[4 + q_]); \
            acc[8 + q_] = __builtin_elementwise_fma(w2_, fp4h(r2_, q_), acc[8 + q_]); acc[12 + q_] = __builtin_elementwise_fma(w2_, fp4h(r3_, q_), acc[12 + q_]); } } } while (0)
    UP_IDS(0); UP_LOADS(RA); UP_IDS(16); UP_WTS(WA, 0);
    float4 gv[4];
#pragma unroll
    for (int q = 0; q < 4; ++q) gv[q] = ((const float4*)(g2b + cb))[q];
    float4 cg[4], ch[4];
#pragma unroll
    for (int q = 0; q < 4; ++q) {
        cg[q] = (float4){0.f, 0.f, 0.f, 0.f}; ch[q] = cg[q];
        if (hAn) { const float4 a = ((const float4*)(g1n + cb))[q], b = ((const float4*)(sc1n + cb))[q]; ch[q] = ((const float4*)(sh1n + cb))[q];
                   cg[q].x = a.x * (1.f + b.x); cg[q].y = a.y * (1.f + b.y); cg[q].z = a.z * (1.f + b.z); cg[q].w = a.w * (1.f + b.w); }
    }
#pragma unroll 1
    for (int tk = 0; tk < 16; ++tk) {
        const int tn = tk < 15 ? tk + 1 : 15;
        float4* xp = (float4*)(x + (size_t)(unsigned)((tile * 128 + w * 16 + tk) * D + cb));
        float4 xv[4];
#pragma unroll
        for (int q = 0; q < 4; ++q) xv[q] = xp[q];
        h16x2 acc[16];
#pragma unroll
        for (int q = 0; q < 16; ++q) acc[q] = (h16x2){(_Float16)0.f, (_Float16)0.f};
#pragma unroll 1
        for (int i = 0; i < 4; ++i) {
            const int pa = tk * 128 + i * 32;
            const int pn = i < 3 ? pa + 32 : tn * 128;
            UP_LOADS(RB); UP_WTS(WB, pa + 16); UP_IDS(pn);
            __builtin_amdgcn_sched_barrier(0);
            UP_COMPUTE(RA, WA);
            UP_LOADS(RA); UP_WTS(WA, pn); UP_IDS(pn + 16);
            __builtin_amdgcn_sched_barrier(0);
            UP_COMPUTE(RB, WB);
        }
        h16x2 tot[8];
#pragma unroll
        for (int q = 0; q < 8; ++q) {
            const unsigned a_ = __builtin_bit_cast(unsigned, acc[q]), b_ = __builtin_bit_cast(unsigned, acc[q + 8]);
            auto sw = __builtin_amdgcn_permlane32_swap(a_, b_, false, false);
            const unsigned s0_ = sw[0], s1_ = sw[1];
            tot[q] = __builtin_bit_cast(h16x2, s0_) + __builtin_bit_cast(h16x2, s1_);
        }
        float ssx = 0.f;
#pragma unroll
        for (int q = 0; q < 4; ++q) {
            xv[q].x += gv[q].x * (float)tot[2 * q].x; xv[q].y += gv[q].y * (float)tot[2 * q].y; xv[q].z += gv[q].z * (float)tot[2 * q + 1].x; xv[q].w += gv[q].w * (float)tot[2 * q + 1].y;
            xp[q] = xv[q];
            ssx += xv[q].x * xv[q].x + xv[q].y * xv[q].y + xv[q].z * xv[q].z + xv[q].w * xv[q].w;
        }
        ssx = wave_sum(ssx);
        if (hAn) {
            const float rs = rsqrtf(ssx * (1.f / D) + EPS);
            bf16_t* orow = hAn + (size_t)(unsigned)((tile * 128 + w * 16 + tk) * D + cb);
#pragma unroll
            for (int j = 0; j < 2; ++j) {
                u32x4 o;
                o.x = pk2(xv[2 * j].x * rs * cg[2 * j].x + ch[2 * j].x, xv[2 * j].y * rs * cg[2 * j].y + ch[2 * j].y);
                o.y = pk2(xv[2 * j].z * rs * cg[2 * j].z + ch[2 * j].z, xv[2 * j].w * rs * cg[2 * j].w + ch[2 * j].w);
                o.z = pk2(xv[2 * j + 1].x * rs * cg[2 * j + 1].x + ch[2 * j + 1].x, xv[2 * j + 1].y * rs * cg[2 * j + 1].y + ch[2 * j + 1].y);
                o.w = pk2(xv[2 * j + 1].z * rs * cg[2 * j + 1].z + ch[2 * j + 1].z, xv[2 * j + 1].w * rs * cg[2 * j + 1].w + ch[2 * j + 1].w);
                *(u32x4*)(orow + 8 * j) = o;
            }
        }
    }
#undef UP_IDS
#undef UP_WTS
#undef UP_LOADS
#undef UP_COMPUTE
}

DI void epi_qk(f32x16 (&acc)[4][2], const float* __restrict__ gain, float scale, bf16_t* __restrict__ dst, int lane) {
    lane = opaque_v(lane);
    const int hh = lane >> 5;
    float gv[2][16];
#pragma unroll
    for (int nb = 0; nb < 2; ++nb)
#pragma unroll
        for (int i = 0; i < 16; ++i) gv[nb][i] = gain[nb * 32 + (i & 3) + 8 * (i >> 2) + 4 * hh] * scale;
#pragma unroll
    for (int mb = 0; mb < 4; ++mb) {
        float ss = 0.f;
#pragma unroll
        for (int nb = 0; nb < 2; ++nb)
#pragma unroll
            for (int i = 0; i < 16; ++i) ss += acc[mb][nb][i] * acc[mb][nb][i];
        ss = x32_sum(ss);
        const float r = rsqrtf(ss * (1.f / 64.f) + EPS);
#pragma unroll
        for (int nb = 0; nb < 2; ++nb)
#pragma unroll
            for (int s = 0; s < 2; ++s) {
                const f32x16& a = acc[mb][nb];
                u32x4 o;
                o.x = pk2(a[8 * s] * r * gv[nb][8 * s], a[8 * s + 1] * r * gv[nb][8 * s + 1]);
                o.y = pk2(a[8 * s + 2] * r * gv[nb][8 * s + 2], a[8 * s + 3] * r * gv[nb][8 * s + 3]);
                o.z = pk2(a[8 * s + 4] * r * gv[nb][8 * s + 4], a[8 * s + 5] * r * gv[nb][8 * s + 5]);
                o.w = pk2(a[8 * s + 6] * r * gv[nb][8 * s + 6], a[8 * s + 7] * r * gv[nb][8 * s + 7]);
                *(u32x4*)(dst + ((unsigned)(((nb * 2 + s) * 4 + mb) * 64 + lane)) * 8) = o;
            }
    }
}
DI void epi_v(const f32x16 (&acc)[4][2], bf16_t* __restrict__ dst, int lane) {
    lane = opaque_v(lane);
#pragma unroll
    for (int nb = 0; nb < 2; ++nb)
#pragma unroll
        for (int mb = 0; mb < 4; ++mb)
#pragma unroll
            for (int s = 0; s < 2; ++s) {
                const f32x16& a = acc[mb][nb];
                u32x4 o; o.x = pk2(a[8 * s], a[8 * s + 1]); o.y = pk2(a[8 * s + 2], a[8 * s + 3]); o.z = pk2(a[8 * s + 4], a[8 * s + 5]); o.w = pk2(a[8 * s + 6], a[8 * s + 7]);
                *(u32x4*)(dst + ((unsigned)(((nb * 4 + mb) * 2 + s) * 64 + lane)) * 8) = o;
            }
}
DI void epi_row(const f32x16 (&acc)[4][2], bf16_t* __restrict__ dst, int ld, int lane) {
    lane = opaque_v(lane);
    const int r5 = lane & 31, hh = lane >> 5;
#pragma unroll
    for (int mb = 0; mb < 4; ++mb)
#pragma unroll
        for (int nb = 0; nb < 2; ++nb)
#pragma unroll
            for (int gq = 0; gq < 4; gq += 2) {
                const f32x16& a = acc[mb][nb];
                const unsigned ax = pk2(a[4 * gq], a[4 * gq + 1]), ay = pk2(a[4 * gq + 2], a[4 * gq + 3]);
                const unsigned bx = pk2(a[4 * gq + 4], a[4 * gq + 5]), by = pk2(a[4 * gq + 6], a[4 * gq + 7]);
                auto sx = __builtin_amdgcn_permlane32_swap(ax, bx, false, false);
                auto sy = __builtin_amdgcn_permlane32_swap(ay, by, false, false);
                u32x4 o; o.x = sx[0]; o.y = sy[0]; o.z = sx[1]; o.w = sy[1];
                *(u32x4*)(dst + (unsigned)((mb * 32 + r5) * ld + nb * 32 + 8 * (gq + hh))) = o;
            }
}
DI void epi_z(const f32x16 (&acc)[4][2], bf16_t* __restrict__ dst, int lane) {
    lane = opaque_v(lane);
    const int r5 = lane & 31, hh = lane >> 5;
#pragma unroll
    for (int mb = 0; mb < 4; ++mb)
#pragma unroll
        for (int gq = 0; gq < 4; gq += 2) {
            const f32x16 &a = acc[mb][0], &b = acc[mb][1];
            const unsigned ax = pk2(a[4 * gq] * b[4 * gq], a[4 * gq + 1] * b[4 * gq + 1]), ay = pk2(a[4 * gq + 2] * b[4 * gq + 2], a[4 * gq + 3] * b[4 * gq + 3]);
            const unsigned bx = pk2(a[4 * gq + 4] * b[4 * gq + 4], a[4 * gq + 5] * b[4 * gq + 5]), by = pk2(a[4 * gq + 6] * b[4 * gq + 6], a[4 * gq + 7] * b[4 * gq + 7]);
            auto sx = __builtin_amdgcn_permlane32_swap(ax, bx, false, false);
            auto sy = __builtin_amdgcn_permlane32_swap(ay, by, false, false);
            u32x4 o; o.x = sx[0]; o.y = sy[0]; o.z = sx[1]; o.w = sy[1];
            *(u32x4*)(dst + (unsigned)((mb * 32 + r5) * 256 + 8 * (gq + hh))) = o;
        }
}
DI void epi_su_park(const f32x16 (&acc)[4][2], unsigned* lds_su, int lane) {
    lane = opaque_v(lane);
#pragma unroll
    for (int mb = 0; mb < 4; ++mb)
#pragma unroll
        for (int nb = 0; nb < 2; ++nb)
#pragma unroll
            for (int q = 0; q < 8; ++q) lds_su[((mb * 2 + nb) * 8 + q) * 64 + lane] = pk2(acc[mb][nb][2 * q], acc[mb][nb][2 * q + 1]);
}
DI void epi_sv(f32x16 (&acc)[4][2], const bf16_t* __restrict__ SWF  , const float* __restrict__ bs_g, const unsigned* lds_su, bf16_t* __restrict__ dst, int lane) {
    lane = opaque_v(lane);
    const int r5 = lane & 31, hh = lane >> 5;
    bf16x8 vb[4][2][2];
#pragma unroll
    for (int mb = 0; mb < 4; ++mb) {
#pragma unroll
        for (int i = 0; i < 16; ++i) {
            float s1 = acc[mb][0][i] + acc[mb][1][i];
            s1 = red32_sum(s1);
            const float mu = s1 * (1.f / 64.f);
            const float d0 = acc[mb][0][i] - mu, d1 = acc[mb][1][i] - mu;
            float s2 = d0 * d0 + d1 * d1;
            s2 = red32_sum(s2);
            const float r = rsqrtf(s2 * (1.f / 64.f) + EPS);
            acc[mb][0][i] = d0 * r; acc[mb][1][i] = d1 * r;
        }
#pragma unroll
        for (int s = 0; s < 2; ++s)
#pragma unroll
            for (int nb = 0; nb < 2; ++nb) {
                const f32x16& a = acc[mb][nb];
                u32x4 o; o.x = pk2(a[8 * s], a[8 * s + 1]); o.y = pk2(a[8 * s + 2], a[8 * s + 3]); o.z = pk2(a[8 * s + 4], a[8 * s + 5]); o.w = pk2(a[8 * s + 6], a[8 * s + 7]);
                vb[mb][s][nb] = __builtin_bit_cast(bf16x8, o);
            }
    }
#pragma unroll
    for (int tb = 0; tb < 4; ++tb) {
        f32x16 y[2];
#pragma unroll
        for (int nb = 0; nb < 2; ++nb)
#pragma unroll
            for (int i = 0; i < 16; ++i) y[nb][i] = 0.f;
#pragma unroll
        for (int kt = 0; kt <= tb; ++kt)
#pragma unroll
            for (int s = 0; s < 2; ++s) {
                const bf16x8 wa = *(const bf16x8*)(SWF + ((unsigned)(((tb * 4 + kt) * 2 + s) * 64 + lane)) * 8);
                y[0] = MFMA32(wa, vb[kt][s][0], y[0]);
                y[1] = MFMA32(wa, vb[kt][s][1], y[1]);
            }
#pragma unroll
        for (int nb = 0; nb < 2; ++nb)
#pragma unroll
            for (int q = 0; q < 8; ++q) {
                const unsigned su2 = lds_su[((tb * 2 + nb) * 8 + q) * 64 + lane];
                const int i0 = 2 * q, i1 = 2 * q + 1;
                const int t0 = tb * 32 + (i0 & 3) + 8 * (i0 >> 2) + 4 * hh, t1 = tb * 32 + (i1 & 3) + 8 * (i1 >> 2) + 4 * hh;
                const float v0 = (y[nb][i0] + bs_g[t0]) * __uint_as_float(su2 << 16), v1 = (y[nb][i1] + bs_g[t1]) * __uint_as_float(su2 & 0xffff0000u);
                const unsigned pk = pk2(v0, v1);
                dst[(unsigned)(t0 * 256 + nb * 32 + r5)] = (bf16_t)(pk & 0xffffu);
                dst[(unsigned)(t1 * 256 + nb * 32 + r5)] = (bf16_t)(pk >> 16);
            }
    }
}

DI void conv_sguw_item(const float* __restrict__ W, bf16_t* __restrict__ SWF, int gid) {
    const int lane = gid & 63, s = (gid >> 6) & 1, kt = (gid >> 7) & 3, tb = (gid >> 9) & 3, g = gid >> 11;
    const int r = lane & 31, hh = lane >> 5, t = tb * 32 + r;
    const float* p = W + ((size_t)g * 128 + t) * 128;
    float v[8];
#pragma unroll
    for (int j = 0; j < 8; ++j) { const int sp = kt * 32 + 16 * s + 8 * (j >> 2) + 4 * hh + (j & 3); v[j] = sp <= t ? p[sp] : 0.f; }
    u32x4 o; o.x = pk2(v[0], v[1]); o.y = pk2(v[2], v[3]); o.z = pk2(v[4], v[5]); o.w = pk2(v[6], v[7]);
    *(u32x4*)(SWF + (size_t)gid * 8) = o;
}

DI int t5_bucket(int d) {
    if (d < 16) return d;
    const float lr = logf((float)d / 16.f) / logf(8.f);
    const int large = 16 + (int)(lr * 16.f);
    return large < 31 ? large : 31;
}

DI void attn_tile(const bf16_t* __restrict__ QF, const bf16_t* __restrict__ KF2, const bf16_t* __restrict__ VF, char* lds, const float* bias_lds, const float* __restrict__ sink, bf16_t* __restrict__ OR, int tile, int tid) {
    tid = opaque_v(tid); tile = opaque_s(tile);
    const int lane = tid & 63, w = __builtin_amdgcn_readfirstlane(tid >> 6), r5 = lane & 31, hh = lane >> 5;
    const bool has_prev = (tile & 31) != 0;
    {
        u32x4 tmp[16];
#pragma unroll
        for (int i = 0; i < 16; ++i) {
            const int blk = w * 16 + i;
            const int isv = blk >> 6, bb = blk & 63;
            const bf16_t* src;
            if (!isv) { const int kvh = bb >> 5, ks = (bb >> 3) & 3, wt = bb & 7, st = (wt >= 4 || !has_prev) ? tile : tile - 1;
                src = KF2 + ((unsigned)((((st * 2 + kvh) * 4 + ks) * 4 + (wt & 3)) * 64 + lane)) * 8; }
            else { const int kvh = bb >> 5, dt = (bb >> 4) & 1, wt = (bb >> 1) & 7, s2 = bb & 1, st = (wt >= 4 || !has_prev) ? tile : tile - 1;
                src = VF + ((unsigned)(((((st * 2 + kvh) * 2 + dt) * 4 + (wt & 3)) * 2 + s2) * 64 + lane)) * 8; }
            tmp[i] = *(const u32x4*)src;
        }
#pragma unroll
        for (int i = 0; i < 16; ++i) *(u32x4*)(lds + (w * 16 + i) * 1024 + lane * 16) = tmp[i];
    }
    __syncthreads();
    const char* ldsK = lds, *ldsV = lds + 65536;
    for (int task = w; task < 32; task += 8) {
        const int qh = task >> 2, qt = task & 3, kvh = qh >> 2;
        bf16x8 bq[4];
#pragma unroll
        for (int ks = 0; ks < 4; ++ks) bq[ks] = *(const bf16x8*)(QF + ((unsigned)((((tile * 8 + qh) * 4 + ks) * 4 + qt) * 64 + lane)) * 8);
        f32x16 sc[5];
#pragma unroll
        for (int jj = 0; jj < 5; ++jj) {
#pragma unroll
            for (int i = 0; i < 16; ++i) sc[jj][i] = 0.f;
#pragma unroll
            for (int ks = 0; ks < 4; ++ks) {
                const bf16x8 kf = *(const bf16x8*)(ldsK + ((kvh * 4 + ks) * 8 + qt + jj) * 1024 + lane * 16);
                sc[jj] = MFMA32(kf, bq[ks], sc[jj]);
            }
        }
        const float* bl = bias_lds + qh * 128;
        float m = -1e30f;
#pragma unroll
        for (int jj = 0; jj < 5; ++jj) {
            const bool ex = (qt + jj >= 4) || has_prev;
#pragma unroll
            for (int i = 0; i < 16; ++i) {
                const int cr = (i & 3) + 8 * (i >> 2) + 4 * hh;
                const int dist = 128 + r5 - 32 * jj - cr;
                const bool valid = ex && dist >= 0 && dist < 128;
                float bv = bl[dist & 127];
                asm volatile("" : "+v"(bv));
                const float v = valid ? sc[jj][i] + bv : -1e30f;
                sc[jj][i] = v; m = fmaxf(m, v);
            }
        }
        m = x32_max(m);
        const float sk = sink[qh];
        m = fmaxf(m, sk);
        float l = 0.f;
#pragma unroll
        for (int jj = 0; jj < 5; ++jj)
#pragma unroll
            for (int i = 0; i < 16; ++i) { const float p = __expf(sc[jj][i] - m); sc[jj][i] = p; l += p; }
        l = x32_sum(l);
        l += __expf(sk - m);
        const float rl = 1.f / l;
        f32x16 o[2];
#pragma unroll
        for (int dt = 0; dt < 2; ++dt)
#pragma unroll
            for (int i = 0; i < 16; ++i) o[dt][i] = 0.f;
#pragma unroll
        for (int jj = 0; jj < 5; ++jj) {
#pragma unroll
            for (int s = 0; s < 2; ++s) {
                const f32x16& a = sc[jj];
                u32x4 pp; pp.x = pk2(a[8 * s], a[8 * s + 1]); pp.y = pk2(a[8 * s + 2], a[8 * s + 3]); pp.z = pk2(a[8 * s + 4], a[8 * s + 5]); pp.w = pk2(a[8 * s + 6], a[8 * s + 7]);
                const bf16x8 pb = __builtin_bit_cast(bf16x8, pp);
#pragma unroll
                for (int dt = 0; dt < 2; ++dt) {
                    const bf16x8 vf = *(const bf16x8*)(ldsV + (((kvh * 2 + dt) * 8 + qt + jj) * 2 + s) * 1024 + lane * 16);
                    o[dt] = MFMA32(vf, pb, o[dt]);
                }
            }
        }
        bf16_t* orow = OR + (unsigned)((tile * 128 + qt * 32 + r5) * 512 + qh * 64 + 4 * hh);
#pragma unroll
        for (int dt = 0; dt < 2; ++dt)
#pragma unroll
            for (int gq = 0; gq < 4; ++gq) {
                u32x2 ov; ov.x = pk2(o[dt][4 * gq] * rl, o[dt][4 * gq + 1] * rl); ov.y = pk2(o[dt][4 * gq + 2] * rl, o[dt][4 * gq + 3] * rl);
                *(u32x2*)(orow + dt * 32 + 8 * gq) = ov;
            }
    }
}

DI void unpack8(const u32x4 v, float (&f)[8]) {
    f[0] = __uint_as_float(v.x << 16); f[1] = __uint_as_float(v.x & 0xffff0000u); f[2] = __uint_as_float(v.y << 16); f[3] = __uint_as_float(v.y & 0xffff0000u);
    f[4] = __uint_as_float(v.z << 16); f[5] = __uint_as_float(v.z & 0xffff0000u); f[6] = __uint_as_float(v.w << 16); f[7] = __uint_as_float(v.w & 0xffff0000u);
}
DI void merge_tile(const bf16_t* __restrict__ OR, const bf16_t* __restrict__ CBR, const bf16_t* __restrict__ ZR, const bf16_t* __restrict__ YS, const float* __restrict__ cw  , const float* __restrict__ og  ,
                   bf16_t* __restrict__ mA, int tile, int tid) {
    tid = opaque_v(tid); tile = opaque_s(tile);
    const int lane = tid & 63, w = tid >> 6;
    float cwv[3][8], ga[8], gb[8];
    {
        const int c0 = (lane & 31) * 8;
#pragma unroll
        for (int j = 0; j < 3; ++j) { const float4 p0 = *(const float4*)(cw + j * 256 + c0), p1 = *(const float4*)(cw + j * 256 + c0 + 4);
            cwv[j][0] = p0.x; cwv[j][1] = p0.y; cwv[j][2] = p0.z; cwv[j][3] = p0.w; cwv[j][4] = p1.x; cwv[j][5] = p1.y; cwv[j][6] = p1.z; cwv[j][7] = p1.w; }
        const float4 a0 = *(const float4*)(og + lane * 8), a1 = *(const float4*)(og + lane * 8 + 4), b0 = *(const float4*)(og + 512 + lane * 8), b1 = *(const float4*)(og + 512 + lane * 8 + 4);
        ga[0] = a0.x; ga[1] = a0.y; ga[2] = a0.z; ga[3] = a0.w; ga[4] = a1.x; ga[5] = a1.y; ga[6] = a1.z; ga[7] = a1.w;
        gb[0] = b0.x; gb[1] = b0.y; gb[2] = b0.z; gb[3] = b0.w; gb[4] = b1.x; gb[5] = b1.y; gb[6] = b1.z; gb[7] = b1.w;
    }
#pragma unroll 8
    for (int rr = 0; rr < 16; ++rr) {
        const int row = w * 16 + rr, t = tile * 128 + row, pos = t & (S - 1);
        float a[8], y[8];
        unpack8(*(const u32x4*)(OR + (unsigned)(t * 512 + lane * 8)), a);
        float ssa = 0.f;
#pragma unroll
        for (int q = 0; q < 8; ++q) ssa += a[q] * a[q];
        ssa = wave_sum(ssa);
        {
            const int c0 = (lane & 31) * 8;
            float cb[8], z0[8], z1[8], z2[8], ys[8];
            const float m1 = pos >= 1 ? 1.f : 0.f, m2 = pos >= 2 ? 1.f : 0.f;
            const int t1 = pos >= 1 ? t - 1 : t, t2 = pos >= 2 ? t - 2 : t;
            unpack8(*(const u32x4*)(CBR + (unsigned)(t * 256 + c0)), cb);
            unpack8(*(const u32x4*)(ZR + (unsigned)(t * 256 + c0)), z2);
            unpack8(*(const u32x4*)(ZR + (unsigned)(t1 * 256 + c0)), z1);
            unpack8(*(const u32x4*)(ZR + (unsigned)(t2 * 256 + c0)), z0);
            unpack8(*(const u32x4*)(YS + (unsigned)(t * 256 + c0)), ys);
#pragma unroll
            for (int q = 0; q < 8; ++q) {
                const float yc = cb[q] * (cwv[0][q] * (z0[q] * m2) + cwv[1][q] * (z1[q] * m1) + cwv[2][q] * z2[q]);
                y[q] = lane < 32 ? yc : ys[q];
            }
        }
        float ssy = 0.f;
#pragma unroll
        for (int q = 0; q < 8; ++q) ssy += y[q] * y[q];
        ssy = red32_sum(ssy);
        const float ra = rsqrtf(ssa * (1.f / 512.f) + EPS), ry = rsqrtf(ssy * (1.f / 256.f) + EPS);
        const int mb = row >> 5, r5 = row & 31;
        {
            u32x4 o; o.x = pk2(a[0] * ra * ga[0], a[1] * ra * ga[1]); o.y = pk2(a[2] * ra * ga[2], a[3] * ra * ga[3]); o.z = pk2(a[4] * ra * ga[4], a[5] * ra * ga[5]); o.w = pk2(a[6] * ra * ga[6], a[7] * ra * ga[7]);
            const int c8 = lane;
            (void)c8;
            *(u32x4*)(mA + (unsigned)(t * 1024 + lane * 8)) = o;
        }
        {
            u32x4 o; o.x = pk2(y[0] * ry * gb[0], y[1] * ry * gb[1]); o.y = pk2(y[2] * ry * gb[2], y[3] * ry * gb[3]); o.z = pk2(y[4] * ry * gb[4], y[5] * ry * gb[5]); o.w = pk2(y[6] * ry * gb[6], y[7] * ry * gb[7]);
            const int c8 = 64 + lane;
            (void)c8;
            *(u32x4*)(mA + (unsigned)(t * 1024 + 512 + lane * 8)) = o;
        }
    }
}

struct InProjOut { bf16_t *QF, *KF2, *VF, *CBR, *ZR, *YS; };
DI void inproj_tile(const bf16_t* __restrict__ At, const bf16_t* __restrict__ WF, const float* __restrict__ qg, const float* __restrict__ kg, const bf16_t* __restrict__ SWF, const float* __restrict__ sgu_b,
                    const InProjOut& O, char* lds, int tile, int tid) {
    tid = opaque_v(tid); tile = opaque_s(tile);
    const int lane = tid & 63, w = __builtin_amdgcn_readfirstlane(tid >> 6);
    f32x16 acc[4][2];
    {
        const int nbt0 = w * 2;
        kloop<1>(acc, At, WF + (size_t)nbt0 * 32768, WF + (size_t)(nbt0 + 1) * 32768, lds, tid, lane);
        epi_qk(acc, qg, 0.125f, O.QF + (size_t)(tile * 8 + w) * 8192, lane);
    }
    {
        const int nbt0 = 16 + w * 2;
        if (w == 2 || w == 3) {
            kloop<0>(acc, At, WF + (size_t)nbt0 * 32768, WF + (size_t)(nbt0 + 1) * 32768, lds, tid, lane);
            epi_v(acc, O.VF + (size_t)(tile * 2 + (w - 2)) * 8192, lane);
        } else {
            kloop<1>(acc, At, WF + (size_t)nbt0 * 32768, WF + (size_t)(nbt0 + 1) * 32768, lds, tid, lane);
            if (w < 2) epi_qk(acc, kg, 1.f, O.KF2 + (size_t)(tile * 2 + w) * 8192, lane);
            else epi_row(acc, O.CBR + (size_t)tile * 128 * 256 + (w - 4) * 64, 256, lane);
        }
    }
    {
        const int nbt0 = 32 + w * 2;
        kloop<1>(acc, At, WF + (size_t)nbt0 * 32768, WF + (size_t)(nbt0 + 1) * 32768, lds, tid, lane);
        epi_z(acc, O.ZR + (size_t)tile * 128 * 256 + w * 32, lane);
    }
    {
        const int nbt0 = 48 + w * 2;
        kloop<0>(acc, At, WF + (size_t)nbt0 * 32768, WF + (size_t)(nbt0 + 1) * 32768, lds, tid, lane);
        unsigned* lds_su = (unsigned*)lds;
        if (w < 4) epi_su_park(acc, lds_su + w * 4096, lane);
        __syncthreads();
        if (w >= 4) epi_sv(acc, SWF + (size_t)(w - 4) * 16384, sgu_b + (w - 4) * 128, lds_su + (w - 4) * 4096, O.YS + (size_t)tile * 128 * 256 + (w - 4) * 64, lane);
        __syncthreads();
    }
}


struct Params {
    const float *x, *c, *rel_bias, *w_ada, *b_ada, *norm1_g, *norm2_g, *w_in, *q_norm_g, *k_norm_g, *attn_sink, *conv_w, *sgu_w, *sgu_b, *out_norm_g, *w_out, *peer_wq, *peer_sub_keys, *peer_down, *peer_up;
    float* out;
    char* ws;
};
constexpr size_t MiB = 1u << 20;
constexpr size_t WS_MOD = 0;
constexpr size_t WS_MODP = 1 * MiB;
constexpr size_t WS_WIN = 13 * MiB;
constexpr size_t WS_WOUT = 29 * MiB;
constexpr size_t WS_WPQ = 37 * MiB;
constexpr size_t WS_KEYS = 53 * MiB;
constexpr size_t WS_SWF = 55 * MiB;
constexpr size_t WS_SC = 56 * MiB;
constexpr size_t WS_TB = 57 * MiB;
constexpr size_t WS_HA = 185 * MiB;
constexpr size_t WS_QF = 249 * MiB;
constexpr size_t WS_KF2 = 602 * MiB;
constexpr size_t WS_VF = 634 * MiB;
constexpr size_t WS_ZR = 666 * MiB;
constexpr size_t WS_CBR = 345 * MiB;
constexpr size_t WS_YS = 361 * MiB;
constexpr size_t WS_OR = 377 * MiB;
constexpr size_t WS_QPF = 409 * MiB;
constexpr size_t WS_RIDX = 537 * MiB;
constexpr size_t WS_RGATE = 553 * MiB;
constexpr size_t WS_SEID = 569 * MiB;
constexpr size_t WS_SWGT = 585 * MiB;
constexpr size_t WS_OFFS = 601 * MiB;
constexpr size_t WS_FLAGS = 601 * MiB + 512 * 1024;
constexpr size_t WS_END = 730 * MiB;
static_assert(PL_END <= LDS_RSTD1, "expert-phase lists overlap persistent LDS state");

__global__ __launch_bounds__(512) void hybrid_fwd(Params P) {
    extern __shared__ __attribute__((aligned(16))) char lds[];
    cg::grid_group grid = cg::this_grid();
    const int tid = threadIdx.x, lane = tid & 63, w = __builtin_amdgcn_readfirstlane(tid >> 6);
    const int nblk = gridDim.x, hwb = blockIdx.x;
    const int bid = (nblk == NTILE) ? (hwb & 7) * 32 + (hwb >> 3) : hwb;
    char* ws = P.ws;
    float* mod = (float*)(ws + WS_MOD);
    float* modp = (float*)(ws + WS_MODP);
    bf16_t* WinF = (bf16_t*)(ws + WS_WIN); bf16_t* WoutF = (bf16_t*)(ws + WS_WOUT); bf16_t* WpqF = (bf16_t*)(ws + WS_WPQ);
    bf16_t* KeysF = (bf16_t*)(ws + WS_KEYS); bf16_t* SWF = (bf16_t*)(ws + WS_SWF);
    float* SC = (float*)(ws + WS_SC); unsigned char* TBd = (unsigned char*)(ws + WS_TB); unsigned char* TBu = TBd + 32 * MiB;
    bf16_t* hA = (bf16_t*)(ws + WS_HA);
    bf16_t* OR = (bf16_t*)(ws + WS_OR); bf16_t* QPF = (bf16_t*)(ws + WS_QPF);
    int* ridx = (int*)(ws + WS_RIDX); float* rgate = (float*)(ws + WS_RGATE);
    float* bias_lds = (float*)(lds + LDS_BIAS);
    unsigned* flags = (unsigned*)(ws + WS_FLAGS);

    {
        float* ca = (float*)lds;
        if (tid == 0) for (int tile = bid; tile < NTILE; tile += nblk) __hip_atomic_store(flags + tile, 0u, __ATOMIC_RELAXED, __HIP_MEMORY_SCOPE_AGENT);
        for (int i = tid; i < 8192; i += 512) { const float v = P.c[i]; ca[i] = v / (1.f + __expf(-v)); }
        for (int i = tid; i < 1024; i += 512) bias_lds[i] = P.rel_bias[t5_bucket(i & 127) * 8 + (i >> 7)];
        __syncthreads();
        for (int it = bid; it < 768; it += nblk) {
            const int jc = it % 12, l = (it / 12) & 3, ks = it / 48;
            const int j = jc * 512 + tid;
            const float* wp = P.w_ada + ((size_t)l * 1024 + ks * 64) * 6144 + j;
            float acc[8];
#pragma unroll
            for (int b = 0; b < 8; ++b) acc[b] = 0.f;
#pragma unroll 4
            for (int i = 0; i < 64; ++i) {
                const float wv = wp[(size_t)i * 6144];
#pragma unroll
                for (int b = 0; b < 8; ++b) acc[b] += ca[b * 1024 + ks * 64 + i] * wv;
            }
#pragma unroll
            for (int b = 0; b < 8; ++b) modp[((size_t)(ks * 4 + l) * 8 + b) * 6144 + j] = acc[b];
        }
        const int gthreads = nblk * 512, gtid = bid * 512 + tid;
        for (int rep = 0; rep < REP_P0; ++rep)
        for (int l = 0; l < DEPTH; ++l) {
            for (int g = gtid; g < 64 * 64 * 64; g += gthreads) conv_wfrag_item(P.w_in + (size_t)l * 1024 * 2048, 2048, 64, WinF + (size_t)l * 2097152, g, 1);
            for (int g = gtid; g < 32 * 64 * 64; g += gthreads) conv_wfrag_item(P.w_out + (size_t)l * 1024 * 1024, 1024, 64, WoutF + (size_t)l * 1048576, g, 0);
            for (int g = gtid; g < 64 * 64 * 64; g += gthreads) conv_wfrag_item(P.peer_wq + (size_t)l * 1024 * 2048, 2048, 64, WpqF + (size_t)l * 2097152, g, 0);
            for (int g = gtid; g < 32768; g += gthreads) conv_keys_item(P.peer_sub_keys + (size_t)l * 262144, KeysF + (size_t)l * 262144, g);
            for (int g = gtid; g < 8192; g += gthreads) conv_sguw_item(P.sgu_w + (size_t)l * 65536, SWF + (size_t)l * 65536, g);
        }
        const int gwaves = nblk * 8, gw = bid * 8 + w;
        for (int rep = 0; rep < REP_P0; ++rep)
        for (int r = gw; r < DEPTH * 16384 * 2; r += gwaves) {
            const int which = r & 1, le = r >> 1;
            conv_table_row((which ? P.peer_up : P.peer_down) + (size_t)le * D, (which ? TBu : TBd) + (size_t)le * 512, SC + (size_t)le * 2 + which, lane, which == 0);
        }
    }
    grid.sync();
    for (int tile = bid; tile < NTILE; tile += nblk) {
        const int b = tile >> 5;
        for (int l = 0; l < DEPTH; ++l)
            for (int j = tid; j < 6144; j += 512) {
                float v = P.b_ada[l * 6144 + j];
#pragma unroll
                for (int ks = 0; ks < 16; ++ks) v += modp[((size_t)(ks * 4 + l) * 8 + b) * 6144 + j];
                mod[((size_t)l * 8 + b) * 6144 + j] = v;
            }
    }
    __syncthreads();

    for (int l = 0; l < DEPTH; ++l) {
        const float* xin = l == 0 ? P.x : P.out;
        InProjOut IO;
        IO.QF = (bf16_t*)(ws + WS_QF); IO.KF2 = (bf16_t*)(ws + WS_KF2 + (size_t)l * 8 * MiB); IO.VF = (bf16_t*)(ws + WS_VF + (size_t)l * 8 * MiB);
        IO.CBR = (bf16_t*)(ws + WS_CBR); IO.ZR = (bf16_t*)(ws + WS_ZR + (size_t)l * 16 * MiB); IO.YS = (bf16_t*)(ws + WS_YS);
        for (int tile = bid; tile < NTILE; tile += nblk) {
            const float* mb_ = mod + ((size_t)l * 8 + (tile >> 5)) * 6144;
            if (l == 0) {
                norm_to_frag(xin, P.norm1_g + l * D, mb_ + 0, mb_ + 1024, hA, (float*)lds, tile, tid, false);
                __syncthreads();
            }
            for (int rep = 0; rep < REP_GEMM; ++rep) inproj_tile(hA + (size_t)tile * 131072, WinF + (size_t)l * 2097152, P.q_norm_g + l * 64, P.k_norm_g + l * 64, SWF + (size_t)l * 65536, P.sgu_b + l * 512, IO, lds, tile, tid);
            asm volatile("s_waitcnt vmcnt(0)" ::: "memory");
            __syncthreads();
            if (tid == 0) {
                __builtin_amdgcn_fence(__ATOMIC_RELEASE, "agent");
                asm volatile("s_waitcnt vmcnt(0)" ::: "memory");
                __hip_atomic_store(flags + tile, (unsigned)(l + 1), __ATOMIC_RELAXED, __HIP_MEMORY_SCOPE_AGENT);
            }
        }
        for (int tile = bid; tile < NTILE; tile += nblk) {
            const float* mb_ = mod + ((size_t)l * 8 + (tile >> 5)) * 6144;
            if ((tile & 31) != 0) {
                if (tid == 0) {
                    unsigned spins = 0;
                    while (__hip_atomic_load(flags + tile - 1, __ATOMIC_RELAXED, __HIP_MEMORY_SCOPE_AGENT) < (unsigned)(l + 1) && ++spins < (1u << 24)) __builtin_amdgcn_s_sleep(2);
                    __builtin_amdgcn_fence(__ATOMIC_ACQUIRE, "agent");
                    asm volatile("s_waitcnt vmcnt(0)" ::: "memory");
                }
                __syncthreads();
            }
            for (int rep = 0; rep < REP_MIX; ++rep) {
            attn_tile(IO.QF, IO.KF2, IO.VF, lds, bias_lds, P.attn_sink + l * 8, OR, tile, tid);
            __syncthreads();
            merge_tile(OR, IO.CBR, IO.ZR, IO.YS, P.conv_w + l * 768, P.out_norm_g + l * D, hA, tile, tid);
            __syncthreads();
            }
            {
                const bf16_t* At = hA + (size_t)tile * 131072;
                const bf16_t* WF = WoutF + (size_t)l * 1048576;
                for (int pass = 0; pass < 2; ++pass) {
                    f32x16 acc[4][2];
                    const int nbt0 = pass * 16 + w * 2;
                    kloop<0>(acc, At, WF + (size_t)nbt0 * 32768, WF + (size_t)(nbt0 + 1) * 32768, lds, tid, lane);
                    epi_resid(acc, xin, P.out, mb_ + 2048, (float*)(lds + LDS_EPI) + w * 2176, (float*)(lds + LDS_SSQ) + (pass * 8 + w) * 128, tile, pass * 512 + w * 64, lane);
                }
            }
            __syncthreads();
            if (tid < 128) { const float* sq = (const float*)(lds + LDS_SSQ); float ssum = 0.f;
#pragma unroll
                for (int c = 0; c < 16; ++c) ssum += sq[c * 128 + tid];
                ((float*)lds)[tid] = rsqrtf(ssum * (1.f / D) + EPS); }
            __syncthreads();
            norm_to_frag(P.out, P.norm2_g + l * D, mb_ + 3072, mb_ + 4096, hA, (float*)lds, tile, tid, true);
            __syncthreads();
            {
                const bf16_t* At = hA + (size_t)tile * 131072;
                const bf16_t* WF = WpqF + (size_t)l * 2097152;
                for (int rep = 0; rep < REP_GEMM; ++rep)
                for (int pass = 0; pass < 4; ++pass) {
                    f32x16 acc[4][2];
                    const int nbt0 = pass * 16 + w * 2;
                    kloop<1>(acc, At, WF + (size_t)nbt0 * 32768, WF + (size_t)(nbt0 + 1) * 32768, lds, tid, lane);
                    epi_qpf(acc, QPF, tile, nbt0, lane);
                }
            }
            __syncthreads();
            for (int rep = 0; rep < REP_ROUTE; ++rep) { route_tile(QPF, KeysF + (size_t)l * 262144, lds, (unsigned char*)lds + PL_RIDX, tile, tid); __syncthreads(); }
            peer_down_wave(hA, lds, TBd + (size_t)l * 16384 * 512, SC + (size_t)l * 32768, tile, w, lane);
            __syncthreads();
            {
                const float* mbn = mod + ((size_t)(l + 1 < DEPTH ? l + 1 : l) * 8 + (tile >> 5)) * 6144;
                peer_up_wave(lds, TBu + (size_t)l * 16384 * 512, mb_ + 5120, P.out, tile, w, lane, l + 1 < DEPTH ? hA : nullptr, P.norm1_g + (l + 1 < DEPTH ? l + 1 : l) * D, mbn + 0, mbn + 1024);
            }
            __syncthreads();
        }
    }
}
}

extern "C" void kernel_launch(void* const* d_in, const int* in_sizes, int n_in, void* d_out, int out_size, void* d_ws, size_t ws_size, hipStream_t stream) {
    using namespace op;
    static int grid_blocks = 0;
    if (!grid_blocks) {
        int dev = 0, cus = 0, per_cu = 0;
        (void)hipGetDevice(&dev);
        (void)hipDeviceGetAttribute(&cus, hipDeviceAttributeMultiprocessorCount, dev);
        (void)hipFuncSetAttribute((const void*)hybrid_fwd, hipFuncAttributeMaxDynamicSharedMemorySize, LDS_BYTES);
        (void)hipOccupancyMaxActiveBlocksPerMultiprocessor(&per_cu, (const void*)hybrid_fwd, 512, LDS_BYTES);
        if (per_cu < 1) per_cu = 1;
        grid_blocks = cus * per_cu;
        if (grid_blocks > NTILE) grid_blocks = NTILE;
        if (ws_size < WS_END) { fprintf(stderr, "kernel_launch: workspace too small (%zu < %zu)\n", ws_size, (size_t)WS_END); grid_blocks = -1; }
    }
    if (grid_blocks < 0) return;
    Params p{};
    p.x = (const float*)d_in[0]; p.c = (const float*)d_in[1]; p.rel_bias = (const float*)d_in[2]; p.w_ada = (const float*)d_in[3]; p.b_ada = (const float*)d_in[4];
    p.norm1_g = (const float*)d_in[5]; p.norm2_g = (const float*)d_in[6]; p.w_in = (const float*)d_in[7]; p.q_norm_g = (const float*)d_in[8]; p.k_norm_g = (const float*)d_in[9];
    p.attn_sink = (const float*)d_in[10]; p.conv_w = (const float*)d_in[11]; p.sgu_w = (const float*)d_in[12]; p.sgu_b = (const float*)d_in[13]; p.out_norm_g = (const float*)d_in[14];
    p.w_out = (const float*)d_in[15]; p.peer_wq = (const float*)d_in[16]; p.peer_sub_keys = (const float*)d_in[17]; p.peer_down = (const float*)d_in[18]; p.peer_up = (const float*)d_in[19];
    p.out = (float*)d_out; p.ws = (char*)d_ws;
    void* args[] = {&p};
    hipError_t e = hipLaunchCooperativeKernel((const void*)hybrid_fwd, dim3(grid_blocks), dim3(512), args, LDS_BYTES, stream);
    if (e != hipSuccess) fprintf(stderr, "kernel_launch: cooperative launch failed: %s (grid %d)\n", hipGetErrorString(e), grid_blocks);
}
```

```cpp
#include <hip/hip_runtime.h>
#include <cstdio>
#include <cstdint>
#include <hip/hip_cooperative_groups.h>
namespace cg = cooperative_groups;


namespace op {
#define DI __device__ __forceinline__
typedef unsigned short bf16_t;
typedef short bf16x8 __attribute__((ext_vector_type(8)));
typedef float f32x16 __attribute__((ext_vector_type(16)));
typedef float f32x2 __attribute__((ext_vector_type(2)));
typedef unsigned u32x4 __attribute__((ext_vector_type(4)));
typedef unsigned u32x2 __attribute__((ext_vector_type(2)));
typedef __bf16 bf16v2 __attribute__((ext_vector_type(2)));
constexpr int D = 1024, NB = 8, S = 4096, DEPTH = 4, T = NB * S, NTILE = T / 128;
constexpr float EPS = 1e-6f;
constexpr int PL_SEID = 0, PL_SWGT = 32768, PL_END = 98304, PL_RIDX = 98304;
constexpr int LDS_EPI = 32768, LDS_SSQ = 102400, LDS_RSTD1 = 110592, LDS_BIAS = 128 * 1024, LDS_BYTES = 132 * 1024;
constexpr int REP_GEMM = 1, REP_ROUTE = 1, REP_MIX = 1, REP_NORM = 1, REP_P0 = 1;
#define MFMA32(a, b, c) __builtin_amdgcn_mfma_f32_32x32x16_bf16((a), (b), (c), 0, 0, 0)

DI unsigned pk2(float lo, float hi) { f32x2 v = {lo, hi}; return __builtin_bit_cast(unsigned, __builtin_convertvector(v, bf16v2)); }
DI int opaque_v(int x) { asm volatile("" : "+v"(x)); return x; }
DI int opaque_s(int x) { asm volatile("" : "+s"(x)); return x; }
DI int crow(int reg, int hh) { return (reg & 3) + 8 * (reg >> 2) + 4 * hh; }
template <int CTRL> DI float dppf(float v) { return __int_as_float(__builtin_amdgcn_update_dpp(0, __float_as_int(v), CTRL, 0xf, 0xf, true)); }
template <int CTRL> DI int dppi(int v) { return __builtin_amdgcn_update_dpp(0, v, CTRL, 0xf, 0xf, true); }
DI float red16_sum(float v) { v += dppf<0xB1>(v); v += dppf<0x4E>(v); v += dppf<0x141>(v); v += dppf<0x140>(v); return v; }
DI float red16_max(float v) { v = fmaxf(v, dppf<0xB1>(v)); v = fmaxf(v, dppf<0x4E>(v)); v = fmaxf(v, dppf<0x141>(v)); v = fmaxf(v, dppf<0x140>(v)); return v; }
DI float x16_sum(float v) { auto s = __builtin_amdgcn_permlane16_swap(__float_as_uint(v), __float_as_uint(v), false, false); return __uint_as_float(s[0]) + __uint_as_float(s[1]); }
DI float x32_sum(float v) { auto s = __builtin_amdgcn_permlane32_swap(__float_as_uint(v), __float_as_uint(v), false, false); return __uint_as_float(s[0]) + __uint_as_float(s[1]); }
DI float x16_max(float v) { auto s = __builtin_amdgcn_permlane16_swap(__float_as_uint(v), __float_as_uint(v), false, false); return fmaxf(__uint_as_float(s[0]), __uint_as_float(s[1])); }
DI float x32_max(float v) { auto s = __builtin_amdgcn_permlane32_swap(__float_as_uint(v), __float_as_uint(v), false, false); return fmaxf(__uint_as_float(s[0]), __uint_as_float(s[1])); }
DI float red32_sum(float v) { return x16_sum(red16_sum(v)); }
DI float wave_sum(float v) { return x32_sum(x16_sum(red16_sum(v))); }
DI float wave_max(float v) { return x32_max(x16_max(red16_max(v))); }

DI int col_perm(int npos, int mode) {
    if (mode == 1 && npos >= 1024 && npos < 1536) { const int q = npos - 1024, w = q >> 6, nb = (q >> 5) & 1, r = q & 31; return (nb ? 1280 : 1024) + 32 * w + r; }
    return npos;
}
DI void conv_wfrag_item(const float* __restrict__ W, int N, int KB, bf16_t* __restrict__ WF, int gid, int mode) {
    const int l = gid & 63, kb = (gid >> 6) % KB, nbt = (gid >> 6) / KB, r = l & 31, hh = l >> 5;
    const int n = col_perm(nbt * 32 + r, mode);
    const float* p = W + (size_t)(kb * 16 + 8 * hh) * N + n;
    float v[8];
#pragma unroll
    for (int j = 0; j < 8; ++j) v[j] = p[(size_t)j * N];
    u32x4 o; o.x = pk2(v[0], v[1]); o.y = pk2(v[2], v[3]); o.z = pk2(v[4], v[5]); o.w = pk2(v[6], v[7]);
    *(u32x4*)(WF + (size_t)gid * 8) = o;
}

DI void norm_to_frag(const float* __restrict__ x, const float* __restrict__ g, const float* __restrict__ sh, const float* __restrict__ sc, bf16_t* __restrict__ hA, float* rstd_lds, int tile, int tid, bool have_rstd) {
    tid = opaque_v(tid); tile = opaque_s(tile);
    const int w = tid >> 6, lane = tid & 63;
    float cg[16], cs[16], ch[16];
#pragma unroll
    for (int j = 0; j < 2; ++j)
#pragma unroll
        for (int q = 0; q < 2; ++q) {
            const int c = 512 * j + 8 * lane + 4 * q;
            const float4 a = *(const float4*)(g + c), b = *(const float4*)(sc + c), d = *(const float4*)(sh + c);
            cg[8 * j + 4 * q] = a.x * (1.f + b.x); cg[8 * j + 4 * q + 1] = a.y * (1.f + b.y); cg[8 * j + 4 * q + 2] = a.z * (1.f + b.z); cg[8 * j + 4 * q + 3] = a.w * (1.f + b.w);
            ch[8 * j + 4 * q] = d.x; ch[8 * j + 4 * q + 1] = d.y; ch[8 * j + 4 * q + 2] = d.z; ch[8 * j + 4 * q + 3] = d.w;
            cs[8 * j + 4 * q] = 0.f; cs[8 * j + 4 * q + 1] = 0.f; cs[8 * j + 4 * q + 2] = 0.f; cs[8 * j + 4 * q + 3] = 0.f;
        }
    (void)cs;
#pragma unroll 8
    for (int rr = 0; rr < 16; ++rr) {
        const int row = w * 16 + rr;
        const float* xr = x + ((size_t)tile * 128 + row) * D + 8 * lane;
        float v[16];
#pragma unroll
        for (int j = 0; j < 2; ++j)
#pragma unroll
            for (int q = 0; q < 2; ++q) { const float4 a = *(const float4*)(xr + 512 * j + 4 * q); v[8 * j + 4 * q] = a.x; v[8 * j + 4 * q + 1] = a.y; v[8 * j + 4 * q + 2] = a.z; v[8 * j + 4 * q + 3] = a.w; }
        float r;
        if (have_rstd) r = rstd_lds[row];
        else {
            float ss = 0.f;
#pragma unroll
            for (int e = 0; e < 16; ++e) ss += v[e] * v[e];
            r = rsqrtf(wave_sum(ss) * (1.f / D) + EPS);
        }
        bf16_t* orow = hA + ((size_t)tile * 128 + row) * D + 8 * lane;
#pragma unroll
        for (int j = 0; j < 2; ++j) {
            u32x4 o;
            o.x = pk2(v[8 * j] * r * cg[8 * j] + ch[8 * j], v[8 * j + 1] * r * cg[8 * j + 1] + ch[8 * j + 1]);
            o.y = pk2(v[8 * j + 2] * r * cg[8 * j + 2] + ch[8 * j + 2], v[8 * j + 3] * r * cg[8 * j + 3] + ch[8 * j + 3]);
            o.z = pk2(v[8 * j + 4] * r * cg[8 * j + 4] + ch[8 * j + 4], v[8 * j + 5] * r * cg[8 * j + 5] + ch[8 * j + 5]);
            o.w = pk2(v[8 * j + 6] * r * cg[8 * j + 6] + ch[8 * j + 6], v[8 * j + 7] * r * cg[8 * j + 7] + ch[8 * j + 7]);
            *(u32x4*)(orow + 512 * j) = o;
        }
    }
}

template <int ORIENT>
DI void kloop(f32x16 (&acc)[4][2], const bf16_t* __restrict__ At, const bf16_t* __restrict__ W0, const bf16_t* __restrict__ W1, char* lds, int tid, int lane) {
    tid = opaque_v(tid); lane = opaque_v(lane);
#pragma unroll
    for (int mb = 0; mb < 4; ++mb)
#pragma unroll
        for (int nb = 0; nb < 2; ++nb)
#pragma unroll
            for (int i = 0; i < 16; ++i) acc[mb][nb][i] = 0.f;
    {
    const int c8_ = (tid >> 3) & 7, rowA_ = (tid >> 6) * 8 + (tid & 7);
    const u32x4* Ag = (const u32x4*)(At + (unsigned)(rowA_ * 1024 + c8_ * 8));
    const int ldsA_ = ((((c8_ >> 1) * 4 + (rowA_ >> 5)) * 64) + (rowA_ & 31) + 32 * (c8_ & 1)) * 16;
    const u32x4* W0g = (const u32x4*)W0 + lane;
    const u32x4* W1g = (const u32x4*)W1 + lane;
    u32x4 wq[4][2], arA[2], arB[2];
    arA[0] = Ag[0]; arA[1] = Ag[8192]; arB[0] = Ag[8]; arB[1] = Ag[8 + 8192];
#pragma unroll
    for (int kk = 0; kk < 4; ++kk) { wq[kk][0] = W0g[kk * 64]; wq[kk][1] = W1g[kk * 64]; }
    char* b0 = lds; char* b1 = lds + 16384; char* b2 = lds + 32768;
    *(u32x4*)(b0 + ldsA_) = arA[0]; *(u32x4*)(b0 + ldsA_ + 2048) = arA[1];
    *(u32x4*)(b1 + ldsA_) = arB[0]; *(u32x4*)(b1 + ldsA_ + 2048) = arB[1];
    arA[0] = Ag[2 * 8]; arA[1] = Ag[2 * 8 + 8192]; arB[0] = Ag[3 * 8]; arB[1] = Ag[3 * 8 + 8192];
    __syncthreads();
    bf16x8 afr[2][4];
#pragma unroll
    for (int mb = 0; mb < 4; ++mb) afr[0][mb] = *(const bf16x8*)(b0 + ((0 * 4 + mb) * 64 + lane) * 16);
#define KL_ITER(KC, ARS) do { \
        const int kn = (KC) < 15 ? (KC) + 1 : 15, k4 = (KC) < 12 ? (KC) + 4 : 15; \
        _Pragma("unroll") for (int kk = 0; kk < 4; ++kk) { \
            if (kk < 3) { _Pragma("unroll") for (int mb = 0; mb < 4; ++mb) afr[(kk + 1) & 1][mb] = *(const bf16x8*)(b0 + (((kk + 1) * 4 + mb) * 64 + lane) * 16); } \
            else { _Pragma("unroll") for (int mb = 0; mb < 4; ++mb) afr[0][mb] = *(const bf16x8*)(b1 + ((0 * 4 + mb) * 64 + lane) * 16); }        \
            _Pragma("unroll") for (int mb = 0; mb < 4; ++mb) \
                _Pragma("unroll") for (int nb = 0; nb < 2; ++nb) { \
                    const bf16x8 wf = __builtin_bit_cast(bf16x8, wq[kk][nb]); \
                    if (ORIENT == 0) acc[mb][nb] = MFMA32(afr[kk & 1][mb], wf, acc[mb][nb]); \
                    else acc[mb][nb] = MFMA32(wf, afr[kk & 1][mb], acc[mb][nb]); \
                } \
            if ((KC) < 15) { wq[kk][0] = W0g[(kn * 4 + kk) * 64]; wq[kk][1] = W1g[(kn * 4 + kk) * 64]; } \
            if (kk == 1) { \
                __syncthreads(); \
                if ((KC) < 14) { *(u32x4*)(b2 + ldsA_) = ARS[0]; *(u32x4*)(b2 + ldsA_ + 2048) = ARS[1]; } \
                if ((KC) < 12) { ARS[0] = Ag[k4 * 8]; ARS[1] = Ag[k4 * 8 + 8192]; } \
            } \
            __builtin_amdgcn_sched_barrier(0); \
        } \
        { char* t_ = b0; b0 = b1; b1 = b2; b2 = t_; } \
    } while (0)
    for (int kc = 0; kc < 16; kc += 2) { KL_ITER(kc, arA); KL_ITER(kc + 1, arB); }
#undef KL_ITER
    __syncthreads();
    }
}

DI void epi_f32row(const f32x16 (&acc)[4][2], float* __restrict__ C, int tile, int col0, int lane) {
    lane = opaque_v(lane);
    const int r5 = lane & 31, hh = lane >> 5;
    const unsigned boff = (unsigned)((tile * 128 + 4 * hh) * 2048 + col0 + r5);
#pragma unroll
    for (int mb = 0; mb < 4; ++mb)
#pragma unroll
        for (int nb = 0; nb < 2; ++nb)
#pragma unroll
            for (int i = 0; i < 16; ++i)
                C[boff + (unsigned)((mb * 32 + (i & 3) + 8 * (i >> 2)) * 2048 + nb * 32)] = acc[mb][nb][i];
}
DI void epi_resid(const f32x16 (&acc)[4][2], const float* __restrict__ xin, float* __restrict__ xout, const float* __restrict__ gate_b, float* T  , float* ssq  , int tile, int col0, int lane) {
    lane = opaque_v(lane);
    const int r5 = lane & 31, hh = lane >> 5, rq = lane >> 4, c4 = (lane & 15) * 4;
    const float4 gv = *(const float4*)(gate_b + col0 + c4);
#pragma unroll
    for (int mb = 0; mb < 4; ++mb) {
#pragma unroll
        for (int nb = 0; nb < 2; ++nb)
#pragma unroll
            for (int i = 0; i < 16; ++i) T[((i & 3) + 8 * (i >> 2) + 4 * hh) * 68 + nb * 32 + r5] = acc[mb][nb][i];
        asm volatile("s_waitcnt lgkmcnt(0)" ::: "memory");
#pragma unroll
        for (int j = 0; j < 8; ++j) {
            const int row = rq + 4 * j;
            const float4 v = *(const float4*)(T + row * 68 + c4);
            const unsigned o = (unsigned)((tile * 128 + mb * 32 + row) * D + col0 + c4);
            float4 xv = *(const float4*)(xin + o);
            xv.x += gv.x * v.x; xv.y += gv.y * v.y; xv.z += gv.z * v.z; xv.w += gv.w * v.w;
            *(float4*)(xout + o) = xv;
            float ss = xv.x * xv.x + xv.y * xv.y + xv.z * xv.z + xv.w * xv.w;
            ss = red16_sum(ss);
            if ((lane & 15) == 0) ssq[mb * 32 + row] = ss;
        }
        asm volatile("s_waitcnt lgkmcnt(0)" ::: "memory");
    }
}

DI void epi_qpf(const f32x16 (&acc)[4][2], bf16_t* __restrict__ QPF, int tile, int ft0, int lane) {
    lane = opaque_v(lane);
#pragma unroll
    for (int nb = 0; nb < 2; ++nb)
#pragma unroll
        for (int s = 0; s < 2; ++s)
#pragma unroll
            for (int mb = 0; mb < 4; ++mb) {
                const f32x16& a = acc[mb][nb];
                u32x4 o; o.x = pk2(a[8 * s], a[8 * s + 1]); o.y = pk2(a[8 * s + 2], a[8 * s + 3]); o.z = pk2(a[8 * s + 4], a[8 * s + 5]); o.w = pk2(a[8 * s + 6], a[8 * s + 7]);
                *(u32x4*)(QPF + ((unsigned)((((tile * 64 + ft0 + nb) * 2 + s) * 4 + mb) * 64 + lane)) * 8) = o;
            }
}

DI void conv_keys_item(const float* __restrict__ K, bf16_t* __restrict__ KF, int gid) {
    const int lane = gid & 63, s = (gid >> 6) & 1, nbl = (gid >> 7) & 3, nt = (gid >> 9) & 3, hp = gid >> 11;
    const int r = lane & 31, hh = lane >> 5;
    const float* p = K + ((size_t)hp * 128 + nt * 32 + r) * 128 + nbl * 32 + 16 * s + 4 * hh;
    const float4 a = *(const float4*)p, b = *(const float4*)(p + 8);
    u32x4 o; o.x = pk2(a.x, a.y); o.y = pk2(a.z, a.w); o.z = pk2(b.x, b.y); o.w = pk2(b.z, b.w);
    *(u32x4*)(KF + (size_t)gid * 8) = o;
}

DI void conv_table_row(const float* __restrict__ src, unsigned char* __restrict__ dst, float* __restrict__ sc, int lane, bool as_int4) {
    const float4* p = (const float4*)src + lane * 4;
    float4 v[4];
    float m = 0.f;
#pragma unroll
    for (int j = 0; j < 4; ++j) { v[j] = p[j]; m = fmaxf(m, fmaxf(fmaxf(fabsf(v[j].x), fabsf(v[j].y)), fmaxf(fabsf(v[j].z), fabsf(v[j].w)))); }
    m = wave_max(m);
    float scale = m > 0.f ? m * (1.f / 6.f) : 1.f;
    if (as_int4) {
        float ss = 0.f;
#pragma unroll
        for (int j = 0; j < 4; ++j) ss += v[j].x * v[j].x + v[j].y * v[j].y + v[j].z * v[j].z + v[j].w * v[j].w;
        ss = wave_sum(ss);
        const float sg = sqrtf(ss * (1.f / 1024.f));
        scale = fmaxf(sg * (1.f / 2.8f), m * (1.f / 16.f));
        if (!(scale > 0.f)) scale = 1.f;
    }
    const float inv = 1.f / scale;
    u32x2 o;
    unsigned* op = (unsigned*)&o;
#pragma unroll
    for (int j = 0; j < 2; ++j) {
        const float f[8] = {v[2 * j].x, v[2 * j].y, v[2 * j].z, v[2 * j].w, v[2 * j + 1].x, v[2 * j + 1].y, v[2 * j + 1].z, v[2 * j + 1].w};
        unsigned wv = 0;
        if (as_int4) {
#pragma unroll
            for (int e = 0; e < 8; ++e) { int q = __float2int_rn(f[e] * inv); q = q < -7 ? -7 : (q > 7 ? 7 : q); wv |= ((unsigned)q & 15u) << (4 * e); }
        } else {
            wv = __builtin_amdgcn_cvt_scalef32_pk_fp4_f32(wv, f[0] * inv, f[1] * inv, 1.0f, 0);
            wv = __builtin_amdgcn_cvt_scalef32_pk_fp4_f32(wv, f[2] * inv, f[3] * inv, 1.0f, 1);
            wv = __builtin_amdgcn_cvt_scalef32_pk_fp4_f32(wv, f[4] * inv, f[5] * inv, 1.0f, 2);
            wv = __builtin_amdgcn_cvt_scalef32_pk_fp4_f32(wv, f[6] * inv, f[7] * inv, 1.0f, 3);
        }
        op[j] = wv;
    }
    *(u32x2*)(dst + lane * 8) = o;
    if (lane == 0) *sc = scale;
}

DI void ce_desc(int& a, int& b) { const int mx = a > b ? a : b, mn = a > b ? b : a; a = mx; b = mn; }
DI void sort16_desc(int (&v)[16]) {
#pragma unroll
    for (int k = 2; k <= 16; k <<= 1)
#pragma unroll
        for (int j = k >> 1; j > 0; j >>= 1)
#pragma unroll
            for (int i = 0; i < 16; ++i) {
                const int l = i ^ j;
                if (l > i) { if ((i & k) == 0) ce_desc(v[i], v[l]); else ce_desc(v[l], v[i]); }
            }
}
DI void bitonic_merge16_desc(int (&v)[16]) {
#pragma unroll
    for (int j = 8; j > 0; j >>= 1)
#pragma unroll
        for (int i = 0; i < 16; ++i) { const int l = i ^ j; if (l > i) ce_desc(v[i], v[l]); }
}
DI void merge_top16(int (&a)[16], const int (&b)[16]) {
#pragma unroll
    for (int i = 0; i < 16; ++i) a[i] = a[i] > b[15 - i] ? a[i] : b[15 - i];
    bitonic_merge16_desc(a);
}
DI int f2ord(float f) { int b = __float_as_int(f); return b ^ ((b >> 31) & 0x7fffffff); }
DI float ord2f(int k) { return __int_as_float(k ^ ((k >> 31) & 0x7fffffff)); }

DI void route_tile(const bf16_t* __restrict__ QPF, const bf16_t* __restrict__ KF, char* lds_lists, unsigned char* lds_idx  , int tile, int tid) {
    tid = opaque_v(tid); tile = opaque_s(tile);
    const int lane = tid & 63, w = __builtin_amdgcn_readfirstlane(tid >> 6);
    const int r5 = lane & 31, hh = lane >> 5;
    unsigned char* myidx = lds_idx + w * 1024;
    for (int task = w; task < 32; task += 8) {
        const int h = task >> 2, tt = task & 3;
        f32x16 acc[2][4];
#pragma unroll
        for (int p = 0; p < 2; ++p)
#pragma unroll
            for (int nt = 0; nt < 4; ++nt)
#pragma unroll
                for (int i = 0; i < 16; ++i) acc[p][nt][i] = 0.f;
        {
            bf16x8 bq[3], ak[3][4];
#define ROUTE_LOAD(buf, step) do { const int p_ = (step) >> 3, ks_ = (step) & 7; \
                bq[buf] = *(const bf16x8*)(QPF + ((unsigned)((((tile * 64 + h * 8 + p_ * 4 + (ks_ >> 1)) * 2 + (ks_ & 1)) * 4 + tt) * 64 + lane)) * 8); \
                _Pragma("unroll") for (int nt = 0; nt < 4; ++nt) ak[buf][nt] = *(const bf16x8*)(KF + ((unsigned)(((((h * 2 + p_) * 4 + nt) * 8 + ks_) * 64) + lane)) * 8); } while (0)
            ROUTE_LOAD(0, 0);
            ROUTE_LOAD(1, 1);
#pragma unroll
            for (int step = 0; step < 16; ++step) {
                if (step < 14) ROUTE_LOAD((step + 2) % 3, step + 2);
#pragma unroll
                for (int nt = 0; nt < 4; ++nt) acc[step >> 3][nt] = MFMA32(ak[step % 3][nt], bq[step % 3], acc[step >> 3][nt]);
                __builtin_amdgcn_sched_barrier(0);
            }
#undef ROUTE_LOAD
        }
        int g[8][16];
#pragma unroll
        for (int nt = 0; nt < 4; ++nt)
#pragma unroll
            for (int i = 0; i < 16; ++i) {
                const unsigned a = __float_as_uint(acc[0][nt][i]), b = __float_as_uint(acc[1][nt][i]);
                auto sw = __builtin_amdgcn_permlane32_swap(a, b, false, false);
                const int n0 = nt * 32 + (i & 3) + 8 * (i >> 2);
                g[nt * 2 + (i >> 3)][i & 7] = (f2ord(__uint_as_float(sw[0])) & ~127) | n0;
                g[nt * 2 + (i >> 3)][8 + (i & 7)] = (f2ord(__uint_as_float(sw[1])) & ~127) | (n0 + 4);
            }
#pragma unroll
        for (int q = 0; q < 8; ++q) sort16_desc(g[q]);
        merge_top16(g[0], g[1]); merge_top16(g[2], g[3]); merge_top16(g[4], g[5]); merge_top16(g[6], g[7]);
        merge_top16(g[0], g[2]); merge_top16(g[4], g[6]);
        merge_top16(g[0], g[4]);
        {
            u32x4 pk;
            unsigned* pp = (unsigned*)&pk;
#pragma unroll
            for (int q = 0; q < 4; ++q) pp[q] = (unsigned)(g[0][4 * q] & 127) | ((unsigned)(g[0][4 * q + 1] & 127) << 8) | ((unsigned)(g[0][4 * q + 2] & 127) << 16) | ((unsigned)(g[0][4 * q + 3] & 127) << 24);
            *(u32x4*)(myidx + lane * 16) = pk;
        }
        float f0[16], f1[16];
#pragma unroll
        for (int i = 0; i < 16; ++i) {
            const unsigned a = (unsigned)g[0][i], b = a;
            auto sw = __builtin_amdgcn_permlane32_swap(a, b, false, false);
            f0[i] = ord2f((int)sw[0] & ~127); f1[i] = ord2f((int)sw[1] & ~127);
        }
        int c0[16], c1[16], c2[16], c3[16];
#pragma unroll
        for (int j = 0; j < 16; ++j) c0[j] = (f2ord(f0[0] + f1[j]) & ~255) | j;
#pragma unroll
        for (int i = 1; i < 16; ++i) c1[i - 1] = (f2ord(f0[i] + f1[0]) & ~255) | (i << 4);
        c1[15] = (int)0x80000000;
#define CK(i, j) ((f2ord(f0[i] + f1[j]) & ~255) | ((i) << 4) | (j))
        c2[0] = CK(1, 1); c2[1] = CK(1, 2); c2[2] = CK(1, 3); c2[3] = CK(1, 4); c2[4] = CK(1, 5); c2[5] = CK(1, 6); c2[6] = CK(1, 7);
        c2[7] = CK(2, 1); c2[8] = CK(2, 2); c2[9] = CK(2, 3); c2[10] = CK(2, 4);
        c2[11] = CK(3, 1); c2[12] = CK(3, 2); c2[13] = CK(3, 3);
        c2[14] = CK(4, 1); c2[15] = CK(4, 2);
        c3[0] = CK(5, 1); c3[1] = CK(6, 1); c3[2] = CK(7, 1);
#undef CK
#pragma unroll
        for (int q = 3; q < 16; ++q) c3[q] = (int)0x80000000;
        sort16_desc(c2);
        ce_desc(c3[0], c3[1]); ce_desc(c3[1], c3[2]); ce_desc(c3[0], c3[1]);
        merge_top16(c0, c1); merge_top16(c2, c3); merge_top16(c0, c2);
        float bs[16], den = 0.f;
#pragma unroll
        for (int i = 0; i < 16; ++i) { bs[i] = __expf(ord2f(c0[i] & ~255) - ord2f(c0[0] & ~255)); den += bs[i]; }
        const float rden = 1.f / den;
        asm volatile("s_waitcnt lgkmcnt(0)" ::: "memory");
#pragma unroll
        for (int q = 0; q < 8; ++q) {
            const int key = (int)__builtin_amdgcn_permlane32_swap((unsigned)c0[q], (unsigned)c0[8 + q], false, false)[0];
            const float gv = __uint_as_float(__builtin_amdgcn_permlane32_swap(__float_as_uint(bs[q]), __float_as_uint(bs[8 + q]), false, false)[0]) * rden;
            const int i = (key >> 4) & 15, j = key & 15;
            const int e = (int)myidx[r5 * 16 + i] * 128 + (int)myidx[(32 + r5) * 16 + j];
            const int tokl = tt * 32 + r5;
            ((unsigned short*)(lds_lists + PL_SEID))[tokl * 128 + h * 16 + 8 * hh + q] = (unsigned short)e;
            ((float*)(lds_lists + PL_SWGT))[tokl * 128 + h * 16 + 8 * hh + q] = gv;
        }
        asm volatile("s_waitcnt lgkmcnt(0)" ::: "memory");
    }
}

DI void unpack_h2(const bf16_t* __restrict__ hA, int t, int lane, f32x2 (&hv)[8]) {
    const int tile = t >> 7, row = t & 127, mb = row >> 5, r5 = row & 31;
    const bf16_t* hp = hA + ((unsigned)(((tile * 64 + lane) * 4 + mb) * 64 + r5)) * 8;
    const u32x4 ha = *(const u32x4*)hp, hb = *(const u32x4*)(hp + 32 * 8);
    const unsigned hw[8] = {ha.x, ha.y, ha.z, ha.w, hb.x, hb.y, hb.z, hb.w};
#pragma unroll
    for (int q = 0; q < 8; ++q) { hv[q].x = __uint_as_float(hw[q] << 16); hv[q].y = __uint_as_float(hw[q] & 0xffff0000u); }
}
typedef _Float16 h16x2 __attribute__((ext_vector_type(2)));
DI h16x2 fp4h(unsigned w, int sel) {
    return sel == 0 ? __builtin_amdgcn_cvt_scalef32_pk_f16_fp4(w, 1.0f, 0) : sel == 1 ? __builtin_amdgcn_cvt_scalef32_pk_f16_fp4(w, 1.0f, 1)
         : sel == 2 ? __builtin_amdgcn_cvt_scalef32_pk_f16_fp4(w, 1.0f, 2) : __builtin_amdgcn_cvt_scalef32_pk_f16_fp4(w, 1.0f, 3);
}
DI unsigned rowoff_lo(unsigned pr, unsigned k512, unsigned lane8) { unsigned r; asm("v_mad_u32_u16 %0, %1, %2, %3" : "=v"(r) : "v"(pr), "s"(k512), "v"(lane8)); return r; }
DI unsigned rowoff_hi(unsigned pr, unsigned k512, unsigned lane8) { unsigned r; asm("v_mad_u32_u16 %0, %1, %2, %3 op_sel:[1,0,0,0]" : "=v"(r) : "v"(pr), "s"(k512), "v"(lane8)); return r; }
DI int dot8z(int a, int b) { int r; asm("v_dot8_i32_i4 %0, %1, %2, 0" : "=v"(r) : "v"(a), "v"(b)); return r; }
DI void stage_token(const int* __restrict__ ridx, const float* __restrict__ rgate, char* lds, int t, int tloc, int lane) {
    lane = opaque_v(lane); t = opaque_s(t);
    unsigned short* seid = (unsigned short*)(lds + PL_SEID) + tloc * 128;
    float* swgt = (float*)(lds + PL_SWGT) + tloc * 128;
    seid[lane] = (unsigned short)ridx[(unsigned)(t * 128 + lane)]; seid[64 + lane] = (unsigned short)ridx[(unsigned)(t * 128 + 64 + lane)];
    swgt[lane] = rgate[(unsigned)(t * 128 + lane)]; swgt[64 + lane] = rgate[(unsigned)(t * 128 + 64 + lane)];
}
DI void peer_down_wave(const bf16_t* __restrict__ hA, char* lds, const unsigned char* __restrict__ TBd, const float* __restrict__ SC, int tile, int w, int lane) {
    lane = opaque_v(lane);
    const int half = lane >> 5;
    const unsigned lane16 = (unsigned)(lane & 31) * 16u;
    const int cb = (lane & 31) * 32 + half * 16;
    const int myu = 2 * (((lane >> 4) & 1) * 4 + ((lane >> 3) & 1) * 2 + ((lane >> 2) & 1)) + half;
    const unsigned short* seid = (const unsigned short*)(lds + PL_SEID) + w * 16 * 128;
    float* swgt = (float*)(lds + PL_SWGT) + w * 16 * 128;
    u32x4 haN, hbN;
    { const bf16_t* hp0 = hA + (unsigned)((tile * 128 + w * 16) * 1024 + cb); haN = *(const u32x4*)hp0; hbN = *(const u32x4*)(hp0 + 8); }
    u32x4 R[2][8];
    unsigned IDN[8];
#define DOWN_IDS(P_) do { _Pragma("unroll") for (int u_ = 0; u_ < 8; ++u_) IDN[u_] = seid[(P_) + 2 * u_ + half]; } while (0)
#define DOWN_LOADS(buf) do { _Pragma("unroll") for (int u_ = 0; u_ < 8; ++u_) R[buf][u_] = *(const u32x4*)(TBd + (IDN[u_] * 512u + lane16)); } while (0)
    DOWN_IDS(0); DOWN_LOADS(0); DOWN_IDS(16);
#pragma unroll 1
    for (int tl = 0; tl < 16; ++tl) {
        const int t = tile * 128 + w * 16 + tl;
        float* gp = swgt + tl * 128;
        const u32x4 ha = haN, hb = hbN;
        const int tn = tl < 15 ? tl + 1 : tl;
        const int pa_ = tl * 128 + (lane & 3) * 32 + myu;
        const f32x2 scA = *(const f32x2*)(SC + (unsigned)seid[pa_] * 2u), scB = *(const f32x2*)(SC + (unsigned)seid[pa_ + 16] * 2u);
        int rs[8];
        { const bf16_t* hp = hA + (unsigned)((t - tl + tn) * 1024 + cb); haN = *(const u32x4*)hp; hbN = *(const u32x4*)(hp + 8); }
        unsigned hhi[4], hlo[4];
        float hscale;
        {
            const unsigned hw[8] = {ha.x, ha.y, ha.z, ha.w, hb.x, hb.y, hb.z, hb.w};
            float hf[16];
            float m = 0.f;
#pragma unroll
            for (int q = 0; q < 8; ++q) { hf[2 * q] = __uint_as_float(hw[q] << 16); hf[2 * q + 1] = __uint_as_float(hw[q] & 0xffff0000u); m = fmaxf(m, fmaxf(fabsf(hf[2 * q]), fabsf(hf[2 * q + 1]))); }
            m = wave_max(m);
            hscale = m > 0.f ? m * (1.f / 119.f) : 1.f;
            const float inv = 1.f / hscale;
            unsigned qh[2] = {0u, 0u}, ql[2] = {0u, 0u};
#pragma unroll
            for (int e = 0; e < 16; ++e) {
                const int hq = __float2int_rn(hf[e] * inv);
                const int lo = ((hq + 8) & 15) - 8, hi = (hq - lo) >> 4;
                ql[e >> 3] |= ((unsigned)lo & 15u) << (4 * (e & 7));
                qh[e >> 3] |= ((unsigned)hi & 15u) << (4 * (e & 7));
            }
#pragma unroll
            for (int q = 0; q < 2; ++q) {
                auto sh_ = __builtin_amdgcn_permlane32_swap(qh[q], qh[q], false, false); hhi[q] = sh_[0]; hhi[2 + q] = sh_[1];
                auto sl_ = __builtin_amdgcn_permlane32_swap(ql[q], ql[q], false, false); hlo[q] = sl_[0]; hlo[2 + q] = sl_[1];
            }
        }
#pragma unroll
        for (int bt = 0; bt < 8; ++bt) {
            const int cur = bt & 1, nxt = cur ^ 1;
            const int p2 = bt < 6 ? tl * 128 + (bt + 2) * 16 : tn * 128 + (bt - 6) * 16;
            DOWN_LOADS(nxt);
            DOWN_IDS(p2);
            __builtin_amdgcn_sched_barrier(0);
            int part[8];
#pragma unroll
            for (int u = 0; u < 8; ++u) {
                const int r0_ = (int)R[cur][u].x, r1_ = (int)R[cur][u].y, r2_ = (int)R[cur][u].z, r3_ = (int)R[cur][u].w;
                int shi = dot8z(r0_, (int)hhi[0]);
                shi = __builtin_amdgcn_sdot8(r1_, (int)hhi[1], shi, false);
                shi = __builtin_amdgcn_sdot8(r2_, (int)hhi[2], shi, false);
                shi = __builtin_amdgcn_sdot8(r3_, (int)hhi[3], shi, false);
                int p_ = shi << 4;
                p_ = __builtin_amdgcn_sdot8(r0_, (int)hlo[0], p_, false);
                p_ = __builtin_amdgcn_sdot8(r1_, (int)hlo[1], p_, false);
                p_ = __builtin_amdgcn_sdot8(r2_, (int)hlo[2], p_, false);
                part[u] = __builtin_amdgcn_sdot8(r3_, (int)hlo[3], p_, false);
            }
            int r4[4], r2[2], r1;
            {
                const bool b3 = (lane & 8) != 0, b2 = (lane & 4) != 0;
#pragma unroll
                for (int q = 0; q < 4; ++q) { auto sw = __builtin_amdgcn_permlane16_swap((unsigned)part[q], (unsigned)part[q + 4], false, false); r4[q] = (int)sw[0] + (int)sw[1]; }
#pragma unroll
                for (int q = 0; q < 2; ++q) { const int keep = b3 ? r4[q + 2] : r4[q], give = b3 ? r4[q] : r4[q + 2]; r2[q] = keep + dppi<0x128>(give); }
                { const int keep = b2 ? r2[1] : r2[0], give = b2 ? r2[0] : r2[1]; r1 = keep + dppi<0x141>(give); }
                r1 += dppi<0x4E>(r1); r1 += dppi<0xB1>(r1);
            }
            rs[bt] = r1;
        }
        {
            const int j_ = lane & 3;
            const int ra = j_ == 0 ? rs[0] : j_ == 1 ? rs[2] : j_ == 2 ? rs[4] : rs[6];
            const int rb = j_ == 0 ? rs[1] : j_ == 1 ? rs[3] : j_ == 2 ? rs[5] : rs[7];
            float* gq = gp + j_ * 32 + myu;
            const float a0 = (float)ra * (scA.x * hscale), a1 = (float)rb * (scB.x * hscale);
            const float w0 = gq[0] * (0.5f * a0 * (1.f + erff(a0 * 0.70710678118654752f))) * scA.y;
            const float w1 = gq[16] * (0.5f * a1 * (1.f + erff(a1 * 0.70710678118654752f))) * scB.y;
            ((unsigned*)gq)[0] = (unsigned)__builtin_bit_cast(unsigned short, (_Float16)w0);
            ((unsigned*)gq)[16] = (unsigned)__builtin_bit_cast(unsigned short, (_Float16)w1);
        }
    }
#undef DOWN_IDS
#undef DOWN_LOADS
}
DI void peer_up_wave(char* lds, const unsigned char* __restrict__ TBu, const float* __restrict__ g2b, float* __restrict__ x, int tile, int w, int lane,
                     bf16_t* __restrict__ hAn, const float* __restrict__ g1n, const float* __restrict__ sh1n, const float* __restrict__ sc1n) {
    lane = opaque_v(lane);
    const int half = lane >> 5;
    const unsigned lane16 = (unsigned)(lane & 31) * 16u;
    const int cb = (lane & 31) * 32 + half * 16;
    const unsigned short* seid = (const unsigned short*)(lds + PL_SEID) + w * 16 * 128 + half;
    const unsigned* swgt = (const unsigned*)(lds + PL_SWGT) + w * 16 * 128 + half;
    u32x4 RA[8], RB[8];
    unsigned IDN[8], WA[8], WB[8];
#define UP_IDS(P_) do { _Pragma("unroll") for (int u_ = 0; u_ < 8; ++u_) IDN[u_] = seid[(P_) + 2 * u_]; } while (0)
#define UP_WTS(W, P_) do { _Pragma("unroll") for (int u_ = 0; u_ < 8; ++u_) W[u_] = swgt[(P_) + 2 * u_]; } while (0)
#define UP_LOADS(R) do { _Pragma("unroll") for (int u_ = 0; u_ < 8; ++u_) R[u_] = *(const u32x4*)(TBu + (IDN[u_] * 512u + lane16)); } while (0)
#define UP_COMPUTE(R, W) do { _Pragma("unroll") for (int u_ = 0; u_ < 8; ++u_) { \
        const unsigned wd_ = W[u_]; const h16x2 wp_ = __builtin_bit_cast(h16x2, wd_); const h16x2 w2_ = (h16x2){wp_.x, wp_.x}; \
        const unsigned r0_ = R[u_].x, r1_ = R[u_].y, r2_ = R[u_].z, r3_ = R[u_].w; \
        _Pragma("unroll") for (int q_ = 0; q_ < 4; ++q_) { acc[q_] = __builtin_elementwise_fma(w2_, fp4h(r0_, q_), acc[q_]); acc[4 + q_] = __builtin_elementwise_fma(w2_, fp4h(r1_, q_), acc[4 + q_]); \
            acc[8 + q_] = __builtin_elementwise_fma(w2_, fp4h(r2_, q_), acc[8 + q_]); acc[12 + q_] = __builtin_elementwise_fma(w2_, fp4h(r3_, q_), acc[12 + q_]); } } } while (0)
    UP_IDS(0); UP_LOADS(RA); UP_IDS(16); UP_WTS(WA, 0);
    float4 gv[4];
#pragma unroll
    for (int q = 0; q < 4; ++q) gv[q] = ((const float4*)(g2b + cb))[q];
    float4 cg[4], ch[4];
#pragma unroll
    for (int q = 0; q < 4; ++q) {
        cg[q] = (float4){0.f, 0.f, 0.f, 0.f}; ch[q] = cg[q];
        if (hAn) { const float4 a = ((const float4*)(g1n + cb))[q], b = ((const float4*)(sc1n + cb))[q]; ch[q] = ((const float4*)(sh1n + cb))[q];
                   cg[q].x = a.x * (1.f + b.x); cg[q].y = a.y * (1.f + b.y); cg[q].z = a.z * (1.f + b.z); cg[q].w = a.w * (1.f + b.w); }
    }
#pragma unroll 1
    for (int tk = 0; tk < 16; ++tk) {
        const int tn = tk < 15 ? tk + 1 : 15;
        float4* xp = (float4*)(x + (size_t)(unsigned)((tile * 128 + w * 16 + tk) * D + cb));
        float4 xv[4];
#pragma unroll
        for (int q = 0; q < 4; ++q) xv[q] = xp[q];
        h16x2 acc[16];
#pragma unroll
        for (int q = 0; q < 16; ++q) acc[q] = (h16x2){(_Float16)0.f, (_Float16)0.f};
#pragma unroll 1
        for (int i = 0; i < 4; ++i) {
            const int pa = tk * 128 + i * 32;
            const int pn = i < 3 ? pa + 32 : tn * 128;
            UP_LOADS(RB); UP_WTS(WB, pa + 16); UP_IDS(pn);
            __builtin_amdgcn_sched_barrier(0);
            UP_COMPUTE(RA, WA);
            UP_LOADS(RA); UP_WTS(WA, pn); UP_IDS(pn + 16);
            __builtin_amdgcn_sched_barrier(0);
            UP_COMPUTE(RB, WB);
        }
        h16x2 tot[8];
#pragma unroll
        for (int q = 0; q < 8; ++q) {
            const unsigned a_ = __builtin_bit_cast(unsigned, acc[q]), b_ = __builtin_bit_cast(unsigned, acc[q + 8]);
            auto sw = __builtin_amdgcn_permlane32_swap(a_, b_, false, false);
            const unsigned s0_ = sw[0], s1_ = sw[1];
            tot[q] = __builtin_bit_cast(h16x2, s0_) + __builtin_bit_cast(h16x2, s1_);
        }
        float ssx = 0.f;
#pragma unroll
        for (int q = 0; q < 4; ++q) {
            xv[q].x += gv[q].x * (float)tot[2 * q].x; xv[q].y += gv[q].y * (float)tot[2 * q].y; xv[q].z += gv[q].z * (float)tot[2 * q + 1].x; xv[q].w += gv[q].w * (float)tot[2 * q + 1].y;
            xp[q] = xv[q];
            ssx += xv[q].x * xv[q].x + xv[q].y * xv[q].y + xv[q].z * xv[q].z + xv[q].w * xv[q].w;
        }
        ssx = wave_sum(ssx);
        if (hAn) {
            const float rs = rsqrtf(ssx * (1.f / D) + EPS);
            bf16_t* orow = hAn + (size_t)(unsigned)((tile * 128 + w * 16 + tk) * D + cb);
#pragma unroll
            for (int j = 0; j < 2; ++j) {
                u32x4 o;
                o.x = pk2(xv[2 * j].x * rs * cg[2 * j].x + ch[2 * j].x, xv[2 * j].y * rs * cg[2 * j].y + ch[2 * j].y);
                o.y = pk2(xv[2 * j].z * rs * cg[2 * j].z + ch[2 * j].z, xv[2 * j].w * rs * cg[2 * j].w + ch[2 * j].w);
                o.z = pk2(xv[2 * j + 1].x * rs * cg[2 * j + 1].x + ch[2 * j + 1].x, xv[2 * j + 1].y * rs * cg[2 * j + 1].y + ch[2 * j + 1].y);
                o.w = pk2(xv[2 * j + 1].z * rs * cg[2 * j + 1].z + ch[2 * j + 1].z, xv[2 * j + 1].w * rs * cg[2 * j + 1].w + ch[2 * j + 1].w);
                *(u32x4*)(orow + 8 * j) = o;
            }
        }
    }
#undef UP_IDS
#undef UP_WTS
#undef UP_LOADS
#undef UP_COMPUTE
}

DI void epi_qk(f32x16 (&acc)[4][2], const float* __restrict__ gain, float scale, bf16_t* __restrict__ dst, int lane) {
    lane = opaque_v(lane);
    const int hh = lane >> 5;
    float gv[2][16];
#pragma unroll
    for (int nb = 0; nb < 2; ++nb)
#pragma unroll
        for (int i = 0; i < 16; ++i) gv[nb][i] = gain[nb * 32 + (i & 3) + 8 * (i >> 2) + 4 * hh] * scale;
#pragma unroll
    for (int mb = 0; mb < 4; ++mb) {
        float ss = 0.f;
#pragma unroll
        for (int nb = 0; nb < 2; ++nb)
#pragma unroll
            for (int i = 0; i < 16; ++i) ss += acc[mb][nb][i] * acc[mb][nb][i];
        ss = x32_sum(ss);
        const float r = rsqrtf(ss * (1.f / 64.f) + EPS);
#pragma unroll
        for (int nb = 0; nb < 2; ++nb)
#pragma unroll
            for (int s = 0; s < 2; ++s) {
                const f32x16& a = acc[mb][nb];
                u32x4 o;
                o.x = pk2(a[8 * s] * r * gv[nb][8 * s], a[8 * s + 1] * r * gv[nb][8 * s + 1]);
                o.y = pk2(a[8 * s + 2] * r * gv[nb][8 * s + 2], a[8 * s + 3] * r * gv[nb][8 * s + 3]);
                o.z = pk2(a[8 * s + 4] * r * gv[nb][8 * s + 4], a[8 * s + 5] * r * gv[nb][8 * s + 5]);
                o.w = pk2(a[8 * s + 6] * r * gv[nb][8 * s + 6], a[8 * s + 7] * r * gv[nb][8 * s + 7]);
                *(u32x4*)(dst + ((unsigned)(((nb * 2 + s) * 4 + mb) * 64 + lane)) * 8) = o;
            }
    }
}
DI void epi_v(const f32x16 (&acc)[4][2], bf16_t* __restrict__ dst, int lane) {
    lane = opaque_v(lane);
#pragma unroll
    for (int nb = 0; nb < 2; ++nb)
#pragma unroll
        for (int mb = 0; mb < 4; ++mb)
#pragma unroll
            for (int s = 0; s < 2; ++s) {
                const f32x16& a = acc[mb][nb];
                u32x4 o; o.x = pk2(a[8 * s], a[8 * s + 1]); o.y = pk2(a[8 * s + 2], a[8 * s + 3]); o.z = pk2(a[8 * s + 4], a[8 * s + 5]); o.w = pk2(a[8 * s + 6], a[8 * s + 7]);
                *(u32x4*)(dst + ((unsigned)(((nb * 4 + mb) * 2 + s) * 64 + lane)) * 8) = o;
            }
}
DI void epi_row(const f32x16 (&acc)[4][2], bf16_t* __restrict__ dst, int ld, int lane) {
    lane = opaque_v(lane);
    const int r5 = lane & 31, hh = lane >> 5;
#pragma unroll
    for (int mb = 0; mb < 4; ++mb)
#pragma unroll
        for (int nb = 0; nb < 2; ++nb)
#pragma unroll
            for (int gq = 0; gq < 4; gq += 2) {
                const f32x16& a = acc[mb][nb];
                const unsigned ax = pk2(a[4 * gq], a[4 * gq + 1]), ay = pk2(a[4 * gq + 2], a[4 * gq + 3]);
                const unsigned bx = pk2(a[4 * gq + 4], a[4 * gq + 5]), by = pk2(a[4 * gq + 6], a[4 * gq + 7]);
                auto sx = __builtin_amdgcn_permlane32_swap(ax, bx, false, false);
                auto sy = __builtin_amdgcn_permlane32_swap(ay, by, false, false);
                u32x4 o; o.x = sx[0]; o.y = sy[0]; o.z = sx[1]; o.w = sy[1];
                *(u32x4*)(dst + (unsigned)((mb * 32 + r5) * ld + nb * 32 + 8 * (gq + hh))) = o;
            }
}
DI void epi_z(const f32x16 (&acc)[4][2], bf16_t* __restrict__ dst, int lane) {
    lane = opaque_v(lane);
    const int r5 = lane & 31, hh = lane >> 5;
#pragma unroll
    for (int mb = 0; mb < 4; ++mb)
#pragma unroll
        for (int gq = 0; gq < 4; gq += 2) {
            const f32x16 &a = acc[mb][0], &b = acc[mb][1];
            const unsigned ax = pk2(a[4 * gq] * b[4 * gq], a[4 * gq + 1] * b[4 * gq + 1]), ay = pk2(a[4 * gq + 2] * b[4 * gq + 2], a[4 * gq + 3] * b[4 * gq + 3]);
            const unsigned bx = pk2(a[4 * gq + 4] * b[4 * gq + 4], a[4 * gq + 5] * b[4 * gq + 5]), by = pk2(a[4 * gq + 6] * b[4 * gq + 6], a[4 * gq + 7] * b[4 * gq + 7]);
            auto sx = __builtin_amdgcn_permlane32_swap(ax, bx, false, false);
            auto sy = __builtin_amdgcn_permlane32_swap(ay, by, false, false);
            u32x4 o; o.x = sx[0]; o.y = sy[0]; o.z = sx[1]; o.w = sy[1];
            *(u32x4*)(dst + (unsigned)((mb * 32 + r5) * 256 + 8 * (gq + hh))) = o;
        }
}
DI void epi_su_park(const f32x16 (&acc)[4][2], unsigned* lds_su, int lane) {
    lane = opaque_v(lane);
#pragma unroll
    for (int mb = 0; mb < 4; ++mb)
#pragma unroll
        for (int nb = 0; nb < 2; ++nb)
#pragma unroll
            for (int q = 0; q < 8; ++q) lds_su[((mb * 2 + nb) * 8 + q) * 64 + lane] = pk2(acc[mb][nb][2 * q], acc[mb][nb][2 * q + 1]);
}
DI void epi_sv(f32x16 (&acc)[4][2], const bf16_t* __restrict__ SWF  , const float* __restrict__ bs_g, const unsigned* lds_su, bf16_t* __restrict__ dst, int lane) {
    lane = opaque_v(lane);
    const int r5 = lane & 31, hh = lane >> 5;
    bf16x8 vb[4][2][2];
#pragma unroll
    for (int mb = 0; mb < 4; ++mb) {
#pragma unroll
        for (int i = 0; i < 16; ++i) {
            float s1 = acc[mb][0][i] + acc[mb][1][i];
            s1 = red32_sum(s1);
            const float mu = s1 * (1.f / 64.f);
            const float d0 = acc[mb][0][i] - mu, d1 = acc[mb][1][i] - mu;
            float s2 = d0 * d0 + d1 * d1;
            s2 = red32_sum(s2);
            const float r = rsqrtf(s2 * (1.f / 64.f) + EPS);
            acc[mb][0][i] = d0 * r; acc[mb][1][i] = d1 * r;
        }
#pragma unroll
        for (int s = 0; s < 2; ++s)
#pragma unroll
            for (int nb = 0; nb < 2; ++nb) {
                const f32x16& a = acc[mb][nb];
                u32x4 o; o.x = pk2(a[8 * s], a[8 * s + 1]); o.y = pk2(a[8 * s + 2], a[8 * s + 3]); o.z = pk2(a[8 * s + 4], a[8 * s + 5]); o.w = pk2(a[8 * s + 6], a[8 * s + 7]);
                vb[mb][s][nb] = __builtin_bit_cast(bf16x8, o);
            }
    }
#pragma unroll
    for (int tb = 0; tb < 4; ++tb) {
        f32x16 y[2];
#pragma unroll
        for (int nb = 0; nb < 2; ++nb)
#pragma unroll
            for (int i = 0; i < 16; ++i) y[nb][i] = 0.f;
#pragma unroll
        for (int kt = 0; kt <= tb; ++kt)
#pragma unroll
            for (int s = 0; s < 2; ++s) {
                const bf16x8 wa = *(const bf16x8*)(SWF + ((unsigned)(((tb * 4 + kt) * 2 + s) * 64 + lane)) * 8);
                y[0] = MFMA32(wa, vb[kt][s][0], y[0]);
                y[1] = MFMA32(wa, vb[kt][s][1], y[1]);
            }
#pragma unroll
        for (int nb = 0; nb < 2; ++nb)
#pragma unroll
            for (int q = 0; q < 8; ++q) {
                const unsigned su2 = lds_su[((tb * 2 + nb) * 8 + q) * 64 + lane];
                const int i0 = 2 * q, i1 = 2 * q + 1;
                const int t0 = tb * 32 + (i0 & 3) + 8 * (i0 >> 2) + 4 * hh, t1 = tb * 32 + (i1 & 3) + 8 * (i1 >> 2) + 4 * hh;
                const float v0 = (y[nb][i0] + bs_g[t0]) * __uint_as_float(su2 << 16), v1 = (y[nb][i1] + bs_g[t1]) * __uint_as_float(su2 & 0xffff0000u);
                const unsigned pk = pk2(v0, v1);
                dst[(unsigned)(t0 * 256 + nb * 32 + r5)] = (bf16_t)(pk & 0xffffu);
                dst[(unsigned)(t1 * 256 + nb * 32 + r5)] = (bf16_t)(pk >> 16);
            }
    }
}

DI void conv_sguw_item(const float* __restrict__ W, bf16_t* __restrict__ SWF, int gid) {
    const int lane = gid & 63, s = (gid >> 6) & 1, kt = (gid >> 7) & 3, tb = (gid >> 9) & 3, g = gid >> 11;
    const int r = lane & 31, hh = lane >> 5, t = tb * 32 + r;
    const float* p = W + ((size_t)g * 128 + t) * 128;
    float v[8];
#pragma unroll
    for (int j = 0; j < 8; ++j) { const int sp = kt * 32 + 16 * s + 8 * (j >> 2) + 4 * hh + (j & 3); v[j] = sp <= t ? p[sp] : 0.f; }
    u32x4 o; o.x = pk2(v[0], v[1]); o.y = pk2(v[2], v[3]); o.z = pk2(v[4], v[5]); o.w = pk2(v[6], v[7]);
    *(u32x4*)(SWF + (size_t)gid * 8) = o;
}

DI int t5_bucket(int d) {
    if (d < 16) return d;
    const float lr = logf((float)d / 16.f) / logf(8.f);
    const int large = 16 + (int)(lr * 16.f);
    return large < 31 ? large : 31;
}

DI void attn_tile(const bf16_t* __restrict__ QF, const bf16_t* __restrict__ KF2, const bf16_t* __restrict__ VF, char* lds, const float* bias_lds, const float* __restrict__ sink, bf16_t* __restrict__ OR, int tile, int tid) {
    tid = opaque_v(tid); tile = opaque_s(tile);
    const int lane = tid & 63, w = __builtin_amdgcn_readfirstlane(tid >> 6), r5 = lane & 31, hh = lane >> 5;
    const bool has_prev = (tile & 31) != 0;
    {
        u32x4 tmp[16];
#pragma unroll
        for (int i = 0; i < 16; ++i) {
            const int blk = w * 16 + i;
            const int isv = blk >> 6, bb = blk & 63;
            const bf16_t* src;
            if (!isv) { const int kvh = bb >> 5, ks = (bb >> 3) & 3, wt = bb & 7, st = (wt >= 4 || !has_prev) ? tile : tile - 1;
                src = KF2 + ((unsigned)((((st * 2 + kvh) * 4 + ks) * 4 + (wt & 3)) * 64 + lane)) * 8; }
            else { const int kvh = bb >> 5, dt = (bb >> 4) & 1, wt = (bb >> 1) & 7, s2 = bb & 1, st = (wt >= 4 || !has_prev) ? tile : tile - 1;
                src = VF + ((unsigned)(((((st * 2 + kvh) * 2 + dt) * 4 + (wt & 3)) * 2 + s2) * 64 + lane)) * 8; }
            tmp[i] = *(const u32x4*)src;
        }
#pragma unroll
        for (int i = 0; i < 16; ++i) *(u32x4*)(lds + (w * 16 + i) * 1024 + lane * 16) = tmp[i];
    }
    __syncthreads();
    const char* ldsK = lds, *ldsV = lds + 65536;
    for (int task = w; task < 32; task += 8) {
        const int qh = task >> 2, qt = task & 3, kvh = qh >> 2;
        bf16x8 bq[4];
#pragma unroll
        for (int ks = 0; ks < 4; ++ks) bq[ks] = *(const bf16x8*)(QF + ((unsigned)((((tile * 8 + qh) * 4 + ks) * 4 + qt) * 64 + lane)) * 8);
        f32x16 sc[5];
#pragma unroll
        for (int jj = 0; jj < 5; ++jj) {
#pragma unroll
            for (int i = 0; i < 16; ++i) sc[jj][i] = 0.f;
#pragma unroll
            for (int ks = 0; ks < 4; ++ks) {
                const bf16x8 kf = *(const bf16x8*)(ldsK + ((kvh * 4 + ks) * 8 + qt + jj) * 1024 + lane * 16);
                sc[jj] = MFMA32(kf, bq[ks], sc[jj]);
            }
        }
        const float* bl = bias_lds + qh * 128;
        float m = -1e30f;
#pragma unroll
        for (int jj = 0; jj < 5; ++jj) {
            const bool ex = (qt + jj >= 4) || has_prev;
#pragma unroll
            for (int i = 0; i < 16; ++i) {
                const int cr = (i & 3) + 8 * (i >> 2) + 4 * hh;
                const int dist = 128 + r5 - 32 * jj - cr;
                const bool valid = ex && dist >= 0 && dist < 128;
                float bv = bl[dist & 127];
                asm volatile("" : "+v"(bv));
                const float v = valid ? sc[jj][i] + bv : -1e30f;
                sc[jj][i] = v; m = fmaxf(m, v);
            }
        }
        m = x32_max(m);
        const float sk = sink[qh];
        m = fmaxf(m, sk);
        float l = 0.f;
#pragma unroll
        for (int jj = 0; jj < 5; ++jj)
#pragma unroll
            for (int i = 0; i < 16; ++i) { const float p = __expf(sc[jj][i] - m); sc[jj][i] = p; l += p; }
        l = x32_sum(l);
        l += __expf(sk - m);
        const float rl = 1.f / l;
        f32x16 o[2];
#pragma unroll
        for (int dt = 0; dt < 2; ++dt)
#pragma unroll
            for (int i = 0; i < 16; ++i) o[dt][i] = 0.f;
#pragma unroll
        for (int jj = 0; jj < 5; ++jj) {
#pragma unroll
            for (int s = 0; s < 2; ++s) {
                const f32x16& a = sc[jj];
                u32x4 pp; pp.x = pk2(a[8 * s], a[8 * s + 1]); pp.y = pk2(a[8 * s + 2], a[8 * s + 3]); pp.z = pk2(a[8 * s + 4], a[8 * s + 5]); pp.w = pk2(a[8 * s + 6], a[8 * s + 7]);
                const bf16x8 pb = __builtin_bit_cast(bf16x8, pp);
#pragma unroll
                for (int dt = 0; dt < 2; ++dt) {
                    const bf16x8 vf = *(const bf16x8*)(ldsV + (((kvh * 2 + dt) * 8 + qt + jj) * 2 + s) * 1024 + lane * 16);
                    o[dt] = MFMA32(vf, pb, o[dt]);
                }
            }
        }
        bf16_t* orow = OR + (unsigned)((tile * 128 + qt * 32 + r5) * 512 + qh * 64 + 4 * hh);
#pragma unroll
        for (int dt = 0; dt < 2; ++dt)
#pragma unroll
            for (int gq = 0; gq < 4; ++gq) {
                u32x2 ov; ov.x = pk2(o[dt][4 * gq] * rl, o[dt][4 * gq + 1] * rl); ov.y = pk2(o[dt][4 * gq + 2] * rl, o[dt][4 * gq + 3] * rl);
                *(u32x2*)(orow + dt * 32 + 8 * gq) = ov;
            }
    }
}

DI void unpack8(const u32x4 v, float (&f)[8]) {
    f[0] = __uint_as_float(v.x << 16); f[1] = __uint_as_float(v.x & 0xffff0000u); f[2] = __uint_as_float(v.y << 16); f[3] = __uint_as_float(v.y & 0xffff0000u);
    f[4] = __uint_as_float(v.z << 16); f[5] = __uint_as_float(v.z & 0xffff0000u); f[6] = __uint_as_float(v.w << 16); f[7] = __uint_as_float(v.w & 0xffff0000u);
}
DI void merge_tile(const bf16_t* __restrict__ OR, const bf16_t* __restrict__ CBR, const bf16_t* __restrict__ ZR, const bf16_t* __restrict__ YS, const float* __restrict__ cw  , const float* __restrict__ og  ,
                   bf16_t* __restrict__ mA, int tile, int tid) {
    tid = opaque_v(tid); tile = opaque_s(tile);
    const int lane = tid & 63, w = tid >> 6;
    float cwv[3][8], ga[8], gb[8];
    {
        const int c0 = (lane & 31) * 8;
#pragma unroll
        for (int j = 0; j < 3; ++j) { const float4 p0 = *(const float4*)(cw + j * 256 + c0), p1 = *(const float4*)(cw + j * 256 + c0 + 4);
            cwv[j][0] = p0.x; cwv[j][1] = p0.y; cwv[j][2] = p0.z; cwv[j][3] = p0.w; cwv[j][4] = p1.x; cwv[j][5] = p1.y; cwv[j][6] = p1.z; cwv[j][7] = p1.w; }
        const float4 a0 = *(const float4*)(og + lane * 8), a1 = *(const float4*)(og + lane * 8 + 4), b0 = *(const float4*)(og + 512 + lane * 8), b1 = *(const float4*)(og + 512 + lane * 8 + 4);
        ga[0] = a0.x; ga[1] = a0.y; ga[2] = a0.z; ga[3] = a0.w; ga[4] = a1.x; ga[5] = a1.y; ga[6] = a1.z; ga[7] = a1.w;
        gb[0] = b0.x; gb[1] = b0.y; gb[2] = b0.z; gb[3] = b0.w; gb[4] = b1.x; gb[5] = b1.y; gb[6] = b1.z; gb[7] = b1.w;
    }
#pragma unroll 8
    for (int rr = 0; rr < 16; ++rr) {
        const int row = w * 16 + rr, t = tile * 128 + row, pos = t & (S - 1);
        float a[8], y[8];
        unpack8(*(const u32x4*)(OR + (unsigned)(t * 512 + lane * 8)), a);
        float ssa = 0.f;
#pragma unroll
        for (int q = 0; q < 8; ++q) ssa += a[q] * a[q];
        ssa = wave_sum(ssa);
        {
            const int c0 = (lane & 31) * 8;
            float cb[8], z0[8], z1[8], z2[8], ys[8];
            const float m1 = pos >= 1 ? 1.f : 0.f, m2 = pos >= 2 ? 1.f : 0.f;
            const int t1 = pos >= 1 ? t - 1 : t, t2 = pos >= 2 ? t - 2 : t;
            unpack8(*(const u32x4*)(CBR + (unsigned)(t * 256 + c0)), cb);
            unpack8(*(const u32x4*)(ZR + (unsigned)(t * 256 + c0)), z2);
            unpack8(*(const u32x4*)(ZR + (unsigned)(t1 * 256 + c0)), z1);
            unpack8(*(const u32x4*)(ZR + (unsigned)(t2 * 256 + c0)), z0);
            unpack8(*(const u32x4*)(YS + (unsigned)(t * 256 + c0)), ys);
#pragma unroll
            for (int q = 0; q < 8; ++q) {
                const float yc = cb[q] * (cwv[0][q] * (z0[q] * m2) + cwv[1][q] * (z1[q] * m1) + cwv[2][q] * z2[q]);
                y[q] = lane < 32 ? yc : ys[q];
            }
        }
        float ssy = 0.f;
#pragma unroll
        for (int q = 0; q < 8; ++q) ssy += y[q] * y[q];
        ssy = red32_sum(ssy);
        const float ra = rsqrtf(ssa * (1.f / 512.f) + EPS), ry = rsqrtf(ssy * (1.f / 256.f) + EPS);
        const int mb = row >> 5, r5 = row & 31;
        {
            u32x4 o; o.x = pk2(a[0] * ra * ga[0], a[1] * ra * ga[1]); o.y = pk2(a[2] * ra * ga[2], a[3] * ra * ga[3]); o.z = pk2(a[4] * ra * ga[4], a[5] * ra * ga[5]); o.w = pk2(a[6] * ra * ga[6], a[7] * ra * ga[7]);
            const int c8 = lane;
            (void)c8;
            *(u32x4*)(mA + (unsigned)(t * 1024 + lane * 8)) = o;
        }
        {
            u32x4 o; o.x = pk2(y[0] * ry * gb[0], y[1] * ry * gb[1]); o.y = pk2(y[2] * ry * gb[2], y[3] * ry * gb[3]); o.z = pk2(y[4] * ry * gb[4], y[5] * ry * gb[5]); o.w = pk2(y[6] * ry * gb[6], y[7] * ry * gb[7]);
            const int c8 = 64 + lane;
            (void)c8;
            *(u32x4*)(mA + (unsigned)(t * 1024 + 512 + lane * 8)) = o;
        }
    }
}

struct InProjOut { bf16_t *QF, *KF2, *VF, *CBR, *ZR, *YS; };
DI void inproj_tile(const bf16_t* __restrict__ At, const bf16_t* __restrict__ WF, const float* __restrict__ qg, const float* __restrict__ kg, const bf16_t* __restrict__ SWF, const float* __restrict__ sgu_b,
                    const InProjOut& O, char* lds, int tile, int tid) {
    tid = opaque_v(tid); tile = opaque_s(tile);
    const int lane = tid & 63, w = __builtin_amdgcn_readfirstlane(tid >> 6);
    f32x16 acc[4][2];
    {
        const int nbt0 = w * 2;
        kloop<1>(acc, At, WF + (size_t)nbt0 * 32768, WF + (size_t)(nbt0 + 1) * 32768, lds, tid, lane);
        epi_qk(acc, qg, 0.125f, O.QF + (size_t)(tile * 8 + w) * 8192, lane);
    }
    {
        const int nbt0 = 16 + w * 2;
        if (w == 2 || w == 3) {
            kloop<0>(acc, At, WF + (size_t)nbt0 * 32768, WF + (size_t)(nbt0 + 1) * 32768, lds, tid, lane);
            epi_v(acc, O.VF + (size_t)(tile * 2 + (w - 2)) * 8192, lane);
        } else {
            kloop<1>(acc, At, WF + (size_t)nbt0 * 32768, WF + (size_t)(nbt0 + 1) * 32768, lds, tid, lane);
            if (w < 2) epi_qk(acc, kg, 1.f, O.KF2 + (size_t)(tile * 2 + w) * 8192, lane);
            else epi_row(acc, O.CBR + (size_t)tile * 128 * 256 + (w - 4) * 64, 256, lane);
        }
    }
    {
        const int nbt0 = 32 + w * 2;
        kloop<1>(acc, At, WF + (size_t)nbt0 * 32768, WF + (size_t)(nbt0 + 1) * 32768, lds, tid, lane);
        epi_z(acc, O.ZR + (size_t)tile * 128 * 256 + w * 32, lane);
    }
    {
        const int nbt0 = 48 + w * 2;
        kloop<0>(acc, At, WF + (size_t)nbt0 * 32768, WF + (size_t)(nbt0 + 1) * 32768, lds, tid, lane);
        unsigned* lds_su = (unsigned*)lds;
        if (w < 4) epi_su_park(acc, lds_su + w * 4096, lane);
        __syncthreads();
        if (w >= 4) epi_sv(acc, SWF + (size_t)(w - 4) * 16384, sgu_b + (w - 4) * 128, lds_su + (w - 4) * 4096, O.YS + (size_t)tile * 128 * 256 + (w - 4) * 64, lane);
        __syncthreads();
    }
}


struct Params {
    const float *x, *c, *rel_bias, *w_ada, *b_ada, *norm1_g, *norm2_g, *w_in, *q_norm_g, *k_norm_g, *attn_sink, *conv_w, *sgu_w, *sgu_b, *out_norm_g, *w_out, *peer_wq, *peer_sub_keys, *peer_down, *peer_up;
    float* out;
    char* ws;
};
constexpr size_t MiB = 1u << 20;
constexpr size_t WS_MOD = 0;
constexpr size_t WS_MODP = 1 * MiB;
constexpr size_t WS_WIN = 13 * MiB;
constexpr size_t WS_WOUT = 29 * MiB;
constexpr size_t WS_WPQ = 37 * MiB;
constexpr size_t WS_KEYS = 53 * MiB;
constexpr size_t WS_SWF = 55 * MiB;
constexpr size_t WS_SC = 56 * MiB;
constexpr size_t WS_TB = 57 * MiB;
constexpr size_t WS_HA = 185 * MiB;
constexpr size_t WS_QF = 249 * MiB;
constexpr size_t WS_KF2 = 602 * MiB;
constexpr size_t WS_VF = 634 * MiB;
constexpr size_t WS_ZR = 666 * MiB;
constexpr size_t WS_CBR = 345 * MiB;
constexpr size_t WS_YS = 361 * MiB;
constexpr size_t WS_OR = 377 * MiB;
constexpr size_t WS_QPF = 409 * MiB;
constexpr size_t WS_RIDX = 537 * MiB;
constexpr size_t WS_RGATE = 553 * MiB;
constexpr size_t WS_SEID = 569 * MiB;
constexpr size_t WS_SWGT = 585 * MiB;
constexpr size_t WS_OFFS = 601 * MiB;
constexpr size_t WS_FLAGS = 601 * MiB + 512 * 1024;
constexpr size_t WS_END = 730 * MiB;
static_assert(PL_END <= LDS_RSTD1, "expert-phase lists overlap persistent LDS state");

__global__ __launch_bounds__(512) void hybrid_fwd(Params P) {
    extern __shared__ __attribute__((aligned(16))) char lds[];
    cg::grid_group grid = cg::this_grid();
    const int tid = threadIdx.x, lane = tid & 63, w = __builtin_amdgcn_readfirstlane(tid >> 6);
    const int nblk = gridDim.x, hwb = blockIdx.x;
    const int bid = (nblk == NTILE) ? (hwb & 7) * 32 + (hwb >> 3) : hwb;
    char* ws = P.ws;
    float* mod = (float*)(ws + WS_MOD);
    float* modp = (float*)(ws + WS_MODP);
    bf16_t* WinF = (bf16_t*)(ws + WS_WIN); bf16_t* WoutF = (bf16_t*)(ws + WS_WOUT); bf16_t* WpqF = (bf16_t*)(ws + WS_WPQ);
    bf16_t* KeysF = (bf16_t*)(ws + WS_KEYS); bf16_t* SWF = (bf16_t*)(ws + WS_SWF);
    float* SC = (float*)(ws + WS_SC); unsigned char* TBd = (unsigned char*)(ws + WS_TB); unsigned char* TBu = TBd + 32 * MiB;
    bf16_t* hA = (bf16_t*)(ws + WS_HA);
    bf16_t* OR = (bf16_t*)(ws + WS_OR); bf16_t* QPF = (bf16_t*)(ws + WS_QPF);
    int* ridx = (int*)(ws + WS_RIDX); float* rgate = (float*)(ws + WS_RGATE);
    float* bias_lds = (float*)(lds + LDS_BIAS);
    unsigned* flags = (unsigned*)(ws + WS_FLAGS);

    {
        float* ca = (float*)lds;
        if (tid == 0) for (int tile = bid; tile < NTILE; tile += nblk) __hip_atomic_store(flags + tile, 0u, __ATOMIC_RELAXED, __HIP_MEMORY_SCOPE_AGENT);
        for (int i = tid; i < 8192; i += 512) { const float v = P.c[i]; ca[i] = v / (1.f + __expf(-v)); }
        for (int i = tid; i < 1024; i += 512) bias_lds[i] = P.rel_bias[t5_bucket(i & 127) * 8 + (i >> 7)];
        __syncthreads();
        for (int it = bid; it < 768; it += nblk) {
            const int jc = it % 12, l = (it / 12) & 3, ks = it / 48;
            const int j = jc * 512 + tid;
            const float* wp = P.w_ada + ((size_t)l * 1024 + ks * 64) * 6144 + j;
            float acc[8];
#pragma unroll
            for (int b = 0; b < 8; ++b) acc[b] = 0.f;
#pragma unroll 4
            for (int i = 0; i < 64; ++i) {
                const float wv = wp[(size_t)i * 6144];
#pragma unroll
                for (int b = 0; b < 8; ++b) acc[b] += ca[b * 1024 + ks * 64 + i] * wv;
            }
#pragma unroll
            for (int b = 0; b < 8; ++b) modp[((size_t)(ks * 4 + l) * 8 + b) * 6144 + j] = acc[b];
        }
        const int gthreads = nblk * 512, gtid = bid * 512 + tid;
        for (int rep = 0; rep < REP_P0; ++rep)
        for (int l = 0; l < DEPTH; ++l) {
            for (int g = gtid; g < 64 * 64 * 64; g += gthreads) conv_wfrag_item(P.w_in + (size_t)l * 1024 * 2048, 2048, 64, WinF + (size_t)l * 2097152, g, 1);
            for (int g = gtid; g < 32 * 64 * 64; g += gthreads) conv_wfrag_item(P.w_out + (size_t)l * 1024 * 1024, 1024, 64, WoutF + (size_t)l * 1048576, g, 0);
            for (int g = gtid; g < 64 * 64 * 64; g += gthreads) conv_wfrag_item(P.peer_wq + (size_t)l * 1024 * 2048, 2048, 64, WpqF + (size_t)l * 2097152, g, 0);
            for (int g = gtid; g < 32768; g += gthreads) conv_keys_item(P.peer_sub_keys + (size_t)l * 262144, KeysF + (size_t)l * 262144, g);
            for (int g = gtid; g < 8192; g += gthreads) conv_sguw_item(P.sgu_w + (size_t)l * 65536, SWF + (size_t)l * 65536, g);
        }
        const int gwaves = nblk * 8, gw = bid * 8 + w;
        for (int rep = 0; rep < REP_P0; ++rep)
        for (int r = gw; r < DEPTH * 16384 * 2; r += gwaves) {
            const int which = r & 1, le = r >> 1;
            conv_table_row((which ? P.peer_up : P.peer_down) + (size_t)le * D, (which ? TBu : TBd) + (size_t)le * 512, SC + (size_t)le * 2 + which, lane, which == 0);
        }
    }
    grid.sync();
    for (int tile = bid; tile < NTILE; tile += nblk) {
        const int b = tile >> 5;
        for (int l = 0; l < DEPTH; ++l)
            for (int j = tid; j < 6144; j += 512) {
                float v = P.b_ada[l * 6144 + j];
#pragma unroll
                for (int ks = 0; ks < 16; ++ks) v += modp[((size_t)(ks * 4 + l) * 8 + b) * 6144 + j];
                mod[((size_t)l * 8 + b) * 6144 + j] = v;
            }
    }
    __syncthreads();

    for (int l = 0; l < DEPTH; ++l) {
        const float* xin = l == 0 ? P.x : P.out;
        InProjOut IO;
        IO.QF = (bf16_t*)(ws + WS_QF); IO.KF2 = (bf16_t*)(ws + WS_KF2 + (size_t)l * 8 * MiB); IO.VF = (bf16_t*)(ws + WS_VF + (size_t)l * 8 * MiB);
        IO.CBR = (bf16_t*)(ws + WS_CBR); IO.ZR = (bf16_t*)(ws + WS_ZR + (size_t)l * 16 * MiB); IO.YS = (bf16_t*)(ws + WS_YS);
        for (int tile = bid; tile < NTILE; tile += nblk) {
            const float* mb_ = mod + ((size_t)l * 8 + (tile >> 5)) * 6144;
            if (l == 0) {
                norm_to_frag(xin, P.norm1_g + l * D, mb_ + 0, mb_ + 1024, hA, (float*)lds, tile, tid, false);
                __syncthreads();
            }
            for (int rep = 0; rep < REP_GEMM; ++rep) inproj_tile(hA + (size_t)tile * 131072, WinF + (size_t)l * 2097152, P.q_norm_g + l * 64, P.k_norm_g + l * 64, SWF + (size_t)l * 65536, P.sgu_b + l * 512, IO, lds, tile, tid);
            asm volatile("s_waitcnt vmcnt(0)" ::: "memory");
            __syncthreads();
            if (tid == 0) {
                __builtin_amdgcn_fence(__ATOMIC_RELEASE, "agent");
                asm volatile("s_waitcnt vmcnt(0)" ::: "memory");
                __hip_atomic_store(flags + tile, (unsigned)(l + 1), __ATOMIC_RELAXED, __HIP_MEMORY_SCOPE_AGENT);
            }
        }
        for (int tile = bid; tile < NTILE; tile += nblk) {
            const float* mb_ = mod + ((size_t)l * 8 + (tile >> 5)) * 6144;
            if ((tile & 31) != 0) {
                if (tid == 0) {
                    unsigned spins = 0;
                    while (__hip_atomic_load(flags + tile - 1, __ATOMIC_RELAXED, __HIP_MEMORY_SCOPE_AGENT) < (unsigned)(l + 1) && ++spins < (1u << 24)) __builtin_amdgcn_s_sleep(2);
                    __builtin_amdgcn_fence(__ATOMIC_ACQUIRE, "agent");
                    asm volatile("s_waitcnt vmcnt(0)" ::: "memory");
                }
                __syncthreads();
            }
            for (int rep = 0; rep < REP_MIX; ++rep) {
            attn_tile(IO.QF, IO.KF2, IO.VF, lds, bias_lds, P.attn_sink + l * 8, OR, tile, tid);
            __syncthreads();
            merge_tile(OR, IO.CBR, IO.ZR, IO.YS, P.conv_w + l * 768, P.out_norm_g + l * D, hA, tile, tid);
            __syncthreads();
            }
            {
                const bf16_t* At = hA + (size_t)tile * 131072;
                const bf16_t* WF = WoutF + (size_t)l * 1048576;
                for (int pass = 0; pass < 2; ++pass) {
                    f32x16 acc[4][2];
                    const int nbt0 = pass * 16 + w * 2;
                    kloop<0>(acc, At, WF + (size_t)nbt0 * 32768, WF + (size_t)(nbt0 + 1) * 32768, lds, tid, lane);
                    epi_resid(acc, xin, P.out, mb_ + 2048, (float*)(lds + LDS_EPI) + w * 2176, (float*)(lds + LDS_SSQ) + (pass * 8 + w) * 128, tile, pass * 512 + w * 64, lane);
                }
            }
            __syncthreads();
            if (tid < 128) { const float* sq = (const float*)(lds + LDS_SSQ); float ssum = 0.f;
#pragma unroll
                for (int c = 0; c < 16; ++c) ssum += sq[c * 128 + tid];
                ((float*)lds)[tid] = rsqrtf(ssum * (1.f / D) + EPS); }
            __syncthreads();
            norm_to_frag(P.out, P.norm2_g + l * D, mb_ + 3072, mb_ + 4096, hA, (float*)lds, tile, tid, true);
            __syncthreads();
            {
                const bf16_t* At = hA + (size_t)tile * 131072;
                const bf16_t* WF = WpqF + (size_t)l * 2097152;
                for (int rep = 0; rep < REP_GEMM; ++rep)
                for (int pass = 0; pass < 4; ++pass) {
                    f32x16 acc[4][2];
                    const int nbt0 = pass * 16 + w * 2;
                    kloop<1>(acc, At, WF + (size_t)nbt0 * 32768, WF + (size_t)(nbt0 + 1) * 32768, lds, tid, lane);
                    epi_qpf(acc, QPF, tile, nbt0, lane);
                }
            }
            __syncthreads();
            for (int rep = 0; rep < REP_ROUTE; ++rep) { route_tile(QPF, KeysF + (size_t)l * 262144, lds, (unsigned char*)lds + PL_RIDX, tile, tid); __syncthreads(); }
            peer_down_wave(hA, lds, TBd + (size_t)l * 16384 * 512, SC + (size_t)l * 32768, tile, w, lane);
            __syncthreads();
            {
                const float* mbn = mod + ((size_t)(l + 1 < DEPTH ? l + 1 : l) * 8 + (tile >> 5)) * 6144;
                peer_up_wave(lds, TBu + (size_t)l * 16384 * 512, mb_ + 5120, P.out, tile, w, lane, l + 1 < DEPTH ? hA : nullptr, P.norm1_g + (l + 1 < DEPTH ? l + 1 : l) * D, mbn + 0, mbn + 1024);
            }
            __syncthreads();
        }
    }
}
}

extern "C" void kernel_launch(void* const* d_in, const int* in_sizes, int n_in, void* d_out, int out_size, void* d_ws, size_t ws_size, hipStream_t stream) {
    using namespace op;
    static int grid_blocks = 0;
    if (!grid_blocks) {
        int dev = 0, cus = 0, per_cu = 0;
        (void)hipGetDevice(&dev);
        (void)hipDeviceGetAttribute(&cus, hipDeviceAttributeMultiprocessorCount, dev);
        (void)hipFuncSetAttribute((const void*)hybrid_fwd, hipFuncAttributeMaxDynamicSharedMemorySize, LDS_BYTES);
        (void)hipOccupancyMaxActiveBlocksPerMultiprocessor(&per_cu, (const void*)hybrid_fwd, 512, LDS_BYTES);
        if (per_cu < 1) per_cu = 1;
        grid_blocks = cus * per_cu;
        if (grid_blocks > NTILE) grid_blocks = NTILE;
        if (ws_size < WS_END) { fprintf(stderr, "kernel_launch: workspace too small (%zu < %zu)\n", ws_size, (size_t)WS_END); grid_blocks = -1; }
    }
    if (grid_blocks < 0) return;
    Params p{};
    p.x = (const float*)d_in[0]; p.c = (const float*)d_in[1]; p.rel_bias = (const float*)d_in[2]; p.w_ada = (const float*)d_in[3]; p.b_ada = (const float*)d_in[4];
    p.norm1_g = (const float*)d_in[5]; p.norm2_g = (const float*)d_in[6]; p.w_in = (const float*)d_in[7]; p.q_norm_g = (const float*)d_in[8]; p.k_norm_g = (const float*)d_in[9];
    p.attn_sink = (const float*)d_in[10]; p.conv_w = (const float*)d_in[11]; p.sgu_w = (const float*)d_in[12]; p.sgu_b = (const float*)d_in[13]; p.out_norm_g = (const float*)d_in[14];
    p.w_out = (const float*)d_in[15]; p.peer_wq = (const float*)d_in[16]; p.peer_sub_keys = (const float*)d_in[17]; p.peer_down = (const float*)d_in[18]; p.peer_up = (const float*)d_in[19];
    p.out = (float*)d_out; p.ws = (char*)d_ws;
    void* args[] = {&p};
    hipError_t e = hipLaunchCooperativeKernel((const void*)hybrid_fwd, dim3(grid_blocks), dim3(512), args, LDS_BYTES, stream);
    if (e != hipSuccess) fprintf(stderr, "kernel_launch: cooperative launch failed: %s (grid %d)\n", hipGetErrorString(e), grid_blocks);
}
```

```cpp
#include <hip/hip_runtime.h>
#include <cstdio>
#include <cstdint>
#include <hip/hip_cooperative_groups.h>
namespace cg = cooperative_groups;


namespace op {
#define DI __device__ __forceinline__
typedef unsigned short bf16_t;
typedef short bf16x8 __attribute__((ext_vector_type(8)));
typedef float f32x16 __attribute__((ext_vector_type(16)));
typedef float f32x2 __attribute__((ext_vector_type(2)));
typedef unsigned u32x4 __attribute__((ext_vector_type(4)));
typedef unsigned u32x2 __attribute__((ext_vector_type(2)));
typedef __bf16 bf16v2 __attribute__((ext_vector_type(2)));
constexpr int D = 1024, NB = 8, S = 4096, DEPTH = 4, T = NB * S, NTILE = T / 128;
constexpr float EPS = 1e-6f;
constexpr int PL_SEID = 0, PL_SWGT = 32768, PL_END = 98304, PL_RIDX = 98304;
constexpr int LDS_EPI = 32768, LDS_SSQ = 102400, LDS_RSTD1 = 110592, LDS_BIAS = 128 * 1024, LDS_BYTES = 132 * 1024;
constexpr int REP_GEMM = 1, REP_ROUTE = 1, REP_MIX = 1, REP_NORM = 1, REP_P0 = 1;
#define MFMA32(a, b, c) __builtin_amdgcn_mfma_f32_32x32x16_bf16((a), (b), (c), 0, 0, 0)

DI unsigned pk2(float lo, float hi) { f32x2 v = {lo, hi}; return __builtin_bit_cast(unsigned, __builtin_convertvector(v, bf16v2)); }
DI int opaque_v(int x) { asm volatile("" : "+v"(x)); return x; }
DI int opaque_s(int x) { asm volatile("" : "+s"(x)); return x; }
DI int crow(int reg, int hh) { return (reg & 3) + 8 * (reg >> 2) + 4 * hh; }
template <int CTRL> DI float dppf(float v) { return __int_as_float(__builtin_amdgcn_update_dpp(0, __float_as_int(v), CTRL, 0xf, 0xf, true)); }
template <int CTRL> DI int dppi(int v) { return __builtin_amdgcn_update_dpp(0, v, CTRL, 0xf, 0xf, true); }
DI float red16_sum(float v) { v += dppf<0xB1>(v); v += dppf<0x4E>(v); v += dppf<0x141>(v); v += dppf<0x140>(v); return v; }
DI float red16_max(float v) { v = fmaxf(v, dppf<0xB1>(v)); v = fmaxf(v, dppf<0x4E>(v)); v = fmaxf(v, dppf<0x141>(v)); v = fmaxf(v, dppf<0x140>(v)); return v; }
DI float x16_sum(float v) { auto s = __builtin_amdgcn_permlane16_swap(__float_as_uint(v), __float_as_uint(v), false, false); return __uint_as_float(s[0]) + __uint_as_float(s[1]); }
DI float x32_sum(float v) { auto s = __builtin_amdgcn_permlane32_swap(__float_as_uint(v), __float_as_uint(v), false, false); return __uint_as_float(s[0]) + __uint_as_float(s[1]); }
DI float x16_max(float v) { auto s = __builtin_amdgcn_permlane16_swap(__float_as_uint(v), __float_as_uint(v), false, false); return fmaxf(__uint_as_float(s[0]), __uint_as_float(s[1])); }
DI float x32_max(float v) { auto s = __builtin_amdgcn_permlane32_swap(__float_as_uint(v), __float_as_uint(v), false, false); return fmaxf(__uint_as_float(s[0]), __uint_as_float(s[1])); }
DI float red32_sum(float v) { return x16_sum(red16_sum(v)); }
DI float wave_sum(float v) { return x32_sum(x16_sum(red16_sum(v))); }
DI float wave_max(float v) { return x32_max(x16_max(red16_max(v))); }

DI int col_perm(int npos, int mode) {
    if (mode == 1 && npos >= 1024 && npos < 1536) { const int q = npos - 1024, w = q >> 6, nb = (q >> 5) & 1, r = q & 31; return (nb ? 1280 : 1024) + 32 * w + r; }
    return npos;
}
DI void conv_wfrag_item(const float* __restrict__ W, int N, int KB, bf16_t* __restrict__ WF, int gid, int mode) {
    const int l = gid & 63, kb = (gid >> 6) % KB, nbt = (gid >> 6) / KB, r = l & 31, hh = l >> 5;
    const int n = col_perm(nbt * 32 + r, mode);
    const float* p = W + (size_t)(kb * 16 + 8 * hh) * N + n;
    float v[8];
#pragma unroll
    for (int j = 0; j < 8; ++j) v[j] = p[(size_t)j * N];
    u32x4 o; o.x = pk2(v[0], v[1]); o.y = pk2(v[2], v[3]); o.z = pk2(v[4], v[5]); o.w = pk2(v[6], v[7]);
    *(u32x4*)(WF + (size_t)gid * 8) = o;
}

DI void norm_to_frag(const float* __restrict__ x, const float* __restrict__ g, const float* __restrict__ sh, const float* __restrict__ sc, bf16_t* __restrict__ hA, float* rstd_lds, int tile, int tid, bool have_rstd) {
    tid = opaque_v(tid); tile = opaque_s(tile);
    const int w = tid >> 6, lane = tid & 63;
    float cg[16], cs[16], ch[16];
#pragma unroll
    for (int j = 0; j < 2; ++j)
#pragma unroll
        for (int q = 0; q < 2; ++q) {
            const int c = 512 * j + 8 * lane + 4 * q;
            const float4 a = *(const float4*)(g + c), b = *(const float4*)(sc + c), d = *(const float4*)(sh + c);
            cg[8 * j + 4 * q] = a.x * (1.f + b.x); cg[8 * j + 4 * q + 1] = a.y * (1.f + b.y); cg[8 * j + 4 * q + 2] = a.z * (1.f + b.z); cg[8 * j + 4 * q + 3] = a.w * (1.f + b.w);
            ch[8 * j + 4 * q] = d.x; ch[8 * j + 4 * q + 1] = d.y; ch[8 * j + 4 * q + 2] = d.z; ch[8 * j + 4 * q + 3] = d.w;
            cs[8 * j + 4 * q] = 0.f; cs[8 * j + 4 * q + 1] = 0.f; cs[8 * j + 4 * q + 2] = 0.f; cs[8 * j + 4 * q + 3] = 0.f;
        }
    (void)cs;
#pragma unroll 8
    for (int rr = 0; rr < 16; ++rr) {
        const int row = w * 16 + rr;
        const float* xr = x + ((size_t)tile * 128 + row) * D + 8 * lane;
        float v[16];
#pragma unroll
        for (int j = 0; j < 2; ++j)
#pragma unroll
            for (int q = 0; q < 2; ++q) { const float4 a = *(const float4*)(xr + 512 * j + 4 * q); v[8 * j + 4 * q] = a.x; v[8 * j + 4 * q + 1] = a.y; v[8 * j + 4 * q + 2] = a.z; v[8 * j + 4 * q + 3] = a.w; }
        float r;
        if (have_rstd) r = rstd_lds[row];
        else {
            float ss = 0.f;
#pragma unroll
            for (int e = 0; e < 16; ++e) ss += v[e] * v[e];
            r = rsqrtf(wave_sum(ss) * (1.f / D) + EPS);
        }
        bf16_t* orow = hA + ((size_t)tile * 128 + row) * D + 8 * lane;
#pragma unroll
        for (int j = 0; j < 2; ++j) {
            u32x4 o;
            o.x = pk2(v[8 * j] * r * cg[8 * j] + ch[8 * j], v[8 * j + 1] * r * cg[8 * j + 1] + ch[8 * j + 1]);
            o.y = pk2(v[8 * j + 2] * r * cg[8 * j + 2] + ch[8 * j + 2], v[8 * j + 3] * r * cg[8 * j + 3] + ch[8 * j + 3]);
            o.z = pk2(v[8 * j + 4] * r * cg[8 * j + 4] + ch[8 * j + 4], v[8 * j + 5] * r * cg[8 * j + 5] + ch[8 * j + 5]);
            o.w = pk2(v[8 * j + 6] * r * cg[8 * j + 6] + ch[8 * j + 6], v[8 * j + 7] * r * cg[8 * j + 7] + ch[8 * j + 7]);
            *(u32x4*)(orow + 512 * j) = o;
        }
    }
}

template <int ORIENT>
DI void kloop(f32x16 (&acc)[4][2], const bf16_t* __restrict__ At, const bf16_t* __restrict__ W0, const bf16_t* __restrict__ W1, char* lds, int tid, int lane) {
    tid = opaque_v(tid); lane = opaque_v(lane);
#pragma unroll
    for (int mb = 0; mb < 4; ++mb)
#pragma unroll
        for (int nb = 0; nb < 2; ++nb)
#pragma unroll
            for (int i = 0; i < 16; ++i) acc[mb][nb][i] = 0.f;
    {
    const int c8_ = (tid >> 3) & 7, rowA_ = (tid >> 6) * 8 + (tid & 7);
    const unsigned aoff_ = (unsigned)(rowA_ * 1024 + c8_ * 8) * 2u;
    const char* AtB = (const char*)At;
    const char* AtB2 = (const char*)At + 131072;
#define AG0(KCH) (*(const u32x4*)(AtB + (size_t)((KCH) * 128) + aoff_))
#define AG1(KCH) (*(const u32x4*)(AtB2 + (size_t)((KCH) * 128) + aoff_))
    const int ldsA_ = ((((c8_ >> 1) * 4 + (rowA_ >> 5)) * 64) + (rowA_ & 31) + 32 * (c8_ & 1)) * 16;
    const unsigned woff_ = (unsigned)lane * 16u;
    typedef const __attribute__((address_space(1))) char* gcp_t;
    typedef const __attribute__((address_space(1))) u32x4* gvp_t;
    gcp_t W0s; gcp_t W1s;
    { const unsigned long long a0_ = (unsigned long long)W0, a1_ = (unsigned long long)W1;
      W0s = (gcp_t)(((unsigned long long)(unsigned)__builtin_amdgcn_readfirstlane((int)(unsigned)(a0_ >> 32)) << 32) | (unsigned)__builtin_amdgcn_readfirstlane((int)(unsigned)a0_));
      W1s = (gcp_t)(((unsigned long long)(unsigned)__builtin_amdgcn_readfirstlane((int)(unsigned)(a1_ >> 32)) << 32) | (unsigned)__builtin_amdgcn_readfirstlane((int)(unsigned)a1_)); }
#define WG0(SUB) (*(gvp_t)(W0s + (size_t)((SUB) * 1024) + woff_))
#define WG1(SUB) (*(gvp_t)(W1s + (size_t)((SUB) * 1024) + woff_))
    u32x4 wq[4][2], arA[2], arB[2];
    arA[0] = AG0(0); arA[1] = AG1(0); arB[0] = AG0(1); arB[1] = AG1(1);
#pragma unroll
    for (int kk = 0; kk < 4; ++kk) { wq[kk][0] = WG0(kk); wq[kk][1] = WG1(kk); }
    char* b0 = lds; char* b1 = lds + 16384; char* b2 = lds + 32768;
    *(u32x4*)(b0 + ldsA_) = arA[0]; *(u32x4*)(b0 + ldsA_ + 2048) = arA[1];
    *(u32x4*)(b1 + ldsA_) = arB[0]; *(u32x4*)(b1 + ldsA_ + 2048) = arB[1];
    arA[0] = AG0(2); arA[1] = AG1(2); arB[0] = AG0(3); arB[1] = AG1(3);
    __syncthreads();
    bf16x8 afr[2][4];
#pragma unroll
    for (int mb = 0; mb < 4; ++mb) afr[0][mb] = *(const bf16x8*)(b0 + ((0 * 4 + mb) * 64 + lane) * 16);
#define KL_ITER(KC, ARS) do { \
        const int kn = (KC) < 15 ? (KC) + 1 : 15, k4 = (KC) < 12 ? (KC) + 4 : 15; \
        unsigned long long wa0_ = (unsigned long long)W0s + (unsigned long long)(kn * 4096), wa1_ = (unsigned long long)W1s + (unsigned long long)(kn * 4096); \
        asm volatile("" : "+s"(wa0_), "+s"(wa1_));        \
        _Pragma("unroll") for (int kk = 0; kk < 4; ++kk) { \
            if (kk < 3) { _Pragma("unroll") for (int mb = 0; mb < 4; ++mb) afr[(kk + 1) & 1][mb] = *(const bf16x8*)(b0 + (((kk + 1) * 4 + mb) * 64 + lane) * 16); } \
            else { _Pragma("unroll") for (int mb = 0; mb < 4; ++mb) afr[0][mb] = *(const bf16x8*)(b1 + ((0 * 4 + mb) * 64 + lane) * 16); }        \
            __builtin_amdgcn_sched_barrier(0);         \
            _Pragma("unroll") for (int mb = 0; mb < 4; ++mb) \
                _Pragma("unroll") for (int nb = 0; nb < 2; ++nb) { \
                    const bf16x8 wf = __builtin_bit_cast(bf16x8, wq[kk][nb]); \
                    if (ORIENT == 0) acc[mb][nb] = MFMA32(afr[kk & 1][mb], wf, acc[mb][nb]); \
                    else acc[mb][nb] = MFMA32(wf, afr[kk & 1][mb], acc[mb][nb]); \
                } \
            if ((KC) < 15) { wq[kk][0] = *(gvp_t)((gcp_t)wa0_ + (size_t)(kk * 1024) + woff_); wq[kk][1] = *(gvp_t)((gcp_t)wa1_ + (size_t)(kk * 1024) + woff_); } \
            if (kk == 1) { \
                __syncthreads(); \
                if ((KC) < 14) { *(u32x4*)(b2 + ldsA_) = ARS[0]; *(u32x4*)(b2 + ldsA_ + 2048) = ARS[1]; } \
                if ((KC) < 12) { ARS[0] = AG0(k4); ARS[1] = AG1(k4); } \
            } \
            __builtin_amdgcn_sched_barrier(0); \
        } \
        { char* t_ = b0; b0 = b1; b1 = b2; b2 = t_; } \
    } while (0)
    for (int kc = 0; kc < 16; kc += 2) { KL_ITER(kc, arA); KL_ITER(kc + 1, arB); }
#undef KL_ITER
#undef AG0
#undef AG1
#undef WG0
#undef WG1
    __syncthreads();
    }
}

DI void epi_f32row(const f32x16 (&acc)[4][2], float* __restrict__ C, int tile, int col0, int lane) {
    lane = opaque_v(lane);
    const int r5 = lane & 31, hh = lane >> 5;
    const unsigned boff = (unsigned)((tile * 128 + 4 * hh) * 2048 + col0 + r5);
#pragma unroll
    for (int mb = 0; mb < 4; ++mb)
#pragma unroll
        for (int nb = 0; nb < 2; ++nb)
#pragma unroll
            for (int i = 0; i < 16; ++i)
                C[boff + (unsigned)((mb * 32 + (i & 3) + 8 * (i >> 2)) * 2048 + nb * 32)] = acc[mb][nb][i];
}
DI void epi_resid(const f32x16 (&acc)[4][2], const float* __restrict__ xin, float* __restrict__ xout, const float* __restrict__ gate_b, float* T  , float* ssq  , int tile, int col0, int lane) {
    lane = opaque_v(lane);
    const int r5 = lane & 31, hh = lane >> 5, rq = lane >> 4, c4 = (lane & 15) * 4;
    const float4 gv = *(const float4*)(gate_b + col0 + c4);
#pragma unroll
    for (int mb = 0; mb < 4; ++mb) {
#pragma unroll
        for (int nb = 0; nb < 2; ++nb)
#pragma unroll
            for (int i = 0; i < 16; ++i) T[((i & 3) + 8 * (i >> 2) + 4 * hh) * 68 + nb * 32 + r5] = acc[mb][nb][i];
        asm volatile("s_waitcnt lgkmcnt(0)" ::: "memory");
#pragma unroll
        for (int j = 0; j < 8; ++j) {
            const int row = rq + 4 * j;
            const float4 v = *(const float4*)(T + row * 68 + c4);
            const unsigned o = (unsigned)((tile * 128 + mb * 32 + row) * D + col0 + c4);
            float4 xv = *(const float4*)(xin + o);
            xv.x += gv.x * v.x; xv.y += gv.y * v.y; xv.z += gv.z * v.z; xv.w += gv.w * v.w;
            *(float4*)(xout + o) = xv;
            float ss = xv.x * xv.x + xv.y * xv.y + xv.z * xv.z + xv.w * xv.w;
            ss = red16_sum(ss);
            if ((lane & 15) == 0) ssq[mb * 32 + row] = ss;
        }
        asm volatile("s_waitcnt lgkmcnt(0)" ::: "memory");
    }
}

DI void epi_qpf(const f32x16 (&acc)[4][2], bf16_t* __restrict__ QPF, int tile, int ft0, int lane) {
    lane = opaque_v(lane);
#pragma unroll
    for (int nb = 0; nb < 2; ++nb)
#pragma unroll
        for (int s = 0; s < 2; ++s)
#pragma unroll
            for (int mb = 0; mb < 4; ++mb) {
                const f32x16& a = acc[mb][nb];
                u32x4 o; o.x = pk2(a[8 * s], a[8 * s + 1]); o.y = pk2(a[8 * s + 2], a[8 * s + 3]); o.z = pk2(a[8 * s + 4], a[8 * s + 5]); o.w = pk2(a[8 * s + 6], a[8 * s + 7]);
                *(u32x4*)(QPF + ((unsigned)((((tile * 64 + ft0 + nb) * 2 + s) * 4 + mb) * 64 + lane)) * 8) = o;
            }
}

DI void conv_keys_item(const float* __restrict__ K, bf16_t* __restrict__ KF, int gid) {
    const int lane = gid & 63, s = (gid >> 6) & 1, nbl = (gid >> 7) & 3, nt = (gid >> 9) & 3, hp = gid >> 11;
    const int r = lane & 31, hh = lane >> 5;
    const float* p = K + ((size_t)hp * 128 + nt * 32 + r) * 128 + nbl * 32 + 16 * s + 4 * hh;
    const float4 a = *(const float4*)p, b = *(const float4*)(p + 8);
    u32x4 o; o.x = pk2(a.x, a.y); o.y = pk2(a.z, a.w); o.z = pk2(b.x, b.y); o.w = pk2(b.z, b.w);
    *(u32x4*)(KF + (size_t)gid * 8) = o;
}

DI void conv_table_row(const float* __restrict__ src, unsigned char* __restrict__ dst, float* __restrict__ sc, int lane, bool as_int4) {
    const float4* p = (const float4*)src + lane * 4;
    float4 v[4];
    float m = 0.f;
#pragma unroll
    for (int j = 0; j < 4; ++j) { v[j] = p[j]; m = fmaxf(m, fmaxf(fmaxf(fabsf(v[j].x), fabsf(v[j].y)), fmaxf(fabsf(v[j].z), fabsf(v[j].w)))); }
    m = wave_max(m);
    float scale = m > 0.f ? m * (1.f / 6.f) : 1.f;
    if (as_int4) {
        float ss = 0.f;
#pragma unroll
        for (int j = 0; j < 4; ++j) ss += v[j].x * v[j].x + v[j].y * v[j].y + v[j].z * v[j].z + v[j].w * v[j].w;
        ss = wave_sum(ss);
        const float sg = sqrtf(ss * (1.f / 1024.f));
        scale = fmaxf(sg * (1.f / 2.8f), m * (1.f / 16.f));
        if (!(scale > 0.f)) scale = 1.f;
    }
    const float inv = 1.f / scale;
    u32x2 o;
    unsigned* op = (unsigned*)&o;
#pragma unroll
    for (int j = 0; j < 2; ++j) {
        const float f[8] = {v[2 * j].x, v[2 * j].y, v[2 * j].z, v[2 * j].w, v[2 * j + 1].x, v[2 * j + 1].y, v[2 * j + 1].z, v[2 * j + 1].w};
        unsigned wv = 0;
        if (as_int4) {
#pragma unroll
            for (int e = 0; e < 8; ++e) { int q = __float2int_rn(f[e] * inv); q = q < -7 ? -7 : (q > 7 ? 7 : q); wv |= ((unsigned)q & 15u) << (4 * e); }
        } else {
            wv = __builtin_amdgcn_cvt_scalef32_pk_fp4_f32(wv, f[0] * inv, f[1] * inv, 1.0f, 0);
            wv = __builtin_amdgcn_cvt_scalef32_pk_fp4_f32(wv, f[2] * inv, f[3] * inv, 1.0f, 1);
            wv = __builtin_amdgcn_cvt_scalef32_pk_fp4_f32(wv, f[4] * inv, f[5] * inv, 1.0f, 2);
            wv = __builtin_amdgcn_cvt_scalef32_pk_fp4_f32(wv, f[6] * inv, f[7] * inv, 1.0f, 3);
        }
        op[j] = wv;
    }
    *(u32x2*)(dst + lane * 8) = o;
    if (lane == 0) *sc = scale;
}

DI void ce_desc(int& a, int& b) { const int mx = a > b ? a : b, mn = a > b ? b : a; a = mx; b = mn; }
DI void sort16_desc(int (&v)[16]) {
#pragma unroll
    for (int k = 2; k <= 16; k <<= 1)
#pragma unroll
        for (int j = k >> 1; j > 0; j >>= 1)
#pragma unroll
            for (int i = 0; i < 16; ++i) {
                const int l = i ^ j;
                if (l > i) { if ((i & k) == 0) ce_desc(v[i], v[l]); else ce_desc(v[l], v[i]); }
            }
}
DI void bitonic_merge16_desc(int (&v)[16]) {
#pragma unroll
    for (int j = 8; j > 0; j >>= 1)
#pragma unroll
        for (int i = 0; i < 16; ++i) { const int l = i ^ j; if (l > i) ce_desc(v[i], v[l]); }
}
DI void merge_top16(int (&a)[16], const int (&b)[16]) {
#pragma unroll
    for (int i = 0; i < 16; ++i) a[i] = a[i] > b[15 - i] ? a[i] : b[15 - i];
    bitonic_merge16_desc(a);
}
DI int f2ord(float f) { int b = __float_as_int(f); return b ^ ((b >> 31) & 0x7fffffff); }
DI float ord2f(int k) { return __int_as_float(k ^ ((k >> 31) & 0x7fffffff)); }

DI void route_tile(const bf16_t* __restrict__ QPF, const bf16_t* __restrict__ KF, char* lds_lists, unsigned char* lds_idx  , int tile, int tid) {
    tid = opaque_v(tid); tile = opaque_s(tile);
    const int lane = tid & 63, w = __builtin_amdgcn_readfirstlane(tid >> 6);
    const int r5 = lane & 31, hh = lane >> 5;
    unsigned char* myidx = lds_idx + w * 1024;
    for (int task = w; task < 32; task += 8) {
        const int h = task >> 2, tt = task & 3;
        f32x16 acc[2][4];
#pragma unroll
        for (int p = 0; p < 2; ++p)
#pragma unroll
            for (int nt = 0; nt < 4; ++nt)
#pragma unroll
                for (int i = 0; i < 16; ++i) acc[p][nt][i] = 0.f;
        {
            bf16x8 bq[3], ak[3][4];
#define ROUTE_LOAD(buf, step) do { const int p_ = (step) >> 3, ks_ = (step) & 7; \
                bq[buf] = *(const bf16x8*)(QPF + ((unsigned)((((tile * 64 + h * 8 + p_ * 4 + (ks_ >> 1)) * 2 + (ks_ & 1)) * 4 + tt) * 64 + lane)) * 8); \
                _Pragma("unroll") for (int nt = 0; nt < 4; ++nt) ak[buf][nt] = *(const bf16x8*)(KF + ((unsigned)(((((h * 2 + p_) * 4 + nt) * 8 + ks_) * 64) + lane)) * 8); } while (0)
            ROUTE_LOAD(0, 0);
            ROUTE_LOAD(1, 1);
#pragma unroll
            for (int step = 0; step < 16; ++step) {
                if (step < 14) ROUTE_LOAD((step + 2) % 3, step + 2);
#pragma unroll
                for (int nt = 0; nt < 4; ++nt) acc[step >> 3][nt] = MFMA32(ak[step % 3][nt], bq[step % 3], acc[step >> 3][nt]);
                __builtin_amdgcn_sched_barrier(0);
            }
#undef ROUTE_LOAD
        }
        int g[8][16];
#pragma unroll
        for (int nt = 0; nt < 4; ++nt)
#pragma unroll
            for (int i = 0; i < 16; ++i) {
                const unsigned a = __float_as_uint(acc[0][nt][i]), b = __float_as_uint(acc[1][nt][i]);
                auto sw = __builtin_amdgcn_permlane32_swap(a, b, false, false);
                const int n0 = nt * 32 + (i & 3) + 8 * (i >> 2);
                g[nt * 2 + (i >> 3)][i & 7] = (f2ord(__uint_as_float(sw[0])) & ~127) | n0;
                g[nt * 2 + (i >> 3)][8 + (i & 7)] = (f2ord(__uint_as_float(sw[1])) & ~127) | (n0 + 4);
            }
#pragma unroll
        for (int q = 0; q < 8; ++q) sort16_desc(g[q]);
        merge_top16(g[0], g[1]); merge_top16(g[2], g[3]); merge_top16(g[4], g[5]); merge_top16(g[6], g[7]);
        merge_top16(g[0], g[2]); merge_top16(g[4], g[6]);
        merge_top16(g[0], g[4]);
        {
            u32x4 pk;
            unsigned* pp = (unsigned*)&pk;
#pragma unroll
            for (int q = 0; q < 4; ++q) pp[q] = (unsigned)(g[0][4 * q] & 127) | ((unsigned)(g[0][4 * q + 1] & 127) << 8) | ((unsigned)(g[0][4 * q + 2] & 127) << 16) | ((unsigned)(g[0][4 * q + 3] & 127) << 24);
            *(u32x4*)(myidx + lane * 16) = pk;
        }
        float f0[16], f1[16];
#pragma unroll
        for (int i = 0; i < 16; ++i) {
            const unsigned a = (unsigned)g[0][i], b = a;
            auto sw = __builtin_amdgcn_permlane32_swap(a, b, false, false);
            f0[i] = ord2f((int)sw[0] & ~127); f1[i] = ord2f((int)sw[1] & ~127);
        }
        int c0[16], c1[16], c2[16], c3[16];
#pragma unroll
        for (int j = 0; j < 16; ++j) c0[j] = (f2ord(f0[0] + f1[j]) & ~255) | j;
#pragma unroll
        for (int i = 1; i < 16; ++i) c1[i - 1] = (f2ord(f0[i] + f1[0]) & ~255) | (i << 4);
        c1[15] = (int)0x80000000;
#define CK(i, j) ((f2ord(f0[i] + f1[j]) & ~255) | ((i) << 4) | (j))
        c2[0] = CK(1, 1); c2[1] = CK(1, 2); c2[2] = CK(1, 3); c2[3] = CK(1, 4); c2[4] = CK(1, 5); c2[5] = CK(1, 6); c2[6] = CK(1, 7);
        c2[7] = CK(2, 1); c2[8] = CK(2, 2); c2[9] = CK(2, 3); c2[10] = CK(2, 4);
        c2[11] = CK(3, 1); c2[12] = CK(3, 2); c2[13] = CK(3, 3);
        c2[14] = CK(4, 1); c2[15] = CK(4, 2);
        c3[0] = CK(5, 1); c3[1] = CK(6, 1); c3[2] = CK(7, 1);
#undef CK
#pragma unroll
        for (int q = 3; q < 16; ++q) c3[q] = (int)0x80000000;
        sort16_desc(c2);
        ce_desc(c3[0], c3[1]); ce_desc(c3[1], c3[2]); ce_desc(c3[0], c3[1]);
        merge_top16(c0, c1); merge_top16(c2, c3); merge_top16(c0, c2);
        float bs[16], den = 0.f;
#pragma unroll
        for (int i = 0; i < 16; ++i) { bs[i] = __expf(ord2f(c0[i] & ~255) - ord2f(c0[0] & ~255)); den += bs[i]; }
        const float rden = 1.f / den;
        asm volatile("s_waitcnt lgkmcnt(0)" ::: "memory");
#pragma unroll
        for (int q = 0; q < 8; ++q) {
            const int key = (int)__builtin_amdgcn_permlane32_swap((unsigned)c0[q], (unsigned)c0[8 + q], false, false)[0];
            const float gv = __uint_as_float(__builtin_amdgcn_permlane32_swap(__float_as_uint(bs[q]), __float_as_uint(bs[8 + q]), false, false)[0]) * rden;
            const int i = (key >> 4) & 15, j = key & 15;
            const int e = (int)myidx[r5 * 16 + i] * 128 + (int)myidx[(32 + r5) * 16 + j];
            const int tokl = tt * 32 + r5;
            ((unsigned short*)(lds_lists + PL_SEID))[tokl * 128 + h * 16 + 8 * hh + q] = (unsigned short)e;
            ((float*)(lds_lists + PL_SWGT))[tokl * 128 + h * 16 + 8 * hh + q] = gv;
        }
        asm volatile("s_waitcnt lgkmcnt(0)" ::: "memory");
    }
}

DI void unpack_h2(const bf16_t* __restrict__ hA, int t, int lane, f32x2 (&hv)[8]) {
    const int tile = t >> 7, row = t & 127, mb = row >> 5, r5 = row & 31;
    const bf16_t* hp = hA + ((unsigned)(((tile * 64 + lane) * 4 + mb) * 64 + r5)) * 8;
    const u32x4 ha = *(const u32x4*)hp, hb = *(const u32x4*)(hp + 32 * 8);
    const unsigned hw[8] = {ha.x, ha.y, ha.z, ha.w, hb.x, hb.y, hb.z, hb.w};
#pragma unroll
    for (int q = 0; q < 8; ++q) { hv[q].x = __uint_as_float(hw[q] << 16); hv[q].y = __uint_as_float(hw[q] & 0xffff0000u); }
}
typedef _Float16 h16x2 __attribute__((ext_vector_type(2)));
DI h16x2 fp4h(unsigned w, int sel) {
    return sel == 0 ? __builtin_amdgcn_cvt_scalef32_pk_f16_fp4(w, 1.0f, 0) : sel == 1 ? __builtin_amdgcn_cvt_scalef32_pk_f16_fp4(w, 1.0f, 1)
         : sel == 2 ? __builtin_amdgcn_cvt_scalef32_pk_f16_fp4(w, 1.0f, 2) : __builtin_amdgcn_cvt_scalef32_pk_f16_fp4(w, 1.0f, 3);
}
DI unsigned rowoff_lo(unsigned pr, unsigned k512, unsigned lane8) { unsigned r; asm("v_mad_u32_u16 %0, %1, %2, %3" : "=v"(r) : "v"(pr), "s"(k512), "v"(lane8)); return r; }
DI unsigned rowoff_hi(unsigned pr, unsigned k512, unsigned lane8) { unsigned r; asm("v_mad_u32_u16 %0, %1, %2, %3 op_sel:[1,0,0,0]" : "=v"(r) : "v"(pr), "s"(k512), "v"(lane8)); return r; }
DI int dot8z(int a, int b) { int r; asm("v_dot8_i32_i4 %0, %1, %2, 0" : "=v"(r) : "v"(a), "v"(b)); return r; }
DI void stage_token(const int* __restrict__ ridx, const float* __restrict__ rgate, char* lds, int t, int tloc, int lane) {
    lane = opaque_v(lane); t = opaque_s(t);
    unsigned short* seid = (unsigned short*)(lds + PL_SEID) + tloc * 128;
    float* swgt = (float*)(lds + PL_SWGT) + tloc * 128;
    seid[lane] = (unsigned short)ridx[(unsigned)(t * 128 + lane)]; seid[64 + lane] = (unsigned short)ridx[(unsigned)(t * 128 + 64 + lane)];
    swgt[lane] = rgate[(unsigned)(t * 128 + lane)]; swgt[64 + lane] = rgate[(unsigned)(t * 128 + 64 + lane)];
}
DI void peer_down_wave(const bf16_t* __restrict__ hA, char* lds, const unsigned char* __restrict__ TBd, const float* __restrict__ SC, int tile, int w, int lane) {
    lane = opaque_v(lane);
    const int half = lane >> 5;
    const unsigned lane16 = (unsigned)(lane & 31) * 16u;
    const int cb = (lane & 31) * 32 + half * 16;
    const int myu = 2 * (((lane >> 4) & 1) * 4 + ((lane >> 3) & 1) * 2 + ((lane >> 2) & 1)) + half;
    const unsigned short* seid = (const unsigned short*)(lds + PL_SEID) + w * 16 * 128;
    float* swgt = (float*)(lds + PL_SWGT) + w * 16 * 128;
    u32x4 haN, hbN;
    { const bf16_t* hp0 = hA + (unsigned)((tile * 128 + w * 16) * 1024 + cb); haN = *(const u32x4*)hp0; hbN = *(const u32x4*)(hp0 + 8); }
    u32x4 R[2][8];
    unsigned IDN[8];
#define DOWN_IDS(P_) do { _Pragma("unroll") for (int u_ = 0; u_ < 8; ++u_) IDN[u_] = seid[(P_) + 2 * u_ + half]; } while (0)
#define DOWN_LOADS(buf) do { _Pragma("unroll") for (int u_ = 0; u_ < 8; ++u_) R[buf][u_] = *(const u32x4*)(TBd + (IDN[u_] * 512u + lane16)); } while (0)
    DOWN_IDS(0); DOWN_LOADS(0); DOWN_IDS(16);
#pragma unroll 1
    for (int tl = 0; tl < 16; ++tl) {
        const int t = tile * 128 + w * 16 + tl;
        float* gp = swgt + tl * 128;
        const u32x4 ha = haN, hb = hbN;
        const int tn = tl < 15 ? tl + 1 : tl;
        const int pa_ = tl * 128 + (lane & 3) * 32 + myu;
        const f32x2 scA = *(const f32x2*)(SC + (unsigned)seid[pa_] * 2u), scB = *(const f32x2*)(SC + (unsigned)seid[pa_ + 16] * 2u);
        int rs[8];
        { const bf16_t* hp = hA + (unsigned)((t - tl + tn) * 1024 + cb); haN = *(const u32x4*)hp; hbN = *(const u32x4*)(hp + 8); }
        unsigned hhi[4], hlo[4];
        float hscale;
        {
            const unsigned hw[8] = {ha.x, ha.y, ha.z, ha.w, hb.x, hb.y, hb.z, hb.w};
            float hf[16];
            float m = 0.f;
#pragma unroll
            for (int q = 0; q < 8; ++q) { hf[2 * q] = __uint_as_float(hw[q] << 16); hf[2 * q + 1] = __uint_as_float(hw[q] & 0xffff0000u); m = fmaxf(m, fmaxf(fabsf(hf[2 * q]), fabsf(hf[2 * q + 1]))); }
            m = wave_max(m);
            hscale = m > 0.f ? m * (1.f / 119.f) : 1.f;
            const float inv = 1.f / hscale;
            unsigned qh[2] = {0u, 0u}, ql[2] = {0u, 0u};
#pragma unroll
            for (int e = 0; e < 16; ++e) {
                const int hq = __float2int_rn(hf[e] * inv);
                const int lo = ((hq + 8) & 15) - 8, hi = (hq - lo) >> 4;
                ql[e >> 3] |= ((unsigned)lo & 15u) << (4 * (e & 7));
                qh[e >> 3] |= ((unsigned)hi & 15u) << (4 * (e & 7));
            }
#pragma unroll
            for (int q = 0; q < 2; ++q) {
                auto sh_ = __builtin_amdgcn_permlane32_swap(qh[q], qh[q], false, false); hhi[q] = sh_[0]; hhi[2 + q] = sh_[1];
                auto sl_ = __builtin_amdgcn_permlane32_swap(ql[q], ql[q], false, false); hlo[q] = sl_[0]; hlo[2 + q] = sl_[1];
            }
        }
#pragma unroll
        for (int bt = 0; bt < 8; ++bt) {
            const int cur = bt & 1, nxt = cur ^ 1;
            const int p2 = bt < 6 ? tl * 128 + (bt + 2) * 16 : tn * 128 + (bt - 6) * 16;
            DOWN_LOADS(nxt);
            DOWN_IDS(p2);
            __builtin_amdgcn_sched_barrier(0);
            int part[8];
#pragma unroll
            for (int u = 0; u < 8; ++u) {
                const int r0_ = (int)R[cur][u].x, r1_ = (int)R[cur][u].y, r2_ = (int)R[cur][u].z, r3_ = (int)R[cur][u].w;
                int shi = dot8z(r0_, (int)hhi[0]);
                shi = __builtin_amdgcn_sdot8(r1_, (int)hhi[1], shi, false);
                shi = __builtin_amdgcn_sdot8(r2_, (int)hhi[2], shi, false);
                shi = __builtin_amdgcn_sdot8(r3_, (int)hhi[3], shi, false);
                int p_ = shi << 4;
                p_ = __builtin_amdgcn_sdot8(r0_, (int)hlo[0], p_, false);
                p_ = __builtin_amdgcn_sdot8(r1_, (int)hlo[1], p_, false);
                p_ = __builtin_amdgcn_sdot8(r2_, (int)hlo[2], p_, false);
                part[u] = __builtin_amdgcn_sdot8(r3_, (int)hlo[3], p_, false);
            }
            int r4[4], r2[2], r1;
            {
                const bool b3 = (lane & 8) != 0, b2 = (lane & 4) != 0;
#pragma unroll
                for (int q = 0; q < 4; ++q) { auto sw = __builtin_amdgcn_permlane16_swap((unsigned)part[q], (unsigned)part[q + 4], false, false); r4[q] = (int)sw[0] + (int)sw[1]; }
#pragma unroll
                for (int q = 0; q < 2; ++q) { const int keep = b3 ? r4[q + 2] : r4[q], give = b3 ? r4[q] : r4[q + 2]; r2[q] = keep + dppi<0x128>(give); }
                { const int keep = b2 ? r2[1] : r2[0], give = b2 ? r2[0] : r2[1]; r1 = keep + dppi<0x141>(give); }
                r1 += dppi<0x4E>(r1); r1 += dppi<0xB1>(r1);
            }
            rs[bt] = r1;
        }
        {
            const int j_ = lane & 3;
            const int ra = j_ == 0 ? rs[0] : j_ == 1 ? rs[2] : j_ == 2 ? rs[4] : rs[6];
            const int rb = j_ == 0 ? rs[1] : j_ == 1 ? rs[3] : j_ == 2 ? rs[5] : rs[7];
            float* gq = gp + j_ * 32 + myu;
            const float a0 = (float)ra * (scA.x * hscale), a1 = (float)rb * (scB.x * hscale);
            const float w0 = gq[0] * (0.5f * a0 * (1.f + erff(a0 * 0.70710678118654752f))) * scA.y;
            const float w1 = gq[16] * (0.5f * a1 * (1.f + erff(a1 * 0.70710678118654752f))) * scB.y;
            ((unsigned*)gq)[0] = (unsigned)__builtin_bit_cast(unsigned short, (_Float16)w0);
            ((unsigned*)gq)[16] = (unsigned)__builtin_bit_cast(unsigned short, (_Float16)w1);
        }
    }
#undef DOWN_IDS
#undef DOWN_LOADS
}
DI void peer_up_wave(char* lds, const unsigned char* __restrict__ TBu, const float* __restrict__ g2b, float* __restrict__ x, int tile, int w, int lane,
                     bf16_t* __restrict__ hAn, const float* __restrict__ g1n, const float* __restrict__ sh1n, const float* __restrict__ sc1n) {
    lane = opaque_v(lane);
    const int half = lane >> 5;
    const unsigned lane16 = (unsigned)(lane & 31) * 16u;
    const int cb = (lane & 31) * 32 + half * 16;
    const unsigned short* seid = (const unsigned short*)(lds + PL_SEID) + w * 16 * 128 + half;
    const unsigned* swgt = (const unsigned*)(lds + PL_SWGT) + w * 16 * 128 + half;
    u32x4 RA[8], RB[8];
    unsigned IDN[8], WA[8], WB[8];
#define UP_IDS(P_) do { _Pragma("unroll") for (int u_ = 0; u_ < 8; ++u_) IDN[u_] = seid[(P_) + 2 * u_]; } while (0)
#define UP_WTS(W, P_) do { _Pragma("unroll") for (int u_ = 0; u_ < 8; ++u_) W[u_] = swgt[(P_) + 2 * u_]; } while (0)
#define UP_LOADS(R) do { _Pragma("unroll") for (int u_ = 0; u_ < 8; ++u_) R[u_] = *(const u32x4*)(TBu + (IDN[u_] * 512u + lane16)); } while (0)
#define UP_COMPUTE(R, W) do { _Pragma("unroll") for (int u_ = 0; u_ < 8; ++u_) { \
        const unsigned wd_ = W[u_]; const h16x2 wp_ = __builtin_bit_cast(h16x2, wd_); const h16x2 w2_ = (h16x2){wp_.x, wp_.x}; \
        const unsigned r0_ = R[u_].x, r1_ = R[u_].y, r2_ = R[u_].z, r3_ = R[u_].w; \
        _Pragma("unroll") for (int q_ = 0; q_ < 4; ++q_) { acc[q_] = __builtin_elementwise_fma(w2_, fp4h(r0_, q_), acc[q_]); acc[4 + q_] = __builtin_elementwise_fma(w2_, fp4h(r1_, q_), acc[4 + q_]); \
            acc[8 + q_] = __builtin_elementwise_fma(w2_, fp4h(r2_, q_), acc[8 + q_]); acc[12 + q_] = __builtin_elementwise_fma(w2_, fp4h(r3_, q_), acc[12 + q_]); } } } while (0)
    UP_IDS(0); UP_LOADS(RA); UP_IDS(16); UP_WTS(WA, 0);
    float4 gv[4];
#pragma unroll
    for (int q = 0; q < 4; ++q) gv[q] = ((const float4*)(g2b + cb))[q];
    float4 cg[4], ch[4];
#pragma unroll
    for (int q = 0; q < 4; ++q) {
        cg[q] = (float4){0.f, 0.f, 0.f, 0.f}; ch[q] = cg[q];
        if (hAn) { const float4 a = ((const float4*)(g1n + cb))[q], b = ((const float4*)(sc1n + cb))[q]; ch[q] = ((const float4*)(sh1n + cb))[q];
                   cg[q].x = a.x * (1.f + b.x); cg[q].y = a.y * (1.f + b.y); cg[q].z = a.z * (1.f + b.z); cg[q].w = a.w * (1.f + b.w); }
    }
#pragma unroll 1
    for (int tk = 0; tk < 16; ++tk) {
        const int tn = tk < 15 ? tk + 1 : 15;
        float4* xp = (float4*)(x + (size_t)(unsigned)((tile * 128 + w * 16 + tk) * D + cb));
        float4 xv[4];
#pragma unroll
        for (int q = 0; q < 4; ++q) xv[q] = xp[q];
        h16x2 acc[16];
#pragma unroll
        for (int q = 0; q < 16; ++q) acc[q] = (h16x2){(_Float16)0.f, (_Float16)0.f};
#pragma unroll 1
        for (int i = 0; i < 4; ++i) {
            const int pa = tk * 128 + i * 32;
            const int pn = i < 3 ? pa + 32 : tn * 128;
            UP_LOADS(RB); UP_WTS(WB, pa + 16); UP_IDS(pn);
            __builtin_amdgcn_sched_barrier(0);
            UP_COMPUTE(RA, WA);
            UP_LOADS(RA); UP_WTS(WA, pn); UP_IDS(pn + 16);
            __builtin_amdgcn_sched_barrier(0);
            UP_COMPUTE(RB, WB);
        }
        h16x2 tot[8];
#pragma unroll
        for (int q = 0; q < 8; ++q) {
            const unsigned a_ = __builtin_bit_cast(unsigned, acc[q]), b_ = __builtin_bit_cast(unsigned, acc[q + 8]);
            auto sw = __builtin_amdgcn_permlane32_swap(a_, b_, false, false);
            const unsigned s0_ = sw[0], s1_ = sw[1];
            tot[q] = __builtin_bit_cast(h16x2, s0_) + __builtin_bit_cast(h16x2, s1_);
        }
        float ssx = 0.f;
#pragma unroll
        for (int q = 0; q < 4; ++q) {
            xv[q].x += gv[q].x * (float)tot[2 * q].x; xv[q].y += gv[q].y * (float)tot[2 * q].y; xv[q].z += gv[q].z * (float)tot[2 * q + 1].x; xv[q].w += gv[q].w * (float)tot[2 * q + 1].y;
            xp[q] = xv[q];
            ssx += xv[q].x * xv[q].x + xv[q].y * xv[q].y + xv[q].z * xv[q].z + xv[q].w * xv[q].w;
        }
        ssx = wave_sum(ssx);
        if (hAn) {
            const float rs = rsqrtf(ssx * (1.f / D) + EPS);
            bf16_t* orow = hAn + (size_t)(unsigned)((tile * 128 + w * 16 + tk) * D + cb);
#pragma unroll
            for (int j = 0; j < 2; ++j) {
                u32x4 o;
                o.x = pk2(xv[2 * j].x * rs * cg[2 * j].x + ch[2 * j].x, xv[2 * j].y * rs * cg[2 * j].y + ch[2 * j].y);
                o.y = pk2(xv[2 * j].z * rs * cg[2 * j].z + ch[2 * j].z, xv[2 * j].w * rs * cg[2 * j].w + ch[2 * j].w);
                o.z = pk2(xv[2 * j + 1].x * rs * cg[2 * j + 1].x + ch[2 * j + 1].x, xv[2 * j + 1].y * rs * cg[2 * j + 1].y + ch[2 * j + 1].y);
                o.w = pk2(xv[2 * j + 1].z * rs * cg[2 * j + 1].z + ch[2 * j + 1].z, xv[2 * j + 1].w * rs * cg[2 * j + 1].w + ch[2 * j + 1].w);
                *(u32x4*)(orow + 8 * j) = o;
            }
        }
    }
#undef UP_IDS
#undef UP_WTS
#undef UP_LOADS
#undef UP_COMPUTE
}

DI void epi_qk(f32x16 (&acc)[4][2], const float* __restrict__ gain, float scale, bf16_t* __restrict__ dst, int lane) {
    lane = opaque_v(lane);
    const int hh = lane >> 5;
    float gv[2][16];
#pragma unroll
    for (int nb = 0; nb < 2; ++nb)
#pragma unroll
        for (int i = 0; i < 16; ++i) gv[nb][i] = gain[nb * 32 + (i & 3) + 8 * (i >> 2) + 4 * hh] * scale;
#pragma unroll
    for (int mb = 0; mb < 4; ++mb) {
        float ss = 0.f;
#pragma unroll
        for (int nb = 0; nb < 2; ++nb)
#pragma unroll
            for (int i = 0; i < 16; ++i) ss += acc[mb][nb][i] * acc[mb][nb][i];
        ss = x32_sum(ss);
        const float r = rsqrtf(ss * (1.f / 64.f) + EPS);
#pragma unroll
        for (int nb = 0; nb < 2; ++nb)
#pragma unroll
            for (int s = 0; s < 2; ++s) {
                const f32x16& a = acc[mb][nb];
                u32x4 o;
                o.x = pk2(a[8 * s] * r * gv[nb][8 * s], a[8 * s + 1] * r * gv[nb][8 * s + 1]);
                o.y = pk2(a[8 * s + 2] * r * gv[nb][8 * s + 2], a[8 * s + 3] * r * gv[nb][8 * s + 3]);
                o.z = pk2(a[8 * s + 4] * r * gv[nb][8 * s + 4], a[8 * s + 5] * r * gv[nb][8 * s + 5]);
                o.w = pk2(a[8 * s + 6] * r * gv[nb][8 * s + 6], a[8 * s + 7] * r * gv[nb][8 * s + 7]);
                *(u32x4*)(dst + ((unsigned)(((nb * 2 + s) * 4 + mb) * 64 + lane)) * 8) = o;
            }
    }
}
DI void epi_v(const f32x16 (&acc)[4][2], bf16_t* __restrict__ dst, int lane) {
    lane = opaque_v(lane);
#pragma unroll
    for (int nb = 0; nb < 2; ++nb)
#pragma unroll
        for (int mb = 0; mb < 4; ++mb)
#pragma unroll
            for (int s = 0; s < 2; ++s) {
                const f32x16& a = acc[mb][nb];
                u32x4 o; o.x = pk2(a[8 * s], a[8 * s + 1]); o.y = pk2(a[8 * s + 2], a[8 * s + 3]); o.z = pk2(a[8 * s + 4], a[8 * s + 5]); o.w = pk2(a[8 * s + 6], a[8 * s + 7]);
                *(u32x4*)(dst + ((unsigned)(((nb * 4 + mb) * 2 + s) * 64 + lane)) * 8) = o;
            }
}
DI void epi_row(const f32x16 (&acc)[4][2], bf16_t* __restrict__ dst, int ld, int lane) {
    lane = opaque_v(lane);
    const int r5 = lane & 31, hh = lane >> 5;
#pragma unroll
    for (int mb = 0; mb < 4; ++mb)
#pragma unroll
        for (int nb = 0; nb < 2; ++nb)
#pragma unroll
            for (int gq = 0; gq < 4; gq += 2) {
                const f32x16& a = acc[mb][nb];
                const unsigned ax = pk2(a[4 * gq], a[4 * gq + 1]), ay = pk2(a[4 * gq + 2], a[4 * gq + 3]);
                const unsigned bx = pk2(a[4 * gq + 4], a[4 * gq + 5]), by = pk2(a[4 * gq + 6], a[4 * gq + 7]);
                auto sx = __builtin_amdgcn_permlane32_swap(ax, bx, false, false);
                auto sy = __builtin_amdgcn_permlane32_swap(ay, by, false, false);
                u32x4 o; o.x = sx[0]; o.y = sy[0]; o.z = sx[1]; o.w = sy[1];
                *(u32x4*)(dst + (unsigned)((mb * 32 + r5) * ld + nb * 32 + 8 * (gq + hh))) = o;
            }
}
DI void epi_z(const f32x16 (&acc)[4][2], bf16_t* __restrict__ dst, int lane) {
    lane = opaque_v(lane);
    const int r5 = lane & 31, hh = lane >> 5;
#pragma unroll
    for (int mb = 0; mb < 4; ++mb)
#pragma unroll
        for (int gq = 0; gq < 4; gq += 2) {
            const f32x16 &a = acc[mb][0], &b = acc[mb][1];
            const unsigned ax = pk2(a[4 * gq] * b[4 * gq], a[4 * gq + 1] * b[4 * gq + 1]), ay = pk2(a[4 * gq + 2] * b[4 * gq + 2], a[4 * gq + 3] * b[4 * gq + 3]);
            const unsigned bx = pk2(a[4 * gq + 4] * b[4 * gq + 4], a[4 * gq + 5] * b[4 * gq + 5]), by = pk2(a[4 * gq + 6] * b[4 * gq + 6], a[4 * gq + 7] * b[4 * gq + 7]);
            auto sx = __builtin_amdgcn_permlane32_swap(ax, bx, false, false);
            auto sy = __builtin_amdgcn_permlane32_swap(ay, by, false, false);
            u32x4 o; o.x = sx[0]; o.y = sy[0]; o.z = sx[1]; o.w = sy[1];
            *(u32x4*)(dst + (unsigned)((mb * 32 + r5) * 256 + 8 * (gq + hh))) = o;
        }
}
DI void epi_su_park(const f32x16 (&acc)[4][2], unsigned* lds_su, int lane) {
    lane = opaque_v(lane);
#pragma unroll
    for (int mb = 0; mb < 4; ++mb)
#pragma unroll
        for (int nb = 0; nb < 2; ++nb)
#pragma unroll
            for (int q = 0; q < 8; ++q) lds_su[((mb * 2 + nb) * 8 + q) * 64 + lane] = pk2(acc[mb][nb][2 * q], acc[mb][nb][2 * q + 1]);
}
DI void epi_sv(f32x16 (&acc)[4][2], const bf16_t* __restrict__ SWF  , const float* __restrict__ bs_g, const unsigned* lds_su, bf16_t* __restrict__ dst, int lane) {
    lane = opaque_v(lane);
    const int r5 = lane & 31, hh = lane >> 5;
    bf16x8 vb[4][2][2];
#pragma unroll
    for (int mb = 0; mb < 4; ++mb) {
#pragma unroll
        for (int i = 0; i < 16; ++i) {
            float s1 = acc[mb][0][i] + acc[mb][1][i];
            s1 = red32_sum(s1);
            const float mu = s1 * (1.f / 64.f);
            const float d0 = acc[mb][0][i] - mu, d1 = acc[mb][1][i] - mu;
            float s2 = d0 * d0 + d1 * d1;
            s2 = red32_sum(s2);
            const float r = rsqrtf(s2 * (1.f / 64.f) + EPS);
            acc[mb][0][i] = d0 * r; acc[mb][1][i] = d1 * r;
        }
#pragma unroll
        for (int s = 0; s < 2; ++s)
#pragma unroll
            for (int nb = 0; nb < 2; ++nb) {
                const f32x16& a = acc[mb][nb];
                u32x4 o; o.x = pk2(a[8 * s], a[8 * s + 1]); o.y = pk2(a[8 * s + 2], a[8 * s + 3]); o.z = pk2(a[8 * s + 4], a[8 * s + 5]); o.w = pk2(a[8 * s + 6], a[8 * s + 7]);
                vb[mb][s][nb] = __builtin_bit_cast(bf16x8, o);
            }
    }
#pragma unroll
    for (int tb = 0; tb < 4; ++tb) {
        f32x16 y[2];
#pragma unroll
        for (int nb = 0; nb < 2; ++nb)
#pragma unroll
            for (int i = 0; i < 16; ++i) y[nb][i] = 0.f;
#pragma unroll
        for (int kt = 0; kt <= tb; ++kt)
#pragma unroll
            for (int s = 0; s < 2; ++s) {
                const bf16x8 wa = *(const bf16x8*)(SWF + ((unsigned)(((tb * 4 + kt) * 2 + s) * 64 + lane)) * 8);
                y[0] = MFMA32(wa, vb[kt][s][0], y[0]);
                y[1] = MFMA32(wa, vb[kt][s][1], y[1]);
            }
#pragma unroll
        for (int nb = 0; nb < 2; ++nb)
#pragma unroll
            for (int q = 0; q < 8; ++q) {
                const unsigned su2 = lds_su[((tb * 2 + nb) * 8 + q) * 64 + lane];
                const int i0 = 2 * q, i1 = 2 * q + 1;
                const int t0 = tb * 32 + (i0 & 3) + 8 * (i0 >> 2) + 4 * hh, t1 = tb * 32 + (i1 & 3) + 8 * (i1 >> 2) + 4 * hh;
                const float v0 = (y[nb][i0] + bs_g[t0]) * __uint_as_float(su2 << 16), v1 = (y[nb][i1] + bs_g[t1]) * __uint_as_float(su2 & 0xffff0000u);
                const unsigned pk = pk2(v0, v1);
                dst[(unsigned)(t0 * 256 + nb * 32 + r5)] = (bf16_t)(pk & 0xffffu);
                dst[(unsigned)(t1 * 256 + nb * 32 + r5)] = (bf16_t)(pk >> 16);
            }
    }
}

DI void conv_sguw_item(const float* __restrict__ W, bf16_t* __restrict__ SWF, int gid) {
    const int lane = gid & 63, s = (gid >> 6) & 1, kt = (gid >> 7) & 3, tb = (gid >> 9) & 3, g = gid >> 11;
    const int r = lane & 31, hh = lane >> 5, t = tb * 32 + r;
    const float* p = W + ((size_t)g * 128 + t) * 128;
    float v[8];
#pragma unroll
    for (int j = 0; j < 8; ++j) { const int sp = kt * 32 + 16 * s + 8 * (j >> 2) + 4 * hh + (j & 3); v[j] = sp <= t ? p[sp] : 0.f; }
    u32x4 o; o.x = pk2(v[0], v[1]); o.y = pk2(v[2], v[3]); o.z = pk2(v[4], v[5]); o.w = pk2(v[6], v[7]);
    *(u32x4*)(SWF + (size_t)gid * 8) = o;
}

DI int t5_bucket(int d) {
    if (d < 16) return d;
    const float lr = logf((float)d / 16.f) / logf(8.f);
    const int large = 16 + (int)(lr * 16.f);
    return large < 31 ? large : 31;
}

DI void attn_tile(const bf16_t* __restrict__ QF, const bf16_t* __restrict__ KF2, const bf16_t* __restrict__ VF, char* lds, const float* bias_lds, const float* __restrict__ sink, bf16_t* __restrict__ OR, int tile, int tid) {
    tid = opaque_v(tid); tile = opaque_s(tile);
    const int lane = tid & 63, w = __builtin_amdgcn_readfirstlane(tid >> 6), r5 = lane & 31, hh = lane >> 5;
    const bool has_prev = (tile & 31) != 0;
    {
        u32x4 tmp[16];
#pragma unroll
        for (int i = 0; i < 16; ++i) {
            const int blk = w * 16 + i;
            const int isv = blk >> 6, bb = blk & 63;
            const bf16_t* src;
            if (!isv) { const int kvh = bb >> 5, ks = (bb >> 3) & 3, wt = bb & 7, st = (wt >= 4 || !has_prev) ? tile : tile - 1;
                src = KF2 + ((unsigned)((((st * 2 + kvh) * 4 + ks) * 4 + (wt & 3)) * 64 + lane)) * 8; }
            else { const int kvh = bb >> 5, dt = (bb >> 4) & 1, wt = (bb >> 1) & 7, s2 = bb & 1, st = (wt >= 4 || !has_prev) ? tile : tile - 1;
                src = VF + ((unsigned)(((((st * 2 + kvh) * 2 + dt) * 4 + (wt & 3)) * 2 + s2) * 64 + lane)) * 8; }
            tmp[i] = *(const u32x4*)src;
        }
#pragma unroll
        for (int i = 0; i < 16; ++i) *(u32x4*)(lds + (w * 16 + i) * 1024 + lane * 16) = tmp[i];
    }
    __syncthreads();
    const char* ldsK = lds, *ldsV = lds + 65536;
    for (int task = w; task < 32; task += 8) {
        const int qh = task >> 2, qt = task & 3, kvh = qh >> 2;
        bf16x8 bq[4];
#pragma unroll
        for (int ks = 0; ks < 4; ++ks) bq[ks] = *(const bf16x8*)(QF + ((unsigned)((((tile * 8 + qh) * 4 + ks) * 4 + qt) * 64 + lane)) * 8);
        f32x16 sc[5];
#pragma unroll
        for (int jj = 0; jj < 5; ++jj) {
#pragma unroll
            for (int i = 0; i < 16; ++i) sc[jj][i] = 0.f;
#pragma unroll
            for (int ks = 0; ks < 4; ++ks) {
                const bf16x8 kf = *(const bf16x8*)(ldsK + ((kvh * 4 + ks) * 8 + qt + jj) * 1024 + lane * 16);
                sc[jj] = MFMA32(kf, bq[ks], sc[jj]);
            }
        }
        const float* bl = bias_lds + qh * 128;
        float m = -1e30f;
#pragma unroll
        for (int jj = 0; jj < 5; ++jj) {
            const bool ex = (qt + jj >= 4) || has_prev;
#pragma unroll
            for (int i = 0; i < 16; ++i) {
                const int cr = (i & 3) + 8 * (i >> 2) + 4 * hh;
                const int dist = 128 + r5 - 32 * jj - cr;
                const bool valid = ex && dist >= 0 && dist < 128;
                float bv = bl[dist & 127];
                asm volatile("" : "+v"(bv));
                const float v = valid ? sc[jj][i] + bv : -1e30f;
                sc[jj][i] = v; m = fmaxf(m, v);
            }
        }
        m = x32_max(m);
        const float sk = sink[qh];
        m = fmaxf(m, sk);
        float l = 0.f;
#pragma unroll
        for (int jj = 0; jj < 5; ++jj)
#pragma unroll
            for (int i = 0; i < 16; ++i) { const float p = __expf(sc[jj][i] - m); sc[jj][i] = p; l += p; }
        l = x32_sum(l);
        l += __expf(sk - m);
        const float rl = 1.f / l;
        f32x16 o[2];
#pragma unroll
        for (int dt = 0; dt < 2; ++dt)
#pragma unroll
            for (int i = 0; i < 16; ++i) o[dt][i] = 0.f;
#pragma unroll
        for (int jj = 0; jj < 5; ++jj) {
#pragma unroll
            for (int s = 0; s < 2; ++s) {
                const f32x16& a = sc[jj];
                u32x4 pp; pp.x = pk2(a[8 * s], a[8 * s + 1]); pp.y = pk2(a[8 * s + 2], a[8 * s + 3]); pp.z = pk2(a[8 * s + 4], a[8 * s + 5]); pp.w = pk2(a[8 * s + 6], a[8 * s + 7]);
                const bf16x8 pb = __builtin_bit_cast(bf16x8, pp);
#pragma unroll
                for (int dt = 0; dt < 2; ++dt) {
                    const bf16x8 vf = *(const bf16x8*)(ldsV + (((kvh * 2 + dt) * 8 + qt + jj) * 2 + s) * 1024 + lane * 16);
                    o[dt] = MFMA32(vf, pb, o[dt]);
                }
            }
        }
        bf16_t* orow = OR + (unsigned)((tile * 128 + qt * 32 + r5) * 512 + qh * 64 + 4 * hh);
#pragma unroll
        for (int dt = 0; dt < 2; ++dt)
#pragma unroll
            for (int gq = 0; gq < 4; gq += 2) {
                const unsigned ax = pk2(o[dt][4 * gq] * rl, o[dt][4 * gq + 1] * rl), ay = pk2(o[dt][4 * gq + 2] * rl, o[dt][4 * gq + 3] * rl);
                const unsigned bx = pk2(o[dt][4 * gq + 4] * rl, o[dt][4 * gq + 5] * rl), by = pk2(o[dt][4 * gq + 6] * rl, o[dt][4 * gq + 7] * rl);
                auto sx = __builtin_amdgcn_permlane32_swap(ax, bx, false, false);
                auto sy = __builtin_amdgcn_permlane32_swap(ay, by, false, false);
                u32x4 ov; ov.x = sx[0]; ov.y = sy[0]; ov.z = sx[1]; ov.w = sy[1];
                *(u32x4*)(OR + (unsigned)((tile * 128 + qt * 32 + r5) * 512 + qh * 64 + dt * 32 + 8 * (gq + hh))) = ov;
            }
    }
}

DI void unpack8(const u32x4 v, float (&f)[8]) {
    f[0] = __uint_as_float(v.x << 16); f[1] = __uint_as_float(v.x & 0xffff0000u); f[2] = __uint_as_float(v.y << 16); f[3] = __uint_as_float(v.y & 0xffff0000u);
    f[4] = __uint_as_float(v.z << 16); f[5] = __uint_as_float(v.z & 0xffff0000u); f[6] = __uint_as_float(v.w << 16); f[7] = __uint_as_float(v.w & 0xffff0000u);
}
DI void merge_tile(const bf16_t* __restrict__ OR, const bf16_t* __restrict__ CBR, const bf16_t* __restrict__ ZR, const bf16_t* __restrict__ YS, const float* __restrict__ cw  , const float* __restrict__ og  ,
                   bf16_t* __restrict__ mA, int tile, int tid) {
    tid = opaque_v(tid); tile = opaque_s(tile);
    const int lane = tid & 63, w = tid >> 6;
    float cwv[3][8], ga[8], gb[8];
    {
        const int c0 = (lane & 31) * 8;
#pragma unroll
        for (int j = 0; j < 3; ++j) { const float4 p0 = *(const float4*)(cw + j * 256 + c0), p1 = *(const float4*)(cw + j * 256 + c0 + 4);
            cwv[j][0] = p0.x; cwv[j][1] = p0.y; cwv[j][2] = p0.z; cwv[j][3] = p0.w; cwv[j][4] = p1.x; cwv[j][5] = p1.y; cwv[j][6] = p1.z; cwv[j][7] = p1.w; }
        const float4 a0 = *(const float4*)(og + lane * 8), a1 = *(const float4*)(og + lane * 8 + 4), b0 = *(const float4*)(og + 512 + lane * 8), b1 = *(const float4*)(og + 512 + lane * 8 + 4);
        ga[0] = a0.x; ga[1] = a0.y; ga[2] = a0.z; ga[3] = a0.w; ga[4] = a1.x; ga[5] = a1.y; ga[6] = a1.z; ga[7] = a1.w;
        gb[0] = b0.x; gb[1] = b0.y; gb[2] = b0.z; gb[3] = b0.w; gb[4] = b1.x; gb[5] = b1.y; gb[6] = b1.z; gb[7] = b1.w;
    }
#pragma unroll 8
    for (int rr = 0; rr < 16; ++rr) {
        const int row = w * 16 + rr, t = tile * 128 + row, pos = t & (S - 1);
        float a[8], y[8];
        unpack8(*(const u32x4*)(OR + (unsigned)(t * 512 + lane * 8)), a);
        float ssa = 0.f;
#pragma unroll
        for (int q = 0; q < 8; ++q) ssa += a[q] * a[q];
        ssa = wave_sum(ssa);
        {
            const int c0 = (lane & 31) * 8;
            float cb[8], z0[8], z1[8], z2[8], ys[8];
            const float m1 = pos >= 1 ? 1.f : 0.f, m2 = pos >= 2 ? 1.f : 0.f;
            const int t1 = pos >= 1 ? t - 1 : t, t2 = pos >= 2 ? t - 2 : t;
            unpack8(*(const u32x4*)(CBR + (unsigned)(t * 256 + c0)), cb);
            unpack8(*(const u32x4*)(ZR + (unsigned)(t * 256 + c0)), z2);
            unpack8(*(const u32x4*)(ZR + (unsigned)(t1 * 256 + c0)), z1);
            unpack8(*(const u32x4*)(ZR + (unsigned)(t2 * 256 + c0)), z0);
            unpack8(*(const u32x4*)(YS + (unsigned)(t * 256 + c0)), ys);
#pragma unroll
            for (int q = 0; q < 8; ++q) {
                const float yc = cb[q] * (cwv[0][q] * (z0[q] * m2) + cwv[1][q] * (z1[q] * m1) + cwv[2][q] * z2[q]);
                y[q] = lane < 32 ? yc : ys[q];
            }
        }
        float ssy = 0.f;
#pragma unroll
        for (int q = 0; q < 8; ++q) ssy += y[q] * y[q];
        ssy = red32_sum(ssy);
        const float ra = rsqrtf(ssa * (1.f / 512.f) + EPS), ry = rsqrtf(ssy * (1.f / 256.f) + EPS);
        const int mb = row >> 5, r5 = row & 31;
        {
            u32x4 o; o.x = pk2(a[0] * ra * ga[0], a[1] * ra * ga[1]); o.y = pk2(a[2] * ra * ga[2], a[3] * ra * ga[3]); o.z = pk2(a[4] * ra * ga[4], a[5] * ra * ga[5]); o.w = pk2(a[6] * ra * ga[6], a[7] * ra * ga[7]);
            const int c8 = lane;
            (void)c8;
            *(u32x4*)(mA + (unsigned)(t * 1024 + lane * 8)) = o;
        }
        {
            u32x4 o; o.x = pk2(y[0] * ry * gb[0], y[1] * ry * gb[1]); o.y = pk2(y[2] * ry * gb[2], y[3] * ry * gb[3]); o.z = pk2(y[4] * ry * gb[4], y[5] * ry * gb[5]); o.w = pk2(y[6] * ry * gb[6], y[7] * ry * gb[7]);
            const int c8 = 64 + lane;
            (void)c8;
            *(u32x4*)(mA + (unsigned)(t * 1024 + 512 + lane * 8)) = o;
        }
    }
}

struct InProjOut { bf16_t *QF, *KF2, *VF, *CBR, *ZR, *YS; };
DI void inproj_tile(const bf16_t* __restrict__ At, const bf16_t* __restrict__ WF, const float* __restrict__ qg, const float* __restrict__ kg, const bf16_t* __restrict__ SWF, const float* __restrict__ sgu_b,
                    const InProjOut& O, char* lds, int tile, int tid) {
    tid = opaque_v(tid); tile = opaque_s(tile);
    const int lane = tid & 63, w = __builtin_amdgcn_readfirstlane(tid >> 6);
    f32x16 acc[4][2];
    {
        const int nbt0 = w * 2;
        kloop<1>(acc, At, WF + (size_t)nbt0 * 32768, WF + (size_t)(nbt0 + 1) * 32768, lds, tid, lane);
        epi_qk(acc, qg, 0.125f, O.QF + (size_t)(tile * 8 + w) * 8192, lane);
    }
    {
        const int nbt0 = 16 + w * 2;
        if (w == 2 || w == 3) {
            kloop<0>(acc, At, WF + (size_t)nbt0 * 32768, WF + (size_t)(nbt0 + 1) * 32768, lds, tid, lane);
            epi_v(acc, O.VF + (size_t)(tile * 2 + (w - 2)) * 8192, lane);
        } else {
            kloop<1>(acc, At, WF + (size_t)nbt0 * 32768, WF + (size_t)(nbt0 + 1) * 32768, lds, tid, lane);
            if (w < 2) epi_qk(acc, kg, 1.f, O.KF2 + (size_t)(tile * 2 + w) * 8192, lane);
            else epi_row(acc, O.CBR + (size_t)tile * 128 * 256 + (w - 4) * 64, 256, lane);
        }
    }
    {
        const int nbt0 = 32 + w * 2;
        kloop<1>(acc, At, WF + (size_t)nbt0 * 32768, WF + (size_t)(nbt0 + 1) * 32768, lds, tid, lane);
        epi_z(acc, O.ZR + (size_t)tile * 128 * 256 + w * 32, lane);
    }
    {
        const int nbt0 = 48 + w * 2;
        kloop<0>(acc, At, WF + (size_t)nbt0 * 32768, WF + (size_t)(nbt0 + 1) * 32768, lds, tid, lane);
        unsigned* lds_su = (unsigned*)lds;
        if (w < 4) epi_su_park(acc, lds_su + w * 4096, lane);
        __syncthreads();
        if (w >= 4) epi_sv(acc, SWF + (size_t)(w - 4) * 16384, sgu_b + (w - 4) * 128, lds_su + (w - 4) * 4096, O.YS + (size_t)tile * 128 * 256 + (w - 4) * 64, lane);
        __syncthreads();
    }
}


struct Params {
    const float *x, *c, *rel_bias, *w_ada, *b_ada, *norm1_g, *norm2_g, *w_in, *q_norm_g, *k_norm_g, *attn_sink, *conv_w, *sgu_w, *sgu_b, *out_norm_g, *w_out, *peer_wq, *peer_sub_keys, *peer_down, *peer_up;
    float* out;
    char* ws;
};
constexpr size_t MiB = 1u << 20;
constexpr size_t WS_MOD = 0;
constexpr size_t WS_MODP = 1 * MiB;
constexpr size_t WS_WIN = 13 * MiB;
constexpr size_t WS_WOUT = 29 * MiB;
constexpr size_t WS_WPQ = 37 * MiB;
constexpr size_t WS_KEYS = 53 * MiB;
constexpr size_t WS_SWF = 55 * MiB;
constexpr size_t WS_SC = 56 * MiB;
constexpr size_t WS_TB = 57 * MiB;
constexpr size_t WS_HA = 185 * MiB;
constexpr size_t WS_QF = 249 * MiB;
constexpr size_t WS_KF2 = 602 * MiB;
constexpr size_t WS_VF = 634 * MiB;
constexpr size_t WS_ZR = 666 * MiB;
constexpr size_t WS_CBR = 345 * MiB;
constexpr size_t WS_YS = 361 * MiB;
constexpr size_t WS_OR = 377 * MiB;
constexpr size_t WS_QPF = 409 * MiB;
constexpr size_t WS_RIDX = 537 * MiB;
constexpr size_t WS_RGATE = 553 * MiB;
constexpr size_t WS_SEID = 569 * MiB;
constexpr size_t WS_SWGT = 585 * MiB;
constexpr size_t WS_OFFS = 601 * MiB;
constexpr size_t WS_FLAGS = 601 * MiB + 512 * 1024;
constexpr size_t WS_END = 730 * MiB;
static_assert(PL_END <= LDS_RSTD1, "expert-phase lists overlap persistent LDS state");

__global__ __launch_bounds__(512) void hybrid_fwd(Params P) {
    extern __shared__ __attribute__((aligned(16))) char lds[];
    cg::grid_group grid = cg::this_grid();
    const int tid = threadIdx.x, lane = tid & 63, w = __builtin_amdgcn_readfirstlane(tid >> 6);
    const int nblk = gridDim.x, hwb = blockIdx.x;
    const int bid = (nblk == NTILE) ? (hwb & 7) * 32 + (hwb >> 3) : hwb;
    char* ws = P.ws;
    float* mod = (float*)(ws + WS_MOD);
    float* modp = (float*)(ws + WS_MODP);
    bf16_t* WinF = (bf16_t*)(ws + WS_WIN); bf16_t* WoutF = (bf16_t*)(ws + WS_WOUT); bf16_t* WpqF = (bf16_t*)(ws + WS_WPQ);
    bf16_t* KeysF = (bf16_t*)(ws + WS_KEYS); bf16_t* SWF = (bf16_t*)(ws + WS_SWF);
    float* SC = (float*)(ws + WS_SC); unsigned char* TBd = (unsigned char*)(ws + WS_TB); unsigned char* TBu = TBd + 32 * MiB;
    bf16_t* hA = (bf16_t*)(ws + WS_HA);
    bf16_t* OR = (bf16_t*)(ws + WS_OR); bf16_t* QPF = (bf16_t*)(ws + WS_QPF);
    int* ridx = (int*)(ws + WS_RIDX); float* rgate = (float*)(ws + WS_RGATE);
    float* bias_lds = (float*)(lds + LDS_BIAS);
    unsigned* flags = (unsigned*)(ws + WS_FLAGS);

    {
        float* ca = (float*)lds;
        if (tid == 0) for (int tile = bid; tile < NTILE; tile += nblk) __hip_atomic_store(flags + tile, 0u, __ATOMIC_RELAXED, __HIP_MEMORY_SCOPE_AGENT);
        for (int i = tid; i < 8192; i += 512) { const float v = P.c[i]; ca[i] = v / (1.f + __expf(-v)); }
        for (int i = tid; i < 1024; i += 512) bias_lds[i] = P.rel_bias[t5_bucket(i & 127) * 8 + (i >> 7)];
        __syncthreads();
        for (int it = bid; it < 768; it += nblk) {
            const int jc = it % 12, l = (it / 12) & 3, ks = it / 48;
            const int j = jc * 512 + tid;
            const float* wp = P.w_ada + ((size_t)l * 1024 + ks * 64) * 6144 + j;
            float acc[8];
#pragma unroll
            for (int b = 0; b < 8; ++b) acc[b] = 0.f;
#pragma unroll 4
            for (int i = 0; i < 64; ++i) {
                const float wv = wp[(size_t)i * 6144];
#pragma unroll
                for (int b = 0; b < 8; ++b) acc[b] += ca[b * 1024 + ks * 64 + i] * wv;
            }
#pragma unroll
            for (int b = 0; b < 8; ++b) modp[((size_t)(ks * 4 + l) * 8 + b) * 6144 + j] = acc[b];
        }
        const int gthreads = nblk * 512, gtid = bid * 512 + tid;
        for (int rep = 0; rep < REP_P0; ++rep)
        for (int l = 0; l < DEPTH; ++l) {
            for (int g = gtid; g < 64 * 64 * 64; g += gthreads) conv_wfrag_item(P.w_in + (size_t)l * 1024 * 2048, 2048, 64, WinF + (size_t)l * 2097152, g, 1);
            for (int g = gtid; g < 32 * 64 * 64; g += gthreads) conv_wfrag_item(P.w_out + (size_t)l * 1024 * 1024, 1024, 64, WoutF + (size_t)l * 1048576, g, 0);
            for (int g = gtid; g < 64 * 64 * 64; g += gthreads) conv_wfrag_item(P.peer_wq + (size_t)l * 1024 * 2048, 2048, 64, WpqF + (size_t)l * 2097152, g, 0);
            for (int g = gtid; g < 32768; g += gthreads) conv_keys_item(P.peer_sub_keys + (size_t)l * 262144, KeysF + (size_t)l * 262144, g);
            for (int g = gtid; g < 8192; g += gthreads) conv_sguw_item(P.sgu_w + (size_t)l * 65536, SWF + (size_t)l * 65536, g);
        }
        const int gwaves = nblk * 8, gw = bid * 8 + w;
        for (int rep = 0; rep < REP_P0; ++rep)
        for (int r = gw; r < DEPTH * 16384 * 2; r += gwaves) {
            const int which = r & 1, le = r >> 1;
            conv_table_row((which ? P.peer_up : P.peer_down) + (size_t)le * D, (which ? TBu : TBd) + (size_t)le * 512, SC + (size_t)le * 2 + which, lane, which == 0);
        }
    }
    grid.sync();
    for (int tile = bid; tile < NTILE; tile += nblk) {
        const int b = tile >> 5;
        for (int l = 0; l < DEPTH; ++l)
            for (int j = tid; j < 6144; j += 512) {
                float v = P.b_ada[l * 6144 + j];
#pragma unroll
                for (int ks = 0; ks < 16; ++ks) v += modp[((size_t)(ks * 4 + l) * 8 + b) * 6144 + j];
                mod[((size_t)l * 8 + b) * 6144 + j] = v;
            }
    }
    __syncthreads();

    for (int l = 0; l < DEPTH; ++l) {
        const float* xin = l == 0 ? P.x : P.out;
        InProjOut IO;
        IO.QF = (bf16_t*)(ws + WS_QF); IO.KF2 = (bf16_t*)(ws + WS_KF2 + (size_t)l * 8 * MiB); IO.VF = (bf16_t*)(ws + WS_VF + (size_t)l * 8 * MiB);
        IO.CBR = (bf16_t*)(ws + WS_CBR); IO.ZR = (bf16_t*)(ws + WS_ZR + (size_t)l * 16 * MiB); IO.YS = (bf16_t*)(ws + WS_YS);
        for (int tile = bid; tile < NTILE; tile += nblk) {
            const float* mb_ = mod + ((size_t)l * 8 + (tile >> 5)) * 6144;
            if (l == 0) {
                norm_to_frag(xin, P.norm1_g + l * D, mb_ + 0, mb_ + 1024, hA, (float*)lds, tile, tid, false);
                __syncthreads();
            }
            for (int rep = 0; rep < REP_GEMM; ++rep) inproj_tile(hA + (size_t)tile * 131072, WinF + (size_t)l * 2097152, P.q_norm_g + l * 64, P.k_norm_g + l * 64, SWF + (size_t)l * 65536, P.sgu_b + l * 512, IO, lds, tile, tid);
            asm volatile("s_waitcnt vmcnt(0)" ::: "memory");
            __syncthreads();
            if (tid == 0) {
                __builtin_amdgcn_fence(__ATOMIC_RELEASE, "agent");
                asm volatile("s_waitcnt vmcnt(0)" ::: "memory");
                __hip_atomic_store(flags + tile, (unsigned)(l + 1), __ATOMIC_RELAXED, __HIP_MEMORY_SCOPE_AGENT);
            }
        }
        for (int tile = bid; tile < NTILE; tile += nblk) {
            const float* mb_ = mod + ((size_t)l * 8 + (tile >> 5)) * 6144;
            if ((tile & 31) != 0) {
                if (tid == 0) {
                    unsigned spins = 0;
                    while (__hip_atomic_load(flags + tile - 1, __ATOMIC_RELAXED, __HIP_MEMORY_SCOPE_AGENT) < (unsigned)(l + 1) && ++spins < (1u << 24)) __builtin_amdgcn_s_sleep(2);
                    __builtin_amdgcn_fence(__ATOMIC_ACQUIRE, "agent");
                    asm volatile("s_waitcnt vmcnt(0)" ::: "memory");
                }
                __syncthreads();
            }
            for (int rep = 0; rep < REP_MIX; ++rep) {
            attn_tile(IO.QF, IO.KF2, IO.VF, lds, bias_lds, P.attn_sink + l * 8, OR, tile, tid);
            __syncthreads();
            merge_tile(OR, IO.CBR, IO.ZR, IO.YS, P.conv_w + l * 768, P.out_norm_g + l * D, hA, tile, tid);
            __syncthreads();
            }
            {
                const bf16_t* At = hA + (size_t)tile * 131072;
                const bf16_t* WF = WoutF + (size_t)l * 1048576;
                for (int pass = 0; pass < 2; ++pass) {
                    f32x16 acc[4][2];
                    const int nbt0 = pass * 16 + w * 2;
                    kloop<0>(acc, At, WF + (size_t)nbt0 * 32768, WF + (size_t)(nbt0 + 1) * 32768, lds, tid, lane);
                    epi_resid(acc, xin, P.out, mb_ + 2048, (float*)(lds + LDS_EPI) + w * 2176, (float*)(lds + LDS_SSQ) + (pass * 8 + w) * 128, tile, pass * 512 + w * 64, lane);
                }
            }
            __syncthreads();
            if (tid < 128) { const float* sq = (const float*)(lds + LDS_SSQ); float ssum = 0.f;
#pragma unroll
                for (int c = 0; c < 16; ++c) ssum += sq[c * 128 + tid];
                ((float*)lds)[tid] = rsqrtf(ssum * (1.f / D) + EPS); }
            __syncthreads();
            norm_to_frag(P.out, P.norm2_g + l * D, mb_ + 3072, mb_ + 4096, hA, (float*)lds, tile, tid, true);
            __syncthreads();
            {
                const bf16_t* At = hA + (size_t)tile * 131072;
                const bf16_t* WF = WpqF + (size_t)l * 2097152;
                for (int rep = 0; rep < REP_GEMM; ++rep)
                for (int pass = 0; pass < 4; ++pass) {
                    f32x16 acc[4][2];
                    const int nbt0 = pass * 16 + w * 2;
                    kloop<1>(acc, At, WF + (size_t)nbt0 * 32768, WF + (size_t)(nbt0 + 1) * 32768, lds, tid, lane);
                    epi_qpf(acc, QPF, tile, nbt0, lane);
                }
            }
            __syncthreads();
            for (int rep = 0; rep < REP_ROUTE; ++rep) { route_tile(QPF, KeysF + (size_t)l * 262144, lds, (unsigned char*)lds + PL_RIDX, tile, tid); __syncthreads(); }
            peer_down_wave(hA, lds, TBd + (size_t)l * 16384 * 512, SC + (size_t)l * 32768, tile, w, lane);
            __syncthreads();
            {
                const float* mbn = mod + ((size_t)(l + 1 < DEPTH ? l + 1 : l) * 8 + (tile >> 5)) * 6144;
                peer_up_wave(lds, TBu + (size_t)l * 16384 * 512, mb_ + 5120, P.out, tile, w, lane, l + 1 < DEPTH ? hA : nullptr, P.norm1_g + (l + 1 < DEPTH ? l + 1 : l) * D, mbn + 0, mbn + 1024);
            }
            __syncthreads();
        }
    }
}
}

extern "C" void kernel_launch(void* const* d_in, const int* in_sizes, int n_in, void* d_out, int out_size, void* d_ws, size_t ws_size, hipStream_t stream) {
    using namespace op;
    static int grid_blocks = 0;
    if (!grid_blocks) {
        int dev = 0, cus = 0, per_cu = 0;
        (void)hipGetDevice(&dev);
        (void)hipDeviceGetAttribute(&cus, hipDeviceAttributeMultiprocessorCount, dev);
        (void)hipFuncSetAttribute((const void*)hybrid_fwd, hipFuncAttributeMaxDynamicSharedMemorySize, LDS_BYTES);
        (void)hipOccupancyMaxActiveBlocksPerMultiprocessor(&per_cu, (const void*)hybrid_fwd, 512, LDS_BYTES);
        if (per_cu < 1) per_cu = 1;
        grid_blocks = cus * per_cu;
        if (grid_blocks > NTILE) grid_blocks = NTILE;
        if (ws_size < WS_END) { fprintf(stderr, "kernel_launch: workspace too small (%zu < %zu)\n", ws_size, (size_t)WS_END); grid_blocks = -1; }
    }
    if (grid_blocks < 0) return;
    Params p{};
    p.x = (const float*)d_in[0]; p.c = (const float*)d_in[1]; p.rel_bias = (const float*)d_in[2]; p.w_ada = (const float*)d_in[3]; p.b_ada = (const float*)d_in[4];
    p.norm1_g = (const float*)d_in[5]; p.norm2_g = (const float*)d_in[6]; p.w_in = (const float*)d_in[7]; p.q_norm_g = (const float*)d_in[8]; p.k_norm_g = (const float*)d_in[9];
    p.attn_sink = (const float*)d_in[10]; p.conv_w = (const float*)d_in[11]; p.sgu_w = (const float*)d_in[12]; p.sgu_b = (const float*)d_in[13]; p.out_norm_g = (const float*)d_in[14];
    p.w_out = (const float*)d_in[15]; p.peer_wq = (const float*)d_in[16]; p.peer_sub_keys = (const float*)d_in[17]; p.peer_down = (const float*)d_in[18]; p.peer_up = (const float*)d_in[19];
    p.out = (float*)d_out; p.ws = (char*)d_ws;
    void* args[] = {&p};
    hipError_t e = hipLaunchCooperativeKernel((const void*)hybrid_fwd, dim3(grid_blocks), dim3(512), args, LDS_BYTES, stream);
    if (e != hipSuccess) fprintf(stderr, "kernel_launch: cooperative launch failed: %s (grid %d)\n", hipGetErrorString(e), grid_blocks);
}
```

```cpp
#include <hip/hip_runtime.h>
#include <cstdio>
#include <cstdint>
#include <hip/hip_cooperative_groups.h>
namespace cg = cooperative_groups;


namespace op {
#define DI __device__ __forceinline__
typedef unsigned short bf16_t;
typedef short bf16x8 __attribute__((ext_vector_type(8)));
typedef float f32x16 __attribute__((ext_vector_type(16)));
typedef float f32x2 __attribute__((ext_vector_type(2)));
typedef unsigned u32x4 __attribute__((ext_vector_type(4)));
typedef unsigned u32x2 __attribute__((ext_vector_type(2)));
typedef __bf16 bf16v2 __attribute__((ext_vector_type(2)));
constexpr int D = 1024, NB = 8, S = 4096, DEPTH = 4, T = NB * S, NTILE = T / 128;
constexpr float EPS = 1e-6f;
constexpr int PL_SEID = 0, PL_SWGT = 32768, PL_END = 98304, PL_RIDX = 98304;
constexpr int LDS_EPI = 32768, LDS_SSQ = 102400, LDS_RSTD1 = 110592, LDS_BIAS = 128 * 1024, LDS_BYTES = 132 * 1024;
constexpr int REP_GEMM = 1, REP_ROUTE = 1, REP_MIX = 1, REP_NORM = 1, REP_P0 = 1;
#define MFMA32(a, b, c) __builtin_amdgcn_mfma_f32_32x32x16_bf16((a), (b), (c), 0, 0, 0)

DI unsigned pk2(float lo, float hi) { f32x2 v = {lo, hi}; return __builtin_bit_cast(unsigned, __builtin_convertvector(v, bf16v2)); }
DI int opaque_v(int x) { asm volatile("" : "+v"(x)); return x; }
DI int opaque_s(int x) { asm volatile("" : "+s"(x)); return x; }
DI int crow(int reg, int hh) { return (reg & 3) + 8 * (reg >> 2) + 4 * hh; }
template <int CTRL> DI float dppf(float v) { return __int_as_float(__builtin_amdgcn_update_dpp(0, __float_as_int(v), CTRL, 0xf, 0xf, true)); }
template <int CTRL> DI int dppi(int v) { return __builtin_amdgcn_update_dpp(0, v, CTRL, 0xf, 0xf, true); }
DI float red16_sum(float v) { v += dppf<0xB1>(v); v += dppf<0x4E>(v); v += dppf<0x141>(v); v += dppf<0x140>(v); return v; }
DI float red16_max(float v) { v = fmaxf(v, dppf<0xB1>(v)); v = fmaxf(v, dppf<0x4E>(v)); v = fmaxf(v, dppf<0x141>(v)); v = fmaxf(v, dppf<0x140>(v)); return v; }
DI float x16_sum(float v) { auto s = __builtin_amdgcn_permlane16_swap(__float_as_uint(v), __float_as_uint(v), false, false); return __uint_as_float(s[0]) + __uint_as_float(s[1]); }
DI float x32_sum(float v) { auto s = __builtin_amdgcn_permlane32_swap(__float_as_uint(v), __float_as_uint(v), false, false); return __uint_as_float(s[0]) + __uint_as_float(s[1]); }
DI float x16_max(float v) { auto s = __builtin_amdgcn_permlane16_swap(__float_as_uint(v), __float_as_uint(v), false, false); return fmaxf(__uint_as_float(s[0]), __uint_as_float(s[1])); }
DI float x32_max(float v) { auto s = __builtin_amdgcn_permlane32_swap(__float_as_uint(v), __float_as_uint(v), false, false); return fmaxf(__uint_as_float(s[0]), __uint_as_float(s[1])); }
DI float red32_sum(float v) { return x16_sum(red16_sum(v)); }
DI float wave_sum(float v) { return x32_sum(x16_sum(red16_sum(v))); }
DI float wave_max(float v) { return x32_max(x16_max(red16_max(v))); }

DI int col_perm(int npos, int mode) {
    if (mode == 1 && npos >= 1024 && npos < 1536) { const int q = npos - 1024, w = q >> 6, nb = (q >> 5) & 1, r = q & 31; return (nb ? 1280 : 1024) + 32 * w + r; }
    return npos;
}
DI void conv_wfrag_item(const float* __restrict__ W, int N, int KB, bf16_t* __restrict__ WF, int gid, int mode) {
    const int l = gid & 63, kb = (gid >> 6) % KB, nbt = (gid >> 6) / KB, r = l & 31, hh = l >> 5;
    const int n = col_perm(nbt * 32 + r, mode);
    const float* p = W + (size_t)(kb * 16 + 8 * hh) * N + n;
    float v[8];
#pragma unroll
    for (int j = 0; j < 8; ++j) v[j] = p[(size_t)j * N];
    u32x4 o; o.x = pk2(v[0], v[1]); o.y = pk2(v[2], v[3]); o.z = pk2(v[4], v[5]); o.w = pk2(v[6], v[7]);
    *(u32x4*)(WF + (size_t)gid * 8) = o;
}

DI void norm_to_frag(const float* __restrict__ x, const float* __restrict__ g, const float* __restrict__ sh, const float* __restrict__ sc, bf16_t* __restrict__ hA, float* rstd_lds, int tile, int tid, bool have_rstd) {
    tid = opaque_v(tid); tile = opaque_s(tile);
    const int w = tid >> 6, lane = tid & 63;
    float cg[16], cs[16], ch[16];
#pragma unroll
    for (int j = 0; j < 2; ++j)
#pragma unroll
        for (int q = 0; q < 2; ++q) {
            const int c = 512 * j + 8 * lane + 4 * q;
            const float4 a = *(const float4*)(g + c), b = *(const float4*)(sc + c), d = *(const float4*)(sh + c);
            cg[8 * j + 4 * q] = a.x * (1.f + b.x); cg[8 * j + 4 * q + 1] = a.y * (1.f + b.y); cg[8 * j + 4 * q + 2] = a.z * (1.f + b.z); cg[8 * j + 4 * q + 3] = a.w * (1.f + b.w);
            ch[8 * j + 4 * q] = d.x; ch[8 * j + 4 * q + 1] = d.y; ch[8 * j + 4 * q + 2] = d.z; ch[8 * j + 4 * q + 3] = d.w;
            cs[8 * j + 4 * q] = 0.f; cs[8 * j + 4 * q + 1] = 0.f; cs[8 * j + 4 * q + 2] = 0.f; cs[8 * j + 4 * q + 3] = 0.f;
        }
    (void)cs;
#pragma unroll 8
    for (int rr = 0; rr < 16; ++rr) {
        const int row = w * 16 + rr;
        const float* xr = x + ((size_t)tile * 128 + row) * D + 8 * lane;
        float v[16];
#pragma unroll
        for (int j = 0; j < 2; ++j)
#pragma unroll
            for (int q = 0; q < 2; ++q) { const float4 a = *(const float4*)(xr + 512 * j + 4 * q); v[8 * j + 4 * q] = a.x; v[8 * j + 4 * q + 1] = a.y; v[8 * j + 4 * q + 2] = a.z; v[8 * j + 4 * q + 3] = a.w; }
        float r;
        if (have_rstd) r = rstd_lds[row];
        else {
            float ss = 0.f;
#pragma unroll
            for (int e = 0; e < 16; ++e) ss += v[e] * v[e];
            r = rsqrtf(wave_sum(ss) * (1.f / D) + EPS);
        }
        bf16_t* orow = hA + ((size_t)tile * 128 + row) * D + 8 * lane;
#pragma unroll
        for (int j = 0; j < 2; ++j) {
            u32x4 o;
            o.x = pk2(v[8 * j] * r * cg[8 * j] + ch[8 * j], v[8 * j + 1] * r * cg[8 * j + 1] + ch[8 * j + 1]);
            o.y = pk2(v[8 * j + 2] * r * cg[8 * j + 2] + ch[8 * j + 2], v[8 * j + 3] * r * cg[8 * j + 3] + ch[8 * j + 3]);
            o.z = pk2(v[8 * j + 4] * r * cg[8 * j + 4] + ch[8 * j + 4], v[8 * j + 5] * r * cg[8 * j + 5] + ch[8 * j + 5]);
            o.w = pk2(v[8 * j + 6] * r * cg[8 * j + 6] + ch[8 * j + 6], v[8 * j + 7] * r * cg[8 * j + 7] + ch[8 * j + 7]);
            *(u32x4*)(orow + 512 * j) = o;
        }
    }
}

template <int ORIENT>
DI void kloop(f32x16 (&acc)[4][2], const bf16_t* __restrict__ At, const bf16_t* __restrict__ W0, const bf16_t* __restrict__ W1, char* lds, int tid, int lane) {
    tid = opaque_v(tid); lane = opaque_v(lane);
#pragma unroll
    for (int mb = 0; mb < 4; ++mb)
#pragma unroll
        for (int nb = 0; nb < 2; ++nb)
#pragma unroll
            for (int i = 0; i < 16; ++i) acc[mb][nb][i] = 0.f;
    {
    const int c8_ = (tid >> 3) & 7, rowA_ = (tid >> 6) * 8 + (tid & 7);
    const unsigned aoff_ = (unsigned)(rowA_ * 1024 + c8_ * 8) * 2u;
    const char* AtB = (const char*)At;
    const char* AtB2 = (const char*)At + 131072;
#define AG0(KCH) (*(const u32x4*)(AtB + (size_t)((KCH) * 128) + aoff_))
#define AG1(KCH) (*(const u32x4*)(AtB2 + (size_t)((KCH) * 128) + aoff_))
    const int ldsA_ = ((((c8_ >> 1) * 4 + (rowA_ >> 5)) * 64) + (rowA_ & 31) + 32 * (c8_ & 1)) * 16;
    const unsigned woff_ = (unsigned)lane * 16u;
    typedef const __attribute__((address_space(1))) char* gcp_t;
    typedef const __attribute__((address_space(1))) u32x4* gvp_t;
    gcp_t W0s; gcp_t W1s;
    { const unsigned long long a0_ = (unsigned long long)W0, a1_ = (unsigned long long)W1;
      W0s = (gcp_t)(((unsigned long long)(unsigned)__builtin_amdgcn_readfirstlane((int)(unsigned)(a0_ >> 32)) << 32) | (unsigned)__builtin_amdgcn_readfirstlane((int)(unsigned)a0_));
      W1s = (gcp_t)(((unsigned long long)(unsigned)__builtin_amdgcn_readfirstlane((int)(unsigned)(a1_ >> 32)) << 32) | (unsigned)__builtin_amdgcn_readfirstlane((int)(unsigned)a1_)); }
#define WG0(SUB) (*(gvp_t)(W0s + (size_t)((SUB) * 1024) + woff_))
#define WG1(SUB) (*(gvp_t)(W1s + (size_t)((SUB) * 1024) + woff_))
    u32x4 wq[4][2], arA[2], arB[2];
    arA[0] = AG0(0); arA[1] = AG1(0); arB[0] = AG0(1); arB[1] = AG1(1);
#pragma unroll
    for (int kk = 0; kk < 4; ++kk) { wq[kk][0] = WG0(kk); wq[kk][1] = WG1(kk); }
    char* b0 = lds; char* b1 = lds + 16384; char* b2 = lds + 32768;
    *(u32x4*)(b0 + ldsA_) = arA[0]; *(u32x4*)(b0 + ldsA_ + 2048) = arA[1];
    *(u32x4*)(b1 + ldsA_) = arB[0]; *(u32x4*)(b1 + ldsA_ + 2048) = arB[1];
    arA[0] = AG0(2); arA[1] = AG1(2); arB[0] = AG0(3); arB[1] = AG1(3);
    __syncthreads();
    bf16x8 afr[2][4];
#pragma unroll
    for (int mb = 0; mb < 4; ++mb) afr[0][mb] = *(const bf16x8*)(b0 + ((0 * 4 + mb) * 64 + lane) * 16);
#define KL_ITER(KC, ARS) do { \
        const int kn = (KC) < 15 ? (KC) + 1 : 15, k4 = (KC) < 12 ? (KC) + 4 : 15; \
        unsigned long long wa0_ = (unsigned long long)W0s + (unsigned long long)(kn * 4096), wa1_ = (unsigned long long)W1s + (unsigned long long)(kn * 4096); \
        asm volatile("" : "+s"(wa0_), "+s"(wa1_));        \
        _Pragma("unroll") for (int kk = 0; kk < 4; ++kk) { \
            if (kk < 3) { _Pragma("unroll") for (int mb = 0; mb < 4; ++mb) afr[(kk + 1) & 1][mb] = *(const bf16x8*)(b0 + (((kk + 1) * 4 + mb) * 64 + lane) * 16); } \
            else { _Pragma("unroll") for (int mb = 0; mb < 4; ++mb) afr[0][mb] = *(const bf16x8*)(b1 + ((0 * 4 + mb) * 64 + lane) * 16); }        \
            __builtin_amdgcn_sched_barrier(0);         \
            _Pragma("unroll") for (int mb = 0; mb < 4; ++mb) \
                _Pragma("unroll") for (int nb = 0; nb < 2; ++nb) { \
                    const bf16x8 wf = __builtin_bit_cast(bf16x8, wq[kk][nb]); \
                    if (ORIENT == 0) acc[mb][nb] = MFMA32(afr[kk & 1][mb], wf, acc[mb][nb]); \
                    else acc[mb][nb] = MFMA32(wf, afr[kk & 1][mb], acc[mb][nb]); \
                } \
            if ((KC) < 15) { wq[kk][0] = *(gvp_t)((gcp_t)wa0_ + (size_t)(kk * 1024) + woff_); wq[kk][1] = *(gvp_t)((gcp_t)wa1_ + (size_t)(kk * 1024) + woff_); } \
            if (kk == 1) { \
                __syncthreads(); \
                if ((KC) < 14) { *(u32x4*)(b2 + ldsA_) = ARS[0]; *(u32x4*)(b2 + ldsA_ + 2048) = ARS[1]; } \
                if ((KC) < 12) { ARS[0] = AG0(k4); ARS[1] = AG1(k4); } \
            } \
            __builtin_amdgcn_sched_barrier(0); \
        } \
        { char* t_ = b0; b0 = b1; b1 = b2; b2 = t_; } \
    } while (0)
    for (int kc = 0; kc < 16; kc += 2) { KL_ITER(kc, arA); KL_ITER(kc + 1, arB); }
#undef KL_ITER
#undef AG0
#undef AG1
#undef WG0
#undef WG1
    __syncthreads();
    }
}

DI void epi_f32row(const f32x16 (&acc)[4][2], float* __restrict__ C, int tile, int col0, int lane) {
    lane = opaque_v(lane);
    const int r5 = lane & 31, hh = lane >> 5;
    const unsigned boff = (unsigned)((tile * 128 + 4 * hh) * 2048 + col0 + r5);
#pragma unroll
    for (int mb = 0; mb < 4; ++mb)
#pragma unroll
        for (int nb = 0; nb < 2; ++nb)
#pragma unroll
            for (int i = 0; i < 16; ++i)
                C[boff + (unsigned)((mb * 32 + (i & 3) + 8 * (i >> 2)) * 2048 + nb * 32)] = acc[mb][nb][i];
}
DI void epi_resid(const f32x16 (&acc)[4][2], const float* __restrict__ xin, float* __restrict__ xout, const float* __restrict__ gate_b, float* T  , float* ssq  , int tile, int col0, int lane) {
    lane = opaque_v(lane);
    const int r5 = lane & 31, hh = lane >> 5, rq = lane >> 4, c4 = (lane & 15) * 4;
    const float4 gv = *(const float4*)(gate_b + col0 + c4);
#pragma unroll
    for (int mb = 0; mb < 4; ++mb) {
#pragma unroll
        for (int nb = 0; nb < 2; ++nb)
#pragma unroll
            for (int i = 0; i < 16; ++i) T[((i & 3) + 8 * (i >> 2) + 4 * hh) * 68 + nb * 32 + r5] = acc[mb][nb][i];
        asm volatile("s_waitcnt lgkmcnt(0)" ::: "memory");
#pragma unroll
        for (int j = 0; j < 8; ++j) {
            const int row = rq + 4 * j;
            const float4 v = *(const float4*)(T + row * 68 + c4);
            const unsigned o = (unsigned)((tile * 128 + mb * 32 + row) * D + col0 + c4);
            float4 xv = *(const float4*)(xin + o);
            xv.x += gv.x * v.x; xv.y += gv.y * v.y; xv.z += gv.z * v.z; xv.w += gv.w * v.w;
            *(float4*)(xout + o) = xv;
            float ss = xv.x * xv.x + xv.y * xv.y + xv.z * xv.z + xv.w * xv.w;
            ss = red16_sum(ss);
            if ((lane & 15) == 0) ssq[mb * 32 + row] = ss;
        }
        asm volatile("s_waitcnt lgkmcnt(0)" ::: "memory");
    }
}

DI void epi_qpf(const f32x16 (&acc)[4][2], bf16_t* __restrict__ QPF, int tile, int ft0, int lane) {
    lane = opaque_v(lane);
#pragma unroll
    for (int nb = 0; nb < 2; ++nb)
#pragma unroll
        for (int s = 0; s < 2; ++s)
#pragma unroll
            for (int mb = 0; mb < 4; ++mb) {
                const f32x16& a = acc[mb][nb];
                u32x4 o; o.x = pk2(a[8 * s], a[8 * s + 1]); o.y = pk2(a[8 * s + 2], a[8 * s + 3]); o.z = pk2(a[8 * s + 4], a[8 * s + 5]); o.w = pk2(a[8 * s + 6], a[8 * s + 7]);
                *(u32x4*)(QPF + ((unsigned)((((tile * 64 + ft0 + nb) * 2 + s) * 4 + mb) * 64 + lane)) * 8) = o;
            }
}

DI void conv_keys_item(const float* __restrict__ K, bf16_t* __restrict__ KF, int gid) {
    const int lane = gid & 63, s = (gid >> 6) & 1, nbl = (gid >> 7) & 3, nt = (gid >> 9) & 3, hp = gid >> 11;
    const int r = lane & 31, hh = lane >> 5;
    const float* p = K + ((size_t)hp * 128 + nt * 32 + r) * 128 + nbl * 32 + 16 * s + 4 * hh;
    const float4 a = *(const float4*)p, b = *(const float4*)(p + 8);
    u32x4 o; o.x = pk2(a.x, a.y); o.y = pk2(a.z, a.w); o.z = pk2(b.x, b.y); o.w = pk2(b.z, b.w);
    *(u32x4*)(KF + (size_t)gid * 8) = o;
}

DI void conv_table_row(const float* __restrict__ src, unsigned char* __restrict__ dst, float* __restrict__ sc, int lane, bool as_int4) {
    const float4* p = (const float4*)src + lane * 4;
    float4 v[4];
    float m = 0.f;
#pragma unroll
    for (int j = 0; j < 4; ++j) { v[j] = p[j]; m = fmaxf(m, fmaxf(fmaxf(fabsf(v[j].x), fabsf(v[j].y)), fmaxf(fabsf(v[j].z), fabsf(v[j].w)))); }
    m = wave_max(m);
    float scale = m > 0.f ? m * (1.f / 6.f) : 1.f;
    if (as_int4) {
        float ss = 0.f;
#pragma unroll
        for (int j = 0; j < 4; ++j) ss += v[j].x * v[j].x + v[j].y * v[j].y + v[j].z * v[j].z + v[j].w * v[j].w;
        ss = wave_sum(ss);
        const float sg = sqrtf(ss * (1.f / 1024.f));
        scale = fmaxf(sg * (1.f / 2.8f), m * (1.f / 16.f));
        if (!(scale > 0.f)) scale = 1.f;
    }
    const float inv = 1.f / scale;
    u32x2 o;
    unsigned* op = (unsigned*)&o;
#pragma unroll
    for (int j = 0; j < 2; ++j) {
        const float f[8] = {v[2 * j].x, v[2 * j].y, v[2 * j].z, v[2 * j].w, v[2 * j + 1].x, v[2 * j + 1].y, v[2 * j + 1].z, v[2 * j + 1].w};
        unsigned wv = 0;
        if (as_int4) {
#pragma unroll
            for (int e = 0; e < 8; ++e) { int q = __float2int_rn(f[e] * inv); q = q < -7 ? -7 : (q > 7 ? 7 : q); wv |= ((unsigned)q & 15u) << (4 * e); }
        } else {
            wv = __builtin_amdgcn_cvt_scalef32_pk_fp4_f32(wv, f[0] * inv, f[1] * inv, 1.0f, 0);
            wv = __builtin_amdgcn_cvt_scalef32_pk_fp4_f32(wv, f[2] * inv, f[3] * inv, 1.0f, 1);
            wv = __builtin_amdgcn_cvt_scalef32_pk_fp4_f32(wv, f[4] * inv, f[5] * inv, 1.0f, 2);
            wv = __builtin_amdgcn_cvt_scalef32_pk_fp4_f32(wv, f[6] * inv, f[7] * inv, 1.0f, 3);
        }
        op[j] = wv;
    }
    *(u32x2*)(dst + lane * 8) = o;
    if (lane == 0) *sc = scale;
}

DI void ce_desc(int& a, int& b) { const int mx = a > b ? a : b, mn = a > b ? b : a; a = mx; b = mn; }
DI void sort16_desc(int (&v)[16]) {
#pragma unroll
    for (int k = 2; k <= 16; k <<= 1)
#pragma unroll
        for (int j = k >> 1; j > 0; j >>= 1)
#pragma unroll
            for (int i = 0; i < 16; ++i) {
                const int l = i ^ j;
                if (l > i) { if ((i & k) == 0) ce_desc(v[i], v[l]); else ce_desc(v[l], v[i]); }
            }
}
DI void bitonic_merge16_desc(int (&v)[16]) {
#pragma unroll
    for (int j = 8; j > 0; j >>= 1)
#pragma unroll
        for (int i = 0; i < 16; ++i) { const int l = i ^ j; if (l > i) ce_desc(v[i], v[l]); }
}
DI void merge_top16(int (&a)[16], const int (&b)[16]) {
#pragma unroll
    for (int i = 0; i < 16; ++i) a[i] = a[i] > b[15 - i] ? a[i] : b[15 - i];
    bitonic_merge16_desc(a);
}
DI int f2ord(float f) { int b = __float_as_int(f); return b ^ ((b >> 31) & 0x7fffffff); }
DI float ord2f(int k) { return __int_as_float(k ^ ((k >> 31) & 0x7fffffff)); }

DI void route_tile(const bf16_t* __restrict__ QPF, const bf16_t* __restrict__ KF, char* lds_lists, unsigned char* lds_idx  , int tile, int tid) {
    tid = opaque_v(tid); tile = opaque_s(tile);
    const int lane = tid & 63, w = __builtin_amdgcn_readfirstlane(tid >> 6);
    const int r5 = lane & 31, hh = lane >> 5;
    unsigned char* myidx = lds_idx + w * 1024;
    for (int task = w; task < 32; task += 8) {
        const int h = task >> 2, tt = task & 3;
        f32x16 acc[2][4];
#pragma unroll
        for (int p = 0; p < 2; ++p)
#pragma unroll
            for (int nt = 0; nt < 4; ++nt)
#pragma unroll
                for (int i = 0; i < 16; ++i) acc[p][nt][i] = 0.f;
        {
            bf16x8 bq[3], ak[3][4];
#define ROUTE_LOAD(buf, step) do { const int p_ = (step) >> 3, ks_ = (step) & 7; \
                bq[buf] = *(const bf16x8*)(QPF + ((unsigned)((((tile * 64 + h * 8 + p_ * 4 + (ks_ >> 1)) * 2 + (ks_ & 1)) * 4 + tt) * 64 + lane)) * 8); \
                _Pragma("unroll") for (int nt = 0; nt < 4; ++nt) ak[buf][nt] = *(const bf16x8*)(KF + ((unsigned)(((((h * 2 + p_) * 4 + nt) * 8 + ks_) * 64) + lane)) * 8); } while (0)
            ROUTE_LOAD(0, 0);
            ROUTE_LOAD(1, 1);
#pragma unroll
            for (int step = 0; step < 16; ++step) {
                if (step < 14) ROUTE_LOAD((step + 2) % 3, step + 2);
#pragma unroll
                for (int nt = 0; nt < 4; ++nt) acc[step >> 3][nt] = MFMA32(ak[step % 3][nt], bq[step % 3], acc[step >> 3][nt]);
                __builtin_amdgcn_sched_barrier(0);
            }
#undef ROUTE_LOAD
        }
        int g[8][16];
#pragma unroll
        for (int nt = 0; nt < 4; ++nt)
#pragma unroll
            for (int i = 0; i < 16; ++i) {
                const unsigned a = __float_as_uint(acc[0][nt][i]), b = __float_as_uint(acc[1][nt][i]);
                auto sw = __builtin_amdgcn_permlane32_swap(a, b, false, false);
                const int n0 = nt * 32 + (i & 3) + 8 * (i >> 2);
                g[nt * 2 + (i >> 3)][i & 7] = (f2ord(__uint_as_float(sw[0])) & ~127) | n0;
                g[nt * 2 + (i >> 3)][8 + (i & 7)] = (f2ord(__uint_as_float(sw[1])) & ~127) | (n0 + 4);
            }
#pragma unroll
        for (int q = 0; q < 8; ++q) sort16_desc(g[q]);
        merge_top16(g[0], g[1]); merge_top16(g[2], g[3]); merge_top16(g[4], g[5]); merge_top16(g[6], g[7]);
        merge_top16(g[0], g[2]); merge_top16(g[4], g[6]);
        merge_top16(g[0], g[4]);
        {
            u32x4 pk;
            unsigned* pp = (unsigned*)&pk;
#pragma unroll
            for (int q = 0; q < 4; ++q) pp[q] = (unsigned)(g[0][4 * q] & 127) | ((unsigned)(g[0][4 * q + 1] & 127) << 8) | ((unsigned)(g[0][4 * q + 2] & 127) << 16) | ((unsigned)(g[0][4 * q + 3] & 127) << 24);
            *(u32x4*)(myidx + lane * 16) = pk;
        }
        float f0[16], f1[16];
#pragma unroll
        for (int i = 0; i < 16; ++i) {
            const unsigned a = (unsigned)g[0][i], b = a;
            auto sw = __builtin_amdgcn_permlane32_swap(a, b, false, false);
            f0[i] = ord2f((int)sw[0] & ~127); f1[i] = ord2f((int)sw[1] & ~127);
        }
        int c0[16], c1[16], c2[16], c3[16];
#pragma unroll
        for (int j = 0; j < 16; ++j) c0[j] = (f2ord(f0[0] + f1[j]) & ~255) | j;
#pragma unroll
        for (int i = 1; i < 16; ++i) c1[i - 1] = (f2ord(f0[i] + f1[0]) & ~255) | (i << 4);
        c1[15] = (int)0x80000000;
#define CK(i, j) ((f2ord(f0[i] + f1[j]) & ~255) | ((i) << 4) | (j))
        c2[0] = CK(1, 1); c2[1] = CK(1, 2); c2[2] = CK(1, 3); c2[3] = CK(1, 4); c2[4] = CK(1, 5); c2[5] = CK(1, 6); c2[6] = CK(1, 7);
        c2[7] = CK(2, 1); c2[8] = CK(2, 2); c2[9] = CK(2, 3); c2[10] = CK(2, 4);
        c2[11] = CK(3, 1); c2[12] = CK(3, 2); c2[13] = CK(3, 3);
        c2[14] = CK(4, 1); c2[15] = CK(4, 2);
        c3[0] = CK(5, 1); c3[1] = CK(6, 1); c3[2] = CK(7, 1);
#undef CK
#pragma unroll
        for (int q = 3; q < 16; ++q) c3[q] = (int)0x80000000;
        sort16_desc(c2);
        ce_desc(c3[0], c3[1]); ce_desc(c3[1], c3[2]); ce_desc(c3[0], c3[1]);
        merge_top16(c0, c1); merge_top16(c2, c3); merge_top16(c0, c2);
        float bs[16], den = 0.f;
#pragma unroll
        for (int i = 0; i < 16; ++i) { bs[i] = __expf(ord2f(c0[i] & ~255) - ord2f(c0[0] & ~255)); den += bs[i]; }
        const float rden = 1.f / den;
        asm volatile("s_waitcnt lgkmcnt(0)" ::: "memory");
#pragma unroll
        for (int q = 0; q < 8; ++q) {
            const int key = (int)__builtin_amdgcn_permlane32_swap((unsigned)c0[q], (unsigned)c0[8 + q], false, false)[0];
            const float gv = __uint_as_float(__builtin_amdgcn_permlane32_swap(__float_as_uint(bs[q]), __float_as_uint(bs[8 + q]), false, false)[0]) * rden;
            const int i = (key >> 4) & 15, j = key & 15;
            const int e = (int)myidx[r5 * 16 + i] * 128 + (int)myidx[(32 + r5) * 16 + j];
            const int tokl = tt * 32 + r5;
            ((unsigned short*)(lds_lists + PL_SEID))[tokl * 128 + h * 16 + 8 * hh + q] = (unsigned short)e;
            ((float*)(lds_lists + PL_SWGT))[tokl * 128 + h * 16 + 8 * hh + q] = gv;
        }
        asm volatile("s_waitcnt lgkmcnt(0)" ::: "memory");
    }
}

DI void unpack_h2(const bf16_t* __restrict__ hA, int t, int lane, f32x2 (&hv)[8]) {
    const int tile = t >> 7, row = t & 127, mb = row >> 5, r5 = row & 31;
    const bf16_t* hp = hA + ((unsigned)(((tile * 64 + lane) * 4 + mb) * 64 + r5)) * 8;
    const u32x4 ha = *(const u32x4*)hp, hb = *(const u32x4*)(hp + 32 * 8);
    const unsigned hw[8] = {ha.x, ha.y, ha.z, ha.w, hb.x, hb.y, hb.z, hb.w};
#pragma unroll
    for (int q = 0; q < 8; ++q) { hv[q].x = __uint_as_float(hw[q] << 16); hv[q].y = __uint_as_float(hw[q] & 0xffff0000u); }
}
typedef _Float16 h16x2 __attribute__((ext_vector_type(2)));
DI h16x2 fp4h(unsigned w, int sel) {
    return sel == 0 ? __builtin_amdgcn_cvt_scalef32_pk_f16_fp4(w, 1.0f, 0) : sel == 1 ? __builtin_amdgcn_cvt_scalef32_pk_f16_fp4(w, 1.0f, 1)
         : sel == 2 ? __builtin_amdgcn_cvt_scalef32_pk_f16_fp4(w, 1.0f, 2) : __builtin_amdgcn_cvt_scalef32_pk_f16_fp4(w, 1.0f, 3);
}
DI unsigned rowoff_lo(unsigned pr, unsigned k512, unsigned lane8) { unsigned r; asm("v_mad_u32_u16 %0, %1, %2, %3" : "=v"(r) : "v"(pr), "s"(k512), "v"(lane8)); return r; }
DI unsigned rowoff_hi(unsigned pr, unsigned k512, unsigned lane8) { unsigned r; asm("v_mad_u32_u16 %0, %1, %2, %3 op_sel:[1,0,0,0]" : "=v"(r) : "v"(pr), "s"(k512), "v"(lane8)); return r; }
DI int dot8z(int a, int b) { int r; asm("v_dot8_i32_i4 %0, %1, %2, 0" : "=v"(r) : "v"(a), "v"(b)); return r; }
DI void stage_token(const int* __restrict__ ridx, const float* __restrict__ rgate, char* lds, int t, int tloc, int lane) {
    lane = opaque_v(lane); t = opaque_s(t);
    unsigned short* seid = (unsigned short*)(lds + PL_SEID) + tloc * 128;
    float* swgt = (float*)(lds + PL_SWGT) + tloc * 128;
    seid[lane] = (unsigned short)ridx[(unsigned)(t * 128 + lane)]; seid[64 + lane] = (unsigned short)ridx[(unsigned)(t * 128 + 64 + lane)];
    swgt[lane] = rgate[(unsigned)(t * 128 + lane)]; swgt[64 + lane] = rgate[(unsigned)(t * 128 + 64 + lane)];
}
DI void peer_down_wave(const bf16_t* __restrict__ hA, char* lds, const unsigned char* __restrict__ TBd, const float* __restrict__ SC, int tile, int w, int lane) {
    lane = opaque_v(lane);
    const int half = lane >> 5;
    const unsigned lane16 = (unsigned)(lane & 31) * 16u;
    const int cb = (lane & 31) * 32 + half * 16;
    const int myu = 2 * (((lane >> 4) & 1) * 4 + ((lane >> 3) & 1) * 2 + ((lane >> 2) & 1)) + half;
    const unsigned short* seid = (const unsigned short*)(lds + PL_SEID) + w * 16 * 128;
    float* swgt = (float*)(lds + PL_SWGT) + w * 16 * 128;
    u32x4 haN, hbN;
    { const bf16_t* hp0 = hA + (unsigned)((tile * 128 + w * 16) * 1024 + cb); haN = *(const u32x4*)hp0; hbN = *(const u32x4*)(hp0 + 8); }
    u32x4 R[2][8];
    unsigned IDN[8];
#define DOWN_IDS(P_) do { _Pragma("unroll") for (int u_ = 0; u_ < 8; ++u_) IDN[u_] = seid[(P_) + 2 * u_ + half]; } while (0)
#define DOWN_LOADS(buf) do { _Pragma("unroll") for (int u_ = 0; u_ < 8; ++u_) R[buf][u_] = *(const u32x4*)(TBd + (IDN[u_] * 512u + lane16)); } while (0)
    DOWN_IDS(0); DOWN_LOADS(0); DOWN_IDS(16);
#pragma unroll 1
    for (int tl = 0; tl < 16; ++tl) {
        const int t = tile * 128 + w * 16 + tl;
        float* gp = swgt + tl * 128;
        const u32x4 ha = haN, hb = hbN;
        const int tn = tl < 15 ? tl + 1 : tl;
        const int pa_ = tl * 128 + (lane & 3) * 32 + myu;
        const f32x2 scA = *(const f32x2*)(SC + (unsigned)seid[pa_] * 2u), scB = *(const f32x2*)(SC + (unsigned)seid[pa_ + 16] * 2u);
        int rs[8];
        { const bf16_t* hp = hA + (unsigned)((t - tl + tn) * 1024 + cb); haN = *(const u32x4*)hp; hbN = *(const u32x4*)(hp + 8); }
        unsigned hhi[4], hlo[4];
        float hscale;
        {
            const unsigned hw[8] = {ha.x, ha.y, ha.z, ha.w, hb.x, hb.y, hb.z, hb.w};
            float hf[16];
            float m = 0.f;
#pragma unroll
            for (int q = 0; q < 8; ++q) { hf[2 * q] = __uint_as_float(hw[q] << 16); hf[2 * q + 1] = __uint_as_float(hw[q] & 0xffff0000u); m = fmaxf(m, fmaxf(fabsf(hf[2 * q]), fabsf(hf[2 * q + 1]))); }
            m = wave_max(m);
            hscale = m > 0.f ? m * (1.f / 119.f) : 1.f;
            const float inv = 1.f / hscale;
            unsigned qh[2] = {0u, 0u}, ql[2] = {0u, 0u};
#pragma unroll
            for (int e = 0; e < 16; ++e) {
                const int hq = __float2int_rn(hf[e] * inv);
                const int lo = ((hq + 8) & 15) - 8, hi = (hq - lo) >> 4;
                ql[e >> 3] |= ((unsigned)lo & 15u) << (4 * (e & 7));
                qh[e >> 3] |= ((unsigned)hi & 15u) << (4 * (e & 7));
            }
#pragma unroll
            for (int q = 0; q < 2; ++q) {
                auto sh_ = __builtin_amdgcn_permlane32_swap(qh[q], qh[q], false, false); hhi[q] = sh_[0]; hhi[2 + q] = sh_[1];
                auto sl_ = __builtin_amdgcn_permlane32_swap(ql[q], ql[q], false, false); hlo[q] = sl_[0]; hlo[2 + q] = sl_[1];
            }
        }
#pragma unroll
        for (int bt = 0; bt < 8; ++bt) {
            const int cur = bt & 1, nxt = cur ^ 1;
            const int p2 = bt < 6 ? tl * 128 + (bt + 2) * 16 : tn * 128 + (bt - 6) * 16;
            DOWN_LOADS(nxt);
            DOWN_IDS(p2);
            __builtin_amdgcn_sched_barrier(0);
            int part[8];
#pragma unroll
            for (int u = 0; u < 8; ++u) {
                const int r0_ = (int)R[cur][u].x, r1_ = (int)R[cur][u].y, r2_ = (int)R[cur][u].z, r3_ = (int)R[cur][u].w;
                int shi = dot8z(r0_, (int)hhi[0]);
                shi = __builtin_amdgcn_sdot8(r1_, (int)hhi[1], shi, false);
                shi = __builtin_amdgcn_sdot8(r2_, (int)hhi[2], shi, false);
                shi = __builtin_amdgcn_sdot8(r3_, (int)hhi[3], shi, false);
                int p_ = shi << 4;
                p_ = __builtin_amdgcn_sdot8(r0_, (int)hlo[0], p_, false);
                p_ = __builtin_amdgcn_sdot8(r1_, (int)hlo[1], p_, false);
                p_ = __builtin_amdgcn_sdot8(r2_, (int)hlo[2], p_, false);
                part[u] = __builtin_amdgcn_sdot8(r3_, (int)hlo[3], p_, false);
            }
            int r4[4], r2[2], r1;
            {
                const bool b3 = (lane & 8) != 0, b2 = (lane & 4) != 0;
#pragma unroll
                for (int q = 0; q < 4; ++q) { auto sw = __builtin_amdgcn_permlane16_swap((unsigned)part[q], (unsigned)part[q + 4], false, false); r4[q] = (int)sw[0] + (int)sw[1]; }
#pragma unroll
                for (int q = 0; q < 2; ++q) { const int keep = b3 ? r4[q + 2] : r4[q], give = b3 ? r4[q] : r4[q + 2]; r2[q] = keep + dppi<0x128>(give); }
                { const int keep = b2 ? r2[1] : r2[0], give = b2 ? r2[0] : r2[1]; r1 = keep + dppi<0x141>(give); }
                r1 += dppi<0x4E>(r1); r1 += dppi<0xB1>(r1);
            }
            rs[bt] = r1;
        }
        {
            const int j_ = lane & 3;
            const int ra = j_ == 0 ? rs[0] : j_ == 1 ? rs[2] : j_ == 2 ? rs[4] : rs[6];
            const int rb = j_ == 0 ? rs[1] : j_ == 1 ? rs[3] : j_ == 2 ? rs[5] : rs[7];
            float* gq = gp + j_ * 32 + myu;
            const float a0 = (float)ra * (scA.x * hscale), a1 = (float)rb * (scB.x * hscale);
            const float w0 = gq[0] * (0.5f * a0 * (1.f + erff(a0 * 0.70710678118654752f))) * scA.y;
            const float w1 = gq[16] * (0.5f * a1 * (1.f + erff(a1 * 0.70710678118654752f))) * scB.y;
            ((unsigned*)gq)[0] = (unsigned)__builtin_bit_cast(unsigned short, (_Float16)w0);
            ((unsigned*)gq)[16] = (unsigned)__builtin_bit_cast(unsigned short, (_Float16)w1);
        }
    }
#undef DOWN_IDS
#undef DOWN_LOADS
}
DI void peer_up_wave(char* lds, const unsigned char* __restrict__ TBu, const float* __restrict__ g2b, float* __restrict__ x, int tile, int w, int lane,
                     bf16_t* __restrict__ hAn, const float* __restrict__ g1n, const float* __restrict__ sh1n, const float* __restrict__ sc1n) {
    lane = opaque_v(lane);
    const int half = lane >> 5;
    const unsigned lane16 = (unsigned)(lane & 31) * 16u;
    const int cb = (lane & 31) * 32 + half * 16;
    const unsigned short* seid = (const unsigned short*)(lds + PL_SEID) + w * 16 * 128 + half;
    const unsigned* swgt = (const unsigned*)(lds + PL_SWGT) + w * 16 * 128 + half;
    u32x4 RA[8], RB[8];
    unsigned IDN[8], WA[8], WB[8];
#define UP_IDS(P_) do { _Pragma("unroll") for (int u_ = 0; u_ < 8; ++u_) IDN[u_] = seid[(P_) + 2 * u_]; } while (0)
#define UP_WTS(W, P_) do { _Pragma("unroll") for (int u_ = 0; u_ < 8; ++u_) W[u_] = swgt[(P_) + 2 * u_]; } while (0)
#define UP_LOADS(R) do { _Pragma("unroll") for (int u_ = 0; u_ < 8; ++u_) R[u_] = *(const u32x4*)(TBu + (IDN[u_] * 512u + lane16)); } while (0)
#define UP_COMPUTE(R, W) do { _Pragma("unroll") for (int u_ = 0; u_ < 8; ++u_) { \
        const unsigned wd_ = W[u_]; const h16x2 wp_ = __builtin_bit_cast(h16x2, wd_); const h16x2 w2_ = (h16x2){wp_.x, wp_.x}; \
        const unsigned r0_ = R[u_].x, r1_ = R[u_].y, r2_ = R[u_].z, r3_ = R[u_].w; \
        _Pragma("unroll") for (int q_ = 0; q_ < 4; ++q_) { acc[q_] = __builtin_elementwise_fma(w2_, fp4h(r0_, q_), acc[q_]); acc[4 + q_] = __builtin_elementwise_fma(w2_, fp4h(r1_, q_), acc[4 + q_]); \
            acc[8 + q_] = __builtin_elementwise_fma(w2_, fp4h(r2_, q_), acc[8 + q_]); acc[12 + q_] = __builtin_elementwise_fma(w2_, fp4h(r3_, q_), acc[12 + q_]); } } } while (0)
    UP_IDS(0); UP_LOADS(RA); UP_IDS(16); UP_WTS(WA, 0);
    float4 gv[4];
#pragma unroll
    for (int q = 0; q < 4; ++q) gv[q] = ((const float4*)(g2b + cb))[q];
    float4 cg[4], ch[4];
#pragma unroll
    for (int q = 0; q < 4; ++q) {
        cg[q] = (float4){0.f, 0.f, 0.f, 0.f}; ch[q] = cg[q];
        if (hAn) { const float4 a = ((const float4*)(g1n + cb))[q], b = ((const float4*)(sc1n + cb))[q]; ch[q] = ((const float4*)(sh1n + cb))[q];
                   cg[q].x = a.x * (1.f + b.x); cg[q].y = a.y * (1.f + b.y); cg[q].z = a.z * (1.f + b.z); cg[q].w = a.w * (1.f + b.w); }
    }
#pragma unroll 1
    for (int tk = 0; tk < 16; ++tk) {
        const int tn = tk < 15 ? tk + 1 : 15;
        float4* xp = (float4*)(x + (size_t)(unsigned)((tile * 128 + w * 16 + tk) * D + cb));
        float4 xv[4];
#pragma unroll
        for (int q = 0; q < 4; ++q) xv[q] = xp[q];
        h16x2 acc[16];
#pragma unroll
        for (int q = 0; q < 16; ++q) acc[q] = (h16x2){(_Float16)0.f, (_Float16)0.f};
#pragma unroll 1
        for (int i = 0; i < 4; ++i) {
            const int pa = tk * 128 + i * 32;
            const int pn = i < 3 ? pa + 32 : tn * 128;
            UP_LOADS(RB); UP_WTS(WB, pa + 16); UP_IDS(pn);
            __builtin_amdgcn_sched_barrier(0);
            UP_COMPUTE(RA, WA);
            UP_LOADS(RA); UP_WTS(WA, pn); UP_IDS(pn + 16);
            __builtin_amdgcn_sched_barrier(0);
            UP_COMPUTE(RB, WB);
        }
        h16x2 tot[8];
#pragma unroll
        for (int q = 0; q < 8; ++q) {
            const unsigned a_ = __builtin_bit_cast(unsigned, acc[q]), b_ = __builtin_bit_cast(unsigned, acc[q + 8]);
            auto sw = __builtin_amdgcn_permlane32_swap(a_, b_, false, false);
            const unsigned s0_ = sw[0], s1_ = sw[1];
            tot[q] = __builtin_bit_cast(h16x2, s0_) + __builtin_bit_cast(h16x2, s1_);
        }
        float ssx = 0.f;
#pragma unroll
        for (int q = 0; q < 4; ++q) {
            xv[q].x += gv[q].x * (float)tot[2 * q].x; xv[q].y += gv[q].y * (float)tot[2 * q].y; xv[q].z += gv[q].z * (float)tot[2 * q + 1].x; xv[q].w += gv[q].w * (float)tot[2 * q + 1].y;
            xp[q] = xv[q];
            ssx += xv[q].x * xv[q].x + xv[q].y * xv[q].y + xv[q].z * xv[q].z + xv[q].w * xv[q].w;
        }
        ssx = wave_sum(ssx);
        if (hAn) {
            const float rs = rsqrtf(ssx * (1.f / D) + EPS);
            bf16_t* orow = hAn + (size_t)(unsigned)((tile * 128 + w * 16 + tk) * D + cb);
#pragma unroll
            for (int j = 0; j < 2; ++j) {
                u32x4 o;
                o.x = pk2(xv[2 * j].x * rs * cg[2 * j].x + ch[2 * j].x, xv[2 * j].y * rs * cg[2 * j].y + ch[2 * j].y);
                o.y = pk2(xv[2 * j].z * rs * cg[2 * j].z + ch[2 * j].z, xv[2 * j].w * rs * cg[2 * j].w + ch[2 * j].w);
                o.z = pk2(xv[2 * j + 1].x * rs * cg[2 * j + 1].x + ch[2 * j + 1].x, xv[2 * j + 1].y * rs * cg[2 * j + 1].y + ch[2 * j + 1].y);
                o.w = pk2(xv[2 * j + 1].z * rs * cg[2 * j + 1].z + ch[2 * j + 1].z, xv[2 * j + 1].w * rs * cg[2 * j + 1].w + ch[2 * j + 1].w);
                *(u32x4*)(orow + 8 * j) = o;
            }
        }
    }
#undef UP_IDS
#undef UP_WTS
#undef UP_LOADS
#undef UP_COMPUTE
}

DI void epi_qk(f32x16 (&acc)[4][2], const float* __restrict__ gain, float scale, bf16_t* __restrict__ dst, int lane) {
    lane = opaque_v(lane);
    const int hh = lane >> 5;
    float gv[2][16];
#pragma unroll
    for (int nb = 0; nb < 2; ++nb)
#pragma unroll
        for (int i = 0; i < 16; ++i) gv[nb][i] = gain[nb * 32 + (i & 3) + 8 * (i >> 2) + 4 * hh] * scale;
#pragma unroll
    for (int mb = 0; mb < 4; ++mb) {
        float ss = 0.f;
#pragma unroll
        for (int nb = 0; nb < 2; ++nb)
#pragma unroll
            for (int i = 0; i < 16; ++i) ss += acc[mb][nb][i] * acc[mb][nb][i];
        ss = x32_sum(ss);
        const float r = rsqrtf(ss * (1.f / 64.f) + EPS);
#pragma unroll
        for (int nb = 0; nb < 2; ++nb)
#pragma unroll
            for (int s = 0; s < 2; ++s) {
                const f32x16& a = acc[mb][nb];
                u32x4 o;
                o.x = pk2(a[8 * s] * r * gv[nb][8 * s], a[8 * s + 1] * r * gv[nb][8 * s + 1]);
                o.y = pk2(a[8 * s + 2] * r * gv[nb][8 * s + 2], a[8 * s + 3] * r * gv[nb][8 * s + 3]);
                o.z = pk2(a[8 * s + 4] * r * gv[nb][8 * s + 4], a[8 * s + 5] * r * gv[nb][8 * s + 5]);
                o.w = pk2(a[8 * s + 6] * r * gv[nb][8 * s + 6], a[8 * s + 7] * r * gv[nb][8 * s + 7]);
                *(u32x4*)(dst + ((unsigned)(((nb * 2 + s) * 4 + mb) * 64 + lane)) * 8) = o;
            }
    }
}
DI void epi_v(const f32x16 (&acc)[4][2], bf16_t* __restrict__ dst, int lane) {
    lane = opaque_v(lane);
#pragma unroll
    for (int nb = 0; nb < 2; ++nb)
#pragma unroll
        for (int mb = 0; mb < 4; ++mb)
#pragma unroll
            for (int s = 0; s < 2; ++s) {
                const f32x16& a = acc[mb][nb];
                u32x4 o; o.x = pk2(a[8 * s], a[8 * s + 1]); o.y = pk2(a[8 * s + 2], a[8 * s + 3]); o.z = pk2(a[8 * s + 4], a[8 * s + 5]); o.w = pk2(a[8 * s + 6], a[8 * s + 7]);
                *(u32x4*)(dst + ((unsigned)(((nb * 4 + mb) * 2 + s) * 64 + lane)) * 8) = o;
            }
}
DI void epi_row(const f32x16 (&acc)[4][2], bf16_t* __restrict__ dst, int ld, int lane) {
    lane = opaque_v(lane);
    const int r5 = lane & 31, hh = lane >> 5;
#pragma unroll
    for (int mb = 0; mb < 4; ++mb)
#pragma unroll
        for (int nb = 0; nb < 2; ++nb)
#pragma unroll
            for (int gq = 0; gq < 4; gq += 2) {
                const f32x16& a = acc[mb][nb];
                const unsigned ax = pk2(a[4 * gq], a[4 * gq + 1]), ay = pk2(a[4 * gq + 2], a[4 * gq + 3]);
                const unsigned bx = pk2(a[4 * gq + 4], a[4 * gq + 5]), by = pk2(a[4 * gq + 6], a[4 * gq + 7]);
                auto sx = __builtin_amdgcn_permlane32_swap(ax, bx, false, false);
                auto sy = __builtin_amdgcn_permlane32_swap(ay, by, false, false);
                u32x4 o; o.x = sx[0]; o.y = sy[0]; o.z = sx[1]; o.w = sy[1];
                *(u32x4*)(dst + (unsigned)((mb * 32 + r5) * ld + nb * 32 + 8 * (gq + hh))) = o;
            }
}
DI void epi_z(const f32x16 (&acc)[4][2], bf16_t* __restrict__ dst, int lane) {
    lane = opaque_v(lane);
    const int r5 = lane & 31, hh = lane >> 5;
#pragma unroll
    for (int mb = 0; mb < 4; ++mb)
#pragma unroll
        for (int gq = 0; gq < 4; gq += 2) {
            const f32x16 &a = acc[mb][0], &b = acc[mb][1];
            const unsigned ax = pk2(a[4 * gq] * b[4 * gq], a[4 * gq + 1] * b[4 * gq + 1]), ay = pk2(a[4 * gq + 2] * b[4 * gq + 2], a[4 * gq + 3] * b[4 * gq + 3]);
            const unsigned bx = pk2(a[4 * gq + 4] * b[4 * gq + 4], a[4 * gq + 5] * b[4 * gq + 5]), by = pk2(a[4 * gq + 6] * b[4 * gq + 6], a[4 * gq + 7] * b[4 * gq + 7]);
            auto sx = __builtin_amdgcn_permlane32_swap(ax, bx, false, false);
            auto sy = __builtin_amdgcn_permlane32_swap(ay, by, false, false);
            u32x4 o; o.x = sx[0]; o.y = sy[0]; o.z = sx[1]; o.w = sy[1];
            *(u32x4*)(dst + (unsigned)((mb * 32 + r5) * 256 + 8 * (gq + hh))) = o;
        }
}
DI void epi_su_park(const f32x16 (&acc)[4][2], unsigned* lds_su, int lane) {
    lane = opaque_v(lane);
#pragma unroll
    for (int mb = 0; mb < 4; ++mb)
#pragma unroll
        for (int nb = 0; nb < 2; ++nb)
#pragma unroll
            for (int q = 0; q < 8; ++q) lds_su[((mb * 2 + nb) * 8 + q) * 64 + lane] = pk2(acc[mb][nb][2 * q], acc[mb][nb][2 * q + 1]);
}
DI void epi_sv(f32x16 (&acc)[4][2], const bf16_t* __restrict__ SWF  , const float* __restrict__ bs_g, const unsigned* lds_su, bf16_t* __restrict__ dst, float* T  , int lane) {
    lane = opaque_v(lane);
    const int r5 = lane & 31, hh = lane >> 5;
    bf16x8 vb[4][2][2];
#pragma unroll
    for (int mb = 0; mb < 4; ++mb) {
#pragma unroll
        for (int i = 0; i < 16; ++i) {
            float s1 = acc[mb][0][i] + acc[mb][1][i];
            s1 = red32_sum(s1);
            const float mu = s1 * (1.f / 64.f);
            const float d0 = acc[mb][0][i] - mu, d1 = acc[mb][1][i] - mu;
            float s2 = d0 * d0 + d1 * d1;
            s2 = red32_sum(s2);
            const float r = rsqrtf(s2 * (1.f / 64.f) + EPS);
            acc[mb][0][i] = d0 * r; acc[mb][1][i] = d1 * r;
        }
#pragma unroll
        for (int s = 0; s < 2; ++s)
#pragma unroll
            for (int nb = 0; nb < 2; ++nb) {
                const f32x16& a = acc[mb][nb];
                u32x4 o; o.x = pk2(a[8 * s], a[8 * s + 1]); o.y = pk2(a[8 * s + 2], a[8 * s + 3]); o.z = pk2(a[8 * s + 4], a[8 * s + 5]); o.w = pk2(a[8 * s + 6], a[8 * s + 7]);
                vb[mb][s][nb] = __builtin_bit_cast(bf16x8, o);
            }
    }
#pragma unroll
    for (int tb = 0; tb < 4; ++tb) {
        f32x16 y[2];
#pragma unroll
        for (int nb = 0; nb < 2; ++nb)
#pragma unroll
            for (int i = 0; i < 16; ++i) y[nb][i] = 0.f;
#pragma unroll
        for (int kt = 0; kt <= tb; ++kt)
#pragma unroll
            for (int s = 0; s < 2; ++s) {
                const bf16x8 wa = *(const bf16x8*)(SWF + ((unsigned)(((tb * 4 + kt) * 2 + s) * 64 + lane)) * 8);
                y[0] = MFMA32(wa, vb[kt][s][0], y[0]);
                y[1] = MFMA32(wa, vb[kt][s][1], y[1]);
            }
        float4 bsv[4];
#pragma unroll
        for (int g = 0; g < 4; ++g) bsv[g] = *(const float4*)(bs_g + tb * 32 + 8 * g + 4 * hh);
#pragma unroll
        for (int nb = 0; nb < 2; ++nb)
#pragma unroll
            for (int q = 0; q < 8; ++q) {
                const unsigned su2 = lds_su[((tb * 2 + nb) * 8 + q) * 64 + lane];
                const int i0 = 2 * q, i1 = 2 * q + 1;
                const int r0 = (i0 & 3) + 8 * (i0 >> 2) + 4 * hh, r1 = (i1 & 3) + 8 * (i1 >> 2) + 4 * hh;
                const float b0 = (q & 1) ? bsv[q >> 1].z : bsv[q >> 1].x, b1 = (q & 1) ? bsv[q >> 1].w : bsv[q >> 1].y;
                T[r0 * 68 + nb * 32 + r5] = (y[nb][i0] + b0) * __uint_as_float(su2 << 16);
                T[r1 * 68 + nb * 32 + r5] = (y[nb][i1] + b1) * __uint_as_float(su2 & 0xffff0000u);
            }
        asm volatile("s_waitcnt lgkmcnt(0)" ::: "memory");
        {
            const int row = lane >> 1, hf = lane & 1;
            const float* tp = T + row * 68 + hf * 32;
            bf16_t* op = dst + (unsigned)((tb * 32 + row) * 256 + hf * 32);
#pragma unroll
            for (int j = 0; j < 4; ++j) {
                const float4 a0 = *(const float4*)(tp + 8 * j), a1 = *(const float4*)(tp + 8 * j + 4);
                u32x4 o; o.x = pk2(a0.x, a0.y); o.y = pk2(a0.z, a0.w); o.z = pk2(a1.x, a1.y); o.w = pk2(a1.z, a1.w);
                *(u32x4*)(op + 8 * j) = o;
            }
        }
        asm volatile("s_waitcnt lgkmcnt(0)" ::: "memory");
    }
}

DI void conv_sguw_item(const float* __restrict__ W, bf16_t* __restrict__ SWF, int gid) {
    const int lane = gid & 63, s = (gid >> 6) & 1, kt = (gid >> 7) & 3, tb = (gid >> 9) & 3, g = gid >> 11;
    const int r = lane & 31, hh = lane >> 5, t = tb * 32 + r;
    const float* p = W + ((size_t)g * 128 + t) * 128;
    float v[8];
#pragma unroll
    for (int j = 0; j < 8; ++j) { const int sp = kt * 32 + 16 * s + 8 * (j >> 2) + 4 * hh + (j & 3); v[j] = sp <= t ? p[sp] : 0.f; }
    u32x4 o; o.x = pk2(v[0], v[1]); o.y = pk2(v[2], v[3]); o.z = pk2(v[4], v[5]); o.w = pk2(v[6], v[7]);
    *(u32x4*)(SWF + (size_t)gid * 8) = o;
}

DI int t5_bucket(int d) {
    if (d < 16) return d;
    const float lr = logf((float)d / 16.f) / logf(8.f);
    const int large = 16 + (int)(lr * 16.f);
    return large < 31 ? large : 31;
}

DI void attn_tile(const bf16_t* __restrict__ QF, const bf16_t* __restrict__ KF2, const bf16_t* __restrict__ VF, char* lds, const float* bias_lds, const float* __restrict__ sink, bf16_t* __restrict__ OR, int tile, int tid) {
    tid = opaque_v(tid); tile = opaque_s(tile);
    const int lane = tid & 63, w = __builtin_amdgcn_readfirstlane(tid >> 6), r5 = lane & 31, hh = lane >> 5;
    const bool has_prev = (tile & 31) != 0;
    {
        u32x4 tmp[16];
#pragma unroll
        for (int i = 0; i < 16; ++i) {
            const int blk = w * 16 + i;
            const int isv = blk >> 6, bb = blk & 63;
            const bf16_t* src;
            if (!isv) { const int kvh = bb >> 5, ks = (bb >> 3) & 3, wt = bb & 7, st = (wt >= 4 || !has_prev) ? tile : tile - 1;
                src = KF2 + ((unsigned)((((st * 2 + kvh) * 4 + ks) * 4 + (wt & 3)) * 64 + lane)) * 8; }
            else { const int kvh = bb >> 5, dt = (bb >> 4) & 1, wt = (bb >> 1) & 7, s2 = bb & 1, st = (wt >= 4 || !has_prev) ? tile : tile - 1;
                src = VF + ((unsigned)(((((st * 2 + kvh) * 2 + dt) * 4 + (wt & 3)) * 2 + s2) * 64 + lane)) * 8; }
            tmp[i] = *(const u32x4*)src;
        }
#pragma unroll
        for (int i = 0; i < 16; ++i) *(u32x4*)(lds + (w * 16 + i) * 1024 + lane * 16) = tmp[i];
    }
    __syncthreads();
    const char* ldsK = lds, *ldsV = lds + 65536;
    for (int task = w; task < 32; task += 8) {
        const int qh = task >> 2, qt = task & 3, kvh = qh >> 2;
        bf16x8 bq[4];
#pragma unroll
        for (int ks = 0; ks < 4; ++ks) bq[ks] = *(const bf16x8*)(QF + ((unsigned)((((tile * 8 + qh) * 4 + ks) * 4 + qt) * 64 + lane)) * 8);
        f32x16 sc[5];
#pragma unroll
        for (int jj = 0; jj < 5; ++jj) {
#pragma unroll
            for (int i = 0; i < 16; ++i) sc[jj][i] = 0.f;
#pragma unroll
            for (int ks = 0; ks < 4; ++ks) {
                const bf16x8 kf = *(const bf16x8*)(ldsK + ((kvh * 4 + ks) * 8 + qt + jj) * 1024 + lane * 16);
                sc[jj] = MFMA32(kf, bq[ks], sc[jj]);
            }
        }
        const float* bl = bias_lds + qh * 128;
        float m = -1e30f;
#pragma unroll
        for (int jj = 0; jj < 5; ++jj) {
            const bool ex = (qt + jj >= 4) || has_prev;
#pragma unroll
            for (int i = 0; i < 16; ++i) {
                const int cr = (i & 3) + 8 * (i >> 2) + 4 * hh;
                const int dist = 128 + r5 - 32 * jj - cr;
                const bool valid = ex && dist >= 0 && dist < 128;
                float bv = bl[dist & 127];
                asm volatile("" : "+v"(bv));
                const float v = valid ? sc[jj][i] + bv : -1e30f;
                sc[jj][i] = v; m = fmaxf(m, v);
            }
        }
        m = x32_max(m);
        const float sk = sink[qh];
        m = fmaxf(m, sk);
        float l = 0.f;
#pragma unroll
        for (int jj = 0; jj < 5; ++jj)
#pragma unroll
            for (int i = 0; i < 16; ++i) { const float p = __expf(sc[jj][i] - m); sc[jj][i] = p; l += p; }
        l = x32_sum(l);
        l += __expf(sk - m);
        const float rl = 1.f / l;
        f32x16 o[2];
#pragma unroll
        for (int dt = 0; dt < 2; ++dt)
#pragma unroll
            for (int i = 0; i < 16; ++i) o[dt][i] = 0.f;
#pragma unroll
        for (int jj = 0; jj < 5; ++jj) {
#pragma unroll
            for (int s = 0; s < 2; ++s) {
                const f32x16& a = sc[jj];
                u32x4 pp; pp.x = pk2(a[8 * s], a[8 * s + 1]); pp.y = pk2(a[8 * s + 2], a[8 * s + 3]); pp.z = pk2(a[8 * s + 4], a[8 * s + 5]); pp.w = pk2(a[8 * s + 6], a[8 * s + 7]);
                const bf16x8 pb = __builtin_bit_cast(bf16x8, pp);
#pragma unroll
                for (int dt = 0; dt < 2; ++dt) {
                    const bf16x8 vf = *(const bf16x8*)(ldsV + (((kvh * 2 + dt) * 8 + qt + jj) * 2 + s) * 1024 + lane * 16);
                    o[dt] = MFMA32(vf, pb, o[dt]);
                }
            }
        }
        bf16_t* orow = OR + (unsigned)((tile * 128 + qt * 32 + r5) * 512 + qh * 64 + 4 * hh);
#pragma unroll
        for (int dt = 0; dt < 2; ++dt)
#pragma unroll
            for (int gq = 0; gq < 4; gq += 2) {
                const unsigned ax = pk2(o[dt][4 * gq] * rl, o[dt][4 * gq + 1] * rl), ay = pk2(o[dt][4 * gq + 2] * rl, o[dt][4 * gq + 3] * rl);
                const unsigned bx = pk2(o[dt][4 * gq + 4] * rl, o[dt][4 * gq + 5] * rl), by = pk2(o[dt][4 * gq + 6] * rl, o[dt][4 * gq + 7] * rl);
                auto sx = __builtin_amdgcn_permlane32_swap(ax, bx, false, false);
                auto sy = __builtin_amdgcn_permlane32_swap(ay, by, false, false);
                u32x4 ov; ov.x = sx[0]; ov.y = sy[0]; ov.z = sx[1]; ov.w = sy[1];
                *(u32x4*)(OR + (unsigned)((tile * 128 + qt * 32 + r5) * 512 + qh * 64 + dt * 32 + 8 * (gq + hh))) = ov;
            }
    }
}

DI void unpack8(const u32x4 v, float (&f)[8]) {
    f[0] = __uint_as_float(v.x << 16); f[1] = __uint_as_float(v.x & 0xffff0000u); f[2] = __uint_as_float(v.y << 16); f[3] = __uint_as_float(v.y & 0xffff0000u);
    f[4] = __uint_as_float(v.z << 16); f[5] = __uint_as_float(v.z & 0xffff0000u); f[6] = __uint_as_float(v.w << 16); f[7] = __uint_as_float(v.w & 0xffff0000u);
}
DI void merge_tile(const bf16_t* __restrict__ OR, const bf16_t* __restrict__ CBR, const bf16_t* __restrict__ ZR, const bf16_t* __restrict__ YS, const float* __restrict__ cw  , const float* __restrict__ og  ,
                   bf16_t* __restrict__ mA, int tile, int tid) {
    tid = opaque_v(tid); tile = opaque_s(tile);
    const int lane = tid & 63, w = tid >> 6;
    float cwv[3][8], ga[8], gb[8];
    {
        const int c0 = (lane & 31) * 8;
#pragma unroll
        for (int j = 0; j < 3; ++j) { const float4 p0 = *(const float4*)(cw + j * 256 + c0), p1 = *(const float4*)(cw + j * 256 + c0 + 4);
            cwv[j][0] = p0.x; cwv[j][1] = p0.y; cwv[j][2] = p0.z; cwv[j][3] = p0.w; cwv[j][4] = p1.x; cwv[j][5] = p1.y; cwv[j][6] = p1.z; cwv[j][7] = p1.w; }
        const float4 a0 = *(const float4*)(og + lane * 8), a1 = *(const float4*)(og + lane * 8 + 4), b0 = *(const float4*)(og + 512 + lane * 8), b1 = *(const float4*)(og + 512 + lane * 8 + 4);
        ga[0] = a0.x; ga[1] = a0.y; ga[2] = a0.z; ga[3] = a0.w; ga[4] = a1.x; ga[5] = a1.y; ga[6] = a1.z; ga[7] = a1.w;
        gb[0] = b0.x; gb[1] = b0.y; gb[2] = b0.z; gb[3] = b0.w; gb[4] = b1.x; gb[5] = b1.y; gb[6] = b1.z; gb[7] = b1.w;
    }
#pragma unroll 8
    for (int rr = 0; rr < 16; ++rr) {
        const int row = w * 16 + rr, t = tile * 128 + row, pos = t & (S - 1);
        float a[8], y[8];
        unpack8(*(const u32x4*)(OR + (unsigned)(t * 512 + lane * 8)), a);
        float ssa = 0.f;
#pragma unroll
        for (int q = 0; q < 8; ++q) ssa += a[q] * a[q];
        ssa = wave_sum(ssa);
        {
            const int c0 = (lane & 31) * 8;
            float cb[8], z0[8], z1[8], z2[8], ys[8];
            const float m1 = pos >= 1 ? 1.f : 0.f, m2 = pos >= 2 ? 1.f : 0.f;
            const int t1 = pos >= 1 ? t - 1 : t, t2 = pos >= 2 ? t - 2 : t;
            unpack8(*(const u32x4*)(CBR + (unsigned)(t * 256 + c0)), cb);
            unpack8(*(const u32x4*)(ZR + (unsigned)(t * 256 + c0)), z2);
            unpack8(*(const u32x4*)(ZR + (unsigned)(t1 * 256 + c0)), z1);
            unpack8(*(const u32x4*)(ZR + (unsigned)(t2 * 256 + c0)), z0);
            unpack8(*(const u32x4*)(YS + (unsigned)(t * 256 + c0)), ys);
#pragma unroll
            for (int q = 0; q < 8; ++q) {
                const float yc = cb[q] * (cwv[0][q] * (z0[q] * m2) + cwv[1][q] * (z1[q] * m1) + cwv[2][q] * z2[q]);
                y[q] = lane < 32 ? yc : ys[q];
            }
        }
        float ssy = 0.f;
#pragma unroll
        for (int q = 0; q < 8; ++q) ssy += y[q] * y[q];
        ssy = red32_sum(ssy);
        const float ra = rsqrtf(ssa * (1.f / 512.f) + EPS), ry = rsqrtf(ssy * (1.f / 256.f) + EPS);
        const int mb = row >> 5, r5 = row & 31;
        {
            u32x4 o; o.x = pk2(a[0] * ra * ga[0], a[1] * ra * ga[1]); o.y = pk2(a[2] * ra * ga[2], a[3] * ra * ga[3]); o.z = pk2(a[4] * ra * ga[4], a[5] * ra * ga[5]); o.w = pk2(a[6] * ra * ga[6], a[7] * ra * ga[7]);
            const int c8 = lane;
            (void)c8;
            *(u32x4*)(mA + (unsigned)(t * 1024 + lane * 8)) = o;
        }
        {
            u32x4 o; o.x = pk2(y[0] * ry * gb[0], y[1] * ry * gb[1]); o.y = pk2(y[2] * ry * gb[2], y[3] * ry * gb[3]); o.z = pk2(y[4] * ry * gb[4], y[5] * ry * gb[5]); o.w = pk2(y[6] * ry * gb[6], y[7] * ry * gb[7]);
            const int c8 = 64 + lane;
            (void)c8;
            *(u32x4*)(mA + (unsigned)(t * 1024 + 512 + lane * 8)) = o;
        }
    }
}

struct InProjOut { bf16_t *QF, *KF2, *VF, *CBR, *ZR, *YS; };
DI void inproj_tile(const bf16_t* __restrict__ At, const bf16_t* __restrict__ WF, const float* __restrict__ qg, const float* __restrict__ kg, const bf16_t* __restrict__ SWF, const float* __restrict__ sgu_b,
                    const InProjOut& O, char* lds, int tile, int tid) {
    tid = opaque_v(tid); tile = opaque_s(tile);
    const int lane = tid & 63, w = __builtin_amdgcn_readfirstlane(tid >> 6);
    f32x16 acc[4][2];
    {
        const int nbt0 = w * 2;
        kloop<1>(acc, At, WF + (size_t)nbt0 * 32768, WF + (size_t)(nbt0 + 1) * 32768, lds, tid, lane);
        epi_qk(acc, qg, 0.125f, O.QF + (size_t)(tile * 8 + w) * 8192, lane);
    }
    {
        const int nbt0 = 16 + w * 2;
        if (w == 2 || w == 3) {
            kloop<0>(acc, At, WF + (size_t)nbt0 * 32768, WF + (size_t)(nbt0 + 1) * 32768, lds, tid, lane);
            epi_v(acc, O.VF + (size_t)(tile * 2 + (w - 2)) * 8192, lane);
        } else {
            kloop<1>(acc, At, WF + (size_t)nbt0 * 32768, WF + (size_t)(nbt0 + 1) * 32768, lds, tid, lane);
            if (w < 2) epi_qk(acc, kg, 1.f, O.KF2 + (size_t)(tile * 2 + w) * 8192, lane);
            else epi_row(acc, O.CBR + (size_t)tile * 128 * 256 + (w - 4) * 64, 256, lane);
        }
    }
    {
        const int nbt0 = 32 + w * 2;
        kloop<1>(acc, At, WF + (size_t)nbt0 * 32768, WF + (size_t)(nbt0 + 1) * 32768, lds, tid, lane);
        epi_z(acc, O.ZR + (size_t)tile * 128 * 256 + w * 32, lane);
    }
    {
        const int nbt0 = 48 + w * 2;
        kloop<0>(acc, At, WF + (size_t)nbt0 * 32768, WF + (size_t)(nbt0 + 1) * 32768, lds, tid, lane);
        unsigned* lds_su = (unsigned*)lds;
        if (w < 4) epi_su_park(acc, lds_su + w * 4096, lane);
        __syncthreads();
        if (w >= 4) epi_sv(acc, SWF + (size_t)(w - 4) * 16384, sgu_b + (w - 4) * 128, lds_su + (w - 4) * 4096, O.YS + (size_t)tile * 128 * 256 + (w - 4) * 64, (float*)(lds + 65536) + (w - 4) * 2176, lane);
        __syncthreads();
    }
}


struct Params {
    const float *x, *c, *rel_bias, *w_ada, *b_ada, *norm1_g, *norm2_g, *w_in, *q_norm_g, *k_norm_g, *attn_sink, *conv_w, *sgu_w, *sgu_b, *out_norm_g, *w_out, *peer_wq, *peer_sub_keys, *peer_down, *peer_up;
    float* out;
    char* ws;
};
constexpr size_t MiB = 1u << 20;
constexpr size_t WS_MOD = 0;
constexpr size_t WS_MODP = 1 * MiB;
constexpr size_t WS_WIN = 13 * MiB;
constexpr size_t WS_WOUT = 29 * MiB;
constexpr size_t WS_WPQ = 37 * MiB;
constexpr size_t WS_KEYS = 53 * MiB;
constexpr size_t WS_SWF = 55 * MiB;
constexpr size_t WS_SC = 56 * MiB;
constexpr size_t WS_TB = 57 * MiB;
constexpr size_t WS_HA = 185 * MiB;
constexpr size_t WS_QF = 249 * MiB;
constexpr size_t WS_KF2 = 602 * MiB;
constexpr size_t WS_VF = 634 * MiB;
constexpr size_t WS_ZR = 666 * MiB;
constexpr size_t WS_CBR = 345 * MiB;
constexpr size_t WS_YS = 361 * MiB;
constexpr size_t WS_OR = 377 * MiB;
constexpr size_t WS_QPF = 409 * MiB;
constexpr size_t WS_RIDX = 537 * MiB;
constexpr size_t WS_RGATE = 553 * MiB;
constexpr size_t WS_SEID = 569 * MiB;
constexpr size_t WS_SWGT = 585 * MiB;
constexpr size_t WS_OFFS = 601 * MiB;
constexpr size_t WS_FLAGS = 601 * MiB + 512 * 1024;
constexpr size_t WS_END = 730 * MiB;
static_assert(PL_END <= LDS_RSTD1, "expert-phase lists overlap persistent LDS state");

__global__ __launch_bounds__(512) void hybrid_fwd(Params P) {
    extern __shared__ __attribute__((aligned(16))) char lds[];
    cg::grid_group grid = cg::this_grid();
    const int tid = threadIdx.x, lane = tid & 63, w = __builtin_amdgcn_readfirstlane(tid >> 6);
    const int nblk = gridDim.x, hwb = blockIdx.x;
    const int bid = (nblk == NTILE) ? (hwb & 7) * 32 + (hwb >> 3) : hwb;
    char* ws = P.ws;
    float* mod = (float*)(ws + WS_MOD);
    float* modp = (float*)(ws + WS_MODP);
    bf16_t* WinF = (bf16_t*)(ws + WS_WIN); bf16_t* WoutF = (bf16_t*)(ws + WS_WOUT); bf16_t* WpqF = (bf16_t*)(ws + WS_WPQ);
    bf16_t* KeysF = (bf16_t*)(ws + WS_KEYS); bf16_t* SWF = (bf16_t*)(ws + WS_SWF);
    float* SC = (float*)(ws + WS_SC); unsigned char* TBd = (unsigned char*)(ws + WS_TB); unsigned char* TBu = TBd + 32 * MiB;
    bf16_t* hA = (bf16_t*)(ws + WS_HA);
    bf16_t* OR = (bf16_t*)(ws + WS_OR); bf16_t* QPF = (bf16_t*)(ws + WS_QPF);
    int* ridx = (int*)(ws + WS_RIDX); float* rgate = (float*)(ws + WS_RGATE);
    float* bias_lds = (float*)(lds + LDS_BIAS);
    unsigned* flags = (unsigned*)(ws + WS_FLAGS);

    {
        float* ca = (float*)lds;
        if (tid == 0) for (int tile = bid; tile < NTILE; tile += nblk) __hip_atomic_store(flags + tile, 0u, __ATOMIC_RELAXED, __HIP_MEMORY_SCOPE_AGENT);
        for (int i = tid; i < 8192; i += 512) { const float v = P.c[i]; ca[i] = v / (1.f + __expf(-v)); }
        for (int i = tid; i < 1024; i += 512) bias_lds[i] = P.rel_bias[t5_bucket(i & 127) * 8 + (i >> 7)];
        __syncthreads();
        for (int it = bid; it < 768; it += nblk) {
            const int jc = it % 12, l = (it / 12) & 3, ks = it / 48;
            const int j = jc * 512 + tid;
            const float* wp = P.w_ada + ((size_t)l * 1024 + ks * 64) * 6144 + j;
            float acc[8];
#pragma unroll
            for (int b = 0; b < 8; ++b) acc[b] = 0.f;
#pragma unroll 4
            for (int i = 0; i < 64; ++i) {
                const float wv = wp[(size_t)i * 6144];
#pragma unroll
                for (int b = 0; b < 8; ++b) acc[b] += ca[b * 1024 + ks * 64 + i] * wv;
            }
#pragma unroll
            for (int b = 0; b < 8; ++b) modp[((size_t)(ks * 4 + l) * 8 + b) * 6144 + j] = acc[b];
        }
        const int gthreads = nblk * 512, gtid = bid * 512 + tid;
        for (int rep = 0; rep < REP_P0; ++rep)
        for (int l = 0; l < DEPTH; ++l) {
            for (int g = gtid; g < 64 * 64 * 64; g += gthreads) conv_wfrag_item(P.w_in + (size_t)l * 1024 * 2048, 2048, 64, WinF + (size_t)l * 2097152, g, 1);
            for (int g = gtid; g < 32 * 64 * 64; g += gthreads) conv_wfrag_item(P.w_out + (size_t)l * 1024 * 1024, 1024, 64, WoutF + (size_t)l * 1048576, g, 0);
            for (int g = gtid; g < 64 * 64 * 64; g += gthreads) conv_wfrag_item(P.peer_wq + (size_t)l * 1024 * 2048, 2048, 64, WpqF + (size_t)l * 2097152, g, 0);
            for (int g = gtid; g < 32768; g += gthreads) conv_keys_item(P.peer_sub_keys + (size_t)l * 262144, KeysF + (size_t)l * 262144, g);
            for (int g = gtid; g < 8192; g += gthreads) conv_sguw_item(P.sgu_w + (size_t)l * 65536, SWF + (size_t)l * 65536, g);
        }
        const int gwaves = nblk * 8, gw = bid * 8 + w;
        for (int rep = 0; rep < REP_P0; ++rep)
        for (int r = gw; r < DEPTH * 16384 * 2; r += gwaves) {
            const int which = r & 1, le = r >> 1;
            conv_table_row((which ? P.peer_up : P.peer_down) + (size_t)le * D, (which ? TBu : TBd) + (size_t)le * 512, SC + (size_t)le * 2 + which, lane, which == 0);
        }
    }
    grid.sync();
    for (int tile = bid; tile < NTILE; tile += nblk) {
        const int b = tile >> 5;
        for (int l = 0; l < DEPTH; ++l)
            for (int j = tid; j < 6144; j += 512) {
                float v = P.b_ada[l * 6144 + j];
#pragma unroll
                for (int ks = 0; ks < 16; ++ks) v += modp[((size_t)(ks * 4 + l) * 8 + b) * 6144 + j];
                mod[((size_t)l * 8 + b) * 6144 + j] = v;
            }
    }
    __syncthreads();

    for (int l = 0; l < DEPTH; ++l) {
        const float* xin = l == 0 ? P.x : P.out;
        InProjOut IO;
        IO.QF = (bf16_t*)(ws + WS_QF); IO.KF2 = (bf16_t*)(ws + WS_KF2 + (size_t)l * 8 * MiB); IO.VF = (bf16_t*)(ws + WS_VF + (size_t)l * 8 * MiB);
        IO.CBR = (bf16_t*)(ws + WS_CBR); IO.ZR = (bf16_t*)(ws + WS_ZR + (size_t)l * 16 * MiB); IO.YS = (bf16_t*)(ws + WS_YS);
        for (int tile = bid; tile < NTILE; tile += nblk) {
            const float* mb_ = mod + ((size_t)l * 8 + (tile >> 5)) * 6144;
            if (l == 0) {
                norm_to_frag(xin, P.norm1_g + l * D, mb_ + 0, mb_ + 1024, hA, (float*)lds, tile, tid, false);
                __syncthreads();
            }
            for (int rep = 0; rep < REP_GEMM; ++rep) inproj_tile(hA + (size_t)tile * 131072, WinF + (size_t)l * 2097152, P.q_norm_g + l * 64, P.k_norm_g + l * 64, SWF + (size_t)l * 65536, P.sgu_b + l * 512, IO, lds, tile, tid);
            asm volatile("s_waitcnt vmcnt(0)" ::: "memory");
            __syncthreads();
            if (tid == 0) {
                __builtin_amdgcn_fence(__ATOMIC_RELEASE, "agent");
                asm volatile("s_waitcnt vmcnt(0)" ::: "memory");
                __hip_atomic_store(flags + tile, (unsigned)(l + 1), __ATOMIC_RELAXED, __HIP_MEMORY_SCOPE_AGENT);
            }
        }
        for (int tile = bid; tile < NTILE; tile += nblk) {
            const float* mb_ = mod + ((size_t)l * 8 + (tile >> 5)) * 6144;
            if ((tile & 31) != 0) {
                if (tid == 0) {
                    unsigned spins = 0;
                    while (__hip_atomic_load(flags + tile - 1, __ATOMIC_RELAXED, __HIP_MEMORY_SCOPE_AGENT) < (unsigned)(l + 1) && ++spins < (1u << 24)) __builtin_amdgcn_s_sleep(2);
                    __builtin_amdgcn_fence(__ATOMIC_ACQUIRE, "agent");
                    asm volatile("s_waitcnt vmcnt(0)" ::: "memory");
                }
                __syncthreads();
            }
            for (int rep = 0; rep < REP_MIX; ++rep) {
            attn_tile(IO.QF, IO.KF2, IO.VF, lds, bias_lds, P.attn_sink + l * 8, OR, tile, tid);
            __syncthreads();
            merge_tile(OR, IO.CBR, IO.ZR, IO.YS, P.conv_w + l * 768, P.out_norm_g + l * D, hA, tile, tid);
            __syncthreads();
            }
            {
                const bf16_t* At = hA + (size_t)tile * 131072;
                const bf16_t* WF = WoutF + (size_t)l * 1048576;
                for (int pass = 0; pass < 2; ++pass) {
                    f32x16 acc[4][2];
                    const int nbt0 = pass * 16 + w * 2;
                    kloop<0>(acc, At, WF + (size_t)nbt0 * 32768, WF + (size_t)(nbt0 + 1) * 32768, lds, tid, lane);
                    epi_resid(acc, xin, P.out, mb_ + 2048, (float*)(lds + LDS_EPI) + w * 2176, (float*)(lds + LDS_SSQ) + (pass * 8 + w) * 128, tile, pass * 512 + w * 64, lane);
                }
            }
            __syncthreads();
            if (tid < 128) { const float* sq = (const float*)(lds + LDS_SSQ); float ssum = 0.f;
#pragma unroll
                for (int c = 0; c < 16; ++c) ssum += sq[c * 128 + tid];
                ((float*)lds)[tid] = rsqrtf(ssum * (1.f / D) + EPS); }
            __syncthreads();
            norm_to_frag(P.out, P.norm2_g + l * D, mb_ + 3072, mb_ + 4096, hA, (float*)lds, tile, tid, true);
            __syncthreads();
            {
                const bf16_t* At = hA + (size_t)tile * 131072;
                const bf16_t* WF = WpqF + (size_t)l * 2097152;
                for (int rep = 0; rep < REP_GEMM; ++rep)
                for (int pass = 0; pass < 4; ++pass) {
                    f32x16 acc[4][2];
                    const int nbt0 = pass * 16 + w * 2;
                    kloop<1>(acc, At, WF + (size_t)nbt0 * 32768, WF + (size_t)(nbt0 + 1) * 32768, lds, tid, lane);
                    epi_qpf(acc, QPF, tile, nbt0, lane);
                }
            }
            __syncthreads();
            for (int rep = 0; rep < REP_ROUTE; ++rep) { route_tile(QPF, KeysF + (size_t)l * 262144, lds, (unsigned char*)lds + PL_RIDX, tile, tid); __syncthreads(); }
            peer_down_wave(hA, lds, TBd + (size_t)l * 16384 * 512, SC + (size_t)l * 32768, tile, w, lane);
            __syncthreads();
            {
                const float* mbn = mod + ((size_t)(l + 1 < DEPTH ? l + 1 : l) * 8 + (tile >> 5)) * 6144;
                peer_up_wave(lds, TBu + (size_t)l * 16384 * 512, mb_ + 5120, P.out, tile, w, lane, l + 1 < DEPTH ? hA : nullptr, P.norm1_g + (l + 1 < DEPTH ? l + 1 : l) * D, mbn + 0, mbn + 1024);
            }
            __syncthreads();
        }
    }
}
}

extern "C" void kernel_launch(void* const* d_in, const int* in_sizes, int n_in, void* d_out, int out_size, void* d_ws, size_t ws_size, hipStream_t stream) {
    using namespace op;
    static int grid_blocks = 0;
    if (!grid_blocks) {
        int dev = 0, cus = 0, per_cu = 0;
        (void)hipGetDevice(&dev);
        (void)hipDeviceGetAttribute(&cus, hipDeviceAttributeMultiprocessorCount, dev);
        (void)hipFuncSetAttribute((const void*)hybrid_fwd, hipFuncAttributeMaxDynamicSharedMemorySize, LDS_BYTES);
        (void)hipOccupancyMaxActiveBlocksPerMultiprocessor(&per_cu, (const void*)hybrid_fwd, 512, LDS_BYTES);
        if (per_cu < 1) per_cu = 1;
        grid_blocks = cus * per_cu;
        if (grid_blocks > NTILE) grid_blocks = NTILE;
        if (ws_size < WS_END) { fprintf(stderr, "kernel_launch: workspace too small (%zu < %zu)\n", ws_size, (size_t)WS_END); grid_blocks = -1; }
    }
    if (grid_blocks < 0) return;
    Params p{};
    p.x = (const float*)d_in[0]; p.c = (const float*)d_in[1]; p.rel_bias = (const float*)d_in[2]; p.w_ada = (const float*)d_in[3]; p.b_ada = (const float*)d_in[4];
    p.norm1_g = (const float*)d_in[5]; p.norm2_g = (const float*)d_in[6]; p.w_in = (const float*)d_in[7]; p.q_norm_g = (const float*)d_in[8]; p.k_norm_g = (const float*)d_in[9];
    p.attn_sink = (const float*)d_in[10]; p.conv_w = (const float*)d_in[11]; p.sgu_w = (const float*)d_in[12]; p.sgu_b = (const float*)d_in[13]; p.out_norm_g = (const float*)d_in[14];
    p.w_out = (const float*)d_in[15]; p.peer_wq = (const float*)d_in[16]; p.peer_sub_keys = (const float*)d_in[17]; p.peer_down = (const float*)d_in[18]; p.peer_up = (const float*)d_in[19];
    p.out = (float*)d_out; p.ws = (char*)d_ws;
    void* args[] = {&p};
    hipError_t e = hipLaunchCooperativeKernel((const void*)hybrid_fwd, dim3(grid_blocks), dim3(512), args, LDS_BYTES, stream);
    if (e != hipSuccess) fprintf(stderr, "kernel_launch: cooperative launch failed: %s (grid %d)\n", hipGetErrorString(e), grid_blocks);
}
```
